# Optimizing an MI355X kernel written in HIP

```python
import jax, jax.numpy as jnp
from jax import lax
import numpy as np

D_MODEL = 2048
BATCH = 2
SEQ = 4096
DEPTH = 4

GRID_W = 64
CTX_LEN = 256
MIX_WIDTH = D_MODEL
N_DIR = 2
LRU_WIDTH = MIX_WIDTH // 2
LRU_HEADS = 16
LRU_HEAD_DIM = LRU_WIDTH // LRU_HEADS
CONV_WIDTH = 4
LRU_C = 8.0
RWKV_WIDTH = MIX_WIDTH - LRU_WIDTH
RWKV_HEAD_DIM = 64
RWKV_HEADS = RWKV_WIDTH // RWKV_HEAD_DIM
DECAY_LORA = 64
AAA_LORA = 64
GATE_LORA = 160
RWKV_COLS = 3 * RWKV_WIDTH + N_DIR * DECAY_LORA + N_DIR * AAA_LORA + GATE_LORA
IN_COLS = 2 * LRU_WIDTH + RWKV_COLS
PEER_HEADS = 8
PEER_N_KEYS = 128
PEER_N_EXPERTS = PEER_N_KEYS * PEER_N_KEYS
PEER_D_QUERY = 256
PEER_TOPK = 16
PEER_BLOCK = 128
ALPHA = (2.0 * DEPTH) ** 0.25
BETA = (8.0 * DEPTH) ** -0.25
LN_EPS = 1e-5
GN_EPS = 64e-5

kernel_name = 'hybrid_rglru_rwkv7_peer_dit_trunk'


def layer_norm(z, g, b):
    zf = z.astype(jnp.float32)
    mu = jnp.mean(zf, -1, keepdims=True)
    var = jnp.mean(jnp.square(zf - mu), -1, keepdims=True)
    return ((zf - mu) * lax.rsqrt(var + LN_EPS) * g + b).astype(z.dtype)


def modulate(z, shift, scale):
    return z * (1.0 + scale) + shift


def grid_pos_embed(rows, dim):
    t = jnp.arange(rows * GRID_W)
    row = (t // GRID_W).astype(jnp.float32)
    col = (t % GRID_W).astype(jnp.float32)
    quarter = dim // 4
    freq = 1.0 / (10000.0 ** (jnp.arange(quarter, dtype=jnp.float32) / quarter))

    def sincos(p):
        ang = p[:, None] * freq[None, :]
        return jnp.concatenate([jnp.sin(ang), jnp.cos(ang)], axis=-1)

    return jnp.concatenate([sincos(row), sincos(col)], axis=-1)


def shift_prev(z):
    return jnp.pad(z, ((0, 0), (1, 0), (0, 0)))[:, :-1]


def shift_next(z):
    return jnp.pad(z, ((0, 0), (0, 1), (0, 0)))[:, 1:]


def centred_dwconv(z, w, b):
    T = z.shape[1]
    left = CONV_WIDTH // 2
    zp = jnp.pad(z, ((0, 0), (left, CONV_WIDTH - 1 - left), (0, 0)))
    out = b
    for tap in range(CONV_WIDTH):
        out = out + zp[:, tap:tap + T] * w[tap]
    return out


def linear_scan(a, b, h0, reverse):
    if reverse:
        a, b = a[:, ::-1], b[:, ::-1]

    def combine(left, right):
        a_l, b_l = left
        a_r, b_r = right
        return a_l * a_r, a_r * b_l + b_r

    a_cum, b_cum = lax.associative_scan(combine, (a, b), axis=1)
    h = b_cum + a_cum * h0[:, None, :]
    return h[:, ::-1] if reverse else h


def block_diag_linear(z, w, b):
    zh = z.reshape(z.shape[:-1] + (LRU_HEADS, LRU_HEAD_DIM))
    out = jnp.einsum('bthi,hij->bthj', zh, w)
    return out.reshape(z.shape) + b


def rglru_coeffs(xc, wa, ba, wx, bx, lam):
    r = jax.nn.sigmoid(block_diag_linear(xc, wa, ba))
    i = jax.nn.sigmoid(block_diag_linear(xc, wx, bx))
    log_a = -LRU_C * r * jax.nn.softplus(-lam)
    return jnp.exp(log_a), jnp.sqrt(-jnp.expm1(2.0 * log_a)) * (i * xc)


def rglru_group(u_ctx, u_lat, conv_w, conv_b, wa, ba, wx, bx, lam):
    xcs = [centred_dwconv(u, conv_w, conv_b).astype(jnp.float32) for u in (u_ctx, u_lat)]
    ys = [jnp.zeros_like(xc) for xc in xcs]
    for d in range(N_DIR):
        reverse = d == 1
        h_end = jnp.zeros_like(xcs[0][:, 0])
        for s, xc in enumerate(xcs):
            a, b_in = rglru_coeffs(xc, wa[d], ba[d], wx[d], bx[d], lam[d])
            h = linear_scan(a, b_in, h_end, reverse)
            h_end = h[:, 0] if reverse else h[:, -1]
            ys[s] = ys[s] + h
    return ys


def to_heads(z):
    return z.reshape(z.shape[:-1] + (RWKV_HEADS, RWKV_HEAD_DIM))


def rwkv7_prepare(rw, mu):
    rw = rw.astype(jnp.float32)
    rw = rw + mu[0] * (shift_prev(rw) - rw) + mu[1] * (shift_next(rw) - rw)
    o = 3 * RWKV_WIDTH
    r, k, v = rw[..., :RWKV_WIDTH], rw[..., RWKV_WIDTH:2 * RWKV_WIDTH], rw[..., 2 * RWKV_WIDTH:o]
    wd = rw[..., o:o + N_DIR * DECAY_LORA].reshape(rw.shape[:-1] + (N_DIR, DECAY_LORA))
    o += N_DIR * DECAY_LORA
    ad = rw[..., o:o + N_DIR * AAA_LORA].reshape(rw.shape[:-1] + (N_DIR, AAA_LORA))
    o += N_DIR * AAA_LORA
    gd = rw[..., o:]
    return r, k, v, wd, ad, gd


def rwkv7_coeffs(k, wd, ad, w0, w2, a0, a2, k_k, k_a):
    w = -jax.nn.softplus(-(w0 + jnp.tanh(wd) @ w2)) - 0.5
    decay = jnp.exp(-jnp.exp(w))
    a = jax.nn.sigmoid(a0 + ad @ a2)
    kk = to_heads(k * k_k)
    kk = kk * lax.rsqrt(jnp.maximum(jnp.sum(kk * kk, -1, keepdims=True), 1e-24))
    kd = k * (1.0 + (a - 1.0) * k_a)
    return to_heads(decay), to_heads(kd), kk, to_heads(a)


def rwkv7_scan(r, w, k, v, a_vec, b_vec, state0, reverse):
    def step(S, inp):
        r_t, w_t, k_t, v_t, a_t, b_t = inp
        sa = jnp.einsum('bhij,bhj->bhi', S, a_t)
        S = S * w_t[:, :, None, :] + sa[..., None] * b_t[:, :, None, :] + v_t[..., None] * k_t[:, :, None, :]
        return S, jnp.einsum('bhij,bhj->bhi', S, r_t)

    xs = tuple(jnp.moveaxis(t, 1, 0) for t in (r, w, k, v, a_vec, b_vec))
    state, ys = lax.scan(step, state0, xs, reverse=reverse)
    return state, jnp.moveaxis(ys, 0, 1)


def head_groupnorm(y, g, b):
    mu = jnp.mean(y, -1, keepdims=True)
    var = jnp.mean(jnp.square(y - mu), -1, keepdims=True)
    yn = (y - mu) * lax.rsqrt(var + GN_EPS)
    return yn.reshape(y.shape[:-2] + (RWKV_WIDTH,)) * g + b


def rwkv7_group(rw_ctx, rw_lat, mu, w0, w2, a0, a2, g2, k_k, k_a, r_k, gn_g, gn_b):
    segs = [rwkv7_prepare(rw, mu) for rw in (rw_ctx, rw_lat)]
    B_ = rw_ctx.shape[0]
    ys = [jnp.zeros(s[0].shape[:-1] + (RWKV_HEADS, RWKV_HEAD_DIM), jnp.float32) for s in segs]
    bonus = [jnp.zeros_like(y) for y in ys]
    for d in range(N_DIR):
        reverse = d == 1
        state = jnp.zeros((B_, RWKV_HEADS, RWKV_HEAD_DIM, RWKV_HEAD_DIM), jnp.float32)
        for s, (r, k, v, wd, ad, gd) in enumerate(segs):
            decay, kd, kk, a = rwkv7_coeffs(k, wd[..., d, :], ad[..., d, :], w0[d], w2[d], a0[d], a2[d], k_k, k_a)
            rh, vh = to_heads(r), to_heads(v)
            state, y = rwkv7_scan(rh, decay, kd, vh, -kk, kk * a, state, reverse)
            ys[s] = ys[s] + y
            bonus[s] = bonus[s] + jnp.sum(rh * kd * r_k, -1, keepdims=True) * vh
    outs = []
    for s, (r, k, v, wd, ad, gd) in enumerate(segs):
        g = jax.nn.sigmoid(gd) @ g2
        o = head_groupnorm(ys[s], gn_g, gn_b) + bonus[s].reshape(r.shape)
        outs.append(o * g)
    return outs


def token_mixer(h_ctx, h_lat, keep_ctx, w_in, conv_w, conv_b, wa, ba, wx, bx, lam,
                mu, w0, w2, a0, a2, g2, k_k, k_a, r_k, gn_g, gn_b, w_out):
    p_ctx, p_lat = h_ctx @ w_in, h_lat @ w_in
    y_lru = rglru_group(p_ctx[..., :LRU_WIDTH], p_lat[..., :LRU_WIDTH],
                        conv_w, conv_b, wa, ba, wx, bx, lam)
    y_rwkv = rwkv7_group(p_ctx[..., 2 * LRU_WIDTH:], p_lat[..., 2 * LRU_WIDTH:],
                         mu, w0, w2, a0, a2, g2, k_k, k_a, r_k, gn_g, gn_b)

    def merge(p, yl, yr):
        gate = jax.nn.gelu(p[..., LRU_WIDTH:2 * LRU_WIDTH].astype(jnp.float32))
        return jnp.concatenate([gate * yl, yr], axis=-1).astype(p.dtype) @ w_out

    o_lat = merge(p_lat, y_lru[1], y_rwkv[1])
    o_ctx = merge(p_ctx, y_lru[0], y_rwkv[0]) if keep_ctx else None
    return o_ctx, o_lat


def peer(h, w_q, sub_keys, u, v):
    B_, T, D = h.shape
    q = (h @ w_q).reshape(B_, T, PEER_HEADS, 2, PEER_D_QUERY // 2)
    s = jnp.einsum('bthpd,hpkd->bthpk', q, sub_keys).astype(jnp.float32)
    s1, i1 = lax.top_k(s[..., 0, :], PEER_TOPK)
    s2, i2 = lax.top_k(s[..., 1, :], PEER_TOPK)
    n_cand = PEER_TOPK * PEER_TOPK
    cand_s = (s1[..., :, None] + s2[..., None, :]).reshape(B_, T, PEER_HEADS, n_cand)
    cand_i = (i1[..., :, None] * PEER_N_KEYS + i2[..., None, :]).reshape(B_, T, PEER_HEADS, n_cand)
    top_s, pos = lax.top_k(cand_s, PEER_TOPK)
    idx = jnp.take_along_axis(cand_i, pos, axis=-1)
    gates = jax.nn.softmax(top_s, axis=-1).astype(h.dtype)
    n_blocks = (B_ * T) // PEER_BLOCK
    hb = h.reshape(n_blocks, PEER_BLOCK, D)
    ib = idx.reshape(n_blocks, PEER_BLOCK, PEER_HEADS * PEER_TOPK)
    gb = gates.reshape(n_blocks, PEER_BLOCK, PEER_HEADS * PEER_TOPK)

    def expert_block(args):
        h_blk, i_blk, g_blk = args
        act = jax.nn.gelu(jnp.einsum('nkd,nd->nk', u[i_blk], h_blk), approximate=False)
        return jnp.einsum('nk,nkd->nd', g_blk * act, v[i_blk])

    return lax.map(expert_block, (hb, ib, gb)).reshape(B_, T, D)


def setup_inputs(seed: int = 0) -> dict:
    key = jax.random.key(seed)
    ks = jax.random.split(key, 40)
    ctr = [0]

    def nxt():
        k = ks[ctr[0]]
        ctr[0] += 1
        return k

    def nrm(shape, std):
        return jax.random.normal(nxt(), shape, jnp.float32) * std

    def uni(shape, lo, hi):
        return jax.random.uniform(nxt(), shape, jnp.float32, lo, hi)

    D = D_MODEL
    x = nrm((BATCH, SEQ, D), 1.0)
    c = nrm((BATCH, D), 1.0)
    ctx = nrm((BATCH, CTX_LEN, D), 1.0)
    c_ctx = nrm((D,), 1.0)
    ada_w = nrm((DEPTH, D, 6 * D), D ** -0.5)
    ada_b = nrm((DEPTH, 6 * D), 0.02)
    w_in = nrm((DEPTH, D, IN_COLS), D ** -0.5)
    lru_conv_w = nrm((DEPTH, CONV_WIDTH, LRU_WIDTH), CONV_WIDTH ** -0.5)
    lru_conv_b = nrm((DEPTH, LRU_WIDTH), 0.02)
    lru_wa = nrm((DEPTH, N_DIR, LRU_HEADS, LRU_HEAD_DIM, LRU_HEAD_DIM), LRU_HEAD_DIM ** -0.5)
    lru_ba = nrm((DEPTH, N_DIR, LRU_WIDTH), 0.02)
    lru_wx = nrm((DEPTH, N_DIR, LRU_HEADS, LRU_HEAD_DIM, LRU_HEAD_DIM), LRU_HEAD_DIM ** -0.5)
    lru_bx = nrm((DEPTH, N_DIR, LRU_WIDTH), 0.02)
    a_base = uni((DEPTH, N_DIR, LRU_WIDTH), 0.9, 0.999) ** (1.0 / LRU_C)
    lru_lambda = jnp.log(a_base) - jnp.log1p(-a_base)
    rwkv_mu = uni((DEPTH, 2, RWKV_COLS), 0.0, 0.5)
    rwkv_w0 = uni((DEPTH, N_DIR, RWKV_WIDTH), -6.0, -1.0)
    rwkv_w2 = nrm((DEPTH, N_DIR, DECAY_LORA, RWKV_WIDTH), 0.5 * DECAY_LORA ** -0.5)
    rwkv_a0 = nrm((DEPTH, N_DIR, RWKV_WIDTH), 0.1)
    rwkv_a2 = nrm((DEPTH, N_DIR, AAA_LORA, RWKV_WIDTH), AAA_LORA ** -0.5)
    rwkv_g2 = nrm((DEPTH, GATE_LORA, RWKV_WIDTH), GATE_LORA ** -0.5)
    rwkv_k_k = 0.85 + nrm((DEPTH, RWKV_WIDTH), 0.02)
    rwkv_k_a = 1.0 + nrm((DEPTH, RWKV_WIDTH), 0.02)
    rwkv_r_k = nrm((DEPTH, RWKV_HEADS, RWKV_HEAD_DIM), 0.1)
    rwkv_gn_g = 1.0 + nrm((DEPTH, RWKV_WIDTH), 0.05)
    rwkv_gn_b = nrm((DEPTH, RWKV_WIDTH), 0.02)
    w_out = nrm((DEPTH, MIX_WIDTH, D), BETA * MIX_WIDTH ** -0.5)
    ln1_g = 1.0 + nrm((DEPTH, D), 0.05)
    ln1_b = nrm((DEPTH, D), 0.02)
    peer_wq = nrm((DEPTH, D, PEER_HEADS * PEER_D_QUERY), D ** -0.5)
    peer_subkeys = nrm((DEPTH, PEER_HEADS, 2, PEER_N_KEYS, PEER_D_QUERY // 2), (PEER_D_QUERY // 2) ** -0.5)
    peer_u = nrm((DEPTH, PEER_N_EXPERTS, D), D ** -0.5)
    peer_v = nrm((DEPTH, PEER_N_EXPERTS, D), BETA)
    ln2_g = 1.0 + nrm((DEPTH, D), 0.05)
    ln2_b = nrm((DEPTH, D), 0.02)
    return {'x': x, 'c': c, 'ctx': ctx, 'c_ctx': c_ctx, 'ada_w': ada_w, 'ada_b': ada_b,
            'w_in': w_in, 'lru_conv_w': lru_conv_w, 'lru_conv_b': lru_conv_b,
            'lru_wa': lru_wa, 'lru_ba': lru_ba, 'lru_wx': lru_wx, 'lru_bx': lru_bx,
            'lru_lambda': lru_lambda, 'rwkv_mu': rwkv_mu, 'rwkv_w0': rwkv_w0, 'rwkv_w2': rwkv_w2,
            'rwkv_a0': rwkv_a0, 'rwkv_a2': rwkv_a2, 'rwkv_g2': rwkv_g2, 'rwkv_k_k': rwkv_k_k,
            'rwkv_k_a': rwkv_k_a, 'rwkv_r_k': rwkv_r_k, 'rwkv_gn_g': rwkv_gn_g, 'rwkv_gn_b': rwkv_gn_b,
            'w_out': w_out, 'ln1_g': ln1_g, 'ln1_b': ln1_b, 'peer_wq': peer_wq,
            'peer_subkeys': peer_subkeys, 'peer_u': peer_u, 'peer_v': peer_v,
            'ln2_g': ln2_g, 'ln2_b': ln2_b}


def reference(x, c, ctx, c_ctx, ada_w, ada_b, w_in, lru_conv_w, lru_conv_b, lru_wa, lru_ba,
              lru_wx, lru_bx, lru_lambda, rwkv_mu, rwkv_w0, rwkv_w2, rwkv_a0, rwkv_a2, rwkv_g2,
              rwkv_k_k, rwkv_k_a, rwkv_r_k, rwkv_gn_g, rwkv_gn_b, w_out, ln1_g, ln1_b,
              peer_wq, peer_subkeys, peer_u, peer_v, ln2_g, ln2_b):
    rows = x.shape[1] // GRID_W
    x = x + grid_pos_embed(rows, D_MODEL).astype(x.dtype)[None]
    n_ctx = ctx.shape[1]
    c_act = jax.nn.silu(c)
    cc_act = jax.nn.silu(c_ctx)
    for l in range(DEPTH):
        keep_ctx = l < DEPTH - 1
        mod_lat = (c_act @ ada_w[l] + ada_b[l])[:, None, :]
        mod_ctx = (cc_act @ ada_w[l] + ada_b[l])[None, None, :]
        sh1, sc1, gt1, sh2, sc2, gt2 = jnp.split(mod_lat, 6, axis=-1)
        csh1, csc1, cgt1, csh2, csc2, cgt2 = jnp.split(mod_ctx, 6, axis=-1)
        o_ctx, o_lat = token_mixer(
            modulate(ctx, csh1, csc1), modulate(x, sh1, sc1), keep_ctx, w_in[l],
            lru_conv_w[l], lru_conv_b[l], lru_wa[l], lru_ba[l], lru_wx[l], lru_bx[l], lru_lambda[l],
            rwkv_mu[l], rwkv_w0[l], rwkv_w2[l], rwkv_a0[l], rwkv_a2[l], rwkv_g2[l],
            rwkv_k_k[l], rwkv_k_a[l], rwkv_r_k[l], rwkv_gn_g[l], rwkv_gn_b[l], w_out[l])
        x = layer_norm(ALPHA * x + gt1 * o_lat, ln1_g[l], ln1_b[l])
        if keep_ctx:
            ctx = layer_norm(ALPHA * ctx + cgt1 * o_ctx, ln1_g[l], ln1_b[l])
            h2 = jnp.concatenate([modulate(ctx, csh2, csc2), modulate(x, sh2, sc2)], axis=1)
            f = peer(h2, peer_wq[l], peer_subkeys[l], peer_u[l], peer_v[l])
            ctx = layer_norm(ALPHA * ctx + cgt2 * f[:, :n_ctx], ln2_g[l], ln2_b[l])
            f_lat = f[:, n_ctx:]
        else:
            f_lat = peer(modulate(x, sh2, sc2), peer_wq[l], peer_subkeys[l], peer_u[l], peer_v[l])
        x = layer_norm(ALPHA * x + gt2 * f_lat, ln2_g[l], ln2_b[l])
    return x
```

```cpp
#include <hip/hip_runtime.h>
#include <cstdio>
#include <cstdint>

constexpr int D = 2048, NB = 2, SEQ = 4096, DEPTH = 4, CTXL = 256;
constexpr int NLAT = NB * SEQ, NCTX = NB * CTXL, MTOT = NLAT + NCTX;
constexpr int LRW = 1024, RWW = 1024, NH = 16, HD = 64;
constexpr int RW_COLS = 3488, IN_COLS = 5536, IN_PAD = 5632;
constexpr int PE_H = 8, PE_K = 128, PE_DQ = 256, PE_TOP = 16, PE_NE = 16384, PE_SEL = PE_H * PE_TOP;
constexpr int NTILE = MTOT / 64;
constexpr float ALPHA = 1.681792830507429f;
constexpr float LN_EPS = 1e-5f, GN_EPS = 64e-5f;
constexpr int KSPLIT = 16;

enum { I_X = 0, I_C, I_CTX, I_CCTX, I_ADAW, I_ADAB, I_WIN, I_CONVW, I_CONVB, I_WA, I_BA, I_WX, I_BX, I_LAM, I_MU, I_W0, I_W2, I_A0, I_A2, I_G2,
       I_KK, I_KA, I_RK, I_GNG, I_GNB, I_WOUT, I_LN1G, I_LN1B, I_WQ, I_SUBK, I_U, I_V, I_LN2G, I_LN2B, N_IN };

constexpr size_t MiB = 1u << 20;
constexpr size_t al(size_t x) { return (x + MiB - 1) / MiB * MiB; }
constexpr size_t WS_CTL = 0, CTL_ZERO_BYTES = 1 * MiB;
constexpr size_t WS_MOD   = WS_CTL + CTL_ZERO_BYTES;
constexpr size_t WS_MODP  = al(WS_MOD + (size_t)DEPTH * 3 * 6 * D * 4);
constexpr size_t WS_WIN   = al(WS_MODP + (size_t)KSPLIT * DEPTH * 3 * 6 * D * 4);
constexpr size_t WS_WOUT  = al(WS_WIN + (size_t)DEPTH * IN_PAD * D * 2);
constexpr size_t WS_WQ    = al(WS_WOUT + (size_t)DEPTH * D * D * 2);
constexpr size_t WS_SUBK  = al(WS_WQ + (size_t)DEPTH * D * D * 2);
constexpr size_t WS_WLRU  = al(WS_SUBK + (size_t)DEPTH * 8 * 2 * 128 * 128 * 2);
constexpr size_t WS_W2T   = al(WS_WLRU + (size_t)DEPTH * 2 * 2 * 16 * 64 * 64 * 2);
constexpr size_t WS_A2T   = al(WS_W2T + (size_t)DEPTH * 2 * 1024 * 64 * 2);
constexpr size_t WS_G2T   = al(WS_A2T + (size_t)DEPTH * 2 * 1024 * 64 * 2);
constexpr size_t WS_UB    = al(WS_G2T + (size_t)DEPTH * 1024 * 160 * 2);
constexpr size_t WS_VB    = al(WS_UB + (size_t)DEPTH * PE_NE * D * 2);
constexpr size_t WS_X     = al(WS_VB + (size_t)DEPTH * PE_NE * D * 2);
constexpr size_t WS_H     = al(WS_X + (size_t)MTOT * D * 4);
constexpr size_t WS_P     = al(WS_H + (size_t)MTOT * D * 2);
constexpr size_t WS_LA    = al(WS_P + (size_t)MTOT * IN_PAD * 4);
constexpr size_t WS_LB    = al(WS_LA + (size_t)2 * MTOT * LRW * 4);
constexpr size_t WS_YL    = al(WS_LB + (size_t)2 * MTOT * LRW * 4);
constexpr size_t WS_RR    = al(WS_YL + (size_t)2 * MTOT * LRW * 4);
constexpr size_t WS_RV    = al(WS_RR + (size_t)MTOT * RWW * 4);
constexpr size_t WS_RKK   = al(WS_RV + (size_t)MTOT * RWW * 4);
constexpr size_t WS_RW    = al(WS_RKK + (size_t)MTOT * RWW * 4);
constexpr size_t WS_RKD   = al(WS_RW + (size_t)2 * MTOT * RWW * 4);
constexpr size_t WS_RBV   = al(WS_RKD + (size_t)2 * MTOT * RWW * 4);
constexpr size_t WS_YR    = al(WS_RBV + (size_t)2 * MTOT * RWW * 4);
constexpr size_t WS_BETA  = al(WS_YR + (size_t)2 * MTOT * RWW * 4);
constexpr size_t WS_IDX   = al(WS_BETA + (size_t)MTOT * NH * 4);
constexpr size_t WS_GATE  = al(WS_IDX + (size_t)MTOT * PE_SEL * 4);
constexpr size_t WS_END   = al(WS_GATE + (size_t)MTOT * PE_SEL * 4);
constexpr size_t WS_O = WS_P;
constexpr size_t WS_QP = WS_P + (size_t)MTOT * D * 4;
static_assert(WS_QP + (size_t)MTOT * D * 4 <= WS_LA, "O/QP overlay inside P");

constexpr int CW_BAR = 4096;

constexpr int RING_BYTES = 131072;
constexpr int LDSCTL_OFF = RING_BYTES, MISC_OFF = LDSCTL_OFF + 320;
constexpr int LDS_BYTES = 147456;
constexpr int NWAVES = 8, NTHR = 512;

#define GAS __attribute__((address_space(1)))
#define LAS __attribute__((address_space(3)))
typedef unsigned short bf16;
typedef unsigned v4u __attribute__((ext_vector_type(4)));
typedef unsigned v2u __attribute__((ext_vector_type(2)));
typedef float f32x4 __attribute__((ext_vector_type(4)));
typedef float f32x2 __attribute__((ext_vector_type(2)));
typedef short bf16x8 __attribute__((ext_vector_type(8)));
#define RLX_AGENT __ATOMIC_RELAXED, __HIP_MEMORY_SCOPE_AGENT
#define LDS_WAIT() asm volatile("s_waitcnt lgkmcnt(0)" ::: "memory")
#define VM_WAIT() asm volatile("s_waitcnt vmcnt(0)" ::: "memory")

__device__ __forceinline__ unsigned f2bf(float f) { unsigned u = __builtin_bit_cast(unsigned, f); return (u + 0x7fffu + ((u >> 16) & 1u)) >> 16; }
__device__ __forceinline__ unsigned pk2(float lo, float hi) { return f2bf(lo) | (f2bf(hi) << 16); }
__device__ __forceinline__ float bf_lo(unsigned w) { return __builtin_bit_cast(float, w << 16); }
__device__ __forceinline__ float bf_hi(unsigned w) { return __builtin_bit_cast(float, w & 0xffff0000u); }
__device__ __forceinline__ float fexp(float x) { return __builtin_amdgcn_exp2f(x * 1.4426950408889634f); }
__device__ __forceinline__ float fsigmoid(float x) { return __builtin_amdgcn_rcpf(1.0f + fexp(-x)); }
__device__ __forceinline__ float fsoftplus(float x) { return fmaxf(x, 0.f) + log1pf(fexp(-fabsf(x))); }
__device__ __forceinline__ float ftanh(float x) { const float e = fexp(2.0f * x); return 1.0f - 2.0f * __builtin_amdgcn_rcpf(e + 1.0f); }
__device__ __forceinline__ float gelu_tanh(float x) { return 0.5f * x * (1.0f + ftanh(0.7978845608028654f * (x + 0.044715f * x * x * x))); }
__device__ __forceinline__ float gelu_erf(float v) {
    const float av = fabsf(v), t = __builtin_amdgcn_rcpf(av * 0.2316418882f + 1.0f);
    float q = t * 0.5307027145f + (-0.7265760135f); q = q * t + 0.7107068705f; q = q * t + (-0.142248368f); q = q * t + 0.127414796f; q = q * t;
    const float e = __builtin_amdgcn_exp2f((v * v) * (-0.72134752044f));
    const float m = v * (q * e);
    return v < 0.f ? m : v - m;
}
template <int CTRL> __device__ __forceinline__ float dpp_f(float v) { return __builtin_bit_cast(float, __builtin_amdgcn_update_dpp(0, __builtin_bit_cast(int, v), CTRL, 0xf, 0xf, true)); }
__device__ __forceinline__ float red8(float v) { v += dpp_f<0xB1>(v); v += dpp_f<0x4E>(v); v += dpp_f<0x141>(v); return v; }
__device__ __forceinline__ float red16(float v) { v = red8(v); v += dpp_f<0x140>(v); return v; }
__device__ __forceinline__ float wave_sum(float v) { v = red16(v); v += __shfl_xor(v, 16); v += __shfl_xor(v, 32); return v; }
#define MK_PER_PHASE 1
#define XB_TMO      128
#define XB_XCNT(j)  (256  + 64 * (j))
#define XB_XSUB(j)  (1280 + 64 * (j))
#define XB_XGEN(j)  (2304 + 64 * (j))
#define XB_TOP      3328
#define XB_TOPGEN   3392
#define XCD_BAR_WORDS 3456
#define XB_SPIN_CAP (1u << 18)

__device__ __forceinline__ unsigned xb_ld(unsigned* p)              { return __hip_atomic_load(p, __ATOMIC_RELAXED, __HIP_MEMORY_SCOPE_AGENT); }
__device__ __forceinline__ unsigned xb_add(unsigned* p, unsigned v) { return __hip_atomic_fetch_add(p, v, __ATOMIC_RELAXED, __HIP_MEMORY_SCOPE_AGENT); }
__device__ __forceinline__ unsigned xb_xcc_id() { return (unsigned)__builtin_amdgcn_s_getreg((3 << 11) | 20) & 0xFu; }
#define XB_SPIN(cond, bar) do { unsigned _sp = 0; while (cond) { __builtin_amdgcn_s_sleep(1); \
    if ((++_sp & 255u) == 0u) { if (xb_ld(&(bar)[XB_TMO])) break; if (_sp > XB_SPIN_CAP) { atomicAdd(&(bar)[XB_TMO], 1u); break; } } } } while (0)

struct XcdBarrier {
    unsigned* bar; unsigned x;
    volatile LAS unsigned* st;
};

__device__ __forceinline__ XcdBarrier xcd_barrier_post(unsigned* bar, volatile LAS unsigned* st) {
    XcdBarrier b; b.bar = bar; b.x = xb_xcc_id(); b.st = st;
    if (threadIdx.x == 0) (void)xb_add(&bar[XB_XCNT(b.x)], 1u);
    return b;
}
__device__ __forceinline__ void xcd_barrier_complete(unsigned* bar, unsigned x, unsigned& nloc, unsigned& nx) {
    const unsigned G = gridDim.x * gridDim.y * gridDim.z;
    unsigned sum, cnt, mine, sp = 0u;
    for (;;) {
        sum = 0u; cnt = 0u; mine = 0u;
#pragma unroll
        for (unsigned j = 0; j < 16; ++j) { const unsigned c = xb_ld(&bar[XB_XCNT(j)]); sum += c; cnt += (c > 0u) ? 1u : 0u; mine = (j == x) ? c : mine; }
        if (sum == G) break;
        __builtin_amdgcn_s_sleep(1);
        if ((++sp & 255u) == 0u) { if (xb_ld(&bar[XB_TMO])) break; if (sp > XB_SPIN_CAP) { atomicAdd(&bar[XB_TMO], 1u); break; } }
    }
    nloc = mine > 0u ? mine : 1u; nx = cnt > 0u ? cnt : 1u;
}

__device__ __forceinline__ void xcd_barrier(const XcdBarrier& b) {
    asm volatile("s_waitcnt vmcnt(0)" ::: "memory");
    __syncthreads();
    if (threadIdx.x == 0) {
        unsigned* bar = b.bar;
        __builtin_amdgcn_s_waitcnt(0);
        unsigned nloc = b.st[0], nx = b.st[1];
        if (nloc == 0u) { xcd_barrier_complete(bar, b.x, nloc, nx); b.st[0] = nloc; b.st[1] = nx; }
        const unsigned old = xb_add(&bar[XB_XSUB(b.x)], 1u);
        const unsigned gen = old / nloc;
        if (old + 1u == (gen + 1u) * nloc) {
            __builtin_amdgcn_fence(__ATOMIC_RELEASE, "agent");
            asm volatile("s_waitcnt vmcnt(0)" ::: "memory");
            const unsigned og = xb_add(&bar[XB_TOP], 1u);
            const unsigned tg = og / nx;
            if (og + 1u == (tg + 1u) * nx) xb_add(&bar[XB_TOPGEN], 1u);
            else XB_SPIN(xb_ld(&bar[XB_TOPGEN]) == tg, bar);
            __builtin_amdgcn_fence(__ATOMIC_ACQUIRE, "agent");
            xb_add(&bar[XB_XGEN(b.x)], 1u);
            asm volatile("s_waitcnt vmcnt(0)" ::: "memory");
        } else {
            XB_SPIN(xb_ld(&bar[XB_XGEN(b.x)]) == gen, bar);
            __builtin_amdgcn_fence(__ATOMIC_ACQUIRE, "agent");
            asm volatile("s_waitcnt vmcnt(0)" ::: "memory");
        }
    }
    __syncthreads();
}
namespace pg8 {
#define PG8_LAS __attribute__((address_space(3)))
typedef unsigned short bf16_t;
typedef short bf16x8 __attribute__((ext_vector_type(8)));
typedef float f32x4 __attribute__((ext_vector_type(4)));
typedef unsigned u32x4 __attribute__((ext_vector_type(4)));
constexpr int BM = 256, BK = 64, HALF = 128, HTB = HALF * BK * 2  , STAGE_BYTES = 8 * HTB, NXCD = 8, WGM = 8;

__host__ __device__ __forceinline__ int lds_byte(int r, int c) { const int st = (r >> 4) * 2 + (c >> 5), rr = r & 15, cc = c & 31, ob = rr * 64 + cc * 2; return st * 1024 + (ob ^ (((ob >> 9) & 1) << 5)); }
__host__ __device__ __forceinline__ void stage_rc(int b, int& R, int& C) { const int st = b / 1024, sb = b % 1024, swz = sb ^ (((sb >> 9) & 1) << 5); R = (st >> 1) * 16 + swz / 64; C = (st & 1) * 32 + (swz % 64) / 2; }
__host__ __device__ __forceinline__ int perm32(int rho) { const int n = rho >> 4, i = rho & 15; return 8 * (i >> 2) + 4 * n + (i & 3); }

struct Unit { int pm, pn; };
struct Gemm { const bf16_t* A; const bf16_t* Bt; int M, N, K; };

struct StaticOrder {
    int nM, nN, nwg, G, c;
    __host__ __device__ void init(int M, int N, int G_, int c_) { nM = M / BM; nN = N / BM; nwg = nM * nN; G = G_; c = c_; }
    __host__ __device__ bool next(int i, Unit& u) const {
        const long L = (long)i * G + c; if (L >= nwg) return false;
        int wgid = (int)L; { const int q = nwg / NXCD, r = nwg % NXCD, xcd = wgid % NXCD, off = wgid / NXCD; wgid = (xcd < r ? xcd * (q + 1) : r * (q + 1) + (xcd - r) * q) + off; }
        const int nig = WGM * nN, gid = wgid / nig, fm = gid * WGM, gsz = (nM - fm) < WGM ? (nM - fm) : WGM;
        u.pm = fm + ((wgid % nig) % gsz); u.pn = (wgid % nig) / gsz; return true;
    }
    __device__ __forceinline__ void a_ready(const Unit&) const {}
    __device__ __forceinline__ void done(const Unit&) const {}
};
struct CountedOrder : StaticOrder {
    const unsigned* ready; unsigned need; unsigned* tmo;
    __device__ __forceinline__ void a_ready(const Unit& u) const {
        if (threadIdx.x < 64) {
            const unsigned long long t0 = __builtin_amdgcn_s_memrealtime(); unsigned polls = 0;
            while ((unsigned)__builtin_amdgcn_readfirstlane(__hip_atomic_load(ready + 64 * u.pm, __ATOMIC_RELAXED, __HIP_MEMORY_SCOPE_AGENT)) < need) {
                if ((++polls & 255u) == 0u && __builtin_amdgcn_readfirstlane(__hip_atomic_load(tmo, __ATOMIC_RELAXED, __HIP_MEMORY_SCOPE_AGENT)) != 0u) break;
                if (__builtin_amdgcn_s_memrealtime() - t0 > 2000000ull) {
                    if (threadIdx.x == 0) { unsigned expect = 0u; __hip_atomic_compare_exchange_strong(tmo + 1, &expect, 0x600u | (unsigned)(u.pm & 0xff), __ATOMIC_RELAXED, __ATOMIC_RELAXED, __HIP_MEMORY_SCOPE_AGENT); __hip_atomic_store(tmo, 1u, __ATOMIC_RELAXED, __HIP_MEMORY_SCOPE_AGENT); }
                    break; }
                __builtin_amdgcn_s_sleep(2); }
            __builtin_amdgcn_fence(__ATOMIC_ACQUIRE, "agent");
            asm volatile("s_waitcnt vmcnt(0)" ::: "memory");
        }
#if !defined(BROKEN_HOOK_NO_BARRIER)
        asm volatile("" ::: "memory"); __builtin_amdgcn_s_barrier(); asm volatile("" ::: "memory");
#endif
    }
};

__device__ __forceinline__ unsigned cvt_pk_bf16(float lo, float hi) { unsigned r; asm volatile("v_cvt_pk_bf16_f32 %0, %1, %2" : "=v"(r) : "v"(lo), "v"(hi)); return r; }
typedef float f32x2 __attribute__((ext_vector_type(2)));
__device__ __forceinline__ f32x2 gelu_pk(f32x2 v) {
    const f32x2 av = __builtin_elementwise_abs(v), d = av * 0.2316418882f + 1.0f;
    f32x2 t; t.x = __builtin_amdgcn_rcpf(d.x); t.y = __builtin_amdgcn_rcpf(d.y);
    f32x2 q = t * 0.5307027145f + (-0.7265760135f); q = q * t + 0.7107068705f; q = q * t + (-0.142248368f); q = q * t + 0.127414796f; q = q * t;
    const f32x2 s = (v * v) * (-0.72134752044f);
    f32x2 e; e.x = __builtin_amdgcn_exp2f(s.x); e.y = __builtin_amdgcn_exp2f(s.y);
    const f32x2 m = v * (q * e), r = v - m;
    f32x2 o; o.x = v.x < 0.f ? m.x : r.x; o.y = v.y < 0.f ? m.y : r.y; return o;
}

struct EpiF32 {
    static constexpr bool PERM = false, AFTER_DRAIN = false;
    float* C; int ldc; const float* bias;
    __device__ __forceinline__ void operator()(const f32x4 (&acc)[2][2][4][2], const Unit& u, int wr, int wc, int fr, int fq) const {
        const int row0 = u.pm * BM + wr * 64 + fr, col0 = u.pn * BM + wc * 32 + 4 * fq;
        f32x4 bv[2][2];
#pragma unroll
        for (int bj = 0; bj < 2; ++bj)
#pragma unroll
            for (int n = 0; n < 2; ++n) bv[bj][n] = bias ? *(const f32x4*)(bias + col0 + bj * HALF + n * 16) : (f32x4){0.f, 0.f, 0.f, 0.f};
#pragma unroll
        for (int ai = 0; ai < 2; ++ai)
#pragma unroll
            for (int m = 0; m < 4; ++m) { float* rowp = C + (size_t)(row0 + ai * HALF + m * 16) * ldc + col0;
#pragma unroll
                for (int bj = 0; bj < 2; ++bj)
#pragma unroll
                    for (int n = 0; n < 2; ++n) *(f32x4*)(rowp + bj * HALF + n * 16) = acc[ai][bj][m][n] + bv[bj][n]; }
    }
};
template <int ACT  > struct EpiBf16 {
    static constexpr bool PERM = true, AFTER_DRAIN = false;
    bf16_t* O; int ldc; const float* bias; int split_cols; size_t split_stride;
    __device__ __forceinline__ void operator()(const f32x4 (&acc)[2][2][4][2], const Unit& u, int wr, int wc, int fr, int fq) const {
        const int row0 = u.pm * BM + wr * 64 + fr; int colt = u.pn * BM; bf16_t* base = O;
        if (split_cols) { const int t = colt / split_cols; base += (size_t)t * split_stride; colt -= t * split_cols; }
        const int col0 = colt + wc * 32 + 8 * fq, bcol0 = u.pn * BM + wc * 32 + 8 * fq;
        f32x4 bv[2][2];
#pragma unroll
        for (int bj = 0; bj < 2; ++bj)
#pragma unroll
            for (int n = 0; n < 2; ++n) bv[bj][n] = bias ? *(const f32x4*)(bias + bcol0 + bj * HALF + 4 * n) : (f32x4){0.f, 0.f, 0.f, 0.f};
#pragma unroll
        for (int ai = 0; ai < 2; ++ai)
#pragma unroll
            for (int m = 0; m < 4; ++m) { bf16_t* rowp = base + (size_t)(row0 + ai * HALF + m * 16) * ldc + col0;
#pragma unroll
                for (int bj = 0; bj < 2; ++bj) { f32x4 v0 = acc[ai][bj][m][0] + bv[bj][0], v1 = acc[ai][bj][m][1] + bv[bj][1];
                    if (ACT == 1) { f32x2 a = gelu_pk((f32x2){v0[0], v0[1]}), b = gelu_pk((f32x2){v0[2], v0[3]}), c = gelu_pk((f32x2){v1[0], v1[1]}), d = gelu_pk((f32x2){v1[2], v1[3]});
                        v0 = (f32x4){a.x, a.y, b.x, b.y}; v1 = (f32x4){c.x, c.y, d.x, d.y}; }
                    if (ACT == 2) {
#pragma unroll
                        for (int j = 0; j < 4; ++j) { v0[j] = 0.5f * v0[j] * (1.0f + erff(v0[j] * 0.70710678f)); v1[j] = 0.5f * v1[j] * (1.0f + erff(v1[j] * 0.70710678f)); } }
                    u32x4 w; w.x = cvt_pk_bf16(v0[0], v0[1]); w.y = cvt_pk_bf16(v0[2], v0[3]); w.z = cvt_pk_bf16(v1[0], v1[1]); w.w = cvt_pk_bf16(v1[2], v1[3]);
                    *(u32x4*)(rowp + bj * HALF) = w; } }
    }
};
template <class Epi, class Sched, bool STAMP = false>
__device__ __forceinline__ void gemm_phase(PG8_LAS unsigned char* lds, const Gemm g, const Sched& S, const Epi& E, unsigned long long* stamps) {
    const int tid = threadIdx.x, wid = __builtin_amdgcn_readfirstlane(tid >> 6), lane = tid & 63, wr = wid >> 2, wc = wid & 3, fr = lane & 15, fq = lane >> 4;
    const int K = g.K, nt = K / BK;
    int ts_lo = 0, ts_hi = 0, nts = 0; const unsigned long long rt_entry = STAMP ? (unsigned long long)wall_clock64() : 0ull;
#define PG8_STAMP() do { if (STAMP && wid == 0 && nts < 64) { const unsigned long long _c = (unsigned long long)clock64(); \
        ts_lo = (lane == nts) ? (int)(unsigned)_c : ts_lo; ts_hi = (lane == nts) ? (int)(unsigned)(_c >> 32) : ts_hi; ++nts; } } while (0)
    PG8_STAMP();
    unsigned voffA[2], voffB[2];
#pragma unroll
    for (int i = 0; i < 2; ++i) { int R, C; stage_rc(tid * 16 + i * 8192, R, C); const int Rb = Epi::PERM ? ((R & ~31) + perm32(R & 31)) : R;
        voffA[i] = (unsigned)(R * K + C) * 2u; voffB[i] = (unsigned)(Rb * K + C) * 2u; }
    const size_t kstep = (size_t)(BK * 2);
    const size_t hstep = (size_t)HALF * K * 2;
    const size_t tstep = 2 * hstep;
    const unsigned ldsw = (unsigned)wid * 1024u;
    const int aoff = lds_byte(wr * 64 + fr, fq * 8), boff = lds_byte(wc * 32 + fr, fq * 8);
#define PG8_SA(b, h) (((b) * 2 + (h)) * HTB)
#define PG8_SB(b, h) ((4 + (b) * 2 + (h)) * HTB)
#define PG8_STAGE(bufoff, gbase, voff) do { _Pragma("unroll") for (int _i = 0; _i < 2; ++_i) \
        __builtin_amdgcn_global_load_lds((const unsigned*)((const char*)(gbase) + (voff)[_i]), (PG8_LAS unsigned*)(lds + (bufoff) + ldsw + _i * 8192), 16, 0, 0); } while (0)
#define PG8_LDA(dst, b, h) do { _Pragma("unroll") for (int m = 0; m < 4; ++m) _Pragma("unroll") for (int k = 0; k < 2; ++k) dst[m][k] = *(const PG8_LAS bf16x8*)(lds + PG8_SA(b, h) + aoff + m * 2048 + k * 1024); } while (0)
#define PG8_LDB(dst, b, h) do { _Pragma("unroll") for (int n = 0; n < 2; ++n) _Pragma("unroll") for (int k = 0; k < 2; ++k) dst[n][k] = *(const PG8_LAS bf16x8*)(lds + PG8_SB(b, h) + boff + n * 2048 + k * 1024); } while (0)
#define PG8_MMA(ai, bj, At, Bt) do { __builtin_amdgcn_s_setprio(1); _Pragma("unroll") for (int m = 0; m < 4; ++m) _Pragma("unroll") for (int n = 0; n < 2; ++n) _Pragma("unroll") for (int k = 0; k < 2; ++k) \
        acc[ai][bj][m][n] = __builtin_amdgcn_mfma_f32_16x16x32_bf16(Bt[n][k], At[m][k], acc[ai][bj][m][n], 0, 0, 0); __builtin_amdgcn_s_setprio(0); } while (0)
#define PG8_WAIT_V(n) asm volatile("s_waitcnt vmcnt(" #n ")" ::: "memory")
#define PG8_WAIT_L(n) asm volatile("s_waitcnt lgkmcnt(" #n ")" ::: "memory")
#define PG8_BAR __builtin_amdgcn_s_barrier()
#define PG8_SCHED __builtin_amdgcn_sched_barrier(0)
    Unit cur, nxt; int ui = 0;
    if (!S.next(0, cur)) return;
    f32x4 acc[2][2][4][2];
#pragma unroll
    for (int a = 0; a < 2; ++a)
#pragma unroll
        for (int b = 0; b < 2; ++b)
#pragma unroll
            for (int m = 0; m < 4; ++m)
#pragma unroll
                for (int n = 0; n < 2; ++n) acc[a][b][m][n] = (f32x4){0.f, 0.f, 0.f, 0.f};
    bf16x8 At[4][2], B0[2][2], B1[2][2];
    const char* cA = (const char*)g.A + (size_t)cur.pm * tstep; const char* cB = (const char*)g.Bt + (size_t)cur.pn * tstep;
    S.a_ready(cur);
    PG8_STAGE(PG8_SB(0, 0), cB, voffB); PG8_STAGE(PG8_SA(0, 0), cA, voffA); PG8_STAGE(PG8_SB(0, 1), cB + hstep, voffB); PG8_STAGE(PG8_SA(0, 1), cA + hstep, voffA);
    if (wr == 1) PG8_BAR;
    PG8_WAIT_V(4); PG8_BAR;
    PG8_STAGE(PG8_SB(1, 0), cB + kstep, voffB); PG8_STAGE(PG8_SA(1, 0), cA + kstep, voffA); PG8_STAGE(PG8_SB(1, 1), cB + hstep + kstep, voffB);
    PG8_WAIT_V(6); PG8_BAR;
    PG8_STAMP();
    for (;;) {
        const bool has_next = S.next(ui + 1, nxt);
        const char* nA = has_next ? (const char*)g.A + (size_t)nxt.pm * tstep : cA; const char* nB = has_next ? (const char*)g.Bt + (size_t)nxt.pn * tstep : cB;
        for (int t = 0; t < nt; t += 2) {
            const bool last = (t == nt - 2);
            const char* a1 = cA + (size_t)(t + 1) * kstep;
            const char* a2 = last ? nA : cA + (size_t)(t + 2) * kstep; const char* b2 = last ? nB : cB + (size_t)(t + 2) * kstep;
            const char* a3 = a2 + kstep; const char* b3 = b2 + kstep;
            if (last && has_next) S.a_ready(nxt);
            PG8_LDB(B0, 0, 0); PG8_SCHED; PG8_LDA(At, 0, 0); PG8_STAGE(PG8_SA(1, 1), a1 + hstep, voffA);
            PG8_WAIT_L(8); PG8_BAR; PG8_WAIT_L(0); PG8_MMA(0, 0, At, B0); PG8_BAR; PG8_SCHED;
            PG8_LDB(B1, 0, 1); PG8_STAGE(PG8_SB(0, 0), b2, voffB);
            PG8_BAR; PG8_WAIT_L(0); PG8_MMA(0, 1, At, B1); PG8_BAR;
            PG8_LDA(At, 0, 1); PG8_STAGE(PG8_SA(0, 0), a2, voffA);
            PG8_BAR; PG8_WAIT_L(0); PG8_MMA(1, 0, At, B0); PG8_BAR; PG8_SCHED;
            PG8_STAGE(PG8_SB(0, 1), b2 + hstep, voffB);
            PG8_WAIT_V(6); PG8_BAR; PG8_MMA(1, 1, At, B1); PG8_BAR;
            PG8_LDB(B0, 1, 0); PG8_SCHED; PG8_LDA(At, 1, 0); PG8_STAGE(PG8_SA(0, 1), a2 + hstep, voffA);
            PG8_WAIT_L(8); PG8_BAR; PG8_WAIT_L(0); PG8_MMA(0, 0, At, B0); PG8_BAR; PG8_SCHED;
            PG8_LDB(B1, 1, 1); PG8_STAGE(PG8_SB(1, 0), b3, voffB);
            PG8_BAR; PG8_WAIT_L(0); PG8_MMA(0, 1, At, B1); PG8_BAR;
            PG8_LDA(At, 1, 1); PG8_STAGE(PG8_SA(1, 0), a3, voffA);
            PG8_BAR; PG8_WAIT_L(0); PG8_MMA(1, 0, At, B0); PG8_BAR; PG8_SCHED;
            PG8_STAGE(PG8_SB(1, 1), b3 + hstep, voffB);
            PG8_WAIT_V(6); PG8_BAR; PG8_MMA(1, 1, At, B1); PG8_BAR;
        }
        PG8_STAMP();
        if constexpr (!Epi::AFTER_DRAIN) { E(acc, cur, wr, wc, fr, fq); S.done(cur); }
        PG8_STAMP();
        if (!has_next) break;
#pragma unroll
        for (int a = 0; a < 2; ++a)
#pragma unroll
            for (int b = 0; b < 2; ++b)
#pragma unroll
                for (int m = 0; m < 4; ++m)
#pragma unroll
                    for (int n = 0; n < 2; ++n) acc[a][b][m][n] = (f32x4){0.f, 0.f, 0.f, 0.f};
        cur = nxt; cA = nA; cB = nB; ++ui;
    }
    PG8_WAIT_V(0);
    if (wr == 0) PG8_BAR;
    PG8_BAR;
    if constexpr (Epi::AFTER_DRAIN) { E.fused(acc, cur, wr, wc, fr, fq, lds, wid, lane); S.done(cur); }
    PG8_STAMP();
    if (STAMP && wid == 0) { stamps[lane] = lane < nts ? (((unsigned long long)(unsigned)ts_hi << 32) | (unsigned)ts_lo) : 0ull;
        if (lane == 62) stamps[62] = rt_entry; if (lane == 63) stamps[63] = (unsigned long long)wall_clock64(); }
#undef PG8_STAMP
#undef PG8_SA
#undef PG8_SB
#undef PG8_STAGE
#undef PG8_LDA
#undef PG8_LDB
#undef PG8_MMA
#undef PG8_WAIT_V
#undef PG8_WAIT_L
#undef PG8_BAR
#undef PG8_SCHED
}
}
struct Args { const float* in[N_IN]; float* out; unsigned char* ws; int ph_lo, ph_hi; };
struct Frame {
    LAS unsigned char* lds;
    int tid, lane, wave, vcu, G;
    const float* const* in; float* out; unsigned char* ws;
};
using bf16x2v = __attribute__((ext_vector_type(2))) __bf16;
__device__ __forceinline__ float dot2bf(unsigned a, unsigned b, float acc) { return __builtin_amdgcn_fdot2_f32_bf16(__builtin_bit_cast(bf16x2v, a), __builtin_bit_cast(bf16x2v, b), acc, false); }

struct TileInfo { int seq_base, seq_len, t0; };
__device__ __forceinline__ TileInfo tile_info(int c) {
    TileInfo ti;
    if (c < 128) { ti.seq_base = (c >> 6) * SEQ; ti.seq_len = SEQ; ti.t0 = (c & 63) * 64; }
    else { const int cc = c - 128; ti.seq_base = NLAT + (cc >> 2) * CTXL; ti.seq_len = CTXL; ti.t0 = (cc & 3) * 64; }
    return ti;
}
__device__ __forceinline__ int mod_row(int row) { return row < NLAT ? (row >> 12) : 2; }
__device__ __forceinline__ bf16x8 frag_lds(const LAS bf16* base, int ld, int row0, int k0, int lane) { return *(const LAS bf16x8*)(base + (row0 + (lane & 15)) * ld + k0 + 8 * (lane >> 4)); }
__device__ __forceinline__ bf16x8 frag_g(const bf16* base, int ld, int row0, int k0, int lane) { return *(const bf16x8*)(base + (size_t)(row0 + (lane & 15)) * ld + k0 + 8 * (lane >> 4)); }
#define MFMA16(a, b, c) __builtin_amdgcn_mfma_f32_16x16x32_bf16((a), (b), (c), 0, 0, 0)

__device__ __forceinline__ void p0_transpose_item(const float* W, int K, int N, bf16* WT, LAS float* scr, int item, int lane) {
    const int nblk = N / 32, kb = item / nblk, nb = item % nblk, k0 = 64 * kb, n0 = 32 * nb;
#pragma unroll 8
    for (int i = 0; i < 32; ++i) { const int kk = 2 * i + (lane >> 5); scr[kk * 33 + (lane & 31)] = W[(size_t)(k0 + kk) * N + n0 + (lane & 31)]; }
    LDS_WAIT(); asm volatile("" ::: "memory");
    const int c = lane & 7;
#pragma unroll
    for (int j = 0; j < 4; ++j) { const int n = (lane >> 3) + 8 * j; const LAS float* s = scr + (8 * c) * 33 + n;
        v4u o; o.x = pk2(s[0 * 33], s[1 * 33]); o.y = pk2(s[2 * 33], s[3 * 33]); o.z = pk2(s[4 * 33], s[5 * 33]); o.w = pk2(s[6 * 33], s[7 * 33]);
        *(v4u*)(WT + (size_t)(n0 + n) * K + k0 + 8 * c) = o; }
    LDS_WAIT(); asm volatile("" ::: "memory");
}
__device__ __forceinline__ void conv_f32_bf16(const float* src, bf16* dst, size_t n8, size_t i0, size_t stride) {
    for (size_t i = i0; i < n8; i += stride) { const f32x4 a = *(const f32x4*)(src + i * 8), b = *(const f32x4*)(src + i * 8 + 4);
        v4u o; o.x = pk2(a.x, a.y); o.y = pk2(a.z, a.w); o.z = pk2(b.x, b.y); o.w = pk2(b.z, b.w); *(v4u*)(dst + i * 8) = o; }
}
__device__ __forceinline__ void p0_prologue(Frame& F) {
    LAS float* scr = (LAS float*)(F.lds + F.wave * 16384);
    const int gw = F.vcu * NWAVES + F.wave, NGW = F.G * NWAVES;
    const size_t gt = (size_t)F.vcu * NTHR + F.tid, NGT = (size_t)F.G * NTHR;
    constexpr int IT_IN = (D / 64) * (IN_COLS / 32), IT_SQ = (D / 64) * (D / 32);
    constexpr int NIT = DEPTH * (IT_IN + 2 * IT_SQ);
    for (int it = gw; it < NIT; it += NGW) {
        int r = it;
        if (r < DEPTH * IT_IN) { const int l = r / IT_IN; p0_transpose_item(F.in[I_WIN] + (size_t)l * D * IN_COLS, D, IN_COLS, (bf16*)(F.ws + WS_WIN) + (size_t)l * IN_PAD * D, scr, r % IT_IN, F.lane); continue; }
        r -= DEPTH * IT_IN;
        if (r < DEPTH * IT_SQ) { const int l = r / IT_SQ; p0_transpose_item(F.in[I_WOUT] + (size_t)l * D * D, D, D, (bf16*)(F.ws + WS_WOUT) + (size_t)l * D * D, scr, r % IT_SQ, F.lane); continue; }
        r -= DEPTH * IT_SQ;
        { const int l = r / IT_SQ; p0_transpose_item(F.in[I_WQ] + (size_t)l * D * D, D, D, (bf16*)(F.ws + WS_WQ) + (size_t)l * D * D, scr, r % IT_SQ, F.lane); }
    }
    { constexpr int PADV = (IN_PAD - IN_COLS) * D / 8;
      for (size_t i = gt; i < (size_t)DEPTH * PADV; i += NGT) { const int l = (int)(i / PADV), r = (int)(i % PADV); *(v4u*)((bf16*)(F.ws + WS_WIN) + ((size_t)l * IN_PAD + IN_COLS) * D + (size_t)r * 8) = (v4u){0u, 0u, 0u, 0u}; } }
    { bf16* dst = (bf16*)(F.ws + WS_WLRU);
      for (size_t idx = gt; idx < (size_t)DEPTH * 2 * 2 * 16 * 64 * 64; idx += NGT) { const int i = (int)(idx & 63), j = (int)((idx >> 6) & 63), m = (int)(idx >> 12);
          const int hh = m & 15, d = (m >> 4) & 1, gate = (m >> 5) & 1, l = m >> 6; const float* src = F.in[gate ? I_WX : I_WA];
          dst[idx] = (bf16)f2bf(src[((size_t)((l * 2 + d) * 16 + hh) * 64 + i) * 64 + j]); } }
    { bf16* d2 = (bf16*)(F.ws + WS_W2T); bf16* da = (bf16*)(F.ws + WS_A2T);
      for (size_t idx = gt; idx < (size_t)DEPTH * 2 * 1024 * 64; idx += NGT) { const int k = (int)(idx & 63), c = (int)((idx >> 6) & 1023), ld = (int)(idx >> 16);
          d2[idx] = (bf16)f2bf(F.in[I_W2][((size_t)ld * 64 + k) * 1024 + c]); da[idx] = (bf16)f2bf(F.in[I_A2][((size_t)ld * 64 + k) * 1024 + c]); } }
    { bf16* dg = (bf16*)(F.ws + WS_G2T);
      for (size_t idx = gt; idx < (size_t)DEPTH * 1024 * 160; idx += NGT) { const int k = (int)(idx % 160), c = (int)((idx / 160) % 1024), l = (int)(idx / (160 * 1024));
          dg[idx] = (bf16)f2bf(F.in[I_G2][((size_t)l * 160 + k) * 1024 + c]); } }
    conv_f32_bf16(F.in[I_SUBK], (bf16*)(F.ws + WS_SUBK), (size_t)DEPTH * 8 * 2 * 128 * 128 / 8, gt, NGT);
    conv_f32_bf16(F.in[I_U], (bf16*)(F.ws + WS_UB), (size_t)DEPTH * PE_NE * D / 8, gt, NGT);
    conv_f32_bf16(F.in[I_V], (bf16*)(F.ws + WS_VB), (size_t)DEPTH * PE_NE * D / 8, gt, NGT);
    { float* X = (float*)(F.ws + WS_X);
      for (size_t i = gt; i < (size_t)MTOT * D / 4; i += NGT) { const int row = (int)(i / (D / 4)), e0 = (int)(i % (D / 4)) * 4;
          if (row < NLAT) { f32x4 v = *(const f32x4*)(F.in[I_X] + (size_t)row * D + e0); const int t = row & (SEQ - 1); const float pr = (float)(t >> 6), pc = (float)(t & 63);
              float o[4];
#pragma unroll
              for (int j = 0; j < 4; ++j) { const int e = e0 + j, q = e >> 9, fi = e & 511; const float freq = __builtin_amdgcn_exp2f(-13.287712379549449f * (float)fi * (1.0f / 512.0f));
                  const float ang = ((q >> 1) ? pc : pr) * freq; float rev = ang * 0.15915494309189535f; rev -= floorf(rev);
                  o[j] = (q & 1) ? __builtin_amdgcn_cosf(rev) : __builtin_amdgcn_sinf(rev); }
              v.x += o[0]; v.y += o[1]; v.z += o[2]; v.w += o[3]; *(f32x4*)(X + (size_t)row * D + e0) = v; }
          else *(f32x4*)(X + (size_t)row * D + e0) = *(const f32x4*)(F.in[I_CTX] + (size_t)(row - NLAT) * D + e0); } }
    { float* MODP = (float*)(F.ws + WS_MODP); const float* cin = F.in[I_C]; const float* cctx = F.in[I_CCTX];
      for (int it = gw; it < DEPTH * KSPLIT * 48; it += NGW) { const int cg = it % 48, kp = (it / 48) % KSPLIT, l = it / (48 * KSPLIT); const int col = cg * 256 + F.lane * 4, k0 = kp * (D / KSPLIT);
          f32x4 a0 = {0.f, 0.f, 0.f, 0.f}, a1 = a0, a2 = a0; const float* wp = F.in[I_ADAW] + ((size_t)l * D + k0) * (6 * D) + col;
#pragma unroll 4
          for (int k = 0; k < D / KSPLIT; ++k) { const f32x4 w = *(const f32x4*)(wp + (size_t)k * (6 * D)); const float c0 = cin[k0 + k], c1 = cin[D + k0 + k], c2 = cctx[k0 + k];
              const float s0 = c0 * fsigmoid(c0), s1 = c1 * fsigmoid(c1), s2 = c2 * fsigmoid(c2); a0 += w * s0; a1 += w * s1; a2 += w * s2; }
          float* o = MODP + ((size_t)(kp * DEPTH + l) * 3) * (6 * D) + col; *(f32x4*)o = a0; *(f32x4*)(o + 6 * D) = a1; *(f32x4*)(o + 12 * D) = a2; } }
}
__device__ __forceinline__ void p0b_mod_reduce(Frame& F) {
    const size_t gt = (size_t)F.vcu * NTHR + F.tid, NGT = (size_t)F.G * NTHR; const float* MODP = (const float*)(F.ws + WS_MODP); float* MOD = (float*)(F.ws + WS_MOD);
    for (size_t i = gt; i < (size_t)DEPTH * 3 * 6 * D; i += NGT) { const int n = (int)(i % (6 * D)), l = (int)(i / (3 * 6 * D)); float s = F.in[I_ADAB][(size_t)l * 6 * D + n];
#pragma unroll
        for (int kp = 0; kp < KSPLIT; ++kp) s += MODP[(size_t)kp * DEPTH * 3 * 6 * D + i];
        MOD[i] = s; }
}
__device__ __forceinline__ void modulate_rows(Frame& F, int l, int which, int nrows) {
    const int gw = F.vcu * NWAVES + F.wave, NGW = F.G * NWAVES; const float* X = (const float*)(F.ws + WS_X); bf16* H = (bf16*)(F.ws + WS_H);
    for (int row = gw; row < nrows; row += NGW) { const float* md = (const float*)(F.ws + WS_MOD) + ((size_t)l * 3 + mod_row(row)) * (6 * D) + which * 3 * D;
#pragma unroll
        for (int j = 0; j < 4; ++j) { const int e = j * 512 + F.lane * 8; const f32x4 x0 = *(const f32x4*)(X + (size_t)row * D + e), x1 = *(const f32x4*)(X + (size_t)row * D + e + 4);
            const f32x4 s0 = *(const f32x4*)(md + e), s1 = *(const f32x4*)(md + e + 4), c0 = *(const f32x4*)(md + D + e), c1 = *(const f32x4*)(md + D + e + 4);
            const f32x4 y0 = x0 * (c0 + 1.0f) + s0, y1 = x1 * (c1 + 1.0f) + s1;
            v4u o; o.x = pk2(y0.x, y0.y); o.y = pk2(y0.z, y0.w); o.z = pk2(y1.x, y1.y); o.w = pk2(y1.z, y1.w); *(v4u*)(H + (size_t)row * D + e) = o; } }
}

__device__ __forceinline__ void lru_prep_unit(Frame& F, int l, int c, int hh) {
    const TileInfo ti = tile_info(c); const float* P = (const float*)(F.ws + WS_P);
    LAS float* Us = (LAS float*)F.lds; LAS float* XC = (LAS float*)(F.lds + 17408); LAS bf16* XCb = (LAS bf16*)(F.lds + 34304);
    for (int idx = F.tid; idx < 67 * 64; idx += NTHR) { const int r = idx >> 6, ch = idx & 63, t = ti.t0 - 2 + r;
        Us[idx] = (t >= 0 && t < ti.seq_len) ? P[(size_t)(ti.seq_base + t) * IN_PAD + hh * 64 + ch] : 0.f; }
    __syncthreads();
    { const float* cw = F.in[I_CONVW] + (size_t)l * 4 * LRW; const float* cb = F.in[I_CONVB] + (size_t)l * LRW;
      for (int idx = F.tid; idx < 64 * 64; idx += NTHR) { const int t = idx >> 6, ch = idx & 63, cg = hh * 64 + ch;
          float v = cb[cg];
#pragma unroll
          for (int tap = 0; tap < 4; ++tap) v += cw[tap * LRW + cg] * Us[(t + tap) * 64 + ch];
          XC[t * 65 + ch] = v; XCb[t * 72 + ch] = (bf16)f2bf(v); } }
    __syncthreads();
    { const int d = F.wave >> 2, m = F.wave & 3, lane = F.lane;
      const bf16x8 a0 = frag_lds(XCb, 72, 16 * m, 0, lane), a1 = frag_lds(XCb, 72, 16 * m, 32, lane);
      const bf16* Wa = (const bf16*)(F.ws + WS_WLRU) + (size_t)(((l * 2 + 0) * 2 + d) * 16 + hh) * 4096;
      const bf16* Wx = (const bf16*)(F.ws + WS_WLRU) + (size_t)(((l * 2 + 1) * 2 + d) * 16 + hh) * 4096;
      float* LA = (float*)(F.ws + WS_LA) + (size_t)d * MTOT * LRW; float* LB = (float*)(F.ws + WS_LB) + (size_t)d * MTOT * LRW;
#pragma unroll
      for (int n = 0; n < 4; ++n) {
          f32x4 ar = {0.f, 0.f, 0.f, 0.f}, ai = ar;
          ar = MFMA16(a0, frag_g(Wa, 64, 16 * n, 0, lane), ar); ar = MFMA16(a1, frag_g(Wa, 64, 16 * n, 32, lane), ar);
          ai = MFMA16(a0, frag_g(Wx, 64, 16 * n, 0, lane), ai); ai = MFMA16(a1, frag_g(Wx, 64, 16 * n, 32, lane), ai);
          const int col = 16 * n + (lane & 15), cg = hh * 64 + col;
          const float ba = F.in[I_BA][(size_t)(l * 2 + d) * LRW + cg], bx = F.in[I_BX][(size_t)(l * 2 + d) * LRW + cg];
          const float sp = fsoftplus(-F.in[I_LAM][(size_t)(l * 2 + d) * LRW + cg]);
#pragma unroll
          for (int r = 0; r < 4; ++r) { const int row = 16 * m + 4 * (lane >> 4) + r;
              const float rr = fsigmoid(ar[r] + ba), ii = fsigmoid(ai[r] + bx), loga = -8.0f * rr * sp, a = fexp(loga);
              const float bb = sqrtf(fmaxf(-expm1f(2.0f * loga), 0.f)) * ii * XC[row * 65 + col];
              const size_t o = (size_t)(ti.seq_base + ti.t0 + row) * LRW + cg; LA[o] = a; LB[o] = bb; } } }
    __syncthreads();
}
__device__ __forceinline__ void shifted8(const float* P, size_t grow, bool hp, bool hn, const float* mu0, const float* mu1, int rc, float (&o)[8]) {
    const float* p = P + grow * IN_PAD + 2 * LRW + rc;
    const f32x4 x0 = *(const f32x4*)p, x1 = *(const f32x4*)(p + 4);
    f32x4 m0 = {0.f, 0.f, 0.f, 0.f}, m1 = m0, n0 = m0, n1 = m0;
    if (hp) { m0 = *(const f32x4*)(p - IN_PAD); m1 = *(const f32x4*)(p - IN_PAD + 4); }
    if (hn) { n0 = *(const f32x4*)(p + IN_PAD); n1 = *(const f32x4*)(p + IN_PAD + 4); }
    const float xs[8] = {x0.x, x0.y, x0.z, x0.w, x1.x, x1.y, x1.z, x1.w}, ms[8] = {m0.x, m0.y, m0.z, m0.w, m1.x, m1.y, m1.z, m1.w}, ns[8] = {n0.x, n0.y, n0.z, n0.w, n1.x, n1.y, n1.z, n1.w};
#pragma unroll
    for (int e = 0; e < 8; ++e) o[e] = xs[e] + mu0[rc + e] * (ms[e] - xs[e]) + mu1[rc + e] * (ns[e] - xs[e]);
}
__device__ __forceinline__ void rwkv_prep_unit(Frame& F, int l, int c, int hh) {
    const TileInfo ti = tile_info(c); const float* P = (const float*)(F.ws + WS_P);
    LAS float* Rs = (LAS float*)F.lds; LAS float* Ks = (LAS float*)(F.lds + 16896); LAS float* KKn = (LAS float*)(F.lds + 33792);
    LAS bf16* TW = (LAS bf16*)(F.lds + 50688); LAS bf16* AD = (LAS bf16*)(F.lds + 69120); LAS float* BET = (LAS float*)(F.lds + 87552);
    const float* mu0 = F.in[I_MU] + (size_t)l * 2 * RW_COLS; const float* mu1 = mu0 + RW_COLS;
    { const int t = F.tid >> 3, c8 = (F.tid & 7) * 8; const int tt = ti.t0 + t; const size_t grow = (size_t)(ti.seq_base + tt);
      const bool hp = tt > 0, hn = tt + 1 < ti.seq_len;
      float v[8];
      shifted8(P, grow, hp, hn, mu0, mu1, hh * 64 + c8, v);
      { float* R = (float*)(F.ws + WS_RR) + grow * RWW + hh * 64 + c8; *(f32x4*)R = (f32x4){v[0], v[1], v[2], v[3]}; *(f32x4*)(R + 4) = (f32x4){v[4], v[5], v[6], v[7]};
#pragma unroll
        for (int e = 0; e < 8; ++e) Rs[t * 65 + c8 + e] = v[e]; }
      shifted8(P, grow, hp, hn, mu0, mu1, RWW + hh * 64 + c8, v);
      { float kk[8], ss = 0.f; const float* kkw = F.in[I_KK] + (size_t)l * RWW + hh * 64 + c8;
#pragma unroll
        for (int e = 0; e < 8; ++e) { Ks[t * 65 + c8 + e] = v[e]; kk[e] = v[e] * kkw[e]; ss += kk[e] * kk[e]; }
        ss = red8(ss); const float inv = __builtin_amdgcn_rsqf(fmaxf(ss, 1e-24f));
        float* KKg = (float*)(F.ws + WS_RKK) + grow * RWW + hh * 64 + c8;
#pragma unroll
        for (int e = 0; e < 8; ++e) { kk[e] *= inv; KKn[t * 65 + c8 + e] = kk[e]; }
        *(f32x4*)KKg = (f32x4){kk[0], kk[1], kk[2], kk[3]}; *(f32x4*)(KKg + 4) = (f32x4){kk[4], kk[5], kk[6], kk[7]}; }
      shifted8(P, grow, hp, hn, mu0, mu1, 2 * RWW + hh * 64 + c8, v);
      { float* V = (float*)(F.ws + WS_RV) + grow * RWW + hh * 64 + c8; *(f32x4*)V = (f32x4){v[0], v[1], v[2], v[3]}; *(f32x4*)(V + 4) = (f32x4){v[4], v[5], v[6], v[7]}; }
#pragma unroll
      for (int ps = 0; ps < 4; ++ps) {
          shifted8(P, grow, hp, hn, mu0, mu1, 3 * RWW + ps * 64 + c8, v);
          v4u o;
          if (ps < 2) { o.x = pk2(ftanh(v[0]), ftanh(v[1])); o.y = pk2(ftanh(v[2]), ftanh(v[3])); o.z = pk2(ftanh(v[4]), ftanh(v[5])); o.w = pk2(ftanh(v[6]), ftanh(v[7])); *(LAS v4u*)(TW + (ps * 64 + t) * 72 + c8) = o; }
          else { o.x = pk2(v[0], v[1]); o.y = pk2(v[2], v[3]); o.z = pk2(v[4], v[5]); o.w = pk2(v[6], v[7]); *(LAS v4u*)(AD + ((ps - 2) * 64 + t) * 72 + c8) = o; }
      } }
    __syncthreads();
    { const int d = F.wave >> 2, m = F.wave & 3, lane = F.lane;
      const bf16x8 w0f = frag_lds(TW + d * 64 * 72, 72, 16 * m, 0, lane), w1f = frag_lds(TW + d * 64 * 72, 72, 16 * m, 32, lane);
      const bf16x8 d0f = frag_lds(AD + d * 64 * 72, 72, 16 * m, 0, lane), d1f = frag_lds(AD + d * 64 * 72, 72, 16 * m, 32, lane);
      const bf16* W2 = (const bf16*)(F.ws + WS_W2T) + ((size_t)(l * 2 + d) * 1024 + hh * 64) * 64; const bf16* A2 = (const bf16*)(F.ws + WS_A2T) + ((size_t)(l * 2 + d) * 1024 + hh * 64) * 64;
      float* Wg = (float*)(F.ws + WS_RW) + (size_t)d * MTOT * RWW; float* KDg = (float*)(F.ws + WS_RKD) + (size_t)d * MTOT * RWW; float* BVg = (float*)(F.ws + WS_RBV) + (size_t)d * MTOT * RWW;
      float bet[4] = {0.f, 0.f, 0.f, 0.f};
#pragma unroll
      for (int n = 0; n < 4; ++n) {
          f32x4 aw = {0.f, 0.f, 0.f, 0.f}, aa = aw;
          aw = MFMA16(w0f, frag_g(W2, 64, 16 * n, 0, lane), aw); aw = MFMA16(w1f, frag_g(W2, 64, 16 * n, 32, lane), aw);
          aa = MFMA16(d0f, frag_g(A2, 64, 16 * n, 0, lane), aa); aa = MFMA16(d1f, frag_g(A2, 64, 16 * n, 32, lane), aa);
          const int col = 16 * n + (lane & 15), cg = hh * 64 + col;
          const float w0 = F.in[I_W0][(size_t)(l * 2 + d) * RWW + cg], a0 = F.in[I_A0][(size_t)(l * 2 + d) * RWW + cg], ka = F.in[I_KA][(size_t)l * RWW + cg], rk = F.in[I_RK][(size_t)l * RWW + cg];
#pragma unroll
          for (int r = 0; r < 4; ++r) { const int row = 16 * m + 4 * (lane >> 4) + r;
              const float wl = w0 + aw[r], wlog = -fsoftplus(-wl) - 0.5f, dec = fexp(-fexp(wlog)), av = fsigmoid(a0 + aa[r]);
              const float k = Ks[row * 65 + col], kkn = KKn[row * 65 + col], kd = k * (1.0f + (av - 1.0f) * ka);
              bet[r] += Rs[row * 65 + col] * kd * rk;
              const size_t o = (size_t)(ti.seq_base + ti.t0 + row) * RWW + cg; Wg[o] = dec; KDg[o] = kd; BVg[o] = kkn * av; } }
#pragma unroll
      for (int r = 0; r < 4; ++r) { const float s = red16(bet[r]); if ((lane & 15) == 0) BET[d * 64 + 16 * m + 4 * (lane >> 4) + r] = s; } }
    __syncthreads();
    if (F.tid < 64) ((float*)(F.ws + WS_BETA))[(size_t)(ti.seq_base + ti.t0 + F.tid) * NH + hh] = BET[F.tid] + BET[64 + F.tid];
    __syncthreads();
}

__device__ __forceinline__ int blk_row0(int kb, int b, int d) {
    if (kb < CTXL / 32) { const int base = NLAT + b * CTXL; return d ? base + CTXL - 32 - kb * 32 : base + kb * 32; }
    const int lb = kb - CTXL / 32, base = b * SEQ; return d ? base + SEQ - 32 - lb * 32 : base + lb * 32;
}
__device__ __forceinline__ void rwkv_chain(Frame& F, int chain) {
    const int d = chain & 1, hh = (chain >> 1) & 15, b = chain >> 5;
    LAS float* buf = (LAS float*)F.lds; LAS float* YS = (LAS float*)(F.lds + 98304);
    const float* src[6] = { (const float*)(F.ws + WS_RR), (const float*)(F.ws + WS_RW) + (size_t)d * MTOT * RWW, (const float*)(F.ws + WS_RKD) + (size_t)d * MTOT * RWW,
                            (const float*)(F.ws + WS_RKK), (const float*)(F.ws + WS_RBV) + (size_t)d * MTOT * RWW, (const float*)(F.ws + WS_RV) };
    float* YR = (float*)(F.ws + WS_YR) + (size_t)d * MTOT * RWW;
    constexpr int NBLK = (CTXL + SEQ) / 32;
    const int lr = F.tid >> 4, lc4 = (F.tid & 15) * 4;
    f32x4 pre[6];
    { const int r0 = blk_row0(0, b, d);
#pragma unroll
      for (int a = 0; a < 6; ++a) pre[a] = *(const f32x4*)(src[a] + (size_t)(r0 + lr) * RWW + hh * 64 + lc4);
#pragma unroll
      for (int a = 0; a < 6; ++a) *(LAS f32x4*)(buf + (a * 32 + lr) * 64 + lc4) = pre[a]; }
    __syncthreads();
    const int ip = F.tid >> 3, jq = F.tid & 7;
    float s0[8], s1[8];
#pragma unroll
    for (int e = 0; e < 8; ++e) { s0[e] = 0.f; s1[e] = 0.f; }
    for (int kb = 0; kb < NBLK; ++kb) {
        const int r0 = blk_row0(kb, b, d);
        if (kb + 1 < NBLK) { const int r1 = blk_row0(kb + 1, b, d);
#pragma unroll
            for (int a = 0; a < 6; ++a) pre[a] = *(const f32x4*)(src[a] + (size_t)(r1 + lr) * RWW + hh * 64 + lc4); }
        const LAS float* cb = buf + (kb & 1) * (6 * 32 * 64);
        if (F.tid < 256) {
#pragma unroll 2
            for (int j = 0; j < 32; ++j) { const int row = d ? 31 - j : j;
                const LAS float* pr = cb + (0 * 32 + row) * 64 + jq * 8; const LAS float* pw = cb + (1 * 32 + row) * 64 + jq * 8; const LAS float* pk = cb + (2 * 32 + row) * 64 + jq * 8;
                const LAS float* pa = cb + (3 * 32 + row) * 64 + jq * 8; const LAS float* pb = cb + (4 * 32 + row) * 64 + jq * 8; const LAS float* pv = cb + (5 * 32 + row) * 64;
                const f32x4 k0 = *(const LAS f32x4*)pa, k1 = *(const LAS f32x4*)(pa + 4);
                const float kk[8] = {k0.x, k0.y, k0.z, k0.w, k1.x, k1.y, k1.z, k1.w};
                float sa0 = 0.f, sa1 = 0.f;
#pragma unroll
                for (int e = 0; e < 8; ++e) { sa0 -= s0[e] * kk[e]; sa1 -= s1[e] * kk[e]; }
                sa0 = red8(sa0); sa1 = red8(sa1);
                const f32x4 w0 = *(const LAS f32x4*)pw, w1 = *(const LAS f32x4*)(pw + 4), b0 = *(const LAS f32x4*)pb, b1 = *(const LAS f32x4*)(pb + 4), d0 = *(const LAS f32x4*)pk, d1 = *(const LAS f32x4*)(pk + 4), q0 = *(const LAS f32x4*)pr, q1 = *(const LAS f32x4*)(pr + 4);
                const float ww[8] = {w0.x, w0.y, w0.z, w0.w, w1.x, w1.y, w1.z, w1.w}, bb[8] = {b0.x, b0.y, b0.z, b0.w, b1.x, b1.y, b1.z, b1.w}, kd[8] = {d0.x, d0.y, d0.z, d0.w, d1.x, d1.y, d1.z, d1.w}, rr[8] = {q0.x, q0.y, q0.z, q0.w, q1.x, q1.y, q1.z, q1.w};
                const float v0 = pv[ip], v1 = pv[ip + 32];
                float y0 = 0.f, y1 = 0.f;
#pragma unroll
                for (int e = 0; e < 8; ++e) { s0[e] = s0[e] * ww[e] + sa0 * bb[e] + v0 * kd[e]; s1[e] = s1[e] * ww[e] + sa1 * bb[e] + v1 * kd[e]; y0 += s0[e] * rr[e]; y1 += s1[e] * rr[e]; }
                y0 = red8(y0); y1 = red8(y1);
                if (jq == 0) { YS[row * 64 + ip] = y0; YS[row * 64 + ip + 32] = y1; }
            }
        }
        __syncthreads();
        *(f32x4*)(YR + (size_t)(r0 + lr) * RWW + hh * 64 + lc4) = *(const LAS f32x4*)(YS + lr * 64 + lc4);
        if (kb + 1 < NBLK) { LAS float* nb = buf + ((kb + 1) & 1) * (6 * 32 * 64);
#pragma unroll
            for (int a = 0; a < 6; ++a) *(LAS f32x4*)(nb + (a * 32 + lr) * 64 + lc4) = pre[a]; }
        __syncthreads();
    }
}
__device__ __forceinline__ void lru_scan(Frame& F, int blk) {
    const int idx = blk * NTHR + F.tid, ch = idx & 1023, b = (idx >> 10) & 1, d = idx >> 11;
    const float* LA = (const float*)(F.ws + WS_LA) + (size_t)d * MTOT * LRW + ch; const float* LB = (const float*)(F.ws + WS_LB) + (size_t)d * MTOT * LRW + ch;
    float* YL = (float*)(F.ws + WS_YL) + (size_t)d * MTOT * LRW + ch;
    float h = 0.f;
#pragma unroll 1
    for (int seg = 0; seg < 2; ++seg) { const int base = seg ? b * SEQ : NLAT + b * CTXL, len = seg ? SEQ : CTXL;
#pragma unroll 1
        for (int s = 0; s < len; s += 16) { float av[16], bv[16];
#pragma unroll
            for (int u = 0; u < 16; ++u) { const int t = d ? len - 1 - (s + u) : s + u; av[u] = LA[(size_t)(base + t) * LRW]; bv[u] = LB[(size_t)(base + t) * LRW]; }
#pragma unroll
            for (int u = 0; u < 16; ++u) { const int t = d ? len - 1 - (s + u) : s + u; h = av[u] * h + bv[u]; YL[(size_t)(base + t) * LRW] = h; } } }
}

__device__ __forceinline__ void merge_unit(Frame& F, int l, int u) {
    const int c = u >> 1; const TileInfo ti = tile_info(c); const int t0 = ti.t0 + (u & 1) * 32; const float* P = (const float*)(F.ws + WS_P);
    LAS bf16* SG = (LAS bf16*)F.lds; LAS bf16* GO = (LAS bf16*)(F.lds + 10752); LAS f32x2* ST = (LAS f32x2*)(F.lds + 76800);
    const float* mu0 = F.in[I_MU] + (size_t)l * 2 * RW_COLS; const float* mu1 = mu0 + RW_COLS;
    for (int idx = F.tid; idx < 32 * 160; idx += NTHR) { const int t = idx / 160, k = idx % 160, tt = t0 + t, rc = 3 * RWW + 256 + k; const float* p = P + (size_t)(ti.seq_base + tt) * IN_PAD + 2 * LRW + rc;
        const float x = p[0], xm = tt > 0 ? p[-IN_PAD] : 0.f, xn = tt + 1 < ti.seq_len ? p[IN_PAD] : 0.f;
        SG[t * 168 + k] = (bf16)f2bf(fsigmoid(x + mu0[rc] * (xm - x) + mu1[rc] * (xn - x))); }
    { const int t = F.tid >> 4, hh = F.tid & 15; const size_t o = (size_t)(ti.seq_base + t0 + t) * RWW + hh * 64;
      const float* y0 = (const float*)(F.ws + WS_YR) + o; const float* y1 = y0 + (size_t)MTOT * RWW; float s = 0.f, q = 0.f;
#pragma unroll 4
      for (int e = 0; e < 64; e += 4) { const f32x4 a = *(const f32x4*)(y0 + e) + *(const f32x4*)(y1 + e); s += (a.x + a.y) + (a.z + a.w); q += (a.x * a.x + a.y * a.y) + (a.z * a.z + a.w * a.w); }
      const float mean = s * (1.0f / 64.0f), var = fmaxf(q * (1.0f / 64.0f) - mean * mean, 0.f);
      ST[t * 16 + hh] = (f32x2){mean, __builtin_amdgcn_rsqf(var + GN_EPS)}; }
    __syncthreads();
    { const int lane = F.lane; const bf16* G2 = (const bf16*)(F.ws + WS_G2T) + (size_t)l * 1024 * 160;
      bf16x8 af[2][5];
#pragma unroll
      for (int m = 0; m < 2; ++m)
#pragma unroll
          for (int k = 0; k < 5; ++k) af[m][k] = frag_lds(SG, 168, 16 * m, 32 * k, lane);
#pragma unroll 2
      for (int n = 0; n < 8; ++n) { const int n0 = F.wave * 128 + n * 16; f32x4 a0 = {0.f, 0.f, 0.f, 0.f}, a1 = a0;
#pragma unroll
          for (int k = 0; k < 5; ++k) { const bf16x8 bf = frag_g(G2, 160, n0, 32 * k, lane); a0 = MFMA16(af[0][k], bf, a0); a1 = MFMA16(af[1][k], bf, a1); }
#pragma unroll
          for (int r = 0; r < 4; ++r) { GO[(4 * (lane >> 4) + r) * 1032 + n0 + (lane & 15)] = (bf16)f2bf(a0[r]); GO[(16 + 4 * (lane >> 4) + r) * 1032 + n0 + (lane & 15)] = (bf16)f2bf(a1[r]); } } }
    __syncthreads();
    { bf16* MRG = (bf16*)(F.ws + WS_H);
      for (int it = F.tid; it < 32 * 256; it += NTHR) { const int t = it >> 8, cgp = it & 255, tt = t0 + t; const size_t grow = (size_t)(ti.seq_base + tt);
          float o[8];
          if (cgp < 128) { const int ch = cgp * 8; const float* pg = P + grow * IN_PAD + LRW + ch; const f32x4 g0 = *(const f32x4*)pg, g1 = *(const f32x4*)(pg + 4);
              const float* yl = (const float*)(F.ws + WS_YL) + grow * LRW + ch; const f32x4 a0 = *(const f32x4*)yl + *(const f32x4*)(yl + (size_t)MTOT * LRW), a1 = *(const f32x4*)(yl + 4) + *(const f32x4*)(yl + (size_t)MTOT * LRW + 4);
              o[0] = gelu_tanh(g0.x) * a0.x; o[1] = gelu_tanh(g0.y) * a0.y; o[2] = gelu_tanh(g0.z) * a0.z; o[3] = gelu_tanh(g0.w) * a0.w;
              o[4] = gelu_tanh(g1.x) * a1.x; o[5] = gelu_tanh(g1.y) * a1.y; o[6] = gelu_tanh(g1.z) * a1.z; o[7] = gelu_tanh(g1.w) * a1.w; }
          else { const int ch = (cgp - 128) * 8, hh = ch >> 6; const float* yr = (const float*)(F.ws + WS_YR) + grow * RWW + ch;
              const f32x4 a0 = *(const f32x4*)yr + *(const f32x4*)(yr + (size_t)MTOT * RWW), a1 = *(const f32x4*)(yr + 4) + *(const f32x4*)(yr + (size_t)MTOT * RWW + 4);
              const float* vv = (const float*)(F.ws + WS_RV) + grow * RWW + ch; const f32x4 v0 = *(const f32x4*)vv, v1 = *(const f32x4*)(vv + 4);
              const f32x2 st = ST[t * 16 + hh]; const float beta = ((const float*)(F.ws + WS_BETA))[grow * NH + hh];
              const float* gg = F.in[I_GNG] + (size_t)l * RWW + ch; const float* gb = F.in[I_GNB] + (size_t)l * RWW + ch;
              const float ya[8] = {a0.x, a0.y, a0.z, a0.w, a1.x, a1.y, a1.z, a1.w}, va[8] = {v0.x, v0.y, v0.z, v0.w, v1.x, v1.y, v1.z, v1.w};
              const v4u gq = *(const LAS v4u*)(GO + t * 1032 + ch); const float gv[8] = {bf_lo(gq.x), bf_hi(gq.x), bf_lo(gq.y), bf_hi(gq.y), bf_lo(gq.z), bf_hi(gq.z), bf_lo(gq.w), bf_hi(gq.w)};
#pragma unroll
              for (int e = 0; e < 8; ++e) o[e] = ((ya[e] - st.x) * st.y * gg[e] + gb[e] + beta * va[e]) * gv[e]; }
          v4u w; w.x = pk2(o[0], o[1]); w.y = pk2(o[2], o[3]); w.z = pk2(o[4], o[5]); w.w = pk2(o[6], o[7]);
          *(v4u*)(MRG + grow * D + cgp * 8) = w; } }
    __syncthreads();
}

__device__ __forceinline__ void ln_row(float (&z)[32], const float* g, const float* b, int lane) {
    float s = 0.f;
#pragma unroll
    for (int i = 0; i < 32; ++i) s += z[i];
    const float mean = wave_sum(s) * (1.0f / D); float q = 0.f;
#pragma unroll
    for (int i = 0; i < 32; ++i) { z[i] -= mean; q += z[i] * z[i]; }
    const float rstd = __builtin_amdgcn_rsqf(wave_sum(q) * (1.0f / D) + LN_EPS);
#pragma unroll
    for (int j = 0; j < 4; ++j) { const int e = j * 512 + lane * 8; const f32x4 g0 = *(const f32x4*)(g + e), g1 = *(const f32x4*)(g + e + 4), b0 = *(const f32x4*)(b + e), b1 = *(const f32x4*)(b + e + 4);
        const float gs[8] = {g0.x, g0.y, g0.z, g0.w, g1.x, g1.y, g1.z, g1.w}, bs[8] = {b0.x, b0.y, b0.z, b0.w, b1.x, b1.y, b1.z, b1.w};
#pragma unroll
        for (int i = 0; i < 8; ++i) z[j * 8 + i] = z[j * 8 + i] * rstd * gs[i] + bs[i]; }
}
__device__ __forceinline__ void load32(const float* p, int lane, float (&v)[32]) {
#pragma unroll
    for (int j = 0; j < 4; ++j) { const int e = j * 512 + lane * 8; const f32x4 a = *(const f32x4*)(p + e), b = *(const f32x4*)(p + e + 4);
        v[j * 8 + 0] = a.x; v[j * 8 + 1] = a.y; v[j * 8 + 2] = a.z; v[j * 8 + 3] = a.w; v[j * 8 + 4] = b.x; v[j * 8 + 5] = b.y; v[j * 8 + 6] = b.z; v[j * 8 + 7] = b.w; }
}
__device__ __forceinline__ void store32(float* p, int lane, const float (&v)[32]) {
#pragma unroll
    for (int j = 0; j < 4; ++j) { const int e = j * 512 + lane * 8; *(f32x4*)(p + e) = (f32x4){v[j * 8 + 0], v[j * 8 + 1], v[j * 8 + 2], v[j * 8 + 3]}; *(f32x4*)(p + e + 4) = (f32x4){v[j * 8 + 4], v[j * 8 + 5], v[j * 8 + 6], v[j * 8 + 7]}; }
}
__device__ __forceinline__ void store32_mod_bf16(bf16* p, const float* sh, const float* sc, int lane, const float (&v)[32]) {
#pragma unroll
    for (int j = 0; j < 4; ++j) { const int e = j * 512 + lane * 8; const f32x4 s0 = *(const f32x4*)(sh + e), s1 = *(const f32x4*)(sh + e + 4), c0 = *(const f32x4*)(sc + e), c1 = *(const f32x4*)(sc + e + 4);
        v4u o; o.x = pk2(v[j * 8 + 0] * (1.f + c0.x) + s0.x, v[j * 8 + 1] * (1.f + c0.y) + s0.y); o.y = pk2(v[j * 8 + 2] * (1.f + c0.z) + s0.z, v[j * 8 + 3] * (1.f + c0.w) + s0.w);
        o.z = pk2(v[j * 8 + 4] * (1.f + c1.x) + s1.x, v[j * 8 + 5] * (1.f + c1.y) + s1.y); o.w = pk2(v[j * 8 + 6] * (1.f + c1.z) + s1.z, v[j * 8 + 7] * (1.f + c1.w) + s1.w);
        *(v4u*)(p + e) = o; }
}
__device__ __forceinline__ void ln1_rows(Frame& F, int l, int nrows) {
    const int gw = F.vcu * NWAVES + F.wave, NGW = F.G * NWAVES; float* X = (float*)(F.ws + WS_X); const float* O = (const float*)(F.ws + WS_O); bf16* H = (bf16*)(F.ws + WS_H);
    for (int row = gw; row < nrows; row += NGW) { const float* md = (const float*)(F.ws + WS_MOD) + ((size_t)l * 3 + mod_row(row)) * (6 * D);
        float z[32], o[32], gt[32]; load32(X + (size_t)row * D, F.lane, z); load32(O + (size_t)row * D, F.lane, o); load32(md + 2 * D, F.lane, gt);
#pragma unroll
        for (int i = 0; i < 32; ++i) z[i] = ALPHA * z[i] + gt[i] * o[i];
        ln_row(z, F.in[I_LN1G] + (size_t)l * D, F.in[I_LN1B] + (size_t)l * D, F.lane);
        store32(X + (size_t)row * D, F.lane, z);
        store32_mod_bf16(H + (size_t)row * D, md + 3 * D, md + 4 * D, F.lane, z); }
}

__device__ __forceinline__ unsigned ord_key(float s, int k) { unsigned u = __builtin_bit_cast(unsigned, s); u = (u & 0x80000000u) ? ~u : (u | 0x80000000u); return (u & ~127u) | (unsigned)(127 - k); }
__device__ __forceinline__ float key_score(unsigned key) { const unsigned u = key & ~127u; return __builtin_bit_cast(float, (u & 0x80000000u) ? (u ^ 0x80000000u) : ~u); }
__device__ __forceinline__ void peer_topk_unit(Frame& F, int l, int tile, int h) {
    LAS bf16* AQ = (LAS bf16*)F.lds; LAS float* SC = (LAS float*)(F.lds + 33792); LAS unsigned* T1 = (LAS unsigned*)(F.lds + 99584);
    const float* QP = (const float*)(F.ws + WS_QP);
    for (int idx = F.tid; idx < 64 * 64; idx += NTHR) { const int t = idx >> 6, c4 = (idx & 63) * 4; const f32x4 q = *(const f32x4*)(QP + (size_t)(tile * 64 + t) * D + h * 256 + c4);
        v2u o; o.x = pk2(q.x, q.y); o.y = pk2(q.z, q.w); *(LAS v2u*)(AQ + t * 264 + c4) = o; }
    __syncthreads();
    { const int lane = F.lane; const bf16* SK = (const bf16*)(F.ws + WS_SUBK) + (size_t)((l * 8 + h) * 2) * 128 * 128;
#pragma unroll
      for (int p = 0; p < 2; ++p) { bf16x8 bfr[4];
#pragma unroll
          for (int k = 0; k < 4; ++k) bfr[k] = frag_g(SK + (size_t)p * 128 * 128, 128, 16 * F.wave, 32 * k, lane);
#pragma unroll
          for (int m = 0; m < 4; ++m) { f32x4 acc = {0.f, 0.f, 0.f, 0.f};
#pragma unroll
              for (int k = 0; k < 4; ++k) acc = MFMA16(frag_lds(AQ, 264, 16 * m, p * 128 + 32 * k, lane), bfr[k], acc);
#pragma unroll
              for (int r = 0; r < 4; ++r) SC[(16 * m + 4 * (lane >> 4) + r) * 257 + p * 128 + 16 * F.wave + (lane & 15)] = acc[r]; } } }
    __syncthreads();
    if (F.tid < 128) { const int t = F.tid & 63, p = F.tid >> 6; unsigned L[16];
#pragma unroll
        for (int i = 0; i < 16; ++i) L[i] = 0u;
        const LAS float* sp = SC + t * 257 + p * 128;
#pragma unroll 4
        for (int k = 0; k < 128; ++k) { unsigned x = ord_key(sp[k], k);
#pragma unroll
            for (int i = 0; i < 16; ++i) { const unsigned hi = L[i] > x ? L[i] : x; x = L[i] > x ? x : L[i]; L[i] = hi; } }
#pragma unroll
        for (int i = 0; i < 16; ++i) T1[(t * 2 + p) * 16 + i] = L[i]; }
    __syncthreads();
    if (F.tid < 64) { const int t = F.tid; float s1[16], s2[16]; int i1[16], i2[16];
#pragma unroll
        for (int i = 0; i < 16; ++i) { const unsigned a = T1[(t * 2 + 0) * 16 + i], b = T1[(t * 2 + 1) * 16 + i]; s1[i] = key_score(a); i1[i] = 127 - (int)(a & 127u); s2[i] = key_score(b); i2[i] = 127 - (int)(b & 127u); }
        unsigned long long L[16];
#pragma unroll
        for (int i = 0; i < 16; ++i) L[i] = 0ull;
#pragma unroll
        for (int i = 0; i < 16; ++i)
#pragma unroll
            for (int j = 0; j < 16; ++j) if ((i + 1) * (j + 1) <= 16) { const float s = s1[i] + s2[j]; unsigned u = __builtin_bit_cast(unsigned, s); u = (u & 0x80000000u) ? ~u : (u | 0x80000000u);
                unsigned long long x = ((unsigned long long)u << 32) | (unsigned)(i1[i] * 128 + i2[j]);
#pragma unroll
                for (int q = 0; q < 16; ++q) { const bool gtq = L[q] > x; const unsigned long long hi = gtq ? L[q] : x; x = gtq ? x : L[q]; L[q] = hi; } }
        float sc[16], mx, sum = 0.f;
#pragma unroll
        for (int q = 0; q < 16; ++q) { const unsigned u = (unsigned)(L[q] >> 32); sc[q] = __builtin_bit_cast(float, (u & 0x80000000u) ? (u ^ 0x80000000u) : ~u); }
        mx = sc[0];
#pragma unroll
        for (int q = 0; q < 16; ++q) { sc[q] = fexp(sc[q] - mx); sum += sc[q]; }
        const float inv = 1.0f / sum; int* IDX = (int*)(F.ws + WS_IDX) + (size_t)(tile * 64 + t) * PE_SEL + h * 16; float* GT = (float*)(F.ws + WS_GATE) + (size_t)(tile * 64 + t) * PE_SEL + h * 16;
#pragma unroll
        for (int q = 0; q < 16; q += 4) { *(int4*)(IDX + q) = make_int4((int)(L[q] & 0x3fffu), (int)(L[q + 1] & 0x3fffu), (int)(L[q + 2] & 0x3fffu), (int)(L[q + 3] & 0x3fffu));
            *(f32x4*)(GT + q) = (f32x4){sc[q] * inv, sc[q + 1] * inv, sc[q + 2] * inv, sc[q + 3] * inv}; } }
    __syncthreads();
}

__device__ __forceinline__ float wave_total(float v) {
    v = red16(v);
    v += __builtin_bit_cast(float, __builtin_amdgcn_update_dpp(0, __builtin_bit_cast(int, v), 0x142, 0xa, 0xf, false));
    v += __builtin_bit_cast(float, __builtin_amdgcn_update_dpp(0, __builtin_bit_cast(int, v), 0x143, 0xc, 0xf, false));
    return __builtin_bit_cast(float, __builtin_amdgcn_readlane(__builtin_bit_cast(int, v), 63));
}
__device__ __forceinline__ void peer_rows(Frame& F, int l, int nrows) {
    const int gw = F.vcu * NWAVES + F.wave, NGW = F.G * NWAVES, lane = F.lane;
    const bf16* UB = (const bf16*)(F.ws + WS_UB) + (size_t)l * PE_NE * D; const bf16* VB = (const bf16*)(F.ws + WS_VB) + (size_t)l * PE_NE * D;
    float* X = (float*)(F.ws + WS_X); bf16* H = (bf16*)(F.ws + WS_H);
    for (int row = gw; row < nrows; row += NGW) {
        const int* IDX = (const int*)(F.ws + WS_IDX) + (size_t)row * PE_SEL; const float* GT = (const float*)(F.ws + WS_GATE) + (size_t)row * PE_SEL;
        const int il = IDX[lane], ih = IDX[64 + lane]; const float gl = GT[lane], gh = GT[64 + lane];
        v4u hq[4];
#pragma unroll
        for (int j = 0; j < 4; ++j) hq[j] = *(const v4u*)(H + (size_t)row * D + j * 512 + lane * 8);
        int dl = 0, dh = 0;
#pragma unroll 1
        for (int k0 = 0; k0 < PE_SEL; k0 += 4) { v4u w[4][4];
#pragma unroll
            for (int q = 0; q < 4; ++q) { const int k = k0 + q; const int e = __builtin_amdgcn_readlane(k0 < 64 ? il : ih, k & 63); const bf16* ur = UB + (size_t)e * D + lane * 8;
#pragma unroll
                for (int j = 0; j < 4; ++j) w[q][j] = *(const v4u*)(ur + j * 512); }
#pragma unroll
            for (int q = 0; q < 4; ++q) { const int k = k0 + q; float p = 0.f;
#pragma unroll
                for (int j = 0; j < 4; ++j) { p = dot2bf(w[q][j].x, hq[j].x, p); p = dot2bf(w[q][j].y, hq[j].y, p); p = dot2bf(w[q][j].z, hq[j].z, p); p = dot2bf(w[q][j].w, hq[j].w, p); }
                const int tb = __builtin_bit_cast(int, wave_total(p));
                if (k0 < 64) dl = (lane == (k & 63)) ? tb : dl; else dh = (lane == (k & 63)) ? tb : dh; } }
        const float cl = gl * gelu_erf(__builtin_bit_cast(float, dl)), ch = gh * gelu_erf(__builtin_bit_cast(float, dh));
        float acc[32];
#pragma unroll
        for (int i = 0; i < 32; ++i) acc[i] = 0.f;
#pragma unroll 1
        for (int k0 = 0; k0 < PE_SEL; k0 += 4) { v4u w[4][4];
#pragma unroll
            for (int q = 0; q < 4; ++q) { const int k = k0 + q; const int e = __builtin_amdgcn_readlane(k0 < 64 ? il : ih, k & 63); const bf16* vr = VB + (size_t)e * D + lane * 8;
#pragma unroll
                for (int j = 0; j < 4; ++j) w[q][j] = *(const v4u*)(vr + j * 512); }
#pragma unroll
            for (int q = 0; q < 4; ++q) { const int k = k0 + q; const float cf = __builtin_bit_cast(float, __builtin_amdgcn_readlane(__builtin_bit_cast(int, k0 < 64 ? cl : ch), k & 63));
#pragma unroll
                for (int j = 0; j < 4; ++j) { acc[j * 8 + 0] += cf * bf_lo(w[q][j].x); acc[j * 8 + 1] += cf * bf_hi(w[q][j].x); acc[j * 8 + 2] += cf * bf_lo(w[q][j].y); acc[j * 8 + 3] += cf * bf_hi(w[q][j].y);
                    acc[j * 8 + 4] += cf * bf_lo(w[q][j].z); acc[j * 8 + 5] += cf * bf_hi(w[q][j].z); acc[j * 8 + 6] += cf * bf_lo(w[q][j].w); acc[j * 8 + 7] += cf * bf_hi(w[q][j].w); } } }
        const float* md = (const float*)(F.ws + WS_MOD) + ((size_t)l * 3 + mod_row(row)) * (6 * D);
        float z[32], gt[32]; load32(X + (size_t)row * D, lane, z); load32(md + 5 * D, lane, gt);
#pragma unroll
        for (int i = 0; i < 32; ++i) z[i] = ALPHA * z[i] + gt[i] * acc[i];
        ln_row(z, F.in[I_LN2G] + (size_t)l * D, F.in[I_LN2B] + (size_t)l * D, lane);
        if (l + 1 < DEPTH) { store32(X + (size_t)row * D, lane, z); const float* mn = (const float*)(F.ws + WS_MOD) + ((size_t)(l + 1) * 3 + mod_row(row)) * (6 * D); store32_mod_bf16(H + (size_t)row * D, mn, mn + D, lane, z); }
        else store32(F.out + (size_t)row * D, lane, z);
    }
}
#ifndef MK_PER_PHASE
#define MK_PER_PHASE 0
#endif
constexpr int NPH_PRO = 3, NPH_LAYER = 9, NPHASES = NPH_PRO + DEPTH * NPH_LAYER;
__global__ void __launch_bounds__(NTHR, 2) trunk_fwd(Args args) {
    extern __shared__ __attribute__((aligned(16))) unsigned char lds_raw[];
    Frame F0;
    F0.lds = (LAS unsigned char*)lds_raw;
    F0.tid = threadIdx.x; F0.lane = F0.tid & 63; F0.wave = __builtin_amdgcn_readfirstlane(F0.tid >> 6);
    F0.G = gridDim.x; { const int bx = blockIdx.x; F0.vcu = (F0.G % 8 == 0) ? (bx % 8) * (F0.G / 8) + bx / 8 : bx; }
    F0.in = args.in; F0.out = args.out; F0.ws = args.ws;
    volatile LAS unsigned* MISC = (volatile LAS unsigned*)(F0.lds + MISC_OFF);
    for (int u = F0.tid; u < (LDS_BYTES - LDSCTL_OFF) / 4; u += NTHR) ((LAS unsigned*)(F0.lds + LDSCTL_OFF))[u] = 0u;
    __syncthreads();
    const int lo = args.ph_lo, hi = args.ph_hi;
    XcdBarrier bar; bar.bar = (unsigned*)(F0.ws + WS_CTL) + CW_BAR; bar.x = 0; bar.st = nullptr;
    if (hi - lo > 1) bar = xcd_barrier_post((unsigned*)(F0.ws + WS_CTL) + CW_BAR, MISC + 8);
#ifndef PHMASK
#define PHMASK 0xfff
#endif
#define PHM(b) ((PHMASK >> (b)) & 1)
#define IN(k) (lo <= (k) && (k) < hi)
#define LAUNDER() Frame F = F0; { int t_ = F0.tid; asm volatile("" : "+v"(t_)); F.tid = t_; F.lane = t_ & 63; F.wave = __builtin_amdgcn_readfirstlane(t_ >> 6); \
    unsigned char* w_ = F0.ws; asm volatile("" : "+s"(w_)); F.ws = w_; int v_ = F0.vcu; asm volatile("" : "+s"(v_)); F.vcu = v_; }
#define SEAM(k) do { if (IN(k) && IN((k) + 1)) xcd_barrier(bar); } while (0)

    if (PHM(0) && IN(0)) { LAUNDER(); p0_prologue(F); } SEAM(0);
    if (PHM(1) && IN(1)) { LAUNDER(); p0b_mod_reduce(F); } SEAM(1);
    if (PHM(2) && IN(2)) { LAUNDER(); modulate_rows(F, 0, 0, MTOT); } SEAM(2);

#pragma unroll 1
    for (int l = 0; l < DEPTH; ++l) {
        const int pb = NPH_PRO + l * NPH_LAYER;
        const int mrows = (l + 1 < DEPTH) ? MTOT : NLAT;
        if (PHM(3) && IN(pb + 0)) { LAUNDER(); pg8::Gemm g{(const pg8::bf16_t*)(F.ws + WS_H), (const pg8::bf16_t*)(F.ws + WS_WIN) + (size_t)l * IN_PAD * D, MTOT, IN_PAD, D};
            pg8::StaticOrder S; S.init(MTOT, IN_PAD, F.G, (int)blockIdx.x); pg8::EpiF32 E{(float*)(F.ws + WS_P), IN_PAD, nullptr};
            pg8::gemm_phase<pg8::EpiF32, pg8::StaticOrder, false>(F.lds, g, S, E, nullptr); }
        SEAM(pb + 0);
        if (PHM(4) && IN(pb + 1)) { LAUNDER(); for (int u = F.vcu; u < 2 * NTILE * NH; u += F.G) { if (u < NTILE * NH) lru_prep_unit(F, l, u >> 4, u & 15); else { const int v = u - NTILE * NH; rwkv_prep_unit(F, l, v >> 4, v & 15); } } }
        SEAM(pb + 1);
        if (PHM(5) && IN(pb + 2)) { LAUNDER(); for (int u = F.vcu; u < 72; u += F.G) { if (u < 64) rwkv_chain(F, u); else lru_scan(F, u - 64); } }
        SEAM(pb + 2);
        if (PHM(6) && IN(pb + 3)) { LAUNDER(); for (int u = F.vcu; u < 2 * NTILE; u += F.G) merge_unit(F, l, u); }
        SEAM(pb + 3);
        if (PHM(7) && IN(pb + 4)) { LAUNDER(); pg8::Gemm g{(const pg8::bf16_t*)(F.ws + WS_H), (const pg8::bf16_t*)(F.ws + WS_WOUT) + (size_t)l * D * D, mrows, D, D};
            pg8::StaticOrder S; S.init(mrows, D, F.G, (int)blockIdx.x); pg8::EpiF32 E{(float*)(F.ws + WS_O), D, nullptr};
            pg8::gemm_phase<pg8::EpiF32, pg8::StaticOrder, false>(F.lds, g, S, E, nullptr); }
        SEAM(pb + 4);
        if (PHM(8) && IN(pb + 5)) { LAUNDER(); ln1_rows(F, l, mrows); }
        SEAM(pb + 5);
        if (PHM(9) && IN(pb + 6)) { LAUNDER(); pg8::Gemm g{(const pg8::bf16_t*)(F.ws + WS_H), (const pg8::bf16_t*)(F.ws + WS_WQ) + (size_t)l * D * D, mrows, D, D};
            pg8::StaticOrder S; S.init(mrows, D, F.G, (int)blockIdx.x); pg8::EpiF32 E{(float*)(F.ws + WS_QP), D, nullptr};
            pg8::gemm_phase<pg8::EpiF32, pg8::StaticOrder, false>(F.lds, g, S, E, nullptr); }
        SEAM(pb + 6);
        if (PHM(10) && IN(pb + 7)) { LAUNDER(); for (int u = F.vcu; u < (mrows / 64) * PE_H; u += F.G) peer_topk_unit(F, l, u >> 3, u & 7); }
        SEAM(pb + 7);
        if (PHM(11) && IN(pb + 8)) { LAUNDER(); peer_rows(F, l, mrows); }
        if (l + 1 < DEPTH) SEAM(pb + 8);
    }
#undef IN
#undef SEAM
}

extern "C" void kernel_launch(void* const* d_in, const int* in_sizes, int n_in, void* d_out, int out_size, void* d_ws, size_t ws_size, hipStream_t stream) {
    static int grid = 0;
    if (grid == 0) {
        if (n_in != N_IN || out_size != NLAT * D || ws_size < WS_END) { fprintf(stderr, "kernel_launch: unexpected shapes (n_in %d, out %d, ws %zu < %zu)\n", n_in, out_size, ws_size, (size_t)WS_END); grid = -1; return; }
        int dev = 0, cus = 0, per_cu = 0;
        if (hipGetDevice(&dev) != hipSuccess || hipDeviceGetAttribute(&cus, hipDeviceAttributeMultiprocessorCount, dev) != hipSuccess) { grid = -1; return; }
        if (hipFuncSetAttribute((const void*)trunk_fwd, hipFuncAttributeMaxDynamicSharedMemorySize, LDS_BYTES) != hipSuccess) { fprintf(stderr, "kernel_launch: hipFuncSetAttribute failed\n"); grid = -1; return; }
        if (hipOccupancyMaxActiveBlocksPerMultiprocessor(&per_cu, (const void*)trunk_fwd, NTHR, LDS_BYTES) != hipSuccess || per_cu < 1) fprintf(stderr, "kernel_launch: occupancy query reports %d\n", per_cu);
        (void)hipGetLastError();
        grid = cus;
    }
    if (grid < 0) return;
    (void)hipMemsetAsync((char*)d_ws + WS_CTL, 0, CTL_ZERO_BYTES, stream);
    Args a{};
    for (int i = 0; i < N_IN; ++i) a.in[i] = (const float*)d_in[i];
    a.out = (float*)d_out; a.ws = (unsigned char*)d_ws;
#if MK_PER_PHASE
    for (int ph = 0; ph < NPHASES; ++ph) { a.ph_lo = ph; a.ph_hi = ph + 1; hipLaunchKernelGGL(trunk_fwd, dim3(grid), dim3(NTHR), LDS_BYTES, stream, a); }
#else
    a.ph_lo = 0; a.ph_hi = NPHASES;
    hipLaunchKernelGGL(trunk_fwd, dim3(grid), dim3(NTHR), LDS_BYTES, stream, a);
#endif
    const hipError_t le = hipPeekAtLastError();
    if (le != hipSuccess) fprintf(stderr, "kernel_launch: launch failed: %s\n", hipGetErrorName(le));
}
```

```cpp
#include <hip/hip_runtime.h>
#include <cstdio>
#include <cstdint>

constexpr int D = 2048, NB = 2, SEQ = 4096, DEPTH = 4, CTXL = 256;
constexpr int NLAT = NB * SEQ, NCTX = NB * CTXL, MTOT = NLAT + NCTX;
constexpr int LRW = 1024, RWW = 1024, NH = 16, HD = 64;
constexpr int RW_COLS = 3488, IN_COLS = 5536, IN_PAD = 5632;
constexpr int PE_H = 8, PE_K = 128, PE_DQ = 256, PE_TOP = 16, PE_NE = 16384, PE_SEL = PE_H * PE_TOP;
constexpr int NTILE = MTOT / 64;
constexpr float ALPHA = 1.681792830507429f;
constexpr float LN_EPS = 1e-5f, GN_EPS = 64e-5f;
constexpr int KSPLIT = 16;

enum { I_X = 0, I_C, I_CTX, I_CCTX, I_ADAW, I_ADAB, I_WIN, I_CONVW, I_CONVB, I_WA, I_BA, I_WX, I_BX, I_LAM, I_MU, I_W0, I_W2, I_A0, I_A2, I_G2,
       I_KK, I_KA, I_RK, I_GNG, I_GNB, I_WOUT, I_LN1G, I_LN1B, I_WQ, I_SUBK, I_U, I_V, I_LN2G, I_LN2B, N_IN };

constexpr size_t MiB = 1u << 20;
constexpr size_t al(size_t x) { return (x + MiB - 1) / MiB * MiB; }
constexpr size_t WS_CTL = 0, CTL_ZERO_BYTES = 1 * MiB;
constexpr size_t WS_MOD   = WS_CTL + CTL_ZERO_BYTES;
constexpr size_t WS_MODP  = al(WS_MOD + (size_t)DEPTH * 3 * 6 * D * 4);
constexpr size_t WS_WIN   = al(WS_MODP + (size_t)KSPLIT * DEPTH * 3 * 6 * D * 4);
constexpr size_t WS_WOUT  = al(WS_WIN + (size_t)DEPTH * IN_PAD * D * 2);
constexpr size_t WS_WQ    = al(WS_WOUT + (size_t)DEPTH * D * D * 2);
constexpr size_t WS_SUBK  = al(WS_WQ + (size_t)DEPTH * D * D * 2);
constexpr size_t WS_WLRU  = al(WS_SUBK + (size_t)DEPTH * 8 * 2 * 128 * 128 * 2);
constexpr size_t WS_W2T   = al(WS_WLRU + (size_t)DEPTH * 2 * 2 * 16 * 64 * 64 * 2);
constexpr size_t WS_A2T   = al(WS_W2T + (size_t)DEPTH * 2 * 1024 * 64 * 2);
constexpr size_t WS_G2T   = al(WS_A2T + (size_t)DEPTH * 2 * 1024 * 64 * 2);
constexpr size_t WS_UB    = al(WS_G2T + (size_t)DEPTH * 1024 * 160 * 2);
constexpr size_t WS_VB    = al(WS_UB + (size_t)DEPTH * PE_NE * D);
constexpr size_t WS_SU    = al(WS_VB + (size_t)DEPTH * PE_NE * D);
constexpr size_t WS_SV    = al(WS_SU + (size_t)DEPTH * PE_NE * 4);
constexpr size_t WS_X     = al(WS_SV + (size_t)DEPTH * PE_NE * 4);
constexpr size_t WS_H     = al(WS_X + (size_t)MTOT * D * 4);
constexpr size_t WS_P     = al(WS_H + (size_t)MTOT * D * 2);
constexpr size_t WS_LA    = al(WS_P + (size_t)MTOT * IN_PAD * 4);
constexpr size_t WS_LB    = al(WS_LA + (size_t)2 * MTOT * LRW * 4);
constexpr size_t WS_LAGG  = al(WS_LB + (size_t)2 * MTOT * LRW * 4);
constexpr size_t WS_LHIN  = al(WS_LAGG + (size_t)4 * NTILE * LRW * 4);
constexpr int KSL = 8;
constexpr size_t WS_SLAB  = al(WS_LHIN + (size_t)2 * NTILE * LRW * 4);
constexpr size_t WS_YL    = al(WS_SLAB + (size_t)2 * KSL * NCTX * D * 4);
constexpr int NUNIT = NTILE * NH * 2;
constexpr size_t WS_RV    = al(WS_YL + 4096);
constexpr size_t WS_QM    = al(WS_RV + (size_t)MTOT * RWW * 4);
constexpr size_t WS_PHI   = al(WS_QM + (size_t)NUNIT * 4096 * 2);
constexpr size_t WS_Y0F   = al(WS_PHI + (size_t)NUNIT * 4096 * 2);
constexpr size_t WS_PSF   = al(WS_Y0F + (size_t)NUNIT * 4096 * 2);
constexpr size_t WS_YR    = al(WS_PSF + (size_t)NUNIT * 4096 * 2);
constexpr size_t WS_BETA  = al(WS_YR + (size_t)2 * MTOT * RWW * 4);
constexpr size_t WS_IDX   = al(WS_BETA + (size_t)2 * MTOT * NH * 4);
constexpr size_t WS_GATE  = al(WS_IDX + (size_t)MTOT * PE_SEL * 4);
constexpr size_t WS_END   = al(WS_GATE + (size_t)MTOT * PE_SEL * 4);
constexpr size_t WS_O = WS_P;
constexpr size_t WS_QP = WS_P + (size_t)MTOT * D * 4;
static_assert(WS_QP + (size_t)MTOT * D * 4 <= WS_LA, "O/QP overlay inside P");

constexpr int CW_BAR = 4096;

constexpr int RING_BYTES = 131072;
constexpr int LDSCTL_OFF = RING_BYTES, MISC_OFF = LDSCTL_OFF + 320;
constexpr int LDS_BYTES = 147456;
constexpr int NWAVES = 8, NTHR = 512;

#define GAS __attribute__((address_space(1)))
#define LAS __attribute__((address_space(3)))
typedef unsigned short bf16;
typedef unsigned v4u __attribute__((ext_vector_type(4)));
typedef unsigned v2u __attribute__((ext_vector_type(2)));
typedef float f32x4 __attribute__((ext_vector_type(4)));
typedef float f32x2 __attribute__((ext_vector_type(2)));
typedef short bf16x8 __attribute__((ext_vector_type(8)));
#define RLX_AGENT __ATOMIC_RELAXED, __HIP_MEMORY_SCOPE_AGENT
#define LDS_WAIT() asm volatile("s_waitcnt lgkmcnt(0)" ::: "memory")
#define VM_WAIT() asm volatile("s_waitcnt vmcnt(0)" ::: "memory")

__device__ __forceinline__ const float* gin(const float* p) { return (const float*)(const GAS float*)p; }
__device__ __forceinline__ unsigned f2bf(float f) { unsigned u = __builtin_bit_cast(unsigned, f); return (u + 0x7fffu + ((u >> 16) & 1u)) >> 16; }
typedef __bf16 bf16x2t __attribute__((ext_vector_type(2)));
__device__ __forceinline__ unsigned pk2(float lo, float hi) { return __builtin_bit_cast(unsigned, __builtin_convertvector((f32x2){lo, hi}, bf16x2t)); }
__device__ __forceinline__ float bf_lo(unsigned w) { return __builtin_bit_cast(float, w << 16); }
__device__ __forceinline__ float bf_hi(unsigned w) { return __builtin_bit_cast(float, w & 0xffff0000u); }
__device__ __forceinline__ float fexp(float x) { return __builtin_amdgcn_exp2f(x * 1.4426950408889634f); }
__device__ __forceinline__ float fsigmoid(float x) { return __builtin_amdgcn_rcpf(1.0f + fexp(-x)); }
__device__ __forceinline__ float fsoftplus(float x) { return fmaxf(x, 0.f) + 0.6931471805599453f * __builtin_amdgcn_logf(1.0f + fexp(-fabsf(x))); }
__device__ __forceinline__ float ftanh(float x) { const float e = fexp(2.0f * x); return 1.0f - 2.0f * __builtin_amdgcn_rcpf(e + 1.0f); }
__device__ __forceinline__ float gelu_tanh(float x) { return 0.5f * x * (1.0f + ftanh(0.7978845608028654f * (x + 0.044715f * x * x * x))); }
__device__ __forceinline__ float gelu_erf(float v) {
    const float av = fabsf(v), t = __builtin_amdgcn_rcpf(av * 0.2316418882f + 1.0f);
    float q = t * 0.5307027145f + (-0.7265760135f); q = q * t + 0.7107068705f; q = q * t + (-0.142248368f); q = q * t + 0.127414796f; q = q * t;
    const float e = __builtin_amdgcn_exp2f((v * v) * (-0.72134752044f));
    const float m = v * (q * e);
    return v < 0.f ? m : v - m;
}
template <int CTRL> __device__ __forceinline__ float dpp_f(float v) { return __builtin_bit_cast(float, __builtin_amdgcn_update_dpp(0, __builtin_bit_cast(int, v), CTRL, 0xf, 0xf, true)); }
__device__ __forceinline__ float red8(float v) { v += dpp_f<0xB1>(v); v += dpp_f<0x4E>(v); v += dpp_f<0x141>(v); return v; }
__device__ __forceinline__ float red16(float v) { v = red8(v); v += dpp_f<0x140>(v); return v; }
__device__ __forceinline__ float wave_total(float v) {
    v = red16(v);
    v += __builtin_bit_cast(float, __builtin_amdgcn_update_dpp(0, __builtin_bit_cast(int, v), 0x142, 0xa, 0xf, false));
    v += __builtin_bit_cast(float, __builtin_amdgcn_update_dpp(0, __builtin_bit_cast(int, v), 0x143, 0xc, 0xf, false));
    return __builtin_bit_cast(float, __builtin_amdgcn_readlane(__builtin_bit_cast(int, v), 63));
}
__device__ __forceinline__ float wave_sum(float v) { return wave_total(v); }
__device__ __forceinline__ float wave_max(float v) {
    v = fmaxf(v, dpp_f<0xB1>(v)); v = fmaxf(v, dpp_f<0x4E>(v)); v = fmaxf(v, dpp_f<0x141>(v)); v = fmaxf(v, dpp_f<0x140>(v));
    const float a = __builtin_bit_cast(float, __builtin_amdgcn_readlane(__builtin_bit_cast(int, v), 0)), b = __builtin_bit_cast(float, __builtin_amdgcn_readlane(__builtin_bit_cast(int, v), 16));
    const float c = __builtin_bit_cast(float, __builtin_amdgcn_readlane(__builtin_bit_cast(int, v), 32)), d = __builtin_bit_cast(float, __builtin_amdgcn_readlane(__builtin_bit_cast(int, v), 48));
    return fmaxf(fmaxf(a, b), fmaxf(c, d));
}

#define XB_TMO      128
#define XB_XCNT(j)  (256  + 64 * (j))
#define XB_XSUB(j)  (1280 + 64 * (j))
#define XB_XGEN(j)  (2304 + 64 * (j))
#define XB_TOP      3328
#define XB_TOPGEN   3392
#define XCD_BAR_WORDS 3456
#define XB_SPIN_CAP (1u << 18)

__device__ __forceinline__ unsigned xb_ld(unsigned* p)              { return __hip_atomic_load(p, __ATOMIC_RELAXED, __HIP_MEMORY_SCOPE_AGENT); }
__device__ __forceinline__ unsigned xb_add(unsigned* p, unsigned v) { return __hip_atomic_fetch_add(p, v, __ATOMIC_RELAXED, __HIP_MEMORY_SCOPE_AGENT); }
__device__ __forceinline__ unsigned xb_xcc_id() { return (unsigned)__builtin_amdgcn_s_getreg((3 << 11) | 20) & 0xFu; }
#define XB_SPIN(cond, bar) do { unsigned _sp = 0; while (cond) { __builtin_amdgcn_s_sleep(1); \
    if ((++_sp & 255u) == 0u) { if (xb_ld(&(bar)[XB_TMO])) break; if (_sp > XB_SPIN_CAP) { atomicAdd(&(bar)[XB_TMO], 1u); break; } } } } while (0)

struct XcdBarrier {
    unsigned* bar; unsigned x;
    volatile LAS unsigned* st;
};

__device__ __forceinline__ XcdBarrier xcd_barrier_post(unsigned* bar, volatile LAS unsigned* st) {
    XcdBarrier b; b.bar = bar; b.x = xb_xcc_id(); b.st = st;
    if (threadIdx.x == 0) (void)xb_add(&bar[XB_XCNT(b.x)], 1u);
    return b;
}
__device__ __forceinline__ void xcd_barrier_complete(unsigned* bar, unsigned x, unsigned& nloc, unsigned& nx) {
    const unsigned G = gridDim.x * gridDim.y * gridDim.z;
    unsigned sum, cnt, mine, sp = 0u;
    for (;;) {
        sum = 0u; cnt = 0u; mine = 0u;
#pragma unroll
        for (unsigned j = 0; j < 16; ++j) { const unsigned c = xb_ld(&bar[XB_XCNT(j)]); sum += c; cnt += (c > 0u) ? 1u : 0u; }
        if (sum == G) { mine = xb_ld(&bar[XB_XCNT(x)]); break; }
        __builtin_amdgcn_s_sleep(1);
        if ((++sp & 255u) == 0u) { if (xb_ld(&bar[XB_TMO])) break; if (sp > XB_SPIN_CAP) { atomicAdd(&bar[XB_TMO], 1u); break; } }
    }
    nloc = mine > 0u ? mine : 1u; nx = cnt > 0u ? cnt : 1u;
}

__device__ __forceinline__ void xcd_barrier(const XcdBarrier& b) {
    asm volatile("s_waitcnt vmcnt(0)" ::: "memory");
    __syncthreads();
    if (threadIdx.x == 0) {
        unsigned* bar = b.bar;
        __builtin_amdgcn_s_waitcnt(0);
        unsigned nloc = b.st[0], nx = b.st[1];
        if (nloc == 0u) { xcd_barrier_complete(bar, b.x, nloc, nx); b.st[0] = nloc; b.st[1] = nx; }
        const unsigned old = xb_add(&bar[XB_XSUB(b.x)], 1u);
        const unsigned gen = old / nloc;
        if (old + 1u == (gen + 1u) * nloc) {
            __builtin_amdgcn_fence(__ATOMIC_RELEASE, "agent");
            asm volatile("s_waitcnt vmcnt(0)" ::: "memory");
            const unsigned og = xb_add(&bar[XB_TOP], 1u);
            const unsigned tg = og / nx;
            if (og + 1u == (tg + 1u) * nx) xb_add(&bar[XB_TOPGEN], 1u);
            else XB_SPIN(xb_ld(&bar[XB_TOPGEN]) == tg, bar);
            __builtin_amdgcn_fence(__ATOMIC_ACQUIRE, "agent");
            xb_add(&bar[XB_XGEN(b.x)], 1u);
            asm volatile("s_waitcnt vmcnt(0)" ::: "memory");
        } else {
            XB_SPIN(xb_ld(&bar[XB_XGEN(b.x)]) == gen, bar);
            __builtin_amdgcn_fence(__ATOMIC_ACQUIRE, "agent");
            asm volatile("s_waitcnt vmcnt(0)" ::: "memory");
        }
    }
    __syncthreads();
}
namespace pg8 {
#define PG8_LAS __attribute__((address_space(3)))
typedef unsigned short bf16_t;
typedef short bf16x8 __attribute__((ext_vector_type(8)));
typedef float f32x4 __attribute__((ext_vector_type(4)));
typedef unsigned u32x4 __attribute__((ext_vector_type(4)));
constexpr int BM = 256, BK = 64, HALF = 128, HTB = HALF * BK * 2  , STAGE_BYTES = 8 * HTB, NXCD = 8, WGM = 8;

__host__ __device__ __forceinline__ int lds_byte(int r, int c) { const int st = (r >> 4) * 2 + (c >> 5), rr = r & 15, cc = c & 31, ob = rr * 64 + cc * 2; return st * 1024 + (ob ^ (((ob >> 9) & 1) << 5)); }
__host__ __device__ __forceinline__ void stage_rc(int b, int& R, int& C) { const int st = b / 1024, sb = b % 1024, swz = sb ^ (((sb >> 9) & 1) << 5); R = (st >> 1) * 16 + swz / 64; C = (st & 1) * 32 + (swz % 64) / 2; }
__host__ __device__ __forceinline__ int perm32(int rho) { const int n = rho >> 4, i = rho & 15; return 8 * (i >> 2) + 4 * n + (i & 3); }

struct Unit { int pm, pn, kofs = 0, slab = 0; };
struct Gemm { const bf16_t* A; const bf16_t* Bt; int M, N, K, ld; };

struct StaticOrder {
    int nM, nN, nwg, G, c;
    __host__ __device__ void init(int M, int N, int G_, int c_) { nM = M / BM; nN = N / BM; nwg = nM * nN; G = G_; c = c_; }
    __host__ __device__ bool next(int i, Unit& u) const {
        const long L = (long)i * G + c; if (L >= nwg) return false;
        int wgid = (int)L; { const int q = nwg / NXCD, r = nwg % NXCD, xcd = wgid % NXCD, off = wgid / NXCD; wgid = (xcd < r ? xcd * (q + 1) : r * (q + 1) + (xcd - r) * q) + off; }
        const int nig = WGM * nN, gid = wgid / nig, fm = gid * WGM, gsz = (nM - fm) < WGM ? (nM - fm) : WGM;
        u.pm = fm + ((wgid % nig) % gsz); u.pn = (wgid % nig) / gsz; return true;
    }
    __device__ __forceinline__ void a_ready(const Unit&) const {}
    __device__ __forceinline__ void done(const Unit&) const {}
};
struct SplitKOrder {
    int nM, nN, nS, klen, G, c;
    __host__ __device__ void init(int M, int N, int nS_, int klen_, int G_, int c_) { nM = M / BM; nN = N / BM; nS = nS_; klen = klen_; G = G_; c = c_; }
    __host__ __device__ bool next(int i, Unit& u) const { const long L = (long)i * G + c; if (L >= (long)nM * nN * nS) return false; const int l = (int)L; u.pm = l % nM; u.pn = (l / nM) % nN; const int ks = l / (nM * nN); u.kofs = ks * klen; u.slab = ks; return true; }
    __device__ __forceinline__ void a_ready(const Unit&) const {}
    __device__ __forceinline__ void done(const Unit&) const {}
};
struct CountedOrder : StaticOrder {
    const unsigned* ready; unsigned need; unsigned* tmo;
    __device__ __forceinline__ void a_ready(const Unit& u) const {
        if (threadIdx.x < 64) {
            const unsigned long long t0 = __builtin_amdgcn_s_memrealtime(); unsigned polls = 0;
            while ((unsigned)__builtin_amdgcn_readfirstlane(__hip_atomic_load(ready + 64 * u.pm, __ATOMIC_RELAXED, __HIP_MEMORY_SCOPE_AGENT)) < need) {
                if ((++polls & 255u) == 0u && __builtin_amdgcn_readfirstlane(__hip_atomic_load(tmo, __ATOMIC_RELAXED, __HIP_MEMORY_SCOPE_AGENT)) != 0u) break;
                if (__builtin_amdgcn_s_memrealtime() - t0 > 2000000ull) {
                    if (threadIdx.x == 0) { unsigned expect = 0u; __hip_atomic_compare_exchange_strong(tmo + 1, &expect, 0x600u | (unsigned)(u.pm & 0xff), __ATOMIC_RELAXED, __ATOMIC_RELAXED, __HIP_MEMORY_SCOPE_AGENT); __hip_atomic_store(tmo, 1u, __ATOMIC_RELAXED, __HIP_MEMORY_SCOPE_AGENT); }
                    break; }
                __builtin_amdgcn_s_sleep(2); }
            __builtin_amdgcn_fence(__ATOMIC_ACQUIRE, "agent");
            asm volatile("s_waitcnt vmcnt(0)" ::: "memory");
        }
#if !defined(BROKEN_HOOK_NO_BARRIER)
        asm volatile("" ::: "memory"); __builtin_amdgcn_s_barrier(); asm volatile("" ::: "memory");
#endif
    }
};

__device__ __forceinline__ unsigned cvt_pk_bf16(float lo, float hi) { unsigned r; asm volatile("v_cvt_pk_bf16_f32 %0, %1, %2" : "=v"(r) : "v"(lo), "v"(hi)); return r; }
typedef float f32x2 __attribute__((ext_vector_type(2)));
__device__ __forceinline__ f32x2 gelu_pk(f32x2 v) {
    const f32x2 av = __builtin_elementwise_abs(v), d = av * 0.2316418882f + 1.0f;
    f32x2 t; t.x = __builtin_amdgcn_rcpf(d.x); t.y = __builtin_amdgcn_rcpf(d.y);
    f32x2 q = t * 0.5307027145f + (-0.7265760135f); q = q * t + 0.7107068705f; q = q * t + (-0.142248368f); q = q * t + 0.127414796f; q = q * t;
    const f32x2 s = (v * v) * (-0.72134752044f);
    f32x2 e; e.x = __builtin_amdgcn_exp2f(s.x); e.y = __builtin_amdgcn_exp2f(s.y);
    const f32x2 m = v * (q * e), r = v - m;
    f32x2 o; o.x = v.x < 0.f ? m.x : r.x; o.y = v.y < 0.f ? m.y : r.y; return o;
}

struct EpiF32 {
    static constexpr bool PERM = false, AFTER_DRAIN = false;
    float* C; int ldc; const float* bias; size_t slab_stride = 0;
    __device__ __forceinline__ void operator()(const f32x4 (&acc)[2][2][4][2], const Unit& u, int wr, int wc, int fr, int fq) const {
        const int row0 = u.pm * BM + wr * 64 + fr, col0 = u.pn * BM + wc * 32 + 4 * fq; float* const Cb = C + (size_t)u.slab * slab_stride;
        f32x4 bv[2][2];
#pragma unroll
        for (int bj = 0; bj < 2; ++bj)
#pragma unroll
            for (int n = 0; n < 2; ++n) bv[bj][n] = bias ? *(const f32x4*)(bias + col0 + bj * HALF + n * 16) : (f32x4){0.f, 0.f, 0.f, 0.f};
#pragma unroll
        for (int ai = 0; ai < 2; ++ai)
#pragma unroll
            for (int m = 0; m < 4; ++m) { float* rowp = Cb + (size_t)(row0 + ai * HALF + m * 16) * ldc + col0;
#pragma unroll
                for (int bj = 0; bj < 2; ++bj)
#pragma unroll
                    for (int n = 0; n < 2; ++n) *(f32x4*)(rowp + bj * HALF + n * 16) = acc[ai][bj][m][n] + bv[bj][n]; }
    }
};
template <int ACT  > struct EpiBf16 {
    static constexpr bool PERM = true, AFTER_DRAIN = false;
    bf16_t* O; int ldc; const float* bias; int split_cols; size_t split_stride;
    __device__ __forceinline__ void operator()(const f32x4 (&acc)[2][2][4][2], const Unit& u, int wr, int wc, int fr, int fq) const {
        const int row0 = u.pm * BM + wr * 64 + fr; int colt = u.pn * BM; bf16_t* base = O;
        if (split_cols) { const int t = colt / split_cols; base += (size_t)t * split_stride; colt -= t * split_cols; }
        const int col0 = colt + wc * 32 + 8 * fq, bcol0 = u.pn * BM + wc * 32 + 8 * fq;
        f32x4 bv[2][2];
#pragma unroll
        for (int bj = 0; bj < 2; ++bj)
#pragma unroll
            for (int n = 0; n < 2; ++n) bv[bj][n] = bias ? *(const f32x4*)(bias + bcol0 + bj * HALF + 4 * n) : (f32x4){0.f, 0.f, 0.f, 0.f};
#pragma unroll
        for (int ai = 0; ai < 2; ++ai)
#pragma unroll
            for (int m = 0; m < 4; ++m) { bf16_t* rowp = base + (size_t)(row0 + ai * HALF + m * 16) * ldc + col0;
#pragma unroll
                for (int bj = 0; bj < 2; ++bj) { f32x4 v0 = acc[ai][bj][m][0] + bv[bj][0], v1 = acc[ai][bj][m][1] + bv[bj][1];
                    if (ACT == 1) { f32x2 a = gelu_pk((f32x2){v0[0], v0[1]}), b = gelu_pk((f32x2){v0[2], v0[3]}), c = gelu_pk((f32x2){v1[0], v1[1]}), d = gelu_pk((f32x2){v1[2], v1[3]});
                        v0 = (f32x4){a.x, a.y, b.x, b.y}; v1 = (f32x4){c.x, c.y, d.x, d.y}; }
                    if (ACT == 2) {
#pragma unroll
                        for (int j = 0; j < 4; ++j) { v0[j] = 0.5f * v0[j] * (1.0f + erff(v0[j] * 0.70710678f)); v1[j] = 0.5f * v1[j] * (1.0f + erff(v1[j] * 0.70710678f)); } }
                    u32x4 w; w.x = cvt_pk_bf16(v0[0], v0[1]); w.y = cvt_pk_bf16(v0[2], v0[3]); w.z = cvt_pk_bf16(v1[0], v1[1]); w.w = cvt_pk_bf16(v1[2], v1[3]);
                    *(u32x4*)(rowp + bj * HALF) = w; } }
    }
};
template <class Epi, class Sched, bool STAMP = false>
__device__ __forceinline__ void gemm_phase(PG8_LAS unsigned char* lds, const Gemm g, const Sched& S, const Epi& E, unsigned long long* stamps, const int tid) {
    const int  wid = __builtin_amdgcn_readfirstlane(tid >> 6), lane = tid & 63, wr = wid >> 2, wc = wid & 3, fr = lane & 15, fq = lane >> 4;
    const int K = g.ld, nt = g.K / BK;
    int ts_lo = 0, ts_hi = 0, nts = 0; const unsigned long long rt_entry = STAMP ? (unsigned long long)wall_clock64() : 0ull;
#define PG8_STAMP() do { if (STAMP && wid == 0 && nts < 64) { const unsigned long long _c = (unsigned long long)clock64(); \
        ts_lo = (lane == nts) ? (int)(unsigned)_c : ts_lo; ts_hi = (lane == nts) ? (int)(unsigned)(_c >> 32) : ts_hi; ++nts; } } while (0)
    PG8_STAMP();
    unsigned voffA[2], voffB[2];
#pragma unroll
    for (int i = 0; i < 2; ++i) { int R, C; stage_rc(tid * 16 + i * 8192, R, C); const int Rb = Epi::PERM ? ((R & ~31) + perm32(R & 31)) : R;
        voffA[i] = (unsigned)(R * K + C) * 2u; voffB[i] = (unsigned)(Rb * K + C) * 2u; }
    const size_t kstep = (size_t)(BK * 2);
    const size_t hstep = (size_t)HALF * K * 2;
    const size_t tstep = 2 * hstep;
    const unsigned ldsw = (unsigned)wid * 1024u;
    const int aoff = lds_byte(wr * 64 + fr, fq * 8), boff = lds_byte(wc * 32 + fr, fq * 8);
#define PG8_SA(b, h) (((b) * 2 + (h)) * HTB)
#define PG8_SB(b, h) ((4 + (b) * 2 + (h)) * HTB)
#define PG8_STAGE(bufoff, gbase, voff) do { _Pragma("unroll") for (int _i = 0; _i < 2; ++_i) \
        __builtin_amdgcn_global_load_lds((const unsigned*)((const char*)(gbase) + (voff)[_i]), (PG8_LAS unsigned*)(lds + (bufoff) + ldsw + _i * 8192), 16, 0, 0); } while (0)
#define PG8_LDA(dst, b, h) do { _Pragma("unroll") for (int m = 0; m < 4; ++m) _Pragma("unroll") for (int k = 0; k < 2; ++k) dst[m][k] = *(const PG8_LAS bf16x8*)(lds + PG8_SA(b, h) + aoff + m * 2048 + k * 1024); } while (0)
#define PG8_LDB(dst, b, h) do { _Pragma("unroll") for (int n = 0; n < 2; ++n) _Pragma("unroll") for (int k = 0; k < 2; ++k) dst[n][k] = *(const PG8_LAS bf16x8*)(lds + PG8_SB(b, h) + boff + n * 2048 + k * 1024); } while (0)
#define PG8_MMA(ai, bj, At, Bt) do { __builtin_amdgcn_s_setprio(1); _Pragma("unroll") for (int m = 0; m < 4; ++m) _Pragma("unroll") for (int n = 0; n < 2; ++n) _Pragma("unroll") for (int k = 0; k < 2; ++k) \
        acc[ai][bj][m][n] = __builtin_amdgcn_mfma_f32_16x16x32_bf16(Bt[n][k], At[m][k], acc[ai][bj][m][n], 0, 0, 0); __builtin_amdgcn_s_setprio(0); } while (0)
#define PG8_WAIT_V(n) asm volatile("s_waitcnt vmcnt(" #n ")" ::: "memory")
#define PG8_WAIT_L(n) asm volatile("s_waitcnt lgkmcnt(" #n ")" ::: "memory")
#define PG8_BAR __builtin_amdgcn_s_barrier()
#define PG8_SCHED __builtin_amdgcn_sched_barrier(0)
    Unit cur, nxt; int ui = 0;
    if (!S.next(0, cur)) return;
    f32x4 acc[2][2][4][2];
#pragma unroll
    for (int a = 0; a < 2; ++a)
#pragma unroll
        for (int b = 0; b < 2; ++b)
#pragma unroll
            for (int m = 0; m < 4; ++m)
#pragma unroll
                for (int n = 0; n < 2; ++n) acc[a][b][m][n] = (f32x4){0.f, 0.f, 0.f, 0.f};
    bf16x8 At[4][2], B0[2][2], B1[2][2];
    const char* cA = (const char*)g.A + (size_t)cur.pm * tstep + (size_t)cur.kofs * 2; const char* cB = (const char*)g.Bt + (size_t)cur.pn * tstep + (size_t)cur.kofs * 2;
    S.a_ready(cur);
    PG8_STAGE(PG8_SB(0, 0), cB, voffB); PG8_STAGE(PG8_SA(0, 0), cA, voffA); PG8_STAGE(PG8_SB(0, 1), cB + hstep, voffB); PG8_STAGE(PG8_SA(0, 1), cA + hstep, voffA);
    if (wr == 1) PG8_BAR;
    PG8_WAIT_V(4); PG8_BAR;
    PG8_STAGE(PG8_SB(1, 0), cB + kstep, voffB); PG8_STAGE(PG8_SA(1, 0), cA + kstep, voffA); PG8_STAGE(PG8_SB(1, 1), cB + hstep + kstep, voffB);
    PG8_WAIT_V(6); PG8_BAR;
    PG8_STAMP();
    for (;;) {
        const bool has_next = S.next(ui + 1, nxt);
        const char* nA = has_next ? (const char*)g.A + (size_t)nxt.pm * tstep + (size_t)nxt.kofs * 2 : cA; const char* nB = has_next ? (const char*)g.Bt + (size_t)nxt.pn * tstep + (size_t)nxt.kofs * 2 : cB;
        for (int t = 0; t < nt; t += 2) {
            const bool last = (t == nt - 2);
            const char* a1 = cA + (size_t)(t + 1) * kstep;
            const char* a2 = last ? nA : cA + (size_t)(t + 2) * kstep; const char* b2 = last ? nB : cB + (size_t)(t + 2) * kstep;
            const char* a3 = a2 + kstep; const char* b3 = b2 + kstep;
            if (last && has_next) S.a_ready(nxt);
            PG8_LDB(B0, 0, 0); PG8_SCHED; PG8_LDA(At, 0, 0); PG8_STAGE(PG8_SA(1, 1), a1 + hstep, voffA);
            PG8_WAIT_L(8); PG8_BAR; PG8_WAIT_L(0); PG8_MMA(0, 0, At, B0); PG8_BAR; PG8_SCHED;
            PG8_LDB(B1, 0, 1); PG8_STAGE(PG8_SB(0, 0), b2, voffB);
            PG8_BAR; PG8_WAIT_L(0); PG8_MMA(0, 1, At, B1); PG8_BAR;
            PG8_LDA(At, 0, 1); PG8_STAGE(PG8_SA(0, 0), a2, voffA);
            PG8_BAR; PG8_WAIT_L(0); PG8_MMA(1, 0, At, B0); PG8_BAR; PG8_SCHED;
            PG8_STAGE(PG8_SB(0, 1), b2 + hstep, voffB);
            PG8_WAIT_V(6); PG8_BAR; PG8_MMA(1, 1, At, B1); PG8_BAR;
            PG8_LDB(B0, 1, 0); PG8_SCHED; PG8_LDA(At, 1, 0); PG8_STAGE(PG8_SA(0, 1), a2 + hstep, voffA);
            PG8_WAIT_L(8); PG8_BAR; PG8_WAIT_L(0); PG8_MMA(0, 0, At, B0); PG8_BAR; PG8_SCHED;
            PG8_LDB(B1, 1, 1); PG8_STAGE(PG8_SB(1, 0), b3, voffB);
            PG8_BAR; PG8_WAIT_L(0); PG8_MMA(0, 1, At, B1); PG8_BAR;
            PG8_LDA(At, 1, 1); PG8_STAGE(PG8_SA(1, 0), a3, voffA);
            PG8_BAR; PG8_WAIT_L(0); PG8_MMA(1, 0, At, B0); PG8_BAR; PG8_SCHED;
            PG8_STAGE(PG8_SB(1, 1), b3 + hstep, voffB);
            PG8_WAIT_V(6); PG8_BAR; PG8_MMA(1, 1, At, B1); PG8_BAR;
        }
        PG8_STAMP();
        if constexpr (!Epi::AFTER_DRAIN) { E(acc, cur, wr, wc, fr, fq); S.done(cur); }
        PG8_STAMP();
        if (!has_next) break;
#pragma unroll
        for (int a = 0; a < 2; ++a)
#pragma unroll
            for (int b = 0; b < 2; ++b)
#pragma unroll
                for (int m = 0; m < 4; ++m)
#pragma unroll
                    for (int n = 0; n < 2; ++n) acc[a][b][m][n] = (f32x4){0.f, 0.f, 0.f, 0.f};
        cur = nxt; cA = nA; cB = nB; ++ui;
    }
    PG8_WAIT_V(0);
    if (wr == 0) PG8_BAR;
    PG8_BAR;
    if constexpr (Epi::AFTER_DRAIN) { E.fused(acc, cur, wr, wc, fr, fq, lds, wid, lane); S.done(cur); }
    PG8_STAMP();
    if (STAMP && wid == 0) { stamps[lane] = lane < nts ? (((unsigned long long)(unsigned)ts_hi << 32) | (unsigned)ts_lo) : 0ull;
        if (lane == 62) stamps[62] = rt_entry; if (lane == 63) stamps[63] = (unsigned long long)wall_clock64(); }
#undef PG8_STAMP
#undef PG8_SA
#undef PG8_SB
#undef PG8_STAGE
#undef PG8_LDA
#undef PG8_LDB
#undef PG8_MMA
#undef PG8_WAIT_V
#undef PG8_WAIT_L
#undef PG8_BAR
#undef PG8_SCHED
}
}
struct Args { const float* in[N_IN]; float* out; unsigned char* ws; int ph_lo, ph_hi; };
struct Frame {
    LAS unsigned char* lds;
    int tid, lane, wave, vcu, G;
    const float* const* in; GAS float* out; GAS unsigned char* ws;
};
using bf16x2v = __attribute__((ext_vector_type(2))) __bf16;
__device__ __forceinline__ float dot2bf(unsigned a, unsigned b, float acc) { return __builtin_amdgcn_fdot2_f32_bf16(__builtin_bit_cast(bf16x2v, a), __builtin_bit_cast(bf16x2v, b), acc, false); }

__device__ __forceinline__ void ld8bf(const bf16* p, float (&o)[8]) { const v4u w = *(const v4u*)p; o[0] = bf_lo(w.x); o[1] = bf_hi(w.x); o[2] = bf_lo(w.y); o[3] = bf_hi(w.y); o[4] = bf_lo(w.z); o[5] = bf_hi(w.z); o[6] = bf_lo(w.w); o[7] = bf_hi(w.w); }
struct TileInfo { int seq_base, seq_len, t0; };
__device__ __forceinline__ TileInfo tile_info(int c) {
    TileInfo ti;
    if (c < 128) { ti.seq_base = (c >> 6) * SEQ; ti.seq_len = SEQ; ti.t0 = (c & 63) * 64; }
    else { const int cc = c - 128; ti.seq_base = NLAT + (cc >> 2) * CTXL; ti.seq_len = CTXL; ti.t0 = (cc & 3) * 64; }
    return ti;
}
__device__ __forceinline__ int mod_row(int row) { return row < NLAT ? (row >> 12) : 2; }
__device__ __forceinline__ bf16x8 frag_lds(const LAS bf16* base, int ld, int row0, int k0, int lane) { return *(const LAS bf16x8*)(base + (row0 + (lane & 15)) * ld + k0 + 8 * (lane >> 4)); }
__device__ __forceinline__ bf16x8 frag_g(const bf16* base, int ld, int row0, int k0, int lane) { return *(const bf16x8*)(base + (size_t)(row0 + (lane & 15)) * ld + k0 + 8 * (lane >> 4)); }
#define MFMA16(a, b, c) __builtin_amdgcn_mfma_f32_16x16x32_bf16((a), (b), (c), 0, 0, 0)

__device__ __forceinline__ void p0_transpose_item(const float* W, int K, int N, bf16* WT, LAS float* scr, int item, int lane) {
    const int nblk = N / 32, kb = item / nblk, nb = item % nblk, k0 = 64 * kb, n0 = 32 * nb;
#pragma unroll 8
    for (int i = 0; i < 32; ++i) { const int kk = 2 * i + (lane >> 5); scr[kk * 33 + (lane & 31)] = W[(size_t)(k0 + kk) * N + n0 + (lane & 31)]; }
    LDS_WAIT(); asm volatile("" ::: "memory");
    const int c = lane & 7;
#pragma unroll
    for (int j = 0; j < 4; ++j) { const int n = (lane >> 3) + 8 * j; const LAS float* s = scr + (8 * c) * 33 + n;
        v4u o; o.x = pk2(s[0 * 33], s[1 * 33]); o.y = pk2(s[2 * 33], s[3 * 33]); o.z = pk2(s[4 * 33], s[5 * 33]); o.w = pk2(s[6 * 33], s[7 * 33]);
        *(v4u*)(WT + (size_t)(n0 + n) * K + k0 + 8 * c) = o; }
    LDS_WAIT(); asm volatile("" ::: "memory");
}
__device__ __forceinline__ void conv_f32_bf16(const float* src, bf16* dst, size_t n8, size_t i0, size_t stride) {
    for (size_t i = i0; i < n8; i += stride) { const f32x4 a = *(const f32x4*)(src + i * 8), b = *(const f32x4*)(src + i * 8 + 4);
        v4u o; o.x = pk2(a.x, a.y); o.y = pk2(a.z, a.w); o.z = pk2(b.x, b.y); o.w = pk2(b.z, b.w); *(v4u*)(dst + i * 8) = o; }
}
__device__ __forceinline__ void convert_layer(Frame& F, int l, int w, int NW, LAS float* scr) {
    constexpr int IT_IN = (D / 64) * (IN_COLS / 32), IT_SQ = (D / 64) * (D / 32);
    for (int it = w; it < IT_IN + 2 * IT_SQ; it += NW) {
        int r = it;
        if (r < IT_IN) { p0_transpose_item(gin(F.in[I_WIN]) + (size_t)l * D * IN_COLS, D, IN_COLS, (bf16*)(F.ws + WS_WIN) + (size_t)l * IN_PAD * D, scr, r, F.lane); continue; }
        r -= IT_IN;
        if (r < IT_SQ) { p0_transpose_item(gin(F.in[I_WOUT]) + (size_t)l * D * D, D, D, (bf16*)(F.ws + WS_WOUT) + (size_t)l * D * D, scr, r, F.lane); continue; }
        r -= IT_SQ;
        p0_transpose_item(gin(F.in[I_WQ]) + (size_t)l * D * D, D, D, (bf16*)(F.ws + WS_WQ) + (size_t)l * D * D, scr, r, F.lane);
    }
    { constexpr int PADV = (IN_PAD - IN_COLS) * D / 8;
      for (int i = w * 64 + F.lane; i < PADV; i += NW * 64) *(v4u*)((bf16*)(F.ws + WS_WIN) + ((size_t)l * IN_PAD + IN_COLS) * D + (size_t)i * 8) = (v4u){0u, 0u, 0u, 0u}; }
    for (int it = w; it < 2 * PE_NE; it += NW) {
        const int tab = it >= PE_NE, r = l * PE_NE + (tab ? it - PE_NE : it); const float* src = gin(F.in[tab ? I_V : I_U]) + (size_t)r * D + F.lane * 4;
        f32x4 x[8]; float mx = 0.f;
#pragma unroll
        for (int i = 0; i < 8; ++i) { x[i] = *(const f32x4*)(src + i * 256); mx = fmaxf(mx, fmaxf(fmaxf(fabsf(x[i].x), fabsf(x[i].y)), fmaxf(fabsf(x[i].z), fabsf(x[i].w)))); }
        mx = wave_max(mx); const float sc = mx > 0.f ? mx * (1.0f / 448.0f) : 1.0f, inv = 1.0f / sc;
        unsigned* dst = (unsigned*)(F.ws + (tab ? WS_VB : WS_UB) + (size_t)r * D) + F.lane;
#pragma unroll
        for (int i = 0; i < 8; ++i) { int q = __builtin_amdgcn_cvt_pk_fp8_f32(x[i].x * inv, x[i].y * inv, 0, false); q = __builtin_amdgcn_cvt_pk_fp8_f32(x[i].z * inv, x[i].w * inv, q, true); dst[i * 64] = (unsigned)q; }
        if (F.lane == 0) ((float*)(F.ws + (tab ? WS_SV : WS_SU)))[r] = sc;
    }
}
__device__ __forceinline__ void p0_prologue(Frame& F) {
    LAS float* scr = (LAS float*)(F.lds + F.wave * 16384);
    const int gw = F.vcu * NWAVES + F.wave, NGW = F.G * NWAVES;
    const size_t gt = (size_t)F.vcu * NTHR + F.tid, NGT = (size_t)F.G * NTHR;
    for (int l = 0; l < DEPTH; ++l) convert_layer(F, l, gw, NGW, scr);
    { bf16* dst = (bf16*)(F.ws + WS_WLRU);
      for (size_t idx = gt; idx < (size_t)DEPTH * 2 * 2 * 16 * 64 * 64; idx += NGT) { const int i = (int)(idx & 63), j = (int)((idx >> 6) & 63), m = (int)(idx >> 12);
          const int hh = m & 15, d = (m >> 4) & 1, gate = (m >> 5) & 1, l = m >> 6; const float* src = gin(F.in[gate ? I_WX : I_WA]);
          dst[idx] = (bf16)f2bf(src[((size_t)((l * 2 + d) * 16 + hh) * 64 + i) * 64 + j]); } }
    { bf16* d2 = (bf16*)(F.ws + WS_W2T); bf16* da = (bf16*)(F.ws + WS_A2T);
      for (size_t idx = gt; idx < (size_t)DEPTH * 2 * 1024 * 64; idx += NGT) { const int k = (int)(idx & 63), c = (int)((idx >> 6) & 1023), ld = (int)(idx >> 16);
          d2[idx] = (bf16)f2bf(gin(F.in[I_W2])[((size_t)ld * 64 + k) * 1024 + c]); da[idx] = (bf16)f2bf(gin(F.in[I_A2])[((size_t)ld * 64 + k) * 1024 + c]); } }
    { bf16* dg = (bf16*)(F.ws + WS_G2T);
      for (size_t idx = gt; idx < (size_t)DEPTH * 1024 * 160; idx += NGT) { const int k = (int)(idx % 160), c = (int)((idx / 160) % 1024), l = (int)(idx / (160 * 1024));
          dg[idx] = (bf16)f2bf(gin(F.in[I_G2])[((size_t)l * 160 + k) * 1024 + c]); } }
    conv_f32_bf16(gin(F.in[I_SUBK]), (bf16*)(F.ws + WS_SUBK), (size_t)DEPTH * 8 * 2 * 128 * 128 / 8, gt, NGT);
    { float* X = (float*)(F.ws + WS_X);
      for (size_t i = gt; i < (size_t)MTOT * D / 4; i += NGT) { const int row = (int)(i / (D / 4)), e0 = (int)(i % (D / 4)) * 4;
          if (row < NLAT) { f32x4 v = *(const f32x4*)(gin(F.in[I_X]) + (size_t)row * D + e0); const int t = row & (SEQ - 1); const float pr = (float)(t >> 6), pc = (float)(t & 63);
              float o[4];
#pragma unroll
              for (int j = 0; j < 4; ++j) { const int e = e0 + j, q = e >> 9, fi = e & 511; const float freq = __builtin_amdgcn_exp2f(-13.287712379549449f * (float)fi * (1.0f / 512.0f));
                  const float ang = ((q >> 1) ? pc : pr) * freq; float rev = ang * 0.15915494309189535f; rev -= floorf(rev);
                  o[j] = (q & 1) ? __builtin_amdgcn_cosf(rev) : __builtin_amdgcn_sinf(rev); }
              v.x += o[0]; v.y += o[1]; v.z += o[2]; v.w += o[3]; *(f32x4*)(X + (size_t)row * D + e0) = v; }
          else *(f32x4*)(X + (size_t)row * D + e0) = *(const f32x4*)(gin(F.in[I_CTX]) + (size_t)(row - NLAT) * D + e0); } }
    { float* MODP = (float*)(F.ws + WS_MODP); const float* cin = gin(F.in[I_C]); const float* cctx = gin(F.in[I_CCTX]);
      for (int it = gw; it < DEPTH * KSPLIT * 48; it += NGW) { const int cg = it % 48, kp = (it / 48) % KSPLIT, l = it / (48 * KSPLIT); const int col = cg * 256 + F.lane * 4, k0 = kp * (D / KSPLIT);
          f32x4 a0 = {0.f, 0.f, 0.f, 0.f}, a1 = a0, a2 = a0; const float* wp = gin(F.in[I_ADAW]) + ((size_t)l * D + k0) * (6 * D) + col;
#pragma unroll 4
          for (int k = 0; k < D / KSPLIT; ++k) { const f32x4 w = *(const f32x4*)(wp + (size_t)k * (6 * D)); const float c0 = cin[k0 + k], c1 = cin[D + k0 + k], c2 = cctx[k0 + k];
              const float s0 = c0 * fsigmoid(c0), s1 = c1 * fsigmoid(c1), s2 = c2 * fsigmoid(c2); a0 += w * s0; a1 += w * s1; a2 += w * s2; }
          float* o = MODP + ((size_t)(kp * DEPTH + l) * 3) * (6 * D) + col; *(f32x4*)o = a0; *(f32x4*)(o + 6 * D) = a1; *(f32x4*)(o + 12 * D) = a2; } }
}
__device__ __forceinline__ void p0b_mod_reduce(Frame& F) {
    const size_t gt = (size_t)F.vcu * NTHR + F.tid, NGT = (size_t)F.G * NTHR; const float* MODP = (const float*)(F.ws + WS_MODP); float* MOD = (float*)(F.ws + WS_MOD);
    for (size_t i = gt; i < (size_t)DEPTH * 3 * 6 * D; i += NGT) { const int n = (int)(i % (6 * D)), l = (int)(i / (3 * 6 * D)); float s = gin(F.in[I_ADAB])[(size_t)l * 6 * D + n];
#pragma unroll
        for (int kp = 0; kp < KSPLIT; ++kp) s += MODP[(size_t)kp * DEPTH * 3 * 6 * D + i];
        MOD[i] = s; }
}
__device__ __forceinline__ void modulate_rows(Frame& F, int l, int which, int nrows) {
    const int gw = F.vcu * NWAVES + F.wave, NGW = F.G * NWAVES; const float* X = (const float*)(F.ws + WS_X); bf16* H = (bf16*)(F.ws + WS_H);
    for (int row = gw; row < nrows; row += NGW) { const float* md = (const float*)(F.ws + WS_MOD) + ((size_t)l * 3 + mod_row(row)) * (6 * D) + which * 3 * D;
#pragma unroll
        for (int j = 0; j < 4; ++j) { const int e = j * 512 + F.lane * 8; const f32x4 x0 = *(const f32x4*)(X + (size_t)row * D + e), x1 = *(const f32x4*)(X + (size_t)row * D + e + 4);
            const f32x4 s0 = *(const f32x4*)(md + e), s1 = *(const f32x4*)(md + e + 4), c0 = *(const f32x4*)(md + D + e), c1 = *(const f32x4*)(md + D + e + 4);
            const f32x4 y0 = x0 * (c0 + 1.0f) + s0, y1 = x1 * (c1 + 1.0f) + s1;
            v4u o; o.x = pk2(y0.x, y0.y); o.y = pk2(y0.z, y0.w); o.z = pk2(y1.x, y1.y); o.w = pk2(y1.z, y1.w); *(v4u*)(H + (size_t)row * D + e) = o; } }
}

__device__ __forceinline__ void lru_prep_unit(Frame& F, int l, int c, int hh) {
    int tid = F.tid; asm volatile("" : "+v"(tid));
    const int lane = tid & 63, wave = F.wave;
    const TileInfo ti = tile_info(c); const bf16* P = (const bf16*)(F.ws + WS_P);
    LAS float* Us = (LAS float*)F.lds; LAS float* XC = (LAS float*)(F.lds + 17408); LAS bf16* XCb = (LAS bf16*)(F.lds + 34304);
    LAS float* LAs = (LAS float*)(F.lds + 43520); LAS float* LBs = (LAS float*)(F.lds + 76288); LAS float* SEGA = (LAS float*)(F.lds + 109056); LAS float* SEGH = SEGA + 512;
    for (int idx = tid; idx < 67 * 64; idx += NTHR) { const int r = idx >> 6, ch = idx & 63, t = ti.t0 - 2 + r;
        Us[idx] = (t >= 0 && t < ti.seq_len) ? __builtin_bit_cast(float, (unsigned)P[(size_t)(ti.seq_base + t) * IN_PAD + hh * 64 + ch] << 16) : 0.f; }
    __syncthreads();
    { const float* cw = gin(F.in[I_CONVW]) + (size_t)l * 4 * LRW; const float* cb = gin(F.in[I_CONVB]) + (size_t)l * LRW;
      for (int idx = tid; idx < 64 * 64; idx += NTHR) { const int t = idx >> 6, ch = idx & 63, cg = hh * 64 + ch;
          float v = cb[cg];
#pragma unroll
          for (int tap = 0; tap < 4; ++tap) v += cw[tap * LRW + cg] * Us[(t + tap) * 64 + ch];
          XC[t * 65 + ch] = v; XCb[t * 72 + ch] = (bf16)f2bf(v); } }
    __syncthreads();
    { const int d = wave >> 2, m = wave & 3;
      const bf16x8 a0 = frag_lds(XCb, 72, 16 * m, 0, lane), a1 = frag_lds(XCb, 72, 16 * m, 32, lane);
      const bf16* Wa = (const bf16*)(F.ws + WS_WLRU) + (size_t)(((l * 2 + 0) * 2 + d) * 16 + hh) * 4096;
      const bf16* Wx = (const bf16*)(F.ws + WS_WLRU) + (size_t)(((l * 2 + 1) * 2 + d) * 16 + hh) * 4096;
#pragma unroll
      for (int n = 0; n < 4; ++n) {
          f32x4 ar = {0.f, 0.f, 0.f, 0.f}, ai = ar;
          ar = MFMA16(a0, frag_g(Wa, 64, 16 * n, 0, lane), ar); ar = MFMA16(a1, frag_g(Wa, 64, 16 * n, 32, lane), ar);
          ai = MFMA16(a0, frag_g(Wx, 64, 16 * n, 0, lane), ai); ai = MFMA16(a1, frag_g(Wx, 64, 16 * n, 32, lane), ai);
          const int col = 16 * n + (lane & 15), cg = hh * 64 + col;
          const float ba = gin(F.in[I_BA])[(size_t)(l * 2 + d) * LRW + cg], bx = gin(F.in[I_BX])[(size_t)(l * 2 + d) * LRW + cg];
          const float sp = fsoftplus(-gin(F.in[I_LAM])[(size_t)(l * 2 + d) * LRW + cg]);
#pragma unroll
          for (int r = 0; r < 4; ++r) { const int row = 16 * m + 4 * (lane >> 4) + r;
              const float rr = fsigmoid(ar[r] + ba), ii = fsigmoid(ai[r] + bx), loga = -8.0f * rr * sp, a = fexp(loga);
              const float bb = __builtin_amdgcn_sqrtf(fmaxf(1.0f - a * a, 0.f)) * ii * XC[row * 65 + col];
              LAs[(d * 64 + row) * 64 + col] = a; LBs[(d * 64 + row) * 64 + col] = bb; } } }
    __syncthreads();
    { const int col = tid & 63, seg = (tid >> 6) & 3, d = tid >> 8, cg = hh * 64 + col; float hl[16], al[16]; float h = 0.f, A = 1.f;
#pragma unroll
      for (int i = 0; i < 16; ++i) { const int tau = 16 * seg + i, row = d ? 63 - tau : tau; const float a = LAs[(d * 64 + row) * 64 + col], b = LBs[(d * 64 + row) * 64 + col]; h = a * h + b; A *= a; hl[i] = h; al[i] = A; }
      SEGA[(d * 4 + seg) * 64 + col] = A; SEGH[(d * 4 + seg) * 64 + col] = h;
      __syncthreads();
      float Hin = 0.f, Ain = 1.f;
#pragma unroll
      for (int s2 = 0; s2 < 3; ++s2) if (s2 < seg) { const float sa = SEGA[(d * 4 + s2) * 64 + col]; Hin = sa * Hin + SEGH[(d * 4 + s2) * 64 + col]; Ain *= sa; }
      bf16* HL = (bf16*)(F.ws + WS_LB) + (size_t)d * MTOT * LRW; bf16* AC = (bf16*)(F.ws + WS_LA) + (size_t)d * MTOT * LRW;
#pragma unroll
      for (int i = 0; i < 16; ++i) { const int tau = 16 * seg + i, row = d ? 63 - tau : tau; const size_t o = (size_t)(ti.seq_base + ti.t0 + row) * LRW + cg; HL[o] = (bf16)f2bf(hl[i] + al[i] * Hin); AC[o] = (bf16)f2bf(al[i] * Ain); }
      if (seg == 3) { float* AG = (float*)(F.ws + WS_LAGG); AG[((size_t)(0 * 2 + d) * NTILE + c) * LRW + cg] = al[15] * Ain; AG[((size_t)(1 * 2 + d) * NTILE + c) * LRW + cg] = hl[15] + al[15] * Hin; } }
    __syncthreads();
}
__device__ __forceinline__ void shifted8(const bf16* P, size_t grow, bool hp, bool hn, const float* mu0, const float* mu1, int rc, float (&o)[8]) {
    const bf16* p = P + grow * IN_PAD + 2 * LRW + rc;
    float xs[8], ms[8], ns[8]; ld8bf(p, xs);
#pragma unroll
    for (int e = 0; e < 8; ++e) { ms[e] = 0.f; ns[e] = 0.f; }
    if (hp) ld8bf(p - IN_PAD, ms);
    if (hn) ld8bf(p + IN_PAD, ns);
    const f32x4 a0 = *(const f32x4*)(mu0 + rc), a1 = *(const f32x4*)(mu0 + rc + 4), b0 = *(const f32x4*)(mu1 + rc), b1 = *(const f32x4*)(mu1 + rc + 4);
    const float m0[8] = {a0.x, a0.y, a0.z, a0.w, a1.x, a1.y, a1.z, a1.w}, m1[8] = {b0.x, b0.y, b0.z, b0.w, b1.x, b1.y, b1.z, b1.w};
#pragma unroll
    for (int e = 0; e < 8; ++e) o[e] = xs[e] + m0[e] * (ms[e] - xs[e]) + m1[e] * (ns[e] - xs[e]);
}
constexpr int MB = 9216;
constexpr int MLD = 72;
#define MSLOT(k) ((LAS bf16*)(F.lds + (k) * MB))
__device__ __forceinline__ f32x4 mm_tile(const LAS bf16* Y, int rt, const LAS bf16* X, int ct, f32x4 acc, int lane) {
    acc = MFMA16(frag_lds(Y, MLD, 16 * rt, 0, lane), frag_lds(X, MLD, 16 * ct, 0, lane), acc);
    acc = MFMA16(frag_lds(Y, MLD, 16 * rt, 32, lane), frag_lds(X, MLD, 16 * ct, 32, lane), acc);
    return acc;
}
__device__ __forceinline__ void st_tile(LAS bf16* Dst, int rt, int ct, f32x4 acc, int lane) {
    v2u o; o.x = pk2(acc[0], acc[1]); o.y = pk2(acc[2], acc[3]);
    *(LAS v2u*)(Dst + (16 * ct + (lane & 15)) * MLD + 16 * rt + 4 * (lane >> 4)) = o;
}
__device__ __forceinline__ f32x4 ld_tile(const LAS bf16* Src, int rt, int ct, int lane) {
    const v2u o = *(const LAS v2u*)(Src + (16 * ct + (lane & 15)) * MLD + 16 * rt + 4 * (lane >> 4));
    return (f32x4){bf_lo(o.x), bf_hi(o.x), bf_lo(o.y), bf_hi(o.y)};
}
template <int MASK> __device__ __forceinline__ void mm64(LAS bf16* Dst, const LAS bf16* X, const LAS bf16* Y, int wave, int lane) {
    const int rt = wave >> 1;
#pragma unroll
    for (int q = 0; q < 2; ++q) { const int ct = 2 * (wave & 1) + q; f32x4 acc = {0.f, 0.f, 0.f, 0.f};
        acc = mm_tile(Y, rt, X, ct, acc, lane);
        if (MASK) { const int c = 16 * ct + (lane & 15);
#pragma unroll
            for (int g = 0; g < 4; ++g) { const int r = 16 * rt + 4 * (lane >> 4) + g; const bool keep = MASK == 1 ? (c > r) : MASK == 2 ? (r > c) : (c >= r); if (!keep) acc[g] = 0.f; } }
        st_tile(Dst, rt, ct, acc, lane); }
}
__device__ __forceinline__ void rwkv_chunk_prep(Frame& F, int l, int c, int hh, int d) {
    int tid = F.tid; asm volatile("" : "+v"(tid));
    const TileInfo ti = tile_info(c); const bf16* P = (const bf16*)(F.ws + WS_P); const int lane = tid & 63, wave = F.wave;
    LAS bf16* TW = MSLOT(0); LAS bf16* AD = MSLOT(1);
    LAS float* CUM = (LAS float*)(F.lds + 8 * MB); LAS float* AVs = (LAS float*)(F.lds + 8 * MB + 16640);
    LAS float* CWL = (LAS float*)(F.lds + 13 * MB); LAS float* SEGT = (LAS float*)(F.lds + 13 * MB + 256);
    const float* mu0 = gin(F.in[I_MU]) + (size_t)l * 2 * RW_COLS; const float* mu1 = mu0 + RW_COLS;
    const int uidx = (c * NH + hh) * 2 + d;
    const int t = tid >> 3, c8 = (tid & 7) * 8, tt = ti.t0 + t; const size_t grow = (size_t)(ti.seq_base + tt);
    const bool hp = tt > 0, hn = tt + 1 < ti.seq_len;
    float rv[8], kv[8], vv[8], kk[8];
    shifted8(P, grow, hp, hn, mu0, mu1, hh * 64 + c8, rv);
    shifted8(P, grow, hp, hn, mu0, mu1, RWW + hh * 64 + c8, kv);
    shifted8(P, grow, hp, hn, mu0, mu1, 2 * RWW + hh * 64 + c8, vv);
    { float ss = 0.f; const float* kkw = gin(F.in[I_KK]) + (size_t)l * RWW + hh * 64 + c8;
#pragma unroll
      for (int e = 0; e < 8; ++e) { kk[e] = kv[e] * kkw[e]; ss += kk[e] * kk[e]; }
      ss = red8(ss); const float inv = __builtin_amdgcn_rsqf(fmaxf(ss, 1e-24f));
#pragma unroll
      for (int e = 0; e < 8; ++e) kk[e] *= inv; }
    if (d == 0) { v4u o; o.x = pk2(vv[0], vv[1]); o.y = pk2(vv[2], vv[3]); o.z = pk2(vv[4], vv[5]); o.w = pk2(vv[6], vv[7]); *(v4u*)((bf16*)(F.ws + WS_RV) + grow * RWW + hh * 64 + c8) = o; }
    { float x[8]; v4u o;
      shifted8(P, grow, hp, hn, mu0, mu1, 3 * RWW + d * 64 + c8, x);
      o.x = pk2(ftanh(x[0]), ftanh(x[1])); o.y = pk2(ftanh(x[2]), ftanh(x[3])); o.z = pk2(ftanh(x[4]), ftanh(x[5])); o.w = pk2(ftanh(x[6]), ftanh(x[7])); *(LAS v4u*)(TW + t * MLD + c8) = o;
      shifted8(P, grow, hp, hn, mu0, mu1, 3 * RWW + 128 + d * 64 + c8, x);
      o.x = pk2(x[0], x[1]); o.y = pk2(x[2], x[3]); o.z = pk2(x[4], x[5]); o.w = pk2(x[6], x[7]); *(LAS v4u*)(AD + t * MLD + c8) = o; }
    __syncthreads();
    { const int m = wave & 3; const bf16x8 w0f = frag_lds(TW, MLD, 16 * m, 0, lane), w1f = frag_lds(TW, MLD, 16 * m, 32, lane), d0f = frag_lds(AD, MLD, 16 * m, 0, lane), d1f = frag_lds(AD, MLD, 16 * m, 32, lane);
      const bf16* W2 = (const bf16*)(F.ws + WS_W2T) + ((size_t)(l * 2 + d) * 1024 + hh * 64) * 64; const bf16* A2 = (const bf16*)(F.ws + WS_A2T) + ((size_t)(l * 2 + d) * 1024 + hh * 64) * 64;
#pragma unroll
      for (int q = 0; q < 2; ++q) { const int n = (wave >> 2) * 2 + q; f32x4 aw = {0.f, 0.f, 0.f, 0.f}, aa = aw;
          aw = MFMA16(w0f, frag_g(W2, 64, 16 * n, 0, lane), aw); aw = MFMA16(w1f, frag_g(W2, 64, 16 * n, 32, lane), aw);
          aa = MFMA16(d0f, frag_g(A2, 64, 16 * n, 0, lane), aa); aa = MFMA16(d1f, frag_g(A2, 64, 16 * n, 32, lane), aa);
          const int col = 16 * n + (lane & 15), cg = hh * 64 + col; const float w0 = gin(F.in[I_W0])[(size_t)(l * 2 + d) * RWW + cg], a0 = gin(F.in[I_A0])[(size_t)(l * 2 + d) * RWW + cg];
#pragma unroll
          for (int g = 0; g < 4; ++g) { const int row = 16 * m + 4 * (lane >> 4) + g; const float wlog = -fsoftplus(-(w0 + aw[g])) - 0.5f;
              CUM[row * 65 + col] = -fexp(wlog); AVs[row * 65 + col] = fsigmoid(a0 + aa[g]); } } }
    __syncthreads();
    { const int col = tid & 63, seg = tid >> 6; float pre[8]; float run = 0.f;
#pragma unroll
      for (int i = 0; i < 8; ++i) { const int tau = seg * 8 + i, tr = d ? 63 - tau : tau; run += CUM[tr * 65 + col]; pre[i] = run; }
      SEGT[seg * 64 + col] = run;
      __syncthreads();
      float off = 0.f;
#pragma unroll
      for (int s = 0; s < 8; ++s) if (s < seg) off += SEGT[s * 64 + col];
#pragma unroll
      for (int i = 0; i < 8; ++i) { const int tau = seg * 8 + i, tr = d ? 63 - tau : tau; CUM[tr * 65 + col] = off + pre[i]; }
      if (seg == 7) CWL[col] = fexp(off + pre[7]); }
    __syncthreads();
    { const int tau = d ? 63 - t : t, tprev = d ? t + 1 : t - 1;
      const float* kaw = gin(F.in[I_KA]) + (size_t)l * RWW + hh * 64 + c8; const float* rkw = gin(F.in[I_RK]) + (size_t)l * RWW + hh * 64 + c8;
      LAS bf16* At = MSLOT(0); LAS bf16* AtT = MSLOT(1); LAS bf16* Bt = MSLOT(2); LAS bf16* BtT = MSLOT(3); LAS bf16* Kt = MSLOT(4); LAS bf16* KtT = MSLOT(5); LAS bf16* Rt = MSLOT(6); LAS bf16* VT = MSLOT(7);
      float bsum = 0.f; unsigned pa[4], pb[4], pk[4], pr[4];
#pragma unroll
      for (int e2 = 0; e2 < 4; ++e2) { float at2[2], bt2[2], kt2[2], rt2[2];
#pragma unroll
          for (int q = 0; q < 2; ++q) { const int e = 2 * e2 + q; const float cum = CUM[t * 65 + c8 + e], cumx = tau > 0 ? CUM[tprev * 65 + c8 + e] : 0.f, a = AVs[t * 65 + c8 + e];
              const float kd = kv[e] * (1.0f + (a - 1.0f) * kaw[e]), ex = fexp(cum), exm = fexp(-cum);
              at2[q] = -kk[e] * fexp(cumx); bt2[q] = kk[e] * a * exm; kt2[q] = kd * exm; rt2[q] = rv[e] * ex; bsum += rv[e] * kd * rkw[e];
              AtT[(c8 + e) * MLD + tau] = (bf16)f2bf(at2[q]); BtT[(c8 + e) * MLD + tau] = (bf16)f2bf(bt2[q]); KtT[(c8 + e) * MLD + tau] = (bf16)f2bf(kt2[q]); VT[(c8 + e) * MLD + tau] = (bf16)f2bf(vv[e]); }
          pa[e2] = pk2(at2[0], at2[1]); pb[e2] = pk2(bt2[0], bt2[1]); pk[e2] = pk2(kt2[0], kt2[1]); pr[e2] = pk2(rt2[0], rt2[1]); }
      *(LAS v4u*)(At + tau * MLD + c8) = (v4u){pa[0], pa[1], pa[2], pa[3]}; *(LAS v4u*)(Bt + tau * MLD + c8) = (v4u){pb[0], pb[1], pb[2], pb[3]};
      *(LAS v4u*)(Kt + tau * MLD + c8) = (v4u){pk[0], pk[1], pk[2], pk[3]}; *(LAS v4u*)(Rt + tau * MLD + c8) = (v4u){pr[0], pr[1], pr[2], pr[3]};
      bsum = red8(bsum);
      if ((tid & 7) == 0) ((float*)(F.ws + WS_BETA))[((size_t)d * MTOT + grow) * NH + hh] = bsum; }
    __syncthreads();
    LAS bf16* At = MSLOT(0); LAS bf16* AtT = MSLOT(1); LAS bf16* Bt = MSLOT(2); LAS bf16* BtT = MSLOT(3); LAS bf16* Kt = MSLOT(4); LAS bf16* KtT = MSLOT(5); LAS bf16* Rt = MSLOT(6); LAS bf16* VT = MSLOT(7);
    LAS bf16* Pm = MSLOT(8); LAS bf16* AkVT = MSLOT(9); LAS bf16* Gak = MSLOT(10); LAS bf16* Grb = MSLOT(11); LAS bf16* Grk = MSLOT(12);
    LAS bf16* TAT = MSLOT(0); LAS bf16* U0T = MSLOT(2); LAS bf16* TD = MSLOT(4);
    mm64<1>(Pm, At, Bt, wave, lane);
    asm volatile("" ::: "memory");
    mm64<1>(Gak, At, Kt, wave, lane);
    asm volatile("" ::: "memory");
    mm64<3>(Grb, Rt, Bt, wave, lane);
    asm volatile("" ::: "memory");
    mm64<3>(Grk, Rt, Kt, wave, lane);
    __syncthreads();
    if (tid < 64) { const int blk = tid >> 4, cc = tid & 15; float tv[16];
#pragma unroll
        for (int r = 0; r < 16; ++r) { asm volatile("" ::: "memory"); const LAS bf16* ar = Pm + (16 * blk + r) * MLD + 16 * blk; const v4u q0 = *(const LAS v4u*)ar, q1 = *(const LAS v4u*)(ar + 8);
            const float av_[16] = {bf_lo(q0.x), bf_hi(q0.x), bf_lo(q0.y), bf_hi(q0.y), bf_lo(q0.z), bf_hi(q0.z), bf_lo(q0.w), bf_hi(q0.w), bf_lo(q1.x), bf_hi(q1.x), bf_lo(q1.y), bf_hi(q1.y), bf_lo(q1.z), bf_hi(q1.z), bf_lo(q1.w), bf_hi(q1.w)};
            float acc = (r == cc) ? 1.0f : 0.f;
#pragma unroll
            for (int m = 0; m < r; ++m) acc += av_[m] * tv[m];
            tv[r] = acc; }
#pragma unroll
        for (int r = 0; r < 16; ++r) TD[(16 * blk + r) * MLD + cc] = (bf16)f2bf(tv[r]); }
    mm64<0>(AkVT, VT, Gak, wave, lane);
    { const v4u z = {0u, 0u, 0u, 0u}; for (int i = tid; i < 64 * 8; i += NTHR) { const int row = i >> 3, c8_ = (i & 7) * 8; *(LAS v4u*)(TAT + row * MLD + c8_) = z; *(LAS v4u*)(U0T + row * MLD + c8_) = z; } }
    __syncthreads();
#pragma unroll 1
    for (int bi = 0; bi < 4; ++bi) {
        const int g = lane >> 4, il = lane & 15, nt = wave & 3; const LAS bf16* RH = (wave < 4) ? AtT : AkVT; LAS bf16* XT = (wave < 4) ? TAT : U0T;
        const v2u rq = *(const LAS v2u*)(RH + (16 * nt + il) * MLD + 16 * bi + 4 * g);
        f32x4 acc = {bf_lo(rq.x), bf_hi(rq.x), bf_lo(rq.y), bf_hi(rq.y)};
#pragma unroll
        for (int ks = 0; ks < 2; ++ks) if (32 * ks < 16 * bi) {
            bf16x8 af = frag_lds(Pm, MLD, 16 * bi, 32 * ks, lane); if (32 * ks + 8 * g >= 16 * bi) af = (bf16x8){0, 0, 0, 0, 0, 0, 0, 0};
            acc = MFMA16(af, frag_lds(XT, MLD, 16 * nt, 32 * ks, lane), acc); }
        v4u rb; rb.x = pk2(acc[0], acc[1]); rb.y = pk2(acc[2], acc[3]); rb.z = 0u; rb.w = 0u;
        const v2u tq = *(const LAS v2u*)(TD + (16 * bi + il) * MLD + 4 * g); v4u tf; tf.x = tq.x; tf.y = tq.y; tf.z = 0u; tf.w = 0u;
        f32x4 xo = {0.f, 0.f, 0.f, 0.f}; xo = MFMA16(__builtin_bit_cast(bf16x8, tf), __builtin_bit_cast(bf16x8, rb), xo);
        v2u o; o.x = pk2(xo[0], xo[1]); o.y = pk2(xo[2], xo[3]); *(LAS v2u*)(XT + (16 * nt + il) * MLD + 16 * bi + 4 * g) = o;
        __syncthreads();
    }
    {
      bf16* QMg = (bf16*)(F.ws + WS_QM) + (size_t)uidx * 4096; bf16* PHg = (bf16*)(F.ws + WS_PHI) + (size_t)uidx * 4096; const int rt = wave >> 1;
#pragma unroll
      for (int q = 0; q < 2; ++q) { const int ct = 2 * (wave & 1) + q; const int cidx = 16 * ct + (lane & 15), r0 = 16 * rt + 4 * (lane >> 4), qpos = 32 * (rt >> 1) + 8 * (lane >> 4) + 4 * (rt & 1);
          f32x4 acc = ld_tile(Rt, rt, ct, lane); acc = mm_tile(TAT, rt, Grb, ct, acc, lane);
          v2u o; o.x = pk2(acc[0], acc[1]); o.y = pk2(acc[2], acc[3]); *(v2u*)(QMg + cidx * 64 + qpos) = o;
          asm volatile("" ::: "memory");
          f32x4 ph = {0.f, 0.f, 0.f, 0.f}; ph = mm_tile(TAT, rt, BtT, ct, ph, lane); const float cw = CWL[cidx];
#pragma unroll
          for (int g = 0; g < 4; ++g) ph[g] = cw * (ph[g] + ((r0 + g == cidx) ? 1.0f : 0.f));
          o.x = pk2(ph[0], ph[1]); o.y = pk2(ph[2], ph[3]); *(v2u*)(PHg + cidx * 64 + qpos) = o; } }
    __syncthreads();
    {
      bf16* Y0g = (bf16*)(F.ws + WS_Y0F) + (size_t)uidx * 4096; bf16* PSg = (bf16*)(F.ws + WS_PSF) + (size_t)uidx * 4096; const int rt = wave >> 1;
#pragma unroll
      for (int q = 0; q < 2; ++q) { const int ct = 2 * (wave & 1) + q;
          asm volatile("" ::: "memory");
          f32x4 y0 = {0.f, 0.f, 0.f, 0.f}; y0 = mm_tile(Grb, rt, U0T, ct, y0, lane); asm volatile("" ::: "memory"); y0 = mm_tile(Grk, rt, VT, ct, y0, lane);
          { v2u w; w.x = pk2(y0[0], y0[1]); w.y = pk2(y0[2], y0[3]); *(v2u*)(Y0g + ((ct * 4 + rt) * 64 + lane) * 4) = w; }
          asm volatile("" ::: "memory");
          f32x4 ps = {0.f, 0.f, 0.f, 0.f}; ps = mm_tile(BtT, rt, U0T, ct, ps, lane); asm volatile("" ::: "memory"); ps = mm_tile(KtT, rt, VT, ct, ps, lane);
#pragma unroll
          for (int g = 0; g < 4; ++g) ps[g] *= CWL[16 * rt + 4 * (lane >> 4) + g];
          { v2u w; w.x = pk2(ps[0], ps[1]); w.y = pk2(ps[2], ps[3]); *(v2u*)(PSg + ((ct * 4 + rt) * 64 + lane) * 4) = w; } } }
    __syncthreads();
}
#define LDS_BAR() do { asm volatile("s_waitcnt lgkmcnt(0)" ::: "memory"); __builtin_amdgcn_s_barrier(); asm volatile("" ::: "memory"); } while (0)
struct ChunkOps { bf16x8 f[4][2]; v2u c[4]; int tile; };
__device__ __forceinline__ void chunk_load(Frame& F, ChunkOps& o, int step, int b, int hh, int d, int sl, int role, int lane) {
    const int g = lane >> 4, il = lane & 15;
    step = step < 67 ? step : 67;
    const int cc = d ? 3 - step : step, lc = d ? 67 - step : step - 4; const int tile = step < 4 ? 128 + b * 4 + cc : b * 64 + lc;
    o.tile = tile;
    const size_t uidx = (size_t)(tile * NH + hh) * 2 + d;
    const bf16* Mg = (const bf16*)(F.ws + (role ? WS_QM : WS_PHI)) + uidx * 4096 + il * 64 + 8 * g; const bf16* Cg = (const bf16*)(F.ws + (role ? WS_Y0F : WS_PSF)) + uidx * 4096 + (sl * 4 * 64 + lane) * 4;
#pragma unroll
    for (int m = 0; m < 4; ++m) { o.f[m][0] = *(const bf16x8*)(Mg + m * 1024); o.f[m][1] = *(const bf16x8*)(Mg + m * 1024 + 32); o.c[m] = *(const v2u*)(Cg + m * 256); }
}
__device__ __forceinline__ void lru_scan(Frame& F, int idx) {
    const int ch = idx & 1023, b = (idx >> 10) & 1, d = idx >> 11;
    const float* AG = (const float*)(F.ws + WS_LAGG); float* HIN = (float*)(F.ws + WS_LHIN);
    float carry = 0.f;
#pragma unroll 4
    for (int step = 0; step < 68; ++step) { int tile; if (step < 4) tile = 128 + b * 4 + (d ? 3 - step : step); else tile = b * 64 + (d ? 63 - (step - 4) : step - 4);
        const float a = AG[((size_t)(0 * 2 + d) * NTILE + tile) * LRW + ch], hh_ = AG[((size_t)(1 * 2 + d) * NTILE + tile) * LRW + ch];
        HIN[((size_t)d * NTILE + tile) * LRW + ch] = carry; carry = a * carry + hh_; }
}

__device__ __forceinline__ void chunk_apply(Frame& F, const ChunkOps& o, f32x4 (&S)[4], int step, bf16* YR, int hh, int d, int sl, int role, int lane) {
    const int g = lane >> 4, il = lane & 15; LAS v4u* XCH = (LAS v4u*)F.lds;
    bf16x8 bfr[2];
    if (role == 0) {
#pragma unroll
        for (int ks = 0; ks < 2; ++ks) { v4u w; w.x = pk2(S[2 * ks][0], S[2 * ks][1]); w.y = pk2(S[2 * ks][2], S[2 * ks][3]); w.z = pk2(S[2 * ks + 1][0], S[2 * ks + 1][1]); w.w = pk2(S[2 * ks + 1][2], S[2 * ks + 1][3]); bfr[ks] = __builtin_bit_cast(bf16x8, w); }
#pragma unroll
        for (int m = 0; m < 4; ++m) { f32x4 sn = (f32x4){bf_lo(o.c[m].x), bf_hi(o.c[m].x), bf_lo(o.c[m].y), bf_hi(o.c[m].y)}; sn = MFMA16(o.f[m][0], bfr[0], sn); sn = MFMA16(o.f[m][1], bfr[1], sn); S[m] = sn; }
#pragma unroll
        for (int ks = 0; ks < 2; ++ks) { v4u w; w.x = pk2(S[2 * ks][0], S[2 * ks][1]); w.y = pk2(S[2 * ks][2], S[2 * ks][3]); w.z = pk2(S[2 * ks + 1][0], S[2 * ks + 1][1]); w.w = pk2(S[2 * ks + 1][2], S[2 * ks + 1][3]);
            XCH[((((step + 1) & 1) * 4 + sl) * 2 + ks) * 64 + lane] = w; }
    } else {
#pragma unroll
        for (int ks = 0; ks < 2; ++ks) bfr[ks] = __builtin_bit_cast(bf16x8, XCH[(((step & 1) * 4 + sl) * 2 + ks) * 64 + lane]);
#pragma unroll
        for (int m = 0; m < 4; ++m) { f32x4 y = (f32x4){bf_lo(o.c[m].x), bf_hi(o.c[m].x), bf_lo(o.c[m].y), bf_hi(o.c[m].y)}; y = MFMA16(o.f[m][0], bfr[0], y); y = MFMA16(o.f[m][1], bfr[1], y);
#pragma unroll
            for (int r = 0; r < 4; ++r) { const int tau = 16 * m + 4 * g + r, tl = d ? 63 - tau : tau; YR[(size_t)(o.tile * 64 + tl) * RWW + hh * 64 + sl * 16 + il] = (bf16)f2bf(y[r]); } }
    }
}
__device__ __forceinline__ void rwkv_chain_chunks(Frame& F, int item) {
    const int chain = item >> 2, sl = item & 3, d = chain & 1, hh = (chain >> 1) & 15, b = chain >> 5, role = F.wave, lane = F.lane;
    bf16* YR = (bf16*)(F.ws + WS_YR) + (size_t)d * MTOT * RWW;
    { LAS v4u* XCH = (LAS v4u*)F.lds; for (int i = F.tid; i < 4 * 2 * 64; i += NTHR) XCH[i] = (v4u){0u, 0u, 0u, 0u}; }
    __syncthreads();
    if (F.wave >= 2) {
#pragma unroll 1
        for (int step = 0; step < 68; ++step) LDS_BAR();
        return; }
    f32x4 S[4];
#pragma unroll
    for (int m = 0; m < 4; ++m) S[m] = (f32x4){0.f, 0.f, 0.f, 0.f};
    ChunkOps A, B, C, E;
    chunk_load(F, A, 0, b, hh, d, sl, role, lane); chunk_load(F, B, 1, b, hh, d, sl, role, lane); chunk_load(F, C, 2, b, hh, d, sl, role, lane);
#pragma unroll 1
    for (int step = 0; step < 68; step += 4) {
        chunk_load(F, E, step + 3, b, hh, d, sl, role, lane);
        chunk_apply(F, A, S, step, YR, hh, d, sl, role, lane); LDS_BAR();
        chunk_load(F, A, step + 4, b, hh, d, sl, role, lane);
        chunk_apply(F, B, S, step + 1, YR, hh, d, sl, role, lane); LDS_BAR();
        chunk_load(F, B, step + 5, b, hh, d, sl, role, lane);
        chunk_apply(F, C, S, step + 2, YR, hh, d, sl, role, lane); LDS_BAR();
        chunk_load(F, C, step + 6, b, hh, d, sl, role, lane);
        chunk_apply(F, E, S, step + 3, YR, hh, d, sl, role, lane); LDS_BAR();
    }
}
__device__ __forceinline__ void merge_unit(Frame& F, int l, int u) {
    const int c = u >> 1; const TileInfo ti = tile_info(c); const int t0 = ti.t0 + (u & 1) * 32; const bf16* P = (const bf16*)(F.ws + WS_P);
    LAS bf16* SG = (LAS bf16*)F.lds; LAS bf16* GO = (LAS bf16*)(F.lds + 10752); LAS f32x2* ST = (LAS f32x2*)(F.lds + 76800);
    const float* mu0 = gin(F.in[I_MU]) + (size_t)l * 2 * RW_COLS; const float* mu1 = mu0 + RW_COLS;
    for (int idx = F.tid; idx < 32 * 160; idx += NTHR) { const int t = idx / 160, k = idx % 160, tt = t0 + t, rc = 3 * RWW + 256 + k; const bf16* p = P + (size_t)(ti.seq_base + tt) * IN_PAD + 2 * LRW + rc;
        const float x = __builtin_bit_cast(float, (unsigned)p[0] << 16), xm = tt > 0 ? __builtin_bit_cast(float, (unsigned)p[-IN_PAD] << 16) : 0.f, xn = tt + 1 < ti.seq_len ? __builtin_bit_cast(float, (unsigned)p[IN_PAD] << 16) : 0.f;
        SG[t * 168 + k] = (bf16)f2bf(fsigmoid(x + mu0[rc] * (xm - x) + mu1[rc] * (xn - x))); }
    __syncthreads();
    { const int lane = F.lane; const bf16* G2 = (const bf16*)(F.ws + WS_G2T) + (size_t)l * 1024 * 160;
      bf16x8 af[2][5];
#pragma unroll
      for (int m = 0; m < 2; ++m)
#pragma unroll
          for (int k = 0; k < 5; ++k) af[m][k] = frag_lds(SG, 168, 16 * m, 32 * k, lane);
#pragma unroll 2
      for (int n = 0; n < 8; ++n) { const int n0 = F.wave * 128 + n * 16; f32x4 a0 = {0.f, 0.f, 0.f, 0.f}, a1 = a0;
#pragma unroll
          for (int k = 0; k < 5; ++k) { const bf16x8 bf = frag_g(G2, 160, n0, 32 * k, lane); a0 = MFMA16(af[0][k], bf, a0); a1 = MFMA16(af[1][k], bf, a1); }
#pragma unroll
          for (int r = 0; r < 4; ++r) { GO[(4 * (lane >> 4) + r) * 1032 + n0 + (lane & 15)] = (bf16)f2bf(a0[r]); GO[(16 + 4 * (lane >> 4) + r) * 1032 + n0 + (lane & 15)] = (bf16)f2bf(a1[r]); } } }
    __syncthreads();
    { bf16* MRG = (bf16*)(F.ws + WS_H);
      for (int it = F.tid; it < 32 * 256; it += NTHR) { const int t = it >> 8, cgp = it & 255, tt = t0 + t; const size_t grow = (size_t)(ti.seq_base + tt);
          float o[8];
          if (cgp < 128) { const int ch = cgp * 8; float gq8[8]; ld8bf(P + grow * IN_PAD + LRW + ch, gq8); const f32x4 g0 = {gq8[0], gq8[1], gq8[2], gq8[3]}, g1 = {gq8[4], gq8[5], gq8[6], gq8[7]};
              const bf16* hl = (const bf16*)(F.ws + WS_LB) + grow * LRW + ch; const bf16* ac = (const bf16*)(F.ws + WS_LA) + grow * LRW + ch; const float* hi = (const float*)(F.ws + WS_LHIN) + (size_t)c * LRW + ch;
              float h0[8], c0[8], h1[8], c1[8]; ld8bf(hl, h0); ld8bf(ac, c0); ld8bf(hl + (size_t)MTOT * LRW, h1); ld8bf(ac + (size_t)MTOT * LRW, c1);
              const f32x4 i00 = *(const f32x4*)hi, i01 = *(const f32x4*)(hi + 4), i10 = *(const f32x4*)(hi + (size_t)NTILE * LRW), i11 = *(const f32x4*)(hi + (size_t)NTILE * LRW + 4);
              const f32x4 a0 = {h0[0] + c0[0] * i00.x + h1[0] + c1[0] * i10.x, h0[1] + c0[1] * i00.y + h1[1] + c1[1] * i10.y, h0[2] + c0[2] * i00.z + h1[2] + c1[2] * i10.z, h0[3] + c0[3] * i00.w + h1[3] + c1[3] * i10.w};
              const f32x4 a1 = {h0[4] + c0[4] * i01.x + h1[4] + c1[4] * i11.x, h0[5] + c0[5] * i01.y + h1[5] + c1[5] * i11.y, h0[6] + c0[6] * i01.z + h1[6] + c1[6] * i11.z, h0[7] + c0[7] * i01.w + h1[7] + c1[7] * i11.w};
              o[0] = gelu_tanh(g0.x) * a0.x; o[1] = gelu_tanh(g0.y) * a0.y; o[2] = gelu_tanh(g0.z) * a0.z; o[3] = gelu_tanh(g0.w) * a0.w;
              o[4] = gelu_tanh(g1.x) * a1.x; o[5] = gelu_tanh(g1.y) * a1.y; o[6] = gelu_tanh(g1.z) * a1.z; o[7] = gelu_tanh(g1.w) * a1.w; }
          else { const int ch = (cgp - 128) * 8, hh = ch >> 6; const bf16* yr = (const bf16*)(F.ws + WS_YR) + grow * RWW + ch;
              float ya[8], yb[8], va[8]; ld8bf(yr, ya); ld8bf(yr + (size_t)MTOT * RWW, yb); ld8bf((const bf16*)(F.ws + WS_RV) + grow * RWW + ch, va);
              float s1 = 0.f, q1 = 0.f;
#pragma unroll
              for (int e = 0; e < 8; ++e) { ya[e] += yb[e]; s1 += ya[e]; q1 += ya[e] * ya[e]; }
              s1 = red8(s1); q1 = red8(q1);
              const float mean = s1 * (1.0f / 64.0f), var = fmaxf(q1 * (1.0f / 64.0f) - mean * mean, 0.f); const f32x2 st = {mean, __builtin_amdgcn_rsqf(var + GN_EPS)};
              const float beta = ((const float*)(F.ws + WS_BETA))[grow * NH + hh] + ((const float*)(F.ws + WS_BETA))[((size_t)MTOT + grow) * NH + hh];
              const float* gg = gin(F.in[I_GNG]) + (size_t)l * RWW + ch; const float* gb = gin(F.in[I_GNB]) + (size_t)l * RWW + ch;
              const v4u gq = *(const LAS v4u*)(GO + t * 1032 + ch); const float gv[8] = {bf_lo(gq.x), bf_hi(gq.x), bf_lo(gq.y), bf_hi(gq.y), bf_lo(gq.z), bf_hi(gq.z), bf_lo(gq.w), bf_hi(gq.w)};
#pragma unroll
              for (int e = 0; e < 8; ++e) o[e] = ((ya[e] - st.x) * st.y * gg[e] + gb[e] + beta * va[e]) * gv[e]; }
          v4u w; w.x = pk2(o[0], o[1]); w.y = pk2(o[2], o[3]); w.z = pk2(o[4], o[5]); w.w = pk2(o[6], o[7]);
          *(v4u*)(MRG + grow * D + cgp * 8) = w; } }
    __syncthreads();
}

__device__ __forceinline__ void ln_row(float (&z)[32], const float* g, const float* b, int lane) {
    float s = 0.f;
#pragma unroll
    for (int i = 0; i < 32; ++i) s += z[i];
    const float mean = wave_sum(s) * (1.0f / D); float q = 0.f;
#pragma unroll
    for (int i = 0; i < 32; ++i) { z[i] -= mean; q += z[i] * z[i]; }
    const float rstd = __builtin_amdgcn_rsqf(wave_sum(q) * (1.0f / D) + LN_EPS);
#pragma unroll
    for (int j = 0; j < 4; ++j) { const int e = j * 512 + lane * 8; const f32x4 g0 = *(const f32x4*)(g + e), g1 = *(const f32x4*)(g + e + 4), b0 = *(const f32x4*)(b + e), b1 = *(const f32x4*)(b + e + 4);
        const float gs[8] = {g0.x, g0.y, g0.z, g0.w, g1.x, g1.y, g1.z, g1.w}, bs[8] = {b0.x, b0.y, b0.z, b0.w, b1.x, b1.y, b1.z, b1.w};
#pragma unroll
        for (int i = 0; i < 8; ++i) z[j * 8 + i] = z[j * 8 + i] * rstd * gs[i] + bs[i]; }
}
__device__ __forceinline__ void load32(const float* p, int lane, float (&v)[32]) {
#pragma unroll
    for (int j = 0; j < 4; ++j) { const int e = j * 512 + lane * 8; const f32x4 a = *(const f32x4*)(p + e), b = *(const f32x4*)(p + e + 4);
        v[j * 8 + 0] = a.x; v[j * 8 + 1] = a.y; v[j * 8 + 2] = a.z; v[j * 8 + 3] = a.w; v[j * 8 + 4] = b.x; v[j * 8 + 5] = b.y; v[j * 8 + 6] = b.z; v[j * 8 + 7] = b.w; }
}
__device__ __forceinline__ void store32(float* p, int lane, const float (&v)[32]) {
#pragma unroll
    for (int j = 0; j < 4; ++j) { const int e = j * 512 + lane * 8; *(f32x4*)(p + e) = (f32x4){v[j * 8 + 0], v[j * 8 + 1], v[j * 8 + 2], v[j * 8 + 3]}; *(f32x4*)(p + e + 4) = (f32x4){v[j * 8 + 4], v[j * 8 + 5], v[j * 8 + 6], v[j * 8 + 7]}; }
}
__device__ __forceinline__ void store32_mod_bf16(bf16* p, const float* sh, const float* sc, int lane, const float (&v)[32]) {
#pragma unroll
    for (int j = 0; j < 4; ++j) { const int e = j * 512 + lane * 8; const f32x4 s0 = *(const f32x4*)(sh + e), s1 = *(const f32x4*)(sh + e + 4), c0 = *(const f32x4*)(sc + e), c1 = *(const f32x4*)(sc + e + 4);
        v4u o; o.x = pk2(v[j * 8 + 0] * (1.f + c0.x) + s0.x, v[j * 8 + 1] * (1.f + c0.y) + s0.y); o.y = pk2(v[j * 8 + 2] * (1.f + c0.z) + s0.z, v[j * 8 + 3] * (1.f + c0.w) + s0.w);
        o.z = pk2(v[j * 8 + 4] * (1.f + c1.x) + s1.x, v[j * 8 + 5] * (1.f + c1.y) + s1.y); o.w = pk2(v[j * 8 + 6] * (1.f + c1.z) + s1.z, v[j * 8 + 7] * (1.f + c1.w) + s1.w);
        *(v4u*)(p + e) = o; }
}
__device__ __forceinline__ void ln1_rows(Frame& F, int l, int nrows, bool dry = false) {
    const int gw = F.vcu * NWAVES + F.wave, NGW = F.G * NWAVES; float* X = (float*)(F.ws + WS_X); const float* O = (const float*)(F.ws + WS_O); bf16* H = (bf16*)(F.ws + WS_H);
    float* Xo = dry ? (float*)(F.ws + WS_LA) : X; bf16* Ho = dry ? (bf16*)(F.ws + WS_LB) : H;
    for (int row = gw; row < nrows; row += NGW) { const float* md = (const float*)(F.ws + WS_MOD) + ((size_t)l * 3 + mod_row(row)) * (6 * D);
        float z[32], o[32], gt[32]; load32(X + (size_t)row * D, F.lane, z); load32(md + 2 * D, F.lane, gt);
#pragma unroll
        for (int j = 0; j < 4; ++j) { float t8[8]; ld8bf((const bf16*)(F.ws + WS_O) + (size_t)row * D + j * 512 + F.lane * 8, t8);
#pragma unroll
            for (int i = 0; i < 8; ++i) o[j * 8 + i] = t8[i]; }
#pragma unroll
        for (int i = 0; i < 32; ++i) z[i] = ALPHA * z[i] + gt[i] * o[i];
        ln_row(z, gin(F.in[I_LN1G]) + (size_t)l * D, gin(F.in[I_LN1B]) + (size_t)l * D, F.lane);
        store32(Xo + (size_t)row * D, F.lane, z);
        store32_mod_bf16(Ho + (size_t)row * D, md + 3 * D, md + 4 * D, F.lane, z); }
}

__device__ __forceinline__ unsigned ord_key(float s, int k) { unsigned u = __builtin_bit_cast(unsigned, s); u = (u & 0x80000000u) ? ~u : (u | 0x80000000u); return (u & ~127u) | (unsigned)(127 - k); }
__device__ __forceinline__ float key_score(unsigned key) { const unsigned u = key & ~127u; return __builtin_bit_cast(float, (u & 0x80000000u) ? (u ^ 0x80000000u) : ~u); }
__device__ __forceinline__ void bitonic_top16(unsigned (&A)[16], const unsigned (&B)[16]) {
#pragma unroll
    for (int i = 0; i < 16; ++i) A[i] = A[i] > B[15 - i] ? A[i] : B[15 - i];
#pragma unroll
    for (int st = 8; st >= 1; st >>= 1)
#pragma unroll
        for (int i = 0; i < 16; ++i) if (!(i & st)) { const unsigned hi = A[i] > A[i + st] ? A[i] : A[i + st], lo = A[i] > A[i + st] ? A[i + st] : A[i]; A[i] = hi; A[i + st] = lo; }
}
__device__ __forceinline__ void ins16(unsigned (&L)[16], unsigned x) {
#pragma unroll
    for (int i = 0; i < 16; ++i) { const unsigned hi = L[i] > x ? L[i] : x; x = L[i] > x ? x : L[i]; L[i] = hi; }
}
__device__ __forceinline__ unsigned ord_key8(float s, unsigned tag) { unsigned u = __builtin_bit_cast(unsigned, s); u = (u & 0x80000000u) ? ~u : (u | 0x80000000u); return (u & ~255u) | tag; }
__device__ __forceinline__ float key_score8(unsigned key) { const unsigned u = key & ~255u; return __builtin_bit_cast(float, (u & 0x80000000u) ? (u ^ 0x80000000u) : ~u); }
__device__ __forceinline__ void peer_topk_unit(Frame& F, int l, int tile, int h) {
    int tid = F.tid; asm volatile("" : "+v"(tid));
    const int lane = tid & 63, wave = F.wave;
    LAS bf16* AQ = (LAS bf16*)F.lds; LAS float* SC = (LAS float*)(F.lds + 33792);
    LAS unsigned* bufA = (LAS unsigned*)F.lds; LAS unsigned* bufB = (LAS unsigned*)(F.lds + 33792); LAS unsigned* FIN = (LAS unsigned*)(F.lds + 66560); LAS unsigned char* PAIRT = (LAS unsigned char*)(F.lds + 99584);
    if (tid < 50) { int c = tid, i = 0; for (; i < 16; ++i) { const int n = 16 / (i + 1); if (c < n) break; c -= n; } PAIRT[tid] = (unsigned char)(i * 16 + c); }
    for (int idx = tid; idx < 64 * 64; idx += NTHR) { const int t = idx >> 6, c4 = (idx & 63) * 4; *(LAS v2u*)(AQ + t * 264 + c4) = *(const v2u*)((const bf16*)(F.ws + WS_QP) + (size_t)(tile * 64 + t) * D + h * 256 + c4); }
    __syncthreads();
    { const bf16* SK = (const bf16*)(F.ws + WS_SUBK) + (size_t)((l * 8 + h) * 2) * 128 * 128;
#pragma unroll
      for (int p = 0; p < 2; ++p) { bf16x8 bfr[4];
#pragma unroll
          for (int k = 0; k < 4; ++k) bfr[k] = frag_g(SK + (size_t)p * 128 * 128, 128, 16 * wave, 32 * k, lane);
#pragma unroll
          for (int m = 0; m < 4; ++m) { f32x4 acc = {0.f, 0.f, 0.f, 0.f};
#pragma unroll
              for (int k = 0; k < 4; ++k) acc = MFMA16(frag_lds(AQ, 264, 16 * m, p * 128 + 32 * k, lane), bfr[k], acc);
#pragma unroll
              for (int r = 0; r < 4; ++r) SC[(16 * m + 4 * (lane >> 4) + r) * 257 + p * 128 + 16 * wave + (lane & 15)] = acc[r]; } } }
    __syncthreads();
    const int t = lane, r = wave, p = r & 1, qd = r >> 1;
    unsigned L[16], B[16];
#pragma unroll
    for (int i = 0; i < 16; ++i) L[i] = 0u;
    { const LAS float* sp = SC + t * 257 + p * 128 + 32 * qd;
#pragma unroll 4
      for (int k = 0; k < 32; ++k) ins16(L, ord_key(sp[k], 32 * qd + k)); }
#pragma unroll
    for (int i = 0; i < 16; ++i) bufA[(r * 16 + i) * 64 + t] = L[i];
    __syncthreads();
#pragma unroll
    for (int i = 0; i < 16; ++i) B[i] = bufA[((r ^ 2) * 16 + i) * 64 + t];
    bitonic_top16(L, B);
#pragma unroll
    for (int i = 0; i < 16; ++i) bufB[(r * 16 + i) * 64 + t] = L[i];
    __syncthreads();
#pragma unroll
    for (int i = 0; i < 16; ++i) B[i] = bufB[((r ^ 4) * 16 + i) * 64 + t];
    bitonic_top16(L, B);
    if (qd == 0) {
#pragma unroll
        for (int i = 0; i < 16; ++i) FIN[(p * 16 + i) * 64 + t] = L[i]; }
    __syncthreads();
#pragma unroll
    for (int i = 0; i < 16; ++i) L[i] = 0u;
#pragma unroll
    for (int q = 0; q < 7; ++q) { const int c = q * 8 + r; if (c < 50) { const unsigned pr = PAIRT[c]; const unsigned ka = FIN[(0 * 16 + (pr >> 4)) * 64 + t], kb = FIN[(1 * 16 + (pr & 15)) * 64 + t];
            ins16(L, ord_key8(key_score(ka) + key_score(kb), pr)); } }
#pragma unroll
    for (int i = 0; i < 16; ++i) bufB[(r * 16 + i) * 64 + t] = L[i];
    __syncthreads();
#pragma unroll
    for (int i = 0; i < 16; ++i) B[i] = bufB[((r ^ 1) * 16 + i) * 64 + t];
    bitonic_top16(L, B);
#pragma unroll
    for (int i = 0; i < 16; ++i) bufA[(r * 16 + i) * 64 + t] = L[i];
    __syncthreads();
#pragma unroll
    for (int i = 0; i < 16; ++i) B[i] = bufA[((r ^ 2) * 16 + i) * 64 + t];
    bitonic_top16(L, B);
    __syncthreads();
#pragma unroll
    for (int i = 0; i < 16; ++i) bufB[(r * 16 + i) * 64 + t] = L[i];
    __syncthreads();
#pragma unroll
    for (int i = 0; i < 16; ++i) B[i] = bufB[((r ^ 4) * 16 + i) * 64 + t];
    bitonic_top16(L, B);
    { const float mx = key_score8(L[0]); float sum = 0.f, e0 = 0.f, e1 = 0.f; unsigned k0 = 0u, k1 = 0u;
#pragma unroll
      for (int i = 0; i < 16; ++i) { const float e = fexp(key_score8(L[i]) - mx); sum += e; if (i == 2 * r) { e0 = e; k0 = L[i]; } if (i == 2 * r + 1) { e1 = e; k1 = L[i]; } }
      const float inv = __builtin_amdgcn_rcpf(sum);
      const unsigned pa = k0 & 255u, pb = k1 & 255u;
      const int id0 = (127 - (int)(FIN[(0 * 16 + (pa >> 4)) * 64 + t] & 127u)) * 128 + (127 - (int)(FIN[(1 * 16 + (pa & 15)) * 64 + t] & 127u));
      const int id1 = (127 - (int)(FIN[(0 * 16 + (pb >> 4)) * 64 + t] & 127u)) * 128 + (127 - (int)(FIN[(1 * 16 + (pb & 15)) * 64 + t] & 127u));
      int* IDX = (int*)(F.ws + WS_IDX) + (size_t)(tile * 64 + t) * PE_SEL + h * 16 + 2 * r; float* GT = (float*)(F.ws + WS_GATE) + (size_t)(tile * 64 + t) * PE_SEL + h * 16 + 2 * r;
      *(int2*)IDX = make_int2(id0, id1); *(f32x2*)GT = (f32x2){e0 * inv, e1 * inv}; }
    __syncthreads();
}

__device__ __forceinline__ void unpack16(const v4u& w, f32x2 (&o)[8]) {
    o[0] = __builtin_amdgcn_cvt_pk_f32_fp8((int)w.x, false); o[1] = __builtin_amdgcn_cvt_pk_f32_fp8((int)w.x, true); o[2] = __builtin_amdgcn_cvt_pk_f32_fp8((int)w.y, false); o[3] = __builtin_amdgcn_cvt_pk_f32_fp8((int)w.y, true);
    o[4] = __builtin_amdgcn_cvt_pk_f32_fp8((int)w.z, false); o[5] = __builtin_amdgcn_cvt_pk_f32_fp8((int)w.z, true); o[6] = __builtin_amdgcn_cvt_pk_f32_fp8((int)w.w, false); o[7] = __builtin_amdgcn_cvt_pk_f32_fp8((int)w.w, true);
}
__device__ __forceinline__ void peer_rows(Frame& F, int l, int nrows, bool dry = false) {
    const int gw = F.vcu * NWAVES + F.wave, NGW = F.G * NWAVES, lane = F.lane;
    const unsigned char* UB = (const unsigned char*)(F.ws + WS_UB + (size_t)l * PE_NE * D); const unsigned char* VB = (const unsigned char*)(F.ws + WS_VB + (size_t)l * PE_NE * D);
    const float* SU = (const float*)(F.ws + WS_SU) + (size_t)l * PE_NE; const float* SV = (const float*)(F.ws + WS_SV) + (size_t)l * PE_NE;
    float* X = (float*)(F.ws + WS_X); bf16* H = (bf16*)(F.ws + WS_H); float* Xo = dry ? (float*)(F.ws + WS_LA) : X; bf16* Ho = dry ? (bf16*)(F.ws + WS_LB) : H; float* Oo = dry ? (float*)(F.ws + WS_LA) : (float*)F.out;
    constexpr int EB = 8;
    for (int row = gw; row < nrows; row += NGW) {
        const int* IDX = (const int*)(F.ws + WS_IDX) + (size_t)row * PE_SEL; const float* GT = (const float*)(F.ws + WS_GATE) + (size_t)row * PE_SEL;
        const int il = IDX[lane], ih = IDX[64 + lane]; const float gl = GT[lane], gh = GT[64 + lane];
        const float sul = SU[il], suh = SU[ih], svl = SV[il], svh = SV[ih];
        f32x2 hf[2][8];
#pragma unroll
        for (int j = 0; j < 2; ++j) { const v4u a = *(const v4u*)(H + (size_t)row * D + j * 1024 + lane * 16), b = *(const v4u*)(H + (size_t)row * D + j * 1024 + lane * 16 + 8);
            hf[j][0] = (f32x2){bf_lo(a.x), bf_hi(a.x)}; hf[j][1] = (f32x2){bf_lo(a.y), bf_hi(a.y)}; hf[j][2] = (f32x2){bf_lo(a.z), bf_hi(a.z)}; hf[j][3] = (f32x2){bf_lo(a.w), bf_hi(a.w)};
            hf[j][4] = (f32x2){bf_lo(b.x), bf_hi(b.x)}; hf[j][5] = (f32x2){bf_lo(b.y), bf_hi(b.y)}; hf[j][6] = (f32x2){bf_lo(b.z), bf_hi(b.z)}; hf[j][7] = (f32x2){bf_lo(b.w), bf_hi(b.w)}; }
        int dl = 0, dh = 0;
#pragma unroll 1
        for (int k0 = 0; k0 < PE_SEL; k0 += EB) { v4u w[EB][2];
#pragma unroll
            for (int q = 0; q < EB; ++q) { const int k = k0 + q; const int e = __builtin_amdgcn_readlane(k0 < 64 ? il : ih, k & 63); const unsigned char* ur = UB + (size_t)e * D + lane * 16;
                w[q][0] = *(const v4u*)ur; w[q][1] = *(const v4u*)(ur + 1024); }
#pragma unroll
            for (int q = 0; q < EB; ++q) { const int k = k0 + q; f32x2 p2 = {0.f, 0.f};
#pragma unroll
                for (int j = 0; j < 2; ++j) { f32x2 uf[8]; unpack16(w[q][j], uf);
#pragma unroll
                    for (int i = 0; i < 8; ++i) p2 = __builtin_elementwise_fma(uf[i], hf[j][i], p2); }
                const int tb = __builtin_bit_cast(int, wave_total(p2.x + p2.y));
                if (k0 < 64) dl = (lane == (k & 63)) ? tb : dl; else dh = (lane == (k & 63)) ? tb : dh; } }
        const float cl = gl * svl * gelu_erf(__builtin_bit_cast(float, dl) * sul), ch = gh * svh * gelu_erf(__builtin_bit_cast(float, dh) * suh);
        f32x2 acc[2][8];
#pragma unroll
        for (int j = 0; j < 2; ++j)
#pragma unroll
            for (int i = 0; i < 8; ++i) acc[j][i] = (f32x2){0.f, 0.f};
#pragma unroll 1
        for (int k0 = 0; k0 < PE_SEL; k0 += EB) { v4u w[EB][2];
#pragma unroll
            for (int q = 0; q < EB; ++q) { const int k = k0 + q; const int e = __builtin_amdgcn_readlane(k0 < 64 ? il : ih, k & 63); const unsigned char* vr = VB + (size_t)e * D + lane * 16;
                w[q][0] = *(const v4u*)vr; w[q][1] = *(const v4u*)(vr + 1024); }
#pragma unroll
            for (int q = 0; q < EB; ++q) { const int k = k0 + q; const float cf = __builtin_bit_cast(float, __builtin_amdgcn_readlane(__builtin_bit_cast(int, k0 < 64 ? cl : ch), k & 63)); const f32x2 cf2 = {cf, cf};
#pragma unroll
                for (int j = 0; j < 2; ++j) { f32x2 vf[8]; unpack16(w[q][j], vf);
#pragma unroll
                    for (int i = 0; i < 8; ++i) acc[j][i] = __builtin_elementwise_fma(vf[i], cf2, acc[j][i]); } } }
        const float* md = (const float*)(F.ws + WS_MOD) + ((size_t)l * 3 + mod_row(row)) * (6 * D);
        float z[32]; float s = 0.f;
#pragma unroll
        for (int j = 0; j < 2; ++j)
#pragma unroll
            for (int q = 0; q < 4; ++q) { const int e = j * 1024 + lane * 16 + q * 4; const f32x4 xv = *(const f32x4*)(X + (size_t)row * D + e), gv = *(const f32x4*)(md + 5 * D + e);
                z[j * 16 + q * 4 + 0] = ALPHA * xv.x + gv.x * acc[j][2 * q][0]; z[j * 16 + q * 4 + 1] = ALPHA * xv.y + gv.y * acc[j][2 * q][1]; z[j * 16 + q * 4 + 2] = ALPHA * xv.z + gv.z * acc[j][2 * q + 1][0]; z[j * 16 + q * 4 + 3] = ALPHA * xv.w + gv.w * acc[j][2 * q + 1][1]; }
#pragma unroll
        for (int i = 0; i < 32; ++i) s += z[i];
        const float mean = wave_sum(s) * (1.0f / D); float qv = 0.f;
#pragma unroll
        for (int i = 0; i < 32; ++i) { z[i] -= mean; qv += z[i] * z[i]; }
        const float rstd = __builtin_amdgcn_rsqf(wave_sum(qv) * (1.0f / D) + LN_EPS);
        const float* lg = gin(F.in[I_LN2G]) + (size_t)l * D; const float* lb = gin(F.in[I_LN2B]) + (size_t)l * D; const float* mn = (const float*)(F.ws + WS_MOD) + ((size_t)(l + 1 < DEPTH ? l + 1 : l) * 3 + mod_row(row)) * (6 * D);
#pragma unroll
        for (int j = 0; j < 2; ++j) { unsigned hw[8];
#pragma unroll
            for (int q = 0; q < 4; ++q) { const int e = j * 1024 + lane * 16 + q * 4; const f32x4 g4 = *(const f32x4*)(lg + e), b4 = *(const f32x4*)(lb + e);
                f32x4 o; o.x = z[j * 16 + q * 4 + 0] * rstd * g4.x + b4.x; o.y = z[j * 16 + q * 4 + 1] * rstd * g4.y + b4.y; o.z = z[j * 16 + q * 4 + 2] * rstd * g4.z + b4.z; o.w = z[j * 16 + q * 4 + 3] * rstd * g4.w + b4.w;
                if (l + 1 < DEPTH) { *(f32x4*)(Xo + (size_t)row * D + e) = o; const f32x4 s4 = *(const f32x4*)(mn + e), c4 = *(const f32x4*)(mn + D + e);
                    hw[2 * q] = pk2(o.x * (1.f + c4.x) + s4.x, o.y * (1.f + c4.y) + s4.y); hw[2 * q + 1] = pk2(o.z * (1.f + c4.z) + s4.z, o.w * (1.f + c4.w) + s4.w); }
                else *(f32x4*)(Oo + (size_t)row * D + e) = o; }
            if (l + 1 < DEPTH) { *(v4u*)(Ho + (size_t)row * D + j * 1024 + lane * 16) = (v4u){hw[0], hw[1], hw[2], hw[3]}; *(v4u*)(Ho + (size_t)row * D + j * 1024 + lane * 16 + 8) = (v4u){hw[4], hw[5], hw[6], hw[7]}; } }
    }
}
#ifndef MK_PER_PHASE
#define MK_PER_PHASE 0
#endif
constexpr int NPH_PRO = 3, NPH_LAYER = 9, NPHASES = NPH_PRO + DEPTH * NPH_LAYER;
__global__ void __launch_bounds__(NTHR, 2) trunk_fwd(Args args) {
    extern __shared__ __attribute__((aligned(16))) unsigned char lds_raw[];
    Frame F0;
    F0.lds = (LAS unsigned char*)lds_raw;
    F0.tid = threadIdx.x; F0.lane = F0.tid & 63; F0.wave = __builtin_amdgcn_readfirstlane(F0.tid >> 6);
    F0.G = gridDim.x; { const int bx = blockIdx.x; F0.vcu = (F0.G % 8 == 0) ? (bx % 8) * (F0.G / 8) + bx / 8 : bx; }
    F0.in = args.in; F0.out = (GAS float*)args.out; F0.ws = (GAS unsigned char*)args.ws;
    volatile LAS unsigned* MISC = (volatile LAS unsigned*)(F0.lds + MISC_OFF);
    for (int u = F0.tid; u < (LDS_BYTES - LDSCTL_OFF) / 4; u += NTHR) ((LAS unsigned*)(F0.lds + LDSCTL_OFF))[u] = 0u;
    __syncthreads();
    const int lo = args.ph_lo, hi = args.ph_hi;
    XcdBarrier bar; bar.bar = (unsigned*)(F0.ws + WS_CTL) + CW_BAR; bar.x = 0; bar.st = nullptr;
    if (hi - lo > 1) bar = xcd_barrier_post((unsigned*)(F0.ws + WS_CTL) + CW_BAR, MISC + 8);
#ifndef PHMASK
#define PHMASK 0xfff
#endif
#define PHM(b) ((PHMASK >> (b)) & 1)
#ifndef PHREP
#define PHREP 0
#endif
#define NREP(b) (1 + ((PHREP >> (b)) & 1))
#define IN(k) (lo <= (k) && (k) < hi)
#define LAUNDER() Frame F = F0; int bx_ = blockIdx.x; { int ws_ = F0.wave; asm volatile("" : "+s"(ws_)); int ln_; asm volatile("v_mbcnt_lo_u32_b32 %0, -1, 0\n\tv_mbcnt_hi_u32_b32 %0, -1, %0" : "=v"(ln_)); F.wave = ws_; F.lane = ln_; F.tid = ws_ * 64 + ln_; \
    GAS unsigned char* w_ = F0.ws; asm volatile("" : "+s"(w_)); F.ws = w_; int v_ = F0.vcu; asm volatile("" : "+s"(v_)); F.vcu = v_; int g_ = F0.G; asm volatile("" : "+s"(g_)); F.G = g_; \
    GAS float* o_ = F0.out; asm volatile("" : "+s"(o_)); F.out = o_; asm volatile("" : "+s"(bx_)); \
    unsigned l_ = (unsigned)(size_t)F0.lds; asm volatile("" : "+v"(l_)); F.lds = (LAS unsigned char*)(size_t)l_; }
#define SEAM(k) do { if (IN(k) && IN((k) + 1)) xcd_barrier(bar); } while (0)

    if (PHM(0) && IN(0)) for (int rep_ = 0; rep_ < NREP(0); ++rep_) { LAUNDER(); p0_prologue(F); } SEAM(0);
    if (PHM(1) && IN(1)) { LAUNDER(); p0b_mod_reduce(F); } SEAM(1);
    if (PHM(2) && IN(2)) { LAUNDER(); modulate_rows(F, 0, 0, MTOT); } SEAM(2);

#pragma unroll 1
    for (int l = 0; l < DEPTH; ++l) {
        const int pb = NPH_PRO + l * NPH_LAYER;
        const int mrows = (l + 1 < DEPTH) ? MTOT : NLAT;
        if (PHM(3) && IN(pb + 0)) for (int rep_ = 0; rep_ < NREP(3); ++rep_) { LAUNDER(); pg8::Gemm g{(const pg8::bf16_t*)(F.ws + WS_H), (const pg8::bf16_t*)(F.ws + WS_WIN) + (size_t)l * IN_PAD * D, MTOT, IN_PAD, D, D};
            pg8::StaticOrder S; S.init(MTOT, IN_PAD, F.G, bx_); pg8::EpiBf16<0> E{(pg8::bf16_t*)(F.ws + WS_P), IN_PAD, nullptr, 0, 0};
            pg8::gemm_phase<pg8::EpiBf16<0>, pg8::StaticOrder, false>(F.lds, g, S, E, nullptr, F.tid); }
        SEAM(pb + 0);
        if (PHM(4) && IN(pb + 1)) for (int rep_ = 0; rep_ < NREP(4); ++rep_) { LAUNDER(); for (int r2 = 0; r2 < NREP(12); ++r2) for (int u = F.vcu; u < NTILE * NH; u += F.G) lru_prep_unit(F, l, u >> 4, u & 15); asm volatile("" ::: "memory"); for (int r2 = 0; r2 < NREP(13); ++r2) for (int v = F.vcu; v < 2 * NTILE * NH; v += F.G) rwkv_chunk_prep(F, l, v >> 5, (v >> 1) & 15, v & 1); }
        SEAM(pb + 1);
        if (PHM(5) && IN(pb + 2)) for (int rep_ = 0; rep_ < NREP(5); ++rep_) { LAUNDER(); for (int u = F.vcu; u < 256; u += F.G) { if (u < 32 && F.wave >= 2 && F.wave < 4) lru_scan(F, u * 128 + F.tid - 128); rwkv_chain_chunks(F, u); } }
        SEAM(pb + 2);
        if (PHM(6) && IN(pb + 3)) for (int rep_ = 0; rep_ < NREP(6); ++rep_) { LAUNDER(); for (int u = F.vcu; u < 2 * NTILE; u += F.G) merge_unit(F, l, u); }
        SEAM(pb + 3);
        if (PHM(7) && IN(pb + 4)) for (int rep_ = 0; rep_ < NREP(7); ++rep_) { LAUNDER(); pg8::Gemm g{(const pg8::bf16_t*)(F.ws + WS_H), (const pg8::bf16_t*)(F.ws + WS_WOUT) + (size_t)l * D * D, mrows, D, D, D};
            pg8::StaticOrder S; S.init(mrows, D, F.G, bx_); pg8::EpiBf16<0> E{(pg8::bf16_t*)(F.ws + WS_O), D, nullptr, 0, 0};
            pg8::gemm_phase<pg8::EpiBf16<0>, pg8::StaticOrder, false>(F.lds, g, S, E, nullptr, F.tid); }
        SEAM(pb + 4);
        if (PHM(8) && IN(pb + 5)) { LAUNDER(); if (NREP(8) > 1) ln1_rows(F, l, mrows, true); ln1_rows(F, l, mrows); }
        SEAM(pb + 5);
        if (PHM(9) && IN(pb + 6)) for (int rep_ = 0; rep_ < NREP(9); ++rep_) { LAUNDER(); pg8::Gemm g{(const pg8::bf16_t*)(F.ws + WS_H), (const pg8::bf16_t*)(F.ws + WS_WQ) + (size_t)l * D * D, mrows, D, D, D};
            pg8::StaticOrder S; S.init(mrows, D, F.G, bx_); pg8::EpiBf16<0> E{(pg8::bf16_t*)(F.ws + WS_QP), D, nullptr, 0, 0};
            pg8::gemm_phase<pg8::EpiBf16<0>, pg8::StaticOrder, false>(F.lds, g, S, E, nullptr, F.tid); }
        SEAM(pb + 6);
        if (PHM(10) && IN(pb + 7)) for (int rep_ = 0; rep_ < NREP(10); ++rep_) { LAUNDER(); for (int u = F.vcu; u < (mrows / 64) * PE_H; u += F.G) peer_topk_unit(F, l, u >> 3, u & 7); }
        SEAM(pb + 7);
        if (PHM(11) && IN(pb + 8)) { LAUNDER(); if (NREP(11) > 1) peer_rows(F, l, mrows, true); peer_rows(F, l, mrows); }
        if (l + 1 < DEPTH) SEAM(pb + 8);
    }
#undef IN
#undef SEAM
}

extern "C" void kernel_launch(void* const* d_in, const int* in_sizes, int n_in, void* d_out, int out_size, void* d_ws, size_t ws_size, hipStream_t stream) {
    static int grid = 0;
    if (grid == 0) {
        if (n_in != N_IN || out_size != NLAT * D || ws_size < WS_END) { fprintf(stderr, "kernel_launch: unexpected shapes (n_in %d, out %d, ws %zu < %zu)\n", n_in, out_size, ws_size, (size_t)WS_END); grid = -1; return; }
        int dev = 0, cus = 0, per_cu = 0;
        if (hipGetDevice(&dev) != hipSuccess || hipDeviceGetAttribute(&cus, hipDeviceAttributeMultiprocessorCount, dev) != hipSuccess) { grid = -1; return; }
        if (hipFuncSetAttribute((const void*)trunk_fwd, hipFuncAttributeMaxDynamicSharedMemorySize, LDS_BYTES) != hipSuccess) { fprintf(stderr, "kernel_launch: hipFuncSetAttribute failed\n"); grid = -1; return; }
        if (hipOccupancyMaxActiveBlocksPerMultiprocessor(&per_cu, (const void*)trunk_fwd, NTHR, LDS_BYTES) != hipSuccess || per_cu < 1) fprintf(stderr, "kernel_launch: occupancy query reports %d\n", per_cu);
        (void)hipGetLastError();
        grid = cus;
    }
    if (grid < 0) return;
    (void)hipMemsetAsync((char*)d_ws + WS_CTL, 0, CTL_ZERO_BYTES, stream);
    Args a{};
    for (int i = 0; i < N_IN; ++i) a.in[i] = (const float*)d_in[i];
    a.out = (float*)d_out; a.ws = (unsigned char*)d_ws;
#if MK_PER_PHASE
    for (int ph = 0; ph < NPHASES; ++ph) { a.ph_lo = ph; a.ph_hi = ph + 1; hipLaunchKernelGGL(trunk_fwd, dim3(grid), dim3(NTHR), LDS_BYTES, stream, a); }
#else
    a.ph_lo = 0; a.ph_hi = NPHASES;
    hipLaunchKernelGGL(trunk_fwd, dim3(grid), dim3(NTHR), LDS_BYTES, stream, a);
#endif
    const hipError_t le = hipPeekAtLastError();
    if (le != hipSuccess) fprintf(stderr, "kernel_launch: launch failed: %s\n", hipGetErrorName(le));
}
```

```cpp
#include <hip/hip_runtime.h>
#include <cstdio>
#include <cstdint>

constexpr int D = 2048, NB = 2, SEQ = 4096, DEPTH = 4, CTXL = 256;
constexpr int NLAT = NB * SEQ, NCTX = NB * CTXL, MTOT = NLAT + NCTX;
constexpr int LRW = 1024, RWW = 1024, NH = 16, HD = 64;
constexpr int RW_COLS = 3488, IN_COLS = 5536, IN_PAD = 5632;
constexpr int PE_H = 8, PE_K = 128, PE_DQ = 256, PE_TOP = 16, PE_NE = 16384, PE_SEL = PE_H * PE_TOP;
constexpr int NTILE = MTOT / 64;
constexpr float ALPHA = 1.681792830507429f;
constexpr float LN_EPS = 1e-5f, GN_EPS = 64e-5f;
constexpr int KSPLIT = 16;

enum { I_X = 0, I_C, I_CTX, I_CCTX, I_ADAW, I_ADAB, I_WIN, I_CONVW, I_CONVB, I_WA, I_BA, I_WX, I_BX, I_LAM, I_MU, I_W0, I_W2, I_A0, I_A2, I_G2,
       I_KK, I_KA, I_RK, I_GNG, I_GNB, I_WOUT, I_LN1G, I_LN1B, I_WQ, I_SUBK, I_U, I_V, I_LN2G, I_LN2B, N_IN };

constexpr size_t MiB = 1u << 20;
constexpr size_t al(size_t x) { return (x + MiB - 1) / MiB * MiB; }
constexpr size_t WS_CTL = 0, CTL_ZERO_BYTES = 1 * MiB;
constexpr size_t WS_MOD   = WS_CTL + CTL_ZERO_BYTES;
constexpr size_t WS_MODP  = al(WS_MOD + (size_t)DEPTH * 3 * 6 * D * 4);
constexpr size_t WS_WIN   = al(WS_MODP + (size_t)KSPLIT * DEPTH * 3 * 6 * D * 4);
constexpr size_t WS_WOUT  = al(WS_WIN + (size_t)DEPTH * IN_PAD * D * 2);
constexpr size_t WS_WQ    = al(WS_WOUT + (size_t)DEPTH * D * D * 2);
constexpr size_t WS_SUBK  = al(WS_WQ + (size_t)DEPTH * D * D * 2);
constexpr size_t WS_WLRU  = al(WS_SUBK + (size_t)DEPTH * 8 * 2 * 128 * 128 * 2);
constexpr size_t WS_W2T   = al(WS_WLRU + (size_t)DEPTH * 2 * 2 * 16 * 64 * 64 * 2);
constexpr size_t WS_A2T   = al(WS_W2T + (size_t)DEPTH * 2 * 1024 * 64 * 2);
constexpr size_t WS_G2T   = al(WS_A2T + (size_t)DEPTH * 2 * 1024 * 64 * 2);
constexpr size_t WS_UB    = al(WS_G2T + (size_t)DEPTH * 1024 * 160 * 2);
constexpr size_t WS_VB    = al(WS_UB + (size_t)DEPTH * PE_NE * D);
constexpr size_t WS_SU    = al(WS_VB + (size_t)DEPTH * PE_NE * D);
constexpr size_t WS_SV    = al(WS_SU + (size_t)DEPTH * PE_NE * 4);
constexpr size_t WS_X     = al(WS_SV + (size_t)DEPTH * PE_NE * 4);
constexpr size_t WS_H     = al(WS_X + (size_t)MTOT * D * 4);
constexpr size_t WS_P     = al(WS_H + (size_t)MTOT * D * 2);
constexpr size_t WS_LA    = al(WS_P + (size_t)MTOT * IN_PAD * 4);
constexpr size_t WS_LB    = al(WS_LA + (size_t)2 * MTOT * LRW * 4);
constexpr size_t WS_LAGG  = al(WS_LB + (size_t)2 * MTOT * LRW * 4);
constexpr size_t WS_LHIN  = al(WS_LAGG + (size_t)4 * NTILE * LRW * 4);
constexpr int KSL = 8;
constexpr size_t WS_SLAB  = al(WS_LHIN + (size_t)2 * NTILE * LRW * 4);
constexpr size_t WS_YL    = al(WS_SLAB + (size_t)2 * KSL * NCTX * D * 4);
constexpr int NUNIT = NTILE * NH * 2;
constexpr size_t WS_RV    = al(WS_YL + 4096);
constexpr size_t WS_QM    = al(WS_RV + (size_t)MTOT * RWW * 4);
constexpr size_t WS_PHI   = al(WS_QM + (size_t)NUNIT * 4096 * 2);
constexpr size_t WS_Y0F   = al(WS_PHI + (size_t)NUNIT * 4096 * 2);
constexpr size_t WS_PSF   = al(WS_Y0F + (size_t)NUNIT * 4096 * 2);
constexpr size_t WS_YR    = al(WS_PSF + (size_t)NUNIT * 4096 * 2);
constexpr size_t WS_BETA  = al(WS_YR + (size_t)2 * MTOT * RWW * 4);
constexpr size_t WS_IDX   = al(WS_BETA + (size_t)2 * MTOT * NH * 4);
constexpr size_t WS_GATE  = al(WS_IDX + (size_t)MTOT * PE_SEL * 4);
constexpr size_t WS_END   = al(WS_GATE + (size_t)MTOT * PE_SEL * 4);
constexpr size_t WS_O = WS_P;
constexpr size_t WS_QP = WS_P + (size_t)MTOT * D * 4;
static_assert(WS_QP + (size_t)MTOT * D * 4 <= WS_LA, "O/QP overlay inside P");

constexpr int CW_BAR = 4096;

constexpr int RING_BYTES = 131072;
constexpr int LDSCTL_OFF = RING_BYTES, MISC_OFF = LDSCTL_OFF + 320;
constexpr int LDS_BYTES = 147456;
constexpr int NWAVES = 8, NTHR = 512;

#define GAS __attribute__((address_space(1)))
#define LAS __attribute__((address_space(3)))
typedef unsigned short bf16;
typedef unsigned v4u __attribute__((ext_vector_type(4)));
typedef unsigned v2u __attribute__((ext_vector_type(2)));
typedef float f32x4 __attribute__((ext_vector_type(4)));
typedef float f32x2 __attribute__((ext_vector_type(2)));
typedef short bf16x8 __attribute__((ext_vector_type(8)));
#define RLX_AGENT __ATOMIC_RELAXED, __HIP_MEMORY_SCOPE_AGENT
#define LDS_WAIT() asm volatile("s_waitcnt lgkmcnt(0)" ::: "memory")
#define VM_WAIT() asm volatile("s_waitcnt vmcnt(0)" ::: "memory")

__device__ __forceinline__ const float* gin(const float* p) { return (const float*)(const GAS float*)p; }
__device__ __forceinline__ unsigned f2bf(float f) { unsigned u = __builtin_bit_cast(unsigned, f); return (u + 0x7fffu + ((u >> 16) & 1u)) >> 16; }
typedef __bf16 bf16x2t __attribute__((ext_vector_type(2)));
__device__ __forceinline__ unsigned pk2(float lo, float hi) { return __builtin_bit_cast(unsigned, __builtin_convertvector((f32x2){lo, hi}, bf16x2t)); }
__device__ __forceinline__ float bf_lo(unsigned w) { return __builtin_bit_cast(float, w << 16); }
__device__ __forceinline__ float bf_hi(unsigned w) { return __builtin_bit_cast(float, w & 0xffff0000u); }
__device__ __forceinline__ float fexp(float x) { return __builtin_amdgcn_exp2f(x * 1.4426950408889634f); }
__device__ __forceinline__ float fsigmoid(float x) { return __builtin_amdgcn_rcpf(1.0f + fexp(-x)); }
__device__ __forceinline__ float fsoftplus(float x) { return fmaxf(x, 0.f) + 0.6931471805599453f * __builtin_amdgcn_logf(1.0f + fexp(-fabsf(x))); }
__device__ __forceinline__ float ftanh(float x) { const float e = fexp(2.0f * x); return 1.0f - 2.0f * __builtin_amdgcn_rcpf(e + 1.0f); }
__device__ __forceinline__ float gelu_tanh(float x) { return 0.5f * x * (1.0f + ftanh(0.7978845608028654f * (x + 0.044715f * x * x * x))); }
__device__ __forceinline__ float gelu_erf(float v) {
    const float av = fabsf(v), t = __builtin_amdgcn_rcpf(av * 0.2316418882f + 1.0f);
    float q = t * 0.5307027145f + (-0.7265760135f); q = q * t + 0.7107068705f; q = q * t + (-0.142248368f); q = q * t + 0.127414796f; q = q * t;
    const float e = __builtin_amdgcn_exp2f((v * v) * (-0.72134752044f));
    const float m = v * (q * e);
    return v < 0.f ? m : v - m;
}
template <int CTRL> __device__ __forceinline__ float dpp_f(float v) { return __builtin_bit_cast(float, __builtin_amdgcn_update_dpp(0, __builtin_bit_cast(int, v), CTRL, 0xf, 0xf, true)); }
__device__ __forceinline__ float red8(float v) { v += dpp_f<0xB1>(v); v += dpp_f<0x4E>(v); v += dpp_f<0x141>(v); return v; }
__device__ __forceinline__ float red16(float v) { v = red8(v); v += dpp_f<0x140>(v); return v; }
__device__ __forceinline__ float wave_total(float v) {
    v = red16(v);
    v += __builtin_bit_cast(float, __builtin_amdgcn_update_dpp(0, __builtin_bit_cast(int, v), 0x142, 0xa, 0xf, false));
    v += __builtin_bit_cast(float, __builtin_amdgcn_update_dpp(0, __builtin_bit_cast(int, v), 0x143, 0xc, 0xf, false));
    return __builtin_bit_cast(float, __builtin_amdgcn_readlane(__builtin_bit_cast(int, v), 63));
}
__device__ __forceinline__ float wave_sum(float v) { return wave_total(v); }
__device__ __forceinline__ float wave_max(float v) {
    v = fmaxf(v, dpp_f<0xB1>(v)); v = fmaxf(v, dpp_f<0x4E>(v)); v = fmaxf(v, dpp_f<0x141>(v)); v = fmaxf(v, dpp_f<0x140>(v));
    const float a = __builtin_bit_cast(float, __builtin_amdgcn_readlane(__builtin_bit_cast(int, v), 0)), b = __builtin_bit_cast(float, __builtin_amdgcn_readlane(__builtin_bit_cast(int, v), 16));
    const float c = __builtin_bit_cast(float, __builtin_amdgcn_readlane(__builtin_bit_cast(int, v), 32)), d = __builtin_bit_cast(float, __builtin_amdgcn_readlane(__builtin_bit_cast(int, v), 48));
    return fmaxf(fmaxf(a, b), fmaxf(c, d));
}

#define XB_TMO      128
#define XB_XCNT(j)  (256  + 64 * (j))
#define XB_XSUB(j)  (1280 + 64 * (j))
#define XB_XGEN(j)  (2304 + 64 * (j))
#define XB_TOP      3328
#define XB_TOPGEN   3392
#define XCD_BAR_WORDS 3456
#define XB_SPIN_CAP (1u << 18)

__device__ __forceinline__ unsigned xb_ld(unsigned* p)              { return __hip_atomic_load(p, __ATOMIC_RELAXED, __HIP_MEMORY_SCOPE_AGENT); }
__device__ __forceinline__ unsigned xb_add(unsigned* p, unsigned v) { return __hip_atomic_fetch_add(p, v, __ATOMIC_RELAXED, __HIP_MEMORY_SCOPE_AGENT); }
__device__ __forceinline__ unsigned xb_xcc_id() { return (unsigned)__builtin_amdgcn_s_getreg((3 << 11) | 20) & 0xFu; }
#define XB_SPIN(cond, bar) do { unsigned _sp = 0; while (cond) { __builtin_amdgcn_s_sleep(1); \
    if ((++_sp & 255u) == 0u) { if (xb_ld(&(bar)[XB_TMO])) break; if (_sp > XB_SPIN_CAP) { atomicAdd(&(bar)[XB_TMO], 1u); break; } } } } while (0)

struct XcdBarrier {
    unsigned* bar; unsigned x;
    volatile LAS unsigned* st;
};

__device__ __forceinline__ XcdBarrier xcd_barrier_post(unsigned* bar, volatile LAS unsigned* st) {
    XcdBarrier b; b.bar = bar; b.x = xb_xcc_id(); b.st = st;
    if (threadIdx.x == 0) (void)xb_add(&bar[XB_XCNT(b.x)], 1u);
    return b;
}
__device__ __forceinline__ void xcd_barrier_complete(unsigned* bar, unsigned x, unsigned& nloc, unsigned& nx) {
    const unsigned G = gridDim.x * gridDim.y * gridDim.z;
    unsigned sum, cnt, mine, sp = 0u;
    for (;;) {
        sum = 0u; cnt = 0u; mine = 0u;
#pragma unroll
        for (unsigned j = 0; j < 16; ++j) { const unsigned c = xb_ld(&bar[XB_XCNT(j)]); sum += c; cnt += (c > 0u) ? 1u : 0u; }
        if (sum == G) { mine = xb_ld(&bar[XB_XCNT(x)]); break; }
        __builtin_amdgcn_s_sleep(1);
        if ((++sp & 255u) == 0u) { if (xb_ld(&bar[XB_TMO])) break; if (sp > XB_SPIN_CAP) { atomicAdd(&bar[XB_TMO], 1u); break; } }
    }
    nloc = mine > 0u ? mine : 1u; nx = cnt > 0u ? cnt : 1u;
}

__device__ __forceinline__ void xcd_barrier(const XcdBarrier& b) {
    asm volatile("s_waitcnt vmcnt(0)" ::: "memory");
    __syncthreads();
    if (threadIdx.x == 0) {
        unsigned* bar = b.bar;
        __builtin_amdgcn_s_waitcnt(0);
        unsigned nloc = b.st[0], nx = b.st[1];
        if (nloc == 0u) { xcd_barrier_complete(bar, b.x, nloc, nx); b.st[0] = nloc; b.st[1] = nx; }
        const unsigned old = xb_add(&bar[XB_XSUB(b.x)], 1u);
        const unsigned gen = old / nloc;
        if (old + 1u == (gen + 1u) * nloc) {
            __builtin_amdgcn_fence(__ATOMIC_RELEASE, "agent");
            asm volatile("s_waitcnt vmcnt(0)" ::: "memory");
            const unsigned og = xb_add(&bar[XB_TOP], 1u);
            const unsigned tg = og / nx;
            if (og + 1u == (tg + 1u) * nx) xb_add(&bar[XB_TOPGEN], 1u);
            else XB_SPIN(xb_ld(&bar[XB_TOPGEN]) == tg, bar);
            __builtin_amdgcn_fence(__ATOMIC_ACQUIRE, "agent");
            xb_add(&bar[XB_XGEN(b.x)], 1u);
            asm volatile("s_waitcnt vmcnt(0)" ::: "memory");
        } else {
            XB_SPIN(xb_ld(&bar[XB_XGEN(b.x)]) == gen, bar);
            __builtin_amdgcn_fence(__ATOMIC_ACQUIRE, "agent");
            asm volatile("s_waitcnt vmcnt(0)" ::: "memory");
        }
    }
    __syncthreads();
}
namespace pg8 {
#define PG8_LAS __attribute__((address_space(3)))
typedef unsigned short bf16_t;
typedef short bf16x8 __attribute__((ext_vector_type(8)));
typedef float f32x4 __attribute__((ext_vector_type(4)));
typedef unsigned u32x4 __attribute__((ext_vector_type(4)));
constexpr int BM = 256, BK = 64, HALF = 128, HTB = HALF * BK * 2  , STAGE_BYTES = 8 * HTB, NXCD = 8, WGM = 8;

__host__ __device__ __forceinline__ int lds_byte(int r, int c) { const int st = (r >> 4) * 2 + (c >> 5), rr = r & 15, cc = c & 31, ob = rr * 64 + cc * 2; return st * 1024 + (ob ^ (((ob >> 9) & 1) << 5)); }
__host__ __device__ __forceinline__ void stage_rc(int b, int& R, int& C) { const int st = b / 1024, sb = b % 1024, swz = sb ^ (((sb >> 9) & 1) << 5); R = (st >> 1) * 16 + swz / 64; C = (st & 1) * 32 + (swz % 64) / 2; }
__host__ __device__ __forceinline__ int perm32(int rho) { const int n = rho >> 4, i = rho & 15; return 8 * (i >> 2) + 4 * n + (i & 3); }

struct Unit { int pm, pn, kofs = 0, slab = 0; };
struct Gemm { const bf16_t* A; const bf16_t* Bt; int M, N, K, ld; };

struct StaticOrder {
    int nM, nN, nwg, G, c;
    __host__ __device__ void init(int M, int N, int G_, int c_) { nM = M / BM; nN = N / BM; nwg = nM * nN; G = G_; c = c_; }
    __host__ __device__ bool next(int i, Unit& u) const {
        const long L = (long)i * G + c; if (L >= nwg) return false;
        int wgid = (int)L; { const int q = nwg / NXCD, r = nwg % NXCD, xcd = wgid % NXCD, off = wgid / NXCD; wgid = (xcd < r ? xcd * (q + 1) : r * (q + 1) + (xcd - r) * q) + off; }
        const int nig = WGM * nN, gid = wgid / nig, fm = gid * WGM, gsz = (nM - fm) < WGM ? (nM - fm) : WGM;
        u.pm = fm + ((wgid % nig) % gsz); u.pn = (wgid % nig) / gsz; return true;
    }
    __device__ __forceinline__ void a_ready(const Unit&) const {}
    __device__ __forceinline__ void done(const Unit&) const {}
};
struct SplitKOrder {
    int nM, nN, nS, klen, G, c;
    __host__ __device__ void init(int M, int N, int nS_, int klen_, int G_, int c_) { nM = M / BM; nN = N / BM; nS = nS_; klen = klen_; G = G_; c = c_; }
    __host__ __device__ bool next(int i, Unit& u) const { const long L = (long)i * G + c; if (L >= (long)nM * nN * nS) return false; const int l = (int)L; u.pm = l % nM; u.pn = (l / nM) % nN; const int ks = l / (nM * nN); u.kofs = ks * klen; u.slab = ks; return true; }
    __device__ __forceinline__ void a_ready(const Unit&) const {}
    __device__ __forceinline__ void done(const Unit&) const {}
};
struct CountedOrder : StaticOrder {
    const unsigned* ready; unsigned need; unsigned* tmo;
    __device__ __forceinline__ void a_ready(const Unit& u) const {
        if (threadIdx.x < 64) {
            const unsigned long long t0 = __builtin_amdgcn_s_memrealtime(); unsigned polls = 0;
            while ((unsigned)__builtin_amdgcn_readfirstlane(__hip_atomic_load(ready + 64 * u.pm, __ATOMIC_RELAXED, __HIP_MEMORY_SCOPE_AGENT)) < need) {
                if ((++polls & 255u) == 0u && __builtin_amdgcn_readfirstlane(__hip_atomic_load(tmo, __ATOMIC_RELAXED, __HIP_MEMORY_SCOPE_AGENT)) != 0u) break;
                if (__builtin_amdgcn_s_memrealtime() - t0 > 2000000ull) {
                    if (threadIdx.x == 0) { unsigned expect = 0u; __hip_atomic_compare_exchange_strong(tmo + 1, &expect, 0x600u | (unsigned)(u.pm & 0xff), __ATOMIC_RELAXED, __ATOMIC_RELAXED, __HIP_MEMORY_SCOPE_AGENT); __hip_atomic_store(tmo, 1u, __ATOMIC_RELAXED, __HIP_MEMORY_SCOPE_AGENT); }
                    break; }
                __builtin_amdgcn_s_sleep(2); }
            __builtin_amdgcn_fence(__ATOMIC_ACQUIRE, "agent");
            asm volatile("s_waitcnt vmcnt(0)" ::: "memory");
        }
#if !defined(BROKEN_HOOK_NO_BARRIER)
        asm volatile("" ::: "memory"); __builtin_amdgcn_s_barrier(); asm volatile("" ::: "memory");
#endif
    }
};

__device__ __forceinline__ unsigned cvt_pk_bf16(float lo, float hi) { unsigned r; asm volatile("v_cvt_pk_bf16_f32 %0, %1, %2" : "=v"(r) : "v"(lo), "v"(hi)); return r; }
typedef float f32x2 __attribute__((ext_vector_type(2)));
__device__ __forceinline__ f32x2 gelu_pk(f32x2 v) {
    const f32x2 av = __builtin_elementwise_abs(v), d = av * 0.2316418882f + 1.0f;
    f32x2 t; t.x = __builtin_amdgcn_rcpf(d.x); t.y = __builtin_amdgcn_rcpf(d.y);
    f32x2 q = t * 0.5307027145f + (-0.7265760135f); q = q * t + 0.7107068705f; q = q * t + (-0.142248368f); q = q * t + 0.127414796f; q = q * t;
    const f32x2 s = (v * v) * (-0.72134752044f);
    f32x2 e; e.x = __builtin_amdgcn_exp2f(s.x); e.y = __builtin_amdgcn_exp2f(s.y);
    const f32x2 m = v * (q * e), r = v - m;
    f32x2 o; o.x = v.x < 0.f ? m.x : r.x; o.y = v.y < 0.f ? m.y : r.y; return o;
}

struct EpiF32 {
    static constexpr bool PERM = false, AFTER_DRAIN = false;
    float* C; int ldc; const float* bias; size_t slab_stride = 0;
    __device__ __forceinline__ void operator()(const f32x4 (&acc)[2][2][4][2], const Unit& u, int wr, int wc, int fr, int fq) const {
        const int row0 = u.pm * BM + wr * 64 + fr, col0 = u.pn * BM + wc * 32 + 4 * fq; float* const Cb = C + (size_t)u.slab * slab_stride;
        f32x4 bv[2][2];
#pragma unroll
        for (int bj = 0; bj < 2; ++bj)
#pragma unroll
            for (int n = 0; n < 2; ++n) bv[bj][n] = bias ? *(const f32x4*)(bias + col0 + bj * HALF + n * 16) : (f32x4){0.f, 0.f, 0.f, 0.f};
#pragma unroll
        for (int ai = 0; ai < 2; ++ai)
#pragma unroll
            for (int m = 0; m < 4; ++m) { float* rowp = Cb + (size_t)(row0 + ai * HALF + m * 16) * ldc + col0;
#pragma unroll
                for (int bj = 0; bj < 2; ++bj)
#pragma unroll
                    for (int n = 0; n < 2; ++n) *(f32x4*)(rowp + bj * HALF + n * 16) = acc[ai][bj][m][n] + bv[bj][n]; }
    }
};
template <int ACT  > struct EpiBf16 {
    static constexpr bool PERM = true, AFTER_DRAIN = false;
    bf16_t* O; int ldc; const float* bias; int split_cols; size_t split_stride;
    __device__ __forceinline__ void operator()(const f32x4 (&acc)[2][2][4][2], const Unit& u, int wr, int wc, int fr, int fq) const {
        const int row0 = u.pm * BM + wr * 64 + fr; int colt = u.pn * BM; bf16_t* base = O;
        if (split_cols) { const int t = colt / split_cols; base += (size_t)t * split_stride; colt -= t * split_cols; }
        const int col0 = colt + wc * 32 + 8 * fq, bcol0 = u.pn * BM + wc * 32 + 8 * fq;
        f32x4 bv[2][2];
#pragma unroll
        for (int bj = 0; bj < 2; ++bj)
#pragma unroll
            for (int n = 0; n < 2; ++n) bv[bj][n] = bias ? *(const f32x4*)(bias + bcol0 + bj * HALF + 4 * n) : (f32x4){0.f, 0.f, 0.f, 0.f};
#pragma unroll
        for (int ai = 0; ai < 2; ++ai)
#pragma unroll
            for (int m = 0; m < 4; ++m) { bf16_t* rowp = base + (size_t)(row0 + ai * HALF + m * 16) * ldc + col0;
#pragma unroll
                for (int bj = 0; bj < 2; ++bj) { f32x4 v0 = acc[ai][bj][m][0] + bv[bj][0], v1 = acc[ai][bj][m][1] + bv[bj][1];
                    if (ACT == 1) { f32x2 a = gelu_pk((f32x2){v0[0], v0[1]}), b = gelu_pk((f32x2){v0[2], v0[3]}), c = gelu_pk((f32x2){v1[0], v1[1]}), d = gelu_pk((f32x2){v1[2], v1[3]});
                        v0 = (f32x4){a.x, a.y, b.x, b.y}; v1 = (f32x4){c.x, c.y, d.x, d.y}; }
                    if (ACT == 2) {
#pragma unroll
                        for (int j = 0; j < 4; ++j) { v0[j] = 0.5f * v0[j] * (1.0f + erff(v0[j] * 0.70710678f)); v1[j] = 0.5f * v1[j] * (1.0f + erff(v1[j] * 0.70710678f)); } }
                    u32x4 w; w.x = cvt_pk_bf16(v0[0], v0[1]); w.y = cvt_pk_bf16(v0[2], v0[3]); w.z = cvt_pk_bf16(v1[0], v1[1]); w.w = cvt_pk_bf16(v1[2], v1[3]);
                    *(u32x4*)(rowp + bj * HALF) = w; } }
    }
};
template <class Epi, class Sched, bool STAMP = false>
__device__ __forceinline__ void gemm_phase(PG8_LAS unsigned char* lds, const Gemm g, const Sched& S, const Epi& E, unsigned long long* stamps, const int tid) {
    const int  wid = __builtin_amdgcn_readfirstlane(tid >> 6), lane = tid & 63, wr = wid >> 2, wc = wid & 3, fr = lane & 15, fq = lane >> 4;
    const int K = g.ld, nt = g.K / BK;
    int ts_lo = 0, ts_hi = 0, nts = 0; const unsigned long long rt_entry = STAMP ? (unsigned long long)wall_clock64() : 0ull;
#define PG8_STAMP() do { if (STAMP && wid == 0 && nts < 64) { const unsigned long long _c = (unsigned long long)clock64(); \
        ts_lo = (lane == nts) ? (int)(unsigned)_c : ts_lo; ts_hi = (lane == nts) ? (int)(unsigned)(_c >> 32) : ts_hi; ++nts; } } while (0)
    PG8_STAMP();
    unsigned voffA[2], voffB[2];
#pragma unroll
    for (int i = 0; i < 2; ++i) { int R, C; stage_rc(tid * 16 + i * 8192, R, C); const int Rb = Epi::PERM ? ((R & ~31) + perm32(R & 31)) : R;
        voffA[i] = (unsigned)(R * K + C) * 2u; voffB[i] = (unsigned)(Rb * K + C) * 2u; }
    const size_t kstep = (size_t)(BK * 2);
    const size_t hstep = (size_t)HALF * K * 2;
    const size_t tstep = 2 * hstep;
    const unsigned ldsw = (unsigned)wid * 1024u;
    const int aoff = lds_byte(wr * 64 + fr, fq * 8), boff = lds_byte(wc * 32 + fr, fq * 8);
#define PG8_SA(b, h) (((b) * 2 + (h)) * HTB)
#define PG8_SB(b, h) ((4 + (b) * 2 + (h)) * HTB)
#define PG8_STAGE(bufoff, gbase, voff) do { _Pragma("unroll") for (int _i = 0; _i < 2; ++_i) \
        __builtin_amdgcn_global_load_lds((const unsigned*)((const char*)(gbase) + (voff)[_i]), (PG8_LAS unsigned*)(lds + (bufoff) + ldsw + _i * 8192), 16, 0, 0); } while (0)
#define PG8_LDA(dst, b, h) do { _Pragma("unroll") for (int m = 0; m < 4; ++m) _Pragma("unroll") for (int k = 0; k < 2; ++k) dst[m][k] = *(const PG8_LAS bf16x8*)(lds + PG8_SA(b, h) + aoff + m * 2048 + k * 1024); } while (0)
#define PG8_LDB(dst, b, h) do { _Pragma("unroll") for (int n = 0; n < 2; ++n) _Pragma("unroll") for (int k = 0; k < 2; ++k) dst[n][k] = *(const PG8_LAS bf16x8*)(lds + PG8_SB(b, h) + boff + n * 2048 + k * 1024); } while (0)
#define PG8_MMA(ai, bj, At, Bt) do { __builtin_amdgcn_s_setprio(1); _Pragma("unroll") for (int m = 0; m < 4; ++m) _Pragma("unroll") for (int n = 0; n < 2; ++n) _Pragma("unroll") for (int k = 0; k < 2; ++k) \
        acc[ai][bj][m][n] = __builtin_amdgcn_mfma_f32_16x16x32_bf16(Bt[n][k], At[m][k], acc[ai][bj][m][n], 0, 0, 0); __builtin_amdgcn_s_setprio(0); } while (0)
#define PG8_WAIT_V(n) asm volatile("s_waitcnt vmcnt(" #n ")" ::: "memory")
#define PG8_WAIT_L(n) asm volatile("s_waitcnt lgkmcnt(" #n ")" ::: "memory")
#define PG8_BAR __builtin_amdgcn_s_barrier()
#define PG8_SCHED __builtin_amdgcn_sched_barrier(0)
    Unit cur, nxt; int ui = 0;
    if (!S.next(0, cur)) return;
    f32x4 acc[2][2][4][2];
#pragma unroll
    for (int a = 0; a < 2; ++a)
#pragma unroll
        for (int b = 0; b < 2; ++b)
#pragma unroll
            for (int m = 0; m < 4; ++m)
#pragma unroll
                for (int n = 0; n < 2; ++n) acc[a][b][m][n] = (f32x4){0.f, 0.f, 0.f, 0.f};
    bf16x8 At[4][2], B0[2][2], B1[2][2];
    const char* cA = (const char*)g.A + (size_t)cur.pm * tstep + (size_t)cur.kofs * 2; const char* cB = (const char*)g.Bt + (size_t)cur.pn * tstep + (size_t)cur.kofs * 2;
    S.a_ready(cur);
    PG8_STAGE(PG8_SB(0, 0), cB, voffB); PG8_STAGE(PG8_SA(0, 0), cA, voffA); PG8_STAGE(PG8_SB(0, 1), cB + hstep, voffB); PG8_STAGE(PG8_SA(0, 1), cA + hstep, voffA);
    if (wr == 1) PG8_BAR;
    PG8_WAIT_V(4); PG8_BAR;
    PG8_STAGE(PG8_SB(1, 0), cB + kstep, voffB); PG8_STAGE(PG8_SA(1, 0), cA + kstep, voffA); PG8_STAGE(PG8_SB(1, 1), cB + hstep + kstep, voffB);
    PG8_WAIT_V(6); PG8_BAR;
    PG8_STAMP();
    for (;;) {
        const bool has_next = S.next(ui + 1, nxt);
        const char* nA = has_next ? (const char*)g.A + (size_t)nxt.pm * tstep + (size_t)nxt.kofs * 2 : cA; const char* nB = has_next ? (const char*)g.Bt + (size_t)nxt.pn * tstep + (size_t)nxt.kofs * 2 : cB;
        for (int t = 0; t < nt; t += 2) {
            const bool last = (t == nt - 2);
            const char* a1 = cA + (size_t)(t + 1) * kstep;
            const char* a2 = last ? nA : cA + (size_t)(t + 2) * kstep; const char* b2 = last ? nB : cB + (size_t)(t + 2) * kstep;
            const char* a3 = a2 + kstep; const char* b3 = b2 + kstep;
            if (last && has_next) S.a_ready(nxt);
            PG8_LDB(B0, 0, 0); PG8_SCHED; PG8_LDA(At, 0, 0); PG8_STAGE(PG8_SA(1, 1), a1 + hstep, voffA);
            PG8_WAIT_L(8); PG8_BAR; PG8_WAIT_L(0); PG8_MMA(0, 0, At, B0); PG8_BAR; PG8_SCHED;
            PG8_LDB(B1, 0, 1); PG8_STAGE(PG8_SB(0, 0), b2, voffB);
            PG8_BAR; PG8_WAIT_L(0); PG8_MMA(0, 1, At, B1); PG8_BAR;
            PG8_LDA(At, 0, 1); PG8_STAGE(PG8_SA(0, 0), a2, voffA);
            PG8_BAR; PG8_WAIT_L(0); PG8_MMA(1, 0, At, B0); PG8_BAR; PG8_SCHED;
            PG8_STAGE(PG8_SB(0, 1), b2 + hstep, voffB);
            PG8_WAIT_V(6); PG8_BAR; PG8_MMA(1, 1, At, B1); PG8_BAR;
            PG8_LDB(B0, 1, 0); PG8_SCHED; PG8_LDA(At, 1, 0); PG8_STAGE(PG8_SA(0, 1), a2 + hstep, voffA);
            PG8_WAIT_L(8); PG8_BAR; PG8_WAIT_L(0); PG8_MMA(0, 0, At, B0); PG8_BAR; PG8_SCHED;
            PG8_LDB(B1, 1, 1); PG8_STAGE(PG8_SB(1, 0), b3, voffB);
            PG8_BAR; PG8_WAIT_L(0); PG8_MMA(0, 1, At, B1); PG8_BAR;
            PG8_LDA(At, 1, 1); PG8_STAGE(PG8_SA(1, 0), a3, voffA);
            PG8_BAR; PG8_WAIT_L(0); PG8_MMA(1, 0, At, B0); PG8_BAR; PG8_SCHED;
            PG8_STAGE(PG8_SB(1, 1), b3 + hstep, voffB);
            PG8_WAIT_V(6); PG8_BAR; PG8_MMA(1, 1, At, B1); PG8_BAR;
        }
        PG8_STAMP();
        if constexpr (!Epi::AFTER_DRAIN) { E(acc, cur, wr, wc, fr, fq); S.done(cur); }
        PG8_STAMP();
        if (!has_next) break;
#pragma unroll
        for (int a = 0; a < 2; ++a)
#pragma unroll
            for (int b = 0; b < 2; ++b)
#pragma unroll
                for (int m = 0; m < 4; ++m)
#pragma unroll
                    for (int n = 0; n < 2; ++n) acc[a][b][m][n] = (f32x4){0.f, 0.f, 0.f, 0.f};
        cur = nxt; cA = nA; cB = nB; ++ui;
    }
    PG8_WAIT_V(0);
    if (wr == 0) PG8_BAR;
    PG8_BAR;
    if constexpr (Epi::AFTER_DRAIN) { E.fused(acc, cur, wr, wc, fr, fq, lds, wid, lane); S.done(cur); }
    PG8_STAMP();
    if (STAMP && wid == 0) { stamps[lane] = lane < nts ? (((unsigned long long)(unsigned)ts_hi << 32) | (unsigned)ts_lo) : 0ull;
        if (lane == 62) stamps[62] = rt_entry; if (lane == 63) stamps[63] = (unsigned long long)wall_clock64(); }
#undef PG8_STAMP
#undef PG8_SA
#undef PG8_SB
#undef PG8_STAGE
#undef PG8_LDA
#undef PG8_LDB
#undef PG8_MMA
#undef PG8_WAIT_V
#undef PG8_WAIT_L
#undef PG8_BAR
#undef PG8_SCHED
}
}
struct Args { const float* in[N_IN]; float* out; unsigned char* ws; int ph_lo, ph_hi; };
struct Frame {
    LAS unsigned char* lds;
    int tid, lane, wave, vcu, G;
    const float* const* in; GAS float* out; GAS unsigned char* ws;
};
using bf16x2v = __attribute__((ext_vector_type(2))) __bf16;
__device__ __forceinline__ float dot2bf(unsigned a, unsigned b, float acc) { return __builtin_amdgcn_fdot2_f32_bf16(__builtin_bit_cast(bf16x2v, a), __builtin_bit_cast(bf16x2v, b), acc, false); }

__device__ __forceinline__ void ld8bf(const bf16* p, float (&o)[8]) { const v4u w = *(const v4u*)p; o[0] = bf_lo(w.x); o[1] = bf_hi(w.x); o[2] = bf_lo(w.y); o[3] = bf_hi(w.y); o[4] = bf_lo(w.z); o[5] = bf_hi(w.z); o[6] = bf_lo(w.w); o[7] = bf_hi(w.w); }
struct TileInfo { int seq_base, seq_len, t0; };
__device__ __forceinline__ TileInfo tile_info(int c) {
    TileInfo ti;
    if (c < 128) { ti.seq_base = (c >> 6) * SEQ; ti.seq_len = SEQ; ti.t0 = (c & 63) * 64; }
    else { const int cc = c - 128; ti.seq_base = NLAT + (cc >> 2) * CTXL; ti.seq_len = CTXL; ti.t0 = (cc & 3) * 64; }
    return ti;
}
__device__ __forceinline__ int mod_row(int row) { return row < NLAT ? (row >> 12) : 2; }
__device__ __forceinline__ bf16x8 frag_lds(const LAS bf16* base, int ld, int row0, int k0, int lane) { return *(const LAS bf16x8*)(base + (row0 + (lane & 15)) * ld + k0 + 8 * (lane >> 4)); }
__device__ __forceinline__ bf16x8 frag_g(const bf16* base, int ld, int row0, int k0, int lane) { return *(const bf16x8*)(base + (size_t)(row0 + (lane & 15)) * ld + k0 + 8 * (lane >> 4)); }
#define MFMA16(a, b, c) __builtin_amdgcn_mfma_f32_16x16x32_bf16((a), (b), (c), 0, 0, 0)

__device__ __forceinline__ void p0_transpose_item(const float* W, int K, int N, bf16* WT, LAS float* scr, int item, int lane) {
    const int nblk = N / 32, kb = item / nblk, nb = item % nblk, k0 = 64 * kb, n0 = 32 * nb;
#pragma unroll 8
    for (int i = 0; i < 32; ++i) { const int kk = 2 * i + (lane >> 5); scr[kk * 33 + (lane & 31)] = W[(size_t)(k0 + kk) * N + n0 + (lane & 31)]; }
    LDS_WAIT(); asm volatile("" ::: "memory");
    const int c = lane & 7;
#pragma unroll
    for (int j = 0; j < 4; ++j) { const int n = (lane >> 3) + 8 * j; const LAS float* s = scr + (8 * c) * 33 + n;
        v4u o; o.x = pk2(s[0 * 33], s[1 * 33]); o.y = pk2(s[2 * 33], s[3 * 33]); o.z = pk2(s[4 * 33], s[5 * 33]); o.w = pk2(s[6 * 33], s[7 * 33]);
        *(v4u*)(WT + (size_t)(n0 + n) * K + k0 + 8 * c) = o; }
    LDS_WAIT(); asm volatile("" ::: "memory");
}
__device__ __forceinline__ void conv_f32_bf16(const float* src, bf16* dst, size_t n8, size_t i0, size_t stride) {
    for (size_t i = i0; i < n8; i += stride) { const f32x4 a = *(const f32x4*)(src + i * 8), b = *(const f32x4*)(src + i * 8 + 4);
        v4u o; o.x = pk2(a.x, a.y); o.y = pk2(a.z, a.w); o.z = pk2(b.x, b.y); o.w = pk2(b.z, b.w); *(v4u*)(dst + i * 8) = o; }
}
__device__ __forceinline__ void convert_layer(Frame& F, int l, int w, int NW, LAS float* scr) {
    constexpr int IT_IN = (D / 64) * (IN_COLS / 32), IT_SQ = (D / 64) * (D / 32);
    for (int it = w; it < IT_IN + 2 * IT_SQ; it += NW) {
        int r = it;
        if (r < IT_IN) { p0_transpose_item(gin(F.in[I_WIN]) + (size_t)l * D * IN_COLS, D, IN_COLS, (bf16*)(F.ws + WS_WIN) + (size_t)l * IN_PAD * D, scr, r, F.lane); continue; }
        r -= IT_IN;
        if (r < IT_SQ) { p0_transpose_item(gin(F.in[I_WOUT]) + (size_t)l * D * D, D, D, (bf16*)(F.ws + WS_WOUT) + (size_t)l * D * D, scr, r, F.lane); continue; }
        r -= IT_SQ;
        p0_transpose_item(gin(F.in[I_WQ]) + (size_t)l * D * D, D, D, (bf16*)(F.ws + WS_WQ) + (size_t)l * D * D, scr, r, F.lane);
    }
    { constexpr int PADV = (IN_PAD - IN_COLS) * D / 8;
      for (int i = w * 64 + F.lane; i < PADV; i += NW * 64) *(v4u*)((bf16*)(F.ws + WS_WIN) + ((size_t)l * IN_PAD + IN_COLS) * D + (size_t)i * 8) = (v4u){0u, 0u, 0u, 0u}; }
    for (int it = w; it < 2 * PE_NE; it += NW) {
        const int tab = it >= PE_NE, r = l * PE_NE + (tab ? it - PE_NE : it); const float* src = gin(F.in[tab ? I_V : I_U]) + (size_t)r * D + F.lane * 4;
        f32x4 x[8]; float mx = 0.f;
#pragma unroll
        for (int i = 0; i < 8; ++i) { x[i] = *(const f32x4*)(src + i * 256); mx = fmaxf(mx, fmaxf(fmaxf(fabsf(x[i].x), fabsf(x[i].y)), fmaxf(fabsf(x[i].z), fabsf(x[i].w)))); }
        mx = wave_max(mx); const float sc = mx > 0.f ? mx * (1.0f / 448.0f) : 1.0f, inv = 1.0f / sc;
        unsigned* dst = (unsigned*)(F.ws + (tab ? WS_VB : WS_UB) + (size_t)r * D) + F.lane;
#pragma unroll
        for (int i = 0; i < 8; ++i) { int q = __builtin_amdgcn_cvt_pk_fp8_f32(x[i].x * inv, x[i].y * inv, 0, false); q = __builtin_amdgcn_cvt_pk_fp8_f32(x[i].z * inv, x[i].w * inv, q, true); dst[i * 64] = (unsigned)q; }
        if (F.lane == 0) ((float*)(F.ws + (tab ? WS_SV : WS_SU)))[r] = sc;
    }
}
__device__ __forceinline__ void p0_prologue(Frame& F) {
    LAS float* scr = (LAS float*)(F.lds + F.wave * 16384);
    const int gw = F.vcu * NWAVES + F.wave, NGW = F.G * NWAVES;
    const size_t gt = (size_t)F.vcu * NTHR + F.tid, NGT = (size_t)F.G * NTHR;
    for (int l = 0; l < DEPTH; ++l) convert_layer(F, l, gw, NGW, scr);
    { bf16* dst = (bf16*)(F.ws + WS_WLRU);
      for (size_t idx = gt; idx < (size_t)DEPTH * 2 * 2 * 16 * 64 * 64; idx += NGT) { const int i = (int)(idx & 63), j = (int)((idx >> 6) & 63), m = (int)(idx >> 12);
          const int hh = m & 15, d = (m >> 4) & 1, gate = (m >> 5) & 1, l = m >> 6; const float* src = gin(F.in[gate ? I_WX : I_WA]);
          dst[idx] = (bf16)f2bf(src[((size_t)((l * 2 + d) * 16 + hh) * 64 + i) * 64 + j]); } }
    { bf16* d2 = (bf16*)(F.ws + WS_W2T); bf16* da = (bf16*)(F.ws + WS_A2T);
      for (size_t idx = gt; idx < (size_t)DEPTH * 2 * 1024 * 64; idx += NGT) { const int k = (int)(idx & 63), c = (int)((idx >> 6) & 1023), ld = (int)(idx >> 16);
          d2[idx] = (bf16)f2bf(gin(F.in[I_W2])[((size_t)ld * 64 + k) * 1024 + c]); da[idx] = (bf16)f2bf(gin(F.in[I_A2])[((size_t)ld * 64 + k) * 1024 + c]); } }
    { bf16* dg = (bf16*)(F.ws + WS_G2T);
      for (size_t idx = gt; idx < (size_t)DEPTH * 1024 * 160; idx += NGT) { const int k = (int)(idx % 160), c = (int)((idx / 160) % 1024), l = (int)(idx / (160 * 1024));
          dg[idx] = (bf16)f2bf(gin(F.in[I_G2])[((size_t)l * 160 + k) * 1024 + c]); } }
    conv_f32_bf16(gin(F.in[I_SUBK]), (bf16*)(F.ws + WS_SUBK), (size_t)DEPTH * 8 * 2 * 128 * 128 / 8, gt, NGT);
    { float* X = (float*)(F.ws + WS_X);
      for (size_t i0 = gt; i0 < (size_t)MTOT * D / 4; i0 += 4 * NGT) { f32x4 v[4];
#pragma unroll
          for (int u = 0; u < 4; ++u) { const size_t i = i0 + (size_t)u * NGT; const int row = (int)(i / (D / 4)), e0 = (int)(i % (D / 4)) * 4;
              v[u] = i < (size_t)MTOT * D / 4 ? (row < NLAT ? *(const f32x4*)(gin(F.in[I_X]) + (size_t)row * D + e0) : *(const f32x4*)(gin(F.in[I_CTX]) + (size_t)(row - NLAT) * D + e0)) : (f32x4){0.f, 0.f, 0.f, 0.f}; }
#pragma unroll
          for (int u = 0; u < 4; ++u) { const size_t i = i0 + (size_t)u * NGT; if (i >= (size_t)MTOT * D / 4) continue; const int row = (int)(i / (D / 4)), e0 = (int)(i % (D / 4)) * 4;
              if (row < NLAT) { const int t = row & (SEQ - 1); const float pr = (float)(t >> 6), pc = (float)(t & 63); float o[4];
#pragma unroll
                  for (int j = 0; j < 4; ++j) { const int e = e0 + j, q = e >> 9, fi = e & 511; const float freq = __builtin_amdgcn_exp2f(-13.287712379549449f * (float)fi * (1.0f / 512.0f));
                      const float ang = ((q >> 1) ? pc : pr) * freq; float rev = ang * 0.15915494309189535f; rev -= floorf(rev);
                      o[j] = (q & 1) ? __builtin_amdgcn_cosf(rev) : __builtin_amdgcn_sinf(rev); }
                  v[u].x += o[0]; v[u].y += o[1]; v[u].z += o[2]; v[u].w += o[3]; }
              *(f32x4*)(X + (size_t)row * D + e0) = v[u]; } } }
    { float* MODP = (float*)(F.ws + WS_MODP); const float* cin = gin(F.in[I_C]); const float* cctx = gin(F.in[I_CCTX]);
      for (int it = gw; it < DEPTH * KSPLIT * 48; it += NGW) { const int cg = it % 48, kp = (it / 48) % KSPLIT, l = it / (48 * KSPLIT); const int col = cg * 256 + F.lane * 4, k0 = kp * (D / KSPLIT);
          f32x4 a0 = {0.f, 0.f, 0.f, 0.f}, a1 = a0, a2 = a0; const float* wp = gin(F.in[I_ADAW]) + ((size_t)l * D + k0) * (6 * D) + col;
#pragma unroll 8
          for (int k = 0; k < D / KSPLIT; ++k) { const f32x4 w = *(const f32x4*)(wp + (size_t)k * (6 * D)); const float c0 = cin[k0 + k], c1 = cin[D + k0 + k], c2 = cctx[k0 + k];
              const float s0 = c0 * fsigmoid(c0), s1 = c1 * fsigmoid(c1), s2 = c2 * fsigmoid(c2); a0 += w * s0; a1 += w * s1; a2 += w * s2; }
          float* o = MODP + ((size_t)(kp * DEPTH + l) * 3) * (6 * D) + col; *(f32x4*)o = a0; *(f32x4*)(o + 6 * D) = a1; *(f32x4*)(o + 12 * D) = a2; } }
}
__device__ __forceinline__ void p0b_mod_reduce(Frame& F) {
    const size_t gt = (size_t)F.vcu * NTHR + F.tid, NGT = (size_t)F.G * NTHR; const float* MODP = (const float*)(F.ws + WS_MODP); float* MOD = (float*)(F.ws + WS_MOD);
    for (size_t i = gt; i < (size_t)DEPTH * 3 * 6 * D; i += NGT) { const int n = (int)(i % (6 * D)), l = (int)(i / (3 * 6 * D)); float s = gin(F.in[I_ADAB])[(size_t)l * 6 * D + n];
#pragma unroll
        for (int kp = 0; kp < KSPLIT; ++kp) s += MODP[(size_t)kp * DEPTH * 3 * 6 * D + i];
        MOD[i] = s; }
}
__device__ __forceinline__ void modulate_rows(Frame& F, int l, int which, int nrows) {
    const int gw = F.vcu * NWAVES + F.wave, NGW = F.G * NWAVES; const float* X = (const float*)(F.ws + WS_X); bf16* H = (bf16*)(F.ws + WS_H);
    for (int row = gw; row < nrows; row += NGW) { const float* md = (const float*)(F.ws + WS_MOD) + ((size_t)l * 3 + mod_row(row)) * (6 * D) + which * 3 * D;
#pragma unroll
        for (int j = 0; j < 4; ++j) { const int e = j * 512 + F.lane * 8; const f32x4 x0 = *(const f32x4*)(X + (size_t)row * D + e), x1 = *(const f32x4*)(X + (size_t)row * D + e + 4);
            const f32x4 s0 = *(const f32x4*)(md + e), s1 = *(const f32x4*)(md + e + 4), c0 = *(const f32x4*)(md + D + e), c1 = *(const f32x4*)(md + D + e + 4);
            const f32x4 y0 = x0 * (c0 + 1.0f) + s0, y1 = x1 * (c1 + 1.0f) + s1;
            v4u o; o.x = pk2(y0.x, y0.y); o.y = pk2(y0.z, y0.w); o.z = pk2(y1.x, y1.y); o.w = pk2(y1.z, y1.w); *(v4u*)(H + (size_t)row * D + e) = o; } }
}

__device__ __forceinline__ void lru_prep_unit(Frame& F, int l, int c, int hh) {
    int tid = F.tid; asm volatile("" : "+v"(tid));
    const int lane = tid & 63, wave = F.wave;
    const TileInfo ti = tile_info(c); const bf16* P = (const bf16*)(F.ws + WS_P);
    LAS float* Us = (LAS float*)F.lds; LAS float* XC = (LAS float*)(F.lds + 17408); LAS bf16* XCb = (LAS bf16*)(F.lds + 34304);
    LAS float* LAs = (LAS float*)(F.lds + 43520); LAS float* LBs = (LAS float*)(F.lds + 76288); LAS float* SEGA = (LAS float*)(F.lds + 109056); LAS float* SEGH = SEGA + 512;
    for (int idx = tid; idx < 67 * 64; idx += NTHR) { const int r = idx >> 6, ch = idx & 63, t = ti.t0 - 2 + r;
        Us[idx] = (t >= 0 && t < ti.seq_len) ? __builtin_bit_cast(float, (unsigned)P[(size_t)(ti.seq_base + t) * IN_PAD + hh * 64 + ch] << 16) : 0.f; }
    __syncthreads();
    { const float* cw = gin(F.in[I_CONVW]) + (size_t)l * 4 * LRW; const float* cb = gin(F.in[I_CONVB]) + (size_t)l * LRW;
      for (int idx = tid; idx < 64 * 64; idx += NTHR) { const int t = idx >> 6, ch = idx & 63, cg = hh * 64 + ch;
          float v = cb[cg];
#pragma unroll
          for (int tap = 0; tap < 4; ++tap) v += cw[tap * LRW + cg] * Us[(t + tap) * 64 + ch];
          XC[t * 65 + ch] = v; XCb[t * 72 + ch] = (bf16)f2bf(v); } }
    __syncthreads();
    { const int d = wave >> 2, m = wave & 3;
      const bf16x8 a0 = frag_lds(XCb, 72, 16 * m, 0, lane), a1 = frag_lds(XCb, 72, 16 * m, 32, lane);
      const bf16* Wa = (const bf16*)(F.ws + WS_WLRU) + (size_t)(((l * 2 + 0) * 2 + d) * 16 + hh) * 4096;
      const bf16* Wx = (const bf16*)(F.ws + WS_WLRU) + (size_t)(((l * 2 + 1) * 2 + d) * 16 + hh) * 4096;
#pragma unroll
      for (int n = 0; n < 4; ++n) {
          f32x4 ar = {0.f, 0.f, 0.f, 0.f}, ai = ar;
          ar = MFMA16(a0, frag_g(Wa, 64, 16 * n, 0, lane), ar); ar = MFMA16(a1, frag_g(Wa, 64, 16 * n, 32, lane), ar);
          ai = MFMA16(a0, frag_g(Wx, 64, 16 * n, 0, lane), ai); ai = MFMA16(a1, frag_g(Wx, 64, 16 * n, 32, lane), ai);
          const int col = 16 * n + (lane & 15), cg = hh * 64 + col;
          const float ba = gin(F.in[I_BA])[(size_t)(l * 2 + d) * LRW + cg], bx = gin(F.in[I_BX])[(size_t)(l * 2 + d) * LRW + cg];
          const float sp = fsoftplus(-gin(F.in[I_LAM])[(size_t)(l * 2 + d) * LRW + cg]);
#pragma unroll
          for (int r = 0; r < 4; ++r) { const int row = 16 * m + 4 * (lane >> 4) + r;
              const float rr = fsigmoid(ar[r] + ba), ii = fsigmoid(ai[r] + bx), loga = -8.0f * rr * sp, a = fexp(loga);
              const float bb = __builtin_amdgcn_sqrtf(fmaxf(1.0f - a * a, 0.f)) * ii * XC[row * 65 + col];
              LAs[(d * 64 + row) * 64 + col] = a; LBs[(d * 64 + row) * 64 + col] = bb; } } }
    __syncthreads();
    { const int col = tid & 63, seg = (tid >> 6) & 3, d = tid >> 8, cg = hh * 64 + col; float hl[16], al[16]; float h = 0.f, A = 1.f;
#pragma unroll
      for (int i = 0; i < 16; ++i) { const int tau = 16 * seg + i, row = d ? 63 - tau : tau; const float a = LAs[(d * 64 + row) * 64 + col], b = LBs[(d * 64 + row) * 64 + col]; h = a * h + b; A *= a; hl[i] = h; al[i] = A; }
      SEGA[(d * 4 + seg) * 64 + col] = A; SEGH[(d * 4 + seg) * 64 + col] = h;
      __syncthreads();
      float Hin = 0.f, Ain = 1.f;
#pragma unroll
      for (int s2 = 0; s2 < 3; ++s2) if (s2 < seg) { const float sa = SEGA[(d * 4 + s2) * 64 + col]; Hin = sa * Hin + SEGH[(d * 4 + s2) * 64 + col]; Ain *= sa; }
      bf16* HL = (bf16*)(F.ws + WS_LB) + (size_t)d * MTOT * LRW; bf16* AC = (bf16*)(F.ws + WS_LA) + (size_t)d * MTOT * LRW;
#pragma unroll
      for (int i = 0; i < 16; ++i) { const int tau = 16 * seg + i, row = d ? 63 - tau : tau; const size_t o = (size_t)(ti.seq_base + ti.t0 + row) * LRW + cg; HL[o] = (bf16)f2bf(hl[i] + al[i] * Hin); AC[o] = (bf16)f2bf(al[i] * Ain); }
      if (seg == 3) { float* AG = (float*)(F.ws + WS_LAGG); AG[((size_t)(0 * 2 + d) * NTILE + c) * LRW + cg] = al[15] * Ain; AG[((size_t)(1 * 2 + d) * NTILE + c) * LRW + cg] = hl[15] + al[15] * Hin; } }
    __syncthreads();
}
__device__ __forceinline__ void shifted8(const bf16* P, size_t grow, bool hp, bool hn, const float* mu0, const float* mu1, int rc, float (&o)[8]) {
    const bf16* p = P + grow * IN_PAD + 2 * LRW + rc;
    float xs[8], ms[8], ns[8]; ld8bf(p, xs);
#pragma unroll
    for (int e = 0; e < 8; ++e) { ms[e] = 0.f; ns[e] = 0.f; }
    if (hp) ld8bf(p - IN_PAD, ms);
    if (hn) ld8bf(p + IN_PAD, ns);
    const f32x4 a0 = *(const f32x4*)(mu0 + rc), a1 = *(const f32x4*)(mu0 + rc + 4), b0 = *(const f32x4*)(mu1 + rc), b1 = *(const f32x4*)(mu1 + rc + 4);
    const float m0[8] = {a0.x, a0.y, a0.z, a0.w, a1.x, a1.y, a1.z, a1.w}, m1[8] = {b0.x, b0.y, b0.z, b0.w, b1.x, b1.y, b1.z, b1.w};
#pragma unroll
    for (int e = 0; e < 8; ++e) o[e] = xs[e] + m0[e] * (ms[e] - xs[e]) + m1[e] * (ns[e] - xs[e]);
}
constexpr int MB = 9216;
constexpr int MLD = 72;
#define MSLOT(k) ((LAS bf16*)(F.lds + (k) * MB))
__device__ __forceinline__ f32x4 mm_tile(const LAS bf16* Y, int rt, const LAS bf16* X, int ct, f32x4 acc, int lane) {
    acc = MFMA16(frag_lds(Y, MLD, 16 * rt, 0, lane), frag_lds(X, MLD, 16 * ct, 0, lane), acc);
    acc = MFMA16(frag_lds(Y, MLD, 16 * rt, 32, lane), frag_lds(X, MLD, 16 * ct, 32, lane), acc);
    return acc;
}
__device__ __forceinline__ void st_tile(LAS bf16* Dst, int rt, int ct, f32x4 acc, int lane) {
    v2u o; o.x = pk2(acc[0], acc[1]); o.y = pk2(acc[2], acc[3]);
    *(LAS v2u*)(Dst + (16 * ct + (lane & 15)) * MLD + 16 * rt + 4 * (lane >> 4)) = o;
}
__device__ __forceinline__ f32x4 ld_tile(const LAS bf16* Src, int rt, int ct, int lane) {
    const v2u o = *(const LAS v2u*)(Src + (16 * ct + (lane & 15)) * MLD + 16 * rt + 4 * (lane >> 4));
    return (f32x4){bf_lo(o.x), bf_hi(o.x), bf_lo(o.y), bf_hi(o.y)};
}
template <int MASK> __device__ __forceinline__ void mm64(LAS bf16* Dst, const LAS bf16* X, const LAS bf16* Y, int wave, int lane) {
    const int rt = wave >> 1;
#pragma unroll
    for (int q = 0; q < 2; ++q) { const int ct = 2 * (wave & 1) + q; f32x4 acc = {0.f, 0.f, 0.f, 0.f};
        acc = mm_tile(Y, rt, X, ct, acc, lane);
        if (MASK) { const int c = 16 * ct + (lane & 15);
#pragma unroll
            for (int g = 0; g < 4; ++g) { const int r = 16 * rt + 4 * (lane >> 4) + g; const bool keep = MASK == 1 ? (c > r) : MASK == 2 ? (r > c) : (c >= r); if (!keep) acc[g] = 0.f; } }
        st_tile(Dst, rt, ct, acc, lane); }
}
__device__ __forceinline__ void rwkv_chunk_prep(Frame& F, int l, int c, int hh, int d) {
    int tid = F.tid; asm volatile("" : "+v"(tid));
    const TileInfo ti = tile_info(c); const bf16* P = (const bf16*)(F.ws + WS_P); const int lane = tid & 63, wave = F.wave;
    LAS bf16* TW = MSLOT(0); LAS bf16* AD = MSLOT(1);
    LAS float* CUM = (LAS float*)(F.lds + 8 * MB); LAS float* AVs = (LAS float*)(F.lds + 8 * MB + 16640);
    LAS float* CWL = (LAS float*)(F.lds + 13 * MB); LAS float* SEGT = (LAS float*)(F.lds + 13 * MB + 256);
    const float* mu0 = gin(F.in[I_MU]) + (size_t)l * 2 * RW_COLS; const float* mu1 = mu0 + RW_COLS;
    const int uidx = (c * NH + hh) * 2 + d;
    const int t = tid >> 3, c8 = (tid & 7) * 8, tt = ti.t0 + t; const size_t grow = (size_t)(ti.seq_base + tt);
    const bool hp = tt > 0, hn = tt + 1 < ti.seq_len;
    float rv[8], kv[8], vv[8], kk[8];
    shifted8(P, grow, hp, hn, mu0, mu1, hh * 64 + c8, rv);
    shifted8(P, grow, hp, hn, mu0, mu1, RWW + hh * 64 + c8, kv);
    shifted8(P, grow, hp, hn, mu0, mu1, 2 * RWW + hh * 64 + c8, vv);
    { float ss = 0.f; const float* kkw = gin(F.in[I_KK]) + (size_t)l * RWW + hh * 64 + c8;
#pragma unroll
      for (int e = 0; e < 8; ++e) { kk[e] = kv[e] * kkw[e]; ss += kk[e] * kk[e]; }
      ss = red8(ss); const float inv = __builtin_amdgcn_rsqf(fmaxf(ss, 1e-24f));
#pragma unroll
      for (int e = 0; e < 8; ++e) kk[e] *= inv; }
    if (d == 0) { v4u o; o.x = pk2(vv[0], vv[1]); o.y = pk2(vv[2], vv[3]); o.z = pk2(vv[4], vv[5]); o.w = pk2(vv[6], vv[7]); *(v4u*)((bf16*)(F.ws + WS_RV) + grow * RWW + hh * 64 + c8) = o; }
    { float x[8]; v4u o;
      shifted8(P, grow, hp, hn, mu0, mu1, 3 * RWW + d * 64 + c8, x);
      o.x = pk2(ftanh(x[0]), ftanh(x[1])); o.y = pk2(ftanh(x[2]), ftanh(x[3])); o.z = pk2(ftanh(x[4]), ftanh(x[5])); o.w = pk2(ftanh(x[6]), ftanh(x[7])); *(LAS v4u*)(TW + t * MLD + c8) = o;
      shifted8(P, grow, hp, hn, mu0, mu1, 3 * RWW + 128 + d * 64 + c8, x);
      o.x = pk2(x[0], x[1]); o.y = pk2(x[2], x[3]); o.z = pk2(x[4], x[5]); o.w = pk2(x[6], x[7]); *(LAS v4u*)(AD + t * MLD + c8) = o; }
    __syncthreads();
    { const int m = wave & 3; const bf16x8 w0f = frag_lds(TW, MLD, 16 * m, 0, lane), w1f = frag_lds(TW, MLD, 16 * m, 32, lane), d0f = frag_lds(AD, MLD, 16 * m, 0, lane), d1f = frag_lds(AD, MLD, 16 * m, 32, lane);
      const bf16* W2 = (const bf16*)(F.ws + WS_W2T) + ((size_t)(l * 2 + d) * 1024 + hh * 64) * 64; const bf16* A2 = (const bf16*)(F.ws + WS_A2T) + ((size_t)(l * 2 + d) * 1024 + hh * 64) * 64;
#pragma unroll
      for (int q = 0; q < 2; ++q) { const int n = (wave >> 2) * 2 + q; f32x4 aw = {0.f, 0.f, 0.f, 0.f}, aa = aw;
          aw = MFMA16(w0f, frag_g(W2, 64, 16 * n, 0, lane), aw); aw = MFMA16(w1f, frag_g(W2, 64, 16 * n, 32, lane), aw);
          aa = MFMA16(d0f, frag_g(A2, 64, 16 * n, 0, lane), aa); aa = MFMA16(d1f, frag_g(A2, 64, 16 * n, 32, lane), aa);
          const int col = 16 * n + (lane & 15), cg = hh * 64 + col; const float w0 = gin(F.in[I_W0])[(size_t)(l * 2 + d) * RWW + cg], a0 = gin(F.in[I_A0])[(size_t)(l * 2 + d) * RWW + cg];
#pragma unroll
          for (int g = 0; g < 4; ++g) { const int row = 16 * m + 4 * (lane >> 4) + g; const float wlog = -fsoftplus(-(w0 + aw[g])) - 0.5f;
              CUM[row * 65 + col] = -fexp(wlog); AVs[row * 65 + col] = fsigmoid(a0 + aa[g]); } } }
    __syncthreads();
    { const int col = tid & 63, seg = tid >> 6; float pre[8]; float run = 0.f;
#pragma unroll
      for (int i = 0; i < 8; ++i) { const int tau = seg * 8 + i, tr = d ? 63 - tau : tau; run += CUM[tr * 65 + col]; pre[i] = run; }
      SEGT[seg * 64 + col] = run;
      __syncthreads();
      float off = 0.f;
#pragma unroll
      for (int s = 0; s < 8; ++s) if (s < seg) off += SEGT[s * 64 + col];
#pragma unroll
      for (int i = 0; i < 8; ++i) { const int tau = seg * 8 + i, tr = d ? 63 - tau : tau; CUM[tr * 65 + col] = off + pre[i]; }
      if (seg == 7) CWL[col] = fexp(off + pre[7]); }
    __syncthreads();
    { const int tau = d ? 63 - t : t, tprev = d ? t + 1 : t - 1;
      const float* kaw = gin(F.in[I_KA]) + (size_t)l * RWW + hh * 64 + c8; const float* rkw = gin(F.in[I_RK]) + (size_t)l * RWW + hh * 64 + c8;
      LAS bf16* At = MSLOT(0); LAS bf16* AtT = MSLOT(1); LAS bf16* Bt = MSLOT(2); LAS bf16* BtT = MSLOT(3); LAS bf16* Kt = MSLOT(4); LAS bf16* KtT = MSLOT(5); LAS bf16* Rt = MSLOT(6); LAS bf16* VT = MSLOT(7);
      float bsum = 0.f; unsigned pa[4], pb[4], pk[4], pr[4];
#pragma unroll
      for (int e2 = 0; e2 < 4; ++e2) { float at2[2], bt2[2], kt2[2], rt2[2];
#pragma unroll
          for (int q = 0; q < 2; ++q) { const int e = 2 * e2 + q; const float cum = CUM[t * 65 + c8 + e], cumx = tau > 0 ? CUM[tprev * 65 + c8 + e] : 0.f, a = AVs[t * 65 + c8 + e];
              const float kd = kv[e] * (1.0f + (a - 1.0f) * kaw[e]), ex = fexp(cum), exm = fexp(-cum);
              at2[q] = -kk[e] * fexp(cumx); bt2[q] = kk[e] * a * exm; kt2[q] = kd * exm; rt2[q] = rv[e] * ex; bsum += rv[e] * kd * rkw[e];
              AtT[(c8 + e) * MLD + tau] = (bf16)f2bf(at2[q]); BtT[(c8 + e) * MLD + tau] = (bf16)f2bf(bt2[q]); KtT[(c8 + e) * MLD + tau] = (bf16)f2bf(kt2[q]); VT[(c8 + e) * MLD + tau] = (bf16)f2bf(vv[e]); }
          pa[e2] = pk2(at2[0], at2[1]); pb[e2] = pk2(bt2[0], bt2[1]); pk[e2] = pk2(kt2[0], kt2[1]); pr[e2] = pk2(rt2[0], rt2[1]); }
      *(LAS v4u*)(At + tau * MLD + c8) = (v4u){pa[0], pa[1], pa[2], pa[3]}; *(LAS v4u*)(Bt + tau * MLD + c8) = (v4u){pb[0], pb[1], pb[2], pb[3]};
      *(LAS v4u*)(Kt + tau * MLD + c8) = (v4u){pk[0], pk[1], pk[2], pk[3]}; *(LAS v4u*)(Rt + tau * MLD + c8) = (v4u){pr[0], pr[1], pr[2], pr[3]};
      bsum = red8(bsum);
      if ((tid & 7) == 0) ((float*)(F.ws + WS_BETA))[((size_t)d * MTOT + grow) * NH + hh] = bsum; }
    __syncthreads();
    LAS bf16* At = MSLOT(0); LAS bf16* AtT = MSLOT(1); LAS bf16* Bt = MSLOT(2); LAS bf16* BtT = MSLOT(3); LAS bf16* Kt = MSLOT(4); LAS bf16* KtT = MSLOT(5); LAS bf16* Rt = MSLOT(6); LAS bf16* VT = MSLOT(7);
    LAS bf16* Pm = MSLOT(8); LAS bf16* AkVT = MSLOT(9); LAS bf16* Gak = MSLOT(10); LAS bf16* Grb = MSLOT(11); LAS bf16* Grk = MSLOT(12);
    LAS bf16* TAT = MSLOT(0); LAS bf16* U0T = MSLOT(2); LAS bf16* TD = MSLOT(4);
    mm64<1>(Pm, At, Bt, wave, lane);
    asm volatile("" ::: "memory");
    mm64<1>(Gak, At, Kt, wave, lane);
    asm volatile("" ::: "memory");
    mm64<3>(Grb, Rt, Bt, wave, lane);
    asm volatile("" ::: "memory");
    mm64<3>(Grk, Rt, Kt, wave, lane);
    __syncthreads();
    if (tid < 64) { const int blk = tid >> 4, cc = tid & 15; float tv[16];
#pragma unroll
        for (int r = 0; r < 16; ++r) { asm volatile("" ::: "memory"); const LAS bf16* ar = Pm + (16 * blk + r) * MLD + 16 * blk; const v4u q0 = *(const LAS v4u*)ar, q1 = *(const LAS v4u*)(ar + 8);
            const float av_[16] = {bf_lo(q0.x), bf_hi(q0.x), bf_lo(q0.y), bf_hi(q0.y), bf_lo(q0.z), bf_hi(q0.z), bf_lo(q0.w), bf_hi(q0.w), bf_lo(q1.x), bf_hi(q1.x), bf_lo(q1.y), bf_hi(q1.y), bf_lo(q1.z), bf_hi(q1.z), bf_lo(q1.w), bf_hi(q1.w)};
            float acc = (r == cc) ? 1.0f : 0.f;
#pragma unroll
            for (int m = 0; m < r; ++m) acc += av_[m] * tv[m];
            tv[r] = acc; }
#pragma unroll
        for (int r = 0; r < 16; ++r) TD[(16 * blk + r) * MLD + cc] = (bf16)f2bf(tv[r]); }
    mm64<0>(AkVT, VT, Gak, wave, lane);
    { const v4u z = {0u, 0u, 0u, 0u}; for (int i = tid; i < 64 * 8; i += NTHR) { const int row = i >> 3, c8_ = (i & 7) * 8; *(LAS v4u*)(TAT + row * MLD + c8_) = z; *(LAS v4u*)(U0T + row * MLD + c8_) = z; } }
    __syncthreads();
#pragma unroll 1
    for (int bi = 0; bi < 4; ++bi) {
        const int g = lane >> 4, il = lane & 15, nt = wave & 3; const LAS bf16* RH = (wave < 4) ? AtT : AkVT; LAS bf16* XT = (wave < 4) ? TAT : U0T;
        const v2u rq = *(const LAS v2u*)(RH + (16 * nt + il) * MLD + 16 * bi + 4 * g);
        f32x4 acc = {bf_lo(rq.x), bf_hi(rq.x), bf_lo(rq.y), bf_hi(rq.y)};
#pragma unroll
        for (int ks = 0; ks < 2; ++ks) if (32 * ks < 16 * bi) {
            bf16x8 af = frag_lds(Pm, MLD, 16 * bi, 32 * ks, lane); if (32 * ks + 8 * g >= 16 * bi) af = (bf16x8){0, 0, 0, 0, 0, 0, 0, 0};
            acc = MFMA16(af, frag_lds(XT, MLD, 16 * nt, 32 * ks, lane), acc); }
        v4u rb; rb.x = pk2(acc[0], acc[1]); rb.y = pk2(acc[2], acc[3]); rb.z = 0u; rb.w = 0u;
        const v2u tq = *(const LAS v2u*)(TD + (16 * bi + il) * MLD + 4 * g); v4u tf; tf.x = tq.x; tf.y = tq.y; tf.z = 0u; tf.w = 0u;
        f32x4 xo = {0.f, 0.f, 0.f, 0.f}; xo = MFMA16(__builtin_bit_cast(bf16x8, tf), __builtin_bit_cast(bf16x8, rb), xo);
        v2u o; o.x = pk2(xo[0], xo[1]); o.y = pk2(xo[2], xo[3]); *(LAS v2u*)(XT + (16 * nt + il) * MLD + 16 * bi + 4 * g) = o;
        __syncthreads();
    }
    {
      bf16* QMg = (bf16*)(F.ws + WS_QM) + (size_t)uidx * 4096; bf16* PHg = (bf16*)(F.ws + WS_PHI) + (size_t)uidx * 4096; const int rt = wave >> 1;
#pragma unroll
      for (int q = 0; q < 2; ++q) { const int ct = 2 * (wave & 1) + q; const int cidx = 16 * ct + (lane & 15), r0 = 16 * rt + 4 * (lane >> 4), qpos = 32 * (rt >> 1) + 8 * (lane >> 4) + 4 * (rt & 1);
          f32x4 acc = ld_tile(Rt, rt, ct, lane); acc = mm_tile(TAT, rt, Grb, ct, acc, lane);
          v2u o; o.x = pk2(acc[0], acc[1]); o.y = pk2(acc[2], acc[3]); *(v2u*)(QMg + cidx * 64 + qpos) = o;
          asm volatile("" ::: "memory");
          f32x4 ph = {0.f, 0.f, 0.f, 0.f}; ph = mm_tile(TAT, rt, BtT, ct, ph, lane); const float cw = CWL[cidx];
#pragma unroll
          for (int g = 0; g < 4; ++g) ph[g] = cw * (ph[g] + ((r0 + g == cidx) ? 1.0f : 0.f));
          o.x = pk2(ph[0], ph[1]); o.y = pk2(ph[2], ph[3]); *(v2u*)(PHg + cidx * 64 + qpos) = o; } }
    __syncthreads();
    {
      bf16* Y0g = (bf16*)(F.ws + WS_Y0F) + (size_t)uidx * 4096; bf16* PSg = (bf16*)(F.ws + WS_PSF) + (size_t)uidx * 4096; const int rt = wave >> 1;
#pragma unroll
      for (int q = 0; q < 2; ++q) { const int ct = 2 * (wave & 1) + q;
          asm volatile("" ::: "memory");
          f32x4 y0 = {0.f, 0.f, 0.f, 0.f}; y0 = mm_tile(Grb, rt, U0T, ct, y0, lane); asm volatile("" ::: "memory"); y0 = mm_tile(Grk, rt, VT, ct, y0, lane);
          { v2u w; w.x = pk2(y0[0], y0[1]); w.y = pk2(y0[2], y0[3]); *(v2u*)(Y0g + ((ct * 4 + rt) * 64 + lane) * 4) = w; }
          asm volatile("" ::: "memory");
          f32x4 ps = {0.f, 0.f, 0.f, 0.f}; ps = mm_tile(BtT, rt, U0T, ct, ps, lane); asm volatile("" ::: "memory"); ps = mm_tile(KtT, rt, VT, ct, ps, lane);
#pragma unroll
          for (int g = 0; g < 4; ++g) ps[g] *= CWL[16 * rt + 4 * (lane >> 4) + g];
          { v2u w; w.x = pk2(ps[0], ps[1]); w.y = pk2(ps[2], ps[3]); *(v2u*)(PSg + ((ct * 4 + rt) * 64 + lane) * 4) = w; } } }
    __syncthreads();
}
#define LDS_BAR() do { asm volatile("s_waitcnt lgkmcnt(0)" ::: "memory"); __builtin_amdgcn_s_barrier(); asm volatile("" ::: "memory"); } while (0)
struct ChunkOps { bf16x8 f[4][2]; v2u c[4]; int tile; };
__device__ __forceinline__ void chunk_load(Frame& F, ChunkOps& o, int step, int b, int hh, int d, int sl, int role, int lane) {
    const int g = lane >> 4, il = lane & 15;
    step = step < 67 ? step : 67;
    const int cc = d ? 3 - step : step, lc = d ? 67 - step : step - 4; const int tile = step < 4 ? 128 + b * 4 + cc : b * 64 + lc;
    o.tile = tile;
    const size_t uidx = (size_t)(tile * NH + hh) * 2 + d;
    const bf16* Mg = (const bf16*)(F.ws + (role ? WS_QM : WS_PHI)) + uidx * 4096 + il * 64 + 8 * g; const bf16* Cg = (const bf16*)(F.ws + (role ? WS_Y0F : WS_PSF)) + uidx * 4096 + (sl * 4 * 64 + lane) * 4;
#pragma unroll
    for (int m = 0; m < 4; ++m) { o.f[m][0] = *(const bf16x8*)(Mg + m * 1024); o.f[m][1] = *(const bf16x8*)(Mg + m * 1024 + 32); o.c[m] = *(const v2u*)(Cg + m * 256); }
}
__device__ __forceinline__ void lru_scan(Frame& F, int idx) {
    const int ch = idx & 1023, b = (idx >> 10) & 1, d = idx >> 11;
    const float* AG = (const float*)(F.ws + WS_LAGG); float* HIN = (float*)(F.ws + WS_LHIN);
    float carry = 0.f;
#pragma unroll 4
    for (int step = 0; step < 68; ++step) { int tile; if (step < 4) tile = 128 + b * 4 + (d ? 3 - step : step); else tile = b * 64 + (d ? 63 - (step - 4) : step - 4);
        const float a = AG[((size_t)(0 * 2 + d) * NTILE + tile) * LRW + ch], hh_ = AG[((size_t)(1 * 2 + d) * NTILE + tile) * LRW + ch];
        HIN[((size_t)d * NTILE + tile) * LRW + ch] = carry; carry = a * carry + hh_; }
}

__device__ __forceinline__ void chunk_apply(Frame& F, const ChunkOps& o, f32x4 (&S)[4], int step, bf16* YR, int hh, int d, int sl, int role, int lane) {
    const int g = lane >> 4, il = lane & 15; LAS v4u* XCH = (LAS v4u*)F.lds;
    bf16x8 bfr[2];
    if (role == 0) {
#pragma unroll
        for (int ks = 0; ks < 2; ++ks) { v4u w; w.x = pk2(S[2 * ks][0], S[2 * ks][1]); w.y = pk2(S[2 * ks][2], S[2 * ks][3]); w.z = pk2(S[2 * ks + 1][0], S[2 * ks + 1][1]); w.w = pk2(S[2 * ks + 1][2], S[2 * ks + 1][3]); bfr[ks] = __builtin_bit_cast(bf16x8, w); }
#pragma unroll
        for (int m = 0; m < 4; ++m) { f32x4 sn = (f32x4){bf_lo(o.c[m].x), bf_hi(o.c[m].x), bf_lo(o.c[m].y), bf_hi(o.c[m].y)}; sn = MFMA16(o.f[m][0], bfr[0], sn); sn = MFMA16(o.f[m][1], bfr[1], sn); S[m] = sn; }
#pragma unroll
        for (int ks = 0; ks < 2; ++ks) { v4u w; w.x = pk2(S[2 * ks][0], S[2 * ks][1]); w.y = pk2(S[2 * ks][2], S[2 * ks][3]); w.z = pk2(S[2 * ks + 1][0], S[2 * ks + 1][1]); w.w = pk2(S[2 * ks + 1][2], S[2 * ks + 1][3]);
            XCH[((((step + 1) & 1) * 4 + sl) * 2 + ks) * 64 + lane] = w; }
    } else {
#pragma unroll
        for (int ks = 0; ks < 2; ++ks) bfr[ks] = __builtin_bit_cast(bf16x8, XCH[(((step & 1) * 4 + sl) * 2 + ks) * 64 + lane]);
#pragma unroll
        for (int m = 0; m < 4; ++m) { f32x4 y = (f32x4){bf_lo(o.c[m].x), bf_hi(o.c[m].x), bf_lo(o.c[m].y), bf_hi(o.c[m].y)}; y = MFMA16(o.f[m][0], bfr[0], y); y = MFMA16(o.f[m][1], bfr[1], y);
#pragma unroll
            for (int r = 0; r < 4; ++r) { const int tau = 16 * m + 4 * g + r, tl = d ? 63 - tau : tau; YR[(size_t)(o.tile * 64 + tl) * RWW + hh * 64 + sl * 16 + il] = (bf16)f2bf(y[r]); } }
    }
}
__device__ __forceinline__ void rwkv_chain_chunks(Frame& F, int item) {
    const int chain = item >> 2, sl = item & 3, d = chain & 1, hh = (chain >> 1) & 15, b = chain >> 5, role = F.wave, lane = F.lane;
    bf16* YR = (bf16*)(F.ws + WS_YR) + (size_t)d * MTOT * RWW;
    { LAS v4u* XCH = (LAS v4u*)F.lds; for (int i = F.tid; i < 4 * 2 * 64; i += NTHR) XCH[i] = (v4u){0u, 0u, 0u, 0u}; }
    __syncthreads();
    if (F.wave >= 2) {
#pragma unroll 1
        for (int step = 0; step < 68; ++step) LDS_BAR();
        return; }
    f32x4 S[4];
#pragma unroll
    for (int m = 0; m < 4; ++m) S[m] = (f32x4){0.f, 0.f, 0.f, 0.f};
    ChunkOps A, B, C, E;
    chunk_load(F, A, 0, b, hh, d, sl, role, lane); chunk_load(F, B, 1, b, hh, d, sl, role, lane); chunk_load(F, C, 2, b, hh, d, sl, role, lane);
#pragma unroll 1
    for (int step = 0; step < 68; step += 4) {
        chunk_load(F, E, step + 3, b, hh, d, sl, role, lane);
        chunk_apply(F, A, S, step, YR, hh, d, sl, role, lane); LDS_BAR();
        chunk_load(F, A, step + 4, b, hh, d, sl, role, lane);
        chunk_apply(F, B, S, step + 1, YR, hh, d, sl, role, lane); LDS_BAR();
        chunk_load(F, B, step + 5, b, hh, d, sl, role, lane);
        chunk_apply(F, C, S, step + 2, YR, hh, d, sl, role, lane); LDS_BAR();
        chunk_load(F, C, step + 6, b, hh, d, sl, role, lane);
        chunk_apply(F, E, S, step + 3, YR, hh, d, sl, role, lane); LDS_BAR();
    }
}
__device__ __forceinline__ void merge_unit(Frame& F, int l, int u) {
    const int c = u >> 2; const TileInfo ti = tile_info(c); const int t0 = ti.t0 + (u & 3) * 16; const bf16* P = (const bf16*)(F.ws + WS_P);
    LAS bf16* SG = (LAS bf16*)F.lds; LAS bf16* GO = (LAS bf16*)(F.lds + 10752);
    const float* mu0 = gin(F.in[I_MU]) + (size_t)l * 2 * RW_COLS; const float* mu1 = mu0 + RW_COLS;
    for (int idx = F.tid; idx < 16 * 160; idx += NTHR) { const int t = idx / 160, k = idx % 160, tt = t0 + t, rc = 3 * RWW + 256 + k; const bf16* p = P + (size_t)(ti.seq_base + tt) * IN_PAD + 2 * LRW + rc;
        const float x = __builtin_bit_cast(float, (unsigned)p[0] << 16), xm = tt > 0 ? __builtin_bit_cast(float, (unsigned)p[-IN_PAD] << 16) : 0.f, xn = tt + 1 < ti.seq_len ? __builtin_bit_cast(float, (unsigned)p[IN_PAD] << 16) : 0.f;
        SG[t * 168 + k] = (bf16)f2bf(fsigmoid(x + mu0[rc] * (xm - x) + mu1[rc] * (xn - x))); }
    __syncthreads();
    { const int lane = F.lane; const bf16* G2 = (const bf16*)(F.ws + WS_G2T) + (size_t)l * 1024 * 160;
      bf16x8 af[5];
#pragma unroll
      for (int k = 0; k < 5; ++k) af[k] = frag_lds(SG, 168, 0, 32 * k, lane);
#pragma unroll 2
      for (int n = 0; n < 8; ++n) { const int n0 = F.wave * 128 + n * 16; f32x4 a0 = {0.f, 0.f, 0.f, 0.f};
#pragma unroll
          for (int k = 0; k < 5; ++k) a0 = MFMA16(af[k], frag_g(G2, 160, n0, 32 * k, lane), a0);
#pragma unroll
          for (int r = 0; r < 4; ++r) GO[(4 * (lane >> 4) + r) * 1032 + n0 + (lane & 15)] = (bf16)f2bf(a0[r]); } }
    __syncthreads();
    { bf16* MRG = (bf16*)(F.ws + WS_H);
      for (int it = F.tid; it < 16 * 256; it += NTHR) { const int t = it >> 8, cgp = it & 255, tt = t0 + t; const size_t grow = (size_t)(ti.seq_base + tt);
          float o[8];
          if (cgp < 128) { const int ch = cgp * 8; float gq8[8]; ld8bf(P + grow * IN_PAD + LRW + ch, gq8); const f32x4 g0 = {gq8[0], gq8[1], gq8[2], gq8[3]}, g1 = {gq8[4], gq8[5], gq8[6], gq8[7]};
              const bf16* hl = (const bf16*)(F.ws + WS_LB) + grow * LRW + ch; const bf16* ac = (const bf16*)(F.ws + WS_LA) + grow * LRW + ch; const float* hi = (const float*)(F.ws + WS_LHIN) + (size_t)c * LRW + ch;
              float h0[8], c0[8], h1[8], c1[8]; ld8bf(hl, h0); ld8bf(ac, c0); ld8bf(hl + (size_t)MTOT * LRW, h1); ld8bf(ac + (size_t)MTOT * LRW, c1);
              const f32x4 i00 = *(const f32x4*)hi, i01 = *(const f32x4*)(hi + 4), i10 = *(const f32x4*)(hi + (size_t)NTILE * LRW), i11 = *(const f32x4*)(hi + (size_t)NTILE * LRW + 4);
              const f32x4 a0 = {h0[0] + c0[0] * i00.x + h1[0] + c1[0] * i10.x, h0[1] + c0[1] * i00.y + h1[1] + c1[1] * i10.y, h0[2] + c0[2] * i00.z + h1[2] + c1[2] * i10.z, h0[3] + c0[3] * i00.w + h1[3] + c1[3] * i10.w};
              const f32x4 a1 = {h0[4] + c0[4] * i01.x + h1[4] + c1[4] * i11.x, h0[5] + c0[5] * i01.y + h1[5] + c1[5] * i11.y, h0[6] + c0[6] * i01.z + h1[6] + c1[6] * i11.z, h0[7] + c0[7] * i01.w + h1[7] + c1[7] * i11.w};
              o[0] = gelu_tanh(g0.x) * a0.x; o[1] = gelu_tanh(g0.y) * a0.y; o[2] = gelu_tanh(g0.z) * a0.z; o[3] = gelu_tanh(g0.w) * a0.w;
              o[4] = gelu_tanh(g1.x) * a1.x; o[5] = gelu_tanh(g1.y) * a1.y; o[6] = gelu_tanh(g1.z) * a1.z; o[7] = gelu_tanh(g1.w) * a1.w; }
          else { const int ch = (cgp - 128) * 8, hh = ch >> 6; const bf16* yr = (const bf16*)(F.ws + WS_YR) + grow * RWW + ch;
              float ya[8], yb[8], va[8]; ld8bf(yr, ya); ld8bf(yr + (size_t)MTOT * RWW, yb); ld8bf((const bf16*)(F.ws + WS_RV) + grow * RWW + ch, va);
              float s1 = 0.f, q1 = 0.f;
#pragma unroll
              for (int e = 0; e < 8; ++e) { ya[e] += yb[e]; s1 += ya[e]; q1 += ya[e] * ya[e]; }
              s1 = red8(s1); q1 = red8(q1);
              const float mean = s1 * (1.0f / 64.0f), var = fmaxf(q1 * (1.0f / 64.0f) - mean * mean, 0.f); const f32x2 st = {mean, __builtin_amdgcn_rsqf(var + GN_EPS)};
              const float beta = ((const float*)(F.ws + WS_BETA))[grow * NH + hh] + ((const float*)(F.ws + WS_BETA))[((size_t)MTOT + grow) * NH + hh];
              const float* gg = gin(F.in[I_GNG]) + (size_t)l * RWW + ch; const float* gb = gin(F.in[I_GNB]) + (size_t)l * RWW + ch;
              const v4u gq = *(const LAS v4u*)(GO + t * 1032 + ch); const float gv[8] = {bf_lo(gq.x), bf_hi(gq.x), bf_lo(gq.y), bf_hi(gq.y), bf_lo(gq.z), bf_hi(gq.z), bf_lo(gq.w), bf_hi(gq.w)};
#pragma unroll
              for (int e = 0; e < 8; ++e) o[e] = ((ya[e] - st.x) * st.y * gg[e] + gb[e] + beta * va[e]) * gv[e]; }
          v4u w; w.x = pk2(o[0], o[1]); w.y = pk2(o[2], o[3]); w.z = pk2(o[4], o[5]); w.w = pk2(o[6], o[7]);
          *(v4u*)(MRG + grow * D + cgp * 8) = w; } }
    __syncthreads();
}

__device__ __forceinline__ void ln_row(float (&z)[32], const float* g, const float* b, int lane) {
    float s = 0.f;
#pragma unroll
    for (int i = 0; i < 32; ++i) s += z[i];
    const float mean = wave_sum(s) * (1.0f / D); float q = 0.f;
#pragma unroll
    for (int i = 0; i < 32; ++i) { z[i] -= mean; q += z[i] * z[i]; }
    const float rstd = __builtin_amdgcn_rsqf(wave_sum(q) * (1.0f / D) + LN_EPS);
#pragma unroll
    for (int j = 0; j < 4; ++j) { const int e = j * 512 + lane * 8; const f32x4 g0 = *(const f32x4*)(g + e), g1 = *(const f32x4*)(g + e + 4), b0 = *(const f32x4*)(b + e), b1 = *(const f32x4*)(b + e + 4);
        const float gs[8] = {g0.x, g0.y, g0.z, g0.w, g1.x, g1.y, g1.z, g1.w}, bs[8] = {b0.x, b0.y, b0.z, b0.w, b1.x, b1.y, b1.z, b1.w};
#pragma unroll
        for (int i = 0; i < 8; ++i) z[j * 8 + i] = z[j * 8 + i] * rstd * gs[i] + bs[i]; }
}
__device__ __forceinline__ void load32(const float* p, int lane, float (&v)[32]) {
#pragma unroll
    for (int j = 0; j < 4; ++j) { const int e = j * 512 + lane * 8; const f32x4 a = *(const f32x4*)(p + e), b = *(const f32x4*)(p + e + 4);
        v[j * 8 + 0] = a.x; v[j * 8 + 1] = a.y; v[j * 8 + 2] = a.z; v[j * 8 + 3] = a.w; v[j * 8 + 4] = b.x; v[j * 8 + 5] = b.y; v[j * 8 + 6] = b.z; v[j * 8 + 7] = b.w; }
}
__device__ __forceinline__ void store32(float* p, int lane, const float (&v)[32]) {
#pragma unroll
    for (int j = 0; j < 4; ++j) { const int e = j * 512 + lane * 8; *(f32x4*)(p + e) = (f32x4){v[j * 8 + 0], v[j * 8 + 1], v[j * 8 + 2], v[j * 8 + 3]}; *(f32x4*)(p + e + 4) = (f32x4){v[j * 8 + 4], v[j * 8 + 5], v[j * 8 + 6], v[j * 8 + 7]}; }
}
__device__ __forceinline__ void store32_mod_bf16(bf16* p, const float* sh, const float* sc, int lane, const float (&v)[32]) {
#pragma unroll
    for (int j = 0; j < 4; ++j) { const int e = j * 512 + lane * 8; const f32x4 s0 = *(const f32x4*)(sh + e), s1 = *(const f32x4*)(sh + e + 4), c0 = *(const f32x4*)(sc + e), c1 = *(const f32x4*)(sc + e + 4);
        v4u o; o.x = pk2(v[j * 8 + 0] * (1.f + c0.x) + s0.x, v[j * 8 + 1] * (1.f + c0.y) + s0.y); o.y = pk2(v[j * 8 + 2] * (1.f + c0.z) + s0.z, v[j * 8 + 3] * (1.f + c0.w) + s0.w);
        o.z = pk2(v[j * 8 + 4] * (1.f + c1.x) + s1.x, v[j * 8 + 5] * (1.f + c1.y) + s1.y); o.w = pk2(v[j * 8 + 6] * (1.f + c1.z) + s1.z, v[j * 8 + 7] * (1.f + c1.w) + s1.w);
        *(v4u*)(p + e) = o; }
}
__device__ __forceinline__ void ln1_rows(Frame& F, int l, int nrows, bool dry = false) {
    const int gw = F.vcu * NWAVES + F.wave, NGW = F.G * NWAVES; float* X = (float*)(F.ws + WS_X); const float* O = (const float*)(F.ws + WS_O); bf16* H = (bf16*)(F.ws + WS_H);
    float* Xo = dry ? (float*)(F.ws + WS_LA) : X; bf16* Ho = dry ? (bf16*)(F.ws + WS_LB) : H;
    for (int row = gw; row < nrows; row += NGW) { const float* md = (const float*)(F.ws + WS_MOD) + ((size_t)l * 3 + mod_row(row)) * (6 * D);
        float z[32], o[32], gt[32]; load32(X + (size_t)row * D, F.lane, z); load32(md + 2 * D, F.lane, gt);
#pragma unroll
        for (int j = 0; j < 4; ++j) { float t8[8]; ld8bf((const bf16*)(F.ws + WS_O) + (size_t)row * D + j * 512 + F.lane * 8, t8);
#pragma unroll
            for (int i = 0; i < 8; ++i) o[j * 8 + i] = t8[i]; }
#pragma unroll
        for (int i = 0; i < 32; ++i) z[i] = ALPHA * z[i] + gt[i] * o[i];
        ln_row(z, gin(F.in[I_LN1G]) + (size_t)l * D, gin(F.in[I_LN1B]) + (size_t)l * D, F.lane);
        store32(Xo + (size_t)row * D, F.lane, z);
        store32_mod_bf16(Ho + (size_t)row * D, md + 3 * D, md + 4 * D, F.lane, z); }
}

__device__ __forceinline__ unsigned ord_key(float s, int k) { unsigned u = __builtin_bit_cast(unsigned, s); u = (u & 0x80000000u) ? ~u : (u | 0x80000000u); return (u & ~127u) | (unsigned)(127 - k); }
__device__ __forceinline__ float key_score(unsigned key) { const unsigned u = key & ~127u; return __builtin_bit_cast(float, (u & 0x80000000u) ? (u ^ 0x80000000u) : ~u); }
__device__ __forceinline__ void bitonic_top16(unsigned (&A)[16], const unsigned (&B)[16]) {
#pragma unroll
    for (int i = 0; i < 16; ++i) A[i] = A[i] > B[15 - i] ? A[i] : B[15 - i];
#pragma unroll
    for (int st = 8; st >= 1; st >>= 1)
#pragma unroll
        for (int i = 0; i < 16; ++i) if (!(i & st)) { const unsigned hi = A[i] > A[i + st] ? A[i] : A[i + st], lo = A[i] > A[i + st] ? A[i + st] : A[i]; A[i] = hi; A[i + st] = lo; }
}
__device__ __forceinline__ void ins16(unsigned (&L)[16], unsigned x) {
#pragma unroll
    for (int i = 0; i < 16; ++i) { const unsigned hi = L[i] > x ? L[i] : x; x = L[i] > x ? x : L[i]; L[i] = hi; }
}
__device__ __forceinline__ unsigned ord_key8(float s, unsigned tag) { unsigned u = __builtin_bit_cast(unsigned, s); u = (u & 0x80000000u) ? ~u : (u | 0x80000000u); return (u & ~255u) | tag; }
__device__ __forceinline__ float key_score8(unsigned key) { const unsigned u = key & ~255u; return __builtin_bit_cast(float, (u & 0x80000000u) ? (u ^ 0x80000000u) : ~u); }
__device__ __forceinline__ void peer_topk_unit(Frame& F, int l, int tile, int h) {
    int tid = F.tid; asm volatile("" : "+v"(tid));
    const int lane = tid & 63, wave = F.wave;
    LAS bf16* AQ = (LAS bf16*)F.lds; LAS float* SC = (LAS float*)(F.lds + 33792);
    LAS unsigned* bufA = (LAS unsigned*)F.lds; LAS unsigned* bufB = (LAS unsigned*)(F.lds + 33792); LAS unsigned* FIN = (LAS unsigned*)(F.lds + 66560); LAS unsigned char* PAIRT = (LAS unsigned char*)(F.lds + 99584);
    if (tid < 50) { int c = tid, i = 0; for (; i < 16; ++i) { const int n = 16 / (i + 1); if (c < n) break; c -= n; } PAIRT[tid] = (unsigned char)(i * 16 + c); }
    for (int idx = tid; idx < 64 * 64; idx += NTHR) { const int t = idx >> 6, c4 = (idx & 63) * 4; *(LAS v2u*)(AQ + t * 264 + c4) = *(const v2u*)((const bf16*)(F.ws + WS_QP) + (size_t)(tile * 64 + t) * D + h * 256 + c4); }
    __syncthreads();
    { const bf16* SK = (const bf16*)(F.ws + WS_SUBK) + (size_t)((l * 8 + h) * 2) * 128 * 128;
#pragma unroll
      for (int p = 0; p < 2; ++p) { bf16x8 bfr[4];
#pragma unroll
          for (int k = 0; k < 4; ++k) bfr[k] = frag_g(SK + (size_t)p * 128 * 128, 128, 16 * wave, 32 * k, lane);
#pragma unroll
          for (int m = 0; m < 4; ++m) { f32x4 acc = {0.f, 0.f, 0.f, 0.f};
#pragma unroll
              for (int k = 0; k < 4; ++k) acc = MFMA16(frag_lds(AQ, 264, 16 * m, p * 128 + 32 * k, lane), bfr[k], acc);
#pragma unroll
              for (int r = 0; r < 4; ++r) SC[(16 * m + 4 * (lane >> 4) + r) * 257 + p * 128 + 16 * wave + (lane & 15)] = acc[r]; } } }
    __syncthreads();
    const int t = lane, r = wave, p = r & 1, qd = r >> 1;
    unsigned L[16], B[16];
#pragma unroll
    for (int i = 0; i < 16; ++i) L[i] = 0u;
    { const LAS float* sp = SC + t * 257 + p * 128 + 32 * qd;
#pragma unroll 4
      for (int k = 0; k < 32; ++k) ins16(L, ord_key(sp[k], 32 * qd + k)); }
#pragma unroll
    for (int i = 0; i < 16; ++i) bufA[(r * 16 + i) * 64 + t] = L[i];
    __syncthreads();
#pragma unroll
    for (int i = 0; i < 16; ++i) B[i] = bufA[((r ^ 2) * 16 + i) * 64 + t];
    bitonic_top16(L, B);
#pragma unroll
    for (int i = 0; i < 16; ++i) bufB[(r * 16 + i) * 64 + t] = L[i];
    __syncthreads();
#pragma unroll
    for (int i = 0; i < 16; ++i) B[i] = bufB[((r ^ 4) * 16 + i) * 64 + t];
    bitonic_top16(L, B);
    if (qd == 0) {
#pragma unroll
        for (int i = 0; i < 16; ++i) FIN[(p * 16 + i) * 64 + t] = L[i]; }
    __syncthreads();
#pragma unroll
    for (int i = 0; i < 16; ++i) L[i] = 0u;
#pragma unroll
    for (int q = 0; q < 7; ++q) { const int c = q * 8 + r; if (c < 50) { const unsigned pr = PAIRT[c]; const unsigned ka = FIN[(0 * 16 + (pr >> 4)) * 64 + t], kb = FIN[(1 * 16 + (pr & 15)) * 64 + t];
            ins16(L, ord_key8(key_score(ka) + key_score(kb), pr)); } }
#pragma unroll
    for (int i = 0; i < 16; ++i) bufB[(r * 16 + i) * 64 + t] = L[i];
    __syncthreads();
#pragma unroll
    for (int i = 0; i < 16; ++i) B[i] = bufB[((r ^ 1) * 16 + i) * 64 + t];
    bitonic_top16(L, B);
#pragma unroll
    for (int i = 0; i < 16; ++i) bufA[(r * 16 + i) * 64 + t] = L[i];
    __syncthreads();
#pragma unroll
    for (int i = 0; i < 16; ++i) B[i] = bufA[((r ^ 2) * 16 + i) * 64 + t];
    bitonic_top16(L, B);
    __syncthreads();
#pragma unroll
    for (int i = 0; i < 16; ++i) bufB[(r * 16 + i) * 64 + t] = L[i];
    __syncthreads();
#pragma unroll
    for (int i = 0; i < 16; ++i) B[i] = bufB[((r ^ 4) * 16 + i) * 64 + t];
    bitonic_top16(L, B);
    { const float mx = key_score8(L[0]); float sum = 0.f, e0 = 0.f, e1 = 0.f; unsigned k0 = 0u, k1 = 0u;
#pragma unroll
      for (int i = 0; i < 16; ++i) { const float e = fexp(key_score8(L[i]) - mx); sum += e; if (i == 2 * r) { e0 = e; k0 = L[i]; } if (i == 2 * r + 1) { e1 = e; k1 = L[i]; } }
      const float inv = __builtin_amdgcn_rcpf(sum);
      const unsigned pa = k0 & 255u, pb = k1 & 255u;
      const int id0 = (127 - (int)(FIN[(0 * 16 + (pa >> 4)) * 64 + t] & 127u)) * 128 + (127 - (int)(FIN[(1 * 16 + (pa & 15)) * 64 + t] & 127u));
      const int id1 = (127 - (int)(FIN[(0 * 16 + (pb >> 4)) * 64 + t] & 127u)) * 128 + (127 - (int)(FIN[(1 * 16 + (pb & 15)) * 64 + t] & 127u));
      int* IDX = (int*)(F.ws + WS_IDX) + (size_t)(tile * 64 + t) * PE_SEL + h * 16 + 2 * r; float* GT = (float*)(F.ws + WS_GATE) + (size_t)(tile * 64 + t) * PE_SEL + h * 16 + 2 * r;
      *(int2*)IDX = make_int2(id0, id1); *(f32x2*)GT = (f32x2){e0 * inv, e1 * inv}; }
    __syncthreads();
}

__device__ __forceinline__ void unpack16(const v4u& w, f32x2 (&o)[8]) {
    o[0] = __builtin_amdgcn_cvt_pk_f32_fp8((int)w.x, false); o[1] = __builtin_amdgcn_cvt_pk_f32_fp8((int)w.x, true); o[2] = __builtin_amdgcn_cvt_pk_f32_fp8((int)w.y, false); o[3] = __builtin_amdgcn_cvt_pk_f32_fp8((int)w.y, true);
    o[4] = __builtin_amdgcn_cvt_pk_f32_fp8((int)w.z, false); o[5] = __builtin_amdgcn_cvt_pk_f32_fp8((int)w.z, true); o[6] = __builtin_amdgcn_cvt_pk_f32_fp8((int)w.w, false); o[7] = __builtin_amdgcn_cvt_pk_f32_fp8((int)w.w, true);
}
constexpr int EB = 8;
__device__ __forceinline__ void peer_token(Frame& F, int l, int row, int kb, int ke, f32x2 (&acc)[2][8]) {
    const int lane = F.lane;
    const unsigned char* UB = (const unsigned char*)(F.ws + WS_UB + (size_t)l * PE_NE * D); const unsigned char* VB = (const unsigned char*)(F.ws + WS_VB + (size_t)l * PE_NE * D);
    const float* SU = (const float*)(F.ws + WS_SU) + (size_t)l * PE_NE; const float* SV = (const float*)(F.ws + WS_SV) + (size_t)l * PE_NE;
    const bf16* H = (const bf16*)(F.ws + WS_H);
        const int* IDX = (const int*)(F.ws + WS_IDX) + (size_t)row * PE_SEL; const float* GT = (const float*)(F.ws + WS_GATE) + (size_t)row * PE_SEL;
        const int il = IDX[lane], ih = IDX[64 + lane]; const float gl = GT[lane], gh = GT[64 + lane];
        const float sul = SU[il], suh = SU[ih], svl = SV[il], svh = SV[ih];
        f32x2 hf[2][8];
#pragma unroll
        for (int j = 0; j < 2; ++j) { const v4u a = *(const v4u*)(H + (size_t)row * D + j * 1024 + lane * 16), b = *(const v4u*)(H + (size_t)row * D + j * 1024 + lane * 16 + 8);
            hf[j][0] = (f32x2){bf_lo(a.x), bf_hi(a.x)}; hf[j][1] = (f32x2){bf_lo(a.y), bf_hi(a.y)}; hf[j][2] = (f32x2){bf_lo(a.z), bf_hi(a.z)}; hf[j][3] = (f32x2){bf_lo(a.w), bf_hi(a.w)};
            hf[j][4] = (f32x2){bf_lo(b.x), bf_hi(b.x)}; hf[j][5] = (f32x2){bf_lo(b.y), bf_hi(b.y)}; hf[j][6] = (f32x2){bf_lo(b.z), bf_hi(b.z)}; hf[j][7] = (f32x2){bf_lo(b.w), bf_hi(b.w)}; }
        int dl = 0, dh = 0;
#pragma unroll 1
        for (int k0 = kb; k0 < ke; k0 += EB) { v4u w[EB][2];
#pragma unroll
            for (int q = 0; q < EB; ++q) { const int k = k0 + q; const int e = __builtin_amdgcn_readlane(k0 < 64 ? il : ih, k & 63); const unsigned char* ur = UB + (size_t)e * D + lane * 16;
                w[q][0] = *(const v4u*)ur; w[q][1] = *(const v4u*)(ur + 1024); }
#pragma unroll
            for (int q = 0; q < EB; ++q) { const int k = k0 + q; f32x2 p2 = {0.f, 0.f};
#pragma unroll
                for (int j = 0; j < 2; ++j) { f32x2 uf[8]; unpack16(w[q][j], uf);
#pragma unroll
                    for (int i = 0; i < 8; ++i) p2 = __builtin_elementwise_fma(uf[i], hf[j][i], p2); }
                const int tb = __builtin_bit_cast(int, wave_total(p2.x + p2.y));
                if (k0 < 64) dl = (lane == (k & 63)) ? tb : dl; else dh = (lane == (k & 63)) ? tb : dh; } }
        const float cl = gl * svl * gelu_erf(__builtin_bit_cast(float, dl) * sul), ch = gh * svh * gelu_erf(__builtin_bit_cast(float, dh) * suh);
#pragma unroll
        for (int j = 0; j < 2; ++j)
#pragma unroll
            for (int i = 0; i < 8; ++i) acc[j][i] = (f32x2){0.f, 0.f};
#pragma unroll 1
        for (int k0 = kb; k0 < ke; k0 += EB) { v4u w[EB][2];
#pragma unroll
            for (int q = 0; q < EB; ++q) { const int k = k0 + q; const int e = __builtin_amdgcn_readlane(k0 < 64 ? il : ih, k & 63); const unsigned char* vr = VB + (size_t)e * D + lane * 16;
                w[q][0] = *(const v4u*)vr; w[q][1] = *(const v4u*)(vr + 1024); }
#pragma unroll
            for (int q = 0; q < EB; ++q) { const int k = k0 + q; const float cf = __builtin_bit_cast(float, __builtin_amdgcn_readlane(__builtin_bit_cast(int, k0 < 64 ? cl : ch), k & 63)); const f32x2 cf2 = {cf, cf};
#pragma unroll
                for (int j = 0; j < 2; ++j) { f32x2 vf[8]; unpack16(w[q][j], vf);
#pragma unroll
                    for (int i = 0; i < 8; ++i) acc[j][i] = __builtin_elementwise_fma(vf[i], cf2, acc[j][i]); } } }
}
__device__ __forceinline__ void peer_finish(Frame& F, int l, int row, const f32x2 (&acc)[2][8], bool dry) {
    const int lane = F.lane;
    float* X = (float*)(F.ws + WS_X); bf16* H = (bf16*)(F.ws + WS_H); float* Xo = dry ? (float*)(F.ws + WS_LA) : X; bf16* Ho = dry ? (bf16*)(F.ws + WS_LB) : H; float* Oo = dry ? (float*)(F.ws + WS_LA) : (float*)F.out;
        const float* md = (const float*)(F.ws + WS_MOD) + ((size_t)l * 3 + mod_row(row)) * (6 * D);
        float z[32]; float s = 0.f;
#pragma unroll
        for (int j = 0; j < 2; ++j)
#pragma unroll
            for (int q = 0; q < 4; ++q) { const int e = j * 1024 + lane * 16 + q * 4; const f32x4 xv = *(const f32x4*)(X + (size_t)row * D + e), gv = *(const f32x4*)(md + 5 * D + e);
                z[j * 16 + q * 4 + 0] = ALPHA * xv.x + gv.x * acc[j][2 * q][0]; z[j * 16 + q * 4 + 1] = ALPHA * xv.y + gv.y * acc[j][2 * q][1]; z[j * 16 + q * 4 + 2] = ALPHA * xv.z + gv.z * acc[j][2 * q + 1][0]; z[j * 16 + q * 4 + 3] = ALPHA * xv.w + gv.w * acc[j][2 * q + 1][1]; }
#pragma unroll
        for (int i = 0; i < 32; ++i) s += z[i];
        const float mean = wave_sum(s) * (1.0f / D); float qv = 0.f;
#pragma unroll
        for (int i = 0; i < 32; ++i) { z[i] -= mean; qv += z[i] * z[i]; }
        const float rstd = __builtin_amdgcn_rsqf(wave_sum(qv) * (1.0f / D) + LN_EPS);
        const float* lg = gin(F.in[I_LN2G]) + (size_t)l * D; const float* lb = gin(F.in[I_LN2B]) + (size_t)l * D; const float* mn = (const float*)(F.ws + WS_MOD) + ((size_t)(l + 1 < DEPTH ? l + 1 : l) * 3 + mod_row(row)) * (6 * D);
#pragma unroll
        for (int j = 0; j < 2; ++j) { unsigned hw[8];
#pragma unroll
            for (int q = 0; q < 4; ++q) { const int e = j * 1024 + lane * 16 + q * 4; const f32x4 g4 = *(const f32x4*)(lg + e), b4 = *(const f32x4*)(lb + e);
                f32x4 o; o.x = z[j * 16 + q * 4 + 0] * rstd * g4.x + b4.x; o.y = z[j * 16 + q * 4 + 1] * rstd * g4.y + b4.y; o.z = z[j * 16 + q * 4 + 2] * rstd * g4.z + b4.z; o.w = z[j * 16 + q * 4 + 3] * rstd * g4.w + b4.w;
                if (l + 1 < DEPTH) { *(f32x4*)(Xo + (size_t)row * D + e) = o; const f32x4 s4 = *(const f32x4*)(mn + e), c4 = *(const f32x4*)(mn + D + e);
                    hw[2 * q] = pk2(o.x * (1.f + c4.x) + s4.x, o.y * (1.f + c4.y) + s4.y); hw[2 * q + 1] = pk2(o.z * (1.f + c4.z) + s4.z, o.w * (1.f + c4.w) + s4.w); }
                else *(f32x4*)(Oo + (size_t)row * D + e) = o; }
            if (l + 1 < DEPTH) { *(v4u*)(Ho + (size_t)row * D + j * 1024 + lane * 16) = (v4u){hw[0], hw[1], hw[2], hw[3]}; *(v4u*)(Ho + (size_t)row * D + j * 1024 + lane * 16 + 8) = (v4u){hw[4], hw[5], hw[6], hw[7]}; } }
}
__device__ __forceinline__ void peer_rows(Frame& F, int l, int nrows, bool dry = false) {
    const int gw = F.vcu * NWAVES + F.wave, NGW = F.G * NWAVES, lane = F.lane;
    for (int row = gw; row < NLAT; row += NGW) { f32x2 acc[2][8]; peer_token(F, l, row, 0, PE_SEL, acc); peer_finish(F, l, row, acc, dry); }
    if (nrows > NLAT) { LAS f32x2* PART = (LAS f32x2*)F.lds;
        for (int r2 = F.vcu * 2 + (F.wave >> 2); r2 < NCTX; r2 += F.G * 2) { const int row = NLAT + r2, part = F.wave & 3, slot = F.wave >> 2; f32x2 acc[2][8];
            peer_token(F, l, row, 32 * part, 32 * part + 32, acc);
            if (part) {
#pragma unroll
                for (int j = 0; j < 2; ++j)
#pragma unroll
                    for (int i = 0; i < 8; ++i) PART[((slot * 3 + part - 1) * 16 + j * 8 + i) * 64 + lane] = acc[j][i]; }
            __syncthreads();
            if (part == 0) {
#pragma unroll
                for (int p = 0; p < 3; ++p)
#pragma unroll
                    for (int j = 0; j < 2; ++j)
#pragma unroll
                        for (int i = 0; i < 8; ++i) acc[j][i] += PART[((slot * 3 + p) * 16 + j * 8 + i) * 64 + lane];
                peer_finish(F, l, row, acc, dry); }
            __syncthreads(); } }
}
#ifndef MK_PER_PHASE
#define MK_PER_PHASE 0
#endif
constexpr int NPH_PRO = 3, NPH_LAYER = 9, NPHASES = NPH_PRO + DEPTH * NPH_LAYER;
__global__ void __launch_bounds__(NTHR, 2) trunk_fwd(Args args) {
    extern __shared__ __attribute__((aligned(16))) unsigned char lds_raw[];
    Frame F0;
    F0.lds = (LAS unsigned char*)lds_raw;
    F0.tid = threadIdx.x; F0.lane = F0.tid & 63; F0.wave = __builtin_amdgcn_readfirstlane(F0.tid >> 6);
    F0.G = gridDim.x; { const int bx = blockIdx.x; F0.vcu = (F0.G % 8 == 0) ? (bx % 8) * (F0.G / 8) + bx / 8 : bx; }
    F0.in = args.in; F0.out = (GAS float*)args.out; F0.ws = (GAS unsigned char*)args.ws;
    volatile LAS unsigned* MISC = (volatile LAS unsigned*)(F0.lds + MISC_OFF);
    for (int u = F0.tid; u < (LDS_BYTES - LDSCTL_OFF) / 4; u += NTHR) ((LAS unsigned*)(F0.lds + LDSCTL_OFF))[u] = 0u;
    __syncthreads();
    const int lo = args.ph_lo, hi = args.ph_hi;
    XcdBarrier bar; bar.bar = (unsigned*)(F0.ws + WS_CTL) + CW_BAR; bar.x = 0; bar.st = nullptr;
    if (hi - lo > 1) bar = xcd_barrier_post((unsigned*)(F0.ws + WS_CTL) + CW_BAR, MISC + 8);
#ifndef PHMASK
#define PHMASK 0xfff
#endif
#define PHM(b) ((PHMASK >> (b)) & 1)
#ifndef PHREP
#define PHREP 0
#endif
#define NREP(b) (1 + ((PHREP >> (b)) & 1))
#define IN(k) (lo <= (k) && (k) < hi)
#define LAUNDER() Frame F = F0; int bx_ = blockIdx.x; { int ws_ = F0.wave; asm volatile("" : "+s"(ws_)); int ln_; asm volatile("v_mbcnt_lo_u32_b32 %0, -1, 0\n\tv_mbcnt_hi_u32_b32 %0, -1, %0" : "=v"(ln_)); F.wave = ws_; F.lane = ln_; F.tid = ws_ * 64 + ln_; \
    GAS unsigned char* w_ = F0.ws; asm volatile("" : "+s"(w_)); F.ws = w_; int v_ = F0.vcu; asm volatile("" : "+s"(v_)); F.vcu = v_; int g_ = F0.G; asm volatile("" : "+s"(g_)); F.G = g_; \
    GAS float* o_ = F0.out; asm volatile("" : "+s"(o_)); F.out = o_; asm volatile("" : "+s"(bx_)); \
    unsigned l_ = (unsigned)(size_t)F0.lds; asm volatile("" : "+v"(l_)); F.lds = (LAS unsigned char*)(size_t)l_; }
#define SEAM(k) do { if (IN(k) && IN((k) + 1)) xcd_barrier(bar); } while (0)

    if (PHM(0) && IN(0)) for (int rep_ = 0; rep_ < NREP(0); ++rep_) { LAUNDER(); p0_prologue(F); } SEAM(0);
    if (PHM(1) && IN(1)) { LAUNDER(); p0b_mod_reduce(F); } SEAM(1);
    if (PHM(2) && IN(2)) { LAUNDER(); modulate_rows(F, 0, 0, MTOT); } SEAM(2);

#pragma unroll 1
    for (int l = 0; l < DEPTH; ++l) {
        const int pb = NPH_PRO + l * NPH_LAYER;
        const int mrows = (l + 1 < DEPTH) ? MTOT : NLAT;
        if (PHM(3) && IN(pb + 0)) for (int rep_ = 0; rep_ < NREP(3); ++rep_) { LAUNDER(); pg8::Gemm g{(const pg8::bf16_t*)(F.ws + WS_H), (const pg8::bf16_t*)(F.ws + WS_WIN) + (size_t)l * IN_PAD * D, MTOT, IN_PAD, D, D};
            pg8::StaticOrder S; S.init(MTOT, IN_PAD, F.G, bx_); pg8::EpiBf16<0> E{(pg8::bf16_t*)(F.ws + WS_P), IN_PAD, nullptr, 0, 0};
            pg8::gemm_phase<pg8::EpiBf16<0>, pg8::StaticOrder, false>(F.lds, g, S, E, nullptr, F.tid); }
        SEAM(pb + 0);
        if (PHM(4) && IN(pb + 1)) for (int rep_ = 0; rep_ < NREP(4); ++rep_) { LAUNDER(); for (int r2 = 0; r2 < NREP(12); ++r2) for (int u = F.vcu; u < NTILE * NH; u += F.G) lru_prep_unit(F, l, u >> 4, u & 15); asm volatile("" ::: "memory"); for (int r2 = 0; r2 < NREP(13); ++r2) for (int v = F.vcu; v < 2 * NTILE * NH; v += F.G) rwkv_chunk_prep(F, l, v >> 5, (v >> 1) & 15, v & 1); }
        SEAM(pb + 1);
        if (PHM(5) && IN(pb + 2)) for (int rep_ = 0; rep_ < NREP(5); ++rep_) { LAUNDER(); for (int u = F.vcu; u < 256; u += F.G) { if (u < 32 && F.wave >= 2 && F.wave < 4) lru_scan(F, u * 128 + F.tid - 128); rwkv_chain_chunks(F, u); } }
        SEAM(pb + 2);
        if (PHM(6) && IN(pb + 3)) for (int rep_ = 0; rep_ < NREP(6); ++rep_) { LAUNDER(); for (int u = F.vcu; u < 4 * NTILE; u += F.G) merge_unit(F, l, u); }
        SEAM(pb + 3);
        if (PHM(7) && IN(pb + 4)) for (int rep_ = 0; rep_ < NREP(7); ++rep_) { LAUNDER(); pg8::Gemm g{(const pg8::bf16_t*)(F.ws + WS_H), (const pg8::bf16_t*)(F.ws + WS_WOUT) + (size_t)l * D * D, mrows, D, D, D};
            pg8::StaticOrder S; S.init(mrows, D, F.G, bx_); pg8::EpiBf16<0> E{(pg8::bf16_t*)(F.ws + WS_O), D, nullptr, 0, 0};
            pg8::gemm_phase<pg8::EpiBf16<0>, pg8::StaticOrder, false>(F.lds, g, S, E, nullptr, F.tid); }
        SEAM(pb + 4);
        if (PHM(8) && IN(pb + 5)) { LAUNDER(); if (NREP(8) > 1) ln1_rows(F, l, mrows, true); ln1_rows(F, l, mrows); }
        SEAM(pb + 5);
        if (PHM(9) && IN(pb + 6)) for (int rep_ = 0; rep_ < NREP(9); ++rep_) { LAUNDER(); pg8::Gemm g{(const pg8::bf16_t*)(F.ws + WS_H), (const pg8::bf16_t*)(F.ws + WS_WQ) + (size_t)l * D * D, mrows, D, D, D};
            pg8::StaticOrder S; S.init(mrows, D, F.G, bx_); pg8::EpiBf16<0> E{(pg8::bf16_t*)(F.ws + WS_QP), D, nullptr, 0, 0};
            pg8::gemm_phase<pg8::EpiBf16<0>, pg8::StaticOrder, false>(F.lds, g, S, E, nullptr, F.tid); }
        SEAM(pb + 6);
        if (PHM(10) && IN(pb + 7)) for (int rep_ = 0; rep_ < NREP(10); ++rep_) { LAUNDER(); for (int u = F.vcu; u < (mrows / 64) * PE_H; u += F.G) peer_topk_unit(F, l, u >> 3, u & 7); }
        SEAM(pb + 7);
        if (PHM(11) && IN(pb + 8)) { LAUNDER(); if (NREP(11) > 1) peer_rows(F, l, mrows, true); peer_rows(F, l, mrows); }
        if (l + 1 < DEPTH) SEAM(pb + 8);
    }
#undef IN
#undef SEAM
}

extern "C" void kernel_launch(void* const* d_in, const int* in_sizes, int n_in, void* d_out, int out_size, void* d_ws, size_t ws_size, hipStream_t stream) {
    static int grid = 0;
    if (grid == 0) {
        if (n_in != N_IN || out_size != NLAT * D || ws_size < WS_END) { fprintf(stderr, "kernel_launch: unexpected shapes (n_in %d, out %d, ws %zu < %zu)\n", n_in, out_size, ws_size, (size_t)WS_END); grid = -1; return; }
        int dev = 0, cus = 0, per_cu = 0;
        if (hipGetDevice(&dev) != hipSuccess || hipDeviceGetAttribute(&cus, hipDeviceAttributeMultiprocessorCount, dev) != hipSuccess) { grid = -1; return; }
        if (hipFuncSetAttribute((const void*)trunk_fwd, hipFuncAttributeMaxDynamicSharedMemorySize, LDS_BYTES) != hipSuccess) { fprintf(stderr, "kernel_launch: hipFuncSetAttribute failed\n"); grid = -1; return; }
        if (hipOccupancyMaxActiveBlocksPerMultiprocessor(&per_cu, (const void*)trunk_fwd, NTHR, LDS_BYTES) != hipSuccess || per_cu < 1) fprintf(stderr, "kernel_launch: occupancy query reports %d\n", per_cu);
        (void)hipGetLastError();
        grid = cus;
    }
    if (grid < 0) return;
    (void)hipMemsetAsync((char*)d_ws + WS_CTL, 0, CTL_ZERO_BYTES, stream);
    Args a{};
    for (int i = 0; i < N_IN; ++i) a.in[i] = (const float*)d_in[i];
    a.out = (float*)d_out; a.ws = (unsigned char*)d_ws;
#if MK_PER_PHASE
    for (int ph = 0; ph < NPHASES; ++ph) { a.ph_lo = ph; a.ph_hi = ph + 1; hipLaunchKernelGGL(trunk_fwd, dim3(grid), dim3(NTHR), LDS_BYTES, stream, a); }
#else
    a.ph_lo = 0; a.ph_hi = NPHASES;
    hipLaunchKernelGGL(trunk_fwd, dim3(grid), dim3(NTHR), LDS_BYTES, stream, a);
#endif
    const hipError_t le = hipPeekAtLastError();
    if (le != hipSuccess) fprintf(stderr, "kernel_launch: launch failed: %s\n", hipGetErrorName(le));
}
```

```cpp
#include <hip/hip_runtime.h>
#include <cstdio>
#include <cstdint>

constexpr int D = 2048, NB = 2, SEQ = 4096, DEPTH = 4, CTXL = 256;
constexpr int NLAT = NB * SEQ, NCTX = NB * CTXL, MTOT = NLAT + NCTX;
constexpr int LRW = 1024, RWW = 1024, NH = 16, HD = 64;
constexpr int RW_COLS = 3488, IN_COLS = 5536, IN_PAD = 5632;
constexpr int PE_H = 8, PE_K = 128, PE_DQ = 256, PE_TOP = 16, PE_NE = 16384, PE_SEL = PE_H * PE_TOP;
constexpr int NTILE = MTOT / 64;
constexpr float ALPHA = 1.681792830507429f;
constexpr float LN_EPS = 1e-5f, GN_EPS = 64e-5f;
constexpr int KSPLIT = 16;

enum { I_X = 0, I_C, I_CTX, I_CCTX, I_ADAW, I_ADAB, I_WIN, I_CONVW, I_CONVB, I_WA, I_BA, I_WX, I_BX, I_LAM, I_MU, I_W0, I_W2, I_A0, I_A2, I_G2,
       I_KK, I_KA, I_RK, I_GNG, I_GNB, I_WOUT, I_LN1G, I_LN1B, I_WQ, I_SUBK, I_U, I_V, I_LN2G, I_LN2B, N_IN };

constexpr size_t MiB = 1u << 20;
constexpr size_t al(size_t x) { return (x + MiB - 1) / MiB * MiB; }
constexpr size_t WS_CTL = 0, CTL_ZERO_BYTES = 1 * MiB;
constexpr size_t WS_MOD   = WS_CTL + CTL_ZERO_BYTES;
constexpr size_t WS_MODP  = al(WS_MOD + (size_t)DEPTH * 3 * 6 * D * 4);
constexpr size_t WS_WIN   = al(WS_MODP + (size_t)KSPLIT * DEPTH * 3 * 6 * D * 4);
constexpr size_t WS_WOUT  = al(WS_WIN + (size_t)DEPTH * IN_PAD * D * 2);
constexpr size_t WS_WQ    = al(WS_WOUT + (size_t)DEPTH * D * D * 2);
constexpr size_t WS_SUBK  = al(WS_WQ + (size_t)DEPTH * D * D * 2);
constexpr size_t WS_WLRU  = al(WS_SUBK + (size_t)DEPTH * 8 * 2 * 128 * 128 * 2);
constexpr size_t WS_W2T   = al(WS_WLRU + (size_t)DEPTH * 2 * 2 * 16 * 64 * 64 * 2);
constexpr size_t WS_A2T   = al(WS_W2T + (size_t)DEPTH * 2 * 1024 * 64 * 2);
constexpr size_t WS_G2T   = al(WS_A2T + (size_t)DEPTH * 2 * 1024 * 64 * 2);
constexpr size_t WS_UB    = al(WS_G2T + (size_t)DEPTH * 1024 * 160 * 2);
constexpr size_t WS_VB    = al(WS_UB + (size_t)DEPTH * PE_NE * D);
constexpr size_t WS_SU    = al(WS_VB + (size_t)DEPTH * PE_NE * D);
constexpr size_t WS_SV    = al(WS_SU + (size_t)DEPTH * PE_NE * 4);
constexpr size_t WS_X     = al(WS_SV + (size_t)DEPTH * PE_NE * 4);
constexpr size_t WS_H     = al(WS_X + (size_t)MTOT * D * 4);
constexpr size_t WS_P     = al(WS_H + (size_t)MTOT * D * 2);
constexpr size_t WS_LA    = al(WS_P + (size_t)MTOT * IN_PAD * 4);
constexpr size_t WS_LB    = al(WS_LA + (size_t)2 * MTOT * LRW * 4);
constexpr size_t WS_LAGG  = al(WS_LB + (size_t)2 * MTOT * LRW * 4);
constexpr size_t WS_LHIN  = al(WS_LAGG + (size_t)4 * NTILE * LRW * 4);
constexpr int KSL = 8;
constexpr size_t WS_SLAB  = al(WS_LHIN + (size_t)2 * NTILE * LRW * 4);
constexpr size_t WS_YL    = al(WS_SLAB + (size_t)2 * KSL * NCTX * D * 4);
constexpr int NUNIT = NTILE * NH * 2;
constexpr size_t WS_RV    = al(WS_YL + 4096);
constexpr size_t WS_QM    = al(WS_RV + (size_t)MTOT * RWW * 4);
constexpr size_t WS_PHI   = al(WS_QM + (size_t)NUNIT * 4096 * 2);
constexpr size_t WS_Y0F   = al(WS_PHI + (size_t)NUNIT * 4096 * 2);
constexpr size_t WS_PSF   = al(WS_Y0F + (size_t)NUNIT * 4096 * 2);
constexpr size_t WS_YR    = al(WS_PSF + (size_t)NUNIT * 4096 * 2);
constexpr size_t WS_BETA  = al(WS_YR + (size_t)2 * MTOT * RWW * 4);
constexpr size_t WS_IDX   = al(WS_BETA + (size_t)2 * MTOT * NH * 4);
constexpr size_t WS_GATE  = al(WS_IDX + (size_t)MTOT * PE_SEL * 4);
constexpr size_t WS_END   = al(WS_GATE + (size_t)MTOT * PE_SEL * 4);
constexpr size_t WS_O = WS_P;
constexpr size_t WS_QP = WS_P + (size_t)MTOT * D * 4;
static_assert(WS_QP + (size_t)MTOT * D * 4 <= WS_LA, "O/QP overlay inside P");

constexpr int CW_BAR = 4096;

constexpr int RING_BYTES = 131072;
constexpr int LDSCTL_OFF = RING_BYTES, MISC_OFF = LDSCTL_OFF + 320;
constexpr int LDS_BYTES = 147456;
constexpr int NWAVES = 8, NTHR = 512;

#define GAS __attribute__((address_space(1)))
#define LAS __attribute__((address_space(3)))
typedef unsigned short bf16;
typedef unsigned v4u __attribute__((ext_vector_type(4)));
typedef unsigned v2u __attribute__((ext_vector_type(2)));
typedef float f32x4 __attribute__((ext_vector_type(4)));
typedef float f32x2 __attribute__((ext_vector_type(2)));
typedef short bf16x8 __attribute__((ext_vector_type(8)));
#define RLX_AGENT __ATOMIC_RELAXED, __HIP_MEMORY_SCOPE_AGENT
#define LDS_WAIT() asm volatile("s_waitcnt lgkmcnt(0)" ::: "memory")
#define VM_WAIT() asm volatile("s_waitcnt vmcnt(0)" ::: "memory")

__device__ __forceinline__ const float* gin(const float* p) { return (const float*)(const GAS float*)p; }
__device__ __forceinline__ unsigned f2bf(float f) { unsigned u = __builtin_bit_cast(unsigned, f); return (u + 0x7fffu + ((u >> 16) & 1u)) >> 16; }
typedef __bf16 bf16x2t __attribute__((ext_vector_type(2)));
__device__ __forceinline__ unsigned pk2(float lo, float hi) { return __builtin_bit_cast(unsigned, __builtin_convertvector((f32x2){lo, hi}, bf16x2t)); }
__device__ __forceinline__ float bf_lo(unsigned w) { return __builtin_bit_cast(float, w << 16); }
__device__ __forceinline__ float bf_hi(unsigned w) { return __builtin_bit_cast(float, w & 0xffff0000u); }
__device__ __forceinline__ float fexp(float x) { return __builtin_amdgcn_exp2f(x * 1.4426950408889634f); }
__device__ __forceinline__ float fsigmoid(float x) { return __builtin_amdgcn_rcpf(1.0f + fexp(-x)); }
__device__ __forceinline__ float fsoftplus(float x) { return fmaxf(x, 0.f) + 0.6931471805599453f * __builtin_amdgcn_logf(1.0f + fexp(-fabsf(x))); }
__device__ __forceinline__ float ftanh(float x) { const float e = fexp(2.0f * x); return 1.0f - 2.0f * __builtin_amdgcn_rcpf(e + 1.0f); }
__device__ __forceinline__ float gelu_tanh(float x) { return 0.5f * x * (1.0f + ftanh(0.7978845608028654f * (x + 0.044715f * x * x * x))); }
__device__ __forceinline__ float gelu_erf(float v) {
    const float av = fabsf(v), t = __builtin_amdgcn_rcpf(av * 0.2316418882f + 1.0f);
    float q = t * 0.5307027145f + (-0.7265760135f); q = q * t + 0.7107068705f; q = q * t + (-0.142248368f); q = q * t + 0.127414796f; q = q * t;
    const float e = __builtin_amdgcn_exp2f((v * v) * (-0.72134752044f));
    const float m = v * (q * e);
    return v < 0.f ? m : v - m;
}
template <int CTRL> __device__ __forceinline__ float dpp_f(float v) { return __builtin_bit_cast(float, __builtin_amdgcn_update_dpp(0, __builtin_bit_cast(int, v), CTRL, 0xf, 0xf, true)); }
__device__ __forceinline__ float red8(float v) { v += dpp_f<0xB1>(v); v += dpp_f<0x4E>(v); v += dpp_f<0x141>(v); return v; }
__device__ __forceinline__ float red16(float v) { v = red8(v); v += dpp_f<0x140>(v); return v; }
__device__ __forceinline__ float wave_total(float v) {
    v = red16(v);
    v += __builtin_bit_cast(float, __builtin_amdgcn_update_dpp(0, __builtin_bit_cast(int, v), 0x142, 0xa, 0xf, false));
    v += __builtin_bit_cast(float, __builtin_amdgcn_update_dpp(0, __builtin_bit_cast(int, v), 0x143, 0xc, 0xf, false));
    return __builtin_bit_cast(float, __builtin_amdgcn_readlane(__builtin_bit_cast(int, v), 63));
}
__device__ __forceinline__ float wave_sum(float v) { return wave_total(v); }
__device__ __forceinline__ float wave_max(float v) {
    v = fmaxf(v, dpp_f<0xB1>(v)); v = fmaxf(v, dpp_f<0x4E>(v)); v = fmaxf(v, dpp_f<0x141>(v)); v = fmaxf(v, dpp_f<0x140>(v));
    const float a = __builtin_bit_cast(float, __builtin_amdgcn_readlane(__builtin_bit_cast(int, v), 0)), b = __builtin_bit_cast(float, __builtin_amdgcn_readlane(__builtin_bit_cast(int, v), 16));
    const float c = __builtin_bit_cast(float, __builtin_amdgcn_readlane(__builtin_bit_cast(int, v), 32)), d = __builtin_bit_cast(float, __builtin_amdgcn_readlane(__builtin_bit_cast(int, v), 48));
    return fmaxf(fmaxf(a, b), fmaxf(c, d));
}

#define XB_TMO      128
#define XB_XCNT(j)  (256  + 64 * (j))
#define XB_XSUB(j)  (1280 + 64 * (j))
#define XB_XGEN(j)  (2304 + 64 * (j))
#define XB_TOP      3328
#define XB_TOPGEN   3392
#define XCD_BAR_WORDS 3456
#define XB_SPIN_CAP (1u << 18)

__device__ __forceinline__ unsigned xb_ld(unsigned* p)              { return __hip_atomic_load(p, __ATOMIC_RELAXED, __HIP_MEMORY_SCOPE_AGENT); }
__device__ __forceinline__ unsigned xb_add(unsigned* p, unsigned v) { return __hip_atomic_fetch_add(p, v, __ATOMIC_RELAXED, __HIP_MEMORY_SCOPE_AGENT); }
__device__ __forceinline__ unsigned xb_xcc_id() { return (unsigned)__builtin_amdgcn_s_getreg((3 << 11) | 20) & 0xFu; }
#define XB_SPIN(cond, bar) do { unsigned _sp = 0; while (cond) { __builtin_amdgcn_s_sleep(1); \
    if ((++_sp & 255u) == 0u) { if (xb_ld(&(bar)[XB_TMO])) break; if (_sp > XB_SPIN_CAP) { atomicAdd(&(bar)[XB_TMO], 1u); break; } } } } while (0)

struct XcdBarrier {
    unsigned* bar; unsigned x;
    volatile LAS unsigned* st;
};

__device__ __forceinline__ XcdBarrier xcd_barrier_post(unsigned* bar, volatile LAS unsigned* st) {
    XcdBarrier b; b.bar = bar; b.x = xb_xcc_id(); b.st = st;
    if (threadIdx.x == 0) (void)xb_add(&bar[XB_XCNT(b.x)], 1u);
    return b;
}
__device__ __forceinline__ void xcd_barrier_complete(unsigned* bar, unsigned x, unsigned& nloc, unsigned& nx) {
    const unsigned G = gridDim.x * gridDim.y * gridDim.z;
    unsigned sum, cnt, mine, sp = 0u;
    for (;;) {
        sum = 0u; cnt = 0u; mine = 0u;
#pragma unroll
        for (unsigned j = 0; j < 16; ++j) { const unsigned c = xb_ld(&bar[XB_XCNT(j)]); sum += c; cnt += (c > 0u) ? 1u : 0u; }
        if (sum == G) { mine = xb_ld(&bar[XB_XCNT(x)]); break; }
        __builtin_amdgcn_s_sleep(1);
        if ((++sp & 255u) == 0u) { if (xb_ld(&bar[XB_TMO])) break; if (sp > XB_SPIN_CAP) { atomicAdd(&bar[XB_TMO], 1u); break; } }
    }
    nloc = mine > 0u ? mine : 1u; nx = cnt > 0u ? cnt : 1u;
}

__device__ __forceinline__ void xcd_barrier(const XcdBarrier& b) {
    asm volatile("s_waitcnt vmcnt(0)" ::: "memory");
    __syncthreads();
    if (threadIdx.x == 0) {
        unsigned* bar = b.bar;
        __builtin_amdgcn_s_waitcnt(0);
        unsigned nloc = b.st[0], nx = b.st[1];
        if (nloc == 0u) { xcd_barrier_complete(bar, b.x, nloc, nx); b.st[0] = nloc; b.st[1] = nx; }
        const unsigned old = xb_add(&bar[XB_XSUB(b.x)], 1u);
        const unsigned gen = old / nloc;
        if (old + 1u == (gen + 1u) * nloc) {
            __builtin_amdgcn_fence(__ATOMIC_RELEASE, "agent");
            asm volatile("s_waitcnt vmcnt(0)" ::: "memory");
            const unsigned og = xb_add(&bar[XB_TOP], 1u);
            const unsigned tg = og / nx;
            if (og + 1u == (tg + 1u) * nx) xb_add(&bar[XB_TOPGEN], 1u);
            else XB_SPIN(xb_ld(&bar[XB_TOPGEN]) == tg, bar);
            __builtin_amdgcn_fence(__ATOMIC_ACQUIRE, "agent");
            xb_add(&bar[XB_XGEN(b.x)], 1u);
            asm volatile("s_waitcnt vmcnt(0)" ::: "memory");
        } else {
            XB_SPIN(xb_ld(&bar[XB_XGEN(b.x)]) == gen, bar);
            __builtin_amdgcn_fence(__ATOMIC_ACQUIRE, "agent");
            asm volatile("s_waitcnt vmcnt(0)" ::: "memory");
        }
    }
    __syncthreads();
}
namespace pg8 {
#define PG8_LAS __attribute__((address_space(3)))
typedef unsigned short bf16_t;
typedef short bf16x8 __attribute__((ext_vector_type(8)));
typedef float f32x4 __attribute__((ext_vector_type(4)));
typedef unsigned u32x4 __attribute__((ext_vector_type(4)));
constexpr int BM = 256, BK = 64, HALF = 128, HTB = HALF * BK * 2  , STAGE_BYTES = 8 * HTB, NXCD = 8, WGM = 8;

__host__ __device__ __forceinline__ int lds_byte(int r, int c) { const int st = (r >> 4) * 2 + (c >> 5), rr = r & 15, cc = c & 31, ob = rr * 64 + cc * 2; return st * 1024 + (ob ^ (((ob >> 9) & 1) << 5)); }
__host__ __device__ __forceinline__ void stage_rc(int b, int& R, int& C) { const int st = b / 1024, sb = b % 1024, swz = sb ^ (((sb >> 9) & 1) << 5); R = (st >> 1) * 16 + swz / 64; C = (st & 1) * 32 + (swz % 64) / 2; }
__host__ __device__ __forceinline__ int perm32(int rho) { const int n = rho >> 4, i = rho & 15; return 8 * (i >> 2) + 4 * n + (i & 3); }

struct Unit { int pm, pn, kofs = 0, slab = 0; };
struct Gemm { const bf16_t* A; const bf16_t* Bt; int M, N, K, ld; };

struct StaticOrder {
    int nM, nN, nwg, G, c;
    __host__ __device__ void init(int M, int N, int G_, int c_) { nM = M / BM; nN = N / BM; nwg = nM * nN; G = G_; c = c_; }
    __host__ __device__ bool next(int i, Unit& u) const {
        const long L = (long)i * G + c; if (L >= nwg) return false;
        int wgid = (int)L; { const int q = nwg / NXCD, r = nwg % NXCD, xcd = wgid % NXCD, off = wgid / NXCD; wgid = (xcd < r ? xcd * (q + 1) : r * (q + 1) + (xcd - r) * q) + off; }
        const int nig = WGM * nN, gid = wgid / nig, fm = gid * WGM, gsz = (nM - fm) < WGM ? (nM - fm) : WGM;
        u.pm = fm + ((wgid % nig) % gsz); u.pn = (wgid % nig) / gsz; return true;
    }
    __device__ __forceinline__ void a_ready(const Unit&) const {}
    __device__ __forceinline__ void done(const Unit&) const {}
};
struct SplitKOrder {
    int nM, nN, nS, klen, G, c;
    __host__ __device__ void init(int M, int N, int nS_, int klen_, int G_, int c_) { nM = M / BM; nN = N / BM; nS = nS_; klen = klen_; G = G_; c = c_; }
    __host__ __device__ bool next(int i, Unit& u) const { const long L = (long)i * G + c; if (L >= (long)nM * nN * nS) return false; const int l = (int)L; u.pm = l % nM; u.pn = (l / nM) % nN; const int ks = l / (nM * nN); u.kofs = ks * klen; u.slab = ks; return true; }
    __device__ __forceinline__ void a_ready(const Unit&) const {}
    __device__ __forceinline__ void done(const Unit&) const {}
};
struct CountedOrder : StaticOrder {
    const unsigned* ready; unsigned need; unsigned* tmo;
    __device__ __forceinline__ void a_ready(const Unit& u) const {
        if (threadIdx.x < 64) {
            const unsigned long long t0 = __builtin_amdgcn_s_memrealtime(); unsigned polls = 0;
            while ((unsigned)__builtin_amdgcn_readfirstlane(__hip_atomic_load(ready + 64 * u.pm, __ATOMIC_RELAXED, __HIP_MEMORY_SCOPE_AGENT)) < need) {
                if ((++polls & 255u) == 0u && __builtin_amdgcn_readfirstlane(__hip_atomic_load(tmo, __ATOMIC_RELAXED, __HIP_MEMORY_SCOPE_AGENT)) != 0u) break;
                if (__builtin_amdgcn_s_memrealtime() - t0 > 2000000ull) {
                    if (threadIdx.x == 0) { unsigned expect = 0u; __hip_atomic_compare_exchange_strong(tmo + 1, &expect, 0x600u | (unsigned)(u.pm & 0xff), __ATOMIC_RELAXED, __ATOMIC_RELAXED, __HIP_MEMORY_SCOPE_AGENT); __hip_atomic_store(tmo, 1u, __ATOMIC_RELAXED, __HIP_MEMORY_SCOPE_AGENT); }
                    break; }
                __builtin_amdgcn_s_sleep(2); }
            __builtin_amdgcn_fence(__ATOMIC_ACQUIRE, "agent");
            asm volatile("s_waitcnt vmcnt(0)" ::: "memory");
        }
#if !defined(BROKEN_HOOK_NO_BARRIER)
        asm volatile("" ::: "memory"); __builtin_amdgcn_s_barrier(); asm volatile("" ::: "memory");
#endif
    }
};

__device__ __forceinline__ unsigned cvt_pk_bf16(float lo, float hi) { unsigned r; asm volatile("v_cvt_pk_bf16_f32 %0, %1, %2" : "=v"(r) : "v"(lo), "v"(hi)); return r; }
typedef float f32x2 __attribute__((ext_vector_type(2)));
__device__ __forceinline__ f32x2 gelu_pk(f32x2 v) {
    const f32x2 av = __builtin_elementwise_abs(v), d = av * 0.2316418882f + 1.0f;
    f32x2 t; t.x = __builtin_amdgcn_rcpf(d.x); t.y = __builtin_amdgcn_rcpf(d.y);
    f32x2 q = t * 0.5307027145f + (-0.7265760135f); q = q * t + 0.7107068705f; q = q * t + (-0.142248368f); q = q * t + 0.127414796f; q = q * t;
    const f32x2 s = (v * v) * (-0.72134752044f);
    f32x2 e; e.x = __builtin_amdgcn_exp2f(s.x); e.y = __builtin_amdgcn_exp2f(s.y);
    const f32x2 m = v * (q * e), r = v - m;
    f32x2 o; o.x = v.x < 0.f ? m.x : r.x; o.y = v.y < 0.f ? m.y : r.y; return o;
}

struct EpiF32 {
    static constexpr bool PERM = false, AFTER_DRAIN = false;
    float* C; int ldc; const float* bias; size_t slab_stride = 0;
    __device__ __forceinline__ void operator()(const f32x4 (&acc)[2][2][4][2], const Unit& u, int wr, int wc, int fr, int fq) const {
        const int row0 = u.pm * BM + wr * 64 + fr, col0 = u.pn * BM + wc * 32 + 4 * fq; float* const Cb = C + (size_t)u.slab * slab_stride;
        f32x4 bv[2][2];
#pragma unroll
        for (int bj = 0; bj < 2; ++bj)
#pragma unroll
            for (int n = 0; n < 2; ++n) bv[bj][n] = bias ? *(const f32x4*)(bias + col0 + bj * HALF + n * 16) : (f32x4){0.f, 0.f, 0.f, 0.f};
#pragma unroll
        for (int ai = 0; ai < 2; ++ai)
#pragma unroll
            for (int m = 0; m < 4; ++m) { float* rowp = Cb + (size_t)(row0 + ai * HALF + m * 16) * ldc + col0;
#pragma unroll
                for (int bj = 0; bj < 2; ++bj)
#pragma unroll
                    for (int n = 0; n < 2; ++n) *(f32x4*)(rowp + bj * HALF + n * 16) = acc[ai][bj][m][n] + bv[bj][n]; }
    }
};
template <int ACT  > struct EpiBf16 {
    static constexpr bool PERM = true, AFTER_DRAIN = false;
    bf16_t* O; int ldc; const float* bias; int split_cols; size_t split_stride;
    __device__ __forceinline__ void operator()(const f32x4 (&acc)[2][2][4][2], const Unit& u, int wr, int wc, int fr, int fq) const {
        const int row0 = u.pm * BM + wr * 64 + fr; int colt = u.pn * BM; bf16_t* base = O;
        if (split_cols) { const int t = colt / split_cols; base += (size_t)t * split_stride; colt -= t * split_cols; }
        const int col0 = colt + wc * 32 + 8 * fq, bcol0 = u.pn * BM + wc * 32 + 8 * fq;
        f32x4 bv[2][2];
#pragma unroll
        for (int bj = 0; bj < 2; ++bj)
#pragma unroll
            for (int n = 0; n < 2; ++n) bv[bj][n] = bias ? *(const f32x4*)(bias + bcol0 + bj * HALF + 4 * n) : (f32x4){0.f, 0.f, 0.f, 0.f};
#pragma unroll
        for (int ai = 0; ai < 2; ++ai)
#pragma unroll
            for (int m = 0; m < 4; ++m) { bf16_t* rowp = base + (size_t)(row0 + ai * HALF + m * 16) * ldc + col0;
#pragma unroll
                for (int bj = 0; bj < 2; ++bj) { f32x4 v0 = acc[ai][bj][m][0] + bv[bj][0], v1 = acc[ai][bj][m][1] + bv[bj][1];
                    if (ACT == 1) { f32x2 a = gelu_pk((f32x2){v0[0], v0[1]}), b = gelu_pk((f32x2){v0[2], v0[3]}), c = gelu_pk((f32x2){v1[0], v1[1]}), d = gelu_pk((f32x2){v1[2], v1[3]});
                        v0 = (f32x4){a.x, a.y, b.x, b.y}; v1 = (f32x4){c.x, c.y, d.x, d.y}; }
                    if (ACT == 2) {
#pragma unroll
                        for (int j = 0; j < 4; ++j) { v0[j] = 0.5f * v0[j] * (1.0f + erff(v0[j] * 0.70710678f)); v1[j] = 0.5f * v1[j] * (1.0f + erff(v1[j] * 0.70710678f)); } }
                    u32x4 w; w.x = cvt_pk_bf16(v0[0], v0[1]); w.y = cvt_pk_bf16(v0[2], v0[3]); w.z = cvt_pk_bf16(v1[0], v1[1]); w.w = cvt_pk_bf16(v1[2], v1[3]);
                    *(u32x4*)(rowp + bj * HALF) = w; } }
    }
};
template <class Epi, class Sched, bool STAMP = false>
__device__ __forceinline__ void gemm_phase(PG8_LAS unsigned char* lds, const Gemm g, const Sched& S, const Epi& E, unsigned long long* stamps, const int tid) {
    const int  wid = __builtin_amdgcn_readfirstlane(tid >> 6), lane = tid & 63, wr = wid >> 2, wc = wid & 3, fr = lane & 15, fq = lane >> 4;
    const int K = g.ld, nt = g.K / BK;
    int ts_lo = 0, ts_hi = 0, nts = 0; const unsigned long long rt_entry = STAMP ? (unsigned long long)wall_clock64() : 0ull;
#define PG8_STAMP() do { if (STAMP && wid == 0 && nts < 64) { const unsigned long long _c = (unsigned long long)clock64(); \
        ts_lo = (lane == nts) ? (int)(unsigned)_c : ts_lo; ts_hi = (lane == nts) ? (int)(unsigned)(_c >> 32) : ts_hi; ++nts; } } while (0)
    PG8_STAMP();
    unsigned voffA[2], voffB[2];
#pragma unroll
    for (int i = 0; i < 2; ++i) { int R, C; stage_rc(tid * 16 + i * 8192, R, C); const int Rb = Epi::PERM ? ((R & ~31) + perm32(R & 31)) : R;
        voffA[i] = (unsigned)(R * K + C) * 2u; voffB[i] = (unsigned)(Rb * K + C) * 2u; }
    const size_t kstep = (size_t)(BK * 2);
    const size_t hstep = (size_t)HALF * K * 2;
    const size_t tstep = 2 * hstep;
    const unsigned ldsw = (unsigned)wid * 1024u;
    const int aoff = lds_byte(wr * 64 + fr, fq * 8), boff = lds_byte(wc * 32 + fr, fq * 8);
#define PG8_SA(b, h) (((b) * 2 + (h)) * HTB)
#define PG8_SB(b, h) ((4 + (b) * 2 + (h)) * HTB)
#define PG8_STAGE(bufoff, gbase, voff) do { _Pragma("unroll") for (int _i = 0; _i < 2; ++_i) \
        __builtin_amdgcn_global_load_lds((const unsigned*)((const char*)(gbase) + (voff)[_i]), (PG8_LAS unsigned*)(lds + (bufoff) + ldsw + _i * 8192), 16, 0, 0); } while (0)
#define PG8_LDA(dst, b, h) do { _Pragma("unroll") for (int m = 0; m < 4; ++m) _Pragma("unroll") for (int k = 0; k < 2; ++k) dst[m][k] = *(const PG8_LAS bf16x8*)(lds + PG8_SA(b, h) + aoff + m * 2048 + k * 1024); } while (0)
#define PG8_LDB(dst, b, h) do { _Pragma("unroll") for (int n = 0; n < 2; ++n) _Pragma("unroll") for (int k = 0; k < 2; ++k) dst[n][k] = *(const PG8_LAS bf16x8*)(lds + PG8_SB(b, h) + boff + n * 2048 + k * 1024); } while (0)
#define PG8_MMA(ai, bj, At, Bt) do { __builtin_amdgcn_s_setprio(1); _Pragma("unroll") for (int m = 0; m < 4; ++m) _Pragma("unroll") for (int n = 0; n < 2; ++n) _Pragma("unroll") for (int k = 0; k < 2; ++k) \
        acc[ai][bj][m][n] = __builtin_amdgcn_mfma_f32_16x16x32_bf16(Bt[n][k], At[m][k], acc[ai][bj][m][n], 0, 0, 0); __builtin_amdgcn_s_setprio(0); } while (0)
#define PG8_WAIT_V(n) asm volatile("s_waitcnt vmcnt(" #n ")" ::: "memory")
#define PG8_WAIT_L(n) asm volatile("s_waitcnt lgkmcnt(" #n ")" ::: "memory")
#define PG8_BAR __builtin_amdgcn_s_barrier()
#define PG8_SCHED __builtin_amdgcn_sched_barrier(0)
    Unit cur, nxt; int ui = 0;
    if (!S.next(0, cur)) return;
    f32x4 acc[2][2][4][2];
#pragma unroll
    for (int a = 0; a < 2; ++a)
#pragma unroll
        for (int b = 0; b < 2; ++b)
#pragma unroll
            for (int m = 0; m < 4; ++m)
#pragma unroll
                for (int n = 0; n < 2; ++n) acc[a][b][m][n] = (f32x4){0.f, 0.f, 0.f, 0.f};
    bf16x8 At[4][2], B0[2][2], B1[2][2];
    const char* cA = (const char*)g.A + (size_t)cur.pm * tstep + (size_t)cur.kofs * 2; const char* cB = (const char*)g.Bt + (size_t)cur.pn * tstep + (size_t)cur.kofs * 2;
    S.a_ready(cur);
    PG8_STAGE(PG8_SB(0, 0), cB, voffB); PG8_STAGE(PG8_SA(0, 0), cA, voffA); PG8_STAGE(PG8_SB(0, 1), cB + hstep, voffB); PG8_STAGE(PG8_SA(0, 1), cA + hstep, voffA);
    if (wr == 1) PG8_BAR;
    PG8_WAIT_V(4); PG8_BAR;
    PG8_STAGE(PG8_SB(1, 0), cB + kstep, voffB); PG8_STAGE(PG8_SA(1, 0), cA + kstep, voffA); PG8_STAGE(PG8_SB(1, 1), cB + hstep + kstep, voffB);
    PG8_WAIT_V(6); PG8_BAR;
    PG8_STAMP();
    for (;;) {
        const bool has_next = S.next(ui + 1, nxt);
        const char* nA = has_next ? (const char*)g.A + (size_t)nxt.pm * tstep + (size_t)nxt.kofs * 2 : cA; const char* nB = has_next ? (const char*)g.Bt + (size_t)nxt.pn * tstep + (size_t)nxt.kofs * 2 : cB;
        for (int t = 0; t < nt; t += 2) {
            const bool last = (t == nt - 2);
            const char* a1 = cA + (size_t)(t + 1) * kstep;
            const char* a2 = last ? nA : cA + (size_t)(t + 2) * kstep; const char* b2 = last ? nB : cB + (size_t)(t + 2) * kstep;
            const char* a3 = a2 + kstep; const char* b3 = b2 + kstep;
            if (last && has_next) S.a_ready(nxt);
            PG8_LDB(B0, 0, 0); PG8_SCHED; PG8_LDA(At, 0, 0); PG8_STAGE(PG8_SA(1, 1), a1 + hstep, voffA);
            PG8_WAIT_L(8); PG8_BAR; PG8_WAIT_L(0); PG8_MMA(0, 0, At, B0); PG8_BAR; PG8_SCHED;
            PG8_LDB(B1, 0, 1); PG8_STAGE(PG8_SB(0, 0), b2, voffB);
            PG8_BAR; PG8_WAIT_L(0); PG8_MMA(0, 1, At, B1); PG8_BAR;
            PG8_LDA(At, 0, 1); PG8_STAGE(PG8_SA(0, 0), a2, voffA);
            PG8_BAR; PG8_WAIT_L(0); PG8_MMA(1, 0, At, B0); PG8_BAR; PG8_SCHED;
            PG8_STAGE(PG8_SB(0, 1), b2 + hstep, voffB);
            PG8_WAIT_V(6); PG8_BAR; PG8_MMA(1, 1, At, B1); PG8_BAR;
            PG8_LDB(B0, 1, 0); PG8_SCHED; PG8_LDA(At, 1, 0); PG8_STAGE(PG8_SA(0, 1), a2 + hstep, voffA);
            PG8_WAIT_L(8); PG8_BAR; PG8_WAIT_L(0); PG8_MMA(0, 0, At, B0); PG8_BAR; PG8_SCHED;
            PG8_LDB(B1, 1, 1); PG8_STAGE(PG8_SB(1, 0), b3, voffB);
            PG8_BAR; PG8_WAIT_L(0); PG8_MMA(0, 1, At, B1); PG8_BAR;
            PG8_LDA(At, 1, 1); PG8_STAGE(PG8_SA(1, 0), a3, voffA);
            PG8_BAR; PG8_WAIT_L(0); PG8_MMA(1, 0, At, B0); PG8_BAR; PG8_SCHED;
            PG8_STAGE(PG8_SB(1, 1), b3 + hstep, voffB);
            PG8_WAIT_V(6); PG8_BAR; PG8_MMA(1, 1, At, B1); PG8_BAR;
        }
        PG8_STAMP();
        if constexpr (!Epi::AFTER_DRAIN) { E(acc, cur, wr, wc, fr, fq); S.done(cur); }
        PG8_STAMP();
        if (!has_next) break;
#pragma unroll
        for (int a = 0; a < 2; ++a)
#pragma unroll
            for (int b = 0; b < 2; ++b)
#pragma unroll
                for (int m = 0; m < 4; ++m)
#pragma unroll
                    for (int n = 0; n < 2; ++n) acc[a][b][m][n] = (f32x4){0.f, 0.f, 0.f, 0.f};
        cur = nxt; cA = nA; cB = nB; ++ui;
    }
    PG8_WAIT_V(0);
    if (wr == 0) PG8_BAR;
    PG8_BAR;
    if constexpr (Epi::AFTER_DRAIN) { E.fused(acc, cur, wr, wc, fr, fq, lds, wid, lane); S.done(cur); }
    PG8_STAMP();
    if (STAMP && wid == 0) { stamps[lane] = lane < nts ? (((unsigned long long)(unsigned)ts_hi << 32) | (unsigned)ts_lo) : 0ull;
        if (lane == 62) stamps[62] = rt_entry; if (lane == 63) stamps[63] = (unsigned long long)wall_clock64(); }
#undef PG8_STAMP
#undef PG8_SA
#undef PG8_SB
#undef PG8_STAGE
#undef PG8_LDA
#undef PG8_LDB
#undef PG8_MMA
#undef PG8_WAIT_V
#undef PG8_WAIT_L
#undef PG8_BAR
#undef PG8_SCHED
}
}
struct Args { const float* in[N_IN]; float* out; unsigned char* ws; int ph_lo, ph_hi; };
struct Frame {
    LAS unsigned char* lds;
    int tid, lane, wave, vcu, G;
    const float* const* in; GAS float* out; GAS unsigned char* ws;
};
using bf16x2v = __attribute__((ext_vector_type(2))) __bf16;
__device__ __forceinline__ float dot2bf(unsigned a, unsigned b, float acc) { return __builtin_amdgcn_fdot2_f32_bf16(__builtin_bit_cast(bf16x2v, a), __builtin_bit_cast(bf16x2v, b), acc, false); }

__device__ __forceinline__ void ld8bf(const bf16* p, float (&o)[8]) { const v4u w = *(const v4u*)p; o[0] = bf_lo(w.x); o[1] = bf_hi(w.x); o[2] = bf_lo(w.y); o[3] = bf_hi(w.y); o[4] = bf_lo(w.z); o[5] = bf_hi(w.z); o[6] = bf_lo(w.w); o[7] = bf_hi(w.w); }
struct TileInfo { int seq_base, seq_len, t0; };
__device__ __forceinline__ TileInfo tile_info(int c) {
    TileInfo ti;
    if (c < 128) { ti.seq_base = (c >> 6) * SEQ; ti.seq_len = SEQ; ti.t0 = (c & 63) * 64; }
    else { const int cc = c - 128; ti.seq_base = NLAT + (cc >> 2) * CTXL; ti.seq_len = CTXL; ti.t0 = (cc & 3) * 64; }
    return ti;
}
__device__ __forceinline__ int mod_row(int row) { return row < NLAT ? (row >> 12) : 2; }
__device__ __forceinline__ bf16x8 frag_lds(const LAS bf16* base, int ld, int row0, int k0, int lane) { return *(const LAS bf16x8*)(base + (row0 + (lane & 15)) * ld + k0 + 8 * (lane >> 4)); }
__device__ __forceinline__ bf16x8 frag_g(const bf16* base, int ld, int row0, int k0, int lane) { return *(const bf16x8*)(base + (size_t)(row0 + (lane & 15)) * ld + k0 + 8 * (lane >> 4)); }
#define MFMA16(a, b, c) __builtin_amdgcn_mfma_f32_16x16x32_bf16((a), (b), (c), 0, 0, 0)

__device__ __forceinline__ void p0_transpose_item(const float* W, int K, int N, bf16* WT, LAS float* scr, int item, int lane) {
    const int nblk = N / 32, kb = item / nblk, nb = item % nblk, k0 = 64 * kb, n0 = 32 * nb;
#pragma unroll 8
    for (int i = 0; i < 32; ++i) { const int kk = 2 * i + (lane >> 5); scr[kk * 33 + (lane & 31)] = W[(size_t)(k0 + kk) * N + n0 + (lane & 31)]; }
    LDS_WAIT(); asm volatile("" ::: "memory");
    const int c = lane & 7;
#pragma unroll
    for (int j = 0; j < 4; ++j) { const int n = (lane >> 3) + 8 * j; const LAS float* s = scr + (8 * c) * 33 + n;
        v4u o; o.x = pk2(s[0 * 33], s[1 * 33]); o.y = pk2(s[2 * 33], s[3 * 33]); o.z = pk2(s[4 * 33], s[5 * 33]); o.w = pk2(s[6 * 33], s[7 * 33]);
        *(v4u*)(WT + (size_t)(n0 + n) * K + k0 + 8 * c) = o; }
    LDS_WAIT(); asm volatile("" ::: "memory");
}
__device__ __forceinline__ void conv_f32_bf16(const float* src, bf16* dst, size_t n8, size_t i0, size_t stride) {
    for (size_t i = i0; i < n8; i += stride) { const f32x4 a = *(const f32x4*)(src + i * 8), b = *(const f32x4*)(src + i * 8 + 4);
        v4u o; o.x = pk2(a.x, a.y); o.y = pk2(a.z, a.w); o.z = pk2(b.x, b.y); o.w = pk2(b.z, b.w); *(v4u*)(dst + i * 8) = o; }
}
__device__ __forceinline__ void convert_layer(Frame& F, int l, int w, int NW, LAS float* scr) {
    constexpr int IT_IN = (D / 64) * (IN_COLS / 32), IT_SQ = (D / 64) * (D / 32);
    for (int it = w; it < IT_IN + 2 * IT_SQ; it += NW) {
        int r = it;
        if (r < IT_IN) { p0_transpose_item(gin(F.in[I_WIN]) + (size_t)l * D * IN_COLS, D, IN_COLS, (bf16*)(F.ws + WS_WIN) + (size_t)l * IN_PAD * D, scr, r, F.lane); continue; }
        r -= IT_IN;
        if (r < IT_SQ) { p0_transpose_item(gin(F.in[I_WOUT]) + (size_t)l * D * D, D, D, (bf16*)(F.ws + WS_WOUT) + (size_t)l * D * D, scr, r, F.lane); continue; }
        r -= IT_SQ;
        p0_transpose_item(gin(F.in[I_WQ]) + (size_t)l * D * D, D, D, (bf16*)(F.ws + WS_WQ) + (size_t)l * D * D, scr, r, F.lane);
    }
    { constexpr int PADV = (IN_PAD - IN_COLS) * D / 8;
      for (int i = w * 64 + F.lane; i < PADV; i += NW * 64) *(v4u*)((bf16*)(F.ws + WS_WIN) + ((size_t)l * IN_PAD + IN_COLS) * D + (size_t)i * 8) = (v4u){0u, 0u, 0u, 0u}; }
    for (int it = w; it < 2 * PE_NE; it += NW) {
        const int tab = it >= PE_NE, r = l * PE_NE + (tab ? it - PE_NE : it); const float* src = gin(F.in[tab ? I_V : I_U]) + (size_t)r * D + F.lane * 4;
        f32x4 x[8]; float mx = 0.f;
#pragma unroll
        for (int i = 0; i < 8; ++i) { x[i] = *(const f32x4*)(src + i * 256); mx = fmaxf(mx, fmaxf(fmaxf(fabsf(x[i].x), fabsf(x[i].y)), fmaxf(fabsf(x[i].z), fabsf(x[i].w)))); }
        mx = wave_max(mx); const float sc = mx > 0.f ? mx * (1.0f / 448.0f) : 1.0f, inv = 1.0f / sc;
        unsigned* dst = (unsigned*)(F.ws + (tab ? WS_VB : WS_UB) + (size_t)r * D) + F.lane;
#pragma unroll
        for (int i = 0; i < 8; ++i) { int q = __builtin_amdgcn_cvt_pk_fp8_f32(x[i].x * inv, x[i].y * inv, 0, false); q = __builtin_amdgcn_cvt_pk_fp8_f32(x[i].z * inv, x[i].w * inv, q, true); dst[i * 64] = (unsigned)q; }
        if (F.lane == 0) ((float*)(F.ws + (tab ? WS_SV : WS_SU)))[r] = sc;
    }
}
__device__ __forceinline__ void p0_prologue(Frame& F) {
    LAS float* scr = (LAS float*)(F.lds + F.wave * 16384);
    const int gw = F.vcu * NWAVES + F.wave, NGW = F.G * NWAVES;
    const size_t gt = (size_t)F.vcu * NTHR + F.tid, NGT = (size_t)F.G * NTHR;
    for (int l = 0; l < DEPTH; ++l) convert_layer(F, l, gw, NGW, scr);
    { bf16* dst = (bf16*)(F.ws + WS_WLRU);
      for (size_t idx = gt; idx < (size_t)DEPTH * 2 * 2 * 16 * 64 * 64; idx += NGT) { const int i = (int)(idx & 63), j = (int)((idx >> 6) & 63), m = (int)(idx >> 12);
          const int hh = m & 15, d = (m >> 4) & 1, gate = (m >> 5) & 1, l = m >> 6; const float* src = gin(F.in[gate ? I_WX : I_WA]);
          dst[idx] = (bf16)f2bf(src[((size_t)((l * 2 + d) * 16 + hh) * 64 + i) * 64 + j]); } }
    { bf16* d2 = (bf16*)(F.ws + WS_W2T); bf16* da = (bf16*)(F.ws + WS_A2T);
      for (size_t idx = gt; idx < (size_t)DEPTH * 2 * 1024 * 64; idx += NGT) { const int k = (int)(idx & 63), c = (int)((idx >> 6) & 1023), ld = (int)(idx >> 16);
          d2[idx] = (bf16)f2bf(gin(F.in[I_W2])[((size_t)ld * 64 + k) * 1024 + c]); da[idx] = (bf16)f2bf(gin(F.in[I_A2])[((size_t)ld * 64 + k) * 1024 + c]); } }
    { bf16* dg = (bf16*)(F.ws + WS_G2T);
      for (size_t idx = gt; idx < (size_t)DEPTH * 1024 * 160; idx += NGT) { const int k = (int)(idx % 160), c = (int)((idx / 160) % 1024), l = (int)(idx / (160 * 1024));
          dg[idx] = (bf16)f2bf(gin(F.in[I_G2])[((size_t)l * 160 + k) * 1024 + c]); } }
    conv_f32_bf16(gin(F.in[I_SUBK]), (bf16*)(F.ws + WS_SUBK), (size_t)DEPTH * 8 * 2 * 128 * 128 / 8, gt, NGT);
    { float* X = (float*)(F.ws + WS_X);
      for (size_t i0 = gt; i0 < (size_t)MTOT * D / 4; i0 += 4 * NGT) { f32x4 v[4];
#pragma unroll
          for (int u = 0; u < 4; ++u) { const size_t i = i0 + (size_t)u * NGT; const int row = (int)(i / (D / 4)), e0 = (int)(i % (D / 4)) * 4;
              v[u] = i < (size_t)MTOT * D / 4 ? (row < NLAT ? *(const f32x4*)(gin(F.in[I_X]) + (size_t)row * D + e0) : *(const f32x4*)(gin(F.in[I_CTX]) + (size_t)(row - NLAT) * D + e0)) : (f32x4){0.f, 0.f, 0.f, 0.f}; }
#pragma unroll
          for (int u = 0; u < 4; ++u) { const size_t i = i0 + (size_t)u * NGT; if (i >= (size_t)MTOT * D / 4) continue; const int row = (int)(i / (D / 4)), e0 = (int)(i % (D / 4)) * 4;
              if (row < NLAT) { const int t = row & (SEQ - 1); const float pr = (float)(t >> 6), pc = (float)(t & 63); float o[4];
#pragma unroll
                  for (int j = 0; j < 4; ++j) { const int e = e0 + j, q = e >> 9, fi = e & 511; const float freq = __builtin_amdgcn_exp2f(-13.287712379549449f * (float)fi * (1.0f / 512.0f));
                      const float ang = ((q >> 1) ? pc : pr) * freq; float rev = ang * 0.15915494309189535f; rev -= floorf(rev);
                      o[j] = (q & 1) ? __builtin_amdgcn_cosf(rev) : __builtin_amdgcn_sinf(rev); }
                  v[u].x += o[0]; v[u].y += o[1]; v[u].z += o[2]; v[u].w += o[3]; }
              *(f32x4*)(X + (size_t)row * D + e0) = v[u]; } } }
    { float* MODP = (float*)(F.ws + WS_MODP); const float* cin = gin(F.in[I_C]); const float* cctx = gin(F.in[I_CCTX]);
      for (int it = gw; it < DEPTH * KSPLIT * 48; it += NGW) { const int cg = it % 48, kp = (it / 48) % KSPLIT, l = it / (48 * KSPLIT); const int col = cg * 256 + F.lane * 4, k0 = kp * (D / KSPLIT);
          f32x4 a0 = {0.f, 0.f, 0.f, 0.f}, a1 = a0, a2 = a0; const float* wp = gin(F.in[I_ADAW]) + ((size_t)l * D + k0) * (6 * D) + col;
#pragma unroll 8
          for (int k = 0; k < D / KSPLIT; ++k) { const f32x4 w = *(const f32x4*)(wp + (size_t)k * (6 * D)); const float c0 = cin[k0 + k], c1 = cin[D + k0 + k], c2 = cctx[k0 + k];
              const float s0 = c0 * fsigmoid(c0), s1 = c1 * fsigmoid(c1), s2 = c2 * fsigmoid(c2); a0 += w * s0; a1 += w * s1; a2 += w * s2; }
          float* o = MODP + ((size_t)(kp * DEPTH + l) * 3) * (6 * D) + col; *(f32x4*)o = a0; *(f32x4*)(o + 6 * D) = a1; *(f32x4*)(o + 12 * D) = a2; } }
}
__device__ __forceinline__ void p0b_mod_reduce(Frame& F) {
    const size_t gt = (size_t)F.vcu * NTHR + F.tid, NGT = (size_t)F.G * NTHR; const float* MODP = (const float*)(F.ws + WS_MODP); float* MOD = (float*)(F.ws + WS_MOD);
    for (size_t i = gt; i < (size_t)DEPTH * 3 * 6 * D; i += NGT) { const int n = (int)(i % (6 * D)), l = (int)(i / (3 * 6 * D)); float s = gin(F.in[I_ADAB])[(size_t)l * 6 * D + n];
#pragma unroll
        for (int kp = 0; kp < KSPLIT; ++kp) s += MODP[(size_t)kp * DEPTH * 3 * 6 * D + i];
        MOD[i] = s; }
}
__device__ __forceinline__ void modulate_rows(Frame& F, int l, int which, int nrows) {
    const int gw = F.vcu * NWAVES + F.wave, NGW = F.G * NWAVES; const float* X = (const float*)(F.ws + WS_X); bf16* H = (bf16*)(F.ws + WS_H);
    for (int row = gw; row < nrows; row += NGW) { const float* md = (const float*)(F.ws + WS_MOD) + ((size_t)l * 3 + mod_row(row)) * (6 * D) + which * 3 * D;
#pragma unroll
        for (int j = 0; j < 4; ++j) { const int e = j * 512 + F.lane * 8; const f32x4 x0 = *(const f32x4*)(X + (size_t)row * D + e), x1 = *(const f32x4*)(X + (size_t)row * D + e + 4);
            const f32x4 s0 = *(const f32x4*)(md + e), s1 = *(const f32x4*)(md + e + 4), c0 = *(const f32x4*)(md + D + e), c1 = *(const f32x4*)(md + D + e + 4);
            const f32x4 y0 = x0 * (c0 + 1.0f) + s0, y1 = x1 * (c1 + 1.0f) + s1;
            v4u o; o.x = pk2(y0.x, y0.y); o.y = pk2(y0.z, y0.w); o.z = pk2(y1.x, y1.y); o.w = pk2(y1.z, y1.w); *(v4u*)(H + (size_t)row * D + e) = o; } }
}

__device__ __forceinline__ void lru_prep_unit(Frame& F, int l, int c, int hh) {
    int tid = F.tid; asm volatile("" : "+v"(tid));
    const int lane = tid & 63, wave = F.wave;
    const TileInfo ti = tile_info(c); const bf16* P = (const bf16*)(F.ws + WS_P);
    LAS float* Us = (LAS float*)F.lds; LAS float* XC = (LAS float*)(F.lds + 17408); LAS bf16* XCb = (LAS bf16*)(F.lds + 34304);
    LAS float* LAs = (LAS float*)(F.lds + 43520); LAS float* LBs = (LAS float*)(F.lds + 76288); LAS float* SEGA = (LAS float*)(F.lds + 109056); LAS float* SEGH = SEGA + 512;
    for (int idx = tid; idx < 67 * 64; idx += NTHR) { const int r = idx >> 6, ch = idx & 63, t = ti.t0 - 2 + r;
        Us[idx] = (t >= 0 && t < ti.seq_len) ? __builtin_bit_cast(float, (unsigned)P[(size_t)(ti.seq_base + t) * IN_PAD + hh * 64 + ch] << 16) : 0.f; }
    __syncthreads();
    { const float* cw = gin(F.in[I_CONVW]) + (size_t)l * 4 * LRW; const float* cb = gin(F.in[I_CONVB]) + (size_t)l * LRW;
      for (int idx = tid; idx < 64 * 64; idx += NTHR) { const int t = idx >> 6, ch = idx & 63, cg = hh * 64 + ch;
          float v = cb[cg];
#pragma unroll
          for (int tap = 0; tap < 4; ++tap) v += cw[tap * LRW + cg] * Us[(t + tap) * 64 + ch];
          XC[t * 65 + ch] = v; XCb[t * 72 + ch] = (bf16)f2bf(v); } }
    __syncthreads();
    { const int d = wave >> 2, m = wave & 3;
      const bf16x8 a0 = frag_lds(XCb, 72, 16 * m, 0, lane), a1 = frag_lds(XCb, 72, 16 * m, 32, lane);
      const bf16* Wa = (const bf16*)(F.ws + WS_WLRU) + (size_t)(((l * 2 + 0) * 2 + d) * 16 + hh) * 4096;
      const bf16* Wx = (const bf16*)(F.ws + WS_WLRU) + (size_t)(((l * 2 + 1) * 2 + d) * 16 + hh) * 4096;
#pragma unroll
      for (int n = 0; n < 4; ++n) {
          f32x4 ar = {0.f, 0.f, 0.f, 0.f}, ai = ar;
          ar = MFMA16(a0, frag_g(Wa, 64, 16 * n, 0, lane), ar); ar = MFMA16(a1, frag_g(Wa, 64, 16 * n, 32, lane), ar);
          ai = MFMA16(a0, frag_g(Wx, 64, 16 * n, 0, lane), ai); ai = MFMA16(a1, frag_g(Wx, 64, 16 * n, 32, lane), ai);
          const int col = 16 * n + (lane & 15), cg = hh * 64 + col;
          const float ba = gin(F.in[I_BA])[(size_t)(l * 2 + d) * LRW + cg], bx = gin(F.in[I_BX])[(size_t)(l * 2 + d) * LRW + cg];
          const float sp = fsoftplus(-gin(F.in[I_LAM])[(size_t)(l * 2 + d) * LRW + cg]);
#pragma unroll
          for (int r = 0; r < 4; ++r) { const int row = 16 * m + 4 * (lane >> 4) + r;
              const float rr = fsigmoid(ar[r] + ba), ii = fsigmoid(ai[r] + bx), loga = -8.0f * rr * sp, a = fexp(loga);
              const float bb = __builtin_amdgcn_sqrtf(fmaxf(1.0f - a * a, 0.f)) * ii * XC[row * 65 + col];
              LAs[(d * 64 + row) * 64 + col] = a; LBs[(d * 64 + row) * 64 + col] = bb; } } }
    __syncthreads();
    { const int col = tid & 63, seg = (tid >> 6) & 3, d = tid >> 8, cg = hh * 64 + col; float hl[16], al[16]; float h = 0.f, A = 1.f;
#pragma unroll
      for (int i = 0; i < 16; ++i) { const int tau = 16 * seg + i, row = d ? 63 - tau : tau; const float a = LAs[(d * 64 + row) * 64 + col], b = LBs[(d * 64 + row) * 64 + col]; h = a * h + b; A *= a; hl[i] = h; al[i] = A; }
      SEGA[(d * 4 + seg) * 64 + col] = A; SEGH[(d * 4 + seg) * 64 + col] = h;
      __syncthreads();
      float Hin = 0.f, Ain = 1.f;
#pragma unroll
      for (int s2 = 0; s2 < 3; ++s2) if (s2 < seg) { const float sa = SEGA[(d * 4 + s2) * 64 + col]; Hin = sa * Hin + SEGH[(d * 4 + s2) * 64 + col]; Ain *= sa; }
      bf16* HL = (bf16*)(F.ws + WS_LB) + (size_t)d * MTOT * LRW; bf16* AC = (bf16*)(F.ws + WS_LA) + (size_t)d * MTOT * LRW;
#pragma unroll
      for (int i = 0; i < 16; ++i) { const int tau = 16 * seg + i, row = d ? 63 - tau : tau; const size_t o = (size_t)(ti.seq_base + ti.t0 + row) * LRW + cg; HL[o] = (bf16)f2bf(hl[i] + al[i] * Hin); AC[o] = (bf16)f2bf(al[i] * Ain); }
      if (seg == 3) { float* AG = (float*)(F.ws + WS_LAGG); AG[((size_t)(0 * 2 + d) * NTILE + c) * LRW + cg] = al[15] * Ain; AG[((size_t)(1 * 2 + d) * NTILE + c) * LRW + cg] = hl[15] + al[15] * Hin; } }
    __syncthreads();
}
__device__ __forceinline__ void shifted8(const bf16* P, size_t grow, bool hp, bool hn, const float* mu0, const float* mu1, int rc, float (&o)[8]) {
    const bf16* p = P + grow * IN_PAD + 2 * LRW + rc;
    float xs[8], ms[8], ns[8]; ld8bf(p, xs);
#pragma unroll
    for (int e = 0; e < 8; ++e) { ms[e] = 0.f; ns[e] = 0.f; }
    if (hp) ld8bf(p - IN_PAD, ms);
    if (hn) ld8bf(p + IN_PAD, ns);
    const f32x4 a0 = *(const f32x4*)(mu0 + rc), a1 = *(const f32x4*)(mu0 + rc + 4), b0 = *(const f32x4*)(mu1 + rc), b1 = *(const f32x4*)(mu1 + rc + 4);
    const float m0[8] = {a0.x, a0.y, a0.z, a0.w, a1.x, a1.y, a1.z, a1.w}, m1[8] = {b0.x, b0.y, b0.z, b0.w, b1.x, b1.y, b1.z, b1.w};
#pragma unroll
    for (int e = 0; e < 8; ++e) o[e] = xs[e] + m0[e] * (ms[e] - xs[e]) + m1[e] * (ns[e] - xs[e]);
}
constexpr int MB = 9216;
constexpr int MLD = 72;
#define MSLOT(k) ((LAS bf16*)(F.lds + (k) * MB))
__device__ __forceinline__ int prow(int c) { return (c & ~7) | ((c + (c >> 3)) & 7); }
__device__ __forceinline__ bf16x8 frag_lds_p(const LAS bf16* base, int ld, int row0, int k0, int lane) { return *(const LAS bf16x8*)(base + prow(row0 + (lane & 15)) * ld + k0 + 8 * (lane >> 4)); }
template <bool PY, bool PX> __device__ __forceinline__ f32x4 mm_tile_p(const LAS bf16* Y, int rt, const LAS bf16* X, int ct, f32x4 acc, int lane) {
    acc = MFMA16(PY ? frag_lds_p(Y, MLD, 16 * rt, 0, lane) : frag_lds(Y, MLD, 16 * rt, 0, lane), PX ? frag_lds_p(X, MLD, 16 * ct, 0, lane) : frag_lds(X, MLD, 16 * ct, 0, lane), acc);
    acc = MFMA16(PY ? frag_lds_p(Y, MLD, 16 * rt, 32, lane) : frag_lds(Y, MLD, 16 * rt, 32, lane), PX ? frag_lds_p(X, MLD, 16 * ct, 32, lane) : frag_lds(X, MLD, 16 * ct, 32, lane), acc);
    return acc;
}
__device__ __forceinline__ f32x4 mm_tile(const LAS bf16* Y, int rt, const LAS bf16* X, int ct, f32x4 acc, int lane) {
    acc = MFMA16(frag_lds(Y, MLD, 16 * rt, 0, lane), frag_lds(X, MLD, 16 * ct, 0, lane), acc);
    acc = MFMA16(frag_lds(Y, MLD, 16 * rt, 32, lane), frag_lds(X, MLD, 16 * ct, 32, lane), acc);
    return acc;
}
__device__ __forceinline__ void st_tile(LAS bf16* Dst, int rt, int ct, f32x4 acc, int lane) {
    v2u o; o.x = pk2(acc[0], acc[1]); o.y = pk2(acc[2], acc[3]);
    *(LAS v2u*)(Dst + (16 * ct + (lane & 15)) * MLD + 16 * rt + 4 * (lane >> 4)) = o;
}
__device__ __forceinline__ f32x4 ld_tile(const LAS bf16* Src, int rt, int ct, int lane) {
    const v2u o = *(const LAS v2u*)(Src + (16 * ct + (lane & 15)) * MLD + 16 * rt + 4 * (lane >> 4));
    return (f32x4){bf_lo(o.x), bf_hi(o.x), bf_lo(o.y), bf_hi(o.y)};
}
template <int MASK> __device__ __forceinline__ void mm64(LAS bf16* Dst, const LAS bf16* X, const LAS bf16* Y, int wave, int lane) {
    const int rt = wave >> 1;
#pragma unroll
    for (int q = 0; q < 2; ++q) { const int ct = 2 * (wave & 1) + q; f32x4 acc = {0.f, 0.f, 0.f, 0.f};
        acc = mm_tile(Y, rt, X, ct, acc, lane);
        if (MASK) { const int c = 16 * ct + (lane & 15);
#pragma unroll
            for (int g = 0; g < 4; ++g) { const int r = 16 * rt + 4 * (lane >> 4) + g; const bool keep = MASK == 1 ? (c > r) : MASK == 2 ? (r > c) : (c >= r); if (!keep) acc[g] = 0.f; } }
        st_tile(Dst, rt, ct, acc, lane); }
}
#ifndef CPROBE
#define CPROBE 0
#endif
struct RawS1 { v4u x[5][3]; };
template <int G0, int G1> __device__ __forceinline__ void load_raw(Frame& F, int c, int hh, int d, int tid, RawS1& raw) {
    const TileInfo ti = tile_info(c); const int t = tid >> 3, c8 = (tid & 7) * 8, tt = ti.t0 + t; const bool hp = tt > 0, hn = tt + 1 < ti.seq_len;
    const bf16* p0 = (const bf16*)(F.ws + WS_P) + (size_t)(ti.seq_base + tt) * IN_PAD + 2 * LRW + c8;
#pragma unroll
    for (int g = G0; g < G1; ++g) { const int rc = g < 3 ? g * RWW + hh * 64 : 3 * RWW + (g - 3) * 128 + d * 64; const bf16* p = p0 + rc;
        raw.x[g][0] = *(const v4u*)p; raw.x[g][1] = *(const v4u*)(p - (hp ? IN_PAD : 0)); raw.x[g][2] = *(const v4u*)(p + (hn ? IN_PAD : 0)); }
}
__device__ __forceinline__ void shift_raw(const v4u (&x)[3], const LAS float* mus, bool hp, bool hn, float (&o)[8]) {
    const f32x4 a0 = *(const LAS f32x4*)mus, a1 = *(const LAS f32x4*)(mus + 4), b0 = *(const LAS f32x4*)(mus + 64), b1 = *(const LAS f32x4*)(mus + 68);
    const float m0[8] = {a0.x, a0.y, a0.z, a0.w, a1.x, a1.y, a1.z, a1.w}, m1[8] = {b0.x, b0.y, b0.z, b0.w, b1.x, b1.y, b1.z, b1.w};
    const unsigned xw[4] = {x[0].x, x[0].y, x[0].z, x[0].w}, pw[4] = {x[1].x, x[1].y, x[1].z, x[1].w}, nw[4] = {x[2].x, x[2].y, x[2].z, x[2].w};
#pragma unroll
    for (int e = 0; e < 8; ++e) { const float xs = (e & 1) ? bf_hi(xw[e >> 1]) : bf_lo(xw[e >> 1]), ms = hp ? ((e & 1) ? bf_hi(pw[e >> 1]) : bf_lo(pw[e >> 1])) : 0.f, ns = hn ? ((e & 1) ? bf_hi(nw[e >> 1]) : bf_lo(nw[e >> 1])) : 0.f;
        o[e] = xs + m0[e] * (ms - xs) + m1[e] * (ns - xs); }
}
__device__ __forceinline__ void rwkv_chunk_prep(Frame& F, int l, int c, int hh, int d) {
    RawS1 raw;
    int tid = F.tid; asm volatile("" : "+v"(tid));
    const TileInfo ti = tile_info(c); const int lane = tid & 63, wave = F.wave;
    LAS bf16* TW = MSLOT(0); LAS bf16* AD = MSLOT(1);
    LAS float* CUM = (LAS float*)(F.lds + 8 * MB); LAS float* AVs = (LAS float*)(F.lds + 8 * MB + 16640);
    LAS float* CWL = (LAS float*)(F.lds + 13 * MB); LAS float* SEGT = (LAS float*)(F.lds + 13 * MB + 256); LAS float* MUS = (LAS float*)(F.lds + 125184);
    const int uidx = (c * NH + hh) * 2 + d;
    const int t = tid >> 3, c8 = (tid & 7) * 8, tt = ti.t0 + t; const size_t grow = (size_t)(ti.seq_base + tt); const bool hp = tt > 0, hn = tt + 1 < ti.seq_len;
    float rv[8], kv[8], vv[8], kk[8];
    load_raw<0, 5>(F, c, hh, d, tid, raw);
    for (int rp_ = 0; rp_ < (CPROBE == 1 ? 2 : 1); ++rp_) {
    shift_raw(raw.x[0], MUS + 0 * 128 + c8, hp, hn, rv);
    shift_raw(raw.x[1], MUS + 1 * 128 + c8, hp, hn, kv);
    shift_raw(raw.x[2], MUS + 2 * 128 + c8, hp, hn, vv);
    { float ss = 0.f; const float* kkw = gin(F.in[I_KK]) + (size_t)l * RWW + hh * 64 + c8;
#pragma unroll
      for (int e = 0; e < 8; ++e) { kk[e] = kv[e] * kkw[e]; ss += kk[e] * kk[e]; }
      ss = red8(ss); const float inv = __builtin_amdgcn_rsqf(fmaxf(ss, 1e-24f));
#pragma unroll
      for (int e = 0; e < 8; ++e) kk[e] *= inv; }
    if (d == 0) { v4u o; o.x = pk2(vv[0], vv[1]); o.y = pk2(vv[2], vv[3]); o.z = pk2(vv[4], vv[5]); o.w = pk2(vv[6], vv[7]); *(v4u*)((bf16*)(F.ws + WS_RV) + grow * RWW + hh * 64 + c8) = o; }
    { float x[8]; v4u o;
      shift_raw(raw.x[3], MUS + 3 * 128 + c8, hp, hn, x);
      o.x = pk2(ftanh(x[0]), ftanh(x[1])); o.y = pk2(ftanh(x[2]), ftanh(x[3])); o.z = pk2(ftanh(x[4]), ftanh(x[5])); o.w = pk2(ftanh(x[6]), ftanh(x[7])); *(LAS v4u*)(TW + t * MLD + c8) = o;
      shift_raw(raw.x[4], MUS + 4 * 128 + c8, hp, hn, x);
      o.x = pk2(x[0], x[1]); o.y = pk2(x[2], x[3]); o.z = pk2(x[4], x[5]); o.w = pk2(x[6], x[7]); *(LAS v4u*)(AD + t * MLD + c8) = o; }
    asm volatile("" ::: "memory"); }
    __syncthreads();
    for (int rp_ = 0; rp_ < (CPROBE == 2 ? 2 : 1); ++rp_) { const int m = wave & 3; const bf16x8 w0f = frag_lds(TW, MLD, 16 * m, 0, lane), w1f = frag_lds(TW, MLD, 16 * m, 32, lane), d0f = frag_lds(AD, MLD, 16 * m, 0, lane), d1f = frag_lds(AD, MLD, 16 * m, 32, lane);
      const bf16* W2 = (const bf16*)(F.ws + WS_W2T) + ((size_t)(l * 2 + d) * 1024 + hh * 64) * 64; const bf16* A2 = (const bf16*)(F.ws + WS_A2T) + ((size_t)(l * 2 + d) * 1024 + hh * 64) * 64;
#pragma unroll
      for (int q = 0; q < 2; ++q) { const int n = (wave >> 2) * 2 + q; f32x4 aw = {0.f, 0.f, 0.f, 0.f}, aa = aw;
          aw = MFMA16(w0f, frag_g(W2, 64, 16 * n, 0, lane), aw); aw = MFMA16(w1f, frag_g(W2, 64, 16 * n, 32, lane), aw);
          aa = MFMA16(d0f, frag_g(A2, 64, 16 * n, 0, lane), aa); aa = MFMA16(d1f, frag_g(A2, 64, 16 * n, 32, lane), aa);
          const int col = 16 * n + (lane & 15), cg = hh * 64 + col; const float w0 = gin(F.in[I_W0])[(size_t)(l * 2 + d) * RWW + cg], a0 = gin(F.in[I_A0])[(size_t)(l * 2 + d) * RWW + cg];
#pragma unroll
          for (int g = 0; g < 4; ++g) { const int row = 16 * m + 4 * (lane >> 4) + g; const float wlog = -fsoftplus(-(w0 + aw[g])) - 0.5f;
              CUM[row * 65 + col] = -fexp(wlog); AVs[row * 65 + col] = fsigmoid(a0 + aa[g]); } } }
    __syncthreads();
    { const int col = tid & 63, seg = tid >> 6; float pre[8]; float run = 0.f;
#pragma unroll
      for (int i = 0; i < 8; ++i) { const int tau = seg * 8 + i, tr = d ? 63 - tau : tau; run += CUM[tr * 65 + col]; pre[i] = run; }
      SEGT[seg * 64 + col] = run;
      __syncthreads();
      float off = 0.f;
#pragma unroll
      for (int s = 0; s < 8; ++s) if (s < seg) off += SEGT[s * 64 + col];
#pragma unroll
      for (int i = 0; i < 8; ++i) { const int tau = seg * 8 + i, tr = d ? 63 - tau : tau; CUM[tr * 65 + col] = off + pre[i]; }
      if (seg == 7) CWL[col] = fexp(off + pre[7]); }
    __syncthreads();
    for (int rp_ = 0; rp_ < (CPROBE == 3 ? 2 : 1); ++rp_) { const int tau = d ? 63 - t : t, tprev = d ? t + 1 : t - 1;
      const float* kaw = gin(F.in[I_KA]) + (size_t)l * RWW + hh * 64 + c8; const float* rkw = gin(F.in[I_RK]) + (size_t)l * RWW + hh * 64 + c8;
      LAS bf16* At = MSLOT(0); LAS bf16* AtT = MSLOT(1); LAS bf16* Bt = MSLOT(2); LAS bf16* BtT = MSLOT(3); LAS bf16* Kt = MSLOT(4); LAS bf16* KtT = MSLOT(5); LAS bf16* Rt = MSLOT(6); LAS bf16* VT = MSLOT(7);
      float bsum = 0.f; unsigned pa[4], pb[4], pk[4], pr[4];
#pragma unroll
      for (int e2 = 0; e2 < 4; ++e2) { float at2[2], bt2[2], kt2[2], rt2[2];
#pragma unroll
          for (int q = 0; q < 2; ++q) { const int e = 2 * e2 + q; const float cum = CUM[t * 65 + c8 + e], cumx = tau > 0 ? CUM[tprev * 65 + c8 + e] : 0.f, a = AVs[t * 65 + c8 + e];
              const float kd = kv[e] * (1.0f + (a - 1.0f) * kaw[e]), ex = fexp(cum), exm = fexp(-cum);
              at2[q] = -kk[e] * fexp(cumx); bt2[q] = kk[e] * a * exm; kt2[q] = kd * exm; rt2[q] = rv[e] * ex; bsum += rv[e] * kd * rkw[e];
              const int pr_ = prow(c8 + e) * MLD + tau; AtT[pr_] = (bf16)f2bf(at2[q]); BtT[pr_] = (bf16)f2bf(bt2[q]); KtT[pr_] = (bf16)f2bf(kt2[q]); VT[pr_] = (bf16)f2bf(vv[e]); }
          pa[e2] = pk2(at2[0], at2[1]); pb[e2] = pk2(bt2[0], bt2[1]); pk[e2] = pk2(kt2[0], kt2[1]); pr[e2] = pk2(rt2[0], rt2[1]); }
      *(LAS v4u*)(At + tau * MLD + c8) = (v4u){pa[0], pa[1], pa[2], pa[3]}; *(LAS v4u*)(Bt + tau * MLD + c8) = (v4u){pb[0], pb[1], pb[2], pb[3]};
      *(LAS v4u*)(Kt + tau * MLD + c8) = (v4u){pk[0], pk[1], pk[2], pk[3]}; *(LAS v4u*)(Rt + tau * MLD + c8) = (v4u){pr[0], pr[1], pr[2], pr[3]};
      bsum = red8(bsum);
      if ((tid & 7) == 0) ((float*)(F.ws + WS_BETA))[((size_t)d * MTOT + grow) * NH + hh] = bsum; }
    __syncthreads();
    LAS bf16* At = MSLOT(0); LAS bf16* AtT = MSLOT(1); LAS bf16* Bt = MSLOT(2); LAS bf16* BtT = MSLOT(3); LAS bf16* Kt = MSLOT(4); LAS bf16* KtT = MSLOT(5); LAS bf16* Rt = MSLOT(6); LAS bf16* VT = MSLOT(7);
    LAS bf16* Pm = MSLOT(8); LAS bf16* AkVT = MSLOT(9); LAS bf16* Gak = MSLOT(10); LAS bf16* Grb = MSLOT(11); LAS bf16* Grk = MSLOT(12);
    LAS bf16* TAT = MSLOT(0); LAS bf16* U0T = MSLOT(2); LAS bf16* TD = (LAS bf16*)(F.lds + 122112); constexpr int TDLD = 24;
    for (int rp_ = 0; rp_ < (CPROBE == 4 ? 2 : 1); ++rp_) {
    mm64<1>(Pm, At, Bt, wave, lane);
    __syncthreads();
    if (wave == 0) { const int blk = lane >> 4, cc = lane & 15; float tv[16];
#pragma unroll
        for (int r = 0; r < 16; ++r) { asm volatile("" ::: "memory"); const LAS bf16* ar = Pm + (16 * blk + r) * MLD + 16 * blk; const v4u q0 = *(const LAS v4u*)ar, q1 = *(const LAS v4u*)(ar + 8);
            const float av_[16] = {bf_lo(q0.x), bf_hi(q0.x), bf_lo(q0.y), bf_hi(q0.y), bf_lo(q0.z), bf_hi(q0.z), bf_lo(q0.w), bf_hi(q0.w), bf_lo(q1.x), bf_hi(q1.x), bf_lo(q1.y), bf_hi(q1.y), bf_lo(q1.z), bf_hi(q1.z), bf_lo(q1.w), bf_hi(q1.w)};
            float acc0 = (r == cc) ? 1.0f : 0.f, acc1 = 0.f;
#pragma unroll
            for (int m = 0; m < r; ++m) { if (m & 1) acc1 += av_[m] * tv[m]; else acc0 += av_[m] * tv[m]; }
            tv[r] = acc0 + acc1; }
#pragma unroll
        for (int r = 0; r < 16; ++r) TD[(16 * blk + r) * TDLD + cc] = (bf16)f2bf(tv[r]);
    } else {
#pragma unroll 1
        for (int q = wave - 1; q < 48; q += 7) { const int pr = q >> 4, tl = q & 15, rt = tl >> 2, ct = tl & 3;
            const LAS bf16* X = pr == 0 ? At : Rt; const LAS bf16* Y = pr == 1 ? Bt : Kt; LAS bf16* Dst = pr == 0 ? Gak : pr == 1 ? Grb : Grk;
            f32x4 acc = {0.f, 0.f, 0.f, 0.f}; acc = mm_tile(Y, rt, X, ct, acc, lane);
            const int cI = 16 * ct + (lane & 15);
#pragma unroll
            for (int g = 0; g < 4; ++g) { const int rI = 16 * rt + 4 * (lane >> 4) + g; const bool keep = pr == 0 ? (cI > rI) : (cI >= rI); if (!keep) acc[g] = 0.f; }
            st_tile(Dst, rt, ct, acc, lane); }
    }
    __syncthreads(); }
    { const int rt = wave >> 1;
#pragma unroll
      for (int q = 0; q < 2; ++q) { const int ct = 2 * (wave & 1) + q; f32x4 acc = {0.f, 0.f, 0.f, 0.f}; acc = mm_tile_p<false, true>(Gak, rt, VT, ct, acc, lane); st_tile(AkVT, rt, ct, acc, lane); } }
    { const v4u z = {0u, 0u, 0u, 0u}; for (int i = tid; i < 64 * 8; i += NTHR) { const int row = i >> 3, c8_ = (i & 7) * 8; *(LAS v4u*)(TAT + row * MLD + c8_) = z; *(LAS v4u*)(U0T + row * MLD + c8_) = z; } }
    __syncthreads();
    for (int rp_ = 0; rp_ < (CPROBE == 5 ? 2 : 1); ++rp_)
#pragma unroll 1
    for (int bi = 0; bi < 4; ++bi) {
        const int g = lane >> 4, il = lane & 15, nt = wave & 3; const LAS bf16* RH = (wave < 4) ? AtT : AkVT; LAS bf16* XT = (wave < 4) ? TAT : U0T;
        const v2u rq = *(const LAS v2u*)(RH + ((wave < 4) ? prow(16 * nt + il) : 16 * nt + il) * MLD + 16 * bi + 4 * g);
        f32x4 acc = {bf_lo(rq.x), bf_hi(rq.x), bf_lo(rq.y), bf_hi(rq.y)};
#pragma unroll
        for (int ks = 0; ks < 2; ++ks) if (32 * ks < 16 * bi) {
            bf16x8 af = frag_lds(Pm, MLD, 16 * bi, 32 * ks, lane); if (32 * ks + 8 * g >= 16 * bi) af = (bf16x8){0, 0, 0, 0, 0, 0, 0, 0};
            acc = MFMA16(af, frag_lds(XT, MLD, 16 * nt, 32 * ks, lane), acc); }
        v4u rb; rb.x = pk2(acc[0], acc[1]); rb.y = pk2(acc[2], acc[3]); rb.z = 0u; rb.w = 0u;
        const v2u tq = *(const LAS v2u*)(TD + (16 * bi + il) * TDLD + 4 * g); v4u tf; tf.x = tq.x; tf.y = tq.y; tf.z = 0u; tf.w = 0u;
        f32x4 xo = {0.f, 0.f, 0.f, 0.f}; xo = MFMA16(__builtin_bit_cast(bf16x8, tf), __builtin_bit_cast(bf16x8, rb), xo);
        v2u o; o.x = pk2(xo[0], xo[1]); o.y = pk2(xo[2], xo[3]); *(LAS v2u*)(XT + (16 * nt + il) * MLD + 16 * bi + 4 * g) = o;
        __syncthreads();
    }
    for (int rp_ = 0; rp_ < (CPROBE == 6 ? 2 : 1); ++rp_) {
    {
      bf16* QMg = (bf16*)(F.ws + WS_QM) + (size_t)uidx * 4096; bf16* PHg = (bf16*)(F.ws + WS_PHI) + (size_t)uidx * 4096; const int rt = wave >> 1;
#pragma unroll
      for (int q = 0; q < 2; ++q) { const int ct = 2 * (wave & 1) + q; const int cidx = 16 * ct + (lane & 15), r0 = 16 * rt + 4 * (lane >> 4), qpos = 32 * (rt >> 1) + 8 * (lane >> 4) + 4 * (rt & 1);
          f32x4 acc = ld_tile(Rt, rt, ct, lane); acc = mm_tile(TAT, rt, Grb, ct, acc, lane);
          v2u o; o.x = pk2(acc[0], acc[1]); o.y = pk2(acc[2], acc[3]); *(v2u*)(QMg + cidx * 64 + qpos) = o;
          asm volatile("" ::: "memory");
          f32x4 ph = {0.f, 0.f, 0.f, 0.f}; ph = mm_tile_p<false, true>(TAT, rt, BtT, ct, ph, lane); const float cw = CWL[cidx];
#pragma unroll
          for (int g = 0; g < 4; ++g) ph[g] = cw * (ph[g] + ((r0 + g == cidx) ? 1.0f : 0.f));
          o.x = pk2(ph[0], ph[1]); o.y = pk2(ph[2], ph[3]); *(v2u*)(PHg + cidx * 64 + qpos) = o; } }
    {
      bf16* Y0g = (bf16*)(F.ws + WS_Y0F) + (size_t)uidx * 4096; bf16* PSg = (bf16*)(F.ws + WS_PSF) + (size_t)uidx * 4096; const int rt = wave >> 1;
#pragma unroll
      for (int q = 0; q < 2; ++q) { const int ct = 2 * (wave & 1) + q;
          asm volatile("" ::: "memory");
          f32x4 y0 = {0.f, 0.f, 0.f, 0.f}; y0 = mm_tile(Grb, rt, U0T, ct, y0, lane); asm volatile("" ::: "memory"); y0 = mm_tile_p<false, true>(Grk, rt, VT, ct, y0, lane);
          { v2u w; w.x = pk2(y0[0], y0[1]); w.y = pk2(y0[2], y0[3]); *(v2u*)(Y0g + ((ct * 4 + rt) * 64 + lane) * 4) = w; }
          asm volatile("" ::: "memory");
          f32x4 ps = {0.f, 0.f, 0.f, 0.f}; ps = mm_tile_p<true, false>(BtT, rt, U0T, ct, ps, lane); asm volatile("" ::: "memory"); ps = mm_tile_p<true, true>(KtT, rt, VT, ct, ps, lane);
#pragma unroll
          for (int g = 0; g < 4; ++g) ps[g] *= CWL[16 * rt + 4 * (lane >> 4) + g];
          { v2u w; w.x = pk2(ps[0], ps[1]); w.y = pk2(ps[2], ps[3]); *(v2u*)(PSg + ((ct * 4 + rt) * 64 + lane) * 4) = w; } } } }
    __syncthreads();
}
#define LDS_BAR() do { asm volatile("s_waitcnt lgkmcnt(0)" ::: "memory"); __builtin_amdgcn_s_barrier(); asm volatile("" ::: "memory"); } while (0)
struct ChunkOps { bf16x8 f[4][2]; v2u c[4]; int tile; };
__device__ __forceinline__ void chunk_load(Frame& F, ChunkOps& o, int step, int b, int hh, int d, int sl, int role, int lane) {
    const int g = lane >> 4, il = lane & 15;
    step = step < 67 ? step : 67;
    const int cc = d ? 3 - step : step, lc = d ? 67 - step : step - 4; const int tile = step < 4 ? 128 + b * 4 + cc : b * 64 + lc;
    o.tile = tile;
    const size_t uidx = (size_t)(tile * NH + hh) * 2 + d;
    const bf16* Mg = (const bf16*)(F.ws + (role ? WS_QM : WS_PHI)) + uidx * 4096 + il * 64 + 8 * g; const bf16* Cg = (const bf16*)(F.ws + (role ? WS_Y0F : WS_PSF)) + uidx * 4096 + (sl * 4 * 64 + lane) * 4;
#pragma unroll
    for (int m = 0; m < 4; ++m) { o.f[m][0] = *(const bf16x8*)(Mg + m * 1024); o.f[m][1] = *(const bf16x8*)(Mg + m * 1024 + 32); o.c[m] = *(const v2u*)(Cg + m * 256); }
}
__device__ __forceinline__ void lru_scan(Frame& F, int idx) {
    const int ch = idx & 1023, b = (idx >> 10) & 1, d = idx >> 11;
    const float* AG = (const float*)(F.ws + WS_LAGG); float* HIN = (float*)(F.ws + WS_LHIN);
    float carry = 0.f;
#pragma unroll 4
    for (int step = 0; step < 68; ++step) { int tile; if (step < 4) tile = 128 + b * 4 + (d ? 3 - step : step); else tile = b * 64 + (d ? 63 - (step - 4) : step - 4);
        const float a = AG[((size_t)(0 * 2 + d) * NTILE + tile) * LRW + ch], hh_ = AG[((size_t)(1 * 2 + d) * NTILE + tile) * LRW + ch];
        HIN[((size_t)d * NTILE + tile) * LRW + ch] = carry; carry = a * carry + hh_; }
}

__device__ __forceinline__ void chunk_apply(Frame& F, const ChunkOps& o, f32x4 (&S)[4], int step, bf16* YR, int hh, int d, int sl, int role, int lane) {
    const int g = lane >> 4, il = lane & 15; LAS v4u* XCH = (LAS v4u*)F.lds;
    bf16x8 bfr[2];
    if (role == 0) {
#pragma unroll
        for (int ks = 0; ks < 2; ++ks) { v4u w; w.x = pk2(S[2 * ks][0], S[2 * ks][1]); w.y = pk2(S[2 * ks][2], S[2 * ks][3]); w.z = pk2(S[2 * ks + 1][0], S[2 * ks + 1][1]); w.w = pk2(S[2 * ks + 1][2], S[2 * ks + 1][3]); bfr[ks] = __builtin_bit_cast(bf16x8, w); }
#pragma unroll
        for (int m = 0; m < 4; ++m) { f32x4 sn = (f32x4){bf_lo(o.c[m].x), bf_hi(o.c[m].x), bf_lo(o.c[m].y), bf_hi(o.c[m].y)}; sn = MFMA16(o.f[m][0], bfr[0], sn); sn = MFMA16(o.f[m][1], bfr[1], sn); S[m] = sn; }
#pragma unroll
        for (int ks = 0; ks < 2; ++ks) { v4u w; w.x = pk2(S[2 * ks][0], S[2 * ks][1]); w.y = pk2(S[2 * ks][2], S[2 * ks][3]); w.z = pk2(S[2 * ks + 1][0], S[2 * ks + 1][1]); w.w = pk2(S[2 * ks + 1][2], S[2 * ks + 1][3]);
            XCH[((((step + 1) & 1) * 4 + sl) * 2 + ks) * 64 + lane] = w; }
    } else {
#pragma unroll
        for (int ks = 0; ks < 2; ++ks) bfr[ks] = __builtin_bit_cast(bf16x8, XCH[(((step & 1) * 4 + sl) * 2 + ks) * 64 + lane]);
#pragma unroll
        for (int m = 0; m < 4; ++m) { f32x4 y = (f32x4){bf_lo(o.c[m].x), bf_hi(o.c[m].x), bf_lo(o.c[m].y), bf_hi(o.c[m].y)}; y = MFMA16(o.f[m][0], bfr[0], y); y = MFMA16(o.f[m][1], bfr[1], y);
#pragma unroll
            for (int r = 0; r < 4; ++r) { const int tau = 16 * m + 4 * g + r, tl = d ? 63 - tau : tau; YR[(size_t)(o.tile * 64 + tl) * RWW + hh * 64 + sl * 16 + il] = (bf16)f2bf(y[r]); } }
    }
}
__device__ __forceinline__ void rwkv_chain_chunks(Frame& F, int item) {
    const int chain = item >> 2, sl = item & 3, d = chain & 1, hh = (chain >> 1) & 15, b = chain >> 5, role = F.wave, lane = F.lane;
    bf16* YR = (bf16*)(F.ws + WS_YR) + (size_t)d * MTOT * RWW;
    { LAS v4u* XCH = (LAS v4u*)F.lds; for (int i = F.tid; i < 4 * 2 * 64; i += NTHR) XCH[i] = (v4u){0u, 0u, 0u, 0u}; }
    __syncthreads();
    if (F.wave >= 2) {
#pragma unroll 1
        for (int step = 0; step < 68; ++step) LDS_BAR();
        return; }
    f32x4 S[4];
#pragma unroll
    for (int m = 0; m < 4; ++m) S[m] = (f32x4){0.f, 0.f, 0.f, 0.f};
    ChunkOps A, B, C, E;
    chunk_load(F, A, 0, b, hh, d, sl, role, lane); chunk_load(F, B, 1, b, hh, d, sl, role, lane); chunk_load(F, C, 2, b, hh, d, sl, role, lane);
#pragma unroll 1
    for (int step = 0; step < 68; step += 4) {
        chunk_load(F, E, step + 3, b, hh, d, sl, role, lane);
        chunk_apply(F, A, S, step, YR, hh, d, sl, role, lane); LDS_BAR();
        chunk_load(F, A, step + 4, b, hh, d, sl, role, lane);
        chunk_apply(F, B, S, step + 1, YR, hh, d, sl, role, lane); LDS_BAR();
        chunk_load(F, B, step + 5, b, hh, d, sl, role, lane);
        chunk_apply(F, C, S, step + 2, YR, hh, d, sl, role, lane); LDS_BAR();
        chunk_load(F, C, step + 6, b, hh, d, sl, role, lane);
        chunk_apply(F, E, S, step + 3, YR, hh, d, sl, role, lane); LDS_BAR();
    }
}
__device__ __forceinline__ void merge_unit(Frame& F, int l, int u) {
    const int c = u >> 2; const TileInfo ti = tile_info(c); const int t0 = ti.t0 + (u & 3) * 16; const bf16* P = (const bf16*)(F.ws + WS_P);
    LAS bf16* SG = (LAS bf16*)F.lds; LAS bf16* GO = (LAS bf16*)(F.lds + 10752);
    const float* mu0 = gin(F.in[I_MU]) + (size_t)l * 2 * RW_COLS; const float* mu1 = mu0 + RW_COLS;
    for (int idx = F.tid; idx < 16 * 160; idx += NTHR) { const int t = idx / 160, k = idx % 160, tt = t0 + t, rc = 3 * RWW + 256 + k; const bf16* p = P + (size_t)(ti.seq_base + tt) * IN_PAD + 2 * LRW + rc;
        const float x = __builtin_bit_cast(float, (unsigned)p[0] << 16), xm = tt > 0 ? __builtin_bit_cast(float, (unsigned)p[-IN_PAD] << 16) : 0.f, xn = tt + 1 < ti.seq_len ? __builtin_bit_cast(float, (unsigned)p[IN_PAD] << 16) : 0.f;
        SG[t * 168 + k] = (bf16)f2bf(fsigmoid(x + mu0[rc] * (xm - x) + mu1[rc] * (xn - x))); }
    __syncthreads();
    { const int lane = F.lane; const bf16* G2 = (const bf16*)(F.ws + WS_G2T) + (size_t)l * 1024 * 160;
      bf16x8 af[5];
#pragma unroll
      for (int k = 0; k < 5; ++k) af[k] = frag_lds(SG, 168, 0, 32 * k, lane);
#pragma unroll 2
      for (int n = 0; n < 8; ++n) { const int n0 = F.wave * 128 + n * 16; f32x4 a0 = {0.f, 0.f, 0.f, 0.f};
#pragma unroll
          for (int k = 0; k < 5; ++k) a0 = MFMA16(af[k], frag_g(G2, 160, n0, 32 * k, lane), a0);
#pragma unroll
          for (int r = 0; r < 4; ++r) GO[(4 * (lane >> 4) + r) * 1032 + n0 + (lane & 15)] = (bf16)f2bf(a0[r]); } }
    __syncthreads();
    { bf16* MRG = (bf16*)(F.ws + WS_H);
      for (int it = F.tid; it < 16 * 256; it += NTHR) { const int t = it >> 8, cgp = it & 255, tt = t0 + t; const size_t grow = (size_t)(ti.seq_base + tt);
          float o[8];
          if (cgp < 128) { const int ch = cgp * 8; float gq8[8]; ld8bf(P + grow * IN_PAD + LRW + ch, gq8); const f32x4 g0 = {gq8[0], gq8[1], gq8[2], gq8[3]}, g1 = {gq8[4], gq8[5], gq8[6], gq8[7]};
              const bf16* hl = (const bf16*)(F.ws + WS_LB) + grow * LRW + ch; const bf16* ac = (const bf16*)(F.ws + WS_LA) + grow * LRW + ch; const float* hi = (const float*)(F.ws + WS_LHIN) + (size_t)c * LRW + ch;
              float h0[8], c0[8], h1[8], c1[8]; ld8bf(hl, h0); ld8bf(ac, c0); ld8bf(hl + (size_t)MTOT * LRW, h1); ld8bf(ac + (size_t)MTOT * LRW, c1);
              const f32x4 i00 = *(const f32x4*)hi, i01 = *(const f32x4*)(hi + 4), i10 = *(const f32x4*)(hi + (size_t)NTILE * LRW), i11 = *(const f32x4*)(hi + (size_t)NTILE * LRW + 4);
              const f32x4 a0 = {h0[0] + c0[0] * i00.x + h1[0] + c1[0] * i10.x, h0[1] + c0[1] * i00.y + h1[1] + c1[1] * i10.y, h0[2] + c0[2] * i00.z + h1[2] + c1[2] * i10.z, h0[3] + c0[3] * i00.w + h1[3] + c1[3] * i10.w};
              const f32x4 a1 = {h0[4] + c0[4] * i01.x + h1[4] + c1[4] * i11.x, h0[5] + c0[5] * i01.y + h1[5] + c1[5] * i11.y, h0[6] + c0[6] * i01.z + h1[6] + c1[6] * i11.z, h0[7] + c0[7] * i01.w + h1[7] + c1[7] * i11.w};
              o[0] = gelu_tanh(g0.x) * a0.x; o[1] = gelu_tanh(g0.y) * a0.y; o[2] = gelu_tanh(g0.z) * a0.z; o[3] = gelu_tanh(g0.w) * a0.w;
              o[4] = gelu_tanh(g1.x) * a1.x; o[5] = gelu_tanh(g1.y) * a1.y; o[6] = gelu_tanh(g1.z) * a1.z; o[7] = gelu_tanh(g1.w) * a1.w; }
          else { const int ch = (cgp - 128) * 8, hh = ch >> 6; const bf16* yr = (const bf16*)(F.ws + WS_YR) + grow * RWW + ch;
              float ya[8], yb[8], va[8]; ld8bf(yr, ya); ld8bf(yr + (size_t)MTOT * RWW, yb); ld8bf((const bf16*)(F.ws + WS_RV) + grow * RWW + ch, va);
              float s1 = 0.f, q1 = 0.f;
#pragma unroll
              for (int e = 0; e < 8; ++e) { ya[e] += yb[e]; s1 += ya[e]; q1 += ya[e] * ya[e]; }
              s1 = red8(s1); q1 = red8(q1);
              const float mean = s1 * (1.0f / 64.0f), var = fmaxf(q1 * (1.0f / 64.0f) - mean * mean, 0.f); const f32x2 st = {mean, __builtin_amdgcn_rsqf(var + GN_EPS)};
              const float beta = ((const float*)(F.ws + WS_BETA))[grow * NH + hh] + ((const float*)(F.ws + WS_BETA))[((size_t)MTOT + grow) * NH + hh];
              const float* gg = gin(F.in[I_GNG]) + (size_t)l * RWW + ch; const float* gb = gin(F.in[I_GNB]) + (size_t)l * RWW + ch;
              const v4u gq = *(const LAS v4u*)(GO + t * 1032 + ch); const float gv[8] = {bf_lo(gq.x), bf_hi(gq.x), bf_lo(gq.y), bf_hi(gq.y), bf_lo(gq.z), bf_hi(gq.z), bf_lo(gq.w), bf_hi(gq.w)};
#pragma unroll
              for (int e = 0; e < 8; ++e) o[e] = ((ya[e] - st.x) * st.y * gg[e] + gb[e] + beta * va[e]) * gv[e]; }
          v4u w; w.x = pk2(o[0], o[1]); w.y = pk2(o[2], o[3]); w.z = pk2(o[4], o[5]); w.w = pk2(o[6], o[7]);
          *(v4u*)(MRG + grow * D + cgp * 8) = w; } }
    __syncthreads();
}

__device__ __forceinline__ void ln_row(float (&z)[32], const float* g, const float* b, int lane) {
    float s = 0.f;
#pragma unroll
    for (int i = 0; i < 32; ++i) s += z[i];
    const float mean = wave_sum(s) * (1.0f / D); float q = 0.f;
#pragma unroll
    for (int i = 0; i < 32; ++i) { z[i] -= mean; q += z[i] * z[i]; }
    const float rstd = __builtin_amdgcn_rsqf(wave_sum(q) * (1.0f / D) + LN_EPS);
#pragma unroll
    for (int j = 0; j < 4; ++j) { const int e = j * 512 + lane * 8; const f32x4 g0 = *(const f32x4*)(g + e), g1 = *(const f32x4*)(g + e + 4), b0 = *(const f32x4*)(b + e), b1 = *(const f32x4*)(b + e + 4);
        const float gs[8] = {g0.x, g0.y, g0.z, g0.w, g1.x, g1.y, g1.z, g1.w}, bs[8] = {b0.x, b0.y, b0.z, b0.w, b1.x, b1.y, b1.z, b1.w};
#pragma unroll
        for (int i = 0; i < 8; ++i) z[j * 8 + i] = z[j * 8 + i] * rstd * gs[i] + bs[i]; }
}
__device__ __forceinline__ void load32(const float* p, int lane, float (&v)[32]) {
#pragma unroll
    for (int j = 0; j < 4; ++j) { const int e = j * 512 + lane * 8; const f32x4 a = *(const f32x4*)(p + e), b = *(const f32x4*)(p + e + 4);
        v[j * 8 + 0] = a.x; v[j * 8 + 1] = a.y; v[j * 8 + 2] = a.z; v[j * 8 + 3] = a.w; v[j * 8 + 4] = b.x; v[j * 8 + 5] = b.y; v[j * 8 + 6] = b.z; v[j * 8 + 7] = b.w; }
}
__device__ __forceinline__ void store32(float* p, int lane, const float (&v)[32]) {
#pragma unroll
    for (int j = 0; j < 4; ++j) { const int e = j * 512 + lane * 8; *(f32x4*)(p + e) = (f32x4){v[j * 8 + 0], v[j * 8 + 1], v[j * 8 + 2], v[j * 8 + 3]}; *(f32x4*)(p + e + 4) = (f32x4){v[j * 8 + 4], v[j * 8 + 5], v[j * 8 + 6], v[j * 8 + 7]}; }
}
__device__ __forceinline__ void store32_mod_bf16(bf16* p, const float* sh, const float* sc, int lane, const float (&v)[32]) {
#pragma unroll
    for (int j = 0; j < 4; ++j) { const int e = j * 512 + lane * 8; const f32x4 s0 = *(const f32x4*)(sh + e), s1 = *(const f32x4*)(sh + e + 4), c0 = *(const f32x4*)(sc + e), c1 = *(const f32x4*)(sc + e + 4);
        v4u o; o.x = pk2(v[j * 8 + 0] * (1.f + c0.x) + s0.x, v[j * 8 + 1] * (1.f + c0.y) + s0.y); o.y = pk2(v[j * 8 + 2] * (1.f + c0.z) + s0.z, v[j * 8 + 3] * (1.f + c0.w) + s0.w);
        o.z = pk2(v[j * 8 + 4] * (1.f + c1.x) + s1.x, v[j * 8 + 5] * (1.f + c1.y) + s1.y); o.w = pk2(v[j * 8 + 6] * (1.f + c1.z) + s1.z, v[j * 8 + 7] * (1.f + c1.w) + s1.w);
        *(v4u*)(p + e) = o; }
}
__device__ __forceinline__ void ln1_rows(Frame& F, int l, int nrows, bool dry = false) {
    const int gw = F.vcu * NWAVES + F.wave, NGW = F.G * NWAVES; float* X = (float*)(F.ws + WS_X); const float* O = (const float*)(F.ws + WS_O); bf16* H = (bf16*)(F.ws + WS_H);
    float* Xo = dry ? (float*)(F.ws + WS_LA) : X; bf16* Ho = dry ? (bf16*)(F.ws + WS_LB) : H;
    for (int row = gw; row < nrows; row += NGW) { const float* md = (const float*)(F.ws + WS_MOD) + ((size_t)l * 3 + mod_row(row)) * (6 * D);
        float z[32], o[32], gt[32]; load32(X + (size_t)row * D, F.lane, z); load32(md + 2 * D, F.lane, gt);
#pragma unroll
        for (int j = 0; j < 4; ++j) { float t8[8]; ld8bf((const bf16*)(F.ws + WS_O) + (size_t)row * D + j * 512 + F.lane * 8, t8);
#pragma unroll
            for (int i = 0; i < 8; ++i) o[j * 8 + i] = t8[i]; }
#pragma unroll
        for (int i = 0; i < 32; ++i) z[i] = ALPHA * z[i] + gt[i] * o[i];
        ln_row(z, gin(F.in[I_LN1G]) + (size_t)l * D, gin(F.in[I_LN1B]) + (size_t)l * D, F.lane);
        store32(Xo + (size_t)row * D, F.lane, z);
        store32_mod_bf16(Ho + (size_t)row * D, md + 3 * D, md + 4 * D, F.lane, z); }
}

__device__ __forceinline__ unsigned ord_key(float s, int k) { unsigned u = __builtin_bit_cast(unsigned, s); u = (u & 0x80000000u) ? ~u : (u | 0x80000000u); return (u & ~127u) | (unsigned)(127 - k); }
__device__ __forceinline__ float key_score(unsigned key) { const unsigned u = key & ~127u; return __builtin_bit_cast(float, (u & 0x80000000u) ? (u ^ 0x80000000u) : ~u); }
__device__ __forceinline__ void bitonic_top16(unsigned (&A)[16], const unsigned (&B)[16]) {
#pragma unroll
    for (int i = 0; i < 16; ++i) A[i] = A[i] > B[15 - i] ? A[i] : B[15 - i];
#pragma unroll
    for (int st = 8; st >= 1; st >>= 1)
#pragma unroll
        for (int i = 0; i < 16; ++i) if (!(i & st)) { const unsigned hi = A[i] > A[i + st] ? A[i] : A[i + st], lo = A[i] > A[i + st] ? A[i + st] : A[i]; A[i] = hi; A[i + st] = lo; }
}
__device__ __forceinline__ void ins16(unsigned (&L)[16], unsigned x) {
#pragma unroll
    for (int i = 0; i < 16; ++i) { const unsigned hi = L[i] > x ? L[i] : x; x = L[i] > x ? x : L[i]; L[i] = hi; }
}
__device__ __forceinline__ unsigned ord_key8(float s, unsigned tag) { unsigned u = __builtin_bit_cast(unsigned, s); u = (u & 0x80000000u) ? ~u : (u | 0x80000000u); return (u & ~255u) | tag; }
__device__ __forceinline__ float key_score8(unsigned key) { const unsigned u = key & ~255u; return __builtin_bit_cast(float, (u & 0x80000000u) ? (u ^ 0x80000000u) : ~u); }
__device__ __forceinline__ void peer_topk_unit(Frame& F, int l, int tile, int h) {
    int tid = F.tid; asm volatile("" : "+v"(tid));
    const int lane = tid & 63, wave = F.wave;
    LAS bf16* AQ = (LAS bf16*)F.lds; LAS float* SC = (LAS float*)(F.lds + 33792);
    LAS unsigned* bufA = (LAS unsigned*)F.lds; LAS unsigned* bufB = (LAS unsigned*)(F.lds + 33792); LAS unsigned* FIN = (LAS unsigned*)(F.lds + 66560); LAS unsigned char* PAIRT = (LAS unsigned char*)(F.lds + 99584);
    if (tid < 50) { int c = tid, i = 0; for (; i < 16; ++i) { const int n = 16 / (i + 1); if (c < n) break; c -= n; } PAIRT[tid] = (unsigned char)(i * 16 + c); }
    for (int idx = tid; idx < 64 * 64; idx += NTHR) { const int t = idx >> 6, c4 = (idx & 63) * 4; *(LAS v2u*)(AQ + t * 264 + c4) = *(const v2u*)((const bf16*)(F.ws + WS_QP) + (size_t)(tile * 64 + t) * D + h * 256 + c4); }
    __syncthreads();
    { const bf16* SK = (const bf16*)(F.ws + WS_SUBK) + (size_t)((l * 8 + h) * 2) * 128 * 128;
#pragma unroll
      for (int p = 0; p < 2; ++p) { bf16x8 bfr[4];
#pragma unroll
          for (int k = 0; k < 4; ++k) bfr[k] = frag_g(SK + (size_t)p * 128 * 128, 128, 16 * wave, 32 * k, lane);
#pragma unroll
          for (int m = 0; m < 4; ++m) { f32x4 acc = {0.f, 0.f, 0.f, 0.f};
#pragma unroll
              for (int k = 0; k < 4; ++k) acc = MFMA16(frag_lds(AQ, 264, 16 * m, p * 128 + 32 * k, lane), bfr[k], acc);
#pragma unroll
              for (int r = 0; r < 4; ++r) SC[(16 * m + 4 * (lane >> 4) + r) * 257 + p * 128 + 16 * wave + (lane & 15)] = acc[r]; } } }
    __syncthreads();
    const int t = lane, r = wave, p = r & 1, qd = r >> 1;
    unsigned L[16], B[16];
#pragma unroll
    for (int i = 0; i < 16; ++i) L[i] = 0u;
    { const LAS float* sp = SC + t * 257 + p * 128 + 32 * qd;
#pragma unroll 4
      for (int k = 0; k < 32; ++k) ins16(L, ord_key(sp[k], 32 * qd + k)); }
#pragma unroll
    for (int i = 0; i < 16; ++i) bufA[(r * 16 + i) * 64 + t] = L[i];
    __syncthreads();
#pragma unroll
    for (int i = 0; i < 16; ++i) B[i] = bufA[((r ^ 2) * 16 + i) * 64 + t];
    bitonic_top16(L, B);
#pragma unroll
    for (int i = 0; i < 16; ++i) bufB[(r * 16 + i) * 64 + t] = L[i];
    __syncthreads();
#pragma unroll
    for (int i = 0; i < 16; ++i) B[i] = bufB[((r ^ 4) * 16 + i) * 64 + t];
    bitonic_top16(L, B);
    if (qd == 0) {
#pragma unroll
        for (int i = 0; i < 16; ++i) FIN[(p * 16 + i) * 64 + t] = L[i]; }
    __syncthreads();
#pragma unroll
    for (int i = 0; i < 16; ++i) L[i] = 0u;
#pragma unroll
    for (int q = 0; q < 7; ++q) { const int c = q * 8 + r; if (c < 50) { const unsigned pr = PAIRT[c]; const unsigned ka = FIN[(0 * 16 + (pr >> 4)) * 64 + t], kb = FIN[(1 * 16 + (pr & 15)) * 64 + t];
            ins16(L, ord_key8(key_score(ka) + key_score(kb), pr)); } }
#pragma unroll
    for (int i = 0; i < 16; ++i) bufB[(r * 16 + i) * 64 + t] = L[i];
    __syncthreads();
#pragma unroll
    for (int i = 0; i < 16; ++i) B[i] = bufB[((r ^ 1) * 16 + i) * 64 + t];
    bitonic_top16(L, B);
#pragma unroll
    for (int i = 0; i < 16; ++i) bufA[(r * 16 + i) * 64 + t] = L[i];
    __syncthreads();
#pragma unroll
    for (int i = 0; i < 16; ++i) B[i] = bufA[((r ^ 2) * 16 + i) * 64 + t];
    bitonic_top16(L, B);
    __syncthreads();
#pragma unroll
    for (int i = 0; i < 16; ++i) bufB[(r * 16 + i) * 64 + t] = L[i];
    __syncthreads();
#pragma unroll
    for (int i = 0; i < 16; ++i) B[i] = bufB[((r ^ 4) * 16 + i) * 64 + t];
    bitonic_top16(L, B);
    { const float mx = key_score8(L[0]); float sum = 0.f, e0 = 0.f, e1 = 0.f; unsigned k0 = 0u, k1 = 0u;
#pragma unroll
      for (int i = 0; i < 16; ++i) { const float e = fexp(key_score8(L[i]) - mx); sum += e; if (i == 2 * r) { e0 = e; k0 = L[i]; } if (i == 2 * r + 1) { e1 = e; k1 = L[i]; } }
      const float inv = __builtin_amdgcn_rcpf(sum);
      const unsigned pa = k0 & 255u, pb = k1 & 255u;
      const int id0 = (127 - (int)(FIN[(0 * 16 + (pa >> 4)) * 64 + t] & 127u)) * 128 + (127 - (int)(FIN[(1 * 16 + (pa & 15)) * 64 + t] & 127u));
      const int id1 = (127 - (int)(FIN[(0 * 16 + (pb >> 4)) * 64 + t] & 127u)) * 128 + (127 - (int)(FIN[(1 * 16 + (pb & 15)) * 64 + t] & 127u));
      int* IDX = (int*)(F.ws + WS_IDX) + (size_t)(tile * 64 + t) * PE_SEL + h * 16 + 2 * r; float* GT = (float*)(F.ws + WS_GATE) + (size_t)(tile * 64 + t) * PE_SEL + h * 16 + 2 * r;
      *(int2*)IDX = make_int2(id0, id1); *(f32x2*)GT = (f32x2){e0 * inv, e1 * inv}; }
    __syncthreads();
}

__device__ __forceinline__ void unpack16(const v4u& w, f32x2 (&o)[8]) {
    o[0] = __builtin_amdgcn_cvt_pk_f32_fp8((int)w.x, false); o[1] = __builtin_amdgcn_cvt_pk_f32_fp8((int)w.x, true); o[2] = __builtin_amdgcn_cvt_pk_f32_fp8((int)w.y, false); o[3] = __builtin_amdgcn_cvt_pk_f32_fp8((int)w.y, true);
    o[4] = __builtin_amdgcn_cvt_pk_f32_fp8((int)w.z, false); o[5] = __builtin_amdgcn_cvt_pk_f32_fp8((int)w.z, true); o[6] = __builtin_amdgcn_cvt_pk_f32_fp8((int)w.w, false); o[7] = __builtin_amdgcn_cvt_pk_f32_fp8((int)w.w, true);
}
constexpr int EB = 8;
__device__ __forceinline__ void peer_token(Frame& F, int l, int row, int kb, int ke, f32x2 (&acc)[2][8]) {
    const int lane = F.lane;
    const unsigned char* UB = (const unsigned char*)(F.ws + WS_UB + (size_t)l * PE_NE * D); const unsigned char* VB = (const unsigned char*)(F.ws + WS_VB + (size_t)l * PE_NE * D);
    const float* SU = (const float*)(F.ws + WS_SU) + (size_t)l * PE_NE; const float* SV = (const float*)(F.ws + WS_SV) + (size_t)l * PE_NE;
    const bf16* H = (const bf16*)(F.ws + WS_H);
        const int* IDX = (const int*)(F.ws + WS_IDX) + (size_t)row * PE_SEL; const float* GT = (const float*)(F.ws + WS_GATE) + (size_t)row * PE_SEL;
        const int il = IDX[lane], ih = IDX[64 + lane]; const float gl = GT[lane], gh = GT[64 + lane];
        const float sul = SU[il], suh = SU[ih], svl = SV[il], svh = SV[ih];
        f32x2 hf[2][8];
#pragma unroll
        for (int j = 0; j < 2; ++j) { const v4u a = *(const v4u*)(H + (size_t)row * D + j * 1024 + lane * 16), b = *(const v4u*)(H + (size_t)row * D + j * 1024 + lane * 16 + 8);
            hf[j][0] = (f32x2){bf_lo(a.x), bf_hi(a.x)}; hf[j][1] = (f32x2){bf_lo(a.y), bf_hi(a.y)}; hf[j][2] = (f32x2){bf_lo(a.z), bf_hi(a.z)}; hf[j][3] = (f32x2){bf_lo(a.w), bf_hi(a.w)};
            hf[j][4] = (f32x2){bf_lo(b.x), bf_hi(b.x)}; hf[j][5] = (f32x2){bf_lo(b.y), bf_hi(b.y)}; hf[j][6] = (f32x2){bf_lo(b.z), bf_hi(b.z)}; hf[j][7] = (f32x2){bf_lo(b.w), bf_hi(b.w)}; }
        int dl = 0, dh = 0;
#pragma unroll 1
        for (int k0 = kb; k0 < ke; k0 += EB) { v4u w[EB][2];
#pragma unroll
            for (int q = 0; q < EB; ++q) { const int k = k0 + q; const int e = __builtin_amdgcn_readlane(k0 < 64 ? il : ih, k & 63); const unsigned char* ur = UB + (size_t)e * D + lane * 16;
                w[q][0] = *(const v4u*)ur; w[q][1] = *(const v4u*)(ur + 1024); }
#pragma unroll
            for (int q = 0; q < EB; ++q) { const int k = k0 + q; f32x2 p2 = {0.f, 0.f};
#pragma unroll
                for (int j = 0; j < 2; ++j) { f32x2 uf[8]; unpack16(w[q][j], uf);
#pragma unroll
                    for (int i = 0; i < 8; ++i) p2 = __builtin_elementwise_fma(uf[i], hf[j][i], p2); }
                const int tb = __builtin_bit_cast(int, wave_total(p2.x + p2.y));
                if (k0 < 64) dl = (lane == (k & 63)) ? tb : dl; else dh = (lane == (k & 63)) ? tb : dh; } }
        const float cl = gl * svl * gelu_erf(__builtin_bit_cast(float, dl) * sul), ch = gh * svh * gelu_erf(__builtin_bit_cast(float, dh) * suh);
#pragma unroll
        for (int j = 0; j < 2; ++j)
#pragma unroll
            for (int i = 0; i < 8; ++i) acc[j][i] = (f32x2){0.f, 0.f};
#pragma unroll 1
        for (int k0 = kb; k0 < ke; k0 += EB) { v4u w[EB][2];
#pragma unroll
            for (int q = 0; q < EB; ++q) { const int k = k0 + q; const int e = __builtin_amdgcn_readlane(k0 < 64 ? il : ih, k & 63); const unsigned char* vr = VB + (size_t)e * D + lane * 16;
                w[q][0] = *(const v4u*)vr; w[q][1] = *(const v4u*)(vr + 1024); }
#pragma unroll
            for (int q = 0; q < EB; ++q) { const int k = k0 + q; const float cf = __builtin_bit_cast(float, __builtin_amdgcn_readlane(__builtin_bit_cast(int, k0 < 64 ? cl : ch), k & 63)); const f32x2 cf2 = {cf, cf};
#pragma unroll
                for (int j = 0; j < 2; ++j) { f32x2 vf[8]; unpack16(w[q][j], vf);
#pragma unroll
                    for (int i = 0; i < 8; ++i) acc[j][i] = __builtin_elementwise_fma(vf[i], cf2, acc[j][i]); } } }
}
__device__ __forceinline__ void peer_finish(Frame& F, int l, int row, const f32x2 (&acc)[2][8], bool dry) {
    const int lane = F.lane;
    float* X = (float*)(F.ws + WS_X); bf16* H = (bf16*)(F.ws + WS_H); float* Xo = dry ? (float*)(F.ws + WS_LA) : X; bf16* Ho = dry ? (bf16*)(F.ws + WS_LB) : H; float* Oo = dry ? (float*)(F.ws + WS_LA) : (float*)F.out;
        const float* md = (const float*)(F.ws + WS_MOD) + ((size_t)l * 3 + mod_row(row)) * (6 * D);
        float z[32]; float s = 0.f;
#pragma unroll
        for (int j = 0; j < 2; ++j)
#pragma unroll
            for (int q = 0; q < 4; ++q) { const int e = j * 1024 + lane * 16 + q * 4; const f32x4 xv = *(const f32x4*)(X + (size_t)row * D + e), gv = *(const f32x4*)(md + 5 * D + e);
                z[j * 16 + q * 4 + 0] = ALPHA * xv.x + gv.x * acc[j][2 * q][0]; z[j * 16 + q * 4 + 1] = ALPHA * xv.y + gv.y * acc[j][2 * q][1]; z[j * 16 + q * 4 + 2] = ALPHA * xv.z + gv.z * acc[j][2 * q + 1][0]; z[j * 16 + q * 4 + 3] = ALPHA * xv.w + gv.w * acc[j][2 * q + 1][1]; }
#pragma unroll
        for (int i = 0; i < 32; ++i) s += z[i];
        const float mean = wave_sum(s) * (1.0f / D); float qv = 0.f;
#pragma unroll
        for (int i = 0; i < 32; ++i) { z[i] -= mean; qv += z[i] * z[i]; }
        const float rstd = __builtin_amdgcn_rsqf(wave_sum(qv) * (1.0f / D) + LN_EPS);
        const float* lg = gin(F.in[I_LN2G]) + (size_t)l * D; const float* lb = gin(F.in[I_LN2B]) + (size_t)l * D; const float* mn = (const float*)(F.ws + WS_MOD) + ((size_t)(l + 1 < DEPTH ? l + 1 : l) * 3 + mod_row(row)) * (6 * D);
#pragma unroll
        for (int j = 0; j < 2; ++j) { unsigned hw[8];
#pragma unroll
            for (int q = 0; q < 4; ++q) { const int e = j * 1024 + lane * 16 + q * 4; const f32x4 g4 = *(const f32x4*)(lg + e), b4 = *(const f32x4*)(lb + e);
                f32x4 o; o.x = z[j * 16 + q * 4 + 0] * rstd * g4.x + b4.x; o.y = z[j * 16 + q * 4 + 1] * rstd * g4.y + b4.y; o.z = z[j * 16 + q * 4 + 2] * rstd * g4.z + b4.z; o.w = z[j * 16 + q * 4 + 3] * rstd * g4.w + b4.w;
                if (l + 1 < DEPTH) { *(f32x4*)(Xo + (size_t)row * D + e) = o; const f32x4 s4 = *(const f32x4*)(mn + e), c4 = *(const f32x4*)(mn + D + e);
                    hw[2 * q] = pk2(o.x * (1.f + c4.x) + s4.x, o.y * (1.f + c4.y) + s4.y); hw[2 * q + 1] = pk2(o.z * (1.f + c4.z) + s4.z, o.w * (1.f + c4.w) + s4.w); }
                else *(f32x4*)(Oo + (size_t)row * D + e) = o; }
            if (l + 1 < DEPTH) { *(v4u*)(Ho + (size_t)row * D + j * 1024 + lane * 16) = (v4u){hw[0], hw[1], hw[2], hw[3]}; *(v4u*)(Ho + (size_t)row * D + j * 1024 + lane * 16 + 8) = (v4u){hw[4], hw[5], hw[6], hw[7]}; } }
}
__device__ __forceinline__ void peer_rows(Frame& F, int l, int nrows, bool dry = false) {
    const int gw = F.vcu * NWAVES + F.wave, NGW = F.G * NWAVES, lane = F.lane;
    for (int row = gw; row < NLAT; row += NGW) { f32x2 acc[2][8]; peer_token(F, l, row, 0, PE_SEL, acc); peer_finish(F, l, row, acc, dry); }
    if (nrows > NLAT) { LAS f32x2* PART = (LAS f32x2*)F.lds;
        for (int r2 = F.vcu * 2 + (F.wave >> 2); r2 < NCTX; r2 += F.G * 2) { const int row = NLAT + r2, part = F.wave & 3, slot = F.wave >> 2; f32x2 acc[2][8];
            peer_token(F, l, row, 32 * part, 32 * part + 32, acc);
            if (part) {
#pragma unroll
                for (int j = 0; j < 2; ++j)
#pragma unroll
                    for (int i = 0; i < 8; ++i) PART[((slot * 3 + part - 1) * 16 + j * 8 + i) * 64 + lane] = acc[j][i]; }
            __syncthreads();
            if (part == 0) {
#pragma unroll
                for (int p = 0; p < 3; ++p)
#pragma unroll
                    for (int j = 0; j < 2; ++j)
#pragma unroll
                        for (int i = 0; i < 8; ++i) acc[j][i] += PART[((slot * 3 + p) * 16 + j * 8 + i) * 64 + lane];
                peer_finish(F, l, row, acc, dry); }
            __syncthreads(); } }
}
#ifndef MK_PER_PHASE
#define MK_PER_PHASE 0
#endif
constexpr int NPH_PRO = 3, NPH_LAYER = 9, NPHASES = NPH_PRO + DEPTH * NPH_LAYER;
__global__ void __launch_bounds__(NTHR, 2) trunk_fwd(Args args) {
    extern __shared__ __attribute__((aligned(16))) unsigned char lds_raw[];
    Frame F0;
    F0.lds = (LAS unsigned char*)lds_raw;
    F0.tid = threadIdx.x; F0.lane = F0.tid & 63; F0.wave = __builtin_amdgcn_readfirstlane(F0.tid >> 6);
    F0.G = gridDim.x; { const int bx = blockIdx.x; F0.vcu = (F0.G % 8 == 0) ? (bx % 8) * (F0.G / 8) + bx / 8 : bx; }
    F0.in = args.in; F0.out = (GAS float*)args.out; F0.ws = (GAS unsigned char*)args.ws;
    volatile LAS unsigned* MISC = (volatile LAS unsigned*)(F0.lds + MISC_OFF);
    for (int u = F0.tid; u < (LDS_BYTES - LDSCTL_OFF) / 4; u += NTHR) ((LAS unsigned*)(F0.lds + LDSCTL_OFF))[u] = 0u;
    __syncthreads();
    const int lo = args.ph_lo, hi = args.ph_hi;
    XcdBarrier bar; bar.bar = (unsigned*)(F0.ws + WS_CTL) + CW_BAR; bar.x = 0; bar.st = nullptr;
    if (hi - lo > 1) bar = xcd_barrier_post((unsigned*)(F0.ws + WS_CTL) + CW_BAR, MISC + 8);
#ifndef PHMASK
#define PHMASK 0xfff
#endif
#define PHM(b) ((PHMASK >> (b)) & 1)
#ifndef PHREP
#define PHREP 0
#endif
#define NREP(b) (1 + ((PHREP >> (b)) & 1))
#define IN(k) (lo <= (k) && (k) < hi)
#define LAUNDER() Frame F = F0; int bx_ = blockIdx.x; { int ws_ = F0.wave; asm volatile("" : "+s"(ws_)); int ln_; asm volatile("v_mbcnt_lo_u32_b32 %0, -1, 0\n\tv_mbcnt_hi_u32_b32 %0, -1, %0" : "=v"(ln_)); F.wave = ws_; F.lane = ln_; F.tid = ws_ * 64 + ln_; \
    GAS unsigned char* w_ = F0.ws; asm volatile("" : "+s"(w_)); F.ws = w_; int v_ = F0.vcu; asm volatile("" : "+s"(v_)); F.vcu = v_; int g_ = F0.G; asm volatile("" : "+s"(g_)); F.G = g_; \
    GAS float* o_ = F0.out; asm volatile("" : "+s"(o_)); F.out = o_; asm volatile("" : "+s"(bx_)); \
    unsigned l_ = (unsigned)(size_t)F0.lds; asm volatile("" : "+v"(l_)); F.lds = (LAS unsigned char*)(size_t)l_; }
#define SEAM(k) do { if (IN(k) && IN((k) + 1)) xcd_barrier(bar); } while (0)

    if (PHM(0) && IN(0)) for (int rep_ = 0; rep_ < NREP(0); ++rep_) { LAUNDER(); p0_prologue(F); } SEAM(0);
    if (PHM(1) && IN(1)) { LAUNDER(); p0b_mod_reduce(F); } SEAM(1);
    if (PHM(2) && IN(2)) { LAUNDER(); modulate_rows(F, 0, 0, MTOT); } SEAM(2);

#pragma unroll 1
    for (int l = 0; l < DEPTH; ++l) {
        const int pb = NPH_PRO + l * NPH_LAYER;
        const int mrows = (l + 1 < DEPTH) ? MTOT : NLAT;
        if (PHM(3) && IN(pb + 0)) for (int rep_ = 0; rep_ < NREP(3); ++rep_) { LAUNDER(); pg8::Gemm g{(const pg8::bf16_t*)(F.ws + WS_H), (const pg8::bf16_t*)(F.ws + WS_WIN) + (size_t)l * IN_PAD * D, MTOT, IN_PAD, D, D};
            pg8::StaticOrder S; S.init(MTOT, IN_PAD, F.G, bx_); pg8::EpiBf16<0> E{(pg8::bf16_t*)(F.ws + WS_P), IN_PAD, nullptr, 0, 0};
            pg8::gemm_phase<pg8::EpiBf16<0>, pg8::StaticOrder, false>(F.lds, g, S, E, nullptr, F.tid); }
        SEAM(pb + 0);
        if (PHM(4) && IN(pb + 1)) for (int rep_ = 0; rep_ < NREP(4); ++rep_) { LAUNDER(); for (int r2 = 0; r2 < NREP(12); ++r2) for (int u = F.vcu; u < NTILE * NH; u += F.G) lru_prep_unit(F, l, u >> 4, u & 15); asm volatile("" ::: "memory"); for (int r2 = 0; r2 < NREP(13); ++r2) { int cur_hd = -1;
                for (int v = F.vcu; v < 2 * NTILE * NH; v += F.G) { const int hh_ = (v >> 1) & 15, d_ = v & 1;
                    if (hh_ * 2 + d_ != cur_hd) { cur_hd = hh_ * 2 + d_; __syncthreads(); LAS float* MUS = (LAS float*)(F.lds + 125184); const float* mu = gin(F.in[I_MU]) + (size_t)l * 2 * RW_COLS;
                        for (int i = F.tid; i < 5 * 2 * 64; i += NTHR) { const int g = i >> 7, wh = (i >> 6) & 1, col = i & 63; const int rc = g < 3 ? g * RWW + hh_ * 64 : 3 * RWW + (g - 3) * 128 + d_ * 64; MUS[i] = mu[(size_t)wh * RW_COLS + rc + col]; }
                        __syncthreads(); }
                    rwkv_chunk_prep(F, l, v >> 5, hh_, d_); } } }
        SEAM(pb + 1);
        if (PHM(5) && IN(pb + 2)) for (int rep_ = 0; rep_ < NREP(5); ++rep_) { LAUNDER(); for (int u = F.vcu; u < 256; u += F.G) { if (u < 32 && F.wave >= 2 && F.wave < 4) lru_scan(F, u * 128 + F.tid - 128); rwkv_chain_chunks(F, u); } }
        SEAM(pb + 2);
        if (PHM(6) && IN(pb + 3)) for (int rep_ = 0; rep_ < NREP(6); ++rep_) { LAUNDER(); for (int u = F.vcu; u < 4 * NTILE; u += F.G) merge_unit(F, l, u); }
        SEAM(pb + 3);
        if (PHM(7) && IN(pb + 4)) for (int rep_ = 0; rep_ < NREP(7); ++rep_) { LAUNDER(); pg8::Gemm g{(const pg8::bf16_t*)(F.ws + WS_H), (const pg8::bf16_t*)(F.ws + WS_WOUT) + (size_t)l * D * D, mrows, D, D, D};
            pg8::StaticOrder S; S.init(mrows, D, F.G, bx_); pg8::EpiBf16<0> E{(pg8::bf16_t*)(F.ws + WS_O), D, nullptr, 0, 0};
            pg8::gemm_phase<pg8::EpiBf16<0>, pg8::StaticOrder, false>(F.lds, g, S, E, nullptr, F.tid); }
        SEAM(pb + 4);
        if (PHM(8) && IN(pb + 5)) { LAUNDER(); if (NREP(8) > 1) ln1_rows(F, l, mrows, true); ln1_rows(F, l, mrows); }
        SEAM(pb + 5);
        if (PHM(9) && IN(pb + 6)) for (int rep_ = 0; rep_ < NREP(9); ++rep_) { LAUNDER(); pg8::Gemm g{(const pg8::bf16_t*)(F.ws + WS_H), (const pg8::bf16_t*)(F.ws + WS_WQ) + (size_t)l * D * D, mrows, D, D, D};
            pg8::StaticOrder S; S.init(mrows, D, F.G, bx_); pg8::EpiBf16<0> E{(pg8::bf16_t*)(F.ws + WS_QP), D, nullptr, 0, 0};
            pg8::gemm_phase<pg8::EpiBf16<0>, pg8::StaticOrder, false>(F.lds, g, S, E, nullptr, F.tid); }
        SEAM(pb + 6);
        if (PHM(10) && IN(pb + 7)) for (int rep_ = 0; rep_ < NREP(10); ++rep_) { LAUNDER(); for (int u = F.vcu; u < (mrows / 64) * PE_H; u += F.G) peer_topk_unit(F, l, u >> 3, u & 7); }
        SEAM(pb + 7);
        if (PHM(11) && IN(pb + 8)) { LAUNDER(); if (NREP(11) > 1) peer_rows(F, l, mrows, true); peer_rows(F, l, mrows); }
        if (l + 1 < DEPTH) SEAM(pb + 8);
    }
#undef IN
#undef SEAM
}

extern "C" void kernel_launch(void* const* d_in, const int* in_sizes, int n_in, void* d_out, int out_size, void* d_ws, size_t ws_size, hipStream_t stream) {
    static int grid = 0;
    if (grid == 0) {
        if (n_in != N_IN || out_size != NLAT * D || ws_size < WS_END) { fprintf(stderr, "kernel_launch: unexpected shapes (n_in %d, out %d, ws %zu < %zu)\n", n_in, out_size, ws_size, (size_t)WS_END); grid = -1; return; }
        int dev = 0, cus = 0, per_cu = 0;
        if (hipGetDevice(&dev) != hipSuccess || hipDeviceGetAttribute(&cus, hipDeviceAttributeMultiprocessorCount, dev) != hipSuccess) { grid = -1; return; }
        if (hipFuncSetAttribute((const void*)trunk_fwd, hipFuncAttributeMaxDynamicSharedMemorySize, LDS_BYTES) != hipSuccess) { fprintf(stderr, "kernel_launch: hipFuncSetAttribute failed\n"); grid = -1; return; }
        if (hipOccupancyMaxActiveBlocksPerMultiprocessor(&per_cu, (const void*)trunk_fwd, NTHR, LDS_BYTES) != hipSuccess || per_cu < 1) fprintf(stderr, "kernel_launch: occupancy query reports %d\n", per_cu);
        (void)hipGetLastError();
        grid = cus;
    }
    if (grid < 0) return;
    (void)hipMemsetAsync((char*)d_ws + WS_CTL, 0, CTL_ZERO_BYTES, stream);
    Args a{};
    for (int i = 0; i < N_IN; ++i) a.in[i] = (const float*)d_in[i];
    a.out = (float*)d_out; a.ws = (unsigned char*)d_ws;
#if MK_PER_PHASE
    for (int ph = 0; ph < NPHASES; ++ph) { a.ph_lo = ph; a.ph_hi = ph + 1; hipLaunchKernelGGL(trunk_fwd, dim3(grid), dim3(NTHR), LDS_BYTES, stream, a); }
#else
    a.ph_lo = 0; a.ph_hi = NPHASES;
    hipLaunchKernelGGL(trunk_fwd, dim3(grid), dim3(NTHR), LDS_BYTES, stream, a);
#endif
    const hipError_t le = hipPeekAtLastError();
    if (le != hipSuccess) fprintf(stderr, "kernel_launch: launch failed: %s\n", hipGetErrorName(le));
}
```

```cpp
#include <hip/hip_runtime.h>
#include <cstdio>
#include <cstdint>

constexpr int D = 2048, NB = 2, SEQ = 4096, DEPTH = 4, CTXL = 256;
constexpr int NLAT = NB * SEQ, NCTX = NB * CTXL, MTOT = NLAT + NCTX;
constexpr int LRW = 1024, RWW = 1024, NH = 16, HD = 64;
constexpr int RW_COLS = 3488, IN_COLS = 5536, IN_PAD = 5632;
constexpr int PE_H = 8, PE_K = 128, PE_DQ = 256, PE_TOP = 16, PE_NE = 16384, PE_SEL = PE_H * PE_TOP;
constexpr int NTILE = MTOT / 64;
constexpr float ALPHA = 1.681792830507429f;
constexpr float LN_EPS = 1e-5f, GN_EPS = 64e-5f;
constexpr int KSPLIT = 16;

enum { I_X = 0, I_C, I_CTX, I_CCTX, I_ADAW, I_ADAB, I_WIN, I_CONVW, I_CONVB, I_WA, I_BA, I_WX, I_BX, I_LAM, I_MU, I_W0, I_W2, I_A0, I_A2, I_G2,
       I_KK, I_KA, I_RK, I_GNG, I_GNB, I_WOUT, I_LN1G, I_LN1B, I_WQ, I_SUBK, I_U, I_V, I_LN2G, I_LN2B, N_IN };

constexpr size_t MiB = 1u << 20;
constexpr size_t al(size_t x) { return (x + MiB - 1) / MiB * MiB; }
constexpr size_t WS_CTL = 0, CTL_ZERO_BYTES = 1 * MiB;
constexpr size_t WS_MOD   = WS_CTL + CTL_ZERO_BYTES;
constexpr size_t WS_MODP  = al(WS_MOD + (size_t)DEPTH * 3 * 6 * D * 4);
constexpr size_t WS_WIN   = al(WS_MODP + (size_t)KSPLIT * DEPTH * 3 * 6 * D * 4);
constexpr size_t WS_WOUT  = al(WS_WIN + (size_t)DEPTH * IN_PAD * D * 2);
constexpr size_t WS_WQ    = al(WS_WOUT + (size_t)DEPTH * D * D * 2);
constexpr size_t WS_SUBK  = al(WS_WQ + (size_t)DEPTH * D * D * 2);
constexpr size_t WS_WLRU  = al(WS_SUBK + (size_t)DEPTH * 8 * 2 * 128 * 128 * 2);
constexpr size_t WS_W2T   = al(WS_WLRU + (size_t)DEPTH * 2 * 2 * 16 * 64 * 64 * 2);
constexpr size_t WS_A2T   = al(WS_W2T + (size_t)DEPTH * 2 * 1024 * 64 * 2);
constexpr size_t WS_G2T   = al(WS_A2T + (size_t)DEPTH * 2 * 1024 * 64 * 2);
constexpr size_t WS_UB    = al(WS_G2T + (size_t)DEPTH * 1024 * 160 * 2);
constexpr size_t WS_VB    = al(WS_UB + (size_t)DEPTH * PE_NE * D);
constexpr size_t WS_SU    = al(WS_VB + (size_t)DEPTH * PE_NE * D);
constexpr size_t WS_SV    = al(WS_SU + (size_t)DEPTH * PE_NE * 4);
constexpr size_t WS_X     = al(WS_SV + (size_t)DEPTH * PE_NE * 4);
constexpr size_t WS_H     = al(WS_X + (size_t)MTOT * D * 4);
constexpr size_t WS_P     = al(WS_H + (size_t)MTOT * D * 2);
constexpr size_t WS_LA    = al(WS_P + (size_t)MTOT * IN_PAD * 4);
constexpr size_t WS_LB    = al(WS_LA + (size_t)2 * MTOT * LRW * 4);
constexpr size_t WS_LAGG  = al(WS_LB + (size_t)2 * MTOT * LRW * 4);
constexpr size_t WS_LHIN  = al(WS_LAGG + (size_t)4 * NTILE * LRW * 4);
constexpr int KSL = 8;
constexpr size_t WS_SLAB  = al(WS_LHIN + (size_t)2 * NTILE * LRW * 4);
constexpr size_t WS_YL    = al(WS_SLAB + (size_t)2 * KSL * NCTX * D * 4);
constexpr int NUNIT = NTILE * NH * 2;
constexpr size_t WS_RV    = al(WS_YL + 4096);
constexpr size_t WS_QM    = al(WS_RV + (size_t)MTOT * RWW * 4);
constexpr size_t WS_PHI   = al(WS_QM + (size_t)NUNIT * 4096 * 2);
constexpr size_t WS_Y0F   = al(WS_PHI + (size_t)NUNIT * 4096 * 2);
constexpr size_t WS_PSF   = al(WS_Y0F + (size_t)NUNIT * 4096 * 2);
constexpr size_t WS_YR    = al(WS_PSF + (size_t)NUNIT * 4096 * 2);
constexpr size_t WS_BETA  = al(WS_YR + (size_t)2 * MTOT * RWW * 4);
constexpr size_t WS_IDX   = al(WS_BETA + (size_t)2 * MTOT * NH * 4);
constexpr size_t WS_GATE  = al(WS_IDX + (size_t)MTOT * PE_SEL * 4);
constexpr size_t WS_END   = al(WS_GATE + (size_t)MTOT * PE_SEL * 4);
constexpr size_t WS_O = WS_P;
constexpr size_t WS_QP = WS_P + (size_t)MTOT * D * 4;
static_assert(WS_QP + (size_t)MTOT * D * 4 <= WS_LA, "O/QP overlay inside P");

constexpr int CW_BAR = 4096;

constexpr int RING_BYTES = 131072;
constexpr int LDSCTL_OFF = RING_BYTES, MISC_OFF = LDSCTL_OFF + 320;
constexpr int LDS_BYTES = 147456;
constexpr int NWAVES = 8, NTHR = 512;

#define GAS __attribute__((address_space(1)))
#define LAS __attribute__((address_space(3)))
typedef unsigned short bf16;
typedef unsigned v4u __attribute__((ext_vector_type(4)));
typedef unsigned v2u __attribute__((ext_vector_type(2)));
typedef float f32x4 __attribute__((ext_vector_type(4)));
typedef float f32x2 __attribute__((ext_vector_type(2)));
typedef short bf16x8 __attribute__((ext_vector_type(8)));
#define RLX_AGENT __ATOMIC_RELAXED, __HIP_MEMORY_SCOPE_AGENT
#define LDS_WAIT() asm volatile("s_waitcnt lgkmcnt(0)" ::: "memory")
#define VM_WAIT() asm volatile("s_waitcnt vmcnt(0)" ::: "memory")

__device__ __forceinline__ const float* gin(const float* p) { return (const float*)(const GAS float*)p; }
__device__ __forceinline__ unsigned f2bf(float f) { unsigned u = __builtin_bit_cast(unsigned, f); return (u + 0x7fffu + ((u >> 16) & 1u)) >> 16; }
typedef __bf16 bf16x2t __attribute__((ext_vector_type(2)));
__device__ __forceinline__ unsigned pk2(float lo, float hi) { return __builtin_bit_cast(unsigned, __builtin_convertvector((f32x2){lo, hi}, bf16x2t)); }
__device__ __forceinline__ float bf_lo(unsigned w) { return __builtin_bit_cast(float, w << 16); }
__device__ __forceinline__ float bf_hi(unsigned w) { return __builtin_bit_cast(float, w & 0xffff0000u); }
__device__ __forceinline__ float fexp(float x) { return __builtin_amdgcn_exp2f(x * 1.4426950408889634f); }
__device__ __forceinline__ float fsigmoid(float x) { return __builtin_amdgcn_rcpf(1.0f + fexp(-x)); }
__device__ __forceinline__ float fsoftplus(float x) { return fmaxf(x, 0.f) + 0.6931471805599453f * __builtin_amdgcn_logf(1.0f + fexp(-fabsf(x))); }
__device__ __forceinline__ float ftanh(float x) { const float e = fexp(2.0f * x); return 1.0f - 2.0f * __builtin_amdgcn_rcpf(e + 1.0f); }
__device__ __forceinline__ float gelu_tanh(float x) { return 0.5f * x * (1.0f + ftanh(0.7978845608028654f * (x + 0.044715f * x * x * x))); }
__device__ __forceinline__ float gelu_erf(float v) {
    const float av = fabsf(v), t = __builtin_amdgcn_rcpf(av * 0.2316418882f + 1.0f);
    float q = t * 0.5307027145f + (-0.7265760135f); q = q * t + 0.7107068705f; q = q * t + (-0.142248368f); q = q * t + 0.127414796f; q = q * t;
    const float e = __builtin_amdgcn_exp2f((v * v) * (-0.72134752044f));
    const float m = v * (q * e);
    return v < 0.f ? m : v - m;
}
template <int CTRL> __device__ __forceinline__ float dpp_f(float v) { return __builtin_bit_cast(float, __builtin_amdgcn_update_dpp(0, __builtin_bit_cast(int, v), CTRL, 0xf, 0xf, true)); }
__device__ __forceinline__ float red8(float v) { v += dpp_f<0xB1>(v); v += dpp_f<0x4E>(v); v += dpp_f<0x141>(v); return v; }
__device__ __forceinline__ float red16(float v) { v = red8(v); v += dpp_f<0x140>(v); return v; }
__device__ __forceinline__ float wave_total(float v) {
    v = red16(v);
    v += __builtin_bit_cast(float, __builtin_amdgcn_update_dpp(0, __builtin_bit_cast(int, v), 0x142, 0xa, 0xf, false));
    v += __builtin_bit_cast(float, __builtin_amdgcn_update_dpp(0, __builtin_bit_cast(int, v), 0x143, 0xc, 0xf, false));
    return __builtin_bit_cast(float, __builtin_amdgcn_readlane(__builtin_bit_cast(int, v), 63));
}
__device__ __forceinline__ float wave_sum(float v) { return wave_total(v); }
__device__ __forceinline__ float wave_max(float v) {
    v = fmaxf(v, dpp_f<0xB1>(v)); v = fmaxf(v, dpp_f<0x4E>(v)); v = fmaxf(v, dpp_f<0x141>(v)); v = fmaxf(v, dpp_f<0x140>(v));
    const float a = __builtin_bit_cast(float, __builtin_amdgcn_readlane(__builtin_bit_cast(int, v), 0)), b = __builtin_bit_cast(float, __builtin_amdgcn_readlane(__builtin_bit_cast(int, v), 16));
    const float c = __builtin_bit_cast(float, __builtin_amdgcn_readlane(__builtin_bit_cast(int, v), 32)), d = __builtin_bit_cast(float, __builtin_amdgcn_readlane(__builtin_bit_cast(int, v), 48));
    return fmaxf(fmaxf(a, b), fmaxf(c, d));
}

#define XB_TMO      128
#define XB_XCNT(j)  (256  + 64 * (j))
#define XB_XSUB(j)  (1280 + 64 * (j))
#define XB_XGEN(j)  (2304 + 64 * (j))
#define XB_TOP      3328
#define XB_TOPGEN   3392
#define XCD_BAR_WORDS 3456
#define XB_SPIN_CAP (1u << 18)

__device__ __forceinline__ unsigned xb_ld(unsigned* p)              { return __hip_atomic_load(p, __ATOMIC_RELAXED, __HIP_MEMORY_SCOPE_AGENT); }
__device__ __forceinline__ unsigned xb_add(unsigned* p, unsigned v) { return __hip_atomic_fetch_add(p, v, __ATOMIC_RELAXED, __HIP_MEMORY_SCOPE_AGENT); }
__device__ __forceinline__ unsigned xb_xcc_id() { return (unsigned)__builtin_amdgcn_s_getreg((3 << 11) | 20) & 0xFu; }
#define XB_SPIN(cond, bar) do { unsigned _sp = 0; while (cond) { __builtin_amdgcn_s_sleep(1); \
    if ((++_sp & 255u) == 0u) { if (xb_ld(&(bar)[XB_TMO])) break; if (_sp > XB_SPIN_CAP) { atomicAdd(&(bar)[XB_TMO], 1u); break; } } } } while (0)

struct XcdBarrier {
    unsigned* bar; unsigned x;
    volatile LAS unsigned* st;
};

__device__ __forceinline__ XcdBarrier xcd_barrier_post(unsigned* bar, volatile LAS unsigned* st) {
    XcdBarrier b; b.bar = bar; b.x = xb_xcc_id(); b.st = st;
    if (threadIdx.x == 0) (void)xb_add(&bar[XB_XCNT(b.x)], 1u);
    return b;
}
__device__ __forceinline__ void xcd_barrier_complete(unsigned* bar, unsigned x, unsigned& nloc, unsigned& nx) {
    const unsigned G = gridDim.x * gridDim.y * gridDim.z;
    unsigned sum, cnt, mine, sp = 0u;
    for (;;) {
        sum = 0u; cnt = 0u; mine = 0u;
#pragma unroll
        for (unsigned j = 0; j < 16; ++j) { const unsigned c = xb_ld(&bar[XB_XCNT(j)]); sum += c; cnt += (c > 0u) ? 1u : 0u; }
        if (sum == G) { mine = xb_ld(&bar[XB_XCNT(x)]); break; }
        __builtin_amdgcn_s_sleep(1);
        if ((++sp & 255u) == 0u) { if (xb_ld(&bar[XB_TMO])) break; if (sp > XB_SPIN_CAP) { atomicAdd(&bar[XB_TMO], 1u); break; } }
    }
    nloc = mine > 0u ? mine : 1u; nx = cnt > 0u ? cnt : 1u;
}

__device__ __forceinline__ void xcd_barrier(const XcdBarrier& b) {
    asm volatile("s_waitcnt vmcnt(0)" ::: "memory");
    __syncthreads();
    if (threadIdx.x == 0) {
        unsigned* bar = b.bar;
        __builtin_amdgcn_s_waitcnt(0);
        unsigned nloc = b.st[0], nx = b.st[1];
        if (nloc == 0u) { xcd_barrier_complete(bar, b.x, nloc, nx); b.st[0] = nloc; b.st[1] = nx; }
        const unsigned old = xb_add(&bar[XB_XSUB(b.x)], 1u);
        const unsigned gen = old / nloc;
        if (old + 1u == (gen + 1u) * nloc) {
            __builtin_amdgcn_fence(__ATOMIC_RELEASE, "agent");
            asm volatile("s_waitcnt vmcnt(0)" ::: "memory");
            const unsigned og = xb_add(&bar[XB_TOP], 1u);
            const unsigned tg = og / nx;
            if (og + 1u == (tg + 1u) * nx) xb_add(&bar[XB_TOPGEN], 1u);
            else XB_SPIN(xb_ld(&bar[XB_TOPGEN]) == tg, bar);
            __builtin_amdgcn_fence(__ATOMIC_ACQUIRE, "agent");
            xb_add(&bar[XB_XGEN(b.x)], 1u);
            asm volatile("s_waitcnt vmcnt(0)" ::: "memory");
        } else {
            XB_SPIN(xb_ld(&bar[XB_XGEN(b.x)]) == gen, bar);
            __builtin_amdgcn_fence(__ATOMIC_ACQUIRE, "agent");
            asm volatile("s_waitcnt vmcnt(0)" ::: "memory");
        }
    }
    __syncthreads();
}
namespace pg8 {
#define PG8_LAS __attribute__((address_space(3)))
typedef unsigned short bf16_t;
typedef short bf16x8 __attribute__((ext_vector_type(8)));
typedef float f32x4 __attribute__((ext_vector_type(4)));
typedef unsigned u32x4 __attribute__((ext_vector_type(4)));
constexpr int BM = 256, BK = 64, HALF = 128, HTB = HALF * BK * 2  , STAGE_BYTES = 8 * HTB, NXCD = 8, WGM = 8;

__host__ __device__ __forceinline__ int lds_byte(int r, int c) { const int st = (r >> 4) * 2 + (c >> 5), rr = r & 15, cc = c & 31, ob = rr * 64 + cc * 2; return st * 1024 + (ob ^ (((ob >> 9) & 1) << 5)); }
__host__ __device__ __forceinline__ void stage_rc(int b, int& R, int& C) { const int st = b / 1024, sb = b % 1024, swz = sb ^ (((sb >> 9) & 1) << 5); R = (st >> 1) * 16 + swz / 64; C = (st & 1) * 32 + (swz % 64) / 2; }
__host__ __device__ __forceinline__ int perm32(int rho) { const int n = rho >> 4, i = rho & 15; return 8 * (i >> 2) + 4 * n + (i & 3); }

struct Unit { int pm, pn, kofs = 0, slab = 0; };
struct Gemm { const bf16_t* A; const bf16_t* Bt; int M, N, K, ld; };

struct StaticOrder {
    int nM, nN, nwg, G, c;
    __host__ __device__ void init(int M, int N, int G_, int c_) { nM = M / BM; nN = N / BM; nwg = nM * nN; G = G_; c = c_; }
    __host__ __device__ bool next(int i, Unit& u) const {
        const long L = (long)i * G + c; if (L >= nwg) return false;
        int wgid = (int)L; { const int q = nwg / NXCD, r = nwg % NXCD, xcd = wgid % NXCD, off = wgid / NXCD; wgid = (xcd < r ? xcd * (q + 1) : r * (q + 1) + (xcd - r) * q) + off; }
        const int nig = WGM * nN, gid = wgid / nig, fm = gid * WGM, gsz = (nM - fm) < WGM ? (nM - fm) : WGM;
        u.pm = fm + ((wgid % nig) % gsz); u.pn = (wgid % nig) / gsz; return true;
    }
    __device__ __forceinline__ void a_ready(const Unit&) const {}
    __device__ __forceinline__ void done(const Unit&) const {}
};
struct SplitKOrder {
    int nM, nN, nS, klen, G, c;
    __host__ __device__ void init(int M, int N, int nS_, int klen_, int G_, int c_) { nM = M / BM; nN = N / BM; nS = nS_; klen = klen_; G = G_; c = c_; }
    __host__ __device__ bool next(int i, Unit& u) const { const long L = (long)i * G + c; if (L >= (long)nM * nN * nS) return false; const int l = (int)L; u.pm = l % nM; u.pn = (l / nM) % nN; const int ks = l / (nM * nN); u.kofs = ks * klen; u.slab = ks; return true; }
    __device__ __forceinline__ void a_ready(const Unit&) const {}
    __device__ __forceinline__ void done(const Unit&) const {}
};
struct CountedOrder : StaticOrder {
    const unsigned* ready; unsigned need; unsigned* tmo;
    __device__ __forceinline__ void a_ready(const Unit& u) const {
        if (threadIdx.x < 64) {
            const unsigned long long t0 = __builtin_amdgcn_s_memrealtime(); unsigned polls = 0;
            while ((unsigned)__builtin_amdgcn_readfirstlane(__hip_atomic_load(ready + 64 * u.pm, __ATOMIC_RELAXED, __HIP_MEMORY_SCOPE_AGENT)) < need) {
                if ((++polls & 255u) == 0u && __builtin_amdgcn_readfirstlane(__hip_atomic_load(tmo, __ATOMIC_RELAXED, __HIP_MEMORY_SCOPE_AGENT)) != 0u) break;
                if (__builtin_amdgcn_s_memrealtime() - t0 > 2000000ull) {
                    if (threadIdx.x == 0) { unsigned expect = 0u; __hip_atomic_compare_exchange_strong(tmo + 1, &expect, 0x600u | (unsigned)(u.pm & 0xff), __ATOMIC_RELAXED, __ATOMIC_RELAXED, __HIP_MEMORY_SCOPE_AGENT); __hip_atomic_store(tmo, 1u, __ATOMIC_RELAXED, __HIP_MEMORY_SCOPE_AGENT); }
                    break; }
                __builtin_amdgcn_s_sleep(2); }
            __builtin_amdgcn_fence(__ATOMIC_ACQUIRE, "agent");
            asm volatile("s_waitcnt vmcnt(0)" ::: "memory");
        }
#if !defined(BROKEN_HOOK_NO_BARRIER)
        asm volatile("" ::: "memory"); __builtin_amdgcn_s_barrier(); asm volatile("" ::: "memory");
#endif
    }
};

__device__ __forceinline__ unsigned cvt_pk_bf16(float lo, float hi) { unsigned r; asm volatile("v_cvt_pk_bf16_f32 %0, %1, %2" : "=v"(r) : "v"(lo), "v"(hi)); return r; }
typedef float f32x2 __attribute__((ext_vector_type(2)));
__device__ __forceinline__ f32x2 gelu_pk(f32x2 v) {
    const f32x2 av = __builtin_elementwise_abs(v), d = av * 0.2316418882f + 1.0f;
    f32x2 t; t.x = __builtin_amdgcn_rcpf(d.x); t.y = __builtin_amdgcn_rcpf(d.y);
    f32x2 q = t * 0.5307027145f + (-0.7265760135f); q = q * t + 0.7107068705f; q = q * t + (-0.142248368f); q = q * t + 0.127414796f; q = q * t;
    const f32x2 s = (v * v) * (-0.72134752044f);
    f32x2 e; e.x = __builtin_amdgcn_exp2f(s.x); e.y = __builtin_amdgcn_exp2f(s.y);
    const f32x2 m = v * (q * e), r = v - m;
    f32x2 o; o.x = v.x < 0.f ? m.x : r.x; o.y = v.y < 0.f ? m.y : r.y; return o;
}

struct EpiF32 {
    static constexpr bool PERM = false, AFTER_DRAIN = false;
    float* C; int ldc; const float* bias; size_t slab_stride = 0;
    __device__ __forceinline__ void operator()(const f32x4 (&acc)[2][2][4][2], const Unit& u, int wr, int wc, int fr, int fq) const {
        const int row0 = u.pm * BM + wr * 64 + fr, col0 = u.pn * BM + wc * 32 + 4 * fq; float* const Cb = C + (size_t)u.slab * slab_stride;
        f32x4 bv[2][2];
#pragma unroll
        for (int bj = 0; bj < 2; ++bj)
#pragma unroll
            for (int n = 0; n < 2; ++n) bv[bj][n] = bias ? *(const f32x4*)(bias + col0 + bj * HALF + n * 16) : (f32x4){0.f, 0.f, 0.f, 0.f};
#pragma unroll
        for (int ai = 0; ai < 2; ++ai)
#pragma unroll
            for (int m = 0; m < 4; ++m) { float* rowp = Cb + (size_t)(row0 + ai * HALF + m * 16) * ldc + col0;
#pragma unroll
                for (int bj = 0; bj < 2; ++bj)
#pragma unroll
                    for (int n = 0; n < 2; ++n) *(f32x4*)(rowp + bj * HALF + n * 16) = acc[ai][bj][m][n] + bv[bj][n]; }
    }
};
template <int ACT  > struct EpiBf16 {
    static constexpr bool PERM = true, AFTER_DRAIN = false;
    bf16_t* O; int ldc; const float* bias; int split_cols; size_t split_stride;
    __device__ __forceinline__ void operator()(const f32x4 (&acc)[2][2][4][2], const Unit& u, int wr, int wc, int fr, int fq) const {
        const int row0 = u.pm * BM + wr * 64 + fr; int colt = u.pn * BM; bf16_t* base = O;
        if (split_cols) { const int t = colt / split_cols; base += (size_t)t * split_stride; colt -= t * split_cols; }
        const int col0 = colt + wc * 32 + 8 * fq, bcol0 = u.pn * BM + wc * 32 + 8 * fq;
        f32x4 bv[2][2];
#pragma unroll
        for (int bj = 0; bj < 2; ++bj)
#pragma unroll
            for (int n = 0; n < 2; ++n) bv[bj][n] = bias ? *(const f32x4*)(bias + bcol0 + bj * HALF + 4 * n) : (f32x4){0.f, 0.f, 0.f, 0.f};
#pragma unroll
        for (int ai = 0; ai < 2; ++ai)
#pragma unroll
            for (int m = 0; m < 4; ++m) { bf16_t* rowp = base + (size_t)(row0 + ai * HALF + m * 16) * ldc + col0;
#pragma unroll
                for (int bj = 0; bj < 2; ++bj) { f32x4 v0 = acc[ai][bj][m][0] + bv[bj][0], v1 = acc[ai][bj][m][1] + bv[bj][1];
                    if (ACT == 1) { f32x2 a = gelu_pk((f32x2){v0[0], v0[1]}), b = gelu_pk((f32x2){v0[2], v0[3]}), c = gelu_pk((f32x2){v1[0], v1[1]}), d = gelu_pk((f32x2){v1[2], v1[3]});
                        v0 = (f32x4){a.x, a.y, b.x, b.y}; v1 = (f32x4){c.x, c.y, d.x, d.y}; }
                    if (ACT == 2) {
#pragma unroll
                        for (int j = 0; j < 4; ++j) { v0[j] = 0.5f * v0[j] * (1.0f + erff(v0[j] * 0.70710678f)); v1[j] = 0.5f * v1[j] * (1.0f + erff(v1[j] * 0.70710678f)); } }
                    u32x4 w; w.x = cvt_pk_bf16(v0[0], v0[1]); w.y = cvt_pk_bf16(v0[2], v0[3]); w.z = cvt_pk_bf16(v1[0], v1[1]); w.w = cvt_pk_bf16(v1[2], v1[3]);
                    *(u32x4*)(rowp + bj * HALF) = w; } }
    }
};
template <class Epi, class Sched, bool STAMP = false>
__device__ __forceinline__ void gemm_phase(PG8_LAS unsigned char* lds, const Gemm g, const Sched& S, const Epi& E, unsigned long long* stamps, const int tid) {
    const int  wid = __builtin_amdgcn_readfirstlane(tid >> 6), lane = tid & 63, wr = wid >> 2, wc = wid & 3, fr = lane & 15, fq = lane >> 4;
    const int K = g.ld, nt = g.K / BK;
    int ts_lo = 0, ts_hi = 0, nts = 0; const unsigned long long rt_entry = STAMP ? (unsigned long long)wall_clock64() : 0ull;
#define PG8_STAMP() do { if (STAMP && wid == 0 && nts < 64) { const unsigned long long _c = (unsigned long long)clock64(); \
        ts_lo = (lane == nts) ? (int)(unsigned)_c : ts_lo; ts_hi = (lane == nts) ? (int)(unsigned)(_c >> 32) : ts_hi; ++nts; } } while (0)
    PG8_STAMP();
    unsigned voffA[2], voffB[2];
#pragma unroll
    for (int i = 0; i < 2; ++i) { int R, C; stage_rc(tid * 16 + i * 8192, R, C); const int Rb = Epi::PERM ? ((R & ~31) + perm32(R & 31)) : R;
        voffA[i] = (unsigned)(R * K + C) * 2u; voffB[i] = (unsigned)(Rb * K + C) * 2u; }
    const size_t kstep = (size_t)(BK * 2);
    const size_t hstep = (size_t)HALF * K * 2;
    const size_t tstep = 2 * hstep;
    const unsigned ldsw = (unsigned)wid * 1024u;
    const int aoff = lds_byte(wr * 64 + fr, fq * 8), boff = lds_byte(wc * 32 + fr, fq * 8);
#define PG8_SA(b, h) (((b) * 2 + (h)) * HTB)
#define PG8_SB(b, h) ((4 + (b) * 2 + (h)) * HTB)
#define PG8_STAGE(bufoff, gbase, voff) do { _Pragma("unroll") for (int _i = 0; _i < 2; ++_i) \
        __builtin_amdgcn_global_load_lds((const unsigned*)((const char*)(gbase) + (voff)[_i]), (PG8_LAS unsigned*)(lds + (bufoff) + ldsw + _i * 8192), 16, 0, 0); } while (0)
#define PG8_LDA(dst, b, h) do { _Pragma("unroll") for (int m = 0; m < 4; ++m) _Pragma("unroll") for (int k = 0; k < 2; ++k) dst[m][k] = *(const PG8_LAS bf16x8*)(lds + PG8_SA(b, h) + aoff + m * 2048 + k * 1024); } while (0)
#define PG8_LDB(dst, b, h) do { _Pragma("unroll") for (int n = 0; n < 2; ++n) _Pragma("unroll") for (int k = 0; k < 2; ++k) dst[n][k] = *(const PG8_LAS bf16x8*)(lds + PG8_SB(b, h) + boff + n * 2048 + k * 1024); } while (0)
#define PG8_MMA(ai, bj, At, Bt) do { __builtin_amdgcn_s_setprio(1); _Pragma("unroll") for (int m = 0; m < 4; ++m) _Pragma("unroll") for (int n = 0; n < 2; ++n) _Pragma("unroll") for (int k = 0; k < 2; ++k) \
        acc[ai][bj][m][n] = __builtin_amdgcn_mfma_f32_16x16x32_bf16(Bt[n][k], At[m][k], acc[ai][bj][m][n], 0, 0, 0); __builtin_amdgcn_s_setprio(0); } while (0)
#define PG8_WAIT_V(n) asm volatile("s_waitcnt vmcnt(" #n ")" ::: "memory")
#define PG8_WAIT_L(n) asm volatile("s_waitcnt lgkmcnt(" #n ")" ::: "memory")
#define PG8_BAR __builtin_amdgcn_s_barrier()
#define PG8_SCHED __builtin_amdgcn_sched_barrier(0)
    Unit cur, nxt; int ui = 0;
    if (!S.next(0, cur)) return;
    f32x4 acc[2][2][4][2];
#pragma unroll
    for (int a = 0; a < 2; ++a)
#pragma unroll
        for (int b = 0; b < 2; ++b)
#pragma unroll
            for (int m = 0; m < 4; ++m)
#pragma unroll
                for (int n = 0; n < 2; ++n) acc[a][b][m][n] = (f32x4){0.f, 0.f, 0.f, 0.f};
    bf16x8 At[4][2], B0[2][2], B1[2][2];
    const char* cA = (const char*)g.A + (size_t)cur.pm * tstep + (size_t)cur.kofs * 2; const char* cB = (const char*)g.Bt + (size_t)cur.pn * tstep + (size_t)cur.kofs * 2;
    S.a_ready(cur);
    PG8_STAGE(PG8_SB(0, 0), cB, voffB); PG8_STAGE(PG8_SA(0, 0), cA, voffA); PG8_STAGE(PG8_SB(0, 1), cB + hstep, voffB); PG8_STAGE(PG8_SA(0, 1), cA + hstep, voffA);
    if (wr == 1) PG8_BAR;
    PG8_WAIT_V(4); PG8_BAR;
    PG8_STAGE(PG8_SB(1, 0), cB + kstep, voffB); PG8_STAGE(PG8_SA(1, 0), cA + kstep, voffA); PG8_STAGE(PG8_SB(1, 1), cB + hstep + kstep, voffB);
    PG8_WAIT_V(6); PG8_BAR;
    PG8_STAMP();
    for (;;) {
        const bool has_next = S.next(ui + 1, nxt);
        const char* nA = has_next ? (const char*)g.A + (size_t)nxt.pm * tstep + (size_t)nxt.kofs * 2 : cA; const char* nB = has_next ? (const char*)g.Bt + (size_t)nxt.pn * tstep + (size_t)nxt.kofs * 2 : cB;
        for (int t = 0; t < nt; t += 2) {
            const bool last = (t == nt - 2);
            const char* a1 = cA + (size_t)(t + 1) * kstep;
            const char* a2 = last ? nA : cA + (size_t)(t + 2) * kstep; const char* b2 = last ? nB : cB + (size_t)(t + 2) * kstep;
            const char* a3 = a2 + kstep; const char* b3 = b2 + kstep;
            if (last && has_next) S.a_ready(nxt);
            PG8_LDB(B0, 0, 0); PG8_SCHED; PG8_LDA(At, 0, 0); PG8_STAGE(PG8_SA(1, 1), a1 + hstep, voffA);
            PG8_WAIT_L(8); PG8_BAR; PG8_WAIT_L(0); PG8_MMA(0, 0, At, B0); PG8_BAR; PG8_SCHED;
            PG8_LDB(B1, 0, 1); PG8_STAGE(PG8_SB(0, 0), b2, voffB);
            PG8_BAR; PG8_WAIT_L(0); PG8_MMA(0, 1, At, B1); PG8_BAR;
            PG8_LDA(At, 0, 1); PG8_STAGE(PG8_SA(0, 0), a2, voffA);
            PG8_BAR; PG8_WAIT_L(0); PG8_MMA(1, 0, At, B0); PG8_BAR; PG8_SCHED;
            PG8_STAGE(PG8_SB(0, 1), b2 + hstep, voffB);
            PG8_WAIT_V(6); PG8_BAR; PG8_MMA(1, 1, At, B1); PG8_BAR;
            PG8_LDB(B0, 1, 0); PG8_SCHED; PG8_LDA(At, 1, 0); PG8_STAGE(PG8_SA(0, 1), a2 + hstep, voffA);
            PG8_WAIT_L(8); PG8_BAR; PG8_WAIT_L(0); PG8_MMA(0, 0, At, B0); PG8_BAR; PG8_SCHED;
            PG8_LDB(B1, 1, 1); PG8_STAGE(PG8_SB(1, 0), b3, voffB);
            PG8_BAR; PG8_WAIT_L(0); PG8_MMA(0, 1, At, B1); PG8_BAR;
            PG8_LDA(At, 1, 1); PG8_STAGE(PG8_SA(1, 0), a3, voffA);
            PG8_BAR; PG8_WAIT_L(0); PG8_MMA(1, 0, At, B0); PG8_BAR; PG8_SCHED;
            PG8_STAGE(PG8_SB(1, 1), b3 + hstep, voffB);
            PG8_WAIT_V(6); PG8_BAR; PG8_MMA(1, 1, At, B1); PG8_BAR;
        }
        PG8_STAMP();
        if constexpr (!Epi::AFTER_DRAIN) { E(acc, cur, wr, wc, fr, fq); S.done(cur); }
        PG8_STAMP();
        if (!has_next) break;
#pragma unroll
        for (int a = 0; a < 2; ++a)
#pragma unroll
            for (int b = 0; b < 2; ++b)
#pragma unroll
                for (int m = 0; m < 4; ++m)
#pragma unroll
                    for (int n = 0; n < 2; ++n) acc[a][b][m][n] = (f32x4){0.f, 0.f, 0.f, 0.f};
        cur = nxt; cA = nA; cB = nB; ++ui;
    }
    PG8_WAIT_V(0);
    if (wr == 0) PG8_BAR;
    PG8_BAR;
    if constexpr (Epi::AFTER_DRAIN) { E.fused(acc, cur, wr, wc, fr, fq, lds, wid, lane); S.done(cur); }
    PG8_STAMP();
    if (STAMP && wid == 0) { stamps[lane] = lane < nts ? (((unsigned long long)(unsigned)ts_hi << 32) | (unsigned)ts_lo) : 0ull;
        if (lane == 62) stamps[62] = rt_entry; if (lane == 63) stamps[63] = (unsigned long long)wall_clock64(); }
#undef PG8_STAMP
#undef PG8_SA
#undef PG8_SB
#undef PG8_STAGE
#undef PG8_LDA
#undef PG8_LDB
#undef PG8_MMA
#undef PG8_WAIT_V
#undef PG8_WAIT_L
#undef PG8_BAR
#undef PG8_SCHED
}
}
struct Args { const float* in[N_IN]; float* out; unsigned char* ws; int ph_lo, ph_hi; };
struct Frame {
    LAS unsigned char* lds;
    int tid, lane, wave, vcu, G;
    const float* const* in; GAS float* out; GAS unsigned char* ws;
};
using bf16x2v = __attribute__((ext_vector_type(2))) __bf16;
__device__ __forceinline__ float dot2bf(unsigned a, unsigned b, float acc) { return __builtin_amdgcn_fdot2_f32_bf16(__builtin_bit_cast(bf16x2v, a), __builtin_bit_cast(bf16x2v, b), acc, false); }

__device__ __forceinline__ void ld8bf(const bf16* p, float (&o)[8]) { const v4u w = *(const v4u*)p; o[0] = bf_lo(w.x); o[1] = bf_hi(w.x); o[2] = bf_lo(w.y); o[3] = bf_hi(w.y); o[4] = bf_lo(w.z); o[5] = bf_hi(w.z); o[6] = bf_lo(w.w); o[7] = bf_hi(w.w); }
struct TileInfo { int seq_base, seq_len, t0; };
__device__ __forceinline__ TileInfo tile_info(int c) {
    TileInfo ti;
    if (c < 128) { ti.seq_base = (c >> 6) * SEQ; ti.seq_len = SEQ; ti.t0 = (c & 63) * 64; }
    else { const int cc = c - 128; ti.seq_base = NLAT + (cc >> 2) * CTXL; ti.seq_len = CTXL; ti.t0 = (cc & 3) * 64; }
    return ti;
}
__device__ __forceinline__ int mod_row(int row) { return row < NLAT ? (row >> 12) : 2; }
__device__ __forceinline__ bf16x8 frag_lds(const LAS bf16* base, int ld, int row0, int k0, int lane) { return *(const LAS bf16x8*)(base + (row0 + (lane & 15)) * ld + k0 + 8 * (lane >> 4)); }
__device__ __forceinline__ bf16x8 frag_g(const bf16* base, int ld, int row0, int k0, int lane) { return *(const bf16x8*)(base + (size_t)(row0 + (lane & 15)) * ld + k0 + 8 * (lane >> 4)); }
#define MFMA16(a, b, c) __builtin_amdgcn_mfma_f32_16x16x32_bf16((a), (b), (c), 0, 0, 0)

__device__ __forceinline__ void p0_transpose_item(const float* W, int K, int N, bf16* WT, LAS float* scr, int item, int lane) {
    const int nblk = N / 32, kb = item / nblk, nb = item % nblk, k0 = 64 * kb, n0 = 32 * nb;
#pragma unroll 8
    for (int i = 0; i < 32; ++i) { const int kk = 2 * i + (lane >> 5); scr[kk * 33 + (lane & 31)] = W[(size_t)(k0 + kk) * N + n0 + (lane & 31)]; }
    LDS_WAIT(); asm volatile("" ::: "memory");
    const int c = lane & 7;
#pragma unroll
    for (int j = 0; j < 4; ++j) { const int n = (lane >> 3) + 8 * j; const LAS float* s = scr + (8 * c) * 33 + n;
        v4u o; o.x = pk2(s[0 * 33], s[1 * 33]); o.y = pk2(s[2 * 33], s[3 * 33]); o.z = pk2(s[4 * 33], s[5 * 33]); o.w = pk2(s[6 * 33], s[7 * 33]);
        *(v4u*)(WT + (size_t)(n0 + n) * K + k0 + 8 * c) = o; }
    LDS_WAIT(); asm volatile("" ::: "memory");
}
__device__ __forceinline__ void conv_f32_bf16(const float* src, bf16* dst, size_t n8, size_t i0, size_t stride) {
    for (size_t i = i0; i < n8; i += stride) { const f32x4 a = *(const f32x4*)(src + i * 8), b = *(const f32x4*)(src + i * 8 + 4);
        v4u o; o.x = pk2(a.x, a.y); o.y = pk2(a.z, a.w); o.z = pk2(b.x, b.y); o.w = pk2(b.z, b.w); *(v4u*)(dst + i * 8) = o; }
}
__device__ __forceinline__ void convert_layer(Frame& F, int l, int w, int NW, LAS float* scr) {
    constexpr int IT_IN = (D / 64) * (IN_COLS / 32), IT_SQ = (D / 64) * (D / 32);
    for (int it = w; it < IT_IN + 2 * IT_SQ; it += NW) {
        int r = it;
        if (r < IT_IN) { p0_transpose_item(gin(F.in[I_WIN]) + (size_t)l * D * IN_COLS, D, IN_COLS, (bf16*)(F.ws + WS_WIN) + (size_t)l * IN_PAD * D, scr, r, F.lane); continue; }
        r -= IT_IN;
        if (r < IT_SQ) { p0_transpose_item(gin(F.in[I_WOUT]) + (size_t)l * D * D, D, D, (bf16*)(F.ws + WS_WOUT) + (size_t)l * D * D, scr, r, F.lane); continue; }
        r -= IT_SQ;
        p0_transpose_item(gin(F.in[I_WQ]) + (size_t)l * D * D, D, D, (bf16*)(F.ws + WS_WQ) + (size_t)l * D * D, scr, r, F.lane);
    }
    { constexpr int PADV = (IN_PAD - IN_COLS) * D / 8;
      for (int i = w * 64 + F.lane; i < PADV; i += NW * 64) *(v4u*)((bf16*)(F.ws + WS_WIN) + ((size_t)l * IN_PAD + IN_COLS) * D + (size_t)i * 8) = (v4u){0u, 0u, 0u, 0u}; }
    for (int it = w; it < 2 * PE_NE; it += NW) {
        const int tab = it >= PE_NE, r = l * PE_NE + (tab ? it - PE_NE : it); const float* src = gin(F.in[tab ? I_V : I_U]) + (size_t)r * D + F.lane * 4;
        f32x4 x[8]; float mx = 0.f;
#pragma unroll
        for (int i = 0; i < 8; ++i) { x[i] = *(const f32x4*)(src + i * 256); mx = fmaxf(mx, fmaxf(fmaxf(fabsf(x[i].x), fabsf(x[i].y)), fmaxf(fabsf(x[i].z), fabsf(x[i].w)))); }
        mx = wave_max(mx); const float sc = mx > 0.f ? mx * (1.0f / 448.0f) : 1.0f, inv = 1.0f / sc;
        unsigned* dst = (unsigned*)(F.ws + (tab ? WS_VB : WS_UB) + (size_t)r * D) + F.lane;
#pragma unroll
        for (int i = 0; i < 8; ++i) { int q = __builtin_amdgcn_cvt_pk_fp8_f32(x[i].x * inv, x[i].y * inv, 0, false); q = __builtin_amdgcn_cvt_pk_fp8_f32(x[i].z * inv, x[i].w * inv, q, true); dst[i * 64] = (unsigned)q; }
        if (F.lane == 0) ((float*)(F.ws + (tab ? WS_SV : WS_SU)))[r] = sc;
    }
}
__device__ __forceinline__ void p0_prologue(Frame& F) {
    LAS float* scr = (LAS float*)(F.lds + F.wave * 16384);
    const int gw = F.vcu * NWAVES + F.wave, NGW = F.G * NWAVES;
    const size_t gt = (size_t)F.vcu * NTHR + F.tid, NGT = (size_t)F.G * NTHR;
    for (int l = 0; l < DEPTH; ++l) convert_layer(F, l, gw, NGW, scr);
    { bf16* dst = (bf16*)(F.ws + WS_WLRU);
      for (size_t idx = gt; idx < (size_t)DEPTH * 2 * 2 * 16 * 64 * 64; idx += NGT) { const int i = (int)(idx & 63), j = (int)((idx >> 6) & 63), m = (int)(idx >> 12);
          const int hh = m & 15, d = (m >> 4) & 1, gate = (m >> 5) & 1, l = m >> 6; const float* src = gin(F.in[gate ? I_WX : I_WA]);
          dst[idx] = (bf16)f2bf(src[((size_t)((l * 2 + d) * 16 + hh) * 64 + i) * 64 + j]); } }
    { bf16* d2 = (bf16*)(F.ws + WS_W2T); bf16* da = (bf16*)(F.ws + WS_A2T);
      for (size_t idx = gt; idx < (size_t)DEPTH * 2 * 1024 * 64; idx += NGT) { const int k = (int)(idx & 63), c = (int)((idx >> 6) & 1023), ld = (int)(idx >> 16);
          d2[idx] = (bf16)f2bf(gin(F.in[I_W2])[((size_t)ld * 64 + k) * 1024 + c]); da[idx] = (bf16)f2bf(gin(F.in[I_A2])[((size_t)ld * 64 + k) * 1024 + c]); } }
    { bf16* dg = (bf16*)(F.ws + WS_G2T);
      for (size_t idx = gt; idx < (size_t)DEPTH * 1024 * 160; idx += NGT) { const int k = (int)(idx % 160), c = (int)((idx / 160) % 1024), l = (int)(idx / (160 * 1024));
          dg[idx] = (bf16)f2bf(gin(F.in[I_G2])[((size_t)l * 160 + k) * 1024 + c]); } }
    conv_f32_bf16(gin(F.in[I_SUBK]), (bf16*)(F.ws + WS_SUBK), (size_t)DEPTH * 8 * 2 * 128 * 128 / 8, gt, NGT);
    { float* X = (float*)(F.ws + WS_X);
      for (size_t i0 = gt; i0 < (size_t)MTOT * D / 4; i0 += 4 * NGT) { f32x4 v[4];
#pragma unroll
          for (int u = 0; u < 4; ++u) { const size_t i = i0 + (size_t)u * NGT; const int row = (int)(i / (D / 4)), e0 = (int)(i % (D / 4)) * 4;
              v[u] = i < (size_t)MTOT * D / 4 ? (row < NLAT ? *(const f32x4*)(gin(F.in[I_X]) + (size_t)row * D + e0) : *(const f32x4*)(gin(F.in[I_CTX]) + (size_t)(row - NLAT) * D + e0)) : (f32x4){0.f, 0.f, 0.f, 0.f}; }
#pragma unroll
          for (int u = 0; u < 4; ++u) { const size_t i = i0 + (size_t)u * NGT; if (i >= (size_t)MTOT * D / 4) continue; const int row = (int)(i / (D / 4)), e0 = (int)(i % (D / 4)) * 4;
              if (row < NLAT) { const int t = row & (SEQ - 1); const float pr = (float)(t >> 6), pc = (float)(t & 63); float o[4];
#pragma unroll
                  for (int j = 0; j < 4; ++j) { const int e = e0 + j, q = e >> 9, fi = e & 511; const float freq = __builtin_amdgcn_exp2f(-13.287712379549449f * (float)fi * (1.0f / 512.0f));
                      const float ang = ((q >> 1) ? pc : pr) * freq; float rev = ang * 0.15915494309189535f; rev -= floorf(rev);
                      o[j] = (q & 1) ? __builtin_amdgcn_cosf(rev) : __builtin_amdgcn_sinf(rev); }
                  v[u].x += o[0]; v[u].y += o[1]; v[u].z += o[2]; v[u].w += o[3]; }
              *(f32x4*)(X + (size_t)row * D + e0) = v[u]; } } }
    { float* MODP = (float*)(F.ws + WS_MODP); const float* cin = gin(F.in[I_C]); const float* cctx = gin(F.in[I_CCTX]);
      for (int it = gw; it < DEPTH * KSPLIT * 48; it += NGW) { const int cg = it % 48, kp = (it / 48) % KSPLIT, l = it / (48 * KSPLIT); const int col = cg * 256 + F.lane * 4, k0 = kp * (D / KSPLIT);
          f32x4 a0 = {0.f, 0.f, 0.f, 0.f}, a1 = a0, a2 = a0; const float* wp = gin(F.in[I_ADAW]) + ((size_t)l * D + k0) * (6 * D) + col;
#pragma unroll 8
          for (int k = 0; k < D / KSPLIT; ++k) { const f32x4 w = *(const f32x4*)(wp + (size_t)k * (6 * D)); const float c0 = cin[k0 + k], c1 = cin[D + k0 + k], c2 = cctx[k0 + k];
              const float s0 = c0 * fsigmoid(c0), s1 = c1 * fsigmoid(c1), s2 = c2 * fsigmoid(c2); a0 += w * s0; a1 += w * s1; a2 += w * s2; }
          float* o = MODP + ((size_t)(kp * DEPTH + l) * 3) * (6 * D) + col; *(f32x4*)o = a0; *(f32x4*)(o + 6 * D) = a1; *(f32x4*)(o + 12 * D) = a2; } }
}
__device__ __forceinline__ void p0b_mod_reduce(Frame& F) {
    const size_t gt = (size_t)F.vcu * NTHR + F.tid, NGT = (size_t)F.G * NTHR; const float* MODP = (const float*)(F.ws + WS_MODP); float* MOD = (float*)(F.ws + WS_MOD);
    for (size_t i = gt; i < (size_t)DEPTH * 3 * 6 * D; i += NGT) { const int n = (int)(i % (6 * D)), l = (int)(i / (3 * 6 * D)); float s = gin(F.in[I_ADAB])[(size_t)l * 6 * D + n];
#pragma unroll
        for (int kp = 0; kp < KSPLIT; ++kp) s += MODP[(size_t)kp * DEPTH * 3 * 6 * D + i];
        MOD[i] = s; }
}
__device__ __forceinline__ void modulate_rows(Frame& F, int l, int which, int nrows) {
    const int gw = F.vcu * NWAVES + F.wave, NGW = F.G * NWAVES; const float* X = (const float*)(F.ws + WS_X); bf16* H = (bf16*)(F.ws + WS_H);
    for (int row = gw; row < nrows; row += NGW) { const float* md = (const float*)(F.ws + WS_MOD) + ((size_t)l * 3 + mod_row(row)) * (6 * D) + which * 3 * D;
#pragma unroll
        for (int j = 0; j < 4; ++j) { const int e = j * 512 + F.lane * 8; const f32x4 x0 = *(const f32x4*)(X + (size_t)row * D + e), x1 = *(const f32x4*)(X + (size_t)row * D + e + 4);
            const f32x4 s0 = *(const f32x4*)(md + e), s1 = *(const f32x4*)(md + e + 4), c0 = *(const f32x4*)(md + D + e), c1 = *(const f32x4*)(md + D + e + 4);
            const f32x4 y0 = x0 * (c0 + 1.0f) + s0, y1 = x1 * (c1 + 1.0f) + s1;
            v4u o; o.x = pk2(y0.x, y0.y); o.y = pk2(y0.z, y0.w); o.z = pk2(y1.x, y1.y); o.w = pk2(y1.z, y1.w); *(v4u*)(H + (size_t)row * D + e) = o; } }
}

__device__ __forceinline__ void lru_prep_unit(Frame& F, int l, int c, int hh) {
    int tid = F.tid; asm volatile("" : "+v"(tid));
    const int lane = tid & 63, wave = F.wave;
    const TileInfo ti = tile_info(c); const bf16* P = (const bf16*)(F.ws + WS_P);
    LAS float* Us = (LAS float*)F.lds; LAS float* XC = (LAS float*)(F.lds + 17408); LAS bf16* XCb = (LAS bf16*)(F.lds + 34304);
    LAS float* LAs = (LAS float*)(F.lds + 43520); LAS float* LBs = (LAS float*)(F.lds + 76288); LAS float* SEGA = (LAS float*)(F.lds + 109056); LAS float* SEGH = SEGA + 512;
    for (int idx = tid; idx < 67 * 8; idx += NTHR) { const int r = idx >> 3, c8 = (idx & 7) * 8, t = ti.t0 - 2 + r; float x[8];
        if (t >= 0 && t < ti.seq_len) ld8bf(P + (size_t)(ti.seq_base + t) * IN_PAD + hh * 64 + c8, x);
        else {
#pragma unroll
            for (int e = 0; e < 8; ++e) x[e] = 0.f; }
        *(LAS f32x4*)(Us + r * 64 + c8) = (f32x4){x[0], x[1], x[2], x[3]}; *(LAS f32x4*)(Us + r * 64 + c8 + 4) = (f32x4){x[4], x[5], x[6], x[7]}; }
    __syncthreads();
    { const int ch = tid & 63, cg = hh * 64 + ch; const float* cw = gin(F.in[I_CONVW]) + (size_t)l * 4 * LRW + cg;
      const float w0 = cw[0], w1 = cw[LRW], w2 = cw[2 * LRW], w3 = cw[3 * LRW], cb = gin(F.in[I_CONVB])[(size_t)l * LRW + cg];
#pragma unroll
      for (int k = 0; k < 8; ++k) { const int t = (tid >> 6) + 8 * k;
          const float v = cb + w0 * Us[t * 64 + ch] + w1 * Us[(t + 1) * 64 + ch] + w2 * Us[(t + 2) * 64 + ch] + w3 * Us[(t + 3) * 64 + ch];
          XC[t * 65 + ch] = v; XCb[t * 72 + ch] = (bf16)f2bf(v); } }
    __syncthreads();
    { const int d = wave >> 2, m = wave & 3;
      const bf16x8 a0 = frag_lds(XCb, 72, 16 * m, 0, lane), a1 = frag_lds(XCb, 72, 16 * m, 32, lane);
      const bf16* Wa = (const bf16*)(F.ws + WS_WLRU) + (size_t)(((l * 2 + 0) * 2 + d) * 16 + hh) * 4096;
      const bf16* Wx = (const bf16*)(F.ws + WS_WLRU) + (size_t)(((l * 2 + 1) * 2 + d) * 16 + hh) * 4096;
#pragma unroll
      for (int n = 0; n < 4; ++n) {
          f32x4 ar = {0.f, 0.f, 0.f, 0.f}, ai = ar;
          ar = MFMA16(a0, frag_g(Wa, 64, 16 * n, 0, lane), ar); ar = MFMA16(a1, frag_g(Wa, 64, 16 * n, 32, lane), ar);
          ai = MFMA16(a0, frag_g(Wx, 64, 16 * n, 0, lane), ai); ai = MFMA16(a1, frag_g(Wx, 64, 16 * n, 32, lane), ai);
          const int col = 16 * n + (lane & 15), cg = hh * 64 + col;
          const float ba = gin(F.in[I_BA])[(size_t)(l * 2 + d) * LRW + cg], bx = gin(F.in[I_BX])[(size_t)(l * 2 + d) * LRW + cg];
          const float sp = fsoftplus(-gin(F.in[I_LAM])[(size_t)(l * 2 + d) * LRW + cg]);
#pragma unroll
          for (int r = 0; r < 4; ++r) { const int row = 16 * m + 4 * (lane >> 4) + r;
              const float rr = fsigmoid(ar[r] + ba), ii = fsigmoid(ai[r] + bx), loga = -8.0f * rr * sp, a = fexp(loga);
              const float bb = __builtin_amdgcn_sqrtf(fmaxf(1.0f - a * a, 0.f)) * ii * XC[row * 65 + col];
              LAs[(d * 64 + row) * 64 + col] = a; LBs[(d * 64 + row) * 64 + col] = bb; } } }
    __syncthreads();
    { const int col = tid & 63, seg = (tid >> 6) & 3, d = tid >> 8, cg = hh * 64 + col; float hl[16], al[16]; float h = 0.f, A = 1.f;
#pragma unroll
      for (int i = 0; i < 16; ++i) { const int tau = 16 * seg + i, row = d ? 63 - tau : tau; const float a = LAs[(d * 64 + row) * 64 + col], b = LBs[(d * 64 + row) * 64 + col]; h = a * h + b; A *= a; hl[i] = h; al[i] = A; }
      SEGA[(d * 4 + seg) * 64 + col] = A; SEGH[(d * 4 + seg) * 64 + col] = h;
      __syncthreads();
      float Hin = 0.f, Ain = 1.f;
#pragma unroll
      for (int s2 = 0; s2 < 3; ++s2) if (s2 < seg) { const float sa = SEGA[(d * 4 + s2) * 64 + col]; Hin = sa * Hin + SEGH[(d * 4 + s2) * 64 + col]; Ain *= sa; }
      bf16* HL = (bf16*)(F.ws + WS_LB) + (size_t)d * MTOT * LRW; bf16* AC = (bf16*)(F.ws + WS_LA) + (size_t)d * MTOT * LRW;
#pragma unroll
      for (int i = 0; i < 16; ++i) { const int tau = 16 * seg + i, row = d ? 63 - tau : tau; const size_t o = (size_t)(ti.seq_base + ti.t0 + row) * LRW + cg; HL[o] = (bf16)f2bf(hl[i] + al[i] * Hin); AC[o] = (bf16)f2bf(al[i] * Ain); }
      if (seg == 3) { float* AG = (float*)(F.ws + WS_LAGG); AG[((size_t)(0 * 2 + d) * NTILE + c) * LRW + cg] = al[15] * Ain; AG[((size_t)(1 * 2 + d) * NTILE + c) * LRW + cg] = hl[15] + al[15] * Hin; } }
    __syncthreads();
}
__device__ __forceinline__ void shifted8(const bf16* P, size_t grow, bool hp, bool hn, const float* mu0, const float* mu1, int rc, float (&o)[8]) {
    const bf16* p = P + grow * IN_PAD + 2 * LRW + rc;
    float xs[8], ms[8], ns[8]; ld8bf(p, xs);
#pragma unroll
    for (int e = 0; e < 8; ++e) { ms[e] = 0.f; ns[e] = 0.f; }
    if (hp) ld8bf(p - IN_PAD, ms);
    if (hn) ld8bf(p + IN_PAD, ns);
    const f32x4 a0 = *(const f32x4*)(mu0 + rc), a1 = *(const f32x4*)(mu0 + rc + 4), b0 = *(const f32x4*)(mu1 + rc), b1 = *(const f32x4*)(mu1 + rc + 4);
    const float m0[8] = {a0.x, a0.y, a0.z, a0.w, a1.x, a1.y, a1.z, a1.w}, m1[8] = {b0.x, b0.y, b0.z, b0.w, b1.x, b1.y, b1.z, b1.w};
#pragma unroll
    for (int e = 0; e < 8; ++e) o[e] = xs[e] + m0[e] * (ms[e] - xs[e]) + m1[e] * (ns[e] - xs[e]);
}
constexpr int MB = 9216;
constexpr int MLD = 72;
#define MSLOT(k) ((LAS bf16*)(F.lds + (k) * MB))
__device__ __forceinline__ int prow(int c) { return (c & ~7) | ((c + (c >> 3)) & 7); }
__device__ __forceinline__ bf16x8 frag_lds_p(const LAS bf16* base, int ld, int row0, int k0, int lane) { return *(const LAS bf16x8*)(base + prow(row0 + (lane & 15)) * ld + k0 + 8 * (lane >> 4)); }
template <bool PY, bool PX> __device__ __forceinline__ f32x4 mm_tile_p(const LAS bf16* Y, int rt, const LAS bf16* X, int ct, f32x4 acc, int lane) {
    acc = MFMA16(PY ? frag_lds_p(Y, MLD, 16 * rt, 0, lane) : frag_lds(Y, MLD, 16 * rt, 0, lane), PX ? frag_lds_p(X, MLD, 16 * ct, 0, lane) : frag_lds(X, MLD, 16 * ct, 0, lane), acc);
    acc = MFMA16(PY ? frag_lds_p(Y, MLD, 16 * rt, 32, lane) : frag_lds(Y, MLD, 16 * rt, 32, lane), PX ? frag_lds_p(X, MLD, 16 * ct, 32, lane) : frag_lds(X, MLD, 16 * ct, 32, lane), acc);
    return acc;
}
__device__ __forceinline__ f32x4 mm_tile(const LAS bf16* Y, int rt, const LAS bf16* X, int ct, f32x4 acc, int lane) {
    acc = MFMA16(frag_lds(Y, MLD, 16 * rt, 0, lane), frag_lds(X, MLD, 16 * ct, 0, lane), acc);
    acc = MFMA16(frag_lds(Y, MLD, 16 * rt, 32, lane), frag_lds(X, MLD, 16 * ct, 32, lane), acc);
    return acc;
}
__device__ __forceinline__ void st_tile(LAS bf16* Dst, int rt, int ct, f32x4 acc, int lane) {
    v2u o; o.x = pk2(acc[0], acc[1]); o.y = pk2(acc[2], acc[3]);
    *(LAS v2u*)(Dst + (16 * ct + (lane & 15)) * MLD + 16 * rt + 4 * (lane >> 4)) = o;
}
__device__ __forceinline__ f32x4 ld_tile(const LAS bf16* Src, int rt, int ct, int lane) {
    const v2u o = *(const LAS v2u*)(Src + (16 * ct + (lane & 15)) * MLD + 16 * rt + 4 * (lane >> 4));
    return (f32x4){bf_lo(o.x), bf_hi(o.x), bf_lo(o.y), bf_hi(o.y)};
}
template <int MASK> __device__ __forceinline__ void mm64(LAS bf16* Dst, const LAS bf16* X, const LAS bf16* Y, int wave, int lane) {
    const int rt = wave >> 1;
#pragma unroll
    for (int q = 0; q < 2; ++q) { const int ct = 2 * (wave & 1) + q; f32x4 acc = {0.f, 0.f, 0.f, 0.f};
        acc = mm_tile(Y, rt, X, ct, acc, lane);
        if (MASK) { const int c = 16 * ct + (lane & 15);
#pragma unroll
            for (int g = 0; g < 4; ++g) { const int r = 16 * rt + 4 * (lane >> 4) + g; const bool keep = MASK == 1 ? (c > r) : MASK == 2 ? (r > c) : (c >= r); if (!keep) acc[g] = 0.f; } }
        st_tile(Dst, rt, ct, acc, lane); }
}
#ifndef CPROBE
#define CPROBE 0
#endif
struct RawS1 { v4u x[5][3]; };
template <int G0, int G1> __device__ __forceinline__ void load_raw(Frame& F, int c, int hh, int d, int tid, RawS1& raw) {
    const TileInfo ti = tile_info(c); const int t = tid >> 3, c8 = (tid & 7) * 8, tt = ti.t0 + t; const bool hp = tt > 0, hn = tt + 1 < ti.seq_len;
    const bf16* p0 = (const bf16*)(F.ws + WS_P) + (size_t)(ti.seq_base + tt) * IN_PAD + 2 * LRW + c8;
#pragma unroll
    for (int g = G0; g < G1; ++g) { const int rc = g < 3 ? g * RWW + hh * 64 : 3 * RWW + (g - 3) * 128 + d * 64; const bf16* p = p0 + rc;
        raw.x[g][0] = *(const v4u*)p; raw.x[g][1] = *(const v4u*)(p - (hp ? IN_PAD : 0)); raw.x[g][2] = *(const v4u*)(p + (hn ? IN_PAD : 0)); }
}
__device__ __forceinline__ void shift_raw(const v4u (&x)[3], const LAS float* mus, bool hp, bool hn, float (&o)[8]) {
    const f32x4 a0 = *(const LAS f32x4*)mus, a1 = *(const LAS f32x4*)(mus + 4), b0 = *(const LAS f32x4*)(mus + 64), b1 = *(const LAS f32x4*)(mus + 68);
    const float m0[8] = {a0.x, a0.y, a0.z, a0.w, a1.x, a1.y, a1.z, a1.w}, m1[8] = {b0.x, b0.y, b0.z, b0.w, b1.x, b1.y, b1.z, b1.w};
    const unsigned xw[4] = {x[0].x, x[0].y, x[0].z, x[0].w}, pw[4] = {x[1].x, x[1].y, x[1].z, x[1].w}, nw[4] = {x[2].x, x[2].y, x[2].z, x[2].w};
#pragma unroll
    for (int e = 0; e < 8; ++e) { const float xs = (e & 1) ? bf_hi(xw[e >> 1]) : bf_lo(xw[e >> 1]), ms = hp ? ((e & 1) ? bf_hi(pw[e >> 1]) : bf_lo(pw[e >> 1])) : 0.f, ns = hn ? ((e & 1) ? bf_hi(nw[e >> 1]) : bf_lo(nw[e >> 1])) : 0.f;
        o[e] = xs + m0[e] * (ms - xs) + m1[e] * (ns - xs); }
}
__device__ __forceinline__ void rwkv_chunk_prep(Frame& F, int l, int c, int hh, int d) {
    RawS1 raw;
    int tid = F.tid; asm volatile("" : "+v"(tid));
    const TileInfo ti = tile_info(c); const int lane = tid & 63, wave = F.wave;
    LAS bf16* TW = MSLOT(0); LAS bf16* AD = MSLOT(1);
    LAS float* CUM = (LAS float*)(F.lds + 8 * MB); LAS float* AVs = (LAS float*)(F.lds + 8 * MB + 16640);
    LAS float* CWL = (LAS float*)(F.lds + 13 * MB); LAS float* SEGT = (LAS float*)(F.lds + 13 * MB + 256); LAS float* MUS = (LAS float*)(F.lds + 125184);
    const int uidx = (c * NH + hh) * 2 + d;
    const int t = tid >> 3, c8 = (tid & 7) * 8, tt = ti.t0 + t; const size_t grow = (size_t)(ti.seq_base + tt); const bool hp = tt > 0, hn = tt + 1 < ti.seq_len;
    float rv[8], kv[8], vv[8], kk[8];
    load_raw<0, 5>(F, c, hh, d, tid, raw);
    for (int rp_ = 0; rp_ < (CPROBE == 1 ? 2 : 1); ++rp_) {
    shift_raw(raw.x[0], MUS + 0 * 128 + c8, hp, hn, rv);
    shift_raw(raw.x[1], MUS + 1 * 128 + c8, hp, hn, kv);
    shift_raw(raw.x[2], MUS + 2 * 128 + c8, hp, hn, vv);
    { float ss = 0.f; const float* kkw = gin(F.in[I_KK]) + (size_t)l * RWW + hh * 64 + c8;
#pragma unroll
      for (int e = 0; e < 8; ++e) { kk[e] = kv[e] * kkw[e]; ss += kk[e] * kk[e]; }
      ss = red8(ss); const float inv = __builtin_amdgcn_rsqf(fmaxf(ss, 1e-24f));
#pragma unroll
      for (int e = 0; e < 8; ++e) kk[e] *= inv; }
    if (d == 0) { v4u o; o.x = pk2(vv[0], vv[1]); o.y = pk2(vv[2], vv[3]); o.z = pk2(vv[4], vv[5]); o.w = pk2(vv[6], vv[7]); *(v4u*)((bf16*)(F.ws + WS_RV) + grow * RWW + hh * 64 + c8) = o; }
    { float x[8]; v4u o;
      shift_raw(raw.x[3], MUS + 3 * 128 + c8, hp, hn, x);
      o.x = pk2(ftanh(x[0]), ftanh(x[1])); o.y = pk2(ftanh(x[2]), ftanh(x[3])); o.z = pk2(ftanh(x[4]), ftanh(x[5])); o.w = pk2(ftanh(x[6]), ftanh(x[7])); *(LAS v4u*)(TW + t * MLD + c8) = o;
      shift_raw(raw.x[4], MUS + 4 * 128 + c8, hp, hn, x);
      o.x = pk2(x[0], x[1]); o.y = pk2(x[2], x[3]); o.z = pk2(x[4], x[5]); o.w = pk2(x[6], x[7]); *(LAS v4u*)(AD + t * MLD + c8) = o; }
    asm volatile("" ::: "memory"); }
    __syncthreads();
    for (int rp_ = 0; rp_ < (CPROBE == 2 ? 2 : 1); ++rp_) { const int m = wave & 3; const bf16x8 w0f = frag_lds(TW, MLD, 16 * m, 0, lane), w1f = frag_lds(TW, MLD, 16 * m, 32, lane), d0f = frag_lds(AD, MLD, 16 * m, 0, lane), d1f = frag_lds(AD, MLD, 16 * m, 32, lane);
      const bf16* W2 = (const bf16*)(F.ws + WS_W2T) + ((size_t)(l * 2 + d) * 1024 + hh * 64) * 64; const bf16* A2 = (const bf16*)(F.ws + WS_A2T) + ((size_t)(l * 2 + d) * 1024 + hh * 64) * 64;
#pragma unroll
      for (int q = 0; q < 2; ++q) { const int n = (wave >> 2) * 2 + q; f32x4 aw = {0.f, 0.f, 0.f, 0.f}, aa = aw;
          aw = MFMA16(w0f, frag_g(W2, 64, 16 * n, 0, lane), aw); aw = MFMA16(w1f, frag_g(W2, 64, 16 * n, 32, lane), aw);
          aa = MFMA16(d0f, frag_g(A2, 64, 16 * n, 0, lane), aa); aa = MFMA16(d1f, frag_g(A2, 64, 16 * n, 32, lane), aa);
          const int col = 16 * n + (lane & 15), cg = hh * 64 + col; const float w0 = gin(F.in[I_W0])[(size_t)(l * 2 + d) * RWW + cg], a0 = gin(F.in[I_A0])[(size_t)(l * 2 + d) * RWW + cg];
#pragma unroll
          for (int g = 0; g < 4; ++g) { const int row = 16 * m + 4 * (lane >> 4) + g; const float wlog = -fsoftplus(-(w0 + aw[g])) - 0.5f;
              CUM[row * 65 + col] = -fexp(wlog); AVs[row * 65 + col] = fsigmoid(a0 + aa[g]); } } }
    __syncthreads();
    { const int col = tid & 63, seg = tid >> 6; float pre[8]; float run = 0.f;
#pragma unroll
      for (int i = 0; i < 8; ++i) { const int tau = seg * 8 + i, tr = d ? 63 - tau : tau; run += CUM[tr * 65 + col]; pre[i] = run; }
      SEGT[seg * 64 + col] = run;
      __syncthreads();
      float off = 0.f;
#pragma unroll
      for (int s = 0; s < 8; ++s) if (s < seg) off += SEGT[s * 64 + col];
#pragma unroll
      for (int i = 0; i < 8; ++i) { const int tau = seg * 8 + i, tr = d ? 63 - tau : tau; CUM[tr * 65 + col] = off + pre[i]; }
      if (seg == 7) CWL[col] = fexp(off + pre[7]); }
    __syncthreads();
    for (int rp_ = 0; rp_ < (CPROBE == 3 ? 2 : 1); ++rp_) { const int tau = d ? 63 - t : t, tprev = d ? t + 1 : t - 1;
      const float* kaw = gin(F.in[I_KA]) + (size_t)l * RWW + hh * 64 + c8; const float* rkw = gin(F.in[I_RK]) + (size_t)l * RWW + hh * 64 + c8;
      LAS bf16* At = MSLOT(0); LAS bf16* AtT = MSLOT(1); LAS bf16* Bt = MSLOT(2); LAS bf16* BtT = MSLOT(3); LAS bf16* Kt = MSLOT(4); LAS bf16* KtT = MSLOT(5); LAS bf16* Rt = MSLOT(6); LAS bf16* VT = MSLOT(7);
      float bsum = 0.f; unsigned pa[4], pb[4], pk[4], pr[4];
#pragma unroll
      for (int e2 = 0; e2 < 4; ++e2) { float at2[2], bt2[2], kt2[2], rt2[2];
#pragma unroll
          for (int q = 0; q < 2; ++q) { const int e = 2 * e2 + q; const float cum = CUM[t * 65 + c8 + e], cumx = tau > 0 ? CUM[tprev * 65 + c8 + e] : 0.f, a = AVs[t * 65 + c8 + e];
              const float kd = kv[e] * (1.0f + (a - 1.0f) * kaw[e]), ex = fexp(cum), exm = fexp(-cum);
              at2[q] = -kk[e] * fexp(cumx); bt2[q] = kk[e] * a * exm; kt2[q] = kd * exm; rt2[q] = rv[e] * ex; bsum += rv[e] * kd * rkw[e];
              const int pr_ = prow(c8 + e) * MLD + tau; AtT[pr_] = (bf16)f2bf(at2[q]); BtT[pr_] = (bf16)f2bf(bt2[q]); KtT[pr_] = (bf16)f2bf(kt2[q]); VT[pr_] = (bf16)f2bf(vv[e]); }
          pa[e2] = pk2(at2[0], at2[1]); pb[e2] = pk2(bt2[0], bt2[1]); pk[e2] = pk2(kt2[0], kt2[1]); pr[e2] = pk2(rt2[0], rt2[1]); }
      *(LAS v4u*)(At + tau * MLD + c8) = (v4u){pa[0], pa[1], pa[2], pa[3]}; *(LAS v4u*)(Bt + tau * MLD + c8) = (v4u){pb[0], pb[1], pb[2], pb[3]};
      *(LAS v4u*)(Kt + tau * MLD + c8) = (v4u){pk[0], pk[1], pk[2], pk[3]}; *(LAS v4u*)(Rt + tau * MLD + c8) = (v4u){pr[0], pr[1], pr[2], pr[3]};
      bsum = red8(bsum);
      if ((tid & 7) == 0) ((float*)(F.ws + WS_BETA))[((size_t)d * MTOT + grow) * NH + hh] = bsum; }
    __syncthreads();
    LAS bf16* At = MSLOT(0); LAS bf16* AtT = MSLOT(1); LAS bf16* Bt = MSLOT(2); LAS bf16* BtT = MSLOT(3); LAS bf16* Kt = MSLOT(4); LAS bf16* KtT = MSLOT(5); LAS bf16* Rt = MSLOT(6); LAS bf16* VT = MSLOT(7);
    LAS bf16* Pm = MSLOT(8); LAS bf16* AkVT = MSLOT(9); LAS bf16* Gak = MSLOT(10); LAS bf16* Grb = MSLOT(11); LAS bf16* Grk = MSLOT(12);
    LAS bf16* TAT = MSLOT(0); LAS bf16* U0T = MSLOT(2); LAS bf16* TD = (LAS bf16*)(F.lds + 122112); constexpr int TDLD = 24;
    for (int rp_ = 0; rp_ < (CPROBE == 4 ? 2 : 1); ++rp_) {
    mm64<1>(Pm, At, Bt, wave, lane);
    __syncthreads();
    if (wave == 0) { const int blk = lane >> 4, cc = lane & 15; float tv[16];
#pragma unroll
        for (int r = 0; r < 16; ++r) { asm volatile("" ::: "memory"); const LAS bf16* ar = Pm + (16 * blk + r) * MLD + 16 * blk; const v4u q0 = *(const LAS v4u*)ar, q1 = *(const LAS v4u*)(ar + 8);
            const float av_[16] = {bf_lo(q0.x), bf_hi(q0.x), bf_lo(q0.y), bf_hi(q0.y), bf_lo(q0.z), bf_hi(q0.z), bf_lo(q0.w), bf_hi(q0.w), bf_lo(q1.x), bf_hi(q1.x), bf_lo(q1.y), bf_hi(q1.y), bf_lo(q1.z), bf_hi(q1.z), bf_lo(q1.w), bf_hi(q1.w)};
            float acc0 = (r == cc) ? 1.0f : 0.f, acc1 = 0.f;
#pragma unroll
            for (int m = 0; m < r; ++m) { if (m & 1) acc1 += av_[m] * tv[m]; else acc0 += av_[m] * tv[m]; }
            tv[r] = acc0 + acc1; }
#pragma unroll
        for (int r = 0; r < 16; ++r) TD[(16 * blk + r) * TDLD + cc] = (bf16)f2bf(tv[r]);
    } else {
#pragma unroll 1
        for (int q = wave - 1; q < 48; q += 7) { const int pr = q >> 4, tl = q & 15, rt = tl >> 2, ct = tl & 3;
            const LAS bf16* X = pr == 0 ? At : Rt; const LAS bf16* Y = pr == 1 ? Bt : Kt; LAS bf16* Dst = pr == 0 ? Gak : pr == 1 ? Grb : Grk;
            f32x4 acc = {0.f, 0.f, 0.f, 0.f}; acc = mm_tile(Y, rt, X, ct, acc, lane);
            const int cI = 16 * ct + (lane & 15);
#pragma unroll
            for (int g = 0; g < 4; ++g) { const int rI = 16 * rt + 4 * (lane >> 4) + g; const bool keep = pr == 0 ? (cI > rI) : (cI >= rI); if (!keep) acc[g] = 0.f; }
            st_tile(Dst, rt, ct, acc, lane); }
    }
    __syncthreads(); }
    { const int rt = wave >> 1;
#pragma unroll
      for (int q = 0; q < 2; ++q) { const int ct = 2 * (wave & 1) + q; f32x4 acc = {0.f, 0.f, 0.f, 0.f}; acc = mm_tile_p<false, true>(Gak, rt, VT, ct, acc, lane); st_tile(AkVT, rt, ct, acc, lane); } }
    { const v4u z = {0u, 0u, 0u, 0u}; for (int i = tid; i < 64 * 8; i += NTHR) { const int row = i >> 3, c8_ = (i & 7) * 8; *(LAS v4u*)(TAT + row * MLD + c8_) = z; *(LAS v4u*)(U0T + row * MLD + c8_) = z; } }
    __syncthreads();
    for (int rp_ = 0; rp_ < (CPROBE == 5 ? 2 : 1); ++rp_)
#pragma unroll 1
    for (int bi = 0; bi < 4; ++bi) {
        const int g = lane >> 4, il = lane & 15, nt = wave & 3; const LAS bf16* RH = (wave < 4) ? AtT : AkVT; LAS bf16* XT = (wave < 4) ? TAT : U0T;
        const v2u rq = *(const LAS v2u*)(RH + ((wave < 4) ? prow(16 * nt + il) : 16 * nt + il) * MLD + 16 * bi + 4 * g);
        f32x4 acc = {bf_lo(rq.x), bf_hi(rq.x), bf_lo(rq.y), bf_hi(rq.y)};
#pragma unroll
        for (int ks = 0; ks < 2; ++ks) if (32 * ks < 16 * bi) {
            bf16x8 af = frag_lds(Pm, MLD, 16 * bi, 32 * ks, lane); if (32 * ks + 8 * g >= 16 * bi) af = (bf16x8){0, 0, 0, 0, 0, 0, 0, 0};
            acc = MFMA16(af, frag_lds(XT, MLD, 16 * nt, 32 * ks, lane), acc); }
        v4u rb; rb.x = pk2(acc[0], acc[1]); rb.y = pk2(acc[2], acc[3]); rb.z = 0u; rb.w = 0u;
        const v2u tq = *(const LAS v2u*)(TD + (16 * bi + il) * TDLD + 4 * g); v4u tf; tf.x = tq.x; tf.y = tq.y; tf.z = 0u; tf.w = 0u;
        f32x4 xo = {0.f, 0.f, 0.f, 0.f}; xo = MFMA16(__builtin_bit_cast(bf16x8, tf), __builtin_bit_cast(bf16x8, rb), xo);
        v2u o; o.x = pk2(xo[0], xo[1]); o.y = pk2(xo[2], xo[3]); *(LAS v2u*)(XT + (16 * nt + il) * MLD + 16 * bi + 4 * g) = o;
        __syncthreads();
    }
    for (int rp_ = 0; rp_ < (CPROBE == 6 ? 2 : 1); ++rp_) {
    {
      bf16* QMg = (bf16*)(F.ws + WS_QM) + (size_t)uidx * 4096; bf16* PHg = (bf16*)(F.ws + WS_PHI) + (size_t)uidx * 4096; const int rt = wave >> 1;
#pragma unroll
      for (int q = 0; q < 2; ++q) { const int ct = 2 * (wave & 1) + q; const int cidx = 16 * ct + (lane & 15), r0 = 16 * rt + 4 * (lane >> 4), qpos = 32 * (rt >> 1) + 8 * (lane >> 4) + 4 * (rt & 1);
          f32x4 acc = ld_tile(Rt, rt, ct, lane); acc = mm_tile(TAT, rt, Grb, ct, acc, lane);
          v2u o; o.x = pk2(acc[0], acc[1]); o.y = pk2(acc[2], acc[3]); *(v2u*)(QMg + cidx * 64 + qpos) = o;
          asm volatile("" ::: "memory");
          f32x4 ph = {0.f, 0.f, 0.f, 0.f}; ph = mm_tile_p<false, true>(TAT, rt, BtT, ct, ph, lane); const float cw = CWL[cidx];
#pragma unroll
          for (int g = 0; g < 4; ++g) ph[g] = cw * (ph[g] + ((r0 + g == cidx) ? 1.0f : 0.f));
          o.x = pk2(ph[0], ph[1]); o.y = pk2(ph[2], ph[3]); *(v2u*)(PHg + cidx * 64 + qpos) = o; } }
    {
      bf16* Y0g = (bf16*)(F.ws + WS_Y0F) + (size_t)uidx * 4096; bf16* PSg = (bf16*)(F.ws + WS_PSF) + (size_t)uidx * 4096; const int rt = wave >> 1;
#pragma unroll
      for (int q = 0; q < 2; ++q) { const int ct = 2 * (wave & 1) + q;
          asm volatile("" ::: "memory");
          f32x4 y0 = {0.f, 0.f, 0.f, 0.f}; y0 = mm_tile(Grb, rt, U0T, ct, y0, lane); asm volatile("" ::: "memory"); y0 = mm_tile_p<false, true>(Grk, rt, VT, ct, y0, lane);
          { v2u w; w.x = pk2(y0[0], y0[1]); w.y = pk2(y0[2], y0[3]); *(v2u*)(Y0g + ((ct * 4 + rt) * 64 + lane) * 4) = w; }
          asm volatile("" ::: "memory");
          f32x4 ps = {0.f, 0.f, 0.f, 0.f}; ps = mm_tile_p<true, false>(BtT, rt, U0T, ct, ps, lane); asm volatile("" ::: "memory"); ps = mm_tile_p<true, true>(KtT, rt, VT, ct, ps, lane);
#pragma unroll
          for (int g = 0; g < 4; ++g) ps[g] *= CWL[16 * rt + 4 * (lane >> 4) + g];
          { v2u w; w.x = pk2(ps[0], ps[1]); w.y = pk2(ps[2], ps[3]); *(v2u*)(PSg + ((ct * 4 + rt) * 64 + lane) * 4) = w; } } } }
    __syncthreads();
}
#define LDS_BAR() do { asm volatile("s_waitcnt lgkmcnt(0)" ::: "memory"); __builtin_amdgcn_s_barrier(); asm volatile("" ::: "memory"); } while (0)
struct ChunkOps { bf16x8 f[4][2]; v2u c[4]; int tile; };
__device__ __forceinline__ void chunk_load(Frame& F, ChunkOps& o, int step, int b, int hh, int d, int sl, int role, int lane) {
    const int g = lane >> 4, il = lane & 15;
    step = step < 67 ? step : 67;
    const int cc = d ? 3 - step : step, lc = d ? 67 - step : step - 4; const int tile = step < 4 ? 128 + b * 4 + cc : b * 64 + lc;
    o.tile = tile;
    const size_t uidx = (size_t)(tile * NH + hh) * 2 + d;
    const bf16* Mg = (const bf16*)(F.ws + (role ? WS_QM : WS_PHI)) + uidx * 4096 + il * 64 + 8 * g; const bf16* Cg = (const bf16*)(F.ws + (role ? WS_Y0F : WS_PSF)) + uidx * 4096 + (sl * 4 * 64 + lane) * 4;
#pragma unroll
    for (int m = 0; m < 4; ++m) { o.f[m][0] = *(const bf16x8*)(Mg + m * 1024); o.f[m][1] = *(const bf16x8*)(Mg + m * 1024 + 32); o.c[m] = *(const v2u*)(Cg + m * 256); }
}
__device__ __forceinline__ void lru_scan(Frame& F, int idx) {
    const int ch = idx & 1023, b = (idx >> 10) & 1, d = idx >> 11;
    const float* AG = (const float*)(F.ws + WS_LAGG); float* HIN = (float*)(F.ws + WS_LHIN);
    float carry = 0.f;
#pragma unroll 4
    for (int step = 0; step < 68; ++step) { int tile; if (step < 4) tile = 128 + b * 4 + (d ? 3 - step : step); else tile = b * 64 + (d ? 63 - (step - 4) : step - 4);
        const float a = AG[((size_t)(0 * 2 + d) * NTILE + tile) * LRW + ch], hh_ = AG[((size_t)(1 * 2 + d) * NTILE + tile) * LRW + ch];
        HIN[((size_t)d * NTILE + tile) * LRW + ch] = carry; carry = a * carry + hh_; }
}

__device__ __forceinline__ void chunk_apply(Frame& F, const ChunkOps& o, f32x4 (&S)[4], int step, bf16* YR, int hh, int d, int sl, int role, int lane) {
    const int g = lane >> 4, il = lane & 15; LAS v4u* XCH = (LAS v4u*)F.lds;
    bf16x8 bfr[2];
    if (role == 0) {
#pragma unroll
        for (int ks = 0; ks < 2; ++ks) { v4u w; w.x = pk2(S[2 * ks][0], S[2 * ks][1]); w.y = pk2(S[2 * ks][2], S[2 * ks][3]); w.z = pk2(S[2 * ks + 1][0], S[2 * ks + 1][1]); w.w = pk2(S[2 * ks + 1][2], S[2 * ks + 1][3]); bfr[ks] = __builtin_bit_cast(bf16x8, w); }
#pragma unroll
        for (int m = 0; m < 4; ++m) { f32x4 sn = (f32x4){bf_lo(o.c[m].x), bf_hi(o.c[m].x), bf_lo(o.c[m].y), bf_hi(o.c[m].y)}; sn = MFMA16(o.f[m][0], bfr[0], sn); sn = MFMA16(o.f[m][1], bfr[1], sn); S[m] = sn; }
#pragma unroll
        for (int ks = 0; ks < 2; ++ks) { v4u w; w.x = pk2(S[2 * ks][0], S[2 * ks][1]); w.y = pk2(S[2 * ks][2], S[2 * ks][3]); w.z = pk2(S[2 * ks + 1][0], S[2 * ks + 1][1]); w.w = pk2(S[2 * ks + 1][2], S[2 * ks + 1][3]);
            XCH[((((step + 1) & 1) * 4 + sl) * 2 + ks) * 64 + lane] = w; }
    } else {
#pragma unroll
        for (int ks = 0; ks < 2; ++ks) bfr[ks] = __builtin_bit_cast(bf16x8, XCH[(((step & 1) * 4 + sl) * 2 + ks) * 64 + lane]);
#pragma unroll
        for (int m = 0; m < 4; ++m) { f32x4 y = (f32x4){bf_lo(o.c[m].x), bf_hi(o.c[m].x), bf_lo(o.c[m].y), bf_hi(o.c[m].y)}; y = MFMA16(o.f[m][0], bfr[0], y); y = MFMA16(o.f[m][1], bfr[1], y);
#pragma unroll
            for (int r = 0; r < 4; ++r) { const int tau = 16 * m + 4 * g + r, tl = d ? 63 - tau : tau; YR[(size_t)(o.tile * 64 + tl) * RWW + hh * 64 + sl * 16 + il] = (bf16)f2bf(y[r]); } }
    }
}
__device__ __forceinline__ void rwkv_chain_chunks(Frame& F, int item) {
    const int chain = item >> 2, sl = item & 3, d = chain & 1, hh = (chain >> 1) & 15, b = chain >> 5, role = F.wave, lane = F.lane;
    bf16* YR = (bf16*)(F.ws + WS_YR) + (size_t)d * MTOT * RWW;
    { LAS v4u* XCH = (LAS v4u*)F.lds; for (int i = F.tid; i < 4 * 2 * 64; i += NTHR) XCH[i] = (v4u){0u, 0u, 0u, 0u}; }
    __syncthreads();
    if (F.wave >= 2) {
#pragma unroll 1
        for (int step = 0; step < 68; ++step) LDS_BAR();
        return; }
    f32x4 S[4];
#pragma unroll
    for (int m = 0; m < 4; ++m) S[m] = (f32x4){0.f, 0.f, 0.f, 0.f};
    ChunkOps A, B, C, E;
    chunk_load(F, A, 0, b, hh, d, sl, role, lane); chunk_load(F, B, 1, b, hh, d, sl, role, lane); chunk_load(F, C, 2, b, hh, d, sl, role, lane);
#pragma unroll 1
    for (int step = 0; step < 68; step += 4) {
        chunk_load(F, E, step + 3, b, hh, d, sl, role, lane);
        chunk_apply(F, A, S, step, YR, hh, d, sl, role, lane); LDS_BAR();
        chunk_load(F, A, step + 4, b, hh, d, sl, role, lane);
        chunk_apply(F, B, S, step + 1, YR, hh, d, sl, role, lane); LDS_BAR();
        chunk_load(F, B, step + 5, b, hh, d, sl, role, lane);
        chunk_apply(F, C, S, step + 2, YR, hh, d, sl, role, lane); LDS_BAR();
        chunk_load(F, C, step + 6, b, hh, d, sl, role, lane);
        chunk_apply(F, E, S, step + 3, YR, hh, d, sl, role, lane); LDS_BAR();
    }
}
__device__ __forceinline__ void merge_unit(Frame& F, int l, int u) {
    const int c = u >> 2; const TileInfo ti = tile_info(c); const int t0 = ti.t0 + (u & 3) * 16; const bf16* P = (const bf16*)(F.ws + WS_P);
    LAS bf16* SG = (LAS bf16*)F.lds; LAS bf16* GO = (LAS bf16*)(F.lds + 10752);
    const float* mu0 = gin(F.in[I_MU]) + (size_t)l * 2 * RW_COLS; const float* mu1 = mu0 + RW_COLS;
    if (F.tid < 16 * 20) { const int t = F.tid / 20, k8 = (F.tid % 20) * 8, tt = t0 + t, rc = 3 * RWW + 256 + k8; const bf16* p = P + (size_t)(ti.seq_base + tt) * IN_PAD + 2 * LRW + rc;
        float x[8], xm[8], xn[8]; ld8bf(p, x); ld8bf(p - (tt > 0 ? IN_PAD : 0), xm); ld8bf(p + (tt + 1 < ti.seq_len ? IN_PAD : 0), xn); float o[8];
#pragma unroll
        for (int e = 0; e < 8; ++e) { const float pm = tt > 0 ? xm[e] : 0.f, pn = tt + 1 < ti.seq_len ? xn[e] : 0.f; o[e] = fsigmoid(x[e] + mu0[rc + e] * (pm - x[e]) + mu1[rc + e] * (pn - x[e])); }
        v4u w; w.x = pk2(o[0], o[1]); w.y = pk2(o[2], o[3]); w.z = pk2(o[4], o[5]); w.w = pk2(o[6], o[7]); *(LAS v4u*)(SG + t * 168 + k8) = w; }
    __syncthreads();
    { const int lane = F.lane; const bf16* G2 = (const bf16*)(F.ws + WS_G2T) + (size_t)l * 1024 * 160;
      bf16x8 af[5];
#pragma unroll
      for (int k = 0; k < 5; ++k) af[k] = frag_lds(SG, 168, 0, 32 * k, lane);
#pragma unroll 2
      for (int n = 0; n < 8; ++n) { const int n0 = F.wave * 128 + n * 16; f32x4 a0 = {0.f, 0.f, 0.f, 0.f};
#pragma unroll
          for (int k = 0; k < 5; ++k) a0 = MFMA16(af[k], frag_g(G2, 160, n0, 32 * k, lane), a0);
#pragma unroll
          for (int r = 0; r < 4; ++r) GO[(4 * (lane >> 4) + r) * 1032 + n0 + (lane & 15)] = (bf16)f2bf(a0[r]); } }
    __syncthreads();
    { bf16* MRG = (bf16*)(F.ws + WS_H);
      for (int it = F.tid; it < 16 * 256; it += NTHR) { const int t = it >> 8, cgp = it & 255, tt = t0 + t; const size_t grow = (size_t)(ti.seq_base + tt);
          float o[8];
          if (cgp < 128) { const int ch = cgp * 8; float gq8[8]; ld8bf(P + grow * IN_PAD + LRW + ch, gq8); const f32x4 g0 = {gq8[0], gq8[1], gq8[2], gq8[3]}, g1 = {gq8[4], gq8[5], gq8[6], gq8[7]};
              const bf16* hl = (const bf16*)(F.ws + WS_LB) + grow * LRW + ch; const bf16* ac = (const bf16*)(F.ws + WS_LA) + grow * LRW + ch; const float* hi = (const float*)(F.ws + WS_LHIN) + (size_t)c * LRW + ch;
              float h0[8], c0[8], h1[8], c1[8]; ld8bf(hl, h0); ld8bf(ac, c0); ld8bf(hl + (size_t)MTOT * LRW, h1); ld8bf(ac + (size_t)MTOT * LRW, c1);
              const f32x4 i00 = *(const f32x4*)hi, i01 = *(const f32x4*)(hi + 4), i10 = *(const f32x4*)(hi + (size_t)NTILE * LRW), i11 = *(const f32x4*)(hi + (size_t)NTILE * LRW + 4);
              const f32x4 a0 = {h0[0] + c0[0] * i00.x + h1[0] + c1[0] * i10.x, h0[1] + c0[1] * i00.y + h1[1] + c1[1] * i10.y, h0[2] + c0[2] * i00.z + h1[2] + c1[2] * i10.z, h0[3] + c0[3] * i00.w + h1[3] + c1[3] * i10.w};
              const f32x4 a1 = {h0[4] + c0[4] * i01.x + h1[4] + c1[4] * i11.x, h0[5] + c0[5] * i01.y + h1[5] + c1[5] * i11.y, h0[6] + c0[6] * i01.z + h1[6] + c1[6] * i11.z, h0[7] + c0[7] * i01.w + h1[7] + c1[7] * i11.w};
              o[0] = gelu_tanh(g0.x) * a0.x; o[1] = gelu_tanh(g0.y) * a0.y; o[2] = gelu_tanh(g0.z) * a0.z; o[3] = gelu_tanh(g0.w) * a0.w;
              o[4] = gelu_tanh(g1.x) * a1.x; o[5] = gelu_tanh(g1.y) * a1.y; o[6] = gelu_tanh(g1.z) * a1.z; o[7] = gelu_tanh(g1.w) * a1.w; }
          else { const int ch = (cgp - 128) * 8, hh = ch >> 6; const bf16* yr = (const bf16*)(F.ws + WS_YR) + grow * RWW + ch;
              float ya[8], yb[8], va[8]; ld8bf(yr, ya); ld8bf(yr + (size_t)MTOT * RWW, yb); ld8bf((const bf16*)(F.ws + WS_RV) + grow * RWW + ch, va);
              float s1 = 0.f, q1 = 0.f;
#pragma unroll
              for (int e = 0; e < 8; ++e) { ya[e] += yb[e]; s1 += ya[e]; q1 += ya[e] * ya[e]; }
              s1 = red8(s1); q1 = red8(q1);
              const float mean = s1 * (1.0f / 64.0f), var = fmaxf(q1 * (1.0f / 64.0f) - mean * mean, 0.f); const f32x2 st = {mean, __builtin_amdgcn_rsqf(var + GN_EPS)};
              const float beta = ((const float*)(F.ws + WS_BETA))[grow * NH + hh] + ((const float*)(F.ws + WS_BETA))[((size_t)MTOT + grow) * NH + hh];
              const float* gg = gin(F.in[I_GNG]) + (size_t)l * RWW + ch; const float* gb = gin(F.in[I_GNB]) + (size_t)l * RWW + ch;
              const v4u gq = *(const LAS v4u*)(GO + t * 1032 + ch); const float gv[8] = {bf_lo(gq.x), bf_hi(gq.x), bf_lo(gq.y), bf_hi(gq.y), bf_lo(gq.z), bf_hi(gq.z), bf_lo(gq.w), bf_hi(gq.w)};
#pragma unroll
              for (int e = 0; e < 8; ++e) o[e] = ((ya[e] - st.x) * st.y * gg[e] + gb[e] + beta * va[e]) * gv[e]; }
          v4u w; w.x = pk2(o[0], o[1]); w.y = pk2(o[2], o[3]); w.z = pk2(o[4], o[5]); w.w = pk2(o[6], o[7]);
          *(v4u*)(MRG + grow * D + cgp * 8) = w; } }
    __syncthreads();
}

__device__ __forceinline__ void ln_row(float (&z)[32], const float* g, const float* b, int lane) {
    float s = 0.f;
#pragma unroll
    for (int i = 0; i < 32; ++i) s += z[i];
    const float mean = wave_sum(s) * (1.0f / D); float q = 0.f;
#pragma unroll
    for (int i = 0; i < 32; ++i) { z[i] -= mean; q += z[i] * z[i]; }
    const float rstd = __builtin_amdgcn_rsqf(wave_sum(q) * (1.0f / D) + LN_EPS);
#pragma unroll
    for (int j = 0; j < 4; ++j) { const int e = j * 512 + lane * 8; const f32x4 g0 = *(const f32x4*)(g + e), g1 = *(const f32x4*)(g + e + 4), b0 = *(const f32x4*)(b + e), b1 = *(const f32x4*)(b + e + 4);
        const float gs[8] = {g0.x, g0.y, g0.z, g0.w, g1.x, g1.y, g1.z, g1.w}, bs[8] = {b0.x, b0.y, b0.z, b0.w, b1.x, b1.y, b1.z, b1.w};
#pragma unroll
        for (int i = 0; i < 8; ++i) z[j * 8 + i] = z[j * 8 + i] * rstd * gs[i] + bs[i]; }
}
__device__ __forceinline__ void load32(const float* p, int lane, float (&v)[32]) {
#pragma unroll
    for (int j = 0; j < 4; ++j) { const int e = j * 512 + lane * 8; const f32x4 a = *(const f32x4*)(p + e), b = *(const f32x4*)(p + e + 4);
        v[j * 8 + 0] = a.x; v[j * 8 + 1] = a.y; v[j * 8 + 2] = a.z; v[j * 8 + 3] = a.w; v[j * 8 + 4] = b.x; v[j * 8 + 5] = b.y; v[j * 8 + 6] = b.z; v[j * 8 + 7] = b.w; }
}
__device__ __forceinline__ void store32(float* p, int lane, const float (&v)[32]) {
#pragma unroll
    for (int j = 0; j < 4; ++j) { const int e = j * 512 + lane * 8; *(f32x4*)(p + e) = (f32x4){v[j * 8 + 0], v[j * 8 + 1], v[j * 8 + 2], v[j * 8 + 3]}; *(f32x4*)(p + e + 4) = (f32x4){v[j * 8 + 4], v[j * 8 + 5], v[j * 8 + 6], v[j * 8 + 7]}; }
}
__device__ __forceinline__ void store32_mod_bf16(bf16* p, const float* sh, const float* sc, int lane, const float (&v)[32]) {
#pragma unroll
    for (int j = 0; j < 4; ++j) { const int e = j * 512 + lane * 8; const f32x4 s0 = *(const f32x4*)(sh + e), s1 = *(const f32x4*)(sh + e + 4), c0 = *(const f32x4*)(sc + e), c1 = *(const f32x4*)(sc + e + 4);
        v4u o; o.x = pk2(v[j * 8 + 0] * (1.f + c0.x) + s0.x, v[j * 8 + 1] * (1.f + c0.y) + s0.y); o.y = pk2(v[j * 8 + 2] * (1.f + c0.z) + s0.z, v[j * 8 + 3] * (1.f + c0.w) + s0.w);
        o.z = pk2(v[j * 8 + 4] * (1.f + c1.x) + s1.x, v[j * 8 + 5] * (1.f + c1.y) + s1.y); o.w = pk2(v[j * 8 + 6] * (1.f + c1.z) + s1.z, v[j * 8 + 7] * (1.f + c1.w) + s1.w);
        *(v4u*)(p + e) = o; }
}
__device__ __forceinline__ void ln1_rows(Frame& F, int l, int nrows, bool dry = false) {
    const int gw = F.vcu * NWAVES + F.wave, NGW = F.G * NWAVES; float* X = (float*)(F.ws + WS_X); const float* O = (const float*)(F.ws + WS_O); bf16* H = (bf16*)(F.ws + WS_H);
    float* Xo = dry ? (float*)(F.ws + WS_LA) : X; bf16* Ho = dry ? (bf16*)(F.ws + WS_LB) : H;
    for (int row = gw; row < nrows; row += NGW) { const float* md = (const float*)(F.ws + WS_MOD) + ((size_t)l * 3 + mod_row(row)) * (6 * D);
        float z[32], o[32], gt[32]; load32(X + (size_t)row * D, F.lane, z); load32(md + 2 * D, F.lane, gt);
#pragma unroll
        for (int j = 0; j < 4; ++j) { float t8[8]; ld8bf((const bf16*)(F.ws + WS_O) + (size_t)row * D + j * 512 + F.lane * 8, t8);
#pragma unroll
            for (int i = 0; i < 8; ++i) o[j * 8 + i] = t8[i]; }
#pragma unroll
        for (int i = 0; i < 32; ++i) z[i] = ALPHA * z[i] + gt[i] * o[i];
        ln_row(z, gin(F.in[I_LN1G]) + (size_t)l * D, gin(F.in[I_LN1B]) + (size_t)l * D, F.lane);
        store32(Xo + (size_t)row * D, F.lane, z);
        store32_mod_bf16(Ho + (size_t)row * D, md + 3 * D, md + 4 * D, F.lane, z); }
}

__device__ __forceinline__ unsigned ord_key(float s, int k) { unsigned u = __builtin_bit_cast(unsigned, s); u = (u & 0x80000000u) ? ~u : (u | 0x80000000u); return (u & ~127u) | (unsigned)(127 - k); }
__device__ __forceinline__ float key_score(unsigned key) { const unsigned u = key & ~127u; return __builtin_bit_cast(float, (u & 0x80000000u) ? (u ^ 0x80000000u) : ~u); }
__device__ __forceinline__ void bitonic_top16(unsigned (&A)[16], const unsigned (&B)[16]) {
#pragma unroll
    for (int i = 0; i < 16; ++i) A[i] = A[i] > B[15 - i] ? A[i] : B[15 - i];
#pragma unroll
    for (int st = 8; st >= 1; st >>= 1)
#pragma unroll
        for (int i = 0; i < 16; ++i) if (!(i & st)) { const unsigned hi = A[i] > A[i + st] ? A[i] : A[i + st], lo = A[i] > A[i + st] ? A[i + st] : A[i]; A[i] = hi; A[i + st] = lo; }
}
__device__ __forceinline__ void ins16(unsigned (&L)[16], unsigned x) {
#pragma unroll
    for (int i = 0; i < 16; ++i) { const unsigned hi = L[i] > x ? L[i] : x; x = L[i] > x ? x : L[i]; L[i] = hi; }
}
__device__ __forceinline__ unsigned ord_key8(float s, unsigned tag) { unsigned u = __builtin_bit_cast(unsigned, s); u = (u & 0x80000000u) ? ~u : (u | 0x80000000u); return (u & ~255u) | tag; }
__device__ __forceinline__ float key_score8(unsigned key) { const unsigned u = key & ~255u; return __builtin_bit_cast(float, (u & 0x80000000u) ? (u ^ 0x80000000u) : ~u); }
__device__ __forceinline__ void peer_topk_unit(Frame& F, int l, int tile, int h) {
    int tid = F.tid; asm volatile("" : "+v"(tid));
    const int lane = tid & 63, wave = F.wave;
    LAS bf16* AQ = (LAS bf16*)F.lds; LAS float* SC = (LAS float*)(F.lds + 33792);
    LAS unsigned* bufA = (LAS unsigned*)F.lds; LAS unsigned* bufB = (LAS unsigned*)(F.lds + 33792); LAS unsigned* FIN = (LAS unsigned*)(F.lds + 66560); LAS unsigned char* PAIRT = (LAS unsigned char*)(F.lds + 99584);
    if (tid < 50) { int c = tid, i = 0; for (; i < 16; ++i) { const int n = 16 / (i + 1); if (c < n) break; c -= n; } PAIRT[tid] = (unsigned char)(i * 16 + c); }
    for (int idx = tid; idx < 64 * 64; idx += NTHR) { const int t = idx >> 6, c4 = (idx & 63) * 4; *(LAS v2u*)(AQ + t * 264 + c4) = *(const v2u*)((const bf16*)(F.ws + WS_QP) + (size_t)(tile * 64 + t) * D + h * 256 + c4); }
    __syncthreads();
    { const bf16* SK = (const bf16*)(F.ws + WS_SUBK) + (size_t)((l * 8 + h) * 2) * 128 * 128;
#pragma unroll
      for (int p = 0; p < 2; ++p) { bf16x8 bfr[4];
#pragma unroll
          for (int k = 0; k < 4; ++k) bfr[k] = frag_g(SK + (size_t)p * 128 * 128, 128, 16 * wave, 32 * k, lane);
#pragma unroll
          for (int m = 0; m < 4; ++m) { f32x4 acc = {0.f, 0.f, 0.f, 0.f};
#pragma unroll
              for (int k = 0; k < 4; ++k) acc = MFMA16(frag_lds(AQ, 264, 16 * m, p * 128 + 32 * k, lane), bfr[k], acc);
#pragma unroll
              for (int r = 0; r < 4; ++r) SC[(16 * m + 4 * (lane >> 4) + r) * 257 + p * 128 + 16 * wave + (lane & 15)] = acc[r]; } } }
    __syncthreads();
    const int t = lane, r = wave, p = r & 1, qd = r >> 1;
    unsigned L[16], B[16];
#pragma unroll
    for (int i = 0; i < 16; ++i) L[i] = 0u;
    { const LAS float* sp = SC + t * 257 + p * 128 + 32 * qd;
#pragma unroll 4
      for (int k = 0; k < 32; ++k) ins16(L, ord_key(sp[k], 32 * qd + k)); }
#pragma unroll
    for (int i = 0; i < 16; ++i) bufA[(r * 16 + i) * 64 + t] = L[i];
    __syncthreads();
#pragma unroll
    for (int i = 0; i < 16; ++i) B[i] = bufA[((r ^ 2) * 16 + i) * 64 + t];
    bitonic_top16(L, B);
#pragma unroll
    for (int i = 0; i < 16; ++i) bufB[(r * 16 + i) * 64 + t] = L[i];
    __syncthreads();
#pragma unroll
    for (int i = 0; i < 16; ++i) B[i] = bufB[((r ^ 4) * 16 + i) * 64 + t];
    bitonic_top16(L, B);
    if (qd == 0) {
#pragma unroll
        for (int i = 0; i < 16; ++i) FIN[(p * 16 + i) * 64 + t] = L[i]; }
    __syncthreads();
#pragma unroll
    for (int i = 0; i < 16; ++i) L[i] = 0u;
#pragma unroll
    for (int q = 0; q < 7; ++q) { const int c = q * 8 + r; if (c < 50) { const unsigned pr = PAIRT[c]; const unsigned ka = FIN[(0 * 16 + (pr >> 4)) * 64 + t], kb = FIN[(1 * 16 + (pr & 15)) * 64 + t];
            ins16(L, ord_key8(key_score(ka) + key_score(kb), pr)); } }
#pragma unroll
    for (int i = 0; i < 16; ++i) bufB[(r * 16 + i) * 64 + t] = L[i];
    __syncthreads();
#pragma unroll
    for (int i = 0; i < 16; ++i) B[i] = bufB[((r ^ 1) * 16 + i) * 64 + t];
    bitonic_top16(L, B);
#pragma unroll
    for (int i = 0; i < 16; ++i) bufA[(r * 16 + i) * 64 + t] = L[i];
    __syncthreads();
#pragma unroll
    for (int i = 0; i < 16; ++i) B[i] = bufA[((r ^ 2) * 16 + i) * 64 + t];
    bitonic_top16(L, B);
    __syncthreads();
#pragma unroll
    for (int i = 0; i < 16; ++i) bufB[(r * 16 + i) * 64 + t] = L[i];
    __syncthreads();
#pragma unroll
    for (int i = 0; i < 16; ++i) B[i] = bufB[((r ^ 4) * 16 + i) * 64 + t];
    bitonic_top16(L, B);
    { const float mx = key_score8(L[0]); float sum = 0.f, e0 = 0.f, e1 = 0.f; unsigned k0 = 0u, k1 = 0u;
#pragma unroll
      for (int i = 0; i < 16; ++i) { const float e = fexp(key_score8(L[i]) - mx); sum += e; if (i == 2 * r) { e0 = e; k0 = L[i]; } if (i == 2 * r + 1) { e1 = e; k1 = L[i]; } }
      const float inv = __builtin_amdgcn_rcpf(sum);
      const unsigned pa = k0 & 255u, pb = k1 & 255u;
      const int id0 = (127 - (int)(FIN[(0 * 16 + (pa >> 4)) * 64 + t] & 127u)) * 128 + (127 - (int)(FIN[(1 * 16 + (pa & 15)) * 64 + t] & 127u));
      const int id1 = (127 - (int)(FIN[(0 * 16 + (pb >> 4)) * 64 + t] & 127u)) * 128 + (127 - (int)(FIN[(1 * 16 + (pb & 15)) * 64 + t] & 127u));
      int* IDX = (int*)(F.ws + WS_IDX) + (size_t)(tile * 64 + t) * PE_SEL + h * 16 + 2 * r; float* GT = (float*)(F.ws + WS_GATE) + (size_t)(tile * 64 + t) * PE_SEL + h * 16 + 2 * r;
      *(int2*)IDX = make_int2(id0, id1); *(f32x2*)GT = (f32x2){e0 * inv, e1 * inv}; }
    __syncthreads();
}

__device__ __forceinline__ void unpack16(const v4u& w, f32x2 (&o)[8]) {
    o[0] = __builtin_amdgcn_cvt_pk_f32_fp8((int)w.x, false); o[1] = __builtin_amdgcn_cvt_pk_f32_fp8((int)w.x, true); o[2] = __builtin_amdgcn_cvt_pk_f32_fp8((int)w.y, false); o[3] = __builtin_amdgcn_cvt_pk_f32_fp8((int)w.y, true);
    o[4] = __builtin_amdgcn_cvt_pk_f32_fp8((int)w.z, false); o[5] = __builtin_amdgcn_cvt_pk_f32_fp8((int)w.z, true); o[6] = __builtin_amdgcn_cvt_pk_f32_fp8((int)w.w, false); o[7] = __builtin_amdgcn_cvt_pk_f32_fp8((int)w.w, true);
}
constexpr int EB = 8;
__device__ __forceinline__ void peer_token(Frame& F, int l, int row, int kb, int ke, f32x2 (&acc)[2][8]) {
    const int lane = F.lane;
    const unsigned char* UB = (const unsigned char*)(F.ws + WS_UB + (size_t)l * PE_NE * D); const unsigned char* VB = (const unsigned char*)(F.ws + WS_VB + (size_t)l * PE_NE * D);
    const float* SU = (const float*)(F.ws + WS_SU) + (size_t)l * PE_NE; const float* SV = (const float*)(F.ws + WS_SV) + (size_t)l * PE_NE;
    const bf16* H = (const bf16*)(F.ws + WS_H);
        const int* IDX = (const int*)(F.ws + WS_IDX) + (size_t)row * PE_SEL; const float* GT = (const float*)(F.ws + WS_GATE) + (size_t)row * PE_SEL;
        const int il = IDX[lane], ih = IDX[64 + lane]; const float gl = GT[lane], gh = GT[64 + lane];
        const float sul = SU[il], suh = SU[ih], svl = SV[il], svh = SV[ih];
        f32x2 hf[2][8];
#pragma unroll
        for (int j = 0; j < 2; ++j) { const v4u a = *(const v4u*)(H + (size_t)row * D + j * 1024 + lane * 16), b = *(const v4u*)(H + (size_t)row * D + j * 1024 + lane * 16 + 8);
            hf[j][0] = (f32x2){bf_lo(a.x), bf_hi(a.x)}; hf[j][1] = (f32x2){bf_lo(a.y), bf_hi(a.y)}; hf[j][2] = (f32x2){bf_lo(a.z), bf_hi(a.z)}; hf[j][3] = (f32x2){bf_lo(a.w), bf_hi(a.w)};
            hf[j][4] = (f32x2){bf_lo(b.x), bf_hi(b.x)}; hf[j][5] = (f32x2){bf_lo(b.y), bf_hi(b.y)}; hf[j][6] = (f32x2){bf_lo(b.z), bf_hi(b.z)}; hf[j][7] = (f32x2){bf_lo(b.w), bf_hi(b.w)}; }
        int dl = 0, dh = 0;
#pragma unroll 1
        for (int k0 = kb; k0 < ke; k0 += EB) { v4u w[EB][2];
#pragma unroll
            for (int q = 0; q < EB; ++q) { const int k = k0 + q; const int e = __builtin_amdgcn_readlane(k0 < 64 ? il : ih, k & 63); const unsigned char* ur = UB + (size_t)e * D + lane * 16;
                w[q][0] = *(const v4u*)ur; w[q][1] = *(const v4u*)(ur + 1024); }
#pragma unroll
            for (int q = 0; q < EB; ++q) { const int k = k0 + q; f32x2 p2 = {0.f, 0.f};
#pragma unroll
                for (int j = 0; j < 2; ++j) { f32x2 uf[8]; unpack16(w[q][j], uf);
#pragma unroll
                    for (int i = 0; i < 8; ++i) p2 = __builtin_elementwise_fma(uf[i], hf[j][i], p2); }
                const int tb = __builtin_bit_cast(int, wave_total(p2.x + p2.y));
                if (k0 < 64) dl = (lane == (k & 63)) ? tb : dl; else dh = (lane == (k & 63)) ? tb : dh; } }
        const float cl = gl * svl * gelu_erf(__builtin_bit_cast(float, dl) * sul), ch = gh * svh * gelu_erf(__builtin_bit_cast(float, dh) * suh);
#pragma unroll
        for (int j = 0; j < 2; ++j)
#pragma unroll
            for (int i = 0; i < 8; ++i) acc[j][i] = (f32x2){0.f, 0.f};
#pragma unroll 1
        for (int k0 = kb; k0 < ke; k0 += EB) { v4u w[EB][2];
#pragma unroll
            for (int q = 0; q < EB; ++q) { const int k = k0 + q; const int e = __builtin_amdgcn_readlane(k0 < 64 ? il : ih, k & 63); const unsigned char* vr = VB + (size_t)e * D + lane * 16;
                w[q][0] = *(const v4u*)vr; w[q][1] = *(const v4u*)(vr + 1024); }
#pragma unroll
            for (int q = 0; q < EB; ++q) { const int k = k0 + q; const float cf = __builtin_bit_cast(float, __builtin_amdgcn_readlane(__builtin_bit_cast(int, k0 < 64 ? cl : ch), k & 63)); const f32x2 cf2 = {cf, cf};
#pragma unroll
                for (int j = 0; j < 2; ++j) { f32x2 vf[8]; unpack16(w[q][j], vf);
#pragma unroll
                    for (int i = 0; i < 8; ++i) acc[j][i] = __builtin_elementwise_fma(vf[i], cf2, acc[j][i]); } } }
}
__device__ __forceinline__ void peer_finish(Frame& F, int l, int row, const f32x2 (&acc)[2][8], bool dry) {
    const int lane = F.lane;
    float* X = (float*)(F.ws + WS_X); bf16* H = (bf16*)(F.ws + WS_H); float* Xo = dry ? (float*)(F.ws + WS_LA) : X; bf16* Ho = dry ? (bf16*)(F.ws + WS_LB) : H; float* Oo = dry ? (float*)(F.ws + WS_LA) : (float*)F.out;
        const float* md = (const float*)(F.ws + WS_MOD) + ((size_t)l * 3 + mod_row(row)) * (6 * D);
        float z[32]; float s = 0.f;
#pragma unroll
        for (int j = 0; j < 2; ++j)
#pragma unroll
            for (int q = 0; q < 4; ++q) { const int e = j * 1024 + lane * 16 + q * 4; const f32x4 xv = *(const f32x4*)(X + (size_t)row * D + e), gv = *(const f32x4*)(md + 5 * D + e);
                z[j * 16 + q * 4 + 0] = ALPHA * xv.x + gv.x * acc[j][2 * q][0]; z[j * 16 + q * 4 + 1] = ALPHA * xv.y + gv.y * acc[j][2 * q][1]; z[j * 16 + q * 4 + 2] = ALPHA * xv.z + gv.z * acc[j][2 * q + 1][0]; z[j * 16 + q * 4 + 3] = ALPHA * xv.w + gv.w * acc[j][2 * q + 1][1]; }
#pragma unroll
        for (int i = 0; i < 32; ++i) s += z[i];
        const float mean = wave_sum(s) * (1.0f / D); float qv = 0.f;
#pragma unroll
        for (int i = 0; i < 32; ++i) { z[i] -= mean; qv += z[i] * z[i]; }
        const float rstd = __builtin_amdgcn_rsqf(wave_sum(qv) * (1.0f / D) + LN_EPS);
        const float* lg = gin(F.in[I_LN2G]) + (size_t)l * D; const float* lb = gin(F.in[I_LN2B]) + (size_t)l * D; const float* mn = (const float*)(F.ws + WS_MOD) + ((size_t)(l + 1 < DEPTH ? l + 1 : l) * 3 + mod_row(row)) * (6 * D);
#pragma unroll
        for (int j = 0; j < 2; ++j) { unsigned hw[8];
#pragma unroll
            for (int q = 0; q < 4; ++q) { const int e = j * 1024 + lane * 16 + q * 4; const f32x4 g4 = *(const f32x4*)(lg + e), b4 = *(const f32x4*)(lb + e);
                f32x4 o; o.x = z[j * 16 + q * 4 + 0] * rstd * g4.x + b4.x; o.y = z[j * 16 + q * 4 + 1] * rstd * g4.y + b4.y; o.z = z[j * 16 + q * 4 + 2] * rstd * g4.z + b4.z; o.w = z[j * 16 + q * 4 + 3] * rstd * g4.w + b4.w;
                if (l + 1 < DEPTH) { *(f32x4*)(Xo + (size_t)row * D + e) = o; const f32x4 s4 = *(const f32x4*)(mn + e), c4 = *(const f32x4*)(mn + D + e);
                    hw[2 * q] = pk2(o.x * (1.f + c4.x) + s4.x, o.y * (1.f + c4.y) + s4.y); hw[2 * q + 1] = pk2(o.z * (1.f + c4.z) + s4.z, o.w * (1.f + c4.w) + s4.w); }
                else *(f32x4*)(Oo + (size_t)row * D + e) = o; }
            if (l + 1 < DEPTH) { *(v4u*)(Ho + (size_t)row * D + j * 1024 + lane * 16) = (v4u){hw[0], hw[1], hw[2], hw[3]}; *(v4u*)(Ho + (size_t)row * D + j * 1024 + lane * 16 + 8) = (v4u){hw[4], hw[5], hw[6], hw[7]}; } }
}
__device__ __forceinline__ void peer_rows(Frame& F, int l, int nrows, bool dry = false) {
    const int gw = F.vcu * NWAVES + F.wave, NGW = F.G * NWAVES, lane = F.lane;
    for (int row = gw; row < NLAT; row += NGW) { f32x2 acc[2][8]; peer_token(F, l, row, 0, PE_SEL, acc); peer_finish(F, l, row, acc, dry); }
    if (nrows > NLAT) { LAS f32x2* PART = (LAS f32x2*)F.lds;
        for (int r2 = F.vcu * 2 + (F.wave >> 2); r2 < NCTX; r2 += F.G * 2) { const int row = NLAT + r2, part = F.wave & 3, slot = F.wave >> 2; f32x2 acc[2][8];
            peer_token(F, l, row, 32 * part, 32 * part + 32, acc);
            if (part) {
#pragma unroll
                for (int j = 0; j < 2; ++j)
#pragma unroll
                    for (int i = 0; i < 8; ++i) PART[((slot * 3 + part - 1) * 16 + j * 8 + i) * 64 + lane] = acc[j][i]; }
            __syncthreads();
            if (part == 0) {
#pragma unroll
                for (int p = 0; p < 3; ++p)
#pragma unroll
                    for (int j = 0; j < 2; ++j)
#pragma unroll
                        for (int i = 0; i < 8; ++i) acc[j][i] += PART[((slot * 3 + p) * 16 + j * 8 + i) * 64 + lane];
                peer_finish(F, l, row, acc, dry); }
            __syncthreads(); } }
}
#ifndef MK_PER_PHASE
#define MK_PER_PHASE 0
#endif
constexpr int NPH_PRO = 3, NPH_LAYER = 9, NPHASES = NPH_PRO + DEPTH * NPH_LAYER;
__global__ void __launch_bounds__(NTHR, 2) trunk_fwd(Args args) {
    extern __shared__ __attribute__((aligned(16))) unsigned char lds_raw[];
    Frame F0;
    F0.lds = (LAS unsigned char*)lds_raw;
    F0.tid = threadIdx.x; F0.lane = F0.tid & 63; F0.wave = __builtin_amdgcn_readfirstlane(F0.tid >> 6);
    F0.G = gridDim.x; { const int bx = blockIdx.x; F0.vcu = (F0.G % 8 == 0) ? (bx % 8) * (F0.G / 8) + bx / 8 : bx; }
    F0.in = args.in; F0.out = (GAS float*)args.out; F0.ws = (GAS unsigned char*)args.ws;
    volatile LAS unsigned* MISC = (volatile LAS unsigned*)(F0.lds + MISC_OFF);
    for (int u = F0.tid; u < (LDS_BYTES - LDSCTL_OFF) / 4; u += NTHR) ((LAS unsigned*)(F0.lds + LDSCTL_OFF))[u] = 0u;
    __syncthreads();
    const int lo = args.ph_lo, hi = args.ph_hi;
    XcdBarrier bar; bar.bar = (unsigned*)(F0.ws + WS_CTL) + CW_BAR; bar.x = 0; bar.st = nullptr;
    if (hi - lo > 1) bar = xcd_barrier_post((unsigned*)(F0.ws + WS_CTL) + CW_BAR, MISC + 8);
#ifndef PHMASK
#define PHMASK 0xfff
#endif
#define PHM(b) ((PHMASK >> (b)) & 1)
#ifndef PHREP
#define PHREP 0
#endif
#define NREP(b) (1 + ((PHREP >> (b)) & 1))
#define IN(k) (lo <= (k) && (k) < hi)
#define LAUNDER() Frame F = F0; int bx_ = blockIdx.x; { int ws_ = F0.wave; asm volatile("" : "+s"(ws_)); int ln_; asm volatile("v_mbcnt_lo_u32_b32 %0, -1, 0\n\tv_mbcnt_hi_u32_b32 %0, -1, %0" : "=v"(ln_)); F.wave = ws_; F.lane = ln_; F.tid = ws_ * 64 + ln_; \
    GAS unsigned char* w_ = F0.ws; asm volatile("" : "+s"(w_)); F.ws = w_; int v_ = F0.vcu; asm volatile("" : "+s"(v_)); F.vcu = v_; int g_ = F0.G; asm volatile("" : "+s"(g_)); F.G = g_; \
    GAS float* o_ = F0.out; asm volatile("" : "+s"(o_)); F.out = o_; asm volatile("" : "+s"(bx_)); \
    unsigned l_ = (unsigned)(size_t)F0.lds; asm volatile("" : "+v"(l_)); F.lds = (LAS unsigned char*)(size_t)l_; }
#define SEAM(k) do { if (IN(k) && IN((k) + 1)) xcd_barrier(bar); } while (0)

    if (PHM(0) && IN(0)) for (int rep_ = 0; rep_ < NREP(0); ++rep_) { LAUNDER(); p0_prologue(F); } SEAM(0);
    if (PHM(1) && IN(1)) { LAUNDER(); p0b_mod_reduce(F); } SEAM(1);
    if (PHM(2) && IN(2)) { LAUNDER(); modulate_rows(F, 0, 0, MTOT); } SEAM(2);

#pragma unroll 1
    for (int l = 0; l < DEPTH; ++l) {
        const int pb = NPH_PRO + l * NPH_LAYER;
        const int mrows = (l + 1 < DEPTH) ? MTOT : NLAT;
        if (PHM(3) && IN(pb + 0)) for (int rep_ = 0; rep_ < NREP(3); ++rep_) { LAUNDER(); pg8::Gemm g{(const pg8::bf16_t*)(F.ws + WS_H), (const pg8::bf16_t*)(F.ws + WS_WIN) + (size_t)l * IN_PAD * D, MTOT, IN_PAD, D, D};
            pg8::StaticOrder S; S.init(MTOT, IN_PAD, F.G, bx_); pg8::EpiBf16<0> E{(pg8::bf16_t*)(F.ws + WS_P), IN_PAD, nullptr, 0, 0};
            pg8::gemm_phase<pg8::EpiBf16<0>, pg8::StaticOrder, false>(F.lds, g, S, E, nullptr, F.tid); }
        SEAM(pb + 0);
        if (PHM(4) && IN(pb + 1)) for (int rep_ = 0; rep_ < NREP(4); ++rep_) { LAUNDER(); for (int r2 = 0; r2 < NREP(12); ++r2) for (int u = F.vcu; u < NTILE * NH; u += F.G) lru_prep_unit(F, l, u >> 4, u & 15); asm volatile("" ::: "memory"); for (int r2 = 0; r2 < NREP(13); ++r2) { int cur_hd = -1;
                for (int v = F.vcu; v < 2 * NTILE * NH; v += F.G) { const int hh_ = (v >> 1) & 15, d_ = v & 1;
                    if (hh_ * 2 + d_ != cur_hd) { cur_hd = hh_ * 2 + d_; __syncthreads(); LAS float* MUS = (LAS float*)(F.lds + 125184); const float* mu = gin(F.in[I_MU]) + (size_t)l * 2 * RW_COLS;
                        for (int i = F.tid; i < 5 * 2 * 64; i += NTHR) { const int g = i >> 7, wh = (i >> 6) & 1, col = i & 63; const int rc = g < 3 ? g * RWW + hh_ * 64 : 3 * RWW + (g - 3) * 128 + d_ * 64; MUS[i] = mu[(size_t)wh * RW_COLS + rc + col]; }
                        __syncthreads(); }
                    rwkv_chunk_prep(F, l, v >> 5, hh_, d_); } } }
        SEAM(pb + 1);
        if (PHM(5) && IN(pb + 2)) for (int rep_ = 0; rep_ < NREP(5); ++rep_) { LAUNDER(); for (int u = F.vcu; u < 256; u += F.G) { if (u < 32 && F.wave >= 2 && F.wave < 4) lru_scan(F, u * 128 + F.tid - 128); rwkv_chain_chunks(F, u); } }
        SEAM(pb + 2);
        if (PHM(6) && IN(pb + 3)) for (int rep_ = 0; rep_ < NREP(6); ++rep_) { LAUNDER(); for (int u = F.vcu; u < 4 * NTILE; u += F.G) merge_unit(F, l, u); }
        SEAM(pb + 3);
        if (PHM(7) && IN(pb + 4)) for (int rep_ = 0; rep_ < NREP(7); ++rep_) { LAUNDER(); pg8::Gemm g{(const pg8::bf16_t*)(F.ws + WS_H), (const pg8::bf16_t*)(F.ws + WS_WOUT) + (size_t)l * D * D, mrows, D, D, D};
            pg8::StaticOrder S; S.init(mrows, D, F.G, bx_); pg8::EpiBf16<0> E{(pg8::bf16_t*)(F.ws + WS_O), D, nullptr, 0, 0};
            pg8::gemm_phase<pg8::EpiBf16<0>, pg8::StaticOrder, false>(F.lds, g, S, E, nullptr, F.tid); }
        SEAM(pb + 4);
        if (PHM(8) && IN(pb + 5)) { LAUNDER(); if (NREP(8) > 1) ln1_rows(F, l, mrows, true); ln1_rows(F, l, mrows); }
        SEAM(pb + 5);
        if (PHM(9) && IN(pb + 6)) for (int rep_ = 0; rep_ < NREP(9); ++rep_) { LAUNDER(); pg8::Gemm g{(const pg8::bf16_t*)(F.ws + WS_H), (const pg8::bf16_t*)(F.ws + WS_WQ) + (size_t)l * D * D, mrows, D, D, D};
            pg8::StaticOrder S; S.init(mrows, D, F.G, bx_); pg8::EpiBf16<0> E{(pg8::bf16_t*)(F.ws + WS_QP), D, nullptr, 0, 0};
            pg8::gemm_phase<pg8::EpiBf16<0>, pg8::StaticOrder, false>(F.lds, g, S, E, nullptr, F.tid); }
        SEAM(pb + 6);
        if (PHM(10) && IN(pb + 7)) for (int rep_ = 0; rep_ < NREP(10); ++rep_) { LAUNDER(); for (int u = F.vcu; u < (mrows / 64) * PE_H; u += F.G) peer_topk_unit(F, l, u >> 3, u & 7); }
        SEAM(pb + 7);
        if (PHM(11) && IN(pb + 8)) { LAUNDER(); if (NREP(11) > 1) peer_rows(F, l, mrows, true); peer_rows(F, l, mrows); }
        if (l + 1 < DEPTH) SEAM(pb + 8);
    }
#undef IN
#undef SEAM
}

extern "C" void kernel_launch(void* const* d_in, const int* in_sizes, int n_in, void* d_out, int out_size, void* d_ws, size_t ws_size, hipStream_t stream) {
    static int grid = 0;
    if (grid == 0) {
        if (n_in != N_IN || out_size != NLAT * D || ws_size < WS_END) { fprintf(stderr, "kernel_launch: unexpected shapes (n_in %d, out %d, ws %zu < %zu)\n", n_in, out_size, ws_size, (size_t)WS_END); grid = -1; return; }
        int dev = 0, cus = 0, per_cu = 0;
        if (hipGetDevice(&dev) != hipSuccess || hipDeviceGetAttribute(&cus, hipDeviceAttributeMultiprocessorCount, dev) != hipSuccess) { grid = -1; return; }
        if (hipFuncSetAttribute((const void*)trunk_fwd, hipFuncAttributeMaxDynamicSharedMemorySize, LDS_BYTES) != hipSuccess) { fprintf(stderr, "kernel_launch: hipFuncSetAttribute failed\n"); grid = -1; return; }
        if (hipOccupancyMaxActiveBlocksPerMultiprocessor(&per_cu, (const void*)trunk_fwd, NTHR, LDS_BYTES) != hipSuccess || per_cu < 1) fprintf(stderr, "kernel_launch: occupancy query reports %d\n", per_cu);
        (void)hipGetLastError();
        grid = cus;
    }
    if (grid < 0) return;
    (void)hipMemsetAsync((char*)d_ws + WS_CTL, 0, CTL_ZERO_BYTES, stream);
    Args a{};
    for (int i = 0; i < N_IN; ++i) a.in[i] = (const float*)d_in[i];
    a.out = (float*)d_out; a.ws = (unsigned char*)d_ws;
#if MK_PER_PHASE
    for (int ph = 0; ph < NPHASES; ++ph) { a.ph_lo = ph; a.ph_hi = ph + 1; hipLaunchKernelGGL(trunk_fwd, dim3(grid), dim3(NTHR), LDS_BYTES, stream, a); }
#else
    a.ph_lo = 0; a.ph_hi = NPHASES;
    hipLaunchKernelGGL(trunk_fwd, dim3(grid), dim3(NTHR), LDS_BYTES, stream, a);
#endif
    const hipError_t le = hipPeekAtLastError();
    if (le != hipSuccess) fprintf(stderr, "kernel_launch: launch failed: %s\n", hipGetErrorName(le));
}
```

```cpp
#include <hip/hip_runtime.h>
#include <cstdio>
#include <cstdint>

constexpr int D = 2048, NB = 2, SEQ = 4096, DEPTH = 4, CTXL = 256;
constexpr int NLAT = NB * SEQ, NCTX = NB * CTXL, MTOT = NLAT + NCTX;
constexpr int LRW = 1024, RWW = 1024, NH = 16, HD = 64;
constexpr int RW_COLS = 3488, IN_COLS = 5536, IN_PAD = 5632;
constexpr int PE_H = 8, PE_K = 128, PE_DQ = 256, PE_TOP = 16, PE_NE = 16384, PE_SEL = PE_H * PE_TOP;
constexpr int NTILE = MTOT / 64;
constexpr float ALPHA = 1.681792830507429f;
constexpr float LN_EPS = 1e-5f, GN_EPS = 64e-5f;
constexpr int KSPLIT = 16;

enum { I_X = 0, I_C, I_CTX, I_CCTX, I_ADAW, I_ADAB, I_WIN, I_CONVW, I_CONVB, I_WA, I_BA, I_WX, I_BX, I_LAM, I_MU, I_W0, I_W2, I_A0, I_A2, I_G2,
       I_KK, I_KA, I_RK, I_GNG, I_GNB, I_WOUT, I_LN1G, I_LN1B, I_WQ, I_SUBK, I_U, I_V, I_LN2G, I_LN2B, N_IN };

constexpr size_t MiB = 1u << 20;
constexpr size_t al(size_t x) { return (x + MiB - 1) / MiB * MiB; }
constexpr size_t WS_CTL = 0, CTL_ZERO_BYTES = 1 * MiB;
constexpr size_t WS_MOD   = WS_CTL + CTL_ZERO_BYTES;
constexpr size_t WS_MODP  = al(WS_MOD + (size_t)DEPTH * 3 * 6 * D * 4);
constexpr size_t WS_WIN   = al(WS_MODP + (size_t)KSPLIT * DEPTH * 3 * 6 * D * 4);
constexpr size_t WS_WOUT  = al(WS_WIN + (size_t)DEPTH * IN_PAD * D * 2);
constexpr size_t WS_WQ    = al(WS_WOUT + (size_t)DEPTH * D * D * 2);
constexpr size_t WS_SUBK  = al(WS_WQ + (size_t)DEPTH * D * D * 2);
constexpr size_t WS_WLRU  = al(WS_SUBK + (size_t)DEPTH * 8 * 2 * 128 * 128 * 2);
constexpr size_t WS_W2T   = al(WS_WLRU + (size_t)DEPTH * 2 * 2 * 16 * 64 * 64 * 2);
constexpr size_t WS_A2T   = al(WS_W2T + (size_t)DEPTH * 2 * 1024 * 64 * 2);
constexpr size_t WS_G2T   = al(WS_A2T + (size_t)DEPTH * 2 * 1024 * 64 * 2);
constexpr size_t WS_UB    = al(WS_G2T + (size_t)DEPTH * 1024 * 160 * 2);
constexpr size_t WS_VB    = al(WS_UB + (size_t)DEPTH * PE_NE * D);
constexpr size_t WS_SU    = al(WS_VB + (size_t)DEPTH * PE_NE * D);
constexpr size_t WS_SV    = al(WS_SU + (size_t)DEPTH * PE_NE * 4);
constexpr size_t WS_X     = al(WS_SV + (size_t)DEPTH * PE_NE * 4);
constexpr size_t WS_H     = al(WS_X + (size_t)MTOT * D * 4);
constexpr size_t WS_P     = al(WS_H + (size_t)MTOT * D * 2);
constexpr size_t WS_LA    = al(WS_P + (size_t)MTOT * IN_PAD * 4);
constexpr size_t WS_LB    = al(WS_LA + (size_t)2 * MTOT * LRW * 4);
constexpr size_t WS_LAGG  = al(WS_LB + (size_t)2 * MTOT * LRW * 4);
constexpr size_t WS_LHIN  = al(WS_LAGG + (size_t)4 * NTILE * LRW * 4);
constexpr int KSL = 8;
constexpr size_t WS_SLAB  = al(WS_LHIN + (size_t)2 * NTILE * LRW * 4);
constexpr size_t WS_YL    = al(WS_SLAB + (size_t)2 * KSL * NCTX * D * 4);
constexpr int NUNIT = NTILE * NH * 2;
constexpr size_t WS_RV    = al(WS_YL + 4096);
constexpr size_t WS_QM    = al(WS_RV + (size_t)MTOT * RWW * 4);
constexpr size_t WS_PHI   = al(WS_QM + (size_t)NUNIT * 4096 * 2);
constexpr size_t WS_Y0F   = al(WS_PHI + (size_t)NUNIT * 4096 * 2);
constexpr size_t WS_PSF   = al(WS_Y0F + (size_t)NUNIT * 4096 * 2);
constexpr size_t WS_YR    = al(WS_PSF + (size_t)NUNIT * 4096 * 2);
constexpr size_t WS_BETA  = al(WS_YR + (size_t)2 * MTOT * RWW * 4);
constexpr size_t WS_IDX   = al(WS_BETA + (size_t)2 * MTOT * NH * 4);
constexpr size_t WS_GATE  = al(WS_IDX + (size_t)MTOT * PE_SEL * 4);
constexpr size_t WS_END   = al(WS_GATE + (size_t)MTOT * PE_SEL * 4);
constexpr size_t WS_O = WS_P;
constexpr size_t WS_QP = WS_P + (size_t)MTOT * D * 4;
static_assert(WS_QP + (size_t)MTOT * D * 4 <= WS_LA, "O/QP overlay inside P");

constexpr int CW_BAR = 4096;

constexpr int RING_BYTES = 131072;
constexpr int LDSCTL_OFF = RING_BYTES, MISC_OFF = LDSCTL_OFF + 320;
constexpr int LDS_BYTES = 147456;
constexpr int NWAVES = 8, NTHR = 512;

#define GAS __attribute__((address_space(1)))
#define LAS __attribute__((address_space(3)))
typedef unsigned short bf16;
typedef unsigned v4u __attribute__((ext_vector_type(4)));
typedef unsigned v2u __attribute__((ext_vector_type(2)));
typedef float f32x4 __attribute__((ext_vector_type(4)));
typedef float f32x2 __attribute__((ext_vector_type(2)));
typedef short bf16x8 __attribute__((ext_vector_type(8)));
#define RLX_AGENT __ATOMIC_RELAXED, __HIP_MEMORY_SCOPE_AGENT
#define LDS_WAIT() asm volatile("s_waitcnt lgkmcnt(0)" ::: "memory")
#define VM_WAIT() asm volatile("s_waitcnt vmcnt(0)" ::: "memory")

__device__ __forceinline__ const float* gin(const float* p) { return (const float*)(const GAS float*)p; }
__device__ __forceinline__ unsigned f2bf(float f) { unsigned u = __builtin_bit_cast(unsigned, f); return (u + 0x7fffu + ((u >> 16) & 1u)) >> 16; }
typedef __bf16 bf16x2t __attribute__((ext_vector_type(2)));
__device__ __forceinline__ unsigned pk2(float lo, float hi) { return __builtin_bit_cast(unsigned, __builtin_convertvector((f32x2){lo, hi}, bf16x2t)); }
__device__ __forceinline__ float bf_lo(unsigned w) { return __builtin_bit_cast(float, w << 16); }
__device__ __forceinline__ float bf_hi(unsigned w) { return __builtin_bit_cast(float, w & 0xffff0000u); }
__device__ __forceinline__ float fexp(float x) { return __builtin_amdgcn_exp2f(x * 1.4426950408889634f); }
__device__ __forceinline__ float fsigmoid(float x) { return __builtin_amdgcn_rcpf(1.0f + fexp(-x)); }
__device__ __forceinline__ float fsoftplus(float x) { return fmaxf(x, 0.f) + 0.6931471805599453f * __builtin_amdgcn_logf(1.0f + fexp(-fabsf(x))); }
__device__ __forceinline__ float ftanh(float x) { const float e = fexp(2.0f * x); return 1.0f - 2.0f * __builtin_amdgcn_rcpf(e + 1.0f); }
__device__ __forceinline__ float gelu_tanh(float x) { return 0.5f * x * (1.0f + ftanh(0.7978845608028654f * (x + 0.044715f * x * x * x))); }
__device__ __forceinline__ float gelu_erf(float v) {
    const float av = fabsf(v), t = __builtin_amdgcn_rcpf(av * 0.2316418882f + 1.0f);
    float q = t * 0.5307027145f + (-0.7265760135f); q = q * t + 0.7107068705f; q = q * t + (-0.142248368f); q = q * t + 0.127414796f; q = q * t;
    const float e = __builtin_amdgcn_exp2f((v * v) * (-0.72134752044f));
    const float m = v * (q * e);
    return v < 0.f ? m : v - m;
}
template <int CTRL> __device__ __forceinline__ float dpp_f(float v) { return __builtin_bit_cast(float, __builtin_amdgcn_update_dpp(0, __builtin_bit_cast(int, v), CTRL, 0xf, 0xf, true)); }
__device__ __forceinline__ float red8(float v) { v += dpp_f<0xB1>(v); v += dpp_f<0x4E>(v); v += dpp_f<0x141>(v); return v; }
__device__ __forceinline__ float red16(float v) { v = red8(v); v += dpp_f<0x140>(v); return v; }
__device__ __forceinline__ float wave_total(float v) {
    v = red16(v);
    v += __builtin_bit_cast(float, __builtin_amdgcn_update_dpp(0, __builtin_bit_cast(int, v), 0x142, 0xa, 0xf, false));
    v += __builtin_bit_cast(float, __builtin_amdgcn_update_dpp(0, __builtin_bit_cast(int, v), 0x143, 0xc, 0xf, false));
    return __builtin_bit_cast(float, __builtin_amdgcn_readlane(__builtin_bit_cast(int, v), 63));
}
__device__ __forceinline__ float wave_sum(float v) { return wave_total(v); }
__device__ __forceinline__ float wave_max(float v) {
    v = fmaxf(v, dpp_f<0xB1>(v)); v = fmaxf(v, dpp_f<0x4E>(v)); v = fmaxf(v, dpp_f<0x141>(v)); v = fmaxf(v, dpp_f<0x140>(v));
    const float a = __builtin_bit_cast(float, __builtin_amdgcn_readlane(__builtin_bit_cast(int, v), 0)), b = __builtin_bit_cast(float, __builtin_amdgcn_readlane(__builtin_bit_cast(int, v), 16));
    const float c = __builtin_bit_cast(float, __builtin_amdgcn_readlane(__builtin_bit_cast(int, v), 32)), d = __builtin_bit_cast(float, __builtin_amdgcn_readlane(__builtin_bit_cast(int, v), 48));
    return fmaxf(fmaxf(a, b), fmaxf(c, d));
}

#define XB_TMO      128
#define XB_XCNT(j)  (256  + 64 * (j))
#define XB_XSUB(j)  (1280 + 64 * (j))
#define XB_XGEN(j)  (2304 + 64 * (j))
#define XB_TOP      3328
#define XB_TOPGEN   3392
#define XCD_BAR_WORDS 3456
#define XB_SPIN_CAP (1u << 18)

__device__ __forceinline__ unsigned xb_ld(unsigned* p)              { return __hip_atomic_load(p, __ATOMIC_RELAXED, __HIP_MEMORY_SCOPE_AGENT); }
__device__ __forceinline__ unsigned xb_add(unsigned* p, unsigned v) { return __hip_atomic_fetch_add(p, v, __ATOMIC_RELAXED, __HIP_MEMORY_SCOPE_AGENT); }
__device__ __forceinline__ unsigned xb_xcc_id() { return (unsigned)__builtin_amdgcn_s_getreg((3 << 11) | 20) & 0xFu; }
#define XB_SPIN(cond, bar) do { unsigned _sp = 0; while (cond) { __builtin_amdgcn_s_sleep(1); \
    if ((++_sp & 255u) == 0u) { if (xb_ld(&(bar)[XB_TMO])) break; if (_sp > XB_SPIN_CAP) { atomicAdd(&(bar)[XB_TMO], 1u); break; } } } } while (0)

struct XcdBarrier {
    unsigned* bar; unsigned x;
    volatile LAS unsigned* st;
};

__device__ __forceinline__ XcdBarrier xcd_barrier_post(unsigned* bar, volatile LAS unsigned* st) {
    XcdBarrier b; b.bar = bar; b.x = xb_xcc_id(); b.st = st;
    if (threadIdx.x == 0) (void)xb_add(&bar[XB_XCNT(b.x)], 1u);
    return b;
}
__device__ __forceinline__ void xcd_barrier_complete(unsigned* bar, unsigned x, unsigned& nloc, unsigned& nx) {
    const unsigned G = gridDim.x * gridDim.y * gridDim.z;
    unsigned sum, cnt, mine, sp = 0u;
    for (;;) {
        sum = 0u; cnt = 0u; mine = 0u;
#pragma unroll
        for (unsigned j = 0; j < 16; ++j) { const unsigned c = xb_ld(&bar[XB_XCNT(j)]); sum += c; cnt += (c > 0u) ? 1u : 0u; }
        if (sum == G) { mine = xb_ld(&bar[XB_XCNT(x)]); break; }
        __builtin_amdgcn_s_sleep(1);
        if ((++sp & 255u) == 0u) { if (xb_ld(&bar[XB_TMO])) break; if (sp > XB_SPIN_CAP) { atomicAdd(&bar[XB_TMO], 1u); break; } }
    }
    nloc = mine > 0u ? mine : 1u; nx = cnt > 0u ? cnt : 1u;
}

__device__ __forceinline__ void xcd_barrier(const XcdBarrier& b) {
    asm volatile("s_waitcnt vmcnt(0)" ::: "memory");
    __syncthreads();
    if (threadIdx.x == 0) {
        unsigned* bar = b.bar;
        __builtin_amdgcn_s_waitcnt(0);
        unsigned nloc = b.st[0], nx = b.st[1];
        if (nloc == 0u) { xcd_barrier_complete(bar, b.x, nloc, nx); b.st[0] = nloc; b.st[1] = nx; }
        const unsigned old = xb_add(&bar[XB_XSUB(b.x)], 1u);
        const unsigned gen = old / nloc;
        if (old + 1u == (gen + 1u) * nloc) {
            __builtin_amdgcn_fence(__ATOMIC_RELEASE, "agent");
            asm volatile("s_waitcnt vmcnt(0)" ::: "memory");
            const unsigned og = xb_add(&bar[XB_TOP], 1u);
            const unsigned tg = og / nx;
            if (og + 1u == (tg + 1u) * nx) xb_add(&bar[XB_TOPGEN], 1u);
            else XB_SPIN(xb_ld(&bar[XB_TOPGEN]) == tg, bar);
            __builtin_amdgcn_fence(__ATOMIC_ACQUIRE, "agent");
            xb_add(&bar[XB_XGEN(b.x)], 1u);
            asm volatile("s_waitcnt vmcnt(0)" ::: "memory");
        } else {
            XB_SPIN(xb_ld(&bar[XB_XGEN(b.x)]) == gen, bar);
            __builtin_amdgcn_fence(__ATOMIC_ACQUIRE, "agent");
            asm volatile("s_waitcnt vmcnt(0)" ::: "memory");
        }
    }
    __syncthreads();
}
namespace pg8 {
#define PG8_LAS __attribute__((address_space(3)))
typedef unsigned short bf16_t;
typedef short bf16x8 __attribute__((ext_vector_type(8)));
typedef float f32x4 __attribute__((ext_vector_type(4)));
typedef unsigned u32x4 __attribute__((ext_vector_type(4)));
constexpr int BM = 256, BK = 64, HALF = 128, HTB = HALF * BK * 2  , STAGE_BYTES = 8 * HTB, NXCD = 8, WGM = 8;

__host__ __device__ __forceinline__ int lds_byte(int r, int c) { const int st = (r >> 4) * 2 + (c >> 5), rr = r & 15, cc = c & 31, ob = rr * 64 + cc * 2; return st * 1024 + (ob ^ (((ob >> 9) & 1) << 5)); }
__host__ __device__ __forceinline__ void stage_rc(int b, int& R, int& C) { const int st = b / 1024, sb = b % 1024, swz = sb ^ (((sb >> 9) & 1) << 5); R = (st >> 1) * 16 + swz / 64; C = (st & 1) * 32 + (swz % 64) / 2; }
__host__ __device__ __forceinline__ int perm32(int rho) { const int n = rho >> 4, i = rho & 15; return 8 * (i >> 2) + 4 * n + (i & 3); }

struct Unit { int pm, pn, kofs = 0, slab = 0; };
struct Gemm { const bf16_t* A; const bf16_t* Bt; int M, N, K, ld; };

struct StaticOrder {
    int nM, nN, nwg, G, c;
    __host__ __device__ void init(int M, int N, int G_, int c_) { nM = M / BM; nN = N / BM; nwg = nM * nN; G = G_; c = c_; }
    __host__ __device__ bool next(int i, Unit& u) const {
        const long L = (long)i * G + c; if (L >= nwg) return false;
        int wgid = (int)L; { const int q = nwg / NXCD, r = nwg % NXCD, xcd = wgid % NXCD, off = wgid / NXCD; wgid = (xcd < r ? xcd * (q + 1) : r * (q + 1) + (xcd - r) * q) + off; }
        const int nig = WGM * nN, gid = wgid / nig, fm = gid * WGM, gsz = (nM - fm) < WGM ? (nM - fm) : WGM;
        u.pm = fm + ((wgid % nig) % gsz); u.pn = (wgid % nig) / gsz; return true;
    }
    __device__ __forceinline__ void a_ready(const Unit&) const {}
    __device__ __forceinline__ void done(const Unit&) const {}
};
struct SplitKOrder {
    int nM, nN, nS, klen, G, c;
    __host__ __device__ void init(int M, int N, int nS_, int klen_, int G_, int c_) { nM = M / BM; nN = N / BM; nS = nS_; klen = klen_; G = G_; c = c_; }
    __host__ __device__ bool next(int i, Unit& u) const { const long L = (long)i * G + c; if (L >= (long)nM * nN * nS) return false; const int l = (int)L; u.pm = l % nM; u.pn = (l / nM) % nN; const int ks = l / (nM * nN); u.kofs = ks * klen; u.slab = ks; return true; }
    __device__ __forceinline__ void a_ready(const Unit&) const {}
    __device__ __forceinline__ void done(const Unit&) const {}
};
struct CountedOrder : StaticOrder {
    const unsigned* ready; unsigned need; unsigned* tmo;
    __device__ __forceinline__ void a_ready(const Unit& u) const {
        if (threadIdx.x < 64) {
            const unsigned long long t0 = __builtin_amdgcn_s_memrealtime(); unsigned polls = 0;
            while ((unsigned)__builtin_amdgcn_readfirstlane(__hip_atomic_load(ready + 64 * u.pm, __ATOMIC_RELAXED, __HIP_MEMORY_SCOPE_AGENT)) < need) {
                if ((++polls & 255u) == 0u && __builtin_amdgcn_readfirstlane(__hip_atomic_load(tmo, __ATOMIC_RELAXED, __HIP_MEMORY_SCOPE_AGENT)) != 0u) break;
                if (__builtin_amdgcn_s_memrealtime() - t0 > 2000000ull) {
                    if (threadIdx.x == 0) { unsigned expect = 0u; __hip_atomic_compare_exchange_strong(tmo + 1, &expect, 0x600u | (unsigned)(u.pm & 0xff), __ATOMIC_RELAXED, __ATOMIC_RELAXED, __HIP_MEMORY_SCOPE_AGENT); __hip_atomic_store(tmo, 1u, __ATOMIC_RELAXED, __HIP_MEMORY_SCOPE_AGENT); }
                    break; }
                __builtin_amdgcn_s_sleep(2); }
            __builtin_amdgcn_fence(__ATOMIC_ACQUIRE, "agent");
            asm volatile("s_waitcnt vmcnt(0)" ::: "memory");
        }
#if !defined(BROKEN_HOOK_NO_BARRIER)
        asm volatile("" ::: "memory"); __builtin_amdgcn_s_barrier(); asm volatile("" ::: "memory");
#endif
    }
};

__device__ __forceinline__ unsigned cvt_pk_bf16(float lo, float hi) { unsigned r; asm volatile("v_cvt_pk_bf16_f32 %0, %1, %2" : "=v"(r) : "v"(lo), "v"(hi)); return r; }
typedef float f32x2 __attribute__((ext_vector_type(2)));
__device__ __forceinline__ f32x2 gelu_pk(f32x2 v) {
    const f32x2 av = __builtin_elementwise_abs(v), d = av * 0.2316418882f + 1.0f;
    f32x2 t; t.x = __builtin_amdgcn_rcpf(d.x); t.y = __builtin_amdgcn_rcpf(d.y);
    f32x2 q = t * 0.5307027145f + (-0.7265760135f); q = q * t + 0.7107068705f; q = q * t + (-0.142248368f); q = q * t + 0.127414796f; q = q * t;
    const f32x2 s = (v * v) * (-0.72134752044f);
    f32x2 e; e.x = __builtin_amdgcn_exp2f(s.x); e.y = __builtin_amdgcn_exp2f(s.y);
    const f32x2 m = v * (q * e), r = v - m;
    f32x2 o; o.x = v.x < 0.f ? m.x : r.x; o.y = v.y < 0.f ? m.y : r.y; return o;
}

struct EpiF32 {
    static constexpr bool PERM = false, AFTER_DRAIN = false;
    float* C; int ldc; const float* bias; size_t slab_stride = 0;
    __device__ __forceinline__ void operator()(const f32x4 (&acc)[2][2][4][2], const Unit& u, int wr, int wc, int fr, int fq) const {
        const int row0 = u.pm * BM + wr * 64 + fr, col0 = u.pn * BM + wc * 32 + 4 * fq; float* const Cb = C + (size_t)u.slab * slab_stride;
        f32x4 bv[2][2];
#pragma unroll
        for (int bj = 0; bj < 2; ++bj)
#pragma unroll
            for (int n = 0; n < 2; ++n) bv[bj][n] = bias ? *(const f32x4*)(bias + col0 + bj * HALF + n * 16) : (f32x4){0.f, 0.f, 0.f, 0.f};
#pragma unroll
        for (int ai = 0; ai < 2; ++ai)
#pragma unroll
            for (int m = 0; m < 4; ++m) { float* rowp = Cb + (size_t)(row0 + ai * HALF + m * 16) * ldc + col0;
#pragma unroll
                for (int bj = 0; bj < 2; ++bj)
#pragma unroll
                    for (int n = 0; n < 2; ++n) *(f32x4*)(rowp + bj * HALF + n * 16) = acc[ai][bj][m][n] + bv[bj][n]; }
    }
};
template <int ACT  > struct EpiBf16 {
    static constexpr bool PERM = true, AFTER_DRAIN = false;
    bf16_t* O; int ldc; const float* bias; int split_cols; size_t split_stride;
    __device__ __forceinline__ void operator()(const f32x4 (&acc)[2][2][4][2], const Unit& u, int wr, int wc, int fr, int fq) const {
        const int row0 = u.pm * BM + wr * 64 + fr; int colt = u.pn * BM; bf16_t* base = O;
        if (split_cols) { const int t = colt / split_cols; base += (size_t)t * split_stride; colt -= t * split_cols; }
        const int col0 = colt + wc * 32 + 8 * fq, bcol0 = u.pn * BM + wc * 32 + 8 * fq;
        f32x4 bv[2][2];
#pragma unroll
        for (int bj = 0; bj < 2; ++bj)
#pragma unroll
            for (int n = 0; n < 2; ++n) bv[bj][n] = bias ? *(const f32x4*)(bias + bcol0 + bj * HALF + 4 * n) : (f32x4){0.f, 0.f, 0.f, 0.f};
#pragma unroll
        for (int ai = 0; ai < 2; ++ai)
#pragma unroll
            for (int m = 0; m < 4; ++m) { bf16_t* rowp = base + (size_t)(row0 + ai * HALF + m * 16) * ldc + col0;
#pragma unroll
                for (int bj = 0; bj < 2; ++bj) { f32x4 v0 = acc[ai][bj][m][0] + bv[bj][0], v1 = acc[ai][bj][m][1] + bv[bj][1];
                    if (ACT == 1) { f32x2 a = gelu_pk((f32x2){v0[0], v0[1]}), b = gelu_pk((f32x2){v0[2], v0[3]}), c = gelu_pk((f32x2){v1[0], v1[1]}), d = gelu_pk((f32x2){v1[2], v1[3]});
                        v0 = (f32x4){a.x, a.y, b.x, b.y}; v1 = (f32x4){c.x, c.y, d.x, d.y}; }
                    if (ACT == 2) {
#pragma unroll
                        for (int j = 0; j < 4; ++j) { v0[j] = 0.5f * v0[j] * (1.0f + erff(v0[j] * 0.70710678f)); v1[j] = 0.5f * v1[j] * (1.0f + erff(v1[j] * 0.70710678f)); } }
                    u32x4 w; w.x = cvt_pk_bf16(v0[0], v0[1]); w.y = cvt_pk_bf16(v0[2], v0[3]); w.z = cvt_pk_bf16(v1[0], v1[1]); w.w = cvt_pk_bf16(v1[2], v1[3]);
                    *(u32x4*)(rowp + bj * HALF) = w; } }
    }
};
template <class Epi, class Sched, bool STAMP = false>
__device__ __forceinline__ void gemm_phase(PG8_LAS unsigned char* lds, const Gemm g, const Sched& S, const Epi& E, unsigned long long* stamps, const int tid) {
    const int  wid = __builtin_amdgcn_readfirstlane(tid >> 6), lane = tid & 63, wr = wid >> 2, wc = wid & 3, fr = lane & 15, fq = lane >> 4;
    const int K = g.ld, nt = g.K / BK;
    int ts_lo = 0, ts_hi = 0, nts = 0; const unsigned long long rt_entry = STAMP ? (unsigned long long)wall_clock64() : 0ull;
#define PG8_STAMP() do { if (STAMP && wid == 0 && nts < 64) { const unsigned long long _c = (unsigned long long)clock64(); \
        ts_lo = (lane == nts) ? (int)(unsigned)_c : ts_lo; ts_hi = (lane == nts) ? (int)(unsigned)(_c >> 32) : ts_hi; ++nts; } } while (0)
    PG8_STAMP();
    unsigned voffA[2], voffB[2];
#pragma unroll
    for (int i = 0; i < 2; ++i) { int R, C; stage_rc(tid * 16 + i * 8192, R, C); const int Rb = Epi::PERM ? ((R & ~31) + perm32(R & 31)) : R;
        voffA[i] = (unsigned)(R * K + C) * 2u; voffB[i] = (unsigned)(Rb * K + C) * 2u; }
    const size_t kstep = (size_t)(BK * 2);
    const size_t hstep = (size_t)HALF * K * 2;
    const size_t tstep = 2 * hstep;
    const unsigned ldsw = (unsigned)wid * 1024u;
    const int aoff = lds_byte(wr * 64 + fr, fq * 8), boff = lds_byte(wc * 32 + fr, fq * 8);
#define PG8_SA(b, h) (((b) * 2 + (h)) * HTB)
#define PG8_SB(b, h) ((4 + (b) * 2 + (h)) * HTB)
#define PG8_STAGE(bufoff, gbase, voff) do { _Pragma("unroll") for (int _i = 0; _i < 2; ++_i) \
        __builtin_amdgcn_global_load_lds((const unsigned*)((const char*)(gbase) + (voff)[_i]), (PG8_LAS unsigned*)(lds + (bufoff) + ldsw + _i * 8192), 16, 0, 0); } while (0)
#define PG8_LDA(dst, b, h) do { _Pragma("unroll") for (int m = 0; m < 4; ++m) _Pragma("unroll") for (int k = 0; k < 2; ++k) dst[m][k] = *(const PG8_LAS bf16x8*)(lds + PG8_SA(b, h) + aoff + m * 2048 + k * 1024); } while (0)
#define PG8_LDB(dst, b, h) do { _Pragma("unroll") for (int n = 0; n < 2; ++n) _Pragma("unroll") for (int k = 0; k < 2; ++k) dst[n][k] = *(const PG8_LAS bf16x8*)(lds + PG8_SB(b, h) + boff + n * 2048 + k * 1024); } while (0)
#define PG8_MMA(ai, bj, At, Bt) do { __builtin_amdgcn_s_setprio(1); _Pragma("unroll") for (int m = 0; m < 4; ++m) _Pragma("unroll") for (int n = 0; n < 2; ++n) _Pragma("unroll") for (int k = 0; k < 2; ++k) \
        acc[ai][bj][m][n] = __builtin_amdgcn_mfma_f32_16x16x32_bf16(Bt[n][k], At[m][k], acc[ai][bj][m][n], 0, 0, 0); __builtin_amdgcn_s_setprio(0); } while (0)
#define PG8_WAIT_V(n) asm volatile("s_waitcnt vmcnt(" #n ")" ::: "memory")
#define PG8_WAIT_L(n) asm volatile("s_waitcnt lgkmcnt(" #n ")" ::: "memory")
#define PG8_BAR __builtin_amdgcn_s_barrier()
#define PG8_SCHED __builtin_amdgcn_sched_barrier(0)
    Unit cur, nxt; int ui = 0;
    if (!S.next(0, cur)) return;
    f32x4 acc[2][2][4][2];
#pragma unroll
    for (int a = 0; a < 2; ++a)
#pragma unroll
        for (int b = 0; b < 2; ++b)
#pragma unroll
            for (int m = 0; m < 4; ++m)
#pragma unroll
                for (int n = 0; n < 2; ++n) acc[a][b][m][n] = (f32x4){0.f, 0.f, 0.f, 0.f};
    bf16x8 At[4][2], B0[2][2], B1[2][2];
    const char* cA = (const char*)g.A + (size_t)cur.pm * tstep + (size_t)cur.kofs * 2; const char* cB = (const char*)g.Bt + (size_t)cur.pn * tstep + (size_t)cur.kofs * 2;
    S.a_ready(cur);
    PG8_STAGE(PG8_SB(0, 0), cB, voffB); PG8_STAGE(PG8_SA(0, 0), cA, voffA); PG8_STAGE(PG8_SB(0, 1), cB + hstep, voffB); PG8_STAGE(PG8_SA(0, 1), cA + hstep, voffA);
    if (wr == 1) PG8_BAR;
    PG8_WAIT_V(4); PG8_BAR;
    PG8_STAGE(PG8_SB(1, 0), cB + kstep, voffB); PG8_STAGE(PG8_SA(1, 0), cA + kstep, voffA); PG8_STAGE(PG8_SB(1, 1), cB + hstep + kstep, voffB);
    PG8_WAIT_V(6); PG8_BAR;
    PG8_STAMP();
    for (;;) {
        const bool has_next = S.next(ui + 1, nxt);
        const char* nA = has_next ? (const char*)g.A + (size_t)nxt.pm * tstep + (size_t)nxt.kofs * 2 : cA; const char* nB = has_next ? (const char*)g.Bt + (size_t)nxt.pn * tstep + (size_t)nxt.kofs * 2 : cB;
        for (int t = 0; t < nt; t += 2) {
            const bool last = (t == nt - 2);
            const char* a1 = cA + (size_t)(t + 1) * kstep;
            const char* a2 = last ? nA : cA + (size_t)(t + 2) * kstep; const char* b2 = last ? nB : cB + (size_t)(t + 2) * kstep;
            const char* a3 = a2 + kstep; const char* b3 = b2 + kstep;
            if (last && has_next) S.a_ready(nxt);
            PG8_LDB(B0, 0, 0); PG8_SCHED; PG8_LDA(At, 0, 0); PG8_STAGE(PG8_SA(1, 1), a1 + hstep, voffA);
            PG8_WAIT_L(8); PG8_BAR; PG8_WAIT_L(0); PG8_MMA(0, 0, At, B0); PG8_BAR; PG8_SCHED;
            PG8_LDB(B1, 0, 1); PG8_STAGE(PG8_SB(0, 0), b2, voffB);
            PG8_BAR; PG8_WAIT_L(0); PG8_MMA(0, 1, At, B1); PG8_BAR;
            PG8_LDA(At, 0, 1); PG8_STAGE(PG8_SA(0, 0), a2, voffA);
            PG8_BAR; PG8_WAIT_L(0); PG8_MMA(1, 0, At, B0); PG8_BAR; PG8_SCHED;
            PG8_STAGE(PG8_SB(0, 1), b2 + hstep, voffB);
            PG8_WAIT_V(6); PG8_BAR; PG8_MMA(1, 1, At, B1); PG8_BAR;
            PG8_LDB(B0, 1, 0); PG8_SCHED; PG8_LDA(At, 1, 0); PG8_STAGE(PG8_SA(0, 1), a2 + hstep, voffA);
            PG8_WAIT_L(8); PG8_BAR; PG8_WAIT_L(0); PG8_MMA(0, 0, At, B0); PG8_BAR; PG8_SCHED;
            PG8_LDB(B1, 1, 1); PG8_STAGE(PG8_SB(1, 0), b3, voffB);
            PG8_BAR; PG8_WAIT_L(0); PG8_MMA(0, 1, At, B1); PG8_BAR;
            PG8_LDA(At, 1, 1); PG8_STAGE(PG8_SA(1, 0), a3, voffA);
            PG8_BAR; PG8_WAIT_L(0); PG8_MMA(1, 0, At, B0); PG8_BAR; PG8_SCHED;
            PG8_STAGE(PG8_SB(1, 1), b3 + hstep, voffB);
            PG8_WAIT_V(6); PG8_BAR; PG8_MMA(1, 1, At, B1); PG8_BAR;
        }
        PG8_STAMP();
        if constexpr (!Epi::AFTER_DRAIN) { E(acc, cur, wr, wc, fr, fq); S.done(cur); }
        PG8_STAMP();
        if (!has_next) break;
#pragma unroll
        for (int a = 0; a < 2; ++a)
#pragma unroll
            for (int b = 0; b < 2; ++b)
#pragma unroll
                for (int m = 0; m < 4; ++m)
#pragma unroll
                    for (int n = 0; n < 2; ++n) acc[a][b][m][n] = (f32x4){0.f, 0.f, 0.f, 0.f};
        cur = nxt; cA = nA; cB = nB; ++ui;
    }
    PG8_WAIT_V(0);
    if (wr == 0) PG8_BAR;
    PG8_BAR;
    if constexpr (Epi::AFTER_DRAIN) { E.fused(acc, cur, wr, wc, fr, fq, lds, wid, lane); S.done(cur); }
    PG8_STAMP();
    if (STAMP && wid == 0) { stamps[lane] = lane < nts ? (((unsigned long long)(unsigned)ts_hi << 32) | (unsigned)ts_lo) : 0ull;
        if (lane == 62) stamps[62] = rt_entry; if (lane == 63) stamps[63] = (unsigned long long)wall_clock64(); }
#undef PG8_STAMP
#undef PG8_SA
#undef PG8_SB
#undef PG8_STAGE
#undef PG8_LDA
#undef PG8_LDB
#undef PG8_MMA
#undef PG8_WAIT_V
#undef PG8_WAIT_L
#undef PG8_BAR
#undef PG8_SCHED
}
}
struct Args { const float* in[N_IN]; float* out; unsigned char* ws; int ph_lo, ph_hi; };
struct Frame {
    LAS unsigned char* lds;
    int tid, lane, wave, vcu, G;
    const float* const* in; GAS float* out; GAS unsigned char* ws;
};
using bf16x2v = __attribute__((ext_vector_type(2))) __bf16;
__device__ __forceinline__ float dot2bf(unsigned a, unsigned b, float acc) { return __builtin_amdgcn_fdot2_f32_bf16(__builtin_bit_cast(bf16x2v, a), __builtin_bit_cast(bf16x2v, b), acc, false); }

__device__ __forceinline__ void ld8bf(const bf16* p, float (&o)[8]) { const v4u w = *(const v4u*)p; o[0] = bf_lo(w.x); o[1] = bf_hi(w.x); o[2] = bf_lo(w.y); o[3] = bf_hi(w.y); o[4] = bf_lo(w.z); o[5] = bf_hi(w.z); o[6] = bf_lo(w.w); o[7] = bf_hi(w.w); }
struct TileInfo { int seq_base, seq_len, t0; };
__device__ __forceinline__ TileInfo tile_info(int c) {
    TileInfo ti;
    if (c < 128) { ti.seq_base = (c >> 6) * SEQ; ti.seq_len = SEQ; ti.t0 = (c & 63) * 64; }
    else { const int cc = c - 128; ti.seq_base = NLAT + (cc >> 2) * CTXL; ti.seq_len = CTXL; ti.t0 = (cc & 3) * 64; }
    return ti;
}
__device__ __forceinline__ int mod_row(int row) { return row < NLAT ? (row >> 12) : 2; }
__device__ __forceinline__ bf16x8 frag_lds(const LAS bf16* base, int ld, int row0, int k0, int lane) { return *(const LAS bf16x8*)(base + (row0 + (lane & 15)) * ld + k0 + 8 * (lane >> 4)); }
__device__ __forceinline__ bf16x8 frag_g(const bf16* base, int ld, int row0, int k0, int lane) { return *(const bf16x8*)(base + (size_t)(row0 + (lane & 15)) * ld + k0 + 8 * (lane >> 4)); }
#define MFMA16(a, b, c) __builtin_amdgcn_mfma_f32_16x16x32_bf16((a), (b), (c), 0, 0, 0)

__device__ __forceinline__ void p0_transpose_item(const float* W, int K, int N, bf16* WT, LAS float* scr, int item, int lane) {
    const int nblk = N / 32, kb = item / nblk, nb = item % nblk, k0 = 64 * kb, n0 = 32 * nb;
#pragma unroll 8
    for (int i = 0; i < 32; ++i) { const int kk = 2 * i + (lane >> 5); scr[kk * 33 + (lane & 31)] = W[(size_t)(k0 + kk) * N + n0 + (lane & 31)]; }
    LDS_WAIT(); asm volatile("" ::: "memory");
    const int c = lane & 7;
#pragma unroll
    for (int j = 0; j < 4; ++j) { const int n = (lane >> 3) + 8 * j; const LAS float* s = scr + (8 * c) * 33 + n;
        v4u o; o.x = pk2(s[0 * 33], s[1 * 33]); o.y = pk2(s[2 * 33], s[3 * 33]); o.z = pk2(s[4 * 33], s[5 * 33]); o.w = pk2(s[6 * 33], s[7 * 33]);
        *(v4u*)(WT + (size_t)(n0 + n) * K + k0 + 8 * c) = o; }
    LDS_WAIT(); asm volatile("" ::: "memory");
}
__device__ __forceinline__ void conv_f32_bf16(const float* src, bf16* dst, size_t n8, size_t i0, size_t stride) {
    for (size_t i = i0; i < n8; i += stride) { const f32x4 a = *(const f32x4*)(src + i * 8), b = *(const f32x4*)(src + i * 8 + 4);
        v4u o; o.x = pk2(a.x, a.y); o.y = pk2(a.z, a.w); o.z = pk2(b.x, b.y); o.w = pk2(b.z, b.w); *(v4u*)(dst + i * 8) = o; }
}
__device__ __forceinline__ void convert_layer(Frame& F, int l, int w, int NW, LAS float* scr) {
    constexpr int IT_IN = (D / 64) * (IN_COLS / 32), IT_SQ = (D / 64) * (D / 32);
    for (int it = w; it < IT_IN + 2 * IT_SQ; it += NW) {
        int r = it;
        if (r < IT_IN) { p0_transpose_item(gin(F.in[I_WIN]) + (size_t)l * D * IN_COLS, D, IN_COLS, (bf16*)(F.ws + WS_WIN) + (size_t)l * IN_PAD * D, scr, r, F.lane); continue; }
        r -= IT_IN;
        if (r < IT_SQ) { p0_transpose_item(gin(F.in[I_WOUT]) + (size_t)l * D * D, D, D, (bf16*)(F.ws + WS_WOUT) + (size_t)l * D * D, scr, r, F.lane); continue; }
        r -= IT_SQ;
        p0_transpose_item(gin(F.in[I_WQ]) + (size_t)l * D * D, D, D, (bf16*)(F.ws + WS_WQ) + (size_t)l * D * D, scr, r, F.lane);
    }
    { constexpr int PADV = (IN_PAD - IN_COLS) * D / 8;
      for (int i = w * 64 + F.lane; i < PADV; i += NW * 64) *(v4u*)((bf16*)(F.ws + WS_WIN) + ((size_t)l * IN_PAD + IN_COLS) * D + (size_t)i * 8) = (v4u){0u, 0u, 0u, 0u}; }
    for (int it = w; it < 2 * PE_NE; it += NW) {
        const int tab = it >= PE_NE, r = l * PE_NE + (tab ? it - PE_NE : it); const float* src = gin(F.in[tab ? I_V : I_U]) + (size_t)r * D + F.lane * 4;
        f32x4 x[8]; float mx = 0.f;
#pragma unroll
        for (int i = 0; i < 8; ++i) { x[i] = *(const f32x4*)(src + i * 256); mx = fmaxf(mx, fmaxf(fmaxf(fabsf(x[i].x), fabsf(x[i].y)), fmaxf(fabsf(x[i].z), fabsf(x[i].w)))); }
        mx = wave_max(mx); const float sc = mx > 0.f ? mx * (1.0f / 448.0f) : 1.0f, inv = 1.0f / sc;
        unsigned* dst = (unsigned*)(F.ws + (tab ? WS_VB : WS_UB) + (size_t)r * D) + F.lane;
#pragma unroll
        for (int i = 0; i < 8; ++i) { int q = __builtin_amdgcn_cvt_pk_fp8_f32(x[i].x * inv, x[i].y * inv, 0, false); q = __builtin_amdgcn_cvt_pk_fp8_f32(x[i].z * inv, x[i].w * inv, q, true); dst[i * 64] = (unsigned)q; }
        if (F.lane == 0) ((float*)(F.ws + (tab ? WS_SV : WS_SU)))[r] = sc;
    }
}
__device__ __forceinline__ void p0_prologue(Frame& F) {
    LAS float* scr = (LAS float*)(F.lds + F.wave * 16384);
    const int gw = F.vcu * NWAVES + F.wave, NGW = F.G * NWAVES;
    const size_t gt = (size_t)F.vcu * NTHR + F.tid, NGT = (size_t)F.G * NTHR;
    for (int l = 0; l < DEPTH; ++l) convert_layer(F, l, gw, NGW, scr);
    { bf16* dst = (bf16*)(F.ws + WS_WLRU);
      for (size_t idx = gt; idx < (size_t)DEPTH * 2 * 2 * 16 * 64 * 64; idx += NGT) { const int i = (int)(idx & 63), j = (int)((idx >> 6) & 63), m = (int)(idx >> 12);
          const int hh = m & 15, d = (m >> 4) & 1, gate = (m >> 5) & 1, l = m >> 6; const float* src = gin(F.in[gate ? I_WX : I_WA]);
          dst[idx] = (bf16)f2bf(src[((size_t)((l * 2 + d) * 16 + hh) * 64 + i) * 64 + j]); } }
    { bf16* d2 = (bf16*)(F.ws + WS_W2T); bf16* da = (bf16*)(F.ws + WS_A2T);
      for (size_t idx = gt; idx < (size_t)DEPTH * 2 * 1024 * 64; idx += NGT) { const int k = (int)(idx & 63), c = (int)((idx >> 6) & 1023), ld = (int)(idx >> 16);
          d2[idx] = (bf16)f2bf(gin(F.in[I_W2])[((size_t)ld * 64 + k) * 1024 + c]); da[idx] = (bf16)f2bf(gin(F.in[I_A2])[((size_t)ld * 64 + k) * 1024 + c]); } }
    { bf16* dg = (bf16*)(F.ws + WS_G2T);
      for (size_t idx = gt; idx < (size_t)DEPTH * 1024 * 160; idx += NGT) { const int k = (int)(idx % 160), c = (int)((idx / 160) % 1024), l = (int)(idx / (160 * 1024));
          dg[idx] = (bf16)f2bf(gin(F.in[I_G2])[((size_t)l * 160 + k) * 1024 + c]); } }
    conv_f32_bf16(gin(F.in[I_SUBK]), (bf16*)(F.ws + WS_SUBK), (size_t)DEPTH * 8 * 2 * 128 * 128 / 8, gt, NGT);
    { float* X = (float*)(F.ws + WS_X);
      for (size_t i0 = gt; i0 < (size_t)MTOT * D / 4; i0 += 4 * NGT) { f32x4 v[4];
#pragma unroll
          for (int u = 0; u < 4; ++u) { const size_t i = i0 + (size_t)u * NGT; const int row = (int)(i / (D / 4)), e0 = (int)(i % (D / 4)) * 4;
              v[u] = i < (size_t)MTOT * D / 4 ? (row < NLAT ? *(const f32x4*)(gin(F.in[I_X]) + (size_t)row * D + e0) : *(const f32x4*)(gin(F.in[I_CTX]) + (size_t)(row - NLAT) * D + e0)) : (f32x4){0.f, 0.f, 0.f, 0.f}; }
#pragma unroll
          for (int u = 0; u < 4; ++u) { const size_t i = i0 + (size_t)u * NGT; if (i >= (size_t)MTOT * D / 4) continue; const int row = (int)(i / (D / 4)), e0 = (int)(i % (D / 4)) * 4;
              if (row < NLAT) { const int t = row & (SEQ - 1); const float pr = (float)(t >> 6), pc = (float)(t & 63); float o[4];
#pragma unroll
                  for (int j = 0; j < 4; ++j) { const int e = e0 + j, q = e >> 9, fi = e & 511; const float freq = __builtin_amdgcn_exp2f(-13.287712379549449f * (float)fi * (1.0f / 512.0f));
                      const float ang = ((q >> 1) ? pc : pr) * freq; float rev = ang * 0.15915494309189535f; rev -= floorf(rev);
                      o[j] = (q & 1) ? __builtin_amdgcn_cosf(rev) : __builtin_amdgcn_sinf(rev); }
                  v[u].x += o[0]; v[u].y += o[1]; v[u].z += o[2]; v[u].w += o[3]; }
              *(f32x4*)(X + (size_t)row * D + e0) = v[u]; } } }
    { float* MODP = (float*)(F.ws + WS_MODP); const float* cin = gin(F.in[I_C]); const float* cctx = gin(F.in[I_CCTX]);
      for (int it = gw; it < DEPTH * KSPLIT * 48; it += NGW) { const int cg = it % 48, kp = (it / 48) % KSPLIT, l = it / (48 * KSPLIT); const int col = cg * 256 + F.lane * 4, k0 = kp * (D / KSPLIT);
          f32x4 a0 = {0.f, 0.f, 0.f, 0.f}, a1 = a0, a2 = a0; const float* wp = gin(F.in[I_ADAW]) + ((size_t)l * D + k0) * (6 * D) + col;
#pragma unroll 8
          for (int k = 0; k < D / KSPLIT; ++k) { const f32x4 w = *(const f32x4*)(wp + (size_t)k * (6 * D)); const float c0 = cin[k0 + k], c1 = cin[D + k0 + k], c2 = cctx[k0 + k];
              const float s0 = c0 * fsigmoid(c0), s1 = c1 * fsigmoid(c1), s2 = c2 * fsigmoid(c2); a0 += w * s0; a1 += w * s1; a2 += w * s2; }
          float* o = MODP + ((size_t)(kp * DEPTH + l) * 3) * (6 * D) + col; *(f32x4*)o = a0; *(f32x4*)(o + 6 * D) = a1; *(f32x4*)(o + 12 * D) = a2; } }
}
__device__ __forceinline__ void p0b_mod_reduce(Frame& F) {
    const size_t gt = (size_t)F.vcu * NTHR + F.tid, NGT = (size_t)F.G * NTHR; const float* MODP = (const float*)(F.ws + WS_MODP); float* MOD = (float*)(F.ws + WS_MOD);
    for (size_t i = gt; i < (size_t)DEPTH * 3 * 6 * D; i += NGT) { const int n = (int)(i % (6 * D)), l = (int)(i / (3 * 6 * D)); float s = gin(F.in[I_ADAB])[(size_t)l * 6 * D + n];
#pragma unroll
        for (int kp = 0; kp < KSPLIT; ++kp) s += MODP[(size_t)kp * DEPTH * 3 * 6 * D + i];
        MOD[i] = s; }
}
__device__ __forceinline__ void modulate_rows(Frame& F, int l, int which, int nrows) {
    const int gw = F.vcu * NWAVES + F.wave, NGW = F.G * NWAVES; const float* X = (const float*)(F.ws + WS_X); bf16* H = (bf16*)(F.ws + WS_H);
    for (int row = gw; row < nrows; row += NGW) { const float* md = (const float*)(F.ws + WS_MOD) + ((size_t)l * 3 + mod_row(row)) * (6 * D) + which * 3 * D;
#pragma unroll
        for (int j = 0; j < 4; ++j) { const int e = j * 512 + F.lane * 8; const f32x4 x0 = *(const f32x4*)(X + (size_t)row * D + e), x1 = *(const f32x4*)(X + (size_t)row * D + e + 4);
            const f32x4 s0 = *(const f32x4*)(md + e), s1 = *(const f32x4*)(md + e + 4), c0 = *(const f32x4*)(md + D + e), c1 = *(const f32x4*)(md + D + e + 4);
            const f32x4 y0 = x0 * (c0 + 1.0f) + s0, y1 = x1 * (c1 + 1.0f) + s1;
            v4u o; o.x = pk2(y0.x, y0.y); o.y = pk2(y0.z, y0.w); o.z = pk2(y1.x, y1.y); o.w = pk2(y1.z, y1.w); *(v4u*)(H + (size_t)row * D + e) = o; } }
}

__device__ __forceinline__ void lru_prep_unit(Frame& F, int l, int c, int hh) {
    int tid = F.tid; asm volatile("" : "+v"(tid));
    const int lane = tid & 63, wave = F.wave;
    const TileInfo ti = tile_info(c); const bf16* P = (const bf16*)(F.ws + WS_P);
    LAS float* Us = (LAS float*)F.lds; LAS float* XC = (LAS float*)(F.lds + 17408); LAS bf16* XCb = (LAS bf16*)(F.lds + 34304);
    LAS float* LAs = (LAS float*)(F.lds + 43520); LAS float* LBs = (LAS float*)(F.lds + 76288); LAS float* SEGA = (LAS float*)(F.lds + 109056); LAS float* SEGH = SEGA + 512;
    for (int idx = tid; idx < 67 * 8; idx += NTHR) { const int r = idx >> 3, c8 = (idx & 7) * 8, t = ti.t0 - 2 + r; float x[8];
        if (t >= 0 && t < ti.seq_len) ld8bf(P + (size_t)(ti.seq_base + t) * IN_PAD + hh * 64 + c8, x);
        else {
#pragma unroll
            for (int e = 0; e < 8; ++e) x[e] = 0.f; }
        *(LAS f32x4*)(Us + r * 64 + c8) = (f32x4){x[0], x[1], x[2], x[3]}; *(LAS f32x4*)(Us + r * 64 + c8 + 4) = (f32x4){x[4], x[5], x[6], x[7]}; }
    __syncthreads();
    { const int ch = tid & 63, cg = hh * 64 + ch; const float* cw = gin(F.in[I_CONVW]) + (size_t)l * 4 * LRW + cg;
      const float w0 = cw[0], w1 = cw[LRW], w2 = cw[2 * LRW], w3 = cw[3 * LRW], cb = gin(F.in[I_CONVB])[(size_t)l * LRW + cg];
#pragma unroll
      for (int k = 0; k < 8; ++k) { const int t = (tid >> 6) + 8 * k;
          const float v = cb + w0 * Us[t * 64 + ch] + w1 * Us[(t + 1) * 64 + ch] + w2 * Us[(t + 2) * 64 + ch] + w3 * Us[(t + 3) * 64 + ch];
          XC[t * 65 + ch] = v; XCb[t * 72 + ch] = (bf16)f2bf(v); } }
    __syncthreads();
    { const int d = wave >> 2, m = wave & 3;
      const bf16x8 a0 = frag_lds(XCb, 72, 16 * m, 0, lane), a1 = frag_lds(XCb, 72, 16 * m, 32, lane);
      const bf16* Wa = (const bf16*)(F.ws + WS_WLRU) + (size_t)(((l * 2 + 0) * 2 + d) * 16 + hh) * 4096;
      const bf16* Wx = (const bf16*)(F.ws + WS_WLRU) + (size_t)(((l * 2 + 1) * 2 + d) * 16 + hh) * 4096;
#pragma unroll
      for (int n = 0; n < 4; ++n) {
          f32x4 ar = {0.f, 0.f, 0.f, 0.f}, ai = ar;
          ar = MFMA16(a0, frag_g(Wa, 64, 16 * n, 0, lane), ar); ar = MFMA16(a1, frag_g(Wa, 64, 16 * n, 32, lane), ar);
          ai = MFMA16(a0, frag_g(Wx, 64, 16 * n, 0, lane), ai); ai = MFMA16(a1, frag_g(Wx, 64, 16 * n, 32, lane), ai);
          const int col = 16 * n + (lane & 15), cg = hh * 64 + col;
          const float ba = gin(F.in[I_BA])[(size_t)(l * 2 + d) * LRW + cg], bx = gin(F.in[I_BX])[(size_t)(l * 2 + d) * LRW + cg];
          const float sp = fsoftplus(-gin(F.in[I_LAM])[(size_t)(l * 2 + d) * LRW + cg]);
#pragma unroll
          for (int r = 0; r < 4; ++r) { const int row = 16 * m + 4 * (lane >> 4) + r;
              const float rr = fsigmoid(ar[r] + ba), ii = fsigmoid(ai[r] + bx), loga = -8.0f * rr * sp, a = fexp(loga);
              const float bb = __builtin_amdgcn_sqrtf(fmaxf(1.0f - a * a, 0.f)) * ii * XC[row * 65 + col];
              LAs[(d * 64 + row) * 64 + col] = a; LBs[(d * 64 + row) * 64 + col] = bb; } } }
    __syncthreads();
    { const int col = tid & 63, seg = (tid >> 6) & 3, d = tid >> 8, cg = hh * 64 + col; float hl[16], al[16]; float h = 0.f, A = 1.f;
#pragma unroll
      for (int i = 0; i < 16; ++i) { const int tau = 16 * seg + i, row = d ? 63 - tau : tau; const float a = LAs[(d * 64 + row) * 64 + col], b = LBs[(d * 64 + row) * 64 + col]; h = a * h + b; A *= a; hl[i] = h; al[i] = A; }
      SEGA[(d * 4 + seg) * 64 + col] = A; SEGH[(d * 4 + seg) * 64 + col] = h;
      __syncthreads();
      float Hin = 0.f, Ain = 1.f;
#pragma unroll
      for (int s2 = 0; s2 < 3; ++s2) if (s2 < seg) { const float sa = SEGA[(d * 4 + s2) * 64 + col]; Hin = sa * Hin + SEGH[(d * 4 + s2) * 64 + col]; Ain *= sa; }
      bf16* HL = (bf16*)(F.ws + WS_LB) + (size_t)d * MTOT * LRW; bf16* AC = (bf16*)(F.ws + WS_LA) + (size_t)d * MTOT * LRW;
#pragma unroll
      for (int i = 0; i < 16; ++i) { const int tau = 16 * seg + i, row = d ? 63 - tau : tau; const size_t o = (size_t)(ti.seq_base + ti.t0 + row) * LRW + cg; HL[o] = (bf16)f2bf(hl[i] + al[i] * Hin); AC[o] = (bf16)f2bf(al[i] * Ain); }
      if (seg == 3) { float* AG = (float*)(F.ws + WS_LAGG); AG[((size_t)(0 * 2 + d) * NTILE + c) * LRW + cg] = al[15] * Ain; AG[((size_t)(1 * 2 + d) * NTILE + c) * LRW + cg] = hl[15] + al[15] * Hin; } }
    __syncthreads();
}
__device__ __forceinline__ void shifted8(const bf16* P, size_t grow, bool hp, bool hn, const float* mu0, const float* mu1, int rc, float (&o)[8]) {
    const bf16* p = P + grow * IN_PAD + 2 * LRW + rc;
    float xs[8], ms[8], ns[8]; ld8bf(p, xs);
#pragma unroll
    for (int e = 0; e < 8; ++e) { ms[e] = 0.f; ns[e] = 0.f; }
    if (hp) ld8bf(p - IN_PAD, ms);
    if (hn) ld8bf(p + IN_PAD, ns);
    const f32x4 a0 = *(const f32x4*)(mu0 + rc), a1 = *(const f32x4*)(mu0 + rc + 4), b0 = *(const f32x4*)(mu1 + rc), b1 = *(const f32x4*)(mu1 + rc + 4);
    const float m0[8] = {a0.x, a0.y, a0.z, a0.w, a1.x, a1.y, a1.z, a1.w}, m1[8] = {b0.x, b0.y, b0.z, b0.w, b1.x, b1.y, b1.z, b1.w};
#pragma unroll
    for (int e = 0; e < 8; ++e) o[e] = xs[e] + m0[e] * (ms[e] - xs[e]) + m1[e] * (ns[e] - xs[e]);
}
constexpr int MB = 9216;
constexpr int MLD = 72;
#define MSLOT(k) ((LAS bf16*)(F.lds + (k) * MB))
__device__ __forceinline__ int prow(int c) { return (c & ~7) | ((c + (c >> 3)) & 7); }
__device__ __forceinline__ bf16x8 frag_lds_p(const LAS bf16* base, int ld, int row0, int k0, int lane) { return *(const LAS bf16x8*)(base + prow(row0 + (lane & 15)) * ld + k0 + 8 * (lane >> 4)); }
template <bool PY, bool PX> __device__ __forceinline__ f32x4 mm_tile_p(const LAS bf16* Y, int rt, const LAS bf16* X, int ct, f32x4 acc, int lane) {
    acc = MFMA16(PY ? frag_lds_p(Y, MLD, 16 * rt, 0, lane) : frag_lds(Y, MLD, 16 * rt, 0, lane), PX ? frag_lds_p(X, MLD, 16 * ct, 0, lane) : frag_lds(X, MLD, 16 * ct, 0, lane), acc);
    acc = MFMA16(PY ? frag_lds_p(Y, MLD, 16 * rt, 32, lane) : frag_lds(Y, MLD, 16 * rt, 32, lane), PX ? frag_lds_p(X, MLD, 16 * ct, 32, lane) : frag_lds(X, MLD, 16 * ct, 32, lane), acc);
    return acc;
}
__device__ __forceinline__ f32x4 mm_tile(const LAS bf16* Y, int rt, const LAS bf16* X, int ct, f32x4 acc, int lane) {
    acc = MFMA16(frag_lds(Y, MLD, 16 * rt, 0, lane), frag_lds(X, MLD, 16 * ct, 0, lane), acc);
    acc = MFMA16(frag_lds(Y, MLD, 16 * rt, 32, lane), frag_lds(X, MLD, 16 * ct, 32, lane), acc);
    return acc;
}
__device__ __forceinline__ void st_tile(LAS bf16* Dst, int rt, int ct, f32x4 acc, int lane) {
    v2u o; o.x = pk2(acc[0], acc[1]); o.y = pk2(acc[2], acc[3]);
    *(LAS v2u*)(Dst + (16 * ct + (lane & 15)) * MLD + 16 * rt + 4 * (lane >> 4)) = o;
}
__device__ __forceinline__ f32x4 ld_tile(const LAS bf16* Src, int rt, int ct, int lane) {
    const v2u o = *(const LAS v2u*)(Src + (16 * ct + (lane & 15)) * MLD + 16 * rt + 4 * (lane >> 4));
    return (f32x4){bf_lo(o.x), bf_hi(o.x), bf_lo(o.y), bf_hi(o.y)};
}
template <int MASK> __device__ __forceinline__ void mm64(LAS bf16* Dst, const LAS bf16* X, const LAS bf16* Y, int wave, int lane) {
    const int rt = wave >> 1;
#pragma unroll
    for (int q = 0; q < 2; ++q) { const int ct = 2 * (wave & 1) + q; f32x4 acc = {0.f, 0.f, 0.f, 0.f};
        acc = mm_tile(Y, rt, X, ct, acc, lane);
        if (MASK) { const int c = 16 * ct + (lane & 15);
#pragma unroll
            for (int g = 0; g < 4; ++g) { const int r = 16 * rt + 4 * (lane >> 4) + g; const bool keep = MASK == 1 ? (c > r) : MASK == 2 ? (r > c) : (c >= r); if (!keep) acc[g] = 0.f; } }
        st_tile(Dst, rt, ct, acc, lane); }
}
#ifndef CPROBE
#define CPROBE 0
#endif
struct RawS1 { v4u x[5][3]; };
template <int G0, int G1> __device__ __forceinline__ void load_raw(Frame& F, int c, int hh, int d, int tid, RawS1& raw) {
    const TileInfo ti = tile_info(c); const int t = tid >> 3, c8 = (tid & 7) * 8, tt = ti.t0 + t; const bool hp = tt > 0, hn = tt + 1 < ti.seq_len;
    const bf16* p0 = (const bf16*)(F.ws + WS_P) + (size_t)(ti.seq_base + tt) * IN_PAD + 2 * LRW + c8;
#pragma unroll
    for (int g = G0; g < G1; ++g) { const int rc = g < 3 ? g * RWW + hh * 64 : 3 * RWW + (g - 3) * 128 + d * 64; const bf16* p = p0 + rc;
        raw.x[g][0] = *(const v4u*)p; raw.x[g][1] = *(const v4u*)(p - (hp ? IN_PAD : 0)); raw.x[g][2] = *(const v4u*)(p + (hn ? IN_PAD : 0)); }
}
__device__ __forceinline__ void shift_raw(const v4u (&x)[3], const LAS float* mus, bool hp, bool hn, float (&o)[8]) {
    const f32x4 a0 = *(const LAS f32x4*)mus, a1 = *(const LAS f32x4*)(mus + 4), b0 = *(const LAS f32x4*)(mus + 64), b1 = *(const LAS f32x4*)(mus + 68);
    const float m0[8] = {a0.x, a0.y, a0.z, a0.w, a1.x, a1.y, a1.z, a1.w}, m1[8] = {b0.x, b0.y, b0.z, b0.w, b1.x, b1.y, b1.z, b1.w};
    const unsigned xw[4] = {x[0].x, x[0].y, x[0].z, x[0].w}, pw[4] = {x[1].x, x[1].y, x[1].z, x[1].w}, nw[4] = {x[2].x, x[2].y, x[2].z, x[2].w};
#pragma unroll
    for (int e = 0; e < 8; ++e) { const float xs = (e & 1) ? bf_hi(xw[e >> 1]) : bf_lo(xw[e >> 1]), ms = hp ? ((e & 1) ? bf_hi(pw[e >> 1]) : bf_lo(pw[e >> 1])) : 0.f, ns = hn ? ((e & 1) ? bf_hi(nw[e >> 1]) : bf_lo(nw[e >> 1])) : 0.f;
        o[e] = xs + m0[e] * (ms - xs) + m1[e] * (ns - xs); }
}
__device__ __forceinline__ void rwkv_chunk_prep(Frame& F, int l, int c, int hh, int d) {
    RawS1 raw;
    int tid = F.tid; asm volatile("" : "+v"(tid));
    const TileInfo ti = tile_info(c); const int lane = tid & 63, wave = F.wave;
    LAS bf16* TW = MSLOT(0); LAS bf16* AD = MSLOT(1);
    LAS float* CUM = (LAS float*)(F.lds + 8 * MB); LAS float* AVs = (LAS float*)(F.lds + 8 * MB + 16640);
    LAS float* CWL = (LAS float*)(F.lds + 13 * MB); LAS float* SEGT = (LAS float*)(F.lds + 13 * MB + 256); LAS float* MUS = (LAS float*)(F.lds + 125184);
    const int uidx = (c * NH + hh) * 2 + d;
    const int t = tid >> 3, c8 = (tid & 7) * 8, tt = ti.t0 + t; const size_t grow = (size_t)(ti.seq_base + tt); const bool hp = tt > 0, hn = tt + 1 < ti.seq_len;
    float rv[8], kv[8], vv[8], kk[8];
    load_raw<0, 5>(F, c, hh, d, tid, raw);
    for (int rp_ = 0; rp_ < (CPROBE == 1 ? 2 : 1); ++rp_) {
    shift_raw(raw.x[0], MUS + 0 * 128 + c8, hp, hn, rv);
    shift_raw(raw.x[1], MUS + 1 * 128 + c8, hp, hn, kv);
    shift_raw(raw.x[2], MUS + 2 * 128 + c8, hp, hn, vv);
    { float ss = 0.f; const float* kkw = gin(F.in[I_KK]) + (size_t)l * RWW + hh * 64 + c8;
#pragma unroll
      for (int e = 0; e < 8; ++e) { kk[e] = kv[e] * kkw[e]; ss += kk[e] * kk[e]; }
      ss = red8(ss); const float inv = __builtin_amdgcn_rsqf(fmaxf(ss, 1e-24f));
#pragma unroll
      for (int e = 0; e < 8; ++e) kk[e] *= inv; }
    if (d == 0) { v4u o; o.x = pk2(vv[0], vv[1]); o.y = pk2(vv[2], vv[3]); o.z = pk2(vv[4], vv[5]); o.w = pk2(vv[6], vv[7]); *(v4u*)((bf16*)(F.ws + WS_RV) + grow * RWW + hh * 64 + c8) = o; }
    { float x[8]; v4u o;
      shift_raw(raw.x[3], MUS + 3 * 128 + c8, hp, hn, x);
      o.x = pk2(ftanh(x[0]), ftanh(x[1])); o.y = pk2(ftanh(x[2]), ftanh(x[3])); o.z = pk2(ftanh(x[4]), ftanh(x[5])); o.w = pk2(ftanh(x[6]), ftanh(x[7])); *(LAS v4u*)(TW + t * MLD + c8) = o;
      shift_raw(raw.x[4], MUS + 4 * 128 + c8, hp, hn, x);
      o.x = pk2(x[0], x[1]); o.y = pk2(x[2], x[3]); o.z = pk2(x[4], x[5]); o.w = pk2(x[6], x[7]); *(LAS v4u*)(AD + t * MLD + c8) = o; }
    asm volatile("" ::: "memory"); }
    bf16x8 w2f[2][2], a2f[2][2];
    { const bf16* W2 = (const bf16*)(F.ws + WS_W2T) + ((size_t)(l * 2 + d) * 1024 + hh * 64) * 64; const bf16* A2 = (const bf16*)(F.ws + WS_A2T) + ((size_t)(l * 2 + d) * 1024 + hh * 64) * 64;
#pragma unroll
      for (int q = 0; q < 2; ++q) { const int n = (wave >> 2) * 2 + q;
#pragma unroll
          for (int k = 0; k < 2; ++k) { w2f[q][k] = frag_g(W2, 64, 16 * n, 32 * k, lane); a2f[q][k] = frag_g(A2, 64, 16 * n, 32 * k, lane); } } }
    __syncthreads();
    for (int rp_ = 0; rp_ < (CPROBE == 2 ? 2 : 1); ++rp_) { const int m = wave & 3; const bf16x8 w0f = frag_lds(TW, MLD, 16 * m, 0, lane), w1f = frag_lds(TW, MLD, 16 * m, 32, lane), d0f = frag_lds(AD, MLD, 16 * m, 0, lane), d1f = frag_lds(AD, MLD, 16 * m, 32, lane);
#pragma unroll
      for (int q = 0; q < 2; ++q) { const int n = (wave >> 2) * 2 + q; f32x4 aw = {0.f, 0.f, 0.f, 0.f}, aa = aw;
          aw = MFMA16(w0f, w2f[q][0], aw); aw = MFMA16(w1f, w2f[q][1], aw);
          aa = MFMA16(d0f, a2f[q][0], aa); aa = MFMA16(d1f, a2f[q][1], aa);
          const int col = 16 * n + (lane & 15), cg = hh * 64 + col; const float w0 = gin(F.in[I_W0])[(size_t)(l * 2 + d) * RWW + cg], a0 = gin(F.in[I_A0])[(size_t)(l * 2 + d) * RWW + cg];
#pragma unroll
          for (int g = 0; g < 4; ++g) { const int row = 16 * m + 4 * (lane >> 4) + g; const float wlog = -fsoftplus(-(w0 + aw[g])) - 0.5f;
              CUM[row * 65 + col] = -fexp(wlog); AVs[row * 65 + col] = fsigmoid(a0 + aa[g]); } } }
    __syncthreads();
    { const int col = tid & 63, seg = tid >> 6; float pre[8]; float run = 0.f;
#pragma unroll
      for (int i = 0; i < 8; ++i) { const int tau = seg * 8 + i, tr = d ? 63 - tau : tau; run += CUM[tr * 65 + col]; pre[i] = run; }
      SEGT[seg * 64 + col] = run;
      __syncthreads();
      float off = 0.f;
#pragma unroll
      for (int s = 0; s < 8; ++s) if (s < seg) off += SEGT[s * 64 + col];
#pragma unroll
      for (int i = 0; i < 8; ++i) { const int tau = seg * 8 + i, tr = d ? 63 - tau : tau; CUM[tr * 65 + col] = off + pre[i]; }
      if (seg == 7) CWL[col] = fexp(off + pre[7]); }
    __syncthreads();
    for (int rp_ = 0; rp_ < (CPROBE == 3 ? 2 : 1); ++rp_) { const int tau = d ? 63 - t : t, tprev = d ? t + 1 : t - 1;
      const float* kaw = gin(F.in[I_KA]) + (size_t)l * RWW + hh * 64 + c8; const float* rkw = gin(F.in[I_RK]) + (size_t)l * RWW + hh * 64 + c8;
      LAS bf16* At = MSLOT(0); LAS bf16* AtT = MSLOT(1); LAS bf16* Bt = MSLOT(2); LAS bf16* BtT = MSLOT(3); LAS bf16* Kt = MSLOT(4); LAS bf16* KtT = MSLOT(5); LAS bf16* Rt = MSLOT(6); LAS bf16* VT = MSLOT(7);
      float bsum = 0.f; unsigned pa[4], pb[4], pk[4], pr[4];
#pragma unroll
      for (int e2 = 0; e2 < 4; ++e2) { float at2[2], bt2[2], kt2[2], rt2[2];
#pragma unroll
          for (int q = 0; q < 2; ++q) { const int e = 2 * e2 + q; const float cum = CUM[t * 65 + c8 + e], cumx = tau > 0 ? CUM[tprev * 65 + c8 + e] : 0.f, a = AVs[t * 65 + c8 + e];
              const float kd = kv[e] * (1.0f + (a - 1.0f) * kaw[e]), ex = fexp(cum), exm = fexp(-cum);
              at2[q] = -kk[e] * fexp(cumx); bt2[q] = kk[e] * a * exm; kt2[q] = kd * exm; rt2[q] = rv[e] * ex; bsum += rv[e] * kd * rkw[e];
              const int pr_ = prow(c8 + e) * MLD + tau; AtT[pr_] = (bf16)f2bf(at2[q]); BtT[pr_] = (bf16)f2bf(bt2[q]); KtT[pr_] = (bf16)f2bf(kt2[q]); VT[pr_] = (bf16)f2bf(vv[e]); }
          pa[e2] = pk2(at2[0], at2[1]); pb[e2] = pk2(bt2[0], bt2[1]); pk[e2] = pk2(kt2[0], kt2[1]); pr[e2] = pk2(rt2[0], rt2[1]); }
      *(LAS v4u*)(At + tau * MLD + c8) = (v4u){pa[0], pa[1], pa[2], pa[3]}; *(LAS v4u*)(Bt + tau * MLD + c8) = (v4u){pb[0], pb[1], pb[2], pb[3]};
      *(LAS v4u*)(Kt + tau * MLD + c8) = (v4u){pk[0], pk[1], pk[2], pk[3]}; *(LAS v4u*)(Rt + tau * MLD + c8) = (v4u){pr[0], pr[1], pr[2], pr[3]};
      bsum = red8(bsum);
      if ((tid & 7) == 0) ((float*)(F.ws + WS_BETA))[((size_t)d * MTOT + grow) * NH + hh] = bsum; }
    __syncthreads();
    LAS bf16* At = MSLOT(0); LAS bf16* AtT = MSLOT(1); LAS bf16* Bt = MSLOT(2); LAS bf16* BtT = MSLOT(3); LAS bf16* Kt = MSLOT(4); LAS bf16* KtT = MSLOT(5); LAS bf16* Rt = MSLOT(6); LAS bf16* VT = MSLOT(7);
    LAS bf16* Pm = MSLOT(8); LAS bf16* AkVT = MSLOT(9); LAS bf16* Gak = MSLOT(10); LAS bf16* Grb = MSLOT(11); LAS bf16* Grk = MSLOT(12);
    LAS bf16* TAT = MSLOT(0); LAS bf16* U0T = MSLOT(2); LAS bf16* TD = (LAS bf16*)(F.lds + 122112); constexpr int TDLD = 24;
    for (int rp_ = 0; rp_ < (CPROBE == 4 ? 2 : 1); ++rp_) {
    mm64<1>(Pm, At, Bt, wave, lane);
    __syncthreads();
    if (wave == 0) { const int blk = lane >> 4, cc = lane & 15; float tv[16];
#pragma unroll
        for (int r = 0; r < 16; ++r) { asm volatile("" ::: "memory"); const LAS bf16* ar = Pm + (16 * blk + r) * MLD + 16 * blk; const v4u q0 = *(const LAS v4u*)ar, q1 = *(const LAS v4u*)(ar + 8);
            const float av_[16] = {bf_lo(q0.x), bf_hi(q0.x), bf_lo(q0.y), bf_hi(q0.y), bf_lo(q0.z), bf_hi(q0.z), bf_lo(q0.w), bf_hi(q0.w), bf_lo(q1.x), bf_hi(q1.x), bf_lo(q1.y), bf_hi(q1.y), bf_lo(q1.z), bf_hi(q1.z), bf_lo(q1.w), bf_hi(q1.w)};
            float acc0 = (r == cc) ? 1.0f : 0.f, acc1 = 0.f;
#pragma unroll
            for (int m = 0; m < r; ++m) { if (m & 1) acc1 += av_[m] * tv[m]; else acc0 += av_[m] * tv[m]; }
            tv[r] = acc0 + acc1; }
#pragma unroll
        for (int r = 0; r < 16; ++r) TD[(16 * blk + r) * TDLD + cc] = (bf16)f2bf(tv[r]);
    } else {
#pragma unroll 1
        for (int q = wave - 1; q < 48; q += 7) { const int pr = q >> 4, tl = q & 15, rt = tl >> 2, ct = tl & 3;
            const LAS bf16* X = pr == 0 ? At : Rt; const LAS bf16* Y = pr == 1 ? Bt : Kt; LAS bf16* Dst = pr == 0 ? Gak : pr == 1 ? Grb : Grk;
            f32x4 acc = {0.f, 0.f, 0.f, 0.f}; acc = mm_tile(Y, rt, X, ct, acc, lane);
            const int cI = 16 * ct + (lane & 15);
#pragma unroll
            for (int g = 0; g < 4; ++g) { const int rI = 16 * rt + 4 * (lane >> 4) + g; const bool keep = pr == 0 ? (cI > rI) : (cI >= rI); if (!keep) acc[g] = 0.f; }
            st_tile(Dst, rt, ct, acc, lane); }
    }
    __syncthreads(); }
    { const int rt = wave >> 1;
#pragma unroll
      for (int q = 0; q < 2; ++q) { const int ct = 2 * (wave & 1) + q; f32x4 acc = {0.f, 0.f, 0.f, 0.f}; acc = mm_tile_p<false, true>(Gak, rt, VT, ct, acc, lane); st_tile(AkVT, rt, ct, acc, lane); } }
    { const v4u z = {0u, 0u, 0u, 0u}; for (int i = tid; i < 64 * 8; i += NTHR) { const int row = i >> 3, c8_ = (i & 7) * 8; *(LAS v4u*)(TAT + row * MLD + c8_) = z; *(LAS v4u*)(U0T + row * MLD + c8_) = z; } }
    __syncthreads();
    for (int rp_ = 0; rp_ < (CPROBE == 5 ? 2 : 1); ++rp_)
#pragma unroll 1
    for (int bi = 0; bi < 4; ++bi) {
        const int g = lane >> 4, il = lane & 15, nt = wave & 3; const LAS bf16* RH = (wave < 4) ? AtT : AkVT; LAS bf16* XT = (wave < 4) ? TAT : U0T;
        const v2u rq = *(const LAS v2u*)(RH + ((wave < 4) ? prow(16 * nt + il) : 16 * nt + il) * MLD + 16 * bi + 4 * g);
        f32x4 acc = {bf_lo(rq.x), bf_hi(rq.x), bf_lo(rq.y), bf_hi(rq.y)};
#pragma unroll
        for (int ks = 0; ks < 2; ++ks) if (32 * ks < 16 * bi) {
            bf16x8 af = frag_lds(Pm, MLD, 16 * bi, 32 * ks, lane); if (32 * ks + 8 * g >= 16 * bi) af = (bf16x8){0, 0, 0, 0, 0, 0, 0, 0};
            acc = MFMA16(af, frag_lds(XT, MLD, 16 * nt, 32 * ks, lane), acc); }
        v4u rb; rb.x = pk2(acc[0], acc[1]); rb.y = pk2(acc[2], acc[3]); rb.z = 0u; rb.w = 0u;
        const v2u tq = *(const LAS v2u*)(TD + (16 * bi + il) * TDLD + 4 * g); v4u tf; tf.x = tq.x; tf.y = tq.y; tf.z = 0u; tf.w = 0u;
        f32x4 xo = {0.f, 0.f, 0.f, 0.f}; xo = MFMA16(__builtin_bit_cast(bf16x8, tf), __builtin_bit_cast(bf16x8, rb), xo);
        v2u o; o.x = pk2(xo[0], xo[1]); o.y = pk2(xo[2], xo[3]); *(LAS v2u*)(XT + (16 * nt + il) * MLD + 16 * bi + 4 * g) = o;
        __syncthreads();
    }
    for (int rp_ = 0; rp_ < (CPROBE == 6 ? 2 : 1); ++rp_) {
    {
      bf16* QMg = (bf16*)(F.ws + WS_QM) + (size_t)uidx * 4096; bf16* PHg = (bf16*)(F.ws + WS_PHI) + (size_t)uidx * 4096; const int rt = wave >> 1;
#pragma unroll
      for (int q = 0; q < 2; ++q) { const int ct = 2 * (wave & 1) + q; const int cidx = 16 * ct + (lane & 15), r0 = 16 * rt + 4 * (lane >> 4), qpos = 32 * (rt >> 1) + 8 * (lane >> 4) + 4 * (rt & 1);
          f32x4 acc = ld_tile(Rt, rt, ct, lane); acc = mm_tile(TAT, rt, Grb, ct, acc, lane);
          v2u o; o.x = pk2(acc[0], acc[1]); o.y = pk2(acc[2], acc[3]); *(v2u*)(QMg + cidx * 64 + qpos) = o;
          asm volatile("" ::: "memory");
          f32x4 ph = {0.f, 0.f, 0.f, 0.f}; ph = mm_tile_p<false, true>(TAT, rt, BtT, ct, ph, lane); const float cw = CWL[cidx];
#pragma unroll
          for (int g = 0; g < 4; ++g) ph[g] = cw * (ph[g] + ((r0 + g == cidx) ? 1.0f : 0.f));
          o.x = pk2(ph[0], ph[1]); o.y = pk2(ph[2], ph[3]); *(v2u*)(PHg + cidx * 64 + qpos) = o; } }
    {
      bf16* Y0g = (bf16*)(F.ws + WS_Y0F) + (size_t)uidx * 4096; bf16* PSg = (bf16*)(F.ws + WS_PSF) + (size_t)uidx * 4096; const int rt = wave >> 1;
#pragma unroll
      for (int q = 0; q < 2; ++q) { const int ct = 2 * (wave & 1) + q;
          asm volatile("" ::: "memory");
          f32x4 y0 = {0.f, 0.f, 0.f, 0.f}; y0 = mm_tile(U0T, rt, Grb, ct, y0, lane); asm volatile("" ::: "memory"); y0 = mm_tile_p<true, false>(VT, rt, Grk, ct, y0, lane);
          { v2u w; w.x = pk2(y0[0], y0[1]); w.y = pk2(y0[2], y0[3]); *(v2u*)(Y0g + ((rt * 4 + ct) * 64 + lane) * 4) = w; }
          asm volatile("" ::: "memory");
          f32x4 ps = {0.f, 0.f, 0.f, 0.f}; ps = mm_tile_p<true, false>(BtT, rt, U0T, ct, ps, lane); asm volatile("" ::: "memory"); ps = mm_tile_p<true, true>(KtT, rt, VT, ct, ps, lane);
#pragma unroll
          for (int g = 0; g < 4; ++g) ps[g] *= CWL[16 * rt + 4 * (lane >> 4) + g];
          { v2u w; w.x = pk2(ps[0], ps[1]); w.y = pk2(ps[2], ps[3]); *(v2u*)(PSg + ((ct * 4 + rt) * 64 + lane) * 4) = w; } } } }
    __syncthreads();
}
#define LDS_BAR() do { asm volatile("s_waitcnt lgkmcnt(0)" ::: "memory"); __builtin_amdgcn_s_barrier(); asm volatile("" ::: "memory"); } while (0)
struct ChunkOps { bf16x8 f[4][2]; v2u c[4]; int tile; };
__device__ __forceinline__ void chunk_load(Frame& F, ChunkOps& o, int step, int b, int hh, int d, int sl, int role, int lane) {
    const int g = lane >> 4, il = lane & 15;
    step = step < 67 ? step : 67;
    const int cc = d ? 3 - step : step, lc = d ? 67 - step : step - 4; const int tile = step < 4 ? 128 + b * 4 + cc : b * 64 + lc;
    o.tile = tile;
    const size_t uidx = (size_t)(tile * NH + hh) * 2 + d;
    const bf16* Mg = (const bf16*)(F.ws + (role ? WS_QM : WS_PHI)) + uidx * 4096 + il * 64 + 8 * g; const bf16* Cg = (const bf16*)(F.ws + (role ? WS_Y0F : WS_PSF)) + uidx * 4096 + (sl * 4 * 64 + lane) * 4;
#pragma unroll
    for (int m = 0; m < 4; ++m) { o.f[m][0] = *(const bf16x8*)(Mg + m * 1024); o.f[m][1] = *(const bf16x8*)(Mg + m * 1024 + 32); o.c[m] = *(const v2u*)(Cg + m * 256); }
}
__device__ __forceinline__ void lru_scan(Frame& F, int idx) {
    const int ch = idx & 1023, b = (idx >> 10) & 1, d = idx >> 11;
    const float* AG = (const float*)(F.ws + WS_LAGG); float* HIN = (float*)(F.ws + WS_LHIN);
    float carry = 0.f;
#pragma unroll 4
    for (int step = 0; step < 68; ++step) { int tile; if (step < 4) tile = 128 + b * 4 + (d ? 3 - step : step); else tile = b * 64 + (d ? 63 - (step - 4) : step - 4);
        const float a = AG[((size_t)(0 * 2 + d) * NTILE + tile) * LRW + ch], hh_ = AG[((size_t)(1 * 2 + d) * NTILE + tile) * LRW + ch];
        HIN[((size_t)d * NTILE + tile) * LRW + ch] = carry; carry = a * carry + hh_; }
}

__device__ __forceinline__ void chunk_apply(Frame& F, const ChunkOps& o, f32x4 (&S)[4], int step, bf16* YR, int hh, int d, int sl, int role, int lane) {
    const int g = lane >> 4, il = lane & 15; LAS v4u* XCH = (LAS v4u*)F.lds;
    bf16x8 bfr[2];
    if (role == 0) {
#pragma unroll
        for (int ks = 0; ks < 2; ++ks) { v4u w; w.x = pk2(S[2 * ks][0], S[2 * ks][1]); w.y = pk2(S[2 * ks][2], S[2 * ks][3]); w.z = pk2(S[2 * ks + 1][0], S[2 * ks + 1][1]); w.w = pk2(S[2 * ks + 1][2], S[2 * ks + 1][3]); bfr[ks] = __builtin_bit_cast(bf16x8, w); }
#pragma unroll
        for (int m = 0; m < 4; ++m) { f32x4 sn = (f32x4){bf_lo(o.c[m].x), bf_hi(o.c[m].x), bf_lo(o.c[m].y), bf_hi(o.c[m].y)}; sn = MFMA16(o.f[m][0], bfr[0], sn); sn = MFMA16(o.f[m][1], bfr[1], sn); S[m] = sn; }
#pragma unroll
        for (int ks = 0; ks < 2; ++ks) { v4u w; w.x = pk2(S[2 * ks][0], S[2 * ks][1]); w.y = pk2(S[2 * ks][2], S[2 * ks][3]); w.z = pk2(S[2 * ks + 1][0], S[2 * ks + 1][1]); w.w = pk2(S[2 * ks + 1][2], S[2 * ks + 1][3]);
            XCH[((((step + 1) & 1) * 4 + sl) * 2 + ks) * 64 + lane] = w; }
    } else {
#pragma unroll
        for (int ks = 0; ks < 2; ++ks) bfr[ks] = __builtin_bit_cast(bf16x8, XCH[(((step & 1) * 4 + sl) * 2 + ks) * 64 + lane]);
#pragma unroll
        for (int m = 0; m < 4; ++m) { f32x4 y = (f32x4){bf_lo(o.c[m].x), bf_hi(o.c[m].x), bf_lo(o.c[m].y), bf_hi(o.c[m].y)}; y = MFMA16(bfr[0], o.f[m][0], y); y = MFMA16(bfr[1], o.f[m][1], y);
            const int tau = 16 * m + il, tl = d ? 63 - tau : tau; v2u w; w.x = pk2(y[0], y[1]); w.y = pk2(y[2], y[3]);
            *(v2u*)(YR + (size_t)(o.tile * 64 + tl) * RWW + hh * 64 + sl * 16 + 4 * g) = w; }
    }
}
__device__ __forceinline__ void rwkv_chain_chunks(Frame& F, int item) {
    const int chain = item >> 2, sl = item & 3, d = chain & 1, hh = (chain >> 1) & 15, b = chain >> 5, role = F.wave, lane = F.lane;
    bf16* YR = (bf16*)(F.ws + WS_YR) + (size_t)d * MTOT * RWW;
    { LAS v4u* XCH = (LAS v4u*)F.lds; for (int i = F.tid; i < 4 * 2 * 64; i += NTHR) XCH[i] = (v4u){0u, 0u, 0u, 0u}; }
    __syncthreads();
    if (F.wave >= 2) {
#pragma unroll 1
        for (int step = 0; step < 68; ++step) LDS_BAR();
        return; }
    f32x4 S[4];
#pragma unroll
    for (int m = 0; m < 4; ++m) S[m] = (f32x4){0.f, 0.f, 0.f, 0.f};
    ChunkOps A, B, C, E;
    chunk_load(F, A, 0, b, hh, d, sl, role, lane); chunk_load(F, B, 1, b, hh, d, sl, role, lane); chunk_load(F, C, 2, b, hh, d, sl, role, lane);
#pragma unroll 1
    for (int step = 0; step < 68; step += 4) {
        chunk_load(F, E, step + 3, b, hh, d, sl, role, lane);
        chunk_apply(F, A, S, step, YR, hh, d, sl, role, lane); LDS_BAR();
        chunk_load(F, A, step + 4, b, hh, d, sl, role, lane);
        chunk_apply(F, B, S, step + 1, YR, hh, d, sl, role, lane); LDS_BAR();
        chunk_load(F, B, step + 5, b, hh, d, sl, role, lane);
        chunk_apply(F, C, S, step + 2, YR, hh, d, sl, role, lane); LDS_BAR();
        chunk_load(F, C, step + 6, b, hh, d, sl, role, lane);
        chunk_apply(F, E, S, step + 3, YR, hh, d, sl, role, lane); LDS_BAR();
    }
}
__device__ __forceinline__ void merge_unit(Frame& F, int l, int u) {
    const int c = u >> 2; const TileInfo ti = tile_info(c); const int t0 = ti.t0 + (u & 3) * 16; const bf16* P = (const bf16*)(F.ws + WS_P);
    LAS bf16* SG = (LAS bf16*)F.lds; LAS bf16* GO = (LAS bf16*)(F.lds + 10752);
    const float* mu0 = gin(F.in[I_MU]) + (size_t)l * 2 * RW_COLS; const float* mu1 = mu0 + RW_COLS;
    if (F.tid < 16 * 20) { const int t = F.tid / 20, k8 = (F.tid % 20) * 8, tt = t0 + t, rc = 3 * RWW + 256 + k8; const bf16* p = P + (size_t)(ti.seq_base + tt) * IN_PAD + 2 * LRW + rc;
        float x[8], xm[8], xn[8]; ld8bf(p, x); ld8bf(p - (tt > 0 ? IN_PAD : 0), xm); ld8bf(p + (tt + 1 < ti.seq_len ? IN_PAD : 0), xn); float o[8];
#pragma unroll
        for (int e = 0; e < 8; ++e) { const float pm = tt > 0 ? xm[e] : 0.f, pn = tt + 1 < ti.seq_len ? xn[e] : 0.f; o[e] = fsigmoid(x[e] + mu0[rc + e] * (pm - x[e]) + mu1[rc + e] * (pn - x[e])); }
        v4u w; w.x = pk2(o[0], o[1]); w.y = pk2(o[2], o[3]); w.z = pk2(o[4], o[5]); w.w = pk2(o[6], o[7]); *(LAS v4u*)(SG + t * 168 + k8) = w; }
    __syncthreads();
    { const int lane = F.lane; const bf16* G2 = (const bf16*)(F.ws + WS_G2T) + (size_t)l * 1024 * 160;
      bf16x8 af[5];
#pragma unroll
      for (int k = 0; k < 5; ++k) af[k] = frag_lds(SG, 168, 0, 32 * k, lane);
#pragma unroll 2
      for (int n = 0; n < 8; ++n) { const int n0 = F.wave * 128 + n * 16; f32x4 a0 = {0.f, 0.f, 0.f, 0.f};
#pragma unroll
          for (int k = 0; k < 5; ++k) a0 = MFMA16(af[k], frag_g(G2, 160, n0, 32 * k, lane), a0);
#pragma unroll
          for (int r = 0; r < 4; ++r) GO[(4 * (lane >> 4) + r) * 1032 + n0 + (lane & 15)] = (bf16)f2bf(a0[r]); } }
    __syncthreads();
    { bf16* MRG = (bf16*)(F.ws + WS_H);
      for (int it = F.tid; it < 16 * 256; it += NTHR) { const int t = it >> 8, cgp = it & 255, tt = t0 + t; const size_t grow = (size_t)(ti.seq_base + tt);
          float o[8];
          if (cgp < 128) { const int ch = cgp * 8; float gq8[8]; ld8bf(P + grow * IN_PAD + LRW + ch, gq8); const f32x4 g0 = {gq8[0], gq8[1], gq8[2], gq8[3]}, g1 = {gq8[4], gq8[5], gq8[6], gq8[7]};
              const bf16* hl = (const bf16*)(F.ws + WS_LB) + grow * LRW + ch; const bf16* ac = (const bf16*)(F.ws + WS_LA) + grow * LRW + ch; const float* hi = (const float*)(F.ws + WS_LHIN) + (size_t)c * LRW + ch;
              float h0[8], c0[8], h1[8], c1[8]; ld8bf(hl, h0); ld8bf(ac, c0); ld8bf(hl + (size_t)MTOT * LRW, h1); ld8bf(ac + (size_t)MTOT * LRW, c1);
              const f32x4 i00 = *(const f32x4*)hi, i01 = *(const f32x4*)(hi + 4), i10 = *(const f32x4*)(hi + (size_t)NTILE * LRW), i11 = *(const f32x4*)(hi + (size_t)NTILE * LRW + 4);
              const f32x4 a0 = {h0[0] + c0[0] * i00.x + h1[0] + c1[0] * i10.x, h0[1] + c0[1] * i00.y + h1[1] + c1[1] * i10.y, h0[2] + c0[2] * i00.z + h1[2] + c1[2] * i10.z, h0[3] + c0[3] * i00.w + h1[3] + c1[3] * i10.w};
              const f32x4 a1 = {h0[4] + c0[4] * i01.x + h1[4] + c1[4] * i11.x, h0[5] + c0[5] * i01.y + h1[5] + c1[5] * i11.y, h0[6] + c0[6] * i01.z + h1[6] + c1[6] * i11.z, h0[7] + c0[7] * i01.w + h1[7] + c1[7] * i11.w};
              o[0] = gelu_tanh(g0.x) * a0.x; o[1] = gelu_tanh(g0.y) * a0.y; o[2] = gelu_tanh(g0.z) * a0.z; o[3] = gelu_tanh(g0.w) * a0.w;
              o[4] = gelu_tanh(g1.x) * a1.x; o[5] = gelu_tanh(g1.y) * a1.y; o[6] = gelu_tanh(g1.z) * a1.z; o[7] = gelu_tanh(g1.w) * a1.w; }
          else { const int ch = (cgp - 128) * 8, hh = ch >> 6; const bf16* yr = (const bf16*)(F.ws + WS_YR) + grow * RWW + ch;
              float ya[8], yb[8], va[8]; ld8bf(yr, ya); ld8bf(yr + (size_t)MTOT * RWW, yb); ld8bf((const bf16*)(F.ws + WS_RV) + grow * RWW + ch, va);
              float s1 = 0.f, q1 = 0.f;
#pragma unroll
              for (int e = 0; e < 8; ++e) { ya[e] += yb[e]; s1 += ya[e]; q1 += ya[e] * ya[e]; }
              s1 = red8(s1); q1 = red8(q1);
              const float mean = s1 * (1.0f / 64.0f), var = fmaxf(q1 * (1.0f / 64.0f) - mean * mean, 0.f); const f32x2 st = {mean, __builtin_amdgcn_rsqf(var + GN_EPS)};
              const float beta = ((const float*)(F.ws + WS_BETA))[grow * NH + hh] + ((const float*)(F.ws + WS_BETA))[((size_t)MTOT + grow) * NH + hh];
              const float* gg = gin(F.in[I_GNG]) + (size_t)l * RWW + ch; const float* gb = gin(F.in[I_GNB]) + (size_t)l * RWW + ch;
              const v4u gq = *(const LAS v4u*)(GO + t * 1032 + ch); const float gv[8] = {bf_lo(gq.x), bf_hi(gq.x), bf_lo(gq.y), bf_hi(gq.y), bf_lo(gq.z), bf_hi(gq.z), bf_lo(gq.w), bf_hi(gq.w)};
#pragma unroll
              for (int e = 0; e < 8; ++e) o[e] = ((ya[e] - st.x) * st.y * gg[e] + gb[e] + beta * va[e]) * gv[e]; }
          v4u w; w.x = pk2(o[0], o[1]); w.y = pk2(o[2], o[3]); w.z = pk2(o[4], o[5]); w.w = pk2(o[6], o[7]);
          *(v4u*)(MRG + grow * D + cgp * 8) = w; } }
    __syncthreads();
}

__device__ __forceinline__ void ln_row(float (&z)[32], const float* g, const float* b, int lane) {
    float s = 0.f;
#pragma unroll
    for (int i = 0; i < 32; ++i) s += z[i];
    const float mean = wave_sum(s) * (1.0f / D); float q = 0.f;
#pragma unroll
    for (int i = 0; i < 32; ++i) { z[i] -= mean; q += z[i] * z[i]; }
    const float rstd = __builtin_amdgcn_rsqf(wave_sum(q) * (1.0f / D) + LN_EPS);
#pragma unroll
    for (int j = 0; j < 4; ++j) { const int e = j * 512 + lane * 8; const f32x4 g0 = *(const f32x4*)(g + e), g1 = *(const f32x4*)(g + e + 4), b0 = *(const f32x4*)(b + e), b1 = *(const f32x4*)(b + e + 4);
        const float gs[8] = {g0.x, g0.y, g0.z, g0.w, g1.x, g1.y, g1.z, g1.w}, bs[8] = {b0.x, b0.y, b0.z, b0.w, b1.x, b1.y, b1.z, b1.w};
#pragma unroll
        for (int i = 0; i < 8; ++i) z[j * 8 + i] = z[j * 8 + i] * rstd * gs[i] + bs[i]; }
}
__device__ __forceinline__ void load32(const float* p, int lane, float (&v)[32]) {
#pragma unroll
    for (int j = 0; j < 4; ++j) { const int e = j * 512 + lane * 8; const f32x4 a = *(const f32x4*)(p + e), b = *(const f32x4*)(p + e + 4);
        v[j * 8 + 0] = a.x; v[j * 8 + 1] = a.y; v[j * 8 + 2] = a.z; v[j * 8 + 3] = a.w; v[j * 8 + 4] = b.x; v[j * 8 + 5] = b.y; v[j * 8 + 6] = b.z; v[j * 8 + 7] = b.w; }
}
__device__ __forceinline__ void store32(float* p, int lane, const float (&v)[32]) {
#pragma unroll
    for (int j = 0; j < 4; ++j) { const int e = j * 512 + lane * 8; *(f32x4*)(p + e) = (f32x4){v[j * 8 + 0], v[j * 8 + 1], v[j * 8 + 2], v[j * 8 + 3]}; *(f32x4*)(p + e + 4) = (f32x4){v[j * 8 + 4], v[j * 8 + 5], v[j * 8 + 6], v[j * 8 + 7]}; }
}
__device__ __forceinline__ void store32_mod_bf16(bf16* p, const float* sh, const float* sc, int lane, const float (&v)[32]) {
#pragma unroll
    for (int j = 0; j < 4; ++j) { const int e = j * 512 + lane * 8; const f32x4 s0 = *(const f32x4*)(sh + e), s1 = *(const f32x4*)(sh + e + 4), c0 = *(const f32x4*)(sc + e), c1 = *(const f32x4*)(sc + e + 4);
        v4u o; o.x = pk2(v[j * 8 + 0] * (1.f + c0.x) + s0.x, v[j * 8 + 1] * (1.f + c0.y) + s0.y); o.y = pk2(v[j * 8 + 2] * (1.f + c0.z) + s0.z, v[j * 8 + 3] * (1.f + c0.w) + s0.w);
        o.z = pk2(v[j * 8 + 4] * (1.f + c1.x) + s1.x, v[j * 8 + 5] * (1.f + c1.y) + s1.y); o.w = pk2(v[j * 8 + 6] * (1.f + c1.z) + s1.z, v[j * 8 + 7] * (1.f + c1.w) + s1.w);
        *(v4u*)(p + e) = o; }
}
__device__ __forceinline__ void ln1_rows(Frame& F, int l, int nrows, bool dry = false) {
    const int gw = F.vcu * NWAVES + F.wave, NGW = F.G * NWAVES; float* X = (float*)(F.ws + WS_X); const float* O = (const float*)(F.ws + WS_O); bf16* H = (bf16*)(F.ws + WS_H);
    float* Xo = dry ? (float*)(F.ws + WS_LA) : X; bf16* Ho = dry ? (bf16*)(F.ws + WS_LB) : H;
    for (int row = gw; row < nrows; row += NGW) { const float* md = (const float*)(F.ws + WS_MOD) + ((size_t)l * 3 + mod_row(row)) * (6 * D);
        float z[32], o[32], gt[32]; load32(X + (size_t)row * D, F.lane, z); load32(md + 2 * D, F.lane, gt);
#pragma unroll
        for (int j = 0; j < 4; ++j) { float t8[8]; ld8bf((const bf16*)(F.ws + WS_O) + (size_t)row * D + j * 512 + F.lane * 8, t8);
#pragma unroll
            for (int i = 0; i < 8; ++i) o[j * 8 + i] = t8[i]; }
#pragma unroll
        for (int i = 0; i < 32; ++i) z[i] = ALPHA * z[i] + gt[i] * o[i];
        ln_row(z, gin(F.in[I_LN1G]) + (size_t)l * D, gin(F.in[I_LN1B]) + (size_t)l * D, F.lane);
        store32(Xo + (size_t)row * D, F.lane, z);
        store32_mod_bf16(Ho + (size_t)row * D, md + 3 * D, md + 4 * D, F.lane, z); }
}

__device__ __forceinline__ unsigned ord_key(float s, int k) { unsigned u = __builtin_bit_cast(unsigned, s); u = (u & 0x80000000u) ? ~u : (u | 0x80000000u); return (u & ~127u) | (unsigned)(127 - k); }
__device__ __forceinline__ float key_score(unsigned key) { const unsigned u = key & ~127u; return __builtin_bit_cast(float, (u & 0x80000000u) ? (u ^ 0x80000000u) : ~u); }
__device__ __forceinline__ void bitonic_top16(unsigned (&A)[16], const unsigned (&B)[16]) {
#pragma unroll
    for (int i = 0; i < 16; ++i) A[i] = A[i] > B[15 - i] ? A[i] : B[15 - i];
#pragma unroll
    for (int st = 8; st >= 1; st >>= 1)
#pragma unroll
        for (int i = 0; i < 16; ++i) if (!(i & st)) { const unsigned hi = A[i] > A[i + st] ? A[i] : A[i + st], lo = A[i] > A[i + st] ? A[i + st] : A[i]; A[i] = hi; A[i + st] = lo; }
}
__device__ __forceinline__ void ins16(unsigned (&L)[16], unsigned x) {
#pragma unroll
    for (int i = 0; i < 16; ++i) { const unsigned hi = L[i] > x ? L[i] : x; x = L[i] > x ? x : L[i]; L[i] = hi; }
}
__device__ __forceinline__ unsigned ord_key8(float s, unsigned tag) { unsigned u = __builtin_bit_cast(unsigned, s); u = (u & 0x80000000u) ? ~u : (u | 0x80000000u); return (u & ~255u) | tag; }
__device__ __forceinline__ float key_score8(unsigned key) { const unsigned u = key & ~255u; return __builtin_bit_cast(float, (u & 0x80000000u) ? (u ^ 0x80000000u) : ~u); }
__device__ __forceinline__ void peer_topk_unit(Frame& F, int l, int tile, int h) {
    int tid = F.tid; asm volatile("" : "+v"(tid));
    const int lane = tid & 63, wave = F.wave;
    LAS bf16* AQ = (LAS bf16*)F.lds; LAS float* SC = (LAS float*)(F.lds + 33792);
    LAS unsigned* bufA = (LAS unsigned*)F.lds; LAS unsigned* bufB = (LAS unsigned*)(F.lds + 33792); LAS unsigned* FIN = (LAS unsigned*)(F.lds + 66560); LAS unsigned char* PAIRT = (LAS unsigned char*)(F.lds + 99584);
    if (tid < 50) { int c = tid, i = 0; for (; i < 16; ++i) { const int n = 16 / (i + 1); if (c < n) break; c -= n; } PAIRT[tid] = (unsigned char)(i * 16 + c); }
    for (int idx = tid; idx < 64 * 64; idx += NTHR) { const int t = idx >> 6, c4 = (idx & 63) * 4; *(LAS v2u*)(AQ + t * 264 + c4) = *(const v2u*)((const bf16*)(F.ws + WS_QP) + (size_t)(tile * 64 + t) * D + h * 256 + c4); }
    __syncthreads();
    { const bf16* SK = (const bf16*)(F.ws + WS_SUBK) + (size_t)((l * 8 + h) * 2) * 128 * 128;
#pragma unroll
      for (int p = 0; p < 2; ++p) { bf16x8 bfr[4];
#pragma unroll
          for (int k = 0; k < 4; ++k) bfr[k] = frag_g(SK + (size_t)p * 128 * 128, 128, 16 * wave, 32 * k, lane);
#pragma unroll
          for (int m = 0; m < 4; ++m) { f32x4 acc = {0.f, 0.f, 0.f, 0.f};
#pragma unroll
              for (int k = 0; k < 4; ++k) acc = MFMA16(frag_lds(AQ, 264, 16 * m, p * 128 + 32 * k, lane), bfr[k], acc);
#pragma unroll
              for (int r = 0; r < 4; ++r) SC[(16 * m + 4 * (lane >> 4) + r) * 257 + p * 128 + 16 * wave + (lane & 15)] = acc[r]; } } }
    __syncthreads();
    const int t = lane, r = wave, p = r & 1, qd = r >> 1;
    unsigned L[16], B[16];
#pragma unroll
    for (int i = 0; i < 16; ++i) L[i] = 0u;
    { const LAS float* sp = SC + t * 257 + p * 128 + 32 * qd;
#pragma unroll 4
      for (int k = 0; k < 32; ++k) ins16(L, ord_key(sp[k], 32 * qd + k)); }
#pragma unroll
    for (int i = 0; i < 16; ++i) bufA[(r * 16 + i) * 64 + t] = L[i];
    __syncthreads();
#pragma unroll
    for (int i = 0; i < 16; ++i) B[i] = bufA[((r ^ 2) * 16 + i) * 64 + t];
    bitonic_top16(L, B);
#pragma unroll
    for (int i = 0; i < 16; ++i) bufB[(r * 16 + i) * 64 + t] = L[i];
    __syncthreads();
#pragma unroll
    for (int i = 0; i < 16; ++i) B[i] = bufB[((r ^ 4) * 16 + i) * 64 + t];
    bitonic_top16(L, B);
    if (qd == 0) {
#pragma unroll
        for (int i = 0; i < 16; ++i) FIN[(p * 16 + i) * 64 + t] = L[i]; }
    __syncthreads();
#pragma unroll
    for (int i = 0; i < 16; ++i) L[i] = 0u;
#pragma unroll
    for (int q = 0; q < 7; ++q) { const int c = q * 8 + r; if (c < 50) { const unsigned pr = PAIRT[c]; const unsigned ka = FIN[(0 * 16 + (pr >> 4)) * 64 + t], kb = FIN[(1 * 16 + (pr & 15)) * 64 + t];
            ins16(L, ord_key8(key_score(ka) + key_score(kb), pr)); } }
#pragma unroll
    for (int i = 0; i < 16; ++i) bufB[(r * 16 + i) * 64 + t] = L[i];
    __syncthreads();
#pragma unroll
    for (int i = 0; i < 16; ++i) B[i] = bufB[((r ^ 1) * 16 + i) * 64 + t];
    bitonic_top16(L, B);
#pragma unroll
    for (int i = 0; i < 16; ++i) bufA[(r * 16 + i) * 64 + t] = L[i];
    __syncthreads();
#pragma unroll
    for (int i = 0; i < 16; ++i) B[i] = bufA[((r ^ 2) * 16 + i) * 64 + t];
    bitonic_top16(L, B);
    __syncthreads();
#pragma unroll
    for (int i = 0; i < 16; ++i) bufB[(r * 16 + i) * 64 + t] = L[i];
    __syncthreads();
#pragma unroll
    for (int i = 0; i < 16; ++i) B[i] = bufB[((r ^ 4) * 16 + i) * 64 + t];
    bitonic_top16(L, B);
    { const float mx = key_score8(L[0]); float sum = 0.f, e0 = 0.f, e1 = 0.f; unsigned k0 = 0u, k1 = 0u;
#pragma unroll
      for (int i = 0; i < 16; ++i) { const float e = fexp(key_score8(L[i]) - mx); sum += e; if (i == 2 * r) { e0 = e; k0 = L[i]; } if (i == 2 * r + 1) { e1 = e; k1 = L[i]; } }
      const float inv = __builtin_amdgcn_rcpf(sum);
      const unsigned pa = k0 & 255u, pb = k1 & 255u;
      const int id0 = (127 - (int)(FIN[(0 * 16 + (pa >> 4)) * 64 + t] & 127u)) * 128 + (127 - (int)(FIN[(1 * 16 + (pa & 15)) * 64 + t] & 127u));
      const int id1 = (127 - (int)(FIN[(0 * 16 + (pb >> 4)) * 64 + t] & 127u)) * 128 + (127 - (int)(FIN[(1 * 16 + (pb & 15)) * 64 + t] & 127u));
      int* IDX = (int*)(F.ws + WS_IDX) + (size_t)(tile * 64 + t) * PE_SEL + h * 16 + 2 * r; float* GT = (float*)(F.ws + WS_GATE) + (size_t)(tile * 64 + t) * PE_SEL + h * 16 + 2 * r;
      *(int2*)IDX = make_int2(id0, id1); *(f32x2*)GT = (f32x2){e0 * inv, e1 * inv}; }
    __syncthreads();
}

__device__ __forceinline__ void unpack16(const v4u& w, f32x2 (&o)[8]) {
    o[0] = __builtin_amdgcn_cvt_pk_f32_fp8((int)w.x, false); o[1] = __builtin_amdgcn_cvt_pk_f32_fp8((int)w.x, true); o[2] = __builtin_amdgcn_cvt_pk_f32_fp8((int)w.y, false); o[3] = __builtin_amdgcn_cvt_pk_f32_fp8((int)w.y, true);
    o[4] = __builtin_amdgcn_cvt_pk_f32_fp8((int)w.z, false); o[5] = __builtin_amdgcn_cvt_pk_f32_fp8((int)w.z, true); o[6] = __builtin_amdgcn_cvt_pk_f32_fp8((int)w.w, false); o[7] = __builtin_amdgcn_cvt_pk_f32_fp8((int)w.w, true);
}
constexpr int EB = 8;
__device__ __forceinline__ void peer_token(Frame& F, int l, int row, int kb, int ke, f32x2 (&acc)[2][8]) {
    const int lane = F.lane;
    const unsigned char* UB = (const unsigned char*)(F.ws + WS_UB + (size_t)l * PE_NE * D); const unsigned char* VB = (const unsigned char*)(F.ws + WS_VB + (size_t)l * PE_NE * D);
    const float* SU = (const float*)(F.ws + WS_SU) + (size_t)l * PE_NE; const float* SV = (const float*)(F.ws + WS_SV) + (size_t)l * PE_NE;
    const bf16* H = (const bf16*)(F.ws + WS_H);
        const int* IDX = (const int*)(F.ws + WS_IDX) + (size_t)row * PE_SEL; const float* GT = (const float*)(F.ws + WS_GATE) + (size_t)row * PE_SEL;
        const int il = IDX[lane], ih = IDX[64 + lane]; const float gl = GT[lane], gh = GT[64 + lane];
        const float sul = SU[il], suh = SU[ih], svl = SV[il], svh = SV[ih];
        f32x2 hf[2][8];
#pragma unroll
        for (int j = 0; j < 2; ++j) { const v4u a = *(const v4u*)(H + (size_t)row * D + j * 1024 + lane * 16), b = *(const v4u*)(H + (size_t)row * D + j * 1024 + lane * 16 + 8);
            hf[j][0] = (f32x2){bf_lo(a.x), bf_hi(a.x)}; hf[j][1] = (f32x2){bf_lo(a.y), bf_hi(a.y)}; hf[j][2] = (f32x2){bf_lo(a.z), bf_hi(a.z)}; hf[j][3] = (f32x2){bf_lo(a.w), bf_hi(a.w)};
            hf[j][4] = (f32x2){bf_lo(b.x), bf_hi(b.x)}; hf[j][5] = (f32x2){bf_lo(b.y), bf_hi(b.y)}; hf[j][6] = (f32x2){bf_lo(b.z), bf_hi(b.z)}; hf[j][7] = (f32x2){bf_lo(b.w), bf_hi(b.w)}; }
        int dl = 0, dh = 0;
#pragma unroll 1
        for (int k0 = kb; k0 < ke; k0 += EB) { v4u w[EB][2];
#pragma unroll
            for (int q = 0; q < EB; ++q) { const int k = k0 + q; const int e = __builtin_amdgcn_readlane(k0 < 64 ? il : ih, k & 63); const unsigned char* ur = UB + (size_t)e * D + lane * 16;
                w[q][0] = *(const v4u*)ur; w[q][1] = *(const v4u*)(ur + 1024); }
#pragma unroll
            for (int q = 0; q < EB; ++q) { const int k = k0 + q; f32x2 p2 = {0.f, 0.f};
#pragma unroll
                for (int j = 0; j < 2; ++j) { f32x2 uf[8]; unpack16(w[q][j], uf);
#pragma unroll
                    for (int i = 0; i < 8; ++i) p2 = __builtin_elementwise_fma(uf[i], hf[j][i], p2); }
                const int tb = __builtin_bit_cast(int, wave_total(p2.x + p2.y));
                if (k0 < 64) dl = (lane == (k & 63)) ? tb : dl; else dh = (lane == (k & 63)) ? tb : dh; } }
        const float cl = gl * svl * gelu_erf(__builtin_bit_cast(float, dl) * sul), ch = gh * svh * gelu_erf(__builtin_bit_cast(float, dh) * suh);
#pragma unroll
        for (int j = 0; j < 2; ++j)
#pragma unroll
            for (int i = 0; i < 8; ++i) acc[j][i] = (f32x2){0.f, 0.f};
#pragma unroll 1
        for (int k0 = kb; k0 < ke; k0 += EB) { v4u w[EB][2];
#pragma unroll
            for (int q = 0; q < EB; ++q) { const int k = k0 + q; const int e = __builtin_amdgcn_readlane(k0 < 64 ? il : ih, k & 63); const unsigned char* vr = VB + (size_t)e * D + lane * 16;
                w[q][0] = *(const v4u*)vr; w[q][1] = *(const v4u*)(vr + 1024); }
#pragma unroll
            for (int q = 0; q < EB; ++q) { const int k = k0 + q; const float cf = __builtin_bit_cast(float, __builtin_amdgcn_readlane(__builtin_bit_cast(int, k0 < 64 ? cl : ch), k & 63)); const f32x2 cf2 = {cf, cf};
#pragma unroll
                for (int j = 0; j < 2; ++j) { f32x2 vf[8]; unpack16(w[q][j], vf);
#pragma unroll
                    for (int i = 0; i < 8; ++i) acc[j][i] = __builtin_elementwise_fma(vf[i], cf2, acc[j][i]); } } }
}
__device__ __forceinline__ void peer_finish(Frame& F, int l, int row, const f32x2 (&acc)[2][8], bool dry) {
    const int lane = F.lane;
    float* X = (float*)(F.ws + WS_X); bf16* H = (bf16*)(F.ws + WS_H); float* Xo = dry ? (float*)(F.ws + WS_LA) : X; bf16* Ho = dry ? (bf16*)(F.ws + WS_LB) : H; float* Oo = dry ? (float*)(F.ws + WS_LA) : (float*)F.out;
        const float* md = (const float*)(F.ws + WS_MOD) + ((size_t)l * 3 + mod_row(row)) * (6 * D);
        float z[32]; float s = 0.f;
#pragma unroll
        for (int j = 0; j < 2; ++j)
#pragma unroll
            for (int q = 0; q < 4; ++q) { const int e = j * 1024 + lane * 16 + q * 4; const f32x4 xv = *(const f32x4*)(X + (size_t)row * D + e), gv = *(const f32x4*)(md + 5 * D + e);
                z[j * 16 + q * 4 + 0] = ALPHA * xv.x + gv.x * acc[j][2 * q][0]; z[j * 16 + q * 4 + 1] = ALPHA * xv.y + gv.y * acc[j][2 * q][1]; z[j * 16 + q * 4 + 2] = ALPHA * xv.z + gv.z * acc[j][2 * q + 1][0]; z[j * 16 + q * 4 + 3] = ALPHA * xv.w + gv.w * acc[j][2 * q + 1][1]; }
#pragma unroll
        for (int i = 0; i < 32; ++i) s += z[i];
        const float mean = wave_sum(s) * (1.0f / D); float qv = 0.f;
#pragma unroll
        for (int i = 0; i < 32; ++i) { z[i] -= mean; qv += z[i] * z[i]; }
        const float rstd = __builtin_amdgcn_rsqf(wave_sum(qv) * (1.0f / D) + LN_EPS);
        const float* lg = gin(F.in[I_LN2G]) + (size_t)l * D; const float* lb = gin(F.in[I_LN2B]) + (size_t)l * D; const float* mn = (const float*)(F.ws + WS_MOD) + ((size_t)(l + 1 < DEPTH ? l + 1 : l) * 3 + mod_row(row)) * (6 * D);
#pragma unroll
        for (int j = 0; j < 2; ++j) { unsigned hw[8];
#pragma unroll
            for (int q = 0; q < 4; ++q) { const int e = j * 1024 + lane * 16 + q * 4; const f32x4 g4 = *(const f32x4*)(lg + e), b4 = *(const f32x4*)(lb + e);
                f32x4 o; o.x = z[j * 16 + q * 4 + 0] * rstd * g4.x + b4.x; o.y = z[j * 16 + q * 4 + 1] * rstd * g4.y + b4.y; o.z = z[j * 16 + q * 4 + 2] * rstd * g4.z + b4.z; o.w = z[j * 16 + q * 4 + 3] * rstd * g4.w + b4.w;
                if (l + 1 < DEPTH) { *(f32x4*)(Xo + (size_t)row * D + e) = o; const f32x4 s4 = *(const f32x4*)(mn + e), c4 = *(const f32x4*)(mn + D + e);
                    hw[2 * q] = pk2(o.x * (1.f + c4.x) + s4.x, o.y * (1.f + c4.y) + s4.y); hw[2 * q + 1] = pk2(o.z * (1.f + c4.z) + s4.z, o.w * (1.f + c4.w) + s4.w); }
                else *(f32x4*)(Oo + (size_t)row * D + e) = o; }
            if (l + 1 < DEPTH) { *(v4u*)(Ho + (size_t)row * D + j * 1024 + lane * 16) = (v4u){hw[0], hw[1], hw[2], hw[3]}; *(v4u*)(Ho + (size_t)row * D + j * 1024 + lane * 16 + 8) = (v4u){hw[4], hw[5], hw[6], hw[7]}; } }
}
__device__ __forceinline__ void peer_rows(Frame& F, int l, int nrows, bool dry = false) {
    const int gw = F.vcu * NWAVES + F.wave, NGW = F.G * NWAVES, lane = F.lane;
    for (int row = gw; row < NLAT; row += NGW) { f32x2 acc[2][8]; peer_token(F, l, row, 0, PE_SEL, acc); peer_finish(F, l, row, acc, dry); }
    if (nrows > NLAT) { LAS f32x2* PART = (LAS f32x2*)F.lds;
        for (int r2 = F.vcu * 2 + (F.wave >> 2); r2 < NCTX; r2 += F.G * 2) { const int row = NLAT + r2, part = F.wave & 3, slot = F.wave >> 2; f32x2 acc[2][8];
            peer_token(F, l, row, 32 * part, 32 * part + 32, acc);
            if (part) {
#pragma unroll
                for (int j = 0; j < 2; ++j)
#pragma unroll
                    for (int i = 0; i < 8; ++i) PART[((slot * 3 + part - 1) * 16 + j * 8 + i) * 64 + lane] = acc[j][i]; }
            __syncthreads();
            if (part == 0) {
#pragma unroll
                for (int p = 0; p < 3; ++p)
#pragma unroll
                    for (int j = 0; j < 2; ++j)
#pragma unroll
                        for (int i = 0; i < 8; ++i) acc[j][i] += PART[((slot * 3 + p) * 16 + j * 8 + i) * 64 + lane];
                peer_finish(F, l, row, acc, dry); }
            __syncthreads(); } }
}
#ifndef MK_PER_PHASE
#define MK_PER_PHASE 0
#endif
constexpr int NPH_PRO = 3, NPH_LAYER = 9, NPHASES = NPH_PRO + DEPTH * NPH_LAYER;
__global__ void __launch_bounds__(NTHR, 2) trunk_fwd(Args args) {
    extern __shared__ __attribute__((aligned(16))) unsigned char lds_raw[];
    Frame F0;
    F0.lds = (LAS unsigned char*)lds_raw;
    F0.tid = threadIdx.x; F0.lane = F0.tid & 63; F0.wave = __builtin_amdgcn_readfirstlane(F0.tid >> 6);
    F0.G = gridDim.x; { const int bx = blockIdx.x; F0.vcu = (F0.G % 8 == 0) ? (bx % 8) * (F0.G / 8) + bx / 8 : bx; }
    F0.in = args.in; F0.out = (GAS float*)args.out; F0.ws = (GAS unsigned char*)args.ws;
    volatile LAS unsigned* MISC = (volatile LAS unsigned*)(F0.lds + MISC_OFF);
    for (int u = F0.tid; u < (LDS_BYTES - LDSCTL_OFF) / 4; u += NTHR) ((LAS unsigned*)(F0.lds + LDSCTL_OFF))[u] = 0u;
    __syncthreads();
    const int lo = args.ph_lo, hi = args.ph_hi;
    XcdBarrier bar; bar.bar = (unsigned*)(F0.ws + WS_CTL) + CW_BAR; bar.x = 0; bar.st = nullptr;
    if (hi - lo > 1) bar = xcd_barrier_post((unsigned*)(F0.ws + WS_CTL) + CW_BAR, MISC + 8);
#ifndef PHMASK
#define PHMASK 0xfff
#endif
#define PHM(b) ((PHMASK >> (b)) & 1)
#ifndef PHREP
#define PHREP 0
#endif
#define NREP(b) (1 + ((PHREP >> (b)) & 1))
#define IN(k) (lo <= (k) && (k) < hi)
#define LAUNDER() Frame F = F0; int bx_ = blockIdx.x; { int ws_ = F0.wave; asm volatile("" : "+s"(ws_)); int ln_; asm volatile("v_mbcnt_lo_u32_b32 %0, -1, 0\n\tv_mbcnt_hi_u32_b32 %0, -1, %0" : "=v"(ln_)); F.wave = ws_; F.lane = ln_; F.tid = ws_ * 64 + ln_; \
    GAS unsigned char* w_ = F0.ws; asm volatile("" : "+s"(w_)); F.ws = w_; int v_ = F0.vcu; asm volatile("" : "+s"(v_)); F.vcu = v_; int g_ = F0.G; asm volatile("" : "+s"(g_)); F.G = g_; \
    GAS float* o_ = F0.out; asm volatile("" : "+s"(o_)); F.out = o_; asm volatile("" : "+s"(bx_)); \
    unsigned l_ = (unsigned)(size_t)F0.lds; asm volatile("" : "+v"(l_)); F.lds = (LAS unsigned char*)(size_t)l_; }
#define SEAM(k) do { if (IN(k) && IN((k) + 1)) xcd_barrier(bar); } while (0)

    if (PHM(0) && IN(0)) for (int rep_ = 0; rep_ < NREP(0); ++rep_) { LAUNDER(); p0_prologue(F); } SEAM(0);
    if (PHM(1) && IN(1)) { LAUNDER(); p0b_mod_reduce(F); } SEAM(1);
    if (PHM(2) && IN(2)) { LAUNDER(); modulate_rows(F, 0, 0, MTOT); } SEAM(2);

#pragma unroll 1
    for (int l = 0; l < DEPTH; ++l) {
        const int pb = NPH_PRO + l * NPH_LAYER;
        const int mrows = (l + 1 < DEPTH) ? MTOT : NLAT;
        if (PHM(3) && IN(pb + 0)) for (int rep_ = 0; rep_ < NREP(3); ++rep_) { LAUNDER(); pg8::Gemm g{(const pg8::bf16_t*)(F.ws + WS_H), (const pg8::bf16_t*)(F.ws + WS_WIN) + (size_t)l * IN_PAD * D, MTOT, IN_PAD, D, D};
            pg8::StaticOrder S; S.init(MTOT, IN_PAD, F.G, bx_); pg8::EpiBf16<0> E{(pg8::bf16_t*)(F.ws + WS_P), IN_PAD, nullptr, 0, 0};
            pg8::gemm_phase<pg8::EpiBf16<0>, pg8::StaticOrder, false>(F.lds, g, S, E, nullptr, F.tid); }
        SEAM(pb + 0);
        if (PHM(4) && IN(pb + 1)) for (int rep_ = 0; rep_ < NREP(4); ++rep_) { LAUNDER(); for (int r2 = 0; r2 < NREP(12); ++r2) for (int u = F.vcu; u < NTILE * NH; u += F.G) lru_prep_unit(F, l, u >> 4, u & 15); asm volatile("" ::: "memory"); for (int r2 = 0; r2 < NREP(13); ++r2) { int cur_hd = -1;
                for (int v = F.vcu; v < 2 * NTILE * NH; v += F.G) { const int hh_ = (v >> 1) & 15, d_ = v & 1;
                    if (hh_ * 2 + d_ != cur_hd) { cur_hd = hh_ * 2 + d_; __syncthreads(); LAS float* MUS = (LAS float*)(F.lds + 125184); const float* mu = gin(F.in[I_MU]) + (size_t)l * 2 * RW_COLS;
                        for (int i = F.tid; i < 5 * 2 * 64; i += NTHR) { const int g = i >> 7, wh = (i >> 6) & 1, col = i & 63; const int rc = g < 3 ? g * RWW + hh_ * 64 : 3 * RWW + (g - 3) * 128 + d_ * 64; MUS[i] = mu[(size_t)wh * RW_COLS + rc + col]; }
                        __syncthreads(); }
                    rwkv_chunk_prep(F, l, v >> 5, hh_, d_); } } }
        SEAM(pb + 1);
        if (PHM(5) && IN(pb + 2)) for (int rep_ = 0; rep_ < NREP(5); ++rep_) { LAUNDER(); for (int u = F.vcu; u < 256; u += F.G) { if (u < 32 && F.wave >= 2 && F.wave < 4) lru_scan(F, u * 128 + F.tid - 128); rwkv_chain_chunks(F, u); } }
        SEAM(pb + 2);
        if (PHM(6) && IN(pb + 3)) for (int rep_ = 0; rep_ < NREP(6); ++rep_) { LAUNDER(); for (int u = F.vcu; u < 4 * NTILE; u += F.G) merge_unit(F, l, u); }
        SEAM(pb + 3);
        if (PHM(7) && IN(pb + 4)) for (int rep_ = 0; rep_ < NREP(7); ++rep_) { LAUNDER(); pg8::Gemm g{(const pg8::bf16_t*)(F.ws + WS_H), (const pg8::bf16_t*)(F.ws + WS_WOUT) + (size_t)l * D * D, mrows, D, D, D};
            pg8::StaticOrder S; S.init(mrows, D, F.G, bx_); pg8::EpiBf16<0> E{(pg8::bf16_t*)(F.ws + WS_O), D, nullptr, 0, 0};
            pg8::gemm_phase<pg8::EpiBf16<0>, pg8::StaticOrder, false>(F.lds, g, S, E, nullptr, F.tid); }
        SEAM(pb + 4);
        if (PHM(8) && IN(pb + 5)) { LAUNDER(); if (NREP(8) > 1) ln1_rows(F, l, mrows, true); ln1_rows(F, l, mrows); }
        SEAM(pb + 5);
        if (PHM(9) && IN(pb + 6)) for (int rep_ = 0; rep_ < NREP(9); ++rep_) { LAUNDER(); pg8::Gemm g{(const pg8::bf16_t*)(F.ws + WS_H), (const pg8::bf16_t*)(F.ws + WS_WQ) + (size_t)l * D * D, mrows, D, D, D};
            pg8::StaticOrder S; S.init(mrows, D, F.G, bx_); pg8::EpiBf16<0> E{(pg8::bf16_t*)(F.ws + WS_QP), D, nullptr, 0, 0};
            pg8::gemm_phase<pg8::EpiBf16<0>, pg8::StaticOrder, false>(F.lds, g, S, E, nullptr, F.tid); }
        SEAM(pb + 6);
        if (PHM(10) && IN(pb + 7)) for (int rep_ = 0; rep_ < NREP(10); ++rep_) { LAUNDER(); for (int u = F.vcu; u < (mrows / 64) * PE_H; u += F.G) peer_topk_unit(F, l, u >> 3, u & 7); }
        SEAM(pb + 7);
        if (PHM(11) && IN(pb + 8)) { LAUNDER(); if (NREP(11) > 1) peer_rows(F, l, mrows, true); peer_rows(F, l, mrows); }
        if (l + 1 < DEPTH) SEAM(pb + 8);
    }
#undef IN
#undef SEAM
}

extern "C" void kernel_launch(void* const* d_in, const int* in_sizes, int n_in, void* d_out, int out_size, void* d_ws, size_t ws_size, hipStream_t stream) {
    static int grid = 0;
    if (grid == 0) {
        if (n_in != N_IN || out_size != NLAT * D || ws_size < WS_END) { fprintf(stderr, "kernel_launch: unexpected shapes (n_in %d, out %d, ws %zu < %zu)\n", n_in, out_size, ws_size, (size_t)WS_END); grid = -1; return; }
        int dev = 0, cus = 0, per_cu = 0;
        if (hipGetDevice(&dev) != hipSuccess || hipDeviceGetAttribute(&cus, hipDeviceAttributeMultiprocessorCount, dev) != hipSuccess) { grid = -1; return; }
        if (hipFuncSetAttribute((const void*)trunk_fwd, hipFuncAttributeMaxDynamicSharedMemorySize, LDS_BYTES) != hipSuccess) { fprintf(stderr, "kernel_launch: hipFuncSetAttribute failed\n"); grid = -1; return; }
        if (hipOccupancyMaxActiveBlocksPerMultiprocessor(&per_cu, (const void*)trunk_fwd, NTHR, LDS_BYTES) != hipSuccess || per_cu < 1) fprintf(stderr, "kernel_launch: occupancy query reports %d\n", per_cu);
        (void)hipGetLastError();
        grid = cus;
    }
    if (grid < 0) return;
    (void)hipMemsetAsync((char*)d_ws + WS_CTL, 0, CTL_ZERO_BYTES, stream);
    Args a{};
    for (int i = 0; i < N_IN; ++i) a.in[i] = (const float*)d_in[i];
    a.out = (float*)d_out; a.ws = (unsigned char*)d_ws;
#if MK_PER_PHASE
    for (int ph = 0; ph < NPHASES; ++ph) { a.ph_lo = ph; a.ph_hi = ph + 1; hipLaunchKernelGGL(trunk_fwd, dim3(grid), dim3(NTHR), LDS_BYTES, stream, a); }
#else
    a.ph_lo = 0; a.ph_hi = NPHASES;
    hipLaunchKernelGGL(trunk_fwd, dim3(grid), dim3(NTHR), LDS_BYTES, stream, a);
#endif
    const hipError_t le = hipPeekAtLastError();
    if (le != hipSuccess) fprintf(stderr, "kernel_launch: launch failed: %s\n", hipGetErrorName(le));
}
```

```cpp
#include <hip/hip_runtime.h>
#include <cstdio>
#include <cstdint>

constexpr int D = 2048, NB = 2, SEQ = 4096, DEPTH = 4, CTXL = 256;
constexpr int NLAT = NB * SEQ, NCTX = NB * CTXL, MTOT = NLAT + NCTX;
constexpr int LRW = 1024, RWW = 1024, NH = 16, HD = 64;
constexpr int RW_COLS = 3488, IN_COLS = 5536, IN_PAD = 5632;
constexpr int PE_H = 8, PE_K = 128, PE_DQ = 256, PE_TOP = 16, PE_NE = 16384, PE_SEL = PE_H * PE_TOP;
constexpr int NTILE = MTOT / 64;
constexpr float ALPHA = 1.681792830507429f;
constexpr float LN_EPS = 1e-5f, GN_EPS = 64e-5f;
constexpr int KSPLIT = 16;

enum { I_X = 0, I_C, I_CTX, I_CCTX, I_ADAW, I_ADAB, I_WIN, I_CONVW, I_CONVB, I_WA, I_BA, I_WX, I_BX, I_LAM, I_MU, I_W0, I_W2, I_A0, I_A2, I_G2,
       I_KK, I_KA, I_RK, I_GNG, I_GNB, I_WOUT, I_LN1G, I_LN1B, I_WQ, I_SUBK, I_U, I_V, I_LN2G, I_LN2B, N_IN };

constexpr size_t MiB = 1u << 20;
constexpr size_t al(size_t x) { return (x + MiB - 1) / MiB * MiB; }
constexpr size_t WS_CTL = 0, CTL_ZERO_BYTES = 1 * MiB;
constexpr size_t WS_MOD   = WS_CTL + CTL_ZERO_BYTES;
constexpr size_t WS_MODP  = al(WS_MOD + (size_t)DEPTH * 3 * 6 * D * 4);
constexpr size_t WS_WIN   = al(WS_MODP + (size_t)KSPLIT * DEPTH * 3 * 6 * D * 4);
constexpr size_t WS_WOUT  = al(WS_WIN + (size_t)DEPTH * IN_PAD * D * 2);
constexpr size_t WS_WQ    = al(WS_WOUT + (size_t)DEPTH * D * D * 2);
constexpr size_t WS_SUBK  = al(WS_WQ + (size_t)DEPTH * D * D * 2);
constexpr size_t WS_WLRU  = al(WS_SUBK + (size_t)DEPTH * 8 * 2 * 128 * 128 * 2);
constexpr size_t WS_W2T   = al(WS_WLRU + (size_t)DEPTH * 2 * 2 * 16 * 64 * 64 * 2);
constexpr size_t WS_A2T   = al(WS_W2T + (size_t)DEPTH * 2 * 1024 * 64 * 2);
constexpr size_t WS_G2T   = al(WS_A2T + (size_t)DEPTH * 2 * 1024 * 64 * 2);
constexpr size_t WS_UB    = al(WS_G2T + (size_t)DEPTH * 1024 * 160 * 2);
constexpr size_t WS_VB    = al(WS_UB + (size_t)DEPTH * PE_NE * D);
constexpr size_t WS_SU    = al(WS_VB + (size_t)DEPTH * PE_NE * D);
constexpr size_t WS_SV    = al(WS_SU + (size_t)DEPTH * PE_NE * 4);
constexpr size_t WS_X     = al(WS_SV + (size_t)DEPTH * PE_NE * 4);
constexpr size_t WS_H     = al(WS_X + (size_t)MTOT * D * 4);
constexpr size_t WS_P     = al(WS_H + (size_t)MTOT * D * 2);
constexpr size_t WS_LA    = al(WS_P + (size_t)MTOT * IN_PAD * 4);
constexpr size_t WS_LB    = al(WS_LA + (size_t)2 * MTOT * LRW * 4);
constexpr size_t WS_LAGG  = al(WS_LB + (size_t)2 * MTOT * LRW * 4);
constexpr size_t WS_LHIN  = al(WS_LAGG + (size_t)4 * NTILE * LRW * 4);
constexpr int KSL = 8;
constexpr size_t WS_SLAB  = al(WS_LHIN + (size_t)2 * NTILE * LRW * 4);
constexpr size_t WS_YL    = al(WS_SLAB + (size_t)2 * KSL * NCTX * D * 4);
constexpr int NUNIT = NTILE * NH * 2;
constexpr size_t WS_RV    = al(WS_YL + 4096);
constexpr size_t WS_QM    = al(WS_RV + (size_t)MTOT * RWW * 4);
constexpr size_t WS_PHI   = al(WS_QM + (size_t)NUNIT * 4096 * 2);
constexpr size_t WS_Y0F   = al(WS_PHI + (size_t)NUNIT * 4096 * 2);
constexpr size_t WS_PSF   = al(WS_Y0F + (size_t)NUNIT * 4096 * 2);
constexpr size_t WS_YR    = al(WS_PSF + (size_t)NUNIT * 4096 * 2);
constexpr size_t WS_BETA  = al(WS_YR + (size_t)2 * MTOT * RWW * 4);
constexpr size_t WS_IDX   = al(WS_BETA + (size_t)2 * MTOT * NH * 4);
constexpr size_t WS_GATE  = al(WS_IDX + (size_t)MTOT * PE_SEL * 4);
constexpr size_t WS_END   = al(WS_GATE + (size_t)MTOT * PE_SEL * 4);
constexpr size_t WS_O = WS_P;
constexpr size_t WS_QP = WS_P + (size_t)MTOT * D * 4;
static_assert(WS_QP + (size_t)MTOT * D * 4 <= WS_LA, "O/QP overlay inside P");

constexpr int CW_BAR = 4096;

constexpr int RING_BYTES = 131072;
constexpr int LDSCTL_OFF = RING_BYTES, MISC_OFF = LDSCTL_OFF + 320;
constexpr int LDS_BYTES = 147456;
constexpr int NWAVES = 8, NTHR = 512;

#define GAS __attribute__((address_space(1)))
#define LAS __attribute__((address_space(3)))
typedef unsigned short bf16;
typedef unsigned v4u __attribute__((ext_vector_type(4)));
typedef unsigned v2u __attribute__((ext_vector_type(2)));
typedef float f32x4 __attribute__((ext_vector_type(4)));
typedef float f32x2 __attribute__((ext_vector_type(2)));
typedef short bf16x8 __attribute__((ext_vector_type(8)));
typedef unsigned v6u __attribute__((ext_vector_type(6)));
typedef unsigned v16u __attribute__((ext_vector_type(16)));
typedef float v32f __attribute__((ext_vector_type(32)));
typedef __bf16 v32bf __attribute__((ext_vector_type(32)));
constexpr int EROW = 1536;
#define RLX_AGENT __ATOMIC_RELAXED, __HIP_MEMORY_SCOPE_AGENT
#define LDS_WAIT() asm volatile("s_waitcnt lgkmcnt(0)" ::: "memory")
#define VM_WAIT() asm volatile("s_waitcnt vmcnt(0)" ::: "memory")

__device__ __forceinline__ const float* gin(const float* p) { return (const float*)(const GAS float*)p; }
__device__ __forceinline__ unsigned f2bf(float f) { unsigned u = __builtin_bit_cast(unsigned, f); return (u + 0x7fffu + ((u >> 16) & 1u)) >> 16; }
typedef __bf16 bf16x2t __attribute__((ext_vector_type(2)));
__device__ __forceinline__ unsigned pk2(float lo, float hi) { return __builtin_bit_cast(unsigned, __builtin_convertvector((f32x2){lo, hi}, bf16x2t)); }
__device__ __forceinline__ float bf_lo(unsigned w) { return __builtin_bit_cast(float, w << 16); }
__device__ __forceinline__ float bf_hi(unsigned w) { return __builtin_bit_cast(float, w & 0xffff0000u); }
__device__ __forceinline__ float fexp(float x) { return __builtin_amdgcn_exp2f(x * 1.4426950408889634f); }
__device__ __forceinline__ float fsigmoid(float x) { return __builtin_amdgcn_rcpf(1.0f + fexp(-x)); }
__device__ __forceinline__ float fsoftplus(float x) { return fmaxf(x, 0.f) + 0.6931471805599453f * __builtin_amdgcn_logf(1.0f + fexp(-fabsf(x))); }
__device__ __forceinline__ float ftanh(float x) { const float e = fexp(2.0f * x); return 1.0f - 2.0f * __builtin_amdgcn_rcpf(e + 1.0f); }
__device__ __forceinline__ float gelu_tanh(float x) { return 0.5f * x * (1.0f + ftanh(0.7978845608028654f * (x + 0.044715f * x * x * x))); }
__device__ __forceinline__ float gelu_erf(float v) {
    const float av = fabsf(v), t = __builtin_amdgcn_rcpf(av * 0.2316418882f + 1.0f);
    float q = t * 0.5307027145f + (-0.7265760135f); q = q * t + 0.7107068705f; q = q * t + (-0.142248368f); q = q * t + 0.127414796f; q = q * t;
    const float e = __builtin_amdgcn_exp2f((v * v) * (-0.72134752044f));
    const float m = v * (q * e);
    return v < 0.f ? m : v - m;
}
template <int CTRL> __device__ __forceinline__ float dpp_f(float v) { return __builtin_bit_cast(float, __builtin_amdgcn_update_dpp(0, __builtin_bit_cast(int, v), CTRL, 0xf, 0xf, true)); }
__device__ __forceinline__ float red8(float v) { v += dpp_f<0xB1>(v); v += dpp_f<0x4E>(v); v += dpp_f<0x141>(v); return v; }
__device__ __forceinline__ float red16(float v) { v = red8(v); v += dpp_f<0x140>(v); return v; }
__device__ __forceinline__ float wave_total(float v) {
    v = red16(v);
    v += __builtin_bit_cast(float, __builtin_amdgcn_update_dpp(0, __builtin_bit_cast(int, v), 0x142, 0xa, 0xf, false));
    v += __builtin_bit_cast(float, __builtin_amdgcn_update_dpp(0, __builtin_bit_cast(int, v), 0x143, 0xc, 0xf, false));
    return __builtin_bit_cast(float, __builtin_amdgcn_readlane(__builtin_bit_cast(int, v), 63));
}
__device__ __forceinline__ float wave_sum(float v) { return wave_total(v); }
__device__ __forceinline__ float wave_max(float v) {
    v = fmaxf(v, dpp_f<0xB1>(v)); v = fmaxf(v, dpp_f<0x4E>(v)); v = fmaxf(v, dpp_f<0x141>(v)); v = fmaxf(v, dpp_f<0x140>(v));
    const float a = __builtin_bit_cast(float, __builtin_amdgcn_readlane(__builtin_bit_cast(int, v), 0)), b = __builtin_bit_cast(float, __builtin_amdgcn_readlane(__builtin_bit_cast(int, v), 16));
    const float c = __builtin_bit_cast(float, __builtin_amdgcn_readlane(__builtin_bit_cast(int, v), 32)), d = __builtin_bit_cast(float, __builtin_amdgcn_readlane(__builtin_bit_cast(int, v), 48));
    return fmaxf(fmaxf(a, b), fmaxf(c, d));
}
#define EBU_ 4
#define XB_TMO      128
#define XB_XCNT(j)  (256  + 64 * (j))
#define XB_XSUB(j)  (1280 + 64 * (j))
#define XB_XGEN(j)  (2304 + 64 * (j))
#define XB_TOP      3328
#define XB_TOPGEN   3392
#define XCD_BAR_WORDS 3456
#define XB_SPIN_CAP (1u << 18)

__device__ __forceinline__ unsigned xb_ld(unsigned* p)              { return __hip_atomic_load(p, __ATOMIC_RELAXED, __HIP_MEMORY_SCOPE_AGENT); }
__device__ __forceinline__ unsigned xb_add(unsigned* p, unsigned v) { return __hip_atomic_fetch_add(p, v, __ATOMIC_RELAXED, __HIP_MEMORY_SCOPE_AGENT); }
__device__ __forceinline__ unsigned xb_xcc_id() { return (unsigned)__builtin_amdgcn_s_getreg((3 << 11) | 20) & 0xFu; }
#define XB_SPIN(cond, bar) do { unsigned _sp = 0; while (cond) { __builtin_amdgcn_s_sleep(1); \
    if ((++_sp & 255u) == 0u) { if (xb_ld(&(bar)[XB_TMO])) break; if (_sp > XB_SPIN_CAP) { atomicAdd(&(bar)[XB_TMO], 1u); break; } } } } while (0)

struct XcdBarrier {
    unsigned* bar; unsigned x;
    volatile LAS unsigned* st;
};

__device__ __forceinline__ XcdBarrier xcd_barrier_post(unsigned* bar, volatile LAS unsigned* st) {
    XcdBarrier b; b.bar = bar; b.x = xb_xcc_id(); b.st = st;
    if (threadIdx.x == 0) (void)xb_add(&bar[XB_XCNT(b.x)], 1u);
    return b;
}
__device__ __forceinline__ void xcd_barrier_complete(unsigned* bar, unsigned x, unsigned& nloc, unsigned& nx) {
    const unsigned G = gridDim.x * gridDim.y * gridDim.z;
    unsigned sum, cnt, mine, sp = 0u;
    for (;;) {
        sum = 0u; cnt = 0u; mine = 0u;
#pragma unroll
        for (unsigned j = 0; j < 16; ++j) { const unsigned c = xb_ld(&bar[XB_XCNT(j)]); sum += c; cnt += (c > 0u) ? 1u : 0u; }
        if (sum == G) { mine = xb_ld(&bar[XB_XCNT(x)]); break; }
        __builtin_amdgcn_s_sleep(1);
        if ((++sp & 255u) == 0u) { if (xb_ld(&bar[XB_TMO])) break; if (sp > XB_SPIN_CAP) { atomicAdd(&bar[XB_TMO], 1u); break; } }
    }
    nloc = mine > 0u ? mine : 1u; nx = cnt > 0u ? cnt : 1u;
}

__device__ __forceinline__ void xcd_barrier(const XcdBarrier& b) {
    asm volatile("s_waitcnt vmcnt(0)" ::: "memory");
    __syncthreads();
    if (threadIdx.x == 0) {
        unsigned* bar = b.bar;
        __builtin_amdgcn_s_waitcnt(0);
        unsigned nloc = b.st[0], nx = b.st[1];
        if (nloc == 0u) { xcd_barrier_complete(bar, b.x, nloc, nx); b.st[0] = nloc; b.st[1] = nx; }
        const unsigned old = xb_add(&bar[XB_XSUB(b.x)], 1u);
        const unsigned gen = old / nloc;
        if (old + 1u == (gen + 1u) * nloc) {
            __builtin_amdgcn_fence(__ATOMIC_RELEASE, "agent");
            asm volatile("s_waitcnt vmcnt(0)" ::: "memory");
            const unsigned og = xb_add(&bar[XB_TOP], 1u);
            const unsigned tg = og / nx;
            if (og + 1u == (tg + 1u) * nx) xb_add(&bar[XB_TOPGEN], 1u);
            else XB_SPIN(xb_ld(&bar[XB_TOPGEN]) == tg, bar);
            __builtin_amdgcn_fence(__ATOMIC_ACQUIRE, "agent");
            xb_add(&bar[XB_XGEN(b.x)], 1u);
            asm volatile("s_waitcnt vmcnt(0)" ::: "memory");
        } else {
            XB_SPIN(xb_ld(&bar[XB_XGEN(b.x)]) == gen, bar);
            __builtin_amdgcn_fence(__ATOMIC_ACQUIRE, "agent");
            asm volatile("s_waitcnt vmcnt(0)" ::: "memory");
        }
    }
    __syncthreads();
}
namespace pg8 {
#define PG8_LAS __attribute__((address_space(3)))
typedef unsigned short bf16_t;
typedef short bf16x8 __attribute__((ext_vector_type(8)));
typedef float f32x4 __attribute__((ext_vector_type(4)));
typedef unsigned u32x4 __attribute__((ext_vector_type(4)));
constexpr int BM = 256, BK = 64, HALF = 128, HTB = HALF * BK * 2  , STAGE_BYTES = 8 * HTB, NXCD = 8, WGM = 8;

__host__ __device__ __forceinline__ int lds_byte(int r, int c) { const int st = (r >> 4) * 2 + (c >> 5), rr = r & 15, cc = c & 31, ob = rr * 64 + cc * 2; return st * 1024 + (ob ^ (((ob >> 9) & 1) << 5)); }
__host__ __device__ __forceinline__ void stage_rc(int b, int& R, int& C) { const int st = b / 1024, sb = b % 1024, swz = sb ^ (((sb >> 9) & 1) << 5); R = (st >> 1) * 16 + swz / 64; C = (st & 1) * 32 + (swz % 64) / 2; }
__host__ __device__ __forceinline__ int perm32(int rho) { const int n = rho >> 4, i = rho & 15; return 8 * (i >> 2) + 4 * n + (i & 3); }

struct Unit { int pm, pn, kofs = 0, slab = 0; };
struct Gemm { const bf16_t* A; const bf16_t* Bt; int M, N, K, ld; };

struct StaticOrder {
    int nM, nN, nwg, G, c;
    __host__ __device__ void init(int M, int N, int G_, int c_) { nM = M / BM; nN = N / BM; nwg = nM * nN; G = G_; c = c_; }
    __host__ __device__ bool next(int i, Unit& u) const {
        const long L = (long)i * G + c; if (L >= nwg) return false;
        int wgid = (int)L; { const int q = nwg / NXCD, r = nwg % NXCD, xcd = wgid % NXCD, off = wgid / NXCD; wgid = (xcd < r ? xcd * (q + 1) : r * (q + 1) + (xcd - r) * q) + off; }
        const int nig = WGM * nN, gid = wgid / nig, fm = gid * WGM, gsz = (nM - fm) < WGM ? (nM - fm) : WGM;
        u.pm = fm + ((wgid % nig) % gsz); u.pn = (wgid % nig) / gsz; return true;
    }
    __device__ __forceinline__ void a_ready(const Unit&) const {}
    __device__ __forceinline__ void done(const Unit&) const {}
};
struct SplitKOrder {
    int nM, nN, nS, klen, G, c;
    __host__ __device__ void init(int M, int N, int nS_, int klen_, int G_, int c_) { nM = M / BM; nN = N / BM; nS = nS_; klen = klen_; G = G_; c = c_; }
    __host__ __device__ bool next(int i, Unit& u) const { const long L = (long)i * G + c; if (L >= (long)nM * nN * nS) return false; const int l = (int)L; u.pm = l % nM; u.pn = (l / nM) % nN; const int ks = l / (nM * nN); u.kofs = ks * klen; u.slab = ks; return true; }
    __device__ __forceinline__ void a_ready(const Unit&) const {}
    __device__ __forceinline__ void done(const Unit&) const {}
};
struct CountedOrder : StaticOrder {
    const unsigned* ready; unsigned need; unsigned* tmo;
    __device__ __forceinline__ void a_ready(const Unit& u) const {
        if (threadIdx.x < 64) {
            const unsigned long long t0 = __builtin_amdgcn_s_memrealtime(); unsigned polls = 0;
            while ((unsigned)__builtin_amdgcn_readfirstlane(__hip_atomic_load(ready + 64 * u.pm, __ATOMIC_RELAXED, __HIP_MEMORY_SCOPE_AGENT)) < need) {
                if ((++polls & 255u) == 0u && __builtin_amdgcn_readfirstlane(__hip_atomic_load(tmo, __ATOMIC_RELAXED, __HIP_MEMORY_SCOPE_AGENT)) != 0u) break;
                if (__builtin_amdgcn_s_memrealtime() - t0 > 2000000ull) {
                    if (threadIdx.x == 0) { unsigned expect = 0u; __hip_atomic_compare_exchange_strong(tmo + 1, &expect, 0x600u | (unsigned)(u.pm & 0xff), __ATOMIC_RELAXED, __ATOMIC_RELAXED, __HIP_MEMORY_SCOPE_AGENT); __hip_atomic_store(tmo, 1u, __ATOMIC_RELAXED, __HIP_MEMORY_SCOPE_AGENT); }
                    break; }
                __builtin_amdgcn_s_sleep(2); }
            __builtin_amdgcn_fence(__ATOMIC_ACQUIRE, "agent");
            asm volatile("s_waitcnt vmcnt(0)" ::: "memory");
        }
#if !defined(BROKEN_HOOK_NO_BARRIER)
        asm volatile("" ::: "memory"); __builtin_amdgcn_s_barrier(); asm volatile("" ::: "memory");
#endif
    }
};

__device__ __forceinline__ unsigned cvt_pk_bf16(float lo, float hi) { unsigned r; asm volatile("v_cvt_pk_bf16_f32 %0, %1, %2" : "=v"(r) : "v"(lo), "v"(hi)); return r; }
typedef float f32x2 __attribute__((ext_vector_type(2)));
__device__ __forceinline__ f32x2 gelu_pk(f32x2 v) {
    const f32x2 av = __builtin_elementwise_abs(v), d = av * 0.2316418882f + 1.0f;
    f32x2 t; t.x = __builtin_amdgcn_rcpf(d.x); t.y = __builtin_amdgcn_rcpf(d.y);
    f32x2 q = t * 0.5307027145f + (-0.7265760135f); q = q * t + 0.7107068705f; q = q * t + (-0.142248368f); q = q * t + 0.127414796f; q = q * t;
    const f32x2 s = (v * v) * (-0.72134752044f);
    f32x2 e; e.x = __builtin_amdgcn_exp2f(s.x); e.y = __builtin_amdgcn_exp2f(s.y);
    const f32x2 m = v * (q * e), r = v - m;
    f32x2 o; o.x = v.x < 0.f ? m.x : r.x; o.y = v.y < 0.f ? m.y : r.y; return o;
}

struct EpiF32 {
    static constexpr bool PERM = false, AFTER_DRAIN = false;
    float* C; int ldc; const float* bias; size_t slab_stride = 0;
    __device__ __forceinline__ void operator()(const f32x4 (&acc)[2][2][4][2], const Unit& u, int wr, int wc, int fr, int fq) const {
        const int row0 = u.pm * BM + wr * 64 + fr, col0 = u.pn * BM + wc * 32 + 4 * fq; float* const Cb = C + (size_t)u.slab * slab_stride;
        f32x4 bv[2][2];
#pragma unroll
        for (int bj = 0; bj < 2; ++bj)
#pragma unroll
            for (int n = 0; n < 2; ++n) bv[bj][n] = bias ? *(const f32x4*)(bias + col0 + bj * HALF + n * 16) : (f32x4){0.f, 0.f, 0.f, 0.f};
#pragma unroll
        for (int ai = 0; ai < 2; ++ai)
#pragma unroll
            for (int m = 0; m < 4; ++m) { float* rowp = Cb + (size_t)(row0 + ai * HALF + m * 16) * ldc + col0;
#pragma unroll
                for (int bj = 0; bj < 2; ++bj)
#pragma unroll
                    for (int n = 0; n < 2; ++n) *(f32x4*)(rowp + bj * HALF + n * 16) = acc[ai][bj][m][n] + bv[bj][n]; }
    }
};
template <int ACT  > struct EpiBf16 {
    static constexpr bool PERM = true, AFTER_DRAIN = false;
    bf16_t* O; int ldc; const float* bias; int split_cols; size_t split_stride;
    __device__ __forceinline__ void operator()(const f32x4 (&acc)[2][2][4][2], const Unit& u, int wr, int wc, int fr, int fq) const {
        const int row0 = u.pm * BM + wr * 64 + fr; int colt = u.pn * BM; bf16_t* base = O;
        if (split_cols) { const int t = colt / split_cols; base += (size_t)t * split_stride; colt -= t * split_cols; }
        const int col0 = colt + wc * 32 + 8 * fq, bcol0 = u.pn * BM + wc * 32 + 8 * fq;
        f32x4 bv[2][2];
#pragma unroll
        for (int bj = 0; bj < 2; ++bj)
#pragma unroll
            for (int n = 0; n < 2; ++n) bv[bj][n] = bias ? *(const f32x4*)(bias + bcol0 + bj * HALF + 4 * n) : (f32x4){0.f, 0.f, 0.f, 0.f};
#pragma unroll
        for (int ai = 0; ai < 2; ++ai)
#pragma unroll
            for (int m = 0; m < 4; ++m) { bf16_t* rowp = base + (size_t)(row0 + ai * HALF + m * 16) * ldc + col0;
#pragma unroll
                for (int bj = 0; bj < 2; ++bj) { f32x4 v0 = acc[ai][bj][m][0] + bv[bj][0], v1 = acc[ai][bj][m][1] + bv[bj][1];
                    if (ACT == 1) { f32x2 a = gelu_pk((f32x2){v0[0], v0[1]}), b = gelu_pk((f32x2){v0[2], v0[3]}), c = gelu_pk((f32x2){v1[0], v1[1]}), d = gelu_pk((f32x2){v1[2], v1[3]});
                        v0 = (f32x4){a.x, a.y, b.x, b.y}; v1 = (f32x4){c.x, c.y, d.x, d.y}; }
                    if (ACT == 2) {
#pragma unroll
                        for (int j = 0; j < 4; ++j) { v0[j] = 0.5f * v0[j] * (1.0f + erff(v0[j] * 0.70710678f)); v1[j] = 0.5f * v1[j] * (1.0f + erff(v1[j] * 0.70710678f)); } }
                    u32x4 w; w.x = cvt_pk_bf16(v0[0], v0[1]); w.y = cvt_pk_bf16(v0[2], v0[3]); w.z = cvt_pk_bf16(v1[0], v1[1]); w.w = cvt_pk_bf16(v1[2], v1[3]);
                    *(u32x4*)(rowp + bj * HALF) = w; } }
    }
};
template <class Epi, class Sched, bool STAMP = false>
__device__ __forceinline__ void gemm_phase(PG8_LAS unsigned char* lds, const Gemm g, const Sched& S, const Epi& E, unsigned long long* stamps, const int tid) {
    const int  wid = __builtin_amdgcn_readfirstlane(tid >> 6), lane = tid & 63, wr = wid >> 2, wc = wid & 3, fr = lane & 15, fq = lane >> 4;
    const int K = g.ld, nt = g.K / BK;
    int ts_lo = 0, ts_hi = 0, nts = 0; const unsigned long long rt_entry = STAMP ? (unsigned long long)wall_clock64() : 0ull;
#define PG8_STAMP() do { if (STAMP && wid == 0 && nts < 64) { const unsigned long long _c = (unsigned long long)clock64(); \
        ts_lo = (lane == nts) ? (int)(unsigned)_c : ts_lo; ts_hi = (lane == nts) ? (int)(unsigned)(_c >> 32) : ts_hi; ++nts; } } while (0)
    PG8_STAMP();
    unsigned voffA[2], voffB[2];
#pragma unroll
    for (int i = 0; i < 2; ++i) { int R, C; stage_rc(tid * 16 + i * 8192, R, C); const int Rb = Epi::PERM ? ((R & ~31) + perm32(R & 31)) : R;
        voffA[i] = (unsigned)(R * K + C) * 2u; voffB[i] = (unsigned)(Rb * K + C) * 2u; }
    const size_t kstep = (size_t)(BK * 2);
    const size_t hstep = (size_t)HALF * K * 2;
    const size_t tstep = 2 * hstep;
    const unsigned ldsw = (unsigned)wid * 1024u;
    const int aoff = lds_byte(wr * 64 + fr, fq * 8), boff = lds_byte(wc * 32 + fr, fq * 8);
#define PG8_SA(b, h) (((b) * 2 + (h)) * HTB)
#define PG8_SB(b, h) ((4 + (b) * 2 + (h)) * HTB)
#define PG8_STAGE(bufoff, gbase, voff) do { _Pragma("unroll") for (int _i = 0; _i < 2; ++_i) \
        __builtin_amdgcn_global_load_lds((const unsigned*)((const char*)(gbase) + (voff)[_i]), (PG8_LAS unsigned*)(lds + (bufoff) + ldsw + _i * 8192), 16, 0, 0); } while (0)
#define PG8_LDA(dst, b, h) do { _Pragma("unroll") for (int m = 0; m < 4; ++m) _Pragma("unroll") for (int k = 0; k < 2; ++k) dst[m][k] = *(const PG8_LAS bf16x8*)(lds + PG8_SA(b, h) + aoff + m * 2048 + k * 1024); } while (0)
#define PG8_LDB(dst, b, h) do { _Pragma("unroll") for (int n = 0; n < 2; ++n) _Pragma("unroll") for (int k = 0; k < 2; ++k) dst[n][k] = *(const PG8_LAS bf16x8*)(lds + PG8_SB(b, h) + boff + n * 2048 + k * 1024); } while (0)
#define PG8_MMA(ai, bj, At, Bt) do { __builtin_amdgcn_s_setprio(1); _Pragma("unroll") for (int m = 0; m < 4; ++m) _Pragma("unroll") for (int n = 0; n < 2; ++n) _Pragma("unroll") for (int k = 0; k < 2; ++k) \
        acc[ai][bj][m][n] = __builtin_amdgcn_mfma_f32_16x16x32_bf16(Bt[n][k], At[m][k], acc[ai][bj][m][n], 0, 0, 0); __builtin_amdgcn_s_setprio(0); } while (0)
#define PG8_WAIT_V(n) asm volatile("s_waitcnt vmcnt(" #n ")" ::: "memory")
#define PG8_WAIT_L(n) asm volatile("s_waitcnt lgkmcnt(" #n ")" ::: "memory")
#define PG8_BAR __builtin_amdgcn_s_barrier()
#define PG8_SCHED __builtin_amdgcn_sched_barrier(0)
    Unit cur, nxt; int ui = 0;
    if (!S.next(0, cur)) return;
    f32x4 acc[2][2][4][2];
#pragma unroll
    for (int a = 0; a < 2; ++a)
#pragma unroll
        for (int b = 0; b < 2; ++b)
#pragma unroll
            for (int m = 0; m < 4; ++m)
#pragma unroll
                for (int n = 0; n < 2; ++n) acc[a][b][m][n] = (f32x4){0.f, 0.f, 0.f, 0.f};
    bf16x8 At[4][2], B0[2][2], B1[2][2];
    const char* cA = (const char*)g.A + (size_t)cur.pm * tstep + (size_t)cur.kofs * 2; const char* cB = (const char*)g.Bt + (size_t)cur.pn * tstep + (size_t)cur.kofs * 2;
    S.a_ready(cur);
    PG8_STAGE(PG8_SB(0, 0), cB, voffB); PG8_STAGE(PG8_SA(0, 0), cA, voffA); PG8_STAGE(PG8_SB(0, 1), cB + hstep, voffB); PG8_STAGE(PG8_SA(0, 1), cA + hstep, voffA);
    if (wr == 1) PG8_BAR;
    PG8_WAIT_V(4); PG8_BAR;
    PG8_STAGE(PG8_SB(1, 0), cB + kstep, voffB); PG8_STAGE(PG8_SA(1, 0), cA + kstep, voffA); PG8_STAGE(PG8_SB(1, 1), cB + hstep + kstep, voffB);
    PG8_WAIT_V(6); PG8_BAR;
    PG8_STAMP();
    for (;;) {
        const bool has_next = S.next(ui + 1, nxt);
        const char* nA = has_next ? (const char*)g.A + (size_t)nxt.pm * tstep + (size_t)nxt.kofs * 2 : cA; const char* nB = has_next ? (const char*)g.Bt + (size_t)nxt.pn * tstep + (size_t)nxt.kofs * 2 : cB;
        for (int t = 0; t < nt; t += 2) {
            const bool last = (t == nt - 2);
            const char* a1 = cA + (size_t)(t + 1) * kstep;
            const char* a2 = last ? nA : cA + (size_t)(t + 2) * kstep; const char* b2 = last ? nB : cB + (size_t)(t + 2) * kstep;
            const char* a3 = a2 + kstep; const char* b3 = b2 + kstep;
            if (last && has_next) S.a_ready(nxt);
            PG8_LDB(B0, 0, 0); PG8_SCHED; PG8_LDA(At, 0, 0); PG8_STAGE(PG8_SA(1, 1), a1 + hstep, voffA);
            PG8_WAIT_L(8); PG8_BAR; PG8_WAIT_L(0); PG8_MMA(0, 0, At, B0); PG8_BAR; PG8_SCHED;
            PG8_LDB(B1, 0, 1); PG8_STAGE(PG8_SB(0, 0), b2, voffB);
            PG8_BAR; PG8_WAIT_L(0); PG8_MMA(0, 1, At, B1); PG8_BAR;
            PG8_LDA(At, 0, 1); PG8_STAGE(PG8_SA(0, 0), a2, voffA);
            PG8_BAR; PG8_WAIT_L(0); PG8_MMA(1, 0, At, B0); PG8_BAR; PG8_SCHED;
            PG8_STAGE(PG8_SB(0, 1), b2 + hstep, voffB);
            PG8_WAIT_V(6); PG8_BAR; PG8_MMA(1, 1, At, B1); PG8_BAR;
            PG8_LDB(B0, 1, 0); PG8_SCHED; PG8_LDA(At, 1, 0); PG8_STAGE(PG8_SA(0, 1), a2 + hstep, voffA);
            PG8_WAIT_L(8); PG8_BAR; PG8_WAIT_L(0); PG8_MMA(0, 0, At, B0); PG8_BAR; PG8_SCHED;
            PG8_LDB(B1, 1, 1); PG8_STAGE(PG8_SB(1, 0), b3, voffB);
            PG8_BAR; PG8_WAIT_L(0); PG8_MMA(0, 1, At, B1); PG8_BAR;
            PG8_LDA(At, 1, 1); PG8_STAGE(PG8_SA(1, 0), a3, voffA);
            PG8_BAR; PG8_WAIT_L(0); PG8_MMA(1, 0, At, B0); PG8_BAR; PG8_SCHED;
            PG8_STAGE(PG8_SB(1, 1), b3 + hstep, voffB);
            PG8_WAIT_V(6); PG8_BAR; PG8_MMA(1, 1, At, B1); PG8_BAR;
        }
        PG8_STAMP();
        if constexpr (!Epi::AFTER_DRAIN) { E(acc, cur, wr, wc, fr, fq); S.done(cur); }
        PG8_STAMP();
        if (!has_next) break;
#pragma unroll
        for (int a = 0; a < 2; ++a)
#pragma unroll
            for (int b = 0; b < 2; ++b)
#pragma unroll
                for (int m = 0; m < 4; ++m)
#pragma unroll
                    for (int n = 0; n < 2; ++n) acc[a][b][m][n] = (f32x4){0.f, 0.f, 0.f, 0.f};
        cur = nxt; cA = nA; cB = nB; ++ui;
    }
    PG8_WAIT_V(0);
    if (wr == 0) PG8_BAR;
    PG8_BAR;
    if constexpr (Epi::AFTER_DRAIN) { E.fused(acc, cur, wr, wc, fr, fq, lds, wid, lane); S.done(cur); }
    PG8_STAMP();
    if (STAMP && wid == 0) { stamps[lane] = lane < nts ? (((unsigned long long)(unsigned)ts_hi << 32) | (unsigned)ts_lo) : 0ull;
        if (lane == 62) stamps[62] = rt_entry; if (lane == 63) stamps[63] = (unsigned long long)wall_clock64(); }
#undef PG8_STAMP
#undef PG8_SA
#undef PG8_SB
#undef PG8_STAGE
#undef PG8_LDA
#undef PG8_LDB
#undef PG8_MMA
#undef PG8_WAIT_V
#undef PG8_WAIT_L
#undef PG8_BAR
#undef PG8_SCHED
}
}
struct Args { const float* in[N_IN]; float* out; unsigned char* ws; int ph_lo, ph_hi; };
struct Frame {
    LAS unsigned char* lds;
    int tid, lane, wave, vcu, G;
    const float* const* in; GAS float* out; GAS unsigned char* ws;
};
using bf16x2v = __attribute__((ext_vector_type(2))) __bf16;
__device__ __forceinline__ float dot2bf(unsigned a, unsigned b, float acc) { return __builtin_amdgcn_fdot2_f32_bf16(__builtin_bit_cast(bf16x2v, a), __builtin_bit_cast(bf16x2v, b), acc, false); }

__device__ __forceinline__ void ld8bf(const bf16* p, float (&o)[8]) { const v4u w = *(const v4u*)p; o[0] = bf_lo(w.x); o[1] = bf_hi(w.x); o[2] = bf_lo(w.y); o[3] = bf_hi(w.y); o[4] = bf_lo(w.z); o[5] = bf_hi(w.z); o[6] = bf_lo(w.w); o[7] = bf_hi(w.w); }
struct TileInfo { int seq_base, seq_len, t0; };
__device__ __forceinline__ TileInfo tile_info(int c) {
    TileInfo ti;
    if (c < 128) { ti.seq_base = (c >> 6) * SEQ; ti.seq_len = SEQ; ti.t0 = (c & 63) * 64; }
    else { const int cc = c - 128; ti.seq_base = NLAT + (cc >> 2) * CTXL; ti.seq_len = CTXL; ti.t0 = (cc & 3) * 64; }
    return ti;
}
__device__ __forceinline__ int mod_row(int row) { return row < NLAT ? (row >> 12) : 2; }
__device__ __forceinline__ bf16x8 frag_lds(const LAS bf16* base, int ld, int row0, int k0, int lane) { return *(const LAS bf16x8*)(base + (row0 + (lane & 15)) * ld + k0 + 8 * (lane >> 4)); }
__device__ __forceinline__ bf16x8 frag_g(const bf16* base, int ld, int row0, int k0, int lane) { return *(const bf16x8*)(base + (size_t)(row0 + (lane & 15)) * ld + k0 + 8 * (lane >> 4)); }
#define MFMA16(a, b, c) __builtin_amdgcn_mfma_f32_16x16x32_bf16((a), (b), (c), 0, 0, 0)

__device__ __forceinline__ void p0_transpose_item(const float* W, int K, int N, bf16* WT, LAS float* scr, int item, int lane) {
    const int nblk = N / 32, kb = item / nblk, nb = item % nblk, k0 = 64 * kb, n0 = 32 * nb;
#pragma unroll 8
    for (int i = 0; i < 32; ++i) { const int kk = 2 * i + (lane >> 5); scr[kk * 33 + (lane & 31)] = W[(size_t)(k0 + kk) * N + n0 + (lane & 31)]; }
    LDS_WAIT(); asm volatile("" ::: "memory");
    const int c = lane & 7;
#pragma unroll
    for (int j = 0; j < 4; ++j) { const int n = (lane >> 3) + 8 * j; const LAS float* s = scr + (8 * c) * 33 + n;
        v4u o; o.x = pk2(s[0 * 33], s[1 * 33]); o.y = pk2(s[2 * 33], s[3 * 33]); o.z = pk2(s[4 * 33], s[5 * 33]); o.w = pk2(s[6 * 33], s[7 * 33]);
        *(v4u*)(WT + (size_t)(n0 + n) * K + k0 + 8 * c) = o; }
    LDS_WAIT(); asm volatile("" ::: "memory");
}
__device__ __forceinline__ void conv_f32_bf16(const float* src, bf16* dst, size_t n8, size_t i0, size_t stride) {
    for (size_t i = i0; i < n8; i += stride) { const f32x4 a = *(const f32x4*)(src + i * 8), b = *(const f32x4*)(src + i * 8 + 4);
        v4u o; o.x = pk2(a.x, a.y); o.y = pk2(a.z, a.w); o.z = pk2(b.x, b.y); o.w = pk2(b.z, b.w); *(v4u*)(dst + i * 8) = o; }
}
__device__ __forceinline__ void convert_layer(Frame& F, int l, int w, int NW, LAS float* scr) {
    constexpr int IT_IN = (D / 64) * (IN_COLS / 32), IT_SQ = (D / 64) * (D / 32);
    for (int it = w; it < IT_IN + 2 * IT_SQ; it += NW) {
        int r = it;
        if (r < IT_IN) { p0_transpose_item(gin(F.in[I_WIN]) + (size_t)l * D * IN_COLS, D, IN_COLS, (bf16*)(F.ws + WS_WIN) + (size_t)l * IN_PAD * D, scr, r, F.lane); continue; }
        r -= IT_IN;
        if (r < IT_SQ) { p0_transpose_item(gin(F.in[I_WOUT]) + (size_t)l * D * D, D, D, (bf16*)(F.ws + WS_WOUT) + (size_t)l * D * D, scr, r, F.lane); continue; }
        r -= IT_SQ;
        p0_transpose_item(gin(F.in[I_WQ]) + (size_t)l * D * D, D, D, (bf16*)(F.ws + WS_WQ) + (size_t)l * D * D, scr, r, F.lane);
    }
    { constexpr int PADV = (IN_PAD - IN_COLS) * D / 8;
      for (int i = w * 64 + F.lane; i < PADV; i += NW * 64) *(v4u*)((bf16*)(F.ws + WS_WIN) + ((size_t)l * IN_PAD + IN_COLS) * D + (size_t)i * 8) = (v4u){0u, 0u, 0u, 0u}; }
    for (int it = w; it < 2 * PE_NE; it += NW) {
        const int tab = it >= PE_NE, r = l * PE_NE + (tab ? it - PE_NE : it); const float* src = gin(F.in[tab ? I_V : I_U]) + (size_t)r * D + F.lane * 32;
        f32x4 x[8]; float mx = 0.f;
#pragma unroll
        for (int i = 0; i < 8; ++i) { x[i] = *(const f32x4*)(src + i * 4); mx = fmaxf(mx, fmaxf(fmaxf(fabsf(x[i].x), fabsf(x[i].y)), fmaxf(fabsf(x[i].z), fabsf(x[i].w)))); }
        mx = wave_max(mx); const float sc = mx > 0.f ? mx * (1.0f / 7.5f) : 1.0f, inv = 1.0f / sc;
        v16u pk;
#pragma unroll
        for (int i = 0; i < 8; ++i) { pk[2 * i] = pk2(x[i].x * inv, x[i].y * inv); pk[2 * i + 1] = pk2(x[i].z * inv, x[i].w * inv); }
        const v6u q = __builtin_amdgcn_cvt_scalef32_pk32_fp6_bf16(__builtin_bit_cast(v32bf, pk), 1.0f);
        unsigned char* dst = (unsigned char*)(F.ws + (tab ? WS_VB : WS_UB)) + (size_t)r * EROW;
        *(v4u*)(dst + F.lane * 16) = (v4u){q[0], q[1], q[2], q[3]}; *(v2u*)(dst + 1024 + F.lane * 8) = (v2u){q[4], q[5]};
        if (F.lane == 0) ((float*)(F.ws + (tab ? WS_SV : WS_SU)))[r] = sc;
    }
}
__device__ __forceinline__ void p0_prologue(Frame& F) {
    LAS float* scr = (LAS float*)(F.lds + F.wave * 16384);
    const int gw = F.vcu * NWAVES + F.wave, NGW = F.G * NWAVES;
    const size_t gt = (size_t)F.vcu * NTHR + F.tid, NGT = (size_t)F.G * NTHR;
    for (int l = 0; l < DEPTH; ++l) convert_layer(F, l, gw, NGW, scr);
    { bf16* dst = (bf16*)(F.ws + WS_WLRU);
      for (size_t idx = gt; idx < (size_t)DEPTH * 2 * 2 * 16 * 64 * 64; idx += NGT) { const int i = (int)(idx & 63), j = (int)((idx >> 6) & 63), m = (int)(idx >> 12);
          const int hh = m & 15, d = (m >> 4) & 1, gate = (m >> 5) & 1, l = m >> 6; const float* src = gin(F.in[gate ? I_WX : I_WA]);
          dst[idx] = (bf16)f2bf(src[((size_t)((l * 2 + d) * 16 + hh) * 64 + i) * 64 + j]); } }
    { bf16* d2 = (bf16*)(F.ws + WS_W2T); bf16* da = (bf16*)(F.ws + WS_A2T);
      for (size_t idx = gt; idx < (size_t)DEPTH * 2 * 1024 * 64; idx += NGT) { const int k = (int)(idx & 63), c = (int)((idx >> 6) & 1023), ld = (int)(idx >> 16);
          d2[idx] = (bf16)f2bf(gin(F.in[I_W2])[((size_t)ld * 64 + k) * 1024 + c]); da[idx] = (bf16)f2bf(gin(F.in[I_A2])[((size_t)ld * 64 + k) * 1024 + c]); } }
    { bf16* dg = (bf16*)(F.ws + WS_G2T);
      for (size_t idx = gt; idx < (size_t)DEPTH * 1024 * 160; idx += NGT) { const int k = (int)(idx % 160), c = (int)((idx / 160) % 1024), l = (int)(idx / (160 * 1024));
          dg[idx] = (bf16)f2bf(gin(F.in[I_G2])[((size_t)l * 160 + k) * 1024 + c]); } }
    conv_f32_bf16(gin(F.in[I_SUBK]), (bf16*)(F.ws + WS_SUBK), (size_t)DEPTH * 8 * 2 * 128 * 128 / 8, gt, NGT);
    { float* X = (float*)(F.ws + WS_X);
      for (size_t i0 = gt; i0 < (size_t)MTOT * D / 4; i0 += 4 * NGT) { f32x4 v[4];
#pragma unroll
          for (int u = 0; u < 4; ++u) { const size_t i = i0 + (size_t)u * NGT; const int row = (int)(i / (D / 4)), e0 = (int)(i % (D / 4)) * 4;
              v[u] = i < (size_t)MTOT * D / 4 ? (row < NLAT ? *(const f32x4*)(gin(F.in[I_X]) + (size_t)row * D + e0) : *(const f32x4*)(gin(F.in[I_CTX]) + (size_t)(row - NLAT) * D + e0)) : (f32x4){0.f, 0.f, 0.f, 0.f}; }
#pragma unroll
          for (int u = 0; u < 4; ++u) { const size_t i = i0 + (size_t)u * NGT; if (i >= (size_t)MTOT * D / 4) continue; const int row = (int)(i / (D / 4)), e0 = (int)(i % (D / 4)) * 4;
              if (row < NLAT) { const int t = row & (SEQ - 1); const float pr = (float)(t >> 6), pc = (float)(t & 63); float o[4];
#pragma unroll
                  for (int j = 0; j < 4; ++j) { const int e = e0 + j, q = e >> 9, fi = e & 511; const float freq = __builtin_amdgcn_exp2f(-13.287712379549449f * (float)fi * (1.0f / 512.0f));
                      const float ang = ((q >> 1) ? pc : pr) * freq; float rev = ang * 0.15915494309189535f; rev -= floorf(rev);
                      o[j] = (q & 1) ? __builtin_amdgcn_cosf(rev) : __builtin_amdgcn_sinf(rev); }
                  v[u].x += o[0]; v[u].y += o[1]; v[u].z += o[2]; v[u].w += o[3]; }
              *(f32x4*)(X + (size_t)row * D + e0) = v[u]; } } }
    { float* MODP = (float*)(F.ws + WS_MODP); const float* cin = gin(F.in[I_C]); const float* cctx = gin(F.in[I_CCTX]);
      for (int it = gw; it < DEPTH * KSPLIT * 48; it += NGW) { const int cg = it % 48, kp = (it / 48) % KSPLIT, l = it / (48 * KSPLIT); const int col = cg * 256 + F.lane * 4, k0 = kp * (D / KSPLIT);
          f32x4 a0 = {0.f, 0.f, 0.f, 0.f}, a1 = a0, a2 = a0; const float* wp = gin(F.in[I_ADAW]) + ((size_t)l * D + k0) * (6 * D) + col;
#pragma unroll 8
          for (int k = 0; k < D / KSPLIT; ++k) { const f32x4 w = *(const f32x4*)(wp + (size_t)k * (6 * D)); const float c0 = cin[k0 + k], c1 = cin[D + k0 + k], c2 = cctx[k0 + k];
              const float s0 = c0 * fsigmoid(c0), s1 = c1 * fsigmoid(c1), s2 = c2 * fsigmoid(c2); a0 += w * s0; a1 += w * s1; a2 += w * s2; }
          float* o = MODP + ((size_t)(kp * DEPTH + l) * 3) * (6 * D) + col; *(f32x4*)o = a0; *(f32x4*)(o + 6 * D) = a1; *(f32x4*)(o + 12 * D) = a2; } }
}
__device__ __forceinline__ void p0b_mod_reduce(Frame& F) {
    const size_t gt = (size_t)F.vcu * NTHR + F.tid, NGT = (size_t)F.G * NTHR; const float* MODP = (const float*)(F.ws + WS_MODP); float* MOD = (float*)(F.ws + WS_MOD);
    for (size_t i = gt; i < (size_t)DEPTH * 3 * 6 * D; i += NGT) { const int n = (int)(i % (6 * D)), l = (int)(i / (3 * 6 * D)); float s = gin(F.in[I_ADAB])[(size_t)l * 6 * D + n];
#pragma unroll
        for (int kp = 0; kp < KSPLIT; ++kp) s += MODP[(size_t)kp * DEPTH * 3 * 6 * D + i];
        MOD[i] = s; }
}
__device__ __forceinline__ void modulate_rows(Frame& F, int l, int which, int nrows) {
    const int gw = F.vcu * NWAVES + F.wave, NGW = F.G * NWAVES; const float* X = (const float*)(F.ws + WS_X); bf16* H = (bf16*)(F.ws + WS_H);
    for (int row = gw; row < nrows; row += NGW) { const float* md = (const float*)(F.ws + WS_MOD) + ((size_t)l * 3 + mod_row(row)) * (6 * D) + which * 3 * D;
#pragma unroll
        for (int j = 0; j < 4; ++j) { const int e = j * 512 + F.lane * 8; const f32x4 x0 = *(const f32x4*)(X + (size_t)row * D + e), x1 = *(const f32x4*)(X + (size_t)row * D + e + 4);
            const f32x4 s0 = *(const f32x4*)(md + e), s1 = *(const f32x4*)(md + e + 4), c0 = *(const f32x4*)(md + D + e), c1 = *(const f32x4*)(md + D + e + 4);
            const f32x4 y0 = x0 * (c0 + 1.0f) + s0, y1 = x1 * (c1 + 1.0f) + s1;
            v4u o; o.x = pk2(y0.x, y0.y); o.y = pk2(y0.z, y0.w); o.z = pk2(y1.x, y1.y); o.w = pk2(y1.z, y1.w); *(v4u*)(H + (size_t)row * D + e) = o; } }
}

__device__ __forceinline__ void lru_prep_unit(Frame& F, int l, int c, int hh) {
    int tid = F.tid; asm volatile("" : "+v"(tid));
    const int lane = tid & 63, wave = F.wave;
    const TileInfo ti = tile_info(c); const bf16* P = (const bf16*)(F.ws + WS_P);
    LAS float* Us = (LAS float*)F.lds; LAS float* XC = (LAS float*)(F.lds + 17408); LAS bf16* XCb = (LAS bf16*)(F.lds + 34304);
    LAS float* LAs = (LAS float*)(F.lds + 43520); LAS float* LBs = (LAS float*)(F.lds + 76288); LAS float* SEGA = (LAS float*)(F.lds + 109056); LAS float* SEGH = SEGA + 512;
    for (int idx = tid; idx < 67 * 8; idx += NTHR) { const int r = idx >> 3, c8 = (idx & 7) * 8, t = ti.t0 - 2 + r; float x[8];
        if (t >= 0 && t < ti.seq_len) ld8bf(P + (size_t)(ti.seq_base + t) * IN_PAD + hh * 64 + c8, x);
        else {
#pragma unroll
            for (int e = 0; e < 8; ++e) x[e] = 0.f; }
        *(LAS f32x4*)(Us + r * 64 + c8) = (f32x4){x[0], x[1], x[2], x[3]}; *(LAS f32x4*)(Us + r * 64 + c8 + 4) = (f32x4){x[4], x[5], x[6], x[7]}; }
    __syncthreads();
    { const int ch = tid & 63, cg = hh * 64 + ch; const float* cw = gin(F.in[I_CONVW]) + (size_t)l * 4 * LRW + cg;
      const float w0 = cw[0], w1 = cw[LRW], w2 = cw[2 * LRW], w3 = cw[3 * LRW], cb = gin(F.in[I_CONVB])[(size_t)l * LRW + cg];
#pragma unroll
      for (int k = 0; k < 8; ++k) { const int t = (tid >> 6) + 8 * k;
          const float v = cb + w0 * Us[t * 64 + ch] + w1 * Us[(t + 1) * 64 + ch] + w2 * Us[(t + 2) * 64 + ch] + w3 * Us[(t + 3) * 64 + ch];
          XC[t * 65 + ch] = v; XCb[t * 72 + ch] = (bf16)f2bf(v); } }
    __syncthreads();
    { const int d = wave >> 2, m = wave & 3;
      const bf16x8 a0 = frag_lds(XCb, 72, 16 * m, 0, lane), a1 = frag_lds(XCb, 72, 16 * m, 32, lane);
      const bf16* Wa = (const bf16*)(F.ws + WS_WLRU) + (size_t)(((l * 2 + 0) * 2 + d) * 16 + hh) * 4096;
      const bf16* Wx = (const bf16*)(F.ws + WS_WLRU) + (size_t)(((l * 2 + 1) * 2 + d) * 16 + hh) * 4096;
#pragma unroll
      for (int n = 0; n < 4; ++n) {
          f32x4 ar = {0.f, 0.f, 0.f, 0.f}, ai = ar;
          ar = MFMA16(a0, frag_g(Wa, 64, 16 * n, 0, lane), ar); ar = MFMA16(a1, frag_g(Wa, 64, 16 * n, 32, lane), ar);
          ai = MFMA16(a0, frag_g(Wx, 64, 16 * n, 0, lane), ai); ai = MFMA16(a1, frag_g(Wx, 64, 16 * n, 32, lane), ai);
          const int col = 16 * n + (lane & 15), cg = hh * 64 + col;
          const float ba = gin(F.in[I_BA])[(size_t)(l * 2 + d) * LRW + cg], bx = gin(F.in[I_BX])[(size_t)(l * 2 + d) * LRW + cg];
          const float sp = fsoftplus(-gin(F.in[I_LAM])[(size_t)(l * 2 + d) * LRW + cg]);
#pragma unroll
          for (int r = 0; r < 4; ++r) { const int row = 16 * m + 4 * (lane >> 4) + r;
              const float rr = fsigmoid(ar[r] + ba), ii = fsigmoid(ai[r] + bx), loga = -8.0f * rr * sp, a = fexp(loga);
              const float bb = __builtin_amdgcn_sqrtf(fmaxf(1.0f - a * a, 0.f)) * ii * XC[row * 65 + col];
              LAs[(d * 64 + row) * 64 + col] = a; LBs[(d * 64 + row) * 64 + col] = bb; } } }
    __syncthreads();
    { const int col = tid & 63, seg = (tid >> 6) & 3, d = tid >> 8, cg = hh * 64 + col; float hl[16], al[16]; float h = 0.f, A = 1.f;
#pragma unroll
      for (int i = 0; i < 16; ++i) { const int tau = 16 * seg + i, row = d ? 63 - tau : tau; const float a = LAs[(d * 64 + row) * 64 + col], b = LBs[(d * 64 + row) * 64 + col]; h = a * h + b; A *= a; hl[i] = h; al[i] = A; }
      SEGA[(d * 4 + seg) * 64 + col] = A; SEGH[(d * 4 + seg) * 64 + col] = h;
      __syncthreads();
      float Hin = 0.f, Ain = 1.f;
#pragma unroll
      for (int s2 = 0; s2 < 3; ++s2) if (s2 < seg) { const float sa = SEGA[(d * 4 + s2) * 64 + col]; Hin = sa * Hin + SEGH[(d * 4 + s2) * 64 + col]; Ain *= sa; }
      bf16* HL = (bf16*)(F.ws + WS_LB) + (size_t)d * MTOT * LRW; bf16* AC = (bf16*)(F.ws + WS_LA) + (size_t)d * MTOT * LRW;
#pragma unroll
      for (int i = 0; i < 16; ++i) { const int tau = 16 * seg + i, row = d ? 63 - tau : tau; const size_t o = (size_t)(ti.seq_base + ti.t0 + row) * LRW + cg; HL[o] = (bf16)f2bf(hl[i] + al[i] * Hin); AC[o] = (bf16)f2bf(al[i] * Ain); }
      if (seg == 3) { float* AG = (float*)(F.ws + WS_LAGG); AG[((size_t)(0 * 2 + d) * NTILE + c) * LRW + cg] = al[15] * Ain; AG[((size_t)(1 * 2 + d) * NTILE + c) * LRW + cg] = hl[15] + al[15] * Hin; } }
    __syncthreads();
}
__device__ __forceinline__ void shifted8(const bf16* P, size_t grow, bool hp, bool hn, const float* mu0, const float* mu1, int rc, float (&o)[8]) {
    const bf16* p = P + grow * IN_PAD + 2 * LRW + rc;
    float xs[8], ms[8], ns[8]; ld8bf(p, xs);
#pragma unroll
    for (int e = 0; e < 8; ++e) { ms[e] = 0.f; ns[e] = 0.f; }
    if (hp) ld8bf(p - IN_PAD, ms);
    if (hn) ld8bf(p + IN_PAD, ns);
    const f32x4 a0 = *(const f32x4*)(mu0 + rc), a1 = *(const f32x4*)(mu0 + rc + 4), b0 = *(const f32x4*)(mu1 + rc), b1 = *(const f32x4*)(mu1 + rc + 4);
    const float m0[8] = {a0.x, a0.y, a0.z, a0.w, a1.x, a1.y, a1.z, a1.w}, m1[8] = {b0.x, b0.y, b0.z, b0.w, b1.x, b1.y, b1.z, b1.w};
#pragma unroll
    for (int e = 0; e < 8; ++e) o[e] = xs[e] + m0[e] * (ms[e] - xs[e]) + m1[e] * (ns[e] - xs[e]);
}
constexpr int MB = 9216;
constexpr int MLD = 72;
#define MSLOT(k) ((LAS bf16*)(F.lds + (k) * MB))
__device__ __forceinline__ int prow(int c) { return (c & ~7) | ((c + (c >> 3)) & 7); }
__device__ __forceinline__ bf16x8 frag_lds_p(const LAS bf16* base, int ld, int row0, int k0, int lane) { return *(const LAS bf16x8*)(base + prow(row0 + (lane & 15)) * ld + k0 + 8 * (lane >> 4)); }
template <bool PY, bool PX> __device__ __forceinline__ f32x4 mm_tile_p(const LAS bf16* Y, int rt, const LAS bf16* X, int ct, f32x4 acc, int lane) {
    acc = MFMA16(PY ? frag_lds_p(Y, MLD, 16 * rt, 0, lane) : frag_lds(Y, MLD, 16 * rt, 0, lane), PX ? frag_lds_p(X, MLD, 16 * ct, 0, lane) : frag_lds(X, MLD, 16 * ct, 0, lane), acc);
    acc = MFMA16(PY ? frag_lds_p(Y, MLD, 16 * rt, 32, lane) : frag_lds(Y, MLD, 16 * rt, 32, lane), PX ? frag_lds_p(X, MLD, 16 * ct, 32, lane) : frag_lds(X, MLD, 16 * ct, 32, lane), acc);
    return acc;
}
__device__ __forceinline__ f32x4 mm_tile(const LAS bf16* Y, int rt, const LAS bf16* X, int ct, f32x4 acc, int lane) {
    acc = MFMA16(frag_lds(Y, MLD, 16 * rt, 0, lane), frag_lds(X, MLD, 16 * ct, 0, lane), acc);
    acc = MFMA16(frag_lds(Y, MLD, 16 * rt, 32, lane), frag_lds(X, MLD, 16 * ct, 32, lane), acc);
    return acc;
}
__device__ __forceinline__ void st_tile(LAS bf16* Dst, int rt, int ct, f32x4 acc, int lane) {
    v2u o; o.x = pk2(acc[0], acc[1]); o.y = pk2(acc[2], acc[3]);
    *(LAS v2u*)(Dst + (16 * ct + (lane & 15)) * MLD + 16 * rt + 4 * (lane >> 4)) = o;
}
__device__ __forceinline__ f32x4 ld_tile(const LAS bf16* Src, int rt, int ct, int lane) {
    const v2u o = *(const LAS v2u*)(Src + (16 * ct + (lane & 15)) * MLD + 16 * rt + 4 * (lane >> 4));
    return (f32x4){bf_lo(o.x), bf_hi(o.x), bf_lo(o.y), bf_hi(o.y)};
}
template <int MASK> __device__ __forceinline__ void mm64(LAS bf16* Dst, const LAS bf16* X, const LAS bf16* Y, int wave, int lane) {
    const int rt = wave >> 1;
#pragma unroll
    for (int q = 0; q < 2; ++q) { const int ct = 2 * (wave & 1) + q; f32x4 acc = {0.f, 0.f, 0.f, 0.f};
        acc = mm_tile(Y, rt, X, ct, acc, lane);
        if (MASK) { const int c = 16 * ct + (lane & 15);
#pragma unroll
            for (int g = 0; g < 4; ++g) { const int r = 16 * rt + 4 * (lane >> 4) + g; const bool keep = MASK == 1 ? (c > r) : MASK == 2 ? (r > c) : (c >= r); if (!keep) acc[g] = 0.f; } }
        st_tile(Dst, rt, ct, acc, lane); }
}
#ifndef CPROBE
#define CPROBE 0
#endif
struct RawS1 { v4u x[5][3]; };
template <int G0, int G1> __device__ __forceinline__ void load_raw(Frame& F, int c, int hh, int d, int tid, RawS1& raw) {
    const TileInfo ti = tile_info(c); const int t = tid >> 3, c8 = (tid & 7) * 8, tt = ti.t0 + t; const bool hp = tt > 0, hn = tt + 1 < ti.seq_len;
    const bf16* p0 = (const bf16*)(F.ws + WS_P) + (size_t)(ti.seq_base + tt) * IN_PAD + 2 * LRW + c8;
#pragma unroll
    for (int g = G0; g < G1; ++g) { const int rc = g < 3 ? g * RWW + hh * 64 : 3 * RWW + (g - 3) * 128 + d * 64; const bf16* p = p0 + rc;
        raw.x[g][0] = *(const v4u*)p; raw.x[g][1] = *(const v4u*)(p - (hp ? IN_PAD : 0)); raw.x[g][2] = *(const v4u*)(p + (hn ? IN_PAD : 0)); }
}
__device__ __forceinline__ void shift_raw(const v4u (&x)[3], const LAS float* mus, bool hp, bool hn, float (&o)[8]) {
    const f32x4 a0 = *(const LAS f32x4*)mus, a1 = *(const LAS f32x4*)(mus + 4), b0 = *(const LAS f32x4*)(mus + 64), b1 = *(const LAS f32x4*)(mus + 68);
    const float m0[8] = {a0.x, a0.y, a0.z, a0.w, a1.x, a1.y, a1.z, a1.w}, m1[8] = {b0.x, b0.y, b0.z, b0.w, b1.x, b1.y, b1.z, b1.w};
    const unsigned xw[4] = {x[0].x, x[0].y, x[0].z, x[0].w}, pw[4] = {x[1].x, x[1].y, x[1].z, x[1].w}, nw[4] = {x[2].x, x[2].y, x[2].z, x[2].w};
#pragma unroll
    for (int e = 0; e < 8; ++e) { const float xs = (e & 1) ? bf_hi(xw[e >> 1]) : bf_lo(xw[e >> 1]), ms = hp ? ((e & 1) ? bf_hi(pw[e >> 1]) : bf_lo(pw[e >> 1])) : 0.f, ns = hn ? ((e & 1) ? bf_hi(nw[e >> 1]) : bf_lo(nw[e >> 1])) : 0.f;
        o[e] = xs + m0[e] * (ms - xs) + m1[e] * (ns - xs); }
}
__device__ __forceinline__ void rwkv_chunk_prep(Frame& F, int l, int c, int hh, int d) {
    RawS1 raw;
    int tid = F.tid; asm volatile("" : "+v"(tid));
    const TileInfo ti = tile_info(c); const int lane = tid & 63, wave = F.wave;
    LAS bf16* TW = MSLOT(0); LAS bf16* AD = MSLOT(1);
    LAS float* CUM = (LAS float*)(F.lds + 8 * MB); LAS float* AVs = (LAS float*)(F.lds + 8 * MB + 16640);
    LAS float* CWL = (LAS float*)(F.lds + 13 * MB); LAS float* SEGT = (LAS float*)(F.lds + 13 * MB + 256); LAS float* MUS = (LAS float*)(F.lds + 125184);
    const int uidx = (c * NH + hh) * 2 + d;
    const int t = tid >> 3, c8 = (tid & 7) * 8, tt = ti.t0 + t; const size_t grow = (size_t)(ti.seq_base + tt); const bool hp = tt > 0, hn = tt + 1 < ti.seq_len;
    float rv[8], kv[8], vv[8], kk[8];
    load_raw<0, 5>(F, c, hh, d, tid, raw);
    for (int rp_ = 0; rp_ < (CPROBE == 1 ? 2 : 1); ++rp_) {
    shift_raw(raw.x[0], MUS + 0 * 128 + c8, hp, hn, rv);
    shift_raw(raw.x[1], MUS + 1 * 128 + c8, hp, hn, kv);
    shift_raw(raw.x[2], MUS + 2 * 128 + c8, hp, hn, vv);
    { float ss = 0.f; const float* kkw = gin(F.in[I_KK]) + (size_t)l * RWW + hh * 64 + c8;
#pragma unroll
      for (int e = 0; e < 8; ++e) { kk[e] = kv[e] * kkw[e]; ss += kk[e] * kk[e]; }
      ss = red8(ss); const float inv = __builtin_amdgcn_rsqf(fmaxf(ss, 1e-24f));
#pragma unroll
      for (int e = 0; e < 8; ++e) kk[e] *= inv; }
    if (d == 0) { v4u o; o.x = pk2(vv[0], vv[1]); o.y = pk2(vv[2], vv[3]); o.z = pk2(vv[4], vv[5]); o.w = pk2(vv[6], vv[7]); *(v4u*)((bf16*)(F.ws + WS_RV) + grow * RWW + hh * 64 + c8) = o; }
    { float x[8]; v4u o;
      shift_raw(raw.x[3], MUS + 3 * 128 + c8, hp, hn, x);
      o.x = pk2(ftanh(x[0]), ftanh(x[1])); o.y = pk2(ftanh(x[2]), ftanh(x[3])); o.z = pk2(ftanh(x[4]), ftanh(x[5])); o.w = pk2(ftanh(x[6]), ftanh(x[7])); *(LAS v4u*)(TW + t * MLD + c8) = o;
      shift_raw(raw.x[4], MUS + 4 * 128 + c8, hp, hn, x);
      o.x = pk2(x[0], x[1]); o.y = pk2(x[2], x[3]); o.z = pk2(x[4], x[5]); o.w = pk2(x[6], x[7]); *(LAS v4u*)(AD + t * MLD + c8) = o; }
    asm volatile("" ::: "memory"); }
    bf16x8 w2f[2][2], a2f[2][2];
    { const bf16* W2 = (const bf16*)(F.ws + WS_W2T) + ((size_t)(l * 2 + d) * 1024 + hh * 64) * 64; const bf16* A2 = (const bf16*)(F.ws + WS_A2T) + ((size_t)(l * 2 + d) * 1024 + hh * 64) * 64;
#pragma unroll
      for (int q = 0; q < 2; ++q) { const int n = (wave >> 2) * 2 + q;
#pragma unroll
          for (int k = 0; k < 2; ++k) { w2f[q][k] = frag_g(W2, 64, 16 * n, 32 * k, lane); a2f[q][k] = frag_g(A2, 64, 16 * n, 32 * k, lane); } } }
    __syncthreads();
    for (int rp_ = 0; rp_ < (CPROBE == 2 ? 2 : 1); ++rp_) { const int m = wave & 3; const bf16x8 w0f = frag_lds(TW, MLD, 16 * m, 0, lane), w1f = frag_lds(TW, MLD, 16 * m, 32, lane), d0f = frag_lds(AD, MLD, 16 * m, 0, lane), d1f = frag_lds(AD, MLD, 16 * m, 32, lane);
#pragma unroll
      for (int q = 0; q < 2; ++q) { const int n = (wave >> 2) * 2 + q; f32x4 aw = {0.f, 0.f, 0.f, 0.f}, aa = aw;
          aw = MFMA16(w0f, w2f[q][0], aw); aw = MFMA16(w1f, w2f[q][1], aw);
          aa = MFMA16(d0f, a2f[q][0], aa); aa = MFMA16(d1f, a2f[q][1], aa);
          const int col = 16 * n + (lane & 15), cg = hh * 64 + col; const float w0 = gin(F.in[I_W0])[(size_t)(l * 2 + d) * RWW + cg], a0 = gin(F.in[I_A0])[(size_t)(l * 2 + d) * RWW + cg];
#pragma unroll
          for (int g = 0; g < 4; ++g) { const int row = 16 * m + 4 * (lane >> 4) + g; const float wlog = -fsoftplus(-(w0 + aw[g])) - 0.5f;
              CUM[row * 65 + col] = -fexp(wlog); AVs[row * 65 + col] = fsigmoid(a0 + aa[g]); } } }
    __syncthreads();
    { const int col = tid & 63, seg = tid >> 6; float pre[8]; float run = 0.f;
#pragma unroll
      for (int i = 0; i < 8; ++i) { const int tau = seg * 8 + i, tr = d ? 63 - tau : tau; run += CUM[tr * 65 + col]; pre[i] = run; }
      SEGT[seg * 64 + col] = run;
      __syncthreads();
      float off = 0.f;
#pragma unroll
      for (int s = 0; s < 8; ++s) if (s < seg) off += SEGT[s * 64 + col];
#pragma unroll
      for (int i = 0; i < 8; ++i) { const int tau = seg * 8 + i, tr = d ? 63 - tau : tau; CUM[tr * 65 + col] = off + pre[i]; }
      if (seg == 7) CWL[col] = fexp(off + pre[7]); }
    __syncthreads();
    for (int rp_ = 0; rp_ < (CPROBE == 3 ? 2 : 1); ++rp_) { const int tau = d ? 63 - t : t, tprev = d ? t + 1 : t - 1;
      const float* kaw = gin(F.in[I_KA]) + (size_t)l * RWW + hh * 64 + c8; const float* rkw = gin(F.in[I_RK]) + (size_t)l * RWW + hh * 64 + c8;
      LAS bf16* At = MSLOT(0); LAS bf16* AtT = MSLOT(1); LAS bf16* Bt = MSLOT(2); LAS bf16* BtT = MSLOT(3); LAS bf16* Kt = MSLOT(4); LAS bf16* KtT = MSLOT(5); LAS bf16* Rt = MSLOT(6); LAS bf16* VT = MSLOT(7);
      float bsum = 0.f; unsigned pa[4], pb[4], pk[4], pr[4];
#pragma unroll
      for (int e2 = 0; e2 < 4; ++e2) { float at2[2], bt2[2], kt2[2], rt2[2];
#pragma unroll
          for (int q = 0; q < 2; ++q) { const int e = 2 * e2 + q; const float cum = CUM[t * 65 + c8 + e], cumx = tau > 0 ? CUM[tprev * 65 + c8 + e] : 0.f, a = AVs[t * 65 + c8 + e];
              const float kd = kv[e] * (1.0f + (a - 1.0f) * kaw[e]), ex = fexp(cum), exm = fexp(-cum);
              at2[q] = -kk[e] * fexp(cumx); bt2[q] = kk[e] * a * exm; kt2[q] = kd * exm; rt2[q] = rv[e] * ex; bsum += rv[e] * kd * rkw[e];
              const int pr_ = prow(c8 + e) * MLD + tau; AtT[pr_] = (bf16)f2bf(at2[q]); BtT[pr_] = (bf16)f2bf(bt2[q]); KtT[pr_] = (bf16)f2bf(kt2[q]); VT[pr_] = (bf16)f2bf(vv[e]); }
          pa[e2] = pk2(at2[0], at2[1]); pb[e2] = pk2(bt2[0], bt2[1]); pk[e2] = pk2(kt2[0], kt2[1]); pr[e2] = pk2(rt2[0], rt2[1]); }
      *(LAS v4u*)(At + tau * MLD + c8) = (v4u){pa[0], pa[1], pa[2], pa[3]}; *(LAS v4u*)(Bt + tau * MLD + c8) = (v4u){pb[0], pb[1], pb[2], pb[3]};
      *(LAS v4u*)(Kt + tau * MLD + c8) = (v4u){pk[0], pk[1], pk[2], pk[3]}; *(LAS v4u*)(Rt + tau * MLD + c8) = (v4u){pr[0], pr[1], pr[2], pr[3]};
      bsum = red8(bsum);
      if ((tid & 7) == 0) ((float*)(F.ws + WS_BETA))[((size_t)d * MTOT + grow) * NH + hh] = bsum; }
    __syncthreads();
    LAS bf16* At = MSLOT(0); LAS bf16* AtT = MSLOT(1); LAS bf16* Bt = MSLOT(2); LAS bf16* BtT = MSLOT(3); LAS bf16* Kt = MSLOT(4); LAS bf16* KtT = MSLOT(5); LAS bf16* Rt = MSLOT(6); LAS bf16* VT = MSLOT(7);
    LAS bf16* Pm = MSLOT(8); LAS bf16* AkVT = MSLOT(9); LAS bf16* Gak = MSLOT(10); LAS bf16* Grb = MSLOT(11); LAS bf16* Grk = MSLOT(12);
    LAS bf16* TAT = MSLOT(0); LAS bf16* U0T = MSLOT(2); LAS bf16* TD = (LAS bf16*)(F.lds + 122112); constexpr int TDLD = 24;
    for (int rp_ = 0; rp_ < (CPROBE == 4 ? 2 : 1); ++rp_) {
    mm64<1>(Pm, At, Bt, wave, lane);
    __syncthreads();
    if (wave == 0) { const int blk = lane >> 4, cc = lane & 15; float tv[16];
#pragma unroll
        for (int r = 0; r < 16; ++r) { asm volatile("" ::: "memory"); const LAS bf16* ar = Pm + (16 * blk + r) * MLD + 16 * blk; const v4u q0 = *(const LAS v4u*)ar, q1 = *(const LAS v4u*)(ar + 8);
            const float av_[16] = {bf_lo(q0.x), bf_hi(q0.x), bf_lo(q0.y), bf_hi(q0.y), bf_lo(q0.z), bf_hi(q0.z), bf_lo(q0.w), bf_hi(q0.w), bf_lo(q1.x), bf_hi(q1.x), bf_lo(q1.y), bf_hi(q1.y), bf_lo(q1.z), bf_hi(q1.z), bf_lo(q1.w), bf_hi(q1.w)};
            float acc0 = (r == cc) ? 1.0f : 0.f, acc1 = 0.f;
#pragma unroll
            for (int m = 0; m < r; ++m) { if (m & 1) acc1 += av_[m] * tv[m]; else acc0 += av_[m] * tv[m]; }
            tv[r] = acc0 + acc1; }
#pragma unroll
        for (int r = 0; r < 16; ++r) TD[(16 * blk + r) * TDLD + cc] = (bf16)f2bf(tv[r]);
    } else {
#pragma unroll 1
        for (int q = wave - 1; q < 48; q += 7) { const int pr = q >> 4, tl = q & 15, rt = tl >> 2, ct = tl & 3;
            const LAS bf16* X = pr == 0 ? At : Rt; const LAS bf16* Y = pr == 1 ? Bt : Kt; LAS bf16* Dst = pr == 0 ? Gak : pr == 1 ? Grb : Grk;
            f32x4 acc = {0.f, 0.f, 0.f, 0.f}; acc = mm_tile(Y, rt, X, ct, acc, lane);
            const int cI = 16 * ct + (lane & 15);
#pragma unroll
            for (int g = 0; g < 4; ++g) { const int rI = 16 * rt + 4 * (lane >> 4) + g; const bool keep = pr == 0 ? (cI > rI) : (cI >= rI); if (!keep) acc[g] = 0.f; }
            st_tile(Dst, rt, ct, acc, lane); }
    }
    __syncthreads(); }
    { const int rt = wave >> 1;
#pragma unroll
      for (int q = 0; q < 2; ++q) { const int ct = 2 * (wave & 1) + q; f32x4 acc = {0.f, 0.f, 0.f, 0.f}; acc = mm_tile_p<false, true>(Gak, rt, VT, ct, acc, lane); st_tile(AkVT, rt, ct, acc, lane); } }
    { const v4u z = {0u, 0u, 0u, 0u}; for (int i = tid; i < 64 * 8; i += NTHR) { const int row = i >> 3, c8_ = (i & 7) * 8; *(LAS v4u*)(TAT + row * MLD + c8_) = z; *(LAS v4u*)(U0T + row * MLD + c8_) = z; } }
    __syncthreads();
    for (int rp_ = 0; rp_ < (CPROBE == 5 ? 2 : 1); ++rp_)
#pragma unroll 1
    for (int bi = 0; bi < 4; ++bi) {
        const int g = lane >> 4, il = lane & 15, nt = wave & 3; const LAS bf16* RH = (wave < 4) ? AtT : AkVT; LAS bf16* XT = (wave < 4) ? TAT : U0T;
        const v2u rq = *(const LAS v2u*)(RH + ((wave < 4) ? prow(16 * nt + il) : 16 * nt + il) * MLD + 16 * bi + 4 * g);
        f32x4 acc = {bf_lo(rq.x), bf_hi(rq.x), bf_lo(rq.y), bf_hi(rq.y)};
#pragma unroll
        for (int ks = 0; ks < 2; ++ks) if (32 * ks < 16 * bi) {
            bf16x8 af = frag_lds(Pm, MLD, 16 * bi, 32 * ks, lane); if (32 * ks + 8 * g >= 16 * bi) af = (bf16x8){0, 0, 0, 0, 0, 0, 0, 0};
            acc = MFMA16(af, frag_lds(XT, MLD, 16 * nt, 32 * ks, lane), acc); }
        v4u rb; rb.x = pk2(acc[0], acc[1]); rb.y = pk2(acc[2], acc[3]); rb.z = 0u; rb.w = 0u;
        const v2u tq = *(const LAS v2u*)(TD + (16 * bi + il) * TDLD + 4 * g); v4u tf; tf.x = tq.x; tf.y = tq.y; tf.z = 0u; tf.w = 0u;
        f32x4 xo = {0.f, 0.f, 0.f, 0.f}; xo = MFMA16(__builtin_bit_cast(bf16x8, tf), __builtin_bit_cast(bf16x8, rb), xo);
        v2u o; o.x = pk2(xo[0], xo[1]); o.y = pk2(xo[2], xo[3]); *(LAS v2u*)(XT + (16 * nt + il) * MLD + 16 * bi + 4 * g) = o;
        __syncthreads();
    }
    for (int rp_ = 0; rp_ < (CPROBE == 6 ? 2 : 1); ++rp_) {
    {
      bf16* QMg = (bf16*)(F.ws + WS_QM) + (size_t)uidx * 4096; bf16* PHg = (bf16*)(F.ws + WS_PHI) + (size_t)uidx * 4096; const int rt = wave >> 1;
#pragma unroll
      for (int q = 0; q < 2; ++q) { const int ct = 2 * (wave & 1) + q; const int cidx = 16 * ct + (lane & 15), r0 = 16 * rt + 4 * (lane >> 4), qpos = 32 * (rt >> 1) + 8 * (lane >> 4) + 4 * (rt & 1);
          f32x4 acc = ld_tile(Rt, rt, ct, lane); acc = mm_tile(TAT, rt, Grb, ct, acc, lane);
          v2u o; o.x = pk2(acc[0], acc[1]); o.y = pk2(acc[2], acc[3]); *(v2u*)(QMg + cidx * 64 + qpos) = o;
          asm volatile("" ::: "memory");
          f32x4 ph = {0.f, 0.f, 0.f, 0.f}; ph = mm_tile_p<false, true>(TAT, rt, BtT, ct, ph, lane); const float cw = CWL[cidx];
#pragma unroll
          for (int g = 0; g < 4; ++g) ph[g] = cw * (ph[g] + ((r0 + g == cidx) ? 1.0f : 0.f));
          o.x = pk2(ph[0], ph[1]); o.y = pk2(ph[2], ph[3]); *(v2u*)(PHg + cidx * 64 + qpos) = o; } }
    {
      bf16* Y0g = (bf16*)(F.ws + WS_Y0F) + (size_t)uidx * 4096; bf16* PSg = (bf16*)(F.ws + WS_PSF) + (size_t)uidx * 4096; const int rt = wave >> 1;
#pragma unroll
      for (int q = 0; q < 2; ++q) { const int ct = 2 * (wave & 1) + q;
          asm volatile("" ::: "memory");
          f32x4 y0 = {0.f, 0.f, 0.f, 0.f}; y0 = mm_tile(U0T, rt, Grb, ct, y0, lane); asm volatile("" ::: "memory"); y0 = mm_tile_p<true, false>(VT, rt, Grk, ct, y0, lane);
          { v2u w; w.x = pk2(y0[0], y0[1]); w.y = pk2(y0[2], y0[3]); *(v2u*)(Y0g + ((rt * 4 + ct) * 64 + lane) * 4) = w; }
          asm volatile("" ::: "memory");
          f32x4 ps = {0.f, 0.f, 0.f, 0.f}; ps = mm_tile_p<true, false>(BtT, rt, U0T, ct, ps, lane); asm volatile("" ::: "memory"); ps = mm_tile_p<true, true>(KtT, rt, VT, ct, ps, lane);
#pragma unroll
          for (int g = 0; g < 4; ++g) ps[g] *= CWL[16 * rt + 4 * (lane >> 4) + g];
          { v2u w; w.x = pk2(ps[0], ps[1]); w.y = pk2(ps[2], ps[3]); *(v2u*)(PSg + ((ct * 4 + rt) * 64 + lane) * 4) = w; } } } }
    __syncthreads();
}
#define LDS_BAR() do { asm volatile("s_waitcnt lgkmcnt(0)" ::: "memory"); __builtin_amdgcn_s_barrier(); asm volatile("" ::: "memory"); } while (0)
struct ChunkOps { bf16x8 f[4][2]; v2u c[4]; int tile; };
__device__ __forceinline__ void chunk_load(Frame& F, ChunkOps& o, int step, int b, int hh, int d, int sl, int role, int lane) {
    const int g = lane >> 4, il = lane & 15;
    step = step < 67 ? step : 67;
    const int cc = d ? 3 - step : step, lc = d ? 67 - step : step - 4; const int tile = step < 4 ? 128 + b * 4 + cc : b * 64 + lc;
    o.tile = tile;
    const size_t uidx = (size_t)(tile * NH + hh) * 2 + d;
    const bf16* Mg = (const bf16*)(F.ws + (role ? WS_QM : WS_PHI)) + uidx * 4096 + il * 64 + 8 * g; const bf16* Cg = (const bf16*)(F.ws + (role ? WS_Y0F : WS_PSF)) + uidx * 4096 + (sl * 4 * 64 + lane) * 4;
#pragma unroll
    for (int m = 0; m < 4; ++m) { o.f[m][0] = *(const bf16x8*)(Mg + m * 1024); o.f[m][1] = *(const bf16x8*)(Mg + m * 1024 + 32); o.c[m] = *(const v2u*)(Cg + m * 256); }
}
__device__ __forceinline__ void lru_scan(Frame& F, int idx) {
    const int ch = idx & 1023, b = (idx >> 10) & 1, d = idx >> 11;
    const float* AG = (const float*)(F.ws + WS_LAGG); float* HIN = (float*)(F.ws + WS_LHIN);
    float carry = 0.f;
#pragma unroll 4
    for (int step = 0; step < 68; ++step) { int tile; if (step < 4) tile = 128 + b * 4 + (d ? 3 - step : step); else tile = b * 64 + (d ? 63 - (step - 4) : step - 4);
        const float a = AG[((size_t)(0 * 2 + d) * NTILE + tile) * LRW + ch], hh_ = AG[((size_t)(1 * 2 + d) * NTILE + tile) * LRW + ch];
        HIN[((size_t)d * NTILE + tile) * LRW + ch] = carry; carry = a * carry + hh_; }
}

__device__ __forceinline__ void chunk_apply(Frame& F, const ChunkOps& o, f32x4 (&S)[4], int step, bf16* YR, int hh, int d, int sl, int role, int lane) {
    const int g = lane >> 4, il = lane & 15; LAS v4u* XCH = (LAS v4u*)F.lds;
    bf16x8 bfr[2];
    if (role == 0) {
#pragma unroll
        for (int ks = 0; ks < 2; ++ks) { v4u w; w.x = pk2(S[2 * ks][0], S[2 * ks][1]); w.y = pk2(S[2 * ks][2], S[2 * ks][3]); w.z = pk2(S[2 * ks + 1][0], S[2 * ks + 1][1]); w.w = pk2(S[2 * ks + 1][2], S[2 * ks + 1][3]); bfr[ks] = __builtin_bit_cast(bf16x8, w); }
#pragma unroll
        for (int m = 0; m < 4; ++m) { f32x4 sn = (f32x4){bf_lo(o.c[m].x), bf_hi(o.c[m].x), bf_lo(o.c[m].y), bf_hi(o.c[m].y)}; sn = MFMA16(o.f[m][0], bfr[0], sn); sn = MFMA16(o.f[m][1], bfr[1], sn); S[m] = sn; }
#pragma unroll
        for (int ks = 0; ks < 2; ++ks) { v4u w; w.x = pk2(S[2 * ks][0], S[2 * ks][1]); w.y = pk2(S[2 * ks][2], S[2 * ks][3]); w.z = pk2(S[2 * ks + 1][0], S[2 * ks + 1][1]); w.w = pk2(S[2 * ks + 1][2], S[2 * ks + 1][3]);
            XCH[((((step + 1) & 1) * 4 + sl) * 2 + ks) * 64 + lane] = w; }
    } else {
#pragma unroll
        for (int ks = 0; ks < 2; ++ks) bfr[ks] = __builtin_bit_cast(bf16x8, XCH[(((step & 1) * 4 + sl) * 2 + ks) * 64 + lane]);
#pragma unroll
        for (int m = 0; m < 4; ++m) { f32x4 y = (f32x4){bf_lo(o.c[m].x), bf_hi(o.c[m].x), bf_lo(o.c[m].y), bf_hi(o.c[m].y)}; y = MFMA16(bfr[0], o.f[m][0], y); y = MFMA16(bfr[1], o.f[m][1], y);
            const int tau = 16 * m + il, tl = d ? 63 - tau : tau; v2u w; w.x = pk2(y[0], y[1]); w.y = pk2(y[2], y[3]);
            *(v2u*)(YR + (size_t)(o.tile * 64 + tl) * RWW + hh * 64 + sl * 16 + 4 * g) = w; }
    }
}
__device__ __forceinline__ void rwkv_chain_chunks(Frame& F, int item) {
    const int chain = item >> 2, sl = item & 3, d = chain & 1, hh = (chain >> 1) & 15, b = chain >> 5, role = F.wave, lane = F.lane;
    bf16* YR = (bf16*)(F.ws + WS_YR) + (size_t)d * MTOT * RWW;
    { LAS v4u* XCH = (LAS v4u*)F.lds; for (int i = F.tid; i < 4 * 2 * 64; i += NTHR) XCH[i] = (v4u){0u, 0u, 0u, 0u}; }
    __syncthreads();
    if (F.wave >= 2) {
#pragma unroll 1
        for (int step = 0; step < 68; ++step) LDS_BAR();
        return; }
    f32x4 S[4];
#pragma unroll
    for (int m = 0; m < 4; ++m) S[m] = (f32x4){0.f, 0.f, 0.f, 0.f};
    ChunkOps A, B, C, E;
    chunk_load(F, A, 0, b, hh, d, sl, role, lane); chunk_load(F, B, 1, b, hh, d, sl, role, lane); chunk_load(F, C, 2, b, hh, d, sl, role, lane);
#pragma unroll 1
    for (int step = 0; step < 68; step += 4) {
        chunk_load(F, E, step + 3, b, hh, d, sl, role, lane);
        chunk_apply(F, A, S, step, YR, hh, d, sl, role, lane); LDS_BAR();
        chunk_load(F, A, step + 4, b, hh, d, sl, role, lane);
        chunk_apply(F, B, S, step + 1, YR, hh, d, sl, role, lane); LDS_BAR();
        chunk_load(F, B, step + 5, b, hh, d, sl, role, lane);
        chunk_apply(F, C, S, step + 2, YR, hh, d, sl, role, lane); LDS_BAR();
        chunk_load(F, C, step + 6, b, hh, d, sl, role, lane);
        chunk_apply(F, E, S, step + 3, YR, hh, d, sl, role, lane); LDS_BAR();
    }
}
__device__ __forceinline__ void merge_unit(Frame& F, int l, int u) {
    const int c = u >> 2; const TileInfo ti = tile_info(c); const int t0 = ti.t0 + (u & 3) * 16; const bf16* P = (const bf16*)(F.ws + WS_P);
    LAS bf16* SG = (LAS bf16*)F.lds; LAS bf16* GO = (LAS bf16*)(F.lds + 10752);
    const float* mu0 = gin(F.in[I_MU]) + (size_t)l * 2 * RW_COLS; const float* mu1 = mu0 + RW_COLS;
    if (F.tid < 16 * 20) { const int t = F.tid / 20, k8 = (F.tid % 20) * 8, tt = t0 + t, rc = 3 * RWW + 256 + k8; const bf16* p = P + (size_t)(ti.seq_base + tt) * IN_PAD + 2 * LRW + rc;
        float x[8], xm[8], xn[8]; ld8bf(p, x); ld8bf(p - (tt > 0 ? IN_PAD : 0), xm); ld8bf(p + (tt + 1 < ti.seq_len ? IN_PAD : 0), xn); float o[8];
#pragma unroll
        for (int e = 0; e < 8; ++e) { const float pm = tt > 0 ? xm[e] : 0.f, pn = tt + 1 < ti.seq_len ? xn[e] : 0.f; o[e] = fsigmoid(x[e] + mu0[rc + e] * (pm - x[e]) + mu1[rc + e] * (pn - x[e])); }
        v4u w; w.x = pk2(o[0], o[1]); w.y = pk2(o[2], o[3]); w.z = pk2(o[4], o[5]); w.w = pk2(o[6], o[7]); *(LAS v4u*)(SG + t * 168 + k8) = w; }
    __syncthreads();
    { const int lane = F.lane; const bf16* G2 = (const bf16*)(F.ws + WS_G2T) + (size_t)l * 1024 * 160;
      bf16x8 af[5];
#pragma unroll
      for (int k = 0; k < 5; ++k) af[k] = frag_lds(SG, 168, 0, 32 * k, lane);
#pragma unroll 2
      for (int n = 0; n < 8; ++n) { const int n0 = F.wave * 128 + n * 16; f32x4 a0 = {0.f, 0.f, 0.f, 0.f};
#pragma unroll
          for (int k = 0; k < 5; ++k) a0 = MFMA16(af[k], frag_g(G2, 160, n0, 32 * k, lane), a0);
#pragma unroll
          for (int r = 0; r < 4; ++r) GO[(4 * (lane >> 4) + r) * 1032 + n0 + (lane & 15)] = (bf16)f2bf(a0[r]); } }
    __syncthreads();
    { bf16* MRG = (bf16*)(F.ws + WS_H);
      for (int it = F.tid; it < 16 * 256; it += NTHR) { const int t = it >> 8, cgp = it & 255, tt = t0 + t; const size_t grow = (size_t)(ti.seq_base + tt);
          float o[8];
          if (cgp < 128) { const int ch = cgp * 8; float gq8[8]; ld8bf(P + grow * IN_PAD + LRW + ch, gq8); const f32x4 g0 = {gq8[0], gq8[1], gq8[2], gq8[3]}, g1 = {gq8[4], gq8[5], gq8[6], gq8[7]};
              const bf16* hl = (const bf16*)(F.ws + WS_LB) + grow * LRW + ch; const bf16* ac = (const bf16*)(F.ws + WS_LA) + grow * LRW + ch; const float* hi = (const float*)(F.ws + WS_LHIN) + (size_t)c * LRW + ch;
              float h0[8], c0[8], h1[8], c1[8]; ld8bf(hl, h0); ld8bf(ac, c0); ld8bf(hl + (size_t)MTOT * LRW, h1); ld8bf(ac + (size_t)MTOT * LRW, c1);
              const f32x4 i00 = *(const f32x4*)hi, i01 = *(const f32x4*)(hi + 4), i10 = *(const f32x4*)(hi + (size_t)NTILE * LRW), i11 = *(const f32x4*)(hi + (size_t)NTILE * LRW + 4);
              const f32x4 a0 = {h0[0] + c0[0] * i00.x + h1[0] + c1[0] * i10.x, h0[1] + c0[1] * i00.y + h1[1] + c1[1] * i10.y, h0[2] + c0[2] * i00.z + h1[2] + c1[2] * i10.z, h0[3] + c0[3] * i00.w + h1[3] + c1[3] * i10.w};
              const f32x4 a1 = {h0[4] + c0[4] * i01.x + h1[4] + c1[4] * i11.x, h0[5] + c0[5] * i01.y + h1[5] + c1[5] * i11.y, h0[6] + c0[6] * i01.z + h1[6] + c1[6] * i11.z, h0[7] + c0[7] * i01.w + h1[7] + c1[7] * i11.w};
              o[0] = gelu_tanh(g0.x) * a0.x; o[1] = gelu_tanh(g0.y) * a0.y; o[2] = gelu_tanh(g0.z) * a0.z; o[3] = gelu_tanh(g0.w) * a0.w;
              o[4] = gelu_tanh(g1.x) * a1.x; o[5] = gelu_tanh(g1.y) * a1.y; o[6] = gelu_tanh(g1.z) * a1.z; o[7] = gelu_tanh(g1.w) * a1.w; }
          else { const int ch = (cgp - 128) * 8, hh = ch >> 6; const bf16* yr = (const bf16*)(F.ws + WS_YR) + grow * RWW + ch;
              float ya[8], yb[8], va[8]; ld8bf(yr, ya); ld8bf(yr + (size_t)MTOT * RWW, yb); ld8bf((const bf16*)(F.ws + WS_RV) + grow * RWW + ch, va);
              float s1 = 0.f, q1 = 0.f;
#pragma unroll
              for (int e = 0; e < 8; ++e) { ya[e] += yb[e]; s1 += ya[e]; q1 += ya[e] * ya[e]; }
              s1 = red8(s1); q1 = red8(q1);
              const float mean = s1 * (1.0f / 64.0f), var = fmaxf(q1 * (1.0f / 64.0f) - mean * mean, 0.f); const f32x2 st = {mean, __builtin_amdgcn_rsqf(var + GN_EPS)};
              const float beta = ((const float*)(F.ws + WS_BETA))[grow * NH + hh] + ((const float*)(F.ws + WS_BETA))[((size_t)MTOT + grow) * NH + hh];
              const float* gg = gin(F.in[I_GNG]) + (size_t)l * RWW + ch; const float* gb = gin(F.in[I_GNB]) + (size_t)l * RWW + ch;
              const v4u gq = *(const LAS v4u*)(GO + t * 1032 + ch); const float gv[8] = {bf_lo(gq.x), bf_hi(gq.x), bf_lo(gq.y), bf_hi(gq.y), bf_lo(gq.z), bf_hi(gq.z), bf_lo(gq.w), bf_hi(gq.w)};
#pragma unroll
              for (int e = 0; e < 8; ++e) o[e] = ((ya[e] - st.x) * st.y * gg[e] + gb[e] + beta * va[e]) * gv[e]; }
          v4u w; w.x = pk2(o[0], o[1]); w.y = pk2(o[2], o[3]); w.z = pk2(o[4], o[5]); w.w = pk2(o[6], o[7]);
          *(v4u*)(MRG + grow * D + cgp * 8) = w; } }
    __syncthreads();
}

__device__ __forceinline__ void ln_row(float (&z)[32], const float* g, const float* b, int lane) {
    float s = 0.f;
#pragma unroll
    for (int i = 0; i < 32; ++i) s += z[i];
    const float mean = wave_sum(s) * (1.0f / D); float q = 0.f;
#pragma unroll
    for (int i = 0; i < 32; ++i) { z[i] -= mean; q += z[i] * z[i]; }
    const float rstd = __builtin_amdgcn_rsqf(wave_sum(q) * (1.0f / D) + LN_EPS);
#pragma unroll
    for (int j = 0; j < 4; ++j) { const int e = j * 512 + lane * 8; const f32x4 g0 = *(const f32x4*)(g + e), g1 = *(const f32x4*)(g + e + 4), b0 = *(const f32x4*)(b + e), b1 = *(const f32x4*)(b + e + 4);
        const float gs[8] = {g0.x, g0.y, g0.z, g0.w, g1.x, g1.y, g1.z, g1.w}, bs[8] = {b0.x, b0.y, b0.z, b0.w, b1.x, b1.y, b1.z, b1.w};
#pragma unroll
        for (int i = 0; i < 8; ++i) z[j * 8 + i] = z[j * 8 + i] * rstd * gs[i] + bs[i]; }
}
__device__ __forceinline__ void load32(const float* p, int lane, float (&v)[32]) {
#pragma unroll
    for (int j = 0; j < 4; ++j) { const int e = j * 512 + lane * 8; const f32x4 a = *(const f32x4*)(p + e), b = *(const f32x4*)(p + e + 4);
        v[j * 8 + 0] = a.x; v[j * 8 + 1] = a.y; v[j * 8 + 2] = a.z; v[j * 8 + 3] = a.w; v[j * 8 + 4] = b.x; v[j * 8 + 5] = b.y; v[j * 8 + 6] = b.z; v[j * 8 + 7] = b.w; }
}
__device__ __forceinline__ void store32(float* p, int lane, const float (&v)[32]) {
#pragma unroll
    for (int j = 0; j < 4; ++j) { const int e = j * 512 + lane * 8; *(f32x4*)(p + e) = (f32x4){v[j * 8 + 0], v[j * 8 + 1], v[j * 8 + 2], v[j * 8 + 3]}; *(f32x4*)(p + e + 4) = (f32x4){v[j * 8 + 4], v[j * 8 + 5], v[j * 8 + 6], v[j * 8 + 7]}; }
}
__device__ __forceinline__ void store32_mod_bf16(bf16* p, const float* sh, const float* sc, int lane, const float (&v)[32]) {
#pragma unroll
    for (int j = 0; j < 4; ++j) { const int e = j * 512 + lane * 8; const f32x4 s0 = *(const f32x4*)(sh + e), s1 = *(const f32x4*)(sh + e + 4), c0 = *(const f32x4*)(sc + e), c1 = *(const f32x4*)(sc + e + 4);
        v4u o; o.x = pk2(v[j * 8 + 0] * (1.f + c0.x) + s0.x, v[j * 8 + 1] * (1.f + c0.y) + s0.y); o.y = pk2(v[j * 8 + 2] * (1.f + c0.z) + s0.z, v[j * 8 + 3] * (1.f + c0.w) + s0.w);
        o.z = pk2(v[j * 8 + 4] * (1.f + c1.x) + s1.x, v[j * 8 + 5] * (1.f + c1.y) + s1.y); o.w = pk2(v[j * 8 + 6] * (1.f + c1.z) + s1.z, v[j * 8 + 7] * (1.f + c1.w) + s1.w);
        *(v4u*)(p + e) = o; }
}
__device__ __forceinline__ void ln1_rows(Frame& F, int l, int nrows, bool dry = false) {
    const int gw = F.vcu * NWAVES + F.wave, NGW = F.G * NWAVES; float* X = (float*)(F.ws + WS_X); const float* O = (const float*)(F.ws + WS_O); bf16* H = (bf16*)(F.ws + WS_H);
    float* Xo = dry ? (float*)(F.ws + WS_LA) : X; bf16* Ho = dry ? (bf16*)(F.ws + WS_LB) : H;
    for (int row = gw; row < nrows; row += NGW) { const float* md = (const float*)(F.ws + WS_MOD) + ((size_t)l * 3 + mod_row(row)) * (6 * D);
        float z[32], o[32], gt[32]; load32(X + (size_t)row * D, F.lane, z); load32(md + 2 * D, F.lane, gt);
#pragma unroll
        for (int j = 0; j < 4; ++j) { float t8[8]; ld8bf((const bf16*)(F.ws + WS_O) + (size_t)row * D + j * 512 + F.lane * 8, t8);
#pragma unroll
            for (int i = 0; i < 8; ++i) o[j * 8 + i] = t8[i]; }
#pragma unroll
        for (int i = 0; i < 32; ++i) z[i] = ALPHA * z[i] + gt[i] * o[i];
        ln_row(z, gin(F.in[I_LN1G]) + (size_t)l * D, gin(F.in[I_LN1B]) + (size_t)l * D, F.lane);
        store32(Xo + (size_t)row * D, F.lane, z);
        store32_mod_bf16(Ho + (size_t)row * D, md + 3 * D, md + 4 * D, F.lane, z); }
}

__device__ __forceinline__ unsigned ord_key(float s, int k) { unsigned u = __builtin_bit_cast(unsigned, s); u = (u & 0x80000000u) ? ~u : (u | 0x80000000u); return (u & ~127u) | (unsigned)(127 - k); }
__device__ __forceinline__ float key_score(unsigned key) { const unsigned u = key & ~127u; return __builtin_bit_cast(float, (u & 0x80000000u) ? (u ^ 0x80000000u) : ~u); }
__device__ __forceinline__ void bitonic_top16(unsigned (&A)[16], const unsigned (&B)[16]) {
#pragma unroll
    for (int i = 0; i < 16; ++i) A[i] = A[i] > B[15 - i] ? A[i] : B[15 - i];
#pragma unroll
    for (int st = 8; st >= 1; st >>= 1)
#pragma unroll
        for (int i = 0; i < 16; ++i) if (!(i & st)) { const unsigned hi = A[i] > A[i + st] ? A[i] : A[i + st], lo = A[i] > A[i + st] ? A[i + st] : A[i]; A[i] = hi; A[i + st] = lo; }
}
__device__ __forceinline__ void ins16(unsigned (&L)[16], unsigned x) {
#pragma unroll
    for (int i = 0; i < 16; ++i) { const unsigned hi = L[i] > x ? L[i] : x; x = L[i] > x ? x : L[i]; L[i] = hi; }
}
__device__ __forceinline__ unsigned ord_key8(float s, unsigned tag) { unsigned u = __builtin_bit_cast(unsigned, s); u = (u & 0x80000000u) ? ~u : (u | 0x80000000u); return (u & ~255u) | tag; }
__device__ __forceinline__ float key_score8(unsigned key) { const unsigned u = key & ~255u; return __builtin_bit_cast(float, (u & 0x80000000u) ? (u ^ 0x80000000u) : ~u); }
__device__ __forceinline__ void peer_topk_unit(Frame& F, int l, int tile, int h) {
    int tid = F.tid; asm volatile("" : "+v"(tid));
    const int lane = tid & 63, wave = F.wave;
    LAS bf16* AQ = (LAS bf16*)F.lds; LAS float* SC = (LAS float*)(F.lds + 33792);
    LAS unsigned* bufA = (LAS unsigned*)F.lds; LAS unsigned* bufB = (LAS unsigned*)(F.lds + 33792); LAS unsigned* FIN = (LAS unsigned*)(F.lds + 66560); LAS unsigned char* PAIRT = (LAS unsigned char*)(F.lds + 99584);
    if (tid < 50) { int c = tid, i = 0; for (; i < 16; ++i) { const int n = 16 / (i + 1); if (c < n) break; c -= n; } PAIRT[tid] = (unsigned char)(i * 16 + c); }
    for (int idx = tid; idx < 64 * 64; idx += NTHR) { const int t = idx >> 6, c4 = (idx & 63) * 4; *(LAS v2u*)(AQ + t * 264 + c4) = *(const v2u*)((const bf16*)(F.ws + WS_QP) + (size_t)(tile * 64 + t) * D + h * 256 + c4); }
    __syncthreads();
    { const bf16* SK = (const bf16*)(F.ws + WS_SUBK) + (size_t)((l * 8 + h) * 2) * 128 * 128;
#pragma unroll
      for (int p = 0; p < 2; ++p) { bf16x8 bfr[4];
#pragma unroll
          for (int k = 0; k < 4; ++k) bfr[k] = frag_g(SK + (size_t)p * 128 * 128, 128, 16 * wave, 32 * k, lane);
#pragma unroll
          for (int m = 0; m < 4; ++m) { f32x4 acc = {0.f, 0.f, 0.f, 0.f};
#pragma unroll
              for (int k = 0; k < 4; ++k) acc = MFMA16(frag_lds(AQ, 264, 16 * m, p * 128 + 32 * k, lane), bfr[k], acc);
#pragma unroll
              for (int r = 0; r < 4; ++r) SC[(16 * m + 4 * (lane >> 4) + r) * 257 + p * 128 + 16 * wave + (lane & 15)] = acc[r]; } } }
    __syncthreads();
    const int t = lane, r = wave, p = r & 1, qd = r >> 1;
    unsigned L[16], B[16];
#pragma unroll
    for (int i = 0; i < 16; ++i) L[i] = 0u;
    { const LAS float* sp = SC + t * 257 + p * 128 + 32 * qd;
#pragma unroll 4
      for (int k = 0; k < 32; ++k) ins16(L, ord_key(sp[k], 32 * qd + k)); }
#pragma unroll
    for (int i = 0; i < 16; ++i) bufA[(r * 16 + i) * 64 + t] = L[i];
    __syncthreads();
#pragma unroll
    for (int i = 0; i < 16; ++i) B[i] = bufA[((r ^ 2) * 16 + i) * 64 + t];
    bitonic_top16(L, B);
#pragma unroll
    for (int i = 0; i < 16; ++i) bufB[(r * 16 + i) * 64 + t] = L[i];
    __syncthreads();
#pragma unroll
    for (int i = 0; i < 16; ++i) B[i] = bufB[((r ^ 4) * 16 + i) * 64 + t];
    bitonic_top16(L, B);
    if (qd == 0) {
#pragma unroll
        for (int i = 0; i < 16; ++i) FIN[(p * 16 + i) * 64 + t] = L[i]; }
    __syncthreads();
#pragma unroll
    for (int i = 0; i < 16; ++i) L[i] = 0u;
#pragma unroll
    for (int q = 0; q < 7; ++q) { const int c = q * 8 + r; if (c < 50) { const unsigned pr = PAIRT[c]; const unsigned ka = FIN[(0 * 16 + (pr >> 4)) * 64 + t], kb = FIN[(1 * 16 + (pr & 15)) * 64 + t];
            ins16(L, ord_key8(key_score(ka) + key_score(kb), pr)); } }
#pragma unroll
    for (int i = 0; i < 16; ++i) bufB[(r * 16 + i) * 64 + t] = L[i];
    __syncthreads();
#pragma unroll
    for (int i = 0; i < 16; ++i) B[i] = bufB[((r ^ 1) * 16 + i) * 64 + t];
    bitonic_top16(L, B);
#pragma unroll
    for (int i = 0; i < 16; ++i) bufA[(r * 16 + i) * 64 + t] = L[i];
    __syncthreads();
#pragma unroll
    for (int i = 0; i < 16; ++i) B[i] = bufA[((r ^ 2) * 16 + i) * 64 + t];
    bitonic_top16(L, B);
    __syncthreads();
#pragma unroll
    for (int i = 0; i < 16; ++i) bufB[(r * 16 + i) * 64 + t] = L[i];
    __syncthreads();
#pragma unroll
    for (int i = 0; i < 16; ++i) B[i] = bufB[((r ^ 4) * 16 + i) * 64 + t];
    bitonic_top16(L, B);
    { const float mx = key_score8(L[0]); float sum = 0.f, e0 = 0.f, e1 = 0.f; unsigned k0 = 0u, k1 = 0u;
#pragma unroll
      for (int i = 0; i < 16; ++i) { const float e = fexp(key_score8(L[i]) - mx); sum += e; if (i == 2 * r) { e0 = e; k0 = L[i]; } if (i == 2 * r + 1) { e1 = e; k1 = L[i]; } }
      const float inv = __builtin_amdgcn_rcpf(sum);
      const unsigned pa = k0 & 255u, pb = k1 & 255u;
      const int id0 = (127 - (int)(FIN[(0 * 16 + (pa >> 4)) * 64 + t] & 127u)) * 128 + (127 - (int)(FIN[(1 * 16 + (pa & 15)) * 64 + t] & 127u));
      const int id1 = (127 - (int)(FIN[(0 * 16 + (pb >> 4)) * 64 + t] & 127u)) * 128 + (127 - (int)(FIN[(1 * 16 + (pb & 15)) * 64 + t] & 127u));
      int* IDX = (int*)(F.ws + WS_IDX) + (size_t)(tile * 64 + t) * PE_SEL + h * 16 + 2 * r; float* GT = (float*)(F.ws + WS_GATE) + (size_t)(tile * 64 + t) * PE_SEL + h * 16 + 2 * r;
      *(int2*)IDX = make_int2(id0, id1); *(f32x2*)GT = (f32x2){e0 * inv, e1 * inv}; }
    __syncthreads();
}

#ifndef GPROBE_MASK
#define GPROBE_MASK (~0u)
#endif
#ifndef EBU_
#define EBU_ 8
#endif
#ifndef EBV_
#define EBV_ 8
#endif
constexpr int EB = 8;
__device__ __forceinline__ v32f ld_row6(const unsigned char* row, int lane) {
    const v4u a = *(const v4u*)(row + lane * 16); const v2u b = *(const v2u*)(row + 1024 + lane * 8);
    return __builtin_amdgcn_cvt_scalef32_pk32_f32_fp6((v6u){a.x, a.y, a.z, a.w, b.x, b.y}, 1.0f);
}
#define SCHED_FENCE() __builtin_amdgcn_sched_barrier(0)
template <int EB> __device__ __forceinline__ void ld_rows(GAS const unsigned char* TB, int sel, int k0, unsigned lo16, unsigned lo8, unsigned emask, v4u (&wa)[EB], v2u (&wb)[EB]) {
#pragma unroll
    for (int q = 0; q < EB; ++q) { const unsigned e = (unsigned)__builtin_amdgcn_readlane(sel, (k0 + q) & 63) & emask;
        GAS const unsigned char* r = TB + (size_t)e * EROW; asm volatile("" : "+s"(r));
        if (emask == 0x12345u) { wa[q] = (v4u){e, lo16, e ^ lo8, lo16 * 3u}; wb[q] = (v2u){e + lo8, lo16 ^ 0x5555u}; continue; }
        wa[q] = *(GAS const v4u*)(r + lo16); wb[q] = *(GAS const v2u*)(r + 1024 + lo8); }
}
typedef float f32p __attribute__((ext_vector_type(2)));
template <int EB> __device__ __forceinline__ void u_batch(const v4u (&wa)[EB], const v2u (&wb)[EB], const f32p (&hf)[16], int k0, int lane, int& dl, int& dh) {
#pragma unroll
    for (int q = 0; q < EB; ++q) { const int k = k0 + q; const v32f uf = __builtin_amdgcn_cvt_scalef32_pk32_f32_fp6((v6u){wa[q].x, wa[q].y, wa[q].z, wa[q].w, wb[q].x, wb[q].y}, 1.0f);
        f32p p0 = {0.f, 0.f}, p1 = {0.f, 0.f};
#pragma unroll
        for (int i = 0; i < 16; i += 2) { p0 = __builtin_elementwise_fma((f32p){uf[2 * i], uf[2 * i + 1]}, hf[i], p0); p1 = __builtin_elementwise_fma((f32p){uf[2 * i + 2], uf[2 * i + 3]}, hf[i + 1], p1); }
        p0 += p1;
        const int tb = __builtin_bit_cast(int, wave_total(p0.x + p0.y));
        if (k0 < 64) dl = (lane == (k & 63)) ? tb : dl; else dh = (lane == (k & 63)) ? tb : dh; }
}
template <int EB> __device__ __forceinline__ void v_batch(const v4u (&wa)[EB], const v2u (&wb)[EB], int k0, float csel, f32p (&acc)[16]) {
#pragma unroll
    for (int q = 0; q < EB; ++q) { const float cf = __builtin_bit_cast(float, __builtin_amdgcn_readlane(__builtin_bit_cast(int, csel), (k0 + q) & 63));
        const v32f vf = __builtin_amdgcn_cvt_scalef32_pk32_f32_fp6((v6u){wa[q].x, wa[q].y, wa[q].z, wa[q].w, wb[q].x, wb[q].y}, 1.0f);
        const f32p c2 = {cf, cf};
#pragma unroll
        for (int i = 0; i < 16; ++i) acc[i] = __builtin_elementwise_fma((f32p){vf[2 * i], vf[2 * i + 1]}, c2, acc[i]); }
}
template <int EB> __device__ __forceinline__ void peer_token(Frame& F, int l, int row, int kb, int ke, float (&acc)[32], unsigned emask = ~0u) {
    const int lane = F.lane; const unsigned lo16 = lane * 16, lo8 = lane * 8;
    GAS const unsigned char* UB = F.ws + WS_UB + (size_t)l * PE_NE * EROW; GAS const unsigned char* VB = F.ws + WS_VB + (size_t)l * PE_NE * EROW;
    const float* SU = (const float*)(F.ws + WS_SU) + (size_t)l * PE_NE; const float* SV = (const float*)(F.ws + WS_SV) + (size_t)l * PE_NE;
    const bf16* H = (const bf16*)(F.ws + WS_H);
    const int* IDX = (const int*)(F.ws + WS_IDX) + (size_t)row * PE_SEL; const float* GT = (const float*)(F.ws + WS_GATE) + (size_t)row * PE_SEL;
    const int il = IDX[lane], ih = IDX[64 + lane]; const float gl = GT[lane], gh = GT[64 + lane];
    f32p hf[16];
#pragma unroll
    for (int j = 0; j < 4; ++j) { const v4u t4 = *(const v4u*)(H + (size_t)row * D + lane * 32 + j * 8);
        hf[4 * j] = (f32p){bf_lo(t4.x), bf_hi(t4.x)}; hf[4 * j + 1] = (f32p){bf_lo(t4.y), bf_hi(t4.y)}; hf[4 * j + 2] = (f32p){bf_lo(t4.z), bf_hi(t4.z)}; hf[4 * j + 3] = (f32p){bf_lo(t4.w), bf_hi(t4.w)}; }
    const float sul = SU[il], suh = SU[ih], svl = SV[il], svh = SV[ih];
    SCHED_FENCE(); __builtin_amdgcn_s_waitcnt(0x0070); SCHED_FENCE();
    v4u a0[EB], a1[EB]; v2u b0[EB], b1[EB];
    ld_rows<EB>(UB, kb < 64 ? il : ih, kb, lo16, lo8, emask, a0, b0); SCHED_FENCE();
    int dl = 0, dh = 0;
#pragma unroll 1
    for (int k0 = kb; k0 < ke; k0 += 2 * EB) {
        ld_rows<EB>(UB, k0 < 64 ? il : ih, k0 + EB, lo16, lo8, emask, a1, b1); SCHED_FENCE();
        u_batch<EB>(a0, b0, hf, k0, lane, dl, dh); SCHED_FENCE();
        { const int kn = k0 + 2 * EB; const bool last = kn >= ke; const int k2 = last ? kb : kn; ld_rows<EB>(last ? VB : UB, k2 < 64 ? il : ih, k2, lo16, lo8, emask, a0, b0); } SCHED_FENCE();
        u_batch<EB>(a1, b1, hf, k0 + EB, lane, dl, dh); SCHED_FENCE(); }
    const float cl = gl * svl * gelu_erf(__builtin_bit_cast(float, dl) * sul), ch = gh * svh * gelu_erf(__builtin_bit_cast(float, dh) * suh);
    f32p ac2[16];
#pragma unroll
    for (int i = 0; i < 16; ++i) ac2[i] = (f32p){0.f, 0.f};
#pragma unroll 1
    for (int k0 = kb; k0 < ke; k0 += 2 * EB) {
        ld_rows<EB>(VB, k0 < 64 ? il : ih, k0 + EB, lo16, lo8, emask, a1, b1); SCHED_FENCE();
        v_batch<EB>(a0, b0, k0, k0 < 64 ? cl : ch, ac2); SCHED_FENCE();
        { const int kn = k0 + 2 * EB; const int k2 = kn >= ke ? k0 : kn; ld_rows<EB>(VB, k2 < 64 ? il : ih, k2, lo16, lo8, emask, a0, b0); } SCHED_FENCE();
        v_batch<EB>(a1, b1, k0 + EB, k0 < 64 ? cl : ch, ac2); SCHED_FENCE(); }
#pragma unroll
    for (int i = 0; i < 16; ++i) { acc[2 * i] = ac2[i].x; acc[2 * i + 1] = ac2[i].y; }
}
__device__ __forceinline__ void peer_finish(Frame& F, int l, int row, const float (&acc)[32], bool dry) {
    const int lane = F.lane;
    float* X = (float*)(F.ws + WS_X); bf16* H = (bf16*)(F.ws + WS_H); float* Xo = dry ? (float*)(F.ws + WS_LA) : X; bf16* Ho = dry ? (bf16*)(F.ws + WS_LB) : H; float* Oo = dry ? (float*)(F.ws + WS_LA) : (float*)F.out;
    const float* md = (const float*)(F.ws + WS_MOD) + ((size_t)l * 3 + mod_row(row)) * (6 * D);
    float z[32]; float s = 0.f;
#pragma unroll
    for (int q = 0; q < 8; ++q) { const int e = lane * 32 + q * 4; const f32x4 xv = *(const f32x4*)(X + (size_t)row * D + e), gv = *(const f32x4*)(md + 5 * D + e);
        z[q * 4 + 0] = ALPHA * xv.x + gv.x * acc[q * 4 + 0]; z[q * 4 + 1] = ALPHA * xv.y + gv.y * acc[q * 4 + 1]; z[q * 4 + 2] = ALPHA * xv.z + gv.z * acc[q * 4 + 2]; z[q * 4 + 3] = ALPHA * xv.w + gv.w * acc[q * 4 + 3]; }
#pragma unroll
    for (int i = 0; i < 32; ++i) s += z[i];
    const float mean = wave_sum(s) * (1.0f / D); float qv = 0.f;
#pragma unroll
    for (int i = 0; i < 32; ++i) { z[i] -= mean; qv += z[i] * z[i]; }
    const float rstd = __builtin_amdgcn_rsqf(wave_sum(qv) * (1.0f / D) + LN_EPS);
    const float* lg = gin(F.in[I_LN2G]) + (size_t)l * D; const float* lb = gin(F.in[I_LN2B]) + (size_t)l * D; const float* mn = (const float*)(F.ws + WS_MOD) + ((size_t)(l + 1 < DEPTH ? l + 1 : l) * 3 + mod_row(row)) * (6 * D);
    unsigned hw[16];
#pragma unroll
    for (int q = 0; q < 8; ++q) { const int e = lane * 32 + q * 4; const f32x4 g4 = *(const f32x4*)(lg + e), b4 = *(const f32x4*)(lb + e);
        f32x4 o; o.x = z[q * 4 + 0] * rstd * g4.x + b4.x; o.y = z[q * 4 + 1] * rstd * g4.y + b4.y; o.z = z[q * 4 + 2] * rstd * g4.z + b4.z; o.w = z[q * 4 + 3] * rstd * g4.w + b4.w;
        if (l + 1 < DEPTH) { *(f32x4*)(Xo + (size_t)row * D + e) = o; const f32x4 s4 = *(const f32x4*)(mn + e), c4 = *(const f32x4*)(mn + D + e);
            hw[2 * q] = pk2(o.x * (1.f + c4.x) + s4.x, o.y * (1.f + c4.y) + s4.y); hw[2 * q + 1] = pk2(o.z * (1.f + c4.z) + s4.z, o.w * (1.f + c4.w) + s4.w); }
        else *(f32x4*)(Oo + (size_t)row * D + e) = o; }
    if (l + 1 < DEPTH) {
#pragma unroll
        for (int j = 0; j < 4; ++j) *(v4u*)(Ho + (size_t)row * D + lane * 32 + j * 8) = (v4u){hw[4 * j], hw[4 * j + 1], hw[4 * j + 2], hw[4 * j + 3]}; }
}
__device__ __forceinline__ void peer_rows(Frame& F, int l, int nrows, bool dry = false) {
    const int gw = F.vcu * NWAVES + F.wave, NGW = F.G * NWAVES, lane = F.lane;
    for (int row = gw; row < NLAT; row += NGW) { Frame F2 = F; { int t_ = F.lane; asm volatile("" : "+v"(t_)); F2.lane = t_; }
        float acc[32]; peer_token<EBU_>(F2, l, row, 0, PE_SEL, acc, dry ? GPROBE_MASK : ~0u); { int t_ = F2.lane; asm volatile("" : "+v"(t_)); F2.lane = t_; } peer_finish(F2, l, row, acc, dry); }
    if (nrows > NLAT) { LAS float* PART = (LAS float*)F.lds;
        for (int r2 = F.vcu * 2 + (F.wave >> 2); r2 < NCTX; r2 += F.G * 2) { const int row = NLAT + r2, part = F.wave & 3, slot = F.wave >> 2; float acc[32]; Frame F2 = F; { int t_ = F.lane; asm volatile("" : "+v"(t_)); F2.lane = t_; }
            peer_token<EBU_>(F2, l, row, 32 * part, 32 * part + 32, acc, dry ? GPROBE_MASK : ~0u);
            if (part) { LAS float* pw = PART + ((slot * 3 + part - 1) * 32) * 64 + lane;
#pragma unroll
                for (int i = 0; i < 32; ++i) pw[i * 64] = acc[i]; }
            __syncthreads();
            if (part == 0) { const LAS float* pr = PART + (slot * 96) * 64 + lane;
#pragma unroll
                for (int p = 0; p < 3; ++p)
#pragma unroll
                    for (int i = 0; i < 32; ++i) acc[i] += pr[(p * 32 + i) * 64];
                peer_finish(F2, l, row, acc, dry); }
            __syncthreads(); } }
}
#ifndef MK_PER_PHASE
#define MK_PER_PHASE 0
#endif
constexpr int NPH_PRO = 3, NPH_LAYER = 9, NPHASES = NPH_PRO + DEPTH * NPH_LAYER;
__global__ void __launch_bounds__(NTHR, 2) trunk_fwd(Args args) {
    extern __shared__ __attribute__((aligned(16))) unsigned char lds_raw[];
    Frame F0;
    F0.lds = (LAS unsigned char*)lds_raw;
    F0.tid = threadIdx.x; F0.lane = F0.tid & 63; F0.wave = __builtin_amdgcn_readfirstlane(F0.tid >> 6);
    F0.G = gridDim.x; { const int bx = blockIdx.x; F0.vcu = (F0.G % 8 == 0) ? (bx % 8) * (F0.G / 8) + bx / 8 : bx; }
    F0.in = args.in; F0.out = (GAS float*)args.out; F0.ws = (GAS unsigned char*)args.ws;
    volatile LAS unsigned* MISC = (volatile LAS unsigned*)(F0.lds + MISC_OFF);
    for (int u = F0.tid; u < (LDS_BYTES - LDSCTL_OFF) / 4; u += NTHR) ((LAS unsigned*)(F0.lds + LDSCTL_OFF))[u] = 0u;
    __syncthreads();
    const int lo = args.ph_lo, hi = args.ph_hi;
    XcdBarrier bar; bar.bar = (unsigned*)(F0.ws + WS_CTL) + CW_BAR; bar.x = 0; bar.st = nullptr;
    if (hi - lo > 1) bar = xcd_barrier_post((unsigned*)(F0.ws + WS_CTL) + CW_BAR, MISC + 8);
#ifndef PHMASK
#define PHMASK 0xfff
#endif
#define PHM(b) ((PHMASK >> (b)) & 1)
#ifndef PHREP
#define PHREP 0
#endif
#define NREP(b) (1 + ((PHREP >> (b)) & 1))
#define IN(k) (lo <= (k) && (k) < hi)
#define LAUNDER() Frame F = F0; int bx_ = blockIdx.x; __builtin_amdgcn_s_waitcnt(0x0070); { int ws_ = F0.wave; asm volatile("" : "+s"(ws_)); int ln_; asm volatile("v_mbcnt_lo_u32_b32 %0, -1, 0\n\tv_mbcnt_hi_u32_b32 %0, -1, %0" : "=v"(ln_)); F.wave = ws_; F.lane = ln_; F.tid = ws_ * 64 + ln_; \
    GAS unsigned char* w_ = F0.ws; asm volatile("" : "+s"(w_)); F.ws = w_; int v_ = F0.vcu; asm volatile("" : "+s"(v_)); F.vcu = v_; int g_ = F0.G; asm volatile("" : "+s"(g_)); F.G = g_; \
    GAS float* o_ = F0.out; asm volatile("" : "+s"(o_)); F.out = o_; asm volatile("" : "+s"(bx_)); \
    unsigned l_ = (unsigned)(size_t)F0.lds; asm volatile("" : "+v"(l_)); F.lds = (LAS unsigned char*)(size_t)l_; }
#define SEAM(k) do { if (IN(k) && IN((k) + 1)) xcd_barrier(bar); } while (0)

    if (PHM(0) && IN(0)) for (int rep_ = 0; rep_ < NREP(0); ++rep_) { LAUNDER(); p0_prologue(F); } SEAM(0);
    if (PHM(1) && IN(1)) { LAUNDER(); p0b_mod_reduce(F); } SEAM(1);
    if (PHM(2) && IN(2)) { LAUNDER(); modulate_rows(F, 0, 0, MTOT); } SEAM(2);

#pragma unroll 1
    for (int l = 0; l < DEPTH; ++l) {
        const int pb = NPH_PRO + l * NPH_LAYER;
        const int mrows = (l + 1 < DEPTH) ? MTOT : NLAT;
        if (PHM(3) && IN(pb + 0)) for (int rep_ = 0; rep_ < NREP(3); ++rep_) { LAUNDER(); pg8::Gemm g{(const pg8::bf16_t*)(F.ws + WS_H), (const pg8::bf16_t*)(F.ws + WS_WIN) + (size_t)l * IN_PAD * D, MTOT, IN_PAD, D, D};
            pg8::StaticOrder S; S.init(MTOT, IN_PAD, F.G, bx_); pg8::EpiBf16<0> E{(pg8::bf16_t*)(F.ws + WS_P), IN_PAD, nullptr, 0, 0};
            pg8::gemm_phase<pg8::EpiBf16<0>, pg8::StaticOrder, false>(F.lds, g, S, E, nullptr, F.tid); }
        SEAM(pb + 0);
        if (PHM(4) && IN(pb + 1)) for (int rep_ = 0; rep_ < NREP(4); ++rep_) { LAUNDER(); for (int r2 = 0; r2 < NREP(12); ++r2) for (int u = F.vcu; u < NTILE * NH; u += F.G) lru_prep_unit(F, l, u >> 4, u & 15); asm volatile("" ::: "memory"); for (int r2 = 0; r2 < NREP(13); ++r2) { int cur_hd = -1;
                for (int v = F.vcu; v < 2 * NTILE * NH; v += F.G) { const int hh_ = (v >> 1) & 15, d_ = v & 1;
                    if (hh_ * 2 + d_ != cur_hd) { cur_hd = hh_ * 2 + d_; __syncthreads(); LAS float* MUS = (LAS float*)(F.lds + 125184); const float* mu = gin(F.in[I_MU]) + (size_t)l * 2 * RW_COLS;
                        for (int i = F.tid; i < 5 * 2 * 64; i += NTHR) { const int g = i >> 7, wh = (i >> 6) & 1, col = i & 63; const int rc = g < 3 ? g * RWW + hh_ * 64 : 3 * RWW + (g - 3) * 128 + d_ * 64; MUS[i] = mu[(size_t)wh * RW_COLS + rc + col]; }
                        __syncthreads(); }
                    rwkv_chunk_prep(F, l, v >> 5, hh_, d_); } } }
        SEAM(pb + 1);
        if (PHM(5) && IN(pb + 2)) for (int rep_ = 0; rep_ < NREP(5); ++rep_) { LAUNDER(); for (int u = F.vcu; u < 256; u += F.G) { if (u < 32 && F.wave >= 2 && F.wave < 4) lru_scan(F, u * 128 + F.tid - 128); rwkv_chain_chunks(F, u); } }
        SEAM(pb + 2);
        if (PHM(6) && IN(pb + 3)) for (int rep_ = 0; rep_ < NREP(6); ++rep_) { LAUNDER(); for (int u = F.vcu; u < 4 * NTILE; u += F.G) merge_unit(F, l, u); }
        SEAM(pb + 3);
        if (PHM(7) && IN(pb + 4)) for (int rep_ = 0; rep_ < NREP(7); ++rep_) { LAUNDER(); pg8::Gemm g{(const pg8::bf16_t*)(F.ws + WS_H), (const pg8::bf16_t*)(F.ws + WS_WOUT) + (size_t)l * D * D, mrows, D, D, D};
            pg8::StaticOrder S; S.init(mrows, D, F.G, bx_); pg8::EpiBf16<0> E{(pg8::bf16_t*)(F.ws + WS_O), D, nullptr, 0, 0};
            pg8::gemm_phase<pg8::EpiBf16<0>, pg8::StaticOrder, false>(F.lds, g, S, E, nullptr, F.tid); }
        SEAM(pb + 4);
        if (PHM(8) && IN(pb + 5)) { LAUNDER(); if (NREP(8) > 1) ln1_rows(F, l, mrows, true); ln1_rows(F, l, mrows); }
        SEAM(pb + 5);
        if (PHM(9) && IN(pb + 6)) for (int rep_ = 0; rep_ < NREP(9); ++rep_) { LAUNDER(); pg8::Gemm g{(const pg8::bf16_t*)(F.ws + WS_H), (const pg8::bf16_t*)(F.ws + WS_WQ) + (size_t)l * D * D, mrows, D, D, D};
            pg8::StaticOrder S; S.init(mrows, D, F.G, bx_); pg8::EpiBf16<0> E{(pg8::bf16_t*)(F.ws + WS_QP), D, nullptr, 0, 0};
            pg8::gemm_phase<pg8::EpiBf16<0>, pg8::StaticOrder, false>(F.lds, g, S, E, nullptr, F.tid); }
        SEAM(pb + 6);
        if (PHM(10) && IN(pb + 7)) for (int rep_ = 0; rep_ < NREP(10); ++rep_) { LAUNDER(); for (int u = F.vcu; u < (mrows / 64) * PE_H; u += F.G) peer_topk_unit(F, l, u >> 3, u & 7); }
        SEAM(pb + 7);
        if (PHM(11) && IN(pb + 8)) { LAUNDER(); if (NREP(11) > 1) peer_rows(F, l, mrows, true); peer_rows(F, l, mrows); }
        if (l + 1 < DEPTH) SEAM(pb + 8);
    }
#undef IN
#undef SEAM
}

extern "C" void kernel_launch(void* const* d_in, const int* in_sizes, int n_in, void* d_out, int out_size, void* d_ws, size_t ws_size, hipStream_t stream) {
    static int grid = 0;
    if (grid == 0) {
        if (n_in != N_IN || out_size != NLAT * D || ws_size < WS_END) { fprintf(stderr, "kernel_launch: unexpected shapes (n_in %d, out %d, ws %zu < %zu)\n", n_in, out_size, ws_size, (size_t)WS_END); grid = -1; return; }
        int dev = 0, cus = 0, per_cu = 0;
        if (hipGetDevice(&dev) != hipSuccess || hipDeviceGetAttribute(&cus, hipDeviceAttributeMultiprocessorCount, dev) != hipSuccess) { grid = -1; return; }
        if (hipFuncSetAttribute((const void*)trunk_fwd, hipFuncAttributeMaxDynamicSharedMemorySize, LDS_BYTES) != hipSuccess) { fprintf(stderr, "kernel_launch: hipFuncSetAttribute failed\n"); grid = -1; return; }
        if (hipOccupancyMaxActiveBlocksPerMultiprocessor(&per_cu, (const void*)trunk_fwd, NTHR, LDS_BYTES) != hipSuccess || per_cu < 1) fprintf(stderr, "kernel_launch: occupancy query reports %d\n", per_cu);
        (void)hipGetLastError();
        grid = cus;
    }
    if (grid < 0) return;
    (void)hipMemsetAsync((char*)d_ws + WS_CTL, 0, CTL_ZERO_BYTES, stream);
    Args a{};
    for (int i = 0; i < N_IN; ++i) a.in[i] = (const float*)d_in[i];
    a.out = (float*)d_out; a.ws = (unsigned char*)d_ws;
#if MK_PER_PHASE
    for (int ph = 0; ph < NPHASES; ++ph) { a.ph_lo = ph; a.ph_hi = ph + 1; hipLaunchKernelGGL(trunk_fwd, dim3(grid), dim3(NTHR), LDS_BYTES, stream, a); }
#else
    a.ph_lo = 0; a.ph_hi = NPHASES;
    hipLaunchKernelGGL(trunk_fwd, dim3(grid), dim3(NTHR), LDS_BYTES, stream, a);
#endif
    const hipError_t le = hipPeekAtLastError();
    if (le != hipSuccess) fprintf(stderr, "kernel_launch: launch failed: %s\n", hipGetErrorName(le));
}
```

```cpp
#include <hip/hip_runtime.h>
#include <cstdio>
#include <cstdint>

constexpr int D = 2048, NB = 2, SEQ = 4096, DEPTH = 4, CTXL = 256;
constexpr int NLAT = NB * SEQ, NCTX = NB * CTXL, MTOT = NLAT + NCTX;
constexpr int LRW = 1024, RWW = 1024, NH = 16, HD = 64;
constexpr int RW_COLS = 3488, IN_COLS = 5536, IN_PAD = 5632;
constexpr int PE_H = 8, PE_K = 128, PE_DQ = 256, PE_TOP = 16, PE_NE = 16384, PE_SEL = PE_H * PE_TOP;
constexpr int NTILE = MTOT / 64;
constexpr float ALPHA = 1.681792830507429f;
constexpr float LN_EPS = 1e-5f, GN_EPS = 64e-5f;
constexpr int KSPLIT = 16;

enum { I_X = 0, I_C, I_CTX, I_CCTX, I_ADAW, I_ADAB, I_WIN, I_CONVW, I_CONVB, I_WA, I_BA, I_WX, I_BX, I_LAM, I_MU, I_W0, I_W2, I_A0, I_A2, I_G2,
       I_KK, I_KA, I_RK, I_GNG, I_GNB, I_WOUT, I_LN1G, I_LN1B, I_WQ, I_SUBK, I_U, I_V, I_LN2G, I_LN2B, N_IN };

constexpr size_t MiB = 1u << 20;
constexpr size_t al(size_t x) { return (x + MiB - 1) / MiB * MiB; }
constexpr size_t WS_CTL = 0, CTL_ZERO_BYTES = 1 * MiB;
constexpr size_t WS_MOD   = WS_CTL + CTL_ZERO_BYTES;
constexpr size_t WS_MODP  = al(WS_MOD + (size_t)DEPTH * 3 * 6 * D * 4);
constexpr size_t WS_WIN   = al(WS_MODP + (size_t)KSPLIT * DEPTH * 3 * 6 * D * 4);
constexpr size_t WS_WOUT  = al(WS_WIN + (size_t)DEPTH * IN_PAD * D * 2);
constexpr size_t WS_WQ    = al(WS_WOUT + (size_t)DEPTH * D * D * 2);
constexpr size_t WS_SUBK  = al(WS_WQ + (size_t)DEPTH * D * D * 2);
constexpr size_t WS_WLRU  = al(WS_SUBK + (size_t)DEPTH * 8 * 2 * 128 * 128 * 2);
constexpr size_t WS_W2T   = al(WS_WLRU + (size_t)DEPTH * 2 * 2 * 16 * 64 * 64 * 2);
constexpr size_t WS_A2T   = al(WS_W2T + (size_t)DEPTH * 2 * 1024 * 64 * 2);
constexpr size_t WS_G2T   = al(WS_A2T + (size_t)DEPTH * 2 * 1024 * 64 * 2);
constexpr size_t WS_UB    = al(WS_G2T + (size_t)DEPTH * 1024 * 160 * 2);
constexpr size_t WS_VB    = al(WS_UB + (size_t)DEPTH * PE_NE * D);
constexpr size_t WS_SU    = al(WS_VB + (size_t)DEPTH * PE_NE * D);
constexpr size_t WS_SV    = al(WS_SU + (size_t)DEPTH * PE_NE * 4);
constexpr size_t WS_X     = al(WS_SV + (size_t)DEPTH * PE_NE * 4);
constexpr size_t WS_H     = al(WS_X + (size_t)MTOT * D * 4);
constexpr size_t WS_P     = al(WS_H + (size_t)MTOT * D * 2);
constexpr size_t WS_LA    = al(WS_P + (size_t)MTOT * IN_PAD * 4);
constexpr size_t WS_LB    = al(WS_LA + (size_t)2 * MTOT * LRW * 4);
constexpr size_t WS_LAGG  = al(WS_LB + (size_t)2 * MTOT * LRW * 4);
constexpr size_t WS_LHIN  = al(WS_LAGG + (size_t)4 * NTILE * LRW * 4);
constexpr int KSL = 8;
constexpr size_t WS_SLAB  = al(WS_LHIN + (size_t)2 * NTILE * LRW * 4);
constexpr size_t WS_YL    = al(WS_SLAB + (size_t)2 * KSL * NCTX * D * 4);
constexpr int NUNIT = NTILE * NH * 2;
constexpr size_t WS_RV    = al(WS_YL + 4096);
constexpr size_t WS_QM    = al(WS_RV + (size_t)MTOT * RWW * 4);
constexpr size_t WS_PHI   = al(WS_QM + (size_t)NUNIT * 4096 * 2);
constexpr size_t WS_Y0F   = al(WS_PHI + (size_t)NUNIT * 4096 * 2);
constexpr size_t WS_PSF   = al(WS_Y0F + (size_t)NUNIT * 4096 * 2);
constexpr size_t WS_YR    = al(WS_PSF + (size_t)NUNIT * 4096 * 2);
constexpr size_t WS_BETA  = al(WS_YR + (size_t)2 * MTOT * RWW * 4);
constexpr size_t WS_IDX   = al(WS_BETA + (size_t)2 * MTOT * NH * 4);
constexpr size_t WS_GATE  = al(WS_IDX + (size_t)MTOT * PE_SEL * 4);
constexpr size_t WS_END   = al(WS_GATE + (size_t)MTOT * PE_SEL * 4);
constexpr size_t WS_O = WS_P;
constexpr size_t WS_QP = WS_P + (size_t)MTOT * D * 4;
static_assert(WS_QP + (size_t)MTOT * D * 4 <= WS_LA, "O/QP overlay inside P");

constexpr int CW_BAR = 4096;

constexpr int RING_BYTES = 131072;
constexpr int LDSCTL_OFF = RING_BYTES, MISC_OFF = LDSCTL_OFF + 320;
constexpr int LDS_BYTES = 147456;
constexpr int NWAVES = 8, NTHR = 512;

#define GAS __attribute__((address_space(1)))
#define LAS __attribute__((address_space(3)))
typedef unsigned short bf16;
typedef unsigned v4u __attribute__((ext_vector_type(4)));
typedef unsigned v2u __attribute__((ext_vector_type(2)));
typedef float f32x4 __attribute__((ext_vector_type(4)));
typedef float f32x2 __attribute__((ext_vector_type(2)));
typedef short bf16x8 __attribute__((ext_vector_type(8)));
typedef unsigned v6u __attribute__((ext_vector_type(6)));
typedef unsigned v16u __attribute__((ext_vector_type(16)));
typedef float v32f __attribute__((ext_vector_type(32)));
typedef __bf16 v32bf __attribute__((ext_vector_type(32)));
constexpr int EROW = 1536;
#define RLX_AGENT __ATOMIC_RELAXED, __HIP_MEMORY_SCOPE_AGENT
#define LDS_WAIT() asm volatile("s_waitcnt lgkmcnt(0)" ::: "memory")
#define VM_WAIT() asm volatile("s_waitcnt vmcnt(0)" ::: "memory")

__device__ __forceinline__ const float* gin(const float* p) { return (const float*)(const GAS float*)p; }
__device__ __forceinline__ unsigned f2bf(float f) { unsigned u = __builtin_bit_cast(unsigned, f); return (u + 0x7fffu + ((u >> 16) & 1u)) >> 16; }
typedef __bf16 bf16x2t __attribute__((ext_vector_type(2)));
__device__ __forceinline__ unsigned pk2(float lo, float hi) { return __builtin_bit_cast(unsigned, __builtin_convertvector((f32x2){lo, hi}, bf16x2t)); }
__device__ __forceinline__ float bf_lo(unsigned w) { return __builtin_bit_cast(float, w << 16); }
__device__ __forceinline__ float bf_hi(unsigned w) { return __builtin_bit_cast(float, w & 0xffff0000u); }
__device__ __forceinline__ float fexp(float x) { return __builtin_amdgcn_exp2f(x * 1.4426950408889634f); }
__device__ __forceinline__ float fsigmoid(float x) { return __builtin_amdgcn_rcpf(1.0f + fexp(-x)); }
__device__ __forceinline__ float fsoftplus(float x) { return fmaxf(x, 0.f) + 0.6931471805599453f * __builtin_amdgcn_logf(1.0f + fexp(-fabsf(x))); }
__device__ __forceinline__ float ftanh(float x) { const float e = fexp(2.0f * x); return 1.0f - 2.0f * __builtin_amdgcn_rcpf(e + 1.0f); }
__device__ __forceinline__ float gelu_tanh(float x) { return 0.5f * x * (1.0f + ftanh(0.7978845608028654f * (x + 0.044715f * x * x * x))); }
__device__ __forceinline__ float gelu_erf(float v) {
    const float av = fabsf(v), t = __builtin_amdgcn_rcpf(av * 0.2316418882f + 1.0f);
    float q = t * 0.5307027145f + (-0.7265760135f); q = q * t + 0.7107068705f; q = q * t + (-0.142248368f); q = q * t + 0.127414796f; q = q * t;
    const float e = __builtin_amdgcn_exp2f((v * v) * (-0.72134752044f));
    const float m = v * (q * e);
    return v < 0.f ? m : v - m;
}
template <int CTRL> __device__ __forceinline__ float dpp_f(float v) { return __builtin_bit_cast(float, __builtin_amdgcn_update_dpp(0, __builtin_bit_cast(int, v), CTRL, 0xf, 0xf, true)); }
__device__ __forceinline__ float red8(float v) { v += dpp_f<0xB1>(v); v += dpp_f<0x4E>(v); v += dpp_f<0x141>(v); return v; }
__device__ __forceinline__ float red16(float v) { v = red8(v); v += dpp_f<0x140>(v); return v; }
__device__ __forceinline__ float wave_total(float v) {
    v = red16(v);
    v += __builtin_bit_cast(float, __builtin_amdgcn_update_dpp(0, __builtin_bit_cast(int, v), 0x142, 0xa, 0xf, false));
    v += __builtin_bit_cast(float, __builtin_amdgcn_update_dpp(0, __builtin_bit_cast(int, v), 0x143, 0xc, 0xf, false));
    return __builtin_bit_cast(float, __builtin_amdgcn_readlane(__builtin_bit_cast(int, v), 63));
}
__device__ __forceinline__ float wave_sum(float v) { return wave_total(v); }
__device__ __forceinline__ float wave_max(float v) {
    v = fmaxf(v, dpp_f<0xB1>(v)); v = fmaxf(v, dpp_f<0x4E>(v)); v = fmaxf(v, dpp_f<0x141>(v)); v = fmaxf(v, dpp_f<0x140>(v));
    const float a = __builtin_bit_cast(float, __builtin_amdgcn_readlane(__builtin_bit_cast(int, v), 0)), b = __builtin_bit_cast(float, __builtin_amdgcn_readlane(__builtin_bit_cast(int, v), 16));
    const float c = __builtin_bit_cast(float, __builtin_amdgcn_readlane(__builtin_bit_cast(int, v), 32)), d = __builtin_bit_cast(float, __builtin_amdgcn_readlane(__builtin_bit_cast(int, v), 48));
    return fmaxf(fmaxf(a, b), fmaxf(c, d));
}
#define EBU_ 4
#define XB_TMO      128
#define XB_XCNT(j)  (256  + 64 * (j))
#define XB_XSUB(j)  (1280 + 64 * (j))
#define XB_XGEN(j)  (2304 + 64 * (j))
#define XB_TOP      3328
#define XB_TOPGEN   3392
#define XCD_BAR_WORDS 3456
#define XB_SPIN_CAP (1u << 18)

__device__ __forceinline__ unsigned xb_ld(unsigned* p)              { return __hip_atomic_load(p, __ATOMIC_RELAXED, __HIP_MEMORY_SCOPE_AGENT); }
__device__ __forceinline__ unsigned xb_add(unsigned* p, unsigned v) { return __hip_atomic_fetch_add(p, v, __ATOMIC_RELAXED, __HIP_MEMORY_SCOPE_AGENT); }
__device__ __forceinline__ unsigned xb_xcc_id() { return (unsigned)__builtin_amdgcn_s_getreg((3 << 11) | 20) & 0xFu; }
#define XB_SPIN(cond, bar) do { unsigned _sp = 0; while (cond) { __builtin_amdgcn_s_sleep(1); \
    if ((++_sp & 255u) == 0u) { if (xb_ld(&(bar)[XB_TMO])) break; if (_sp > XB_SPIN_CAP) { atomicAdd(&(bar)[XB_TMO], 1u); break; } } } } while (0)

struct XcdBarrier {
    unsigned* bar; unsigned x;
    volatile LAS unsigned* st;
};

__device__ __forceinline__ XcdBarrier xcd_barrier_post(unsigned* bar, volatile LAS unsigned* st) {
    XcdBarrier b; b.bar = bar; b.x = xb_xcc_id(); b.st = st;
    if (threadIdx.x == 0) (void)xb_add(&bar[XB_XCNT(b.x)], 1u);
    return b;
}
__device__ __forceinline__ void xcd_barrier_complete(unsigned* bar, unsigned x, unsigned& nloc, unsigned& nx) {
    const unsigned G = gridDim.x * gridDim.y * gridDim.z;
    unsigned sum, cnt, mine, sp = 0u;
    for (;;) {
        sum = 0u; cnt = 0u; mine = 0u;
#pragma unroll
        for (unsigned j = 0; j < 16; ++j) { const unsigned c = xb_ld(&bar[XB_XCNT(j)]); sum += c; cnt += (c > 0u) ? 1u : 0u; }
        if (sum == G) { mine = xb_ld(&bar[XB_XCNT(x)]); break; }
        __builtin_amdgcn_s_sleep(1);
        if ((++sp & 255u) == 0u) { if (xb_ld(&bar[XB_TMO])) break; if (sp > XB_SPIN_CAP) { atomicAdd(&bar[XB_TMO], 1u); break; } }
    }
    nloc = mine > 0u ? mine : 1u; nx = cnt > 0u ? cnt : 1u;
}

__device__ __forceinline__ void xcd_barrier(const XcdBarrier& b) {
    asm volatile("s_waitcnt vmcnt(0)" ::: "memory");
    __syncthreads();
    if (threadIdx.x == 0) {
        unsigned* bar = b.bar;
        __builtin_amdgcn_s_waitcnt(0);
        unsigned nloc = b.st[0], nx = b.st[1];
        if (nloc == 0u) { xcd_barrier_complete(bar, b.x, nloc, nx); b.st[0] = nloc; b.st[1] = nx; }
        const unsigned old = xb_add(&bar[XB_XSUB(b.x)], 1u);
        const unsigned gen = old / nloc;
        if (old + 1u == (gen + 1u) * nloc) {
            __builtin_amdgcn_fence(__ATOMIC_RELEASE, "agent");
            asm volatile("s_waitcnt vmcnt(0)" ::: "memory");
            const unsigned og = xb_add(&bar[XB_TOP], 1u);
            const unsigned tg = og / nx;
            if (og + 1u == (tg + 1u) * nx) xb_add(&bar[XB_TOPGEN], 1u);
            else XB_SPIN(xb_ld(&bar[XB_TOPGEN]) == tg, bar);
            __builtin_amdgcn_fence(__ATOMIC_ACQUIRE, "agent");
            xb_add(&bar[XB_XGEN(b.x)], 1u);
            asm volatile("s_waitcnt vmcnt(0)" ::: "memory");
        } else {
            XB_SPIN(xb_ld(&bar[XB_XGEN(b.x)]) == gen, bar);
            __builtin_amdgcn_fence(__ATOMIC_ACQUIRE, "agent");
            asm volatile("s_waitcnt vmcnt(0)" ::: "memory");
        }
    }
    __syncthreads();
}
namespace pg8 {
#define PG8_LAS __attribute__((address_space(3)))
typedef unsigned short bf16_t;
typedef short bf16x8 __attribute__((ext_vector_type(8)));
typedef float f32x4 __attribute__((ext_vector_type(4)));
typedef unsigned u32x4 __attribute__((ext_vector_type(4)));
constexpr int BM = 256, BK = 64, HALF = 128, HTB = HALF * BK * 2  , STAGE_BYTES = 8 * HTB, NXCD = 8, WGM = 8;

__host__ __device__ __forceinline__ int lds_byte(int r, int c) { const int st = (r >> 4) * 2 + (c >> 5), rr = r & 15, cc = c & 31, ob = rr * 64 + cc * 2; return st * 1024 + (ob ^ (((ob >> 9) & 1) << 5)); }
__host__ __device__ __forceinline__ void stage_rc(int b, int& R, int& C) { const int st = b / 1024, sb = b % 1024, swz = sb ^ (((sb >> 9) & 1) << 5); R = (st >> 1) * 16 + swz / 64; C = (st & 1) * 32 + (swz % 64) / 2; }
__host__ __device__ __forceinline__ int perm32(int rho) { const int n = rho >> 4, i = rho & 15; return 8 * (i >> 2) + 4 * n + (i & 3); }

struct Unit { int pm, pn, kofs = 0, slab = 0; };
struct Gemm { const bf16_t* A; const bf16_t* Bt; int M, N, K, ld; };

struct StaticOrder {
    int nM, nN, nwg, G, c;
    __host__ __device__ void init(int M, int N, int G_, int c_) { nM = M / BM; nN = N / BM; nwg = nM * nN; G = G_; c = c_; }
    __host__ __device__ bool next(int i, Unit& u) const {
        const long L = (long)i * G + c; if (L >= nwg) return false;
        int wgid = (int)L; { const int q = nwg / NXCD, r = nwg % NXCD, xcd = wgid % NXCD, off = wgid / NXCD; wgid = (xcd < r ? xcd * (q + 1) : r * (q + 1) + (xcd - r) * q) + off; }
        const int nig = WGM * nN, gid = wgid / nig, fm = gid * WGM, gsz = (nM - fm) < WGM ? (nM - fm) : WGM;
        u.pm = fm + ((wgid % nig) % gsz); u.pn = (wgid % nig) / gsz; return true;
    }
    __device__ __forceinline__ void a_ready(const Unit&) const {}
    __device__ __forceinline__ void done(const Unit&) const {}
};
struct SplitKOrder {
    int nM, nN, nS, klen, G, c;
    __host__ __device__ void init(int M, int N, int nS_, int klen_, int G_, int c_) { nM = M / BM; nN = N / BM; nS = nS_; klen = klen_; G = G_; c = c_; }
    __host__ __device__ bool next(int i, Unit& u) const { const long L = (long)i * G + c; if (L >= (long)nM * nN * nS) return false; const int l = (int)L; u.pm = l % nM; u.pn = (l / nM) % nN; const int ks = l / (nM * nN); u.kofs = ks * klen; u.slab = ks; return true; }
    __device__ __forceinline__ void a_ready(const Unit&) const {}
    __device__ __forceinline__ void done(const Unit&) const {}
};
struct CountedOrder : StaticOrder {
    const unsigned* ready; unsigned need; unsigned* tmo;
    __device__ __forceinline__ void a_ready(const Unit& u) const {
        if (threadIdx.x < 64) {
            const unsigned long long t0 = __builtin_amdgcn_s_memrealtime(); unsigned polls = 0;
            while ((unsigned)__builtin_amdgcn_readfirstlane(__hip_atomic_load(ready + 64 * u.pm, __ATOMIC_RELAXED, __HIP_MEMORY_SCOPE_AGENT)) < need) {
                if ((++polls & 255u) == 0u && __builtin_amdgcn_readfirstlane(__hip_atomic_load(tmo, __ATOMIC_RELAXED, __HIP_MEMORY_SCOPE_AGENT)) != 0u) break;
                if (__builtin_amdgcn_s_memrealtime() - t0 > 2000000ull) {
                    if (threadIdx.x == 0) { unsigned expect = 0u; __hip_atomic_compare_exchange_strong(tmo + 1, &expect, 0x600u | (unsigned)(u.pm & 0xff), __ATOMIC_RELAXED, __ATOMIC_RELAXED, __HIP_MEMORY_SCOPE_AGENT); __hip_atomic_store(tmo, 1u, __ATOMIC_RELAXED, __HIP_MEMORY_SCOPE_AGENT); }
                    break; }
                __builtin_amdgcn_s_sleep(2); }
            __builtin_amdgcn_fence(__ATOMIC_ACQUIRE, "agent");
            asm volatile("s_waitcnt vmcnt(0)" ::: "memory");
        }
#if !defined(BROKEN_HOOK_NO_BARRIER)
        asm volatile("" ::: "memory"); __builtin_amdgcn_s_barrier(); asm volatile("" ::: "memory");
#endif
    }
};

__device__ __forceinline__ unsigned cvt_pk_bf16(float lo, float hi) { unsigned r; asm volatile("v_cvt_pk_bf16_f32 %0, %1, %2" : "=v"(r) : "v"(lo), "v"(hi)); return r; }
typedef float f32x2 __attribute__((ext_vector_type(2)));
__device__ __forceinline__ f32x2 gelu_pk(f32x2 v) {
    const f32x2 av = __builtin_elementwise_abs(v), d = av * 0.2316418882f + 1.0f;
    f32x2 t; t.x = __builtin_amdgcn_rcpf(d.x); t.y = __builtin_amdgcn_rcpf(d.y);
    f32x2 q = t * 0.5307027145f + (-0.7265760135f); q = q * t + 0.7107068705f; q = q * t + (-0.142248368f); q = q * t + 0.127414796f; q = q * t;
    const f32x2 s = (v * v) * (-0.72134752044f);
    f32x2 e; e.x = __builtin_amdgcn_exp2f(s.x); e.y = __builtin_amdgcn_exp2f(s.y);
    const f32x2 m = v * (q * e), r = v - m;
    f32x2 o; o.x = v.x < 0.f ? m.x : r.x; o.y = v.y < 0.f ? m.y : r.y; return o;
}

struct EpiF32 {
    static constexpr bool PERM = false, AFTER_DRAIN = false;
    float* C; int ldc; const float* bias; size_t slab_stride = 0;
    __device__ __forceinline__ void operator()(const f32x4 (&acc)[2][2][4][2], const Unit& u, int wr, int wc, int fr, int fq) const {
        const int row0 = u.pm * BM + wr * 64 + fr, col0 = u.pn * BM + wc * 32 + 4 * fq; float* const Cb = C + (size_t)u.slab * slab_stride;
        f32x4 bv[2][2];
#pragma unroll
        for (int bj = 0; bj < 2; ++bj)
#pragma unroll
            for (int n = 0; n < 2; ++n) bv[bj][n] = bias ? *(const f32x4*)(bias + col0 + bj * HALF + n * 16) : (f32x4){0.f, 0.f, 0.f, 0.f};
#pragma unroll
        for (int ai = 0; ai < 2; ++ai)
#pragma unroll
            for (int m = 0; m < 4; ++m) { float* rowp = Cb + (size_t)(row0 + ai * HALF + m * 16) * ldc + col0;
#pragma unroll
                for (int bj = 0; bj < 2; ++bj)
#pragma unroll
                    for (int n = 0; n < 2; ++n) *(f32x4*)(rowp + bj * HALF + n * 16) = acc[ai][bj][m][n] + bv[bj][n]; }
    }
};
template <int ACT  > struct EpiBf16 {
    static constexpr bool PERM = true, AFTER_DRAIN = false;
    bf16_t* O; int ldc; const float* bias; int split_cols; size_t split_stride;
    __device__ __forceinline__ void operator()(const f32x4 (&acc)[2][2][4][2], const Unit& u, int wr, int wc, int fr, int fq) const {
        const int row0 = u.pm * BM + wr * 64 + fr; int colt = u.pn * BM; bf16_t* base = O;
        if (split_cols) { const int t = colt / split_cols; base += (size_t)t * split_stride; colt -= t * split_cols; }
        const int col0 = colt + wc * 32 + 8 * fq, bcol0 = u.pn * BM + wc * 32 + 8 * fq;
        f32x4 bv[2][2];
#pragma unroll
        for (int bj = 0; bj < 2; ++bj)
#pragma unroll
            for (int n = 0; n < 2; ++n) bv[bj][n] = bias ? *(const f32x4*)(bias + bcol0 + bj * HALF + 4 * n) : (f32x4){0.f, 0.f, 0.f, 0.f};
#pragma unroll
        for (int ai = 0; ai < 2; ++ai)
#pragma unroll
            for (int m = 0; m < 4; ++m) { bf16_t* rowp = base + (size_t)(row0 + ai * HALF + m * 16) * ldc + col0;
#pragma unroll
                for (int bj = 0; bj < 2; ++bj) { f32x4 v0 = acc[ai][bj][m][0] + bv[bj][0], v1 = acc[ai][bj][m][1] + bv[bj][1];
                    if (ACT == 1) { f32x2 a = gelu_pk((f32x2){v0[0], v0[1]}), b = gelu_pk((f32x2){v0[2], v0[3]}), c = gelu_pk((f32x2){v1[0], v1[1]}), d = gelu_pk((f32x2){v1[2], v1[3]});
                        v0 = (f32x4){a.x, a.y, b.x, b.y}; v1 = (f32x4){c.x, c.y, d.x, d.y}; }
                    if (ACT == 2) {
#pragma unroll
                        for (int j = 0; j < 4; ++j) { v0[j] = 0.5f * v0[j] * (1.0f + erff(v0[j] * 0.70710678f)); v1[j] = 0.5f * v1[j] * (1.0f + erff(v1[j] * 0.70710678f)); } }
                    u32x4 w; w.x = cvt_pk_bf16(v0[0], v0[1]); w.y = cvt_pk_bf16(v0[2], v0[3]); w.z = cvt_pk_bf16(v1[0], v1[1]); w.w = cvt_pk_bf16(v1[2], v1[3]);
                    *(u32x4*)(rowp + bj * HALF) = w; } }
    }
};
template <class Epi, class Sched, bool STAMP = false>
__device__ __forceinline__ void gemm_phase(PG8_LAS unsigned char* lds, const Gemm g, const Sched& S, const Epi& E, unsigned long long* stamps, const int tid) {
    const int  wid = __builtin_amdgcn_readfirstlane(tid >> 6), lane = tid & 63, wr = wid >> 2, wc = wid & 3, fr = lane & 15, fq = lane >> 4;
    const int K = g.ld, nt = g.K / BK;
    int ts_lo = 0, ts_hi = 0, nts = 0; const unsigned long long rt_entry = STAMP ? (unsigned long long)wall_clock64() : 0ull;
#define PG8_STAMP() do { if (STAMP && wid == 0 && nts < 64) { const unsigned long long _c = (unsigned long long)clock64(); \
        ts_lo = (lane == nts) ? (int)(unsigned)_c : ts_lo; ts_hi = (lane == nts) ? (int)(unsigned)(_c >> 32) : ts_hi; ++nts; } } while (0)
    PG8_STAMP();
    unsigned voffA[2], voffB[2];
#pragma unroll
    for (int i = 0; i < 2; ++i) { int R, C; stage_rc(tid * 16 + i * 8192, R, C); const int Rb = Epi::PERM ? ((R & ~31) + perm32(R & 31)) : R;
        voffA[i] = (unsigned)(R * K + C) * 2u; voffB[i] = (unsigned)(Rb * K + C) * 2u; }
    const size_t kstep = (size_t)(BK * 2);
    const size_t hstep = (size_t)HALF * K * 2;
    const size_t tstep = 2 * hstep;
    const unsigned ldsw = (unsigned)wid * 1024u;
    const int aoff = lds_byte(wr * 64 + fr, fq * 8), boff = lds_byte(wc * 32 + fr, fq * 8);
#define PG8_SA(b, h) (((b) * 2 + (h)) * HTB)
#define PG8_SB(b, h) ((4 + (b) * 2 + (h)) * HTB)
#define PG8_STAGE(bufoff, gbase, voff) do { _Pragma("unroll") for (int _i = 0; _i < 2; ++_i) \
        __builtin_amdgcn_global_load_lds((const unsigned*)((const char*)(gbase) + (voff)[_i]), (PG8_LAS unsigned*)(lds + (bufoff) + ldsw + _i * 8192), 16, 0, 0); } while (0)
#define PG8_LDA(dst, b, h) do { _Pragma("unroll") for (int m = 0; m < 4; ++m) _Pragma("unroll") for (int k = 0; k < 2; ++k) dst[m][k] = *(const PG8_LAS bf16x8*)(lds + PG8_SA(b, h) + aoff + m * 2048 + k * 1024); } while (0)
#define PG8_LDB(dst, b, h) do { _Pragma("unroll") for (int n = 0; n < 2; ++n) _Pragma("unroll") for (int k = 0; k < 2; ++k) dst[n][k] = *(const PG8_LAS bf16x8*)(lds + PG8_SB(b, h) + boff + n * 2048 + k * 1024); } while (0)
#define PG8_MMA(ai, bj, At, Bt) do { __builtin_amdgcn_s_setprio(1); _Pragma("unroll") for (int m = 0; m < 4; ++m) _Pragma("unroll") for (int n = 0; n < 2; ++n) _Pragma("unroll") for (int k = 0; k < 2; ++k) \
        acc[ai][bj][m][n] = __builtin_amdgcn_mfma_f32_16x16x32_bf16(Bt[n][k], At[m][k], acc[ai][bj][m][n], 0, 0, 0); __builtin_amdgcn_s_setprio(0); } while (0)
#define PG8_WAIT_V(n) asm volatile("s_waitcnt vmcnt(" #n ")" ::: "memory")
#define PG8_WAIT_L(n) asm volatile("s_waitcnt lgkmcnt(" #n ")" ::: "memory")
#define PG8_BAR __builtin_amdgcn_s_barrier()
#define PG8_SCHED __builtin_amdgcn_sched_barrier(0)
    Unit cur, nxt; int ui = 0;
    if (!S.next(0, cur)) return;
    f32x4 acc[2][2][4][2];
#pragma unroll
    for (int a = 0; a < 2; ++a)
#pragma unroll
        for (int b = 0; b < 2; ++b)
#pragma unroll
            for (int m = 0; m < 4; ++m)
#pragma unroll
                for (int n = 0; n < 2; ++n) acc[a][b][m][n] = (f32x4){0.f, 0.f, 0.f, 0.f};
    bf16x8 At[4][2], B0[2][2], B1[2][2];
    const char* cA = (const char*)g.A + (size_t)cur.pm * tstep + (size_t)cur.kofs * 2; const char* cB = (const char*)g.Bt + (size_t)cur.pn * tstep + (size_t)cur.kofs * 2;
    S.a_ready(cur);
    PG8_STAGE(PG8_SB(0, 0), cB, voffB); PG8_STAGE(PG8_SA(0, 0), cA, voffA); PG8_STAGE(PG8_SB(0, 1), cB + hstep, voffB); PG8_STAGE(PG8_SA(0, 1), cA + hstep, voffA);
    if (wr == 1) PG8_BAR;
    PG8_WAIT_V(4); PG8_BAR;
    PG8_STAGE(PG8_SB(1, 0), cB + kstep, voffB); PG8_STAGE(PG8_SA(1, 0), cA + kstep, voffA); PG8_STAGE(PG8_SB(1, 1), cB + hstep + kstep, voffB);
    PG8_WAIT_V(6); PG8_BAR;
    PG8_STAMP();
    for (;;) {
        const bool has_next = S.next(ui + 1, nxt);
        const char* nA = has_next ? (const char*)g.A + (size_t)nxt.pm * tstep + (size_t)nxt.kofs * 2 : cA; const char* nB = has_next ? (const char*)g.Bt + (size_t)nxt.pn * tstep + (size_t)nxt.kofs * 2 : cB;
        for (int t = 0; t < nt; t += 2) {
            const bool last = (t == nt - 2);
            const char* a1 = cA + (size_t)(t + 1) * kstep;
            const char* a2 = last ? nA : cA + (size_t)(t + 2) * kstep; const char* b2 = last ? nB : cB + (size_t)(t + 2) * kstep;
            const char* a3 = a2 + kstep; const char* b3 = b2 + kstep;
            if (last && has_next) S.a_ready(nxt);
            PG8_LDB(B0, 0, 0); PG8_SCHED; PG8_LDA(At, 0, 0); PG8_STAGE(PG8_SA(1, 1), a1 + hstep, voffA);
            PG8_WAIT_L(8); PG8_BAR; PG8_WAIT_L(0); PG8_MMA(0, 0, At, B0); PG8_BAR; PG8_SCHED;
            PG8_LDB(B1, 0, 1); PG8_STAGE(PG8_SB(0, 0), b2, voffB);
            PG8_BAR; PG8_WAIT_L(0); PG8_MMA(0, 1, At, B1); PG8_BAR;
            PG8_LDA(At, 0, 1); PG8_STAGE(PG8_SA(0, 0), a2, voffA);
            PG8_BAR; PG8_WAIT_L(0); PG8_MMA(1, 0, At, B0); PG8_BAR; PG8_SCHED;
            PG8_STAGE(PG8_SB(0, 1), b2 + hstep, voffB);
            PG8_WAIT_V(6); PG8_BAR; PG8_MMA(1, 1, At, B1); PG8_BAR;
            PG8_LDB(B0, 1, 0); PG8_SCHED; PG8_LDA(At, 1, 0); PG8_STAGE(PG8_SA(0, 1), a2 + hstep, voffA);
            PG8_WAIT_L(8); PG8_BAR; PG8_WAIT_L(0); PG8_MMA(0, 0, At, B0); PG8_BAR; PG8_SCHED;
            PG8_LDB(B1, 1, 1); PG8_STAGE(PG8_SB(1, 0), b3, voffB);
            PG8_BAR; PG8_WAIT_L(0); PG8_MMA(0, 1, At, B1); PG8_BAR;
            PG8_LDA(At, 1, 1); PG8_STAGE(PG8_SA(1, 0), a3, voffA);
            PG8_BAR; PG8_WAIT_L(0); PG8_MMA(1, 0, At, B0); PG8_BAR; PG8_SCHED;
            PG8_STAGE(PG8_SB(1, 1), b3 + hstep, voffB);
            PG8_WAIT_V(6); PG8_BAR; PG8_MMA(1, 1, At, B1); PG8_BAR;
        }
        PG8_STAMP();
        if constexpr (!Epi::AFTER_DRAIN) { E(acc, cur, wr, wc, fr, fq); S.done(cur); }
        PG8_STAMP();
        if (!has_next) break;
#pragma unroll
        for (int a = 0; a < 2; ++a)
#pragma unroll
            for (int b = 0; b < 2; ++b)
#pragma unroll
                for (int m = 0; m < 4; ++m)
#pragma unroll
                    for (int n = 0; n < 2; ++n) acc[a][b][m][n] = (f32x4){0.f, 0.f, 0.f, 0.f};
        cur = nxt; cA = nA; cB = nB; ++ui;
    }
    PG8_WAIT_V(0);
    if (wr == 0) PG8_BAR;
    PG8_BAR;
    if constexpr (Epi::AFTER_DRAIN) { E.fused(acc, cur, wr, wc, fr, fq, lds, wid, lane); S.done(cur); }
    PG8_STAMP();
    if (STAMP && wid == 0) { stamps[lane] = lane < nts ? (((unsigned long long)(unsigned)ts_hi << 32) | (unsigned)ts_lo) : 0ull;
        if (lane == 62) stamps[62] = rt_entry; if (lane == 63) stamps[63] = (unsigned long long)wall_clock64(); }
#undef PG8_STAMP
#undef PG8_SA
#undef PG8_SB
#undef PG8_STAGE
#undef PG8_LDA
#undef PG8_LDB
#undef PG8_MMA
#undef PG8_WAIT_V
#undef PG8_WAIT_L
#undef PG8_BAR
#undef PG8_SCHED
}
}
struct Args { const float* in[N_IN]; float* out; unsigned char* ws; int ph_lo, ph_hi; };
struct Frame {
    LAS unsigned char* lds;
    int tid, lane, wave, vcu, G;
    const float* const* in; GAS float* out; GAS unsigned char* ws;
};
using bf16x2v = __attribute__((ext_vector_type(2))) __bf16;
__device__ __forceinline__ float dot2bf(unsigned a, unsigned b, float acc) { return __builtin_amdgcn_fdot2_f32_bf16(__builtin_bit_cast(bf16x2v, a), __builtin_bit_cast(bf16x2v, b), acc, false); }

__device__ __forceinline__ void ld8bf(const bf16* p, float (&o)[8]) { const v4u w = *(const v4u*)p; o[0] = bf_lo(w.x); o[1] = bf_hi(w.x); o[2] = bf_lo(w.y); o[3] = bf_hi(w.y); o[4] = bf_lo(w.z); o[5] = bf_hi(w.z); o[6] = bf_lo(w.w); o[7] = bf_hi(w.w); }
struct TileInfo { int seq_base, seq_len, t0; };
__device__ __forceinline__ TileInfo tile_info(int c) {
    TileInfo ti;
    if (c < 128) { ti.seq_base = (c >> 6) * SEQ; ti.seq_len = SEQ; ti.t0 = (c & 63) * 64; }
    else { const int cc = c - 128; ti.seq_base = NLAT + (cc >> 2) * CTXL; ti.seq_len = CTXL; ti.t0 = (cc & 3) * 64; }
    return ti;
}
__device__ __forceinline__ int mod_row(int row) { return row < NLAT ? (row >> 12) : 2; }
__device__ __forceinline__ bf16x8 frag_lds(const LAS bf16* base, int ld, int row0, int k0, int lane) { return *(const LAS bf16x8*)(base + (row0 + (lane & 15)) * ld + k0 + 8 * (lane >> 4)); }
__device__ __forceinline__ bf16x8 frag_g(const bf16* base, int ld, int row0, int k0, int lane) { return *(const bf16x8*)(base + (size_t)(row0 + (lane & 15)) * ld + k0 + 8 * (lane >> 4)); }
#define MFMA16(a, b, c) __builtin_amdgcn_mfma_f32_16x16x32_bf16((a), (b), (c), 0, 0, 0)

__device__ __forceinline__ void p0_transpose_item(const float* W, int K, int N, bf16* WT, LAS float* scr, int item, int lane) {
    const int nblk = N / 32, kb = item / nblk, nb = item % nblk, k0 = 64 * kb, n0 = 32 * nb;
#pragma unroll 8
    for (int i = 0; i < 32; ++i) { const int kk = 2 * i + (lane >> 5); scr[kk * 33 + (lane & 31)] = W[(size_t)(k0 + kk) * N + n0 + (lane & 31)]; }
    LDS_WAIT(); asm volatile("" ::: "memory");
    const int c = lane & 7;
#pragma unroll
    for (int j = 0; j < 4; ++j) { const int n = (lane >> 3) + 8 * j; const LAS float* s = scr + (8 * c) * 33 + n;
        v4u o; o.x = pk2(s[0 * 33], s[1 * 33]); o.y = pk2(s[2 * 33], s[3 * 33]); o.z = pk2(s[4 * 33], s[5 * 33]); o.w = pk2(s[6 * 33], s[7 * 33]);
        *(v4u*)(WT + (size_t)(n0 + n) * K + k0 + 8 * c) = o; }
    LDS_WAIT(); asm volatile("" ::: "memory");
}
__device__ __forceinline__ void conv_f32_bf16(const float* src, bf16* dst, size_t n8, size_t i0, size_t stride) {
    for (size_t i = i0; i < n8; i += stride) { const f32x4 a = *(const f32x4*)(src + i * 8), b = *(const f32x4*)(src + i * 8 + 4);
        v4u o; o.x = pk2(a.x, a.y); o.y = pk2(a.z, a.w); o.z = pk2(b.x, b.y); o.w = pk2(b.z, b.w); *(v4u*)(dst + i * 8) = o; }
}
__device__ __forceinline__ void convert_layer(Frame& F, int l, int w, int NW, LAS float* scr) {
    constexpr int IT_IN = (D / 64) * (IN_COLS / 32), IT_SQ = (D / 64) * (D / 32);
    for (int it = w; it < IT_IN + 2 * IT_SQ; it += NW) {
        int r = it;
        if (r < IT_IN) { p0_transpose_item(gin(F.in[I_WIN]) + (size_t)l * D * IN_COLS, D, IN_COLS, (bf16*)(F.ws + WS_WIN) + (size_t)l * IN_PAD * D, scr, r, F.lane); continue; }
        r -= IT_IN;
        if (r < IT_SQ) { p0_transpose_item(gin(F.in[I_WOUT]) + (size_t)l * D * D, D, D, (bf16*)(F.ws + WS_WOUT) + (size_t)l * D * D, scr, r, F.lane); continue; }
        r -= IT_SQ;
        p0_transpose_item(gin(F.in[I_WQ]) + (size_t)l * D * D, D, D, (bf16*)(F.ws + WS_WQ) + (size_t)l * D * D, scr, r, F.lane);
    }
    { constexpr int PADV = (IN_PAD - IN_COLS) * D / 8;
      for (int i = w * 64 + F.lane; i < PADV; i += NW * 64) *(v4u*)((bf16*)(F.ws + WS_WIN) + ((size_t)l * IN_PAD + IN_COLS) * D + (size_t)i * 8) = (v4u){0u, 0u, 0u, 0u}; }
    for (int it = w; it < 2 * PE_NE; it += NW) {
        const int tab = it >= PE_NE, r = l * PE_NE + (tab ? it - PE_NE : it); const float* src = gin(F.in[tab ? I_V : I_U]) + (size_t)r * D + F.lane * 32;
        f32x4 x[8]; float mx = 0.f;
#pragma unroll
        for (int i = 0; i < 8; ++i) { x[i] = *(const f32x4*)(src + i * 4); mx = fmaxf(mx, fmaxf(fmaxf(fabsf(x[i].x), fabsf(x[i].y)), fmaxf(fabsf(x[i].z), fabsf(x[i].w)))); }
        mx = wave_max(mx); const float sc = mx > 0.f ? mx * (1.0f / 7.5f) : 1.0f, inv = 1.0f / sc;
        v16u pk;
#pragma unroll
        for (int i = 0; i < 8; ++i) { pk[2 * i] = pk2(x[i].x * inv, x[i].y * inv); pk[2 * i + 1] = pk2(x[i].z * inv, x[i].w * inv); }
        const v6u q = __builtin_amdgcn_cvt_scalef32_pk32_fp6_bf16(__builtin_bit_cast(v32bf, pk), 1.0f);
        unsigned char* dst = (unsigned char*)(F.ws + (tab ? WS_VB : WS_UB)) + (size_t)r * EROW;
        *(v4u*)(dst + F.lane * 16) = (v4u){q[0], q[1], q[2], q[3]}; *(v2u*)(dst + 1024 + F.lane * 8) = (v2u){q[4], q[5]};
        if (F.lane == 0) ((float*)(F.ws + (tab ? WS_SV : WS_SU)))[r] = sc;
    }
}
__device__ __forceinline__ void p0_prologue(Frame& F) {
    LAS float* scr = (LAS float*)(F.lds + F.wave * 16384);
    const int gw = F.vcu * NWAVES + F.wave, NGW = F.G * NWAVES;
    const size_t gt = (size_t)F.vcu * NTHR + F.tid, NGT = (size_t)F.G * NTHR;
    for (int l = 0; l < DEPTH; ++l) convert_layer(F, l, gw, NGW, scr);
    { bf16* dst = (bf16*)(F.ws + WS_WLRU);
      for (size_t idx = gt; idx < (size_t)DEPTH * 2 * 2 * 16 * 64 * 64; idx += NGT) { const int i = (int)(idx & 63), j = (int)((idx >> 6) & 63), m = (int)(idx >> 12);
          const int hh = m & 15, d = (m >> 4) & 1, gate = (m >> 5) & 1, l = m >> 6; const float* src = gin(F.in[gate ? I_WX : I_WA]);
          dst[idx] = (bf16)f2bf(src[((size_t)((l * 2 + d) * 16 + hh) * 64 + i) * 64 + j]); } }
    { bf16* d2 = (bf16*)(F.ws + WS_W2T); bf16* da = (bf16*)(F.ws + WS_A2T);
      for (size_t idx = gt; idx < (size_t)DEPTH * 2 * 1024 * 64; idx += NGT) { const int k = (int)(idx & 63), c = (int)((idx >> 6) & 1023), ld = (int)(idx >> 16);
          d2[idx] = (bf16)f2bf(gin(F.in[I_W2])[((size_t)ld * 64 + k) * 1024 + c]); da[idx] = (bf16)f2bf(gin(F.in[I_A2])[((size_t)ld * 64 + k) * 1024 + c]); } }
    { bf16* dg = (bf16*)(F.ws + WS_G2T);
      for (size_t idx = gt; idx < (size_t)DEPTH * 1024 * 160; idx += NGT) { const int k = (int)(idx % 160), c = (int)((idx / 160) % 1024), l = (int)(idx / (160 * 1024));
          dg[idx] = (bf16)f2bf(gin(F.in[I_G2])[((size_t)l * 160 + k) * 1024 + c]); } }
    conv_f32_bf16(gin(F.in[I_SUBK]), (bf16*)(F.ws + WS_SUBK), (size_t)DEPTH * 8 * 2 * 128 * 128 / 8, gt, NGT);
    { float* X = (float*)(F.ws + WS_X);
      for (size_t i0 = gt; i0 < (size_t)MTOT * D / 4; i0 += 4 * NGT) { f32x4 v[4];
#pragma unroll
          for (int u = 0; u < 4; ++u) { const size_t i = i0 + (size_t)u * NGT; const int row = (int)(i / (D / 4)), e0 = (int)(i % (D / 4)) * 4;
              v[u] = i < (size_t)MTOT * D / 4 ? (row < NLAT ? *(const f32x4*)(gin(F.in[I_X]) + (size_t)row * D + e0) : *(const f32x4*)(gin(F.in[I_CTX]) + (size_t)(row - NLAT) * D + e0)) : (f32x4){0.f, 0.f, 0.f, 0.f}; }
#pragma unroll
          for (int u = 0; u < 4; ++u) { const size_t i = i0 + (size_t)u * NGT; if (i >= (size_t)MTOT * D / 4) continue; const int row = (int)(i / (D / 4)), e0 = (int)(i % (D / 4)) * 4;
              if (row < NLAT) { const int t = row & (SEQ - 1); const float pr = (float)(t >> 6), pc = (float)(t & 63); float o[4];
#pragma unroll
                  for (int j = 0; j < 4; ++j) { const int e = e0 + j, q = e >> 9, fi = e & 511; const float freq = __builtin_amdgcn_exp2f(-13.287712379549449f * (float)fi * (1.0f / 512.0f));
                      const float ang = ((q >> 1) ? pc : pr) * freq; float rev = ang * 0.15915494309189535f; rev -= floorf(rev);
                      o[j] = (q & 1) ? __builtin_amdgcn_cosf(rev) : __builtin_amdgcn_sinf(rev); }
                  v[u].x += o[0]; v[u].y += o[1]; v[u].z += o[2]; v[u].w += o[3]; }
              *(f32x4*)(X + (size_t)row * D + e0) = v[u]; } } }
    { float* MODP = (float*)(F.ws + WS_MODP); const float* cin = gin(F.in[I_C]); const float* cctx = gin(F.in[I_CCTX]);
      for (int it = gw; it < DEPTH * KSPLIT * 48; it += NGW) { const int cg = it % 48, kp = (it / 48) % KSPLIT, l = it / (48 * KSPLIT); const int col = cg * 256 + F.lane * 4, k0 = kp * (D / KSPLIT);
          f32x4 a0 = {0.f, 0.f, 0.f, 0.f}, a1 = a0, a2 = a0; const float* wp = gin(F.in[I_ADAW]) + ((size_t)l * D + k0) * (6 * D) + col;
#pragma unroll 8
          for (int k = 0; k < D / KSPLIT; ++k) { const f32x4 w = *(const f32x4*)(wp + (size_t)k * (6 * D)); const float c0 = cin[k0 + k], c1 = cin[D + k0 + k], c2 = cctx[k0 + k];
              const float s0 = c0 * fsigmoid(c0), s1 = c1 * fsigmoid(c1), s2 = c2 * fsigmoid(c2); a0 += w * s0; a1 += w * s1; a2 += w * s2; }
          float* o = MODP + ((size_t)(kp * DEPTH + l) * 3) * (6 * D) + col; *(f32x4*)o = a0; *(f32x4*)(o + 6 * D) = a1; *(f32x4*)(o + 12 * D) = a2; } }
}
__device__ __forceinline__ void p0b_mod_reduce(Frame& F) {
    const size_t gt = (size_t)F.vcu * NTHR + F.tid, NGT = (size_t)F.G * NTHR; const float* MODP = (const float*)(F.ws + WS_MODP); float* MOD = (float*)(F.ws + WS_MOD);
    for (size_t i = gt; i < (size_t)DEPTH * 3 * 6 * D; i += NGT) { const int n = (int)(i % (6 * D)), l = (int)(i / (3 * 6 * D)); float s = gin(F.in[I_ADAB])[(size_t)l * 6 * D + n];
#pragma unroll
        for (int kp = 0; kp < KSPLIT; ++kp) s += MODP[(size_t)kp * DEPTH * 3 * 6 * D + i];
        MOD[i] = s; }
}
__device__ __forceinline__ void modulate_rows(Frame& F, int l, int which, int nrows) {
    const int gw = F.vcu * NWAVES + F.wave, NGW = F.G * NWAVES; const float* X = (const float*)(F.ws + WS_X); bf16* H = (bf16*)(F.ws + WS_H);
    for (int row = gw; row < nrows; row += NGW) { const float* md = (const float*)(F.ws + WS_MOD) + ((size_t)l * 3 + mod_row(row)) * (6 * D) + which * 3 * D;
#pragma unroll
        for (int j = 0; j < 4; ++j) { const int e = j * 512 + F.lane * 8; const f32x4 x0 = *(const f32x4*)(X + (size_t)row * D + e), x1 = *(const f32x4*)(X + (size_t)row * D + e + 4);
            const f32x4 s0 = *(const f32x4*)(md + e), s1 = *(const f32x4*)(md + e + 4), c0 = *(const f32x4*)(md + D + e), c1 = *(const f32x4*)(md + D + e + 4);
            const f32x4 y0 = x0 * (c0 + 1.0f) + s0, y1 = x1 * (c1 + 1.0f) + s1;
            v4u o; o.x = pk2(y0.x, y0.y); o.y = pk2(y0.z, y0.w); o.z = pk2(y1.x, y1.y); o.w = pk2(y1.z, y1.w); *(v4u*)(H + (size_t)row * D + e) = o; } }
}

__device__ __forceinline__ void lru_prep_unit(Frame& F, int l, int c, int hh) {
    int tid = F.tid; asm volatile("" : "+v"(tid));
    const int lane = tid & 63, wave = F.wave;
    const TileInfo ti = tile_info(c); const bf16* P = (const bf16*)(F.ws + WS_P);
    LAS float* Us = (LAS float*)F.lds; LAS float* XC = (LAS float*)(F.lds + 17408); LAS bf16* XCb = (LAS bf16*)(F.lds + 34304);
    LAS float* LAs = (LAS float*)(F.lds + 43520); LAS float* LBs = (LAS float*)(F.lds + 76288); LAS float* SEGA = (LAS float*)(F.lds + 109056); LAS float* SEGH = SEGA + 512;
    for (int idx = tid; idx < 67 * 8; idx += NTHR) { const int r = idx >> 3, c8 = (idx & 7) * 8, t = ti.t0 - 2 + r; float x[8];
        if (t >= 0 && t < ti.seq_len) ld8bf(P + (size_t)(ti.seq_base + t) * IN_PAD + hh * 64 + c8, x);
        else {
#pragma unroll
            for (int e = 0; e < 8; ++e) x[e] = 0.f; }
        *(LAS f32x4*)(Us + r * 64 + c8) = (f32x4){x[0], x[1], x[2], x[3]}; *(LAS f32x4*)(Us + r * 64 + c8 + 4) = (f32x4){x[4], x[5], x[6], x[7]}; }
    __syncthreads();
    { const int ch = tid & 63, cg = hh * 64 + ch; const float* cw = gin(F.in[I_CONVW]) + (size_t)l * 4 * LRW + cg;
      const float w0 = cw[0], w1 = cw[LRW], w2 = cw[2 * LRW], w3 = cw[3 * LRW], cb = gin(F.in[I_CONVB])[(size_t)l * LRW + cg];
#pragma unroll
      for (int k = 0; k < 8; ++k) { const int t = (tid >> 6) + 8 * k;
          const float v = cb + w0 * Us[t * 64 + ch] + w1 * Us[(t + 1) * 64 + ch] + w2 * Us[(t + 2) * 64 + ch] + w3 * Us[(t + 3) * 64 + ch];
          XC[t * 65 + ch] = v; XCb[t * 72 + ch] = (bf16)f2bf(v); } }
    __syncthreads();
    { const int d = wave >> 2, m = wave & 3;
      const bf16x8 a0 = frag_lds(XCb, 72, 16 * m, 0, lane), a1 = frag_lds(XCb, 72, 16 * m, 32, lane);
      const bf16* Wa = (const bf16*)(F.ws + WS_WLRU) + (size_t)(((l * 2 + 0) * 2 + d) * 16 + hh) * 4096;
      const bf16* Wx = (const bf16*)(F.ws + WS_WLRU) + (size_t)(((l * 2 + 1) * 2 + d) * 16 + hh) * 4096;
#pragma unroll
      for (int n = 0; n < 4; ++n) {
          f32x4 ar = {0.f, 0.f, 0.f, 0.f}, ai = ar;
          ar = MFMA16(a0, frag_g(Wa, 64, 16 * n, 0, lane), ar); ar = MFMA16(a1, frag_g(Wa, 64, 16 * n, 32, lane), ar);
          ai = MFMA16(a0, frag_g(Wx, 64, 16 * n, 0, lane), ai); ai = MFMA16(a1, frag_g(Wx, 64, 16 * n, 32, lane), ai);
          const int col = 16 * n + (lane & 15), cg = hh * 64 + col;
          const float ba = gin(F.in[I_BA])[(size_t)(l * 2 + d) * LRW + cg], bx = gin(F.in[I_BX])[(size_t)(l * 2 + d) * LRW + cg];
          const float sp = fsoftplus(-gin(F.in[I_LAM])[(size_t)(l * 2 + d) * LRW + cg]);
#pragma unroll
          for (int r = 0; r < 4; ++r) { const int row = 16 * m + 4 * (lane >> 4) + r;
              const float rr = fsigmoid(ar[r] + ba), ii = fsigmoid(ai[r] + bx), loga = -8.0f * rr * sp, a = fexp(loga);
              const float bb = __builtin_amdgcn_sqrtf(fmaxf(1.0f - a * a, 0.f)) * ii * XC[row * 65 + col];
              LAs[(d * 64 + row) * 64 + col] = a; LBs[(d * 64 + row) * 64 + col] = bb; } } }
    __syncthreads();
    { const int col = tid & 63, seg = (tid >> 6) & 3, d = tid >> 8, cg = hh * 64 + col; float hl[16], al[16]; float h = 0.f, A = 1.f;
#pragma unroll
      for (int i = 0; i < 16; ++i) { const int tau = 16 * seg + i, row = d ? 63 - tau : tau; const float a = LAs[(d * 64 + row) * 64 + col], b = LBs[(d * 64 + row) * 64 + col]; h = a * h + b; A *= a; hl[i] = h; al[i] = A; }
      SEGA[(d * 4 + seg) * 64 + col] = A; SEGH[(d * 4 + seg) * 64 + col] = h;
      __syncthreads();
      float Hin = 0.f, Ain = 1.f;
#pragma unroll
      for (int s2 = 0; s2 < 3; ++s2) if (s2 < seg) { const float sa = SEGA[(d * 4 + s2) * 64 + col]; Hin = sa * Hin + SEGH[(d * 4 + s2) * 64 + col]; Ain *= sa; }
      bf16* HL = (bf16*)(F.ws + WS_LB) + (size_t)d * MTOT * LRW; bf16* AC = (bf16*)(F.ws + WS_LA) + (size_t)d * MTOT * LRW;
#pragma unroll
      for (int i = 0; i < 16; ++i) { const int tau = 16 * seg + i, row = d ? 63 - tau : tau; const size_t o = (size_t)(ti.seq_base + ti.t0 + row) * LRW + cg; HL[o] = (bf16)f2bf(hl[i] + al[i] * Hin); AC[o] = (bf16)f2bf(al[i] * Ain); }
      if (seg == 3) { float* AG = (float*)(F.ws + WS_LAGG); AG[((size_t)(0 * 2 + d) * NTILE + c) * LRW + cg] = al[15] * Ain; AG[((size_t)(1 * 2 + d) * NTILE + c) * LRW + cg] = hl[15] + al[15] * Hin; } }
    __syncthreads();
}
__device__ __forceinline__ void shifted8(const bf16* P, size_t grow, bool hp, bool hn, const float* mu0, const float* mu1, int rc, float (&o)[8]) {
    const bf16* p = P + grow * IN_PAD + 2 * LRW + rc;
    float xs[8], ms[8], ns[8]; ld8bf(p, xs);
#pragma unroll
    for (int e = 0; e < 8; ++e) { ms[e] = 0.f; ns[e] = 0.f; }
    if (hp) ld8bf(p - IN_PAD, ms);
    if (hn) ld8bf(p + IN_PAD, ns);
    const f32x4 a0 = *(const f32x4*)(mu0 + rc), a1 = *(const f32x4*)(mu0 + rc + 4), b0 = *(const f32x4*)(mu1 + rc), b1 = *(const f32x4*)(mu1 + rc + 4);
    const float m0[8] = {a0.x, a0.y, a0.z, a0.w, a1.x, a1.y, a1.z, a1.w}, m1[8] = {b0.x, b0.y, b0.z, b0.w, b1.x, b1.y, b1.z, b1.w};
#pragma unroll
    for (int e = 0; e < 8; ++e) o[e] = xs[e] + m0[e] * (ms[e] - xs[e]) + m1[e] * (ns[e] - xs[e]);
}
constexpr int MB = 9216;
constexpr int MLD = 72;
#define MSLOT(k) ((LAS bf16*)(F.lds + (k) * MB))
__device__ __forceinline__ int prow(int c) { return (c & ~7) | ((c + (c >> 3)) & 7); }
__device__ __forceinline__ bf16x8 frag_lds_p(const LAS bf16* base, int ld, int row0, int k0, int lane) { return *(const LAS bf16x8*)(base + prow(row0 + (lane & 15)) * ld + k0 + 8 * (lane >> 4)); }
template <bool PY, bool PX> __device__ __forceinline__ f32x4 mm_tile_p(const LAS bf16* Y, int rt, const LAS bf16* X, int ct, f32x4 acc, int lane) {
    acc = MFMA16(PY ? frag_lds_p(Y, MLD, 16 * rt, 0, lane) : frag_lds(Y, MLD, 16 * rt, 0, lane), PX ? frag_lds_p(X, MLD, 16 * ct, 0, lane) : frag_lds(X, MLD, 16 * ct, 0, lane), acc);
    acc = MFMA16(PY ? frag_lds_p(Y, MLD, 16 * rt, 32, lane) : frag_lds(Y, MLD, 16 * rt, 32, lane), PX ? frag_lds_p(X, MLD, 16 * ct, 32, lane) : frag_lds(X, MLD, 16 * ct, 32, lane), acc);
    return acc;
}
__device__ __forceinline__ f32x4 mm_tile(const LAS bf16* Y, int rt, const LAS bf16* X, int ct, f32x4 acc, int lane) {
    acc = MFMA16(frag_lds(Y, MLD, 16 * rt, 0, lane), frag_lds(X, MLD, 16 * ct, 0, lane), acc);
    acc = MFMA16(frag_lds(Y, MLD, 16 * rt, 32, lane), frag_lds(X, MLD, 16 * ct, 32, lane), acc);
    return acc;
}
__device__ __forceinline__ void st_tile(LAS bf16* Dst, int rt, int ct, f32x4 acc, int lane) {
    v2u o; o.x = pk2(acc[0], acc[1]); o.y = pk2(acc[2], acc[3]);
    *(LAS v2u*)(Dst + (16 * ct + (lane & 15)) * MLD + 16 * rt + 4 * (lane >> 4)) = o;
}
__device__ __forceinline__ f32x4 ld_tile(const LAS bf16* Src, int rt, int ct, int lane) {
    const v2u o = *(const LAS v2u*)(Src + (16 * ct + (lane & 15)) * MLD + 16 * rt + 4 * (lane >> 4));
    return (f32x4){bf_lo(o.x), bf_hi(o.x), bf_lo(o.y), bf_hi(o.y)};
}
template <int MASK> __device__ __forceinline__ void mm64(LAS bf16* Dst, const LAS bf16* X, const LAS bf16* Y, int wave, int lane) {
    const int rt = wave >> 1;
#pragma unroll
    for (int q = 0; q < 2; ++q) { const int ct = 2 * (wave & 1) + q; f32x4 acc = {0.f, 0.f, 0.f, 0.f};
        acc = mm_tile(Y, rt, X, ct, acc, lane);
        if (MASK) { const int c = 16 * ct + (lane & 15);
#pragma unroll
            for (int g = 0; g < 4; ++g) { const int r = 16 * rt + 4 * (lane >> 4) + g; const bool keep = MASK == 1 ? (c > r) : MASK == 2 ? (r > c) : (c >= r); if (!keep) acc[g] = 0.f; } }
        st_tile(Dst, rt, ct, acc, lane); }
}
#ifndef CPROBE
#define CPROBE 0
#endif
struct RawS1 { v4u x[5][3]; };
template <int G0, int G1> __device__ __forceinline__ void load_raw(Frame& F, int c, int hh, int d, int tid, RawS1& raw) {
    const TileInfo ti = tile_info(c); const int t = tid >> 3, c8 = (tid & 7) * 8, tt = ti.t0 + t; const bool hp = tt > 0, hn = tt + 1 < ti.seq_len;
    const bf16* p0 = (const bf16*)(F.ws + WS_P) + (size_t)(ti.seq_base + tt) * IN_PAD + 2 * LRW + c8;
#pragma unroll
    for (int g = G0; g < G1; ++g) { const int rc = g < 3 ? g * RWW + hh * 64 : 3 * RWW + (g - 3) * 128 + d * 64; const bf16* p = p0 + rc;
        raw.x[g][0] = *(const v4u*)p; raw.x[g][1] = *(const v4u*)(p - (hp ? IN_PAD : 0)); raw.x[g][2] = *(const v4u*)(p + (hn ? IN_PAD : 0)); }
}
__device__ __forceinline__ void shift_raw(const v4u (&x)[3], const LAS float* mus, bool hp, bool hn, float (&o)[8]) {
    const f32x4 a0 = *(const LAS f32x4*)mus, a1 = *(const LAS f32x4*)(mus + 4), b0 = *(const LAS f32x4*)(mus + 64), b1 = *(const LAS f32x4*)(mus + 68);
    const float m0[8] = {a0.x, a0.y, a0.z, a0.w, a1.x, a1.y, a1.z, a1.w}, m1[8] = {b0.x, b0.y, b0.z, b0.w, b1.x, b1.y, b1.z, b1.w};
    const unsigned xw[4] = {x[0].x, x[0].y, x[0].z, x[0].w}, pw[4] = {x[1].x, x[1].y, x[1].z, x[1].w}, nw[4] = {x[2].x, x[2].y, x[2].z, x[2].w};
#pragma unroll
    for (int e = 0; e < 8; ++e) { const float xs = (e & 1) ? bf_hi(xw[e >> 1]) : bf_lo(xw[e >> 1]), ms = hp ? ((e & 1) ? bf_hi(pw[e >> 1]) : bf_lo(pw[e >> 1])) : 0.f, ns = hn ? ((e & 1) ? bf_hi(nw[e >> 1]) : bf_lo(nw[e >> 1])) : 0.f;
        o[e] = xs + m0[e] * (ms - xs) + m1[e] * (ns - xs); }
}
__device__ __forceinline__ void rwkv_chunk_prep(Frame& F, int l, int c, int hh, int d) {
    RawS1 raw;
    int tid = F.tid; asm volatile("" : "+v"(tid));
    const TileInfo ti = tile_info(c); const int lane = tid & 63, wave = F.wave;
    LAS bf16* TW = MSLOT(0); LAS bf16* AD = MSLOT(1);
    LAS float* CUM = (LAS float*)(F.lds + 8 * MB); LAS float* AVs = (LAS float*)(F.lds + 8 * MB + 16640);
    LAS float* CWL = (LAS float*)(F.lds + 13 * MB); LAS float* SEGT = (LAS float*)(F.lds + 13 * MB + 256); LAS float* MUS = (LAS float*)(F.lds + 125184);
    const int uidx = (c * NH + hh) * 2 + d;
    const int t = tid >> 3, c8 = (tid & 7) * 8, tt = ti.t0 + t; const size_t grow = (size_t)(ti.seq_base + tt); const bool hp = tt > 0, hn = tt + 1 < ti.seq_len;
    float rv[8], kv[8], vv[8], kk[8];
    load_raw<0, 5>(F, c, hh, d, tid, raw);
    for (int rp_ = 0; rp_ < (CPROBE == 1 ? 2 : 1); ++rp_) {
    shift_raw(raw.x[0], MUS + 0 * 128 + c8, hp, hn, rv);
    shift_raw(raw.x[1], MUS + 1 * 128 + c8, hp, hn, kv);
    shift_raw(raw.x[2], MUS + 2 * 128 + c8, hp, hn, vv);
    { float ss = 0.f; const float* kkw = gin(F.in[I_KK]) + (size_t)l * RWW + hh * 64 + c8;
#pragma unroll
      for (int e = 0; e < 8; ++e) { kk[e] = kv[e] * kkw[e]; ss += kk[e] * kk[e]; }
      ss = red8(ss); const float inv = __builtin_amdgcn_rsqf(fmaxf(ss, 1e-24f));
#pragma unroll
      for (int e = 0; e < 8; ++e) kk[e] *= inv; }
    if (d == 0) { v4u o; o.x = pk2(vv[0], vv[1]); o.y = pk2(vv[2], vv[3]); o.z = pk2(vv[4], vv[5]); o.w = pk2(vv[6], vv[7]); *(v4u*)((bf16*)(F.ws + WS_RV) + grow * RWW + hh * 64 + c8) = o; }
    { float x[8]; v4u o;
      shift_raw(raw.x[3], MUS + 3 * 128 + c8, hp, hn, x);
      o.x = pk2(ftanh(x[0]), ftanh(x[1])); o.y = pk2(ftanh(x[2]), ftanh(x[3])); o.z = pk2(ftanh(x[4]), ftanh(x[5])); o.w = pk2(ftanh(x[6]), ftanh(x[7])); *(LAS v4u*)(TW + t * MLD + c8) = o;
      shift_raw(raw.x[4], MUS + 4 * 128 + c8, hp, hn, x);
      o.x = pk2(x[0], x[1]); o.y = pk2(x[2], x[3]); o.z = pk2(x[4], x[5]); o.w = pk2(x[6], x[7]); *(LAS v4u*)(AD + t * MLD + c8) = o; }
    asm volatile("" ::: "memory"); }
    bf16x8 w2f[2][2], a2f[2][2];
    { const bf16* W2 = (const bf16*)(F.ws + WS_W2T) + ((size_t)(l * 2 + d) * 1024 + hh * 64) * 64; const bf16* A2 = (const bf16*)(F.ws + WS_A2T) + ((size_t)(l * 2 + d) * 1024 + hh * 64) * 64;
#pragma unroll
      for (int q = 0; q < 2; ++q) { const int n = (wave >> 2) * 2 + q;
#pragma unroll
          for (int k = 0; k < 2; ++k) { w2f[q][k] = frag_g(W2, 64, 16 * n, 32 * k, lane); a2f[q][k] = frag_g(A2, 64, 16 * n, 32 * k, lane); } } }
    __syncthreads();
    for (int rp_ = 0; rp_ < (CPROBE == 2 ? 2 : 1); ++rp_) { const int m = wave & 3; const bf16x8 w0f = frag_lds(TW, MLD, 16 * m, 0, lane), w1f = frag_lds(TW, MLD, 16 * m, 32, lane), d0f = frag_lds(AD, MLD, 16 * m, 0, lane), d1f = frag_lds(AD, MLD, 16 * m, 32, lane);
#pragma unroll
      for (int q = 0; q < 2; ++q) { const int n = (wave >> 2) * 2 + q; f32x4 aw = {0.f, 0.f, 0.f, 0.f}, aa = aw;
          aw = MFMA16(w0f, w2f[q][0], aw); aw = MFMA16(w1f, w2f[q][1], aw);
          aa = MFMA16(d0f, a2f[q][0], aa); aa = MFMA16(d1f, a2f[q][1], aa);
          const int col = 16 * n + (lane & 15), cg = hh * 64 + col; const float w0 = gin(F.in[I_W0])[(size_t)(l * 2 + d) * RWW + cg], a0 = gin(F.in[I_A0])[(size_t)(l * 2 + d) * RWW + cg];
#pragma unroll
          for (int g = 0; g < 4; ++g) { const int row = 16 * m + 4 * (lane >> 4) + g; const float wlog = -fsoftplus(-(w0 + aw[g])) - 0.5f;
              CUM[row * 65 + col] = -fexp(wlog); AVs[row * 65 + col] = fsigmoid(a0 + aa[g]); } } }
    __syncthreads();
    { const int col = tid & 63, seg = tid >> 6; float pre[8]; float run = 0.f;
#pragma unroll
      for (int i = 0; i < 8; ++i) { const int tau = seg * 8 + i, tr = d ? 63 - tau : tau; run += CUM[tr * 65 + col]; pre[i] = run; }
      SEGT[seg * 64 + col] = run;
      __syncthreads();
      float off = 0.f;
#pragma unroll
      for (int s = 0; s < 8; ++s) if (s < seg) off += SEGT[s * 64 + col];
#pragma unroll
      for (int i = 0; i < 8; ++i) { const int tau = seg * 8 + i, tr = d ? 63 - tau : tau; CUM[tr * 65 + col] = off + pre[i]; }
      if (seg == 7) CWL[col] = fexp(off + pre[7]); }
    __syncthreads();
    for (int rp_ = 0; rp_ < (CPROBE == 3 ? 2 : 1); ++rp_) { const int tau = d ? 63 - t : t, tprev = d ? t + 1 : t - 1;
      const float* kaw = gin(F.in[I_KA]) + (size_t)l * RWW + hh * 64 + c8; const float* rkw = gin(F.in[I_RK]) + (size_t)l * RWW + hh * 64 + c8;
      LAS bf16* At = MSLOT(0); LAS bf16* AtT = MSLOT(1); LAS bf16* Bt = MSLOT(2); LAS bf16* BtT = MSLOT(3); LAS bf16* Kt = MSLOT(4); LAS bf16* KtT = MSLOT(5); LAS bf16* Rt = MSLOT(6); LAS bf16* VT = MSLOT(7);
      float bsum = 0.f; unsigned pa[4], pb[4], pk[4], pr[4];
#pragma unroll
      for (int e2 = 0; e2 < 4; ++e2) { float at2[2], bt2[2], kt2[2], rt2[2];
#pragma unroll
          for (int q = 0; q < 2; ++q) { const int e = 2 * e2 + q; const float cum = CUM[t * 65 + c8 + e], cumx = tau > 0 ? CUM[tprev * 65 + c8 + e] : 0.f, a = AVs[t * 65 + c8 + e];
              const float kd = kv[e] * (1.0f + (a - 1.0f) * kaw[e]), ex = fexp(cum), exm = fexp(-cum);
              at2[q] = -kk[e] * fexp(cumx); bt2[q] = kk[e] * a * exm; kt2[q] = kd * exm; rt2[q] = rv[e] * ex; bsum += rv[e] * kd * rkw[e];
              const int pr_ = prow(c8 + e) * MLD + tau; AtT[pr_] = (bf16)f2bf(at2[q]); BtT[pr_] = (bf16)f2bf(bt2[q]); KtT[pr_] = (bf16)f2bf(kt2[q]); VT[pr_] = (bf16)f2bf(vv[e]); }
          pa[e2] = pk2(at2[0], at2[1]); pb[e2] = pk2(bt2[0], bt2[1]); pk[e2] = pk2(kt2[0], kt2[1]); pr[e2] = pk2(rt2[0], rt2[1]); }
      *(LAS v4u*)(At + tau * MLD + c8) = (v4u){pa[0], pa[1], pa[2], pa[3]}; *(LAS v4u*)(Bt + tau * MLD + c8) = (v4u){pb[0], pb[1], pb[2], pb[3]};
      *(LAS v4u*)(Kt + tau * MLD + c8) = (v4u){pk[0], pk[1], pk[2], pk[3]}; *(LAS v4u*)(Rt + tau * MLD + c8) = (v4u){pr[0], pr[1], pr[2], pr[3]};
      bsum = red8(bsum);
      if ((tid & 7) == 0) ((float*)(F.ws + WS_BETA))[((size_t)d * MTOT + grow) * NH + hh] = bsum; }
    __syncthreads();
    LAS bf16* At = MSLOT(0); LAS bf16* AtT = MSLOT(1); LAS bf16* Bt = MSLOT(2); LAS bf16* BtT = MSLOT(3); LAS bf16* Kt = MSLOT(4); LAS bf16* KtT = MSLOT(5); LAS bf16* Rt = MSLOT(6); LAS bf16* VT = MSLOT(7);
    LAS bf16* Pm = MSLOT(8); LAS bf16* AkVT = MSLOT(9); LAS bf16* Gak = MSLOT(10); LAS bf16* Grb = MSLOT(11); LAS bf16* Grk = MSLOT(12);
    LAS bf16* TAT = MSLOT(0); LAS bf16* U0T = MSLOT(2); LAS bf16* TD = (LAS bf16*)(F.lds + 122112); constexpr int TDLD = 24;
    for (int rp_ = 0; rp_ < (CPROBE == 4 ? 2 : 1); ++rp_) {
    mm64<1>(Pm, At, Bt, wave, lane);
    __syncthreads();
    if (wave == 0) { const int blk = lane >> 4, cc = lane & 15; float tv[16];
#pragma unroll
        for (int r = 0; r < 16; ++r) { asm volatile("" ::: "memory"); const LAS bf16* ar = Pm + (16 * blk + r) * MLD + 16 * blk; const v4u q0 = *(const LAS v4u*)ar, q1 = *(const LAS v4u*)(ar + 8);
            const float av_[16] = {bf_lo(q0.x), bf_hi(q0.x), bf_lo(q0.y), bf_hi(q0.y), bf_lo(q0.z), bf_hi(q0.z), bf_lo(q0.w), bf_hi(q0.w), bf_lo(q1.x), bf_hi(q1.x), bf_lo(q1.y), bf_hi(q1.y), bf_lo(q1.z), bf_hi(q1.z), bf_lo(q1.w), bf_hi(q1.w)};
            float acc0 = (r == cc) ? 1.0f : 0.f, acc1 = 0.f;
#pragma unroll
            for (int m = 0; m < r; ++m) { if (m & 1) acc1 += av_[m] * tv[m]; else acc0 += av_[m] * tv[m]; }
            tv[r] = acc0 + acc1; }
#pragma unroll
        for (int r = 0; r < 16; ++r) TD[(16 * blk + r) * TDLD + cc] = (bf16)f2bf(tv[r]);
    } else {
#pragma unroll 1
        for (int q = wave - 1; q < 48; q += 7) { const int pr = q >> 4, tl = q & 15, rt = tl >> 2, ct = tl & 3;
            const LAS bf16* X = pr == 0 ? At : Rt; const LAS bf16* Y = pr == 1 ? Bt : Kt; LAS bf16* Dst = pr == 0 ? Gak : pr == 1 ? Grb : Grk;
            f32x4 acc = {0.f, 0.f, 0.f, 0.f}; acc = mm_tile(Y, rt, X, ct, acc, lane);
            const int cI = 16 * ct + (lane & 15);
#pragma unroll
            for (int g = 0; g < 4; ++g) { const int rI = 16 * rt + 4 * (lane >> 4) + g; const bool keep = pr == 0 ? (cI > rI) : (cI >= rI); if (!keep) acc[g] = 0.f; }
            st_tile(Dst, rt, ct, acc, lane); }
    }
    __syncthreads(); }
    { const int rt = wave >> 1;
#pragma unroll
      for (int q = 0; q < 2; ++q) { const int ct = 2 * (wave & 1) + q; f32x4 acc = {0.f, 0.f, 0.f, 0.f}; acc = mm_tile_p<false, true>(Gak, rt, VT, ct, acc, lane); st_tile(AkVT, rt, ct, acc, lane); } }
    { const v4u z = {0u, 0u, 0u, 0u}; for (int i = tid; i < 64 * 8; i += NTHR) { const int row = i >> 3, c8_ = (i & 7) * 8; *(LAS v4u*)(TAT + row * MLD + c8_) = z; *(LAS v4u*)(U0T + row * MLD + c8_) = z; } }
    __syncthreads();
    for (int rp_ = 0; rp_ < (CPROBE == 5 ? 2 : 1); ++rp_)
#pragma unroll 1
    for (int bi = 0; bi < 4; ++bi) {
        const int g = lane >> 4, il = lane & 15, nt = wave & 3; const LAS bf16* RH = (wave < 4) ? AtT : AkVT; LAS bf16* XT = (wave < 4) ? TAT : U0T;
        const v2u rq = *(const LAS v2u*)(RH + ((wave < 4) ? prow(16 * nt + il) : 16 * nt + il) * MLD + 16 * bi + 4 * g);
        f32x4 acc = {bf_lo(rq.x), bf_hi(rq.x), bf_lo(rq.y), bf_hi(rq.y)};
#pragma unroll
        for (int ks = 0; ks < 2; ++ks) if (32 * ks < 16 * bi) {
            bf16x8 af = frag_lds(Pm, MLD, 16 * bi, 32 * ks, lane); if (32 * ks + 8 * g >= 16 * bi) af = (bf16x8){0, 0, 0, 0, 0, 0, 0, 0};
            acc = MFMA16(af, frag_lds(XT, MLD, 16 * nt, 32 * ks, lane), acc); }
        v4u rb; rb.x = pk2(acc[0], acc[1]); rb.y = pk2(acc[2], acc[3]); rb.z = 0u; rb.w = 0u;
        const v2u tq = *(const LAS v2u*)(TD + (16 * bi + il) * TDLD + 4 * g); v4u tf; tf.x = tq.x; tf.y = tq.y; tf.z = 0u; tf.w = 0u;
        f32x4 xo = {0.f, 0.f, 0.f, 0.f}; xo = MFMA16(__builtin_bit_cast(bf16x8, tf), __builtin_bit_cast(bf16x8, rb), xo);
        v2u o; o.x = pk2(xo[0], xo[1]); o.y = pk2(xo[2], xo[3]); *(LAS v2u*)(XT + (16 * nt + il) * MLD + 16 * bi + 4 * g) = o;
        __syncthreads();
    }
    for (int rp_ = 0; rp_ < (CPROBE == 6 ? 2 : 1); ++rp_) {
    {
      bf16* QMg = (bf16*)(F.ws + WS_QM) + (size_t)uidx * 4096; bf16* PHg = (bf16*)(F.ws + WS_PHI) + (size_t)uidx * 4096; const int rt = wave >> 1;
#pragma unroll
      for (int q = 0; q < 2; ++q) { const int ct = 2 * (wave & 1) + q; const int cidx = 16 * ct + (lane & 15), r0 = 16 * rt + 4 * (lane >> 4), qpos = 32 * (rt >> 1) + 8 * (lane >> 4) + 4 * (rt & 1);
          f32x4 acc = ld_tile(Rt, rt, ct, lane); acc = mm_tile(TAT, rt, Grb, ct, acc, lane);
          v2u o; o.x = pk2(acc[0], acc[1]); o.y = pk2(acc[2], acc[3]); *(v2u*)(QMg + cidx * 64 + qpos) = o;
          asm volatile("" ::: "memory");
          f32x4 ph = {0.f, 0.f, 0.f, 0.f}; ph = mm_tile_p<false, true>(TAT, rt, BtT, ct, ph, lane); const float cw = CWL[cidx];
#pragma unroll
          for (int g = 0; g < 4; ++g) ph[g] = cw * (ph[g] + ((r0 + g == cidx) ? 1.0f : 0.f));
          o.x = pk2(ph[0], ph[1]); o.y = pk2(ph[2], ph[3]); *(v2u*)(PHg + cidx * 64 + qpos) = o; } }
    {
      bf16* Y0g = (bf16*)(F.ws + WS_Y0F) + (size_t)uidx * 4096; bf16* PSg = (bf16*)(F.ws + WS_PSF) + (size_t)uidx * 4096; const int rt = wave >> 1;
#pragma unroll
      for (int q = 0; q < 2; ++q) { const int ct = 2 * (wave & 1) + q;
          asm volatile("" ::: "memory");
          f32x4 y0 = {0.f, 0.f, 0.f, 0.f}; y0 = mm_tile(U0T, rt, Grb, ct, y0, lane); asm volatile("" ::: "memory"); y0 = mm_tile_p<true, false>(VT, rt, Grk, ct, y0, lane);
          { v2u w; w.x = pk2(y0[0], y0[1]); w.y = pk2(y0[2], y0[3]); *(v2u*)(Y0g + ((rt * 4 + ct) * 64 + lane) * 4) = w; }
          asm volatile("" ::: "memory");
          f32x4 ps = {0.f, 0.f, 0.f, 0.f}; ps = mm_tile_p<true, false>(BtT, rt, U0T, ct, ps, lane); asm volatile("" ::: "memory"); ps = mm_tile_p<true, true>(KtT, rt, VT, ct, ps, lane);
#pragma unroll
          for (int g = 0; g < 4; ++g) ps[g] *= CWL[16 * rt + 4 * (lane >> 4) + g];
          { v2u w; w.x = pk2(ps[0], ps[1]); w.y = pk2(ps[2], ps[3]); *(v2u*)(PSg + ((ct * 4 + rt) * 64 + lane) * 4) = w; } } } }
    __syncthreads();
}
#define LDS_BAR() do { asm volatile("s_waitcnt lgkmcnt(0)" ::: "memory"); __builtin_amdgcn_s_barrier(); asm volatile("" ::: "memory"); } while (0)
struct ChunkOps { bf16x8 f[4][2]; v2u c[4]; int tile; };
__device__ __forceinline__ void chunk_load(Frame& F, ChunkOps& o, int step, int b, int hh, int d, int sl, int role, int lane) {
    const int g = lane >> 4, il = lane & 15;
    step = step < 67 ? step : 67;
    const int cc = d ? 3 - step : step, lc = d ? 67 - step : step - 4; const int tile = step < 4 ? 128 + b * 4 + cc : b * 64 + lc;
    o.tile = tile;
    const size_t uidx = (size_t)(tile * NH + hh) * 2 + d;
    const bf16* Mg = (const bf16*)(F.ws + (role ? WS_QM : WS_PHI)) + uidx * 4096 + il * 64 + 8 * g; const bf16* Cg = (const bf16*)(F.ws + (role ? WS_Y0F : WS_PSF)) + uidx * 4096 + (sl * 4 * 64 + lane) * 4;
#pragma unroll
    for (int m = 0; m < 4; ++m) { o.f[m][0] = *(const bf16x8*)(Mg + m * 1024); o.f[m][1] = *(const bf16x8*)(Mg + m * 1024 + 32); o.c[m] = *(const v2u*)(Cg + m * 256); }
}
__device__ __forceinline__ void lru_scan(Frame& F, int idx) {
    const int ch = idx & 1023, b = (idx >> 10) & 1, d = idx >> 11;
    const float* AG = (const float*)(F.ws + WS_LAGG); float* HIN = (float*)(F.ws + WS_LHIN);
    float carry = 0.f;
#pragma unroll 4
    for (int step = 0; step < 68; ++step) { int tile; if (step < 4) tile = 128 + b * 4 + (d ? 3 - step : step); else tile = b * 64 + (d ? 63 - (step - 4) : step - 4);
        const float a = AG[((size_t)(0 * 2 + d) * NTILE + tile) * LRW + ch], hh_ = AG[((size_t)(1 * 2 + d) * NTILE + tile) * LRW + ch];
        HIN[((size_t)d * NTILE + tile) * LRW + ch] = carry; carry = a * carry + hh_; }
}

__device__ __forceinline__ void chunk_apply(Frame& F, const ChunkOps& o, f32x4 (&S)[4], int step, bf16* YR, int hh, int d, int sl, int role, int lane) {
    const int g = lane >> 4, il = lane & 15; LAS v4u* XCH = (LAS v4u*)F.lds;
    bf16x8 bfr[2];
    if (role == 0) {
#pragma unroll
        for (int ks = 0; ks < 2; ++ks) { v4u w; w.x = pk2(S[2 * ks][0], S[2 * ks][1]); w.y = pk2(S[2 * ks][2], S[2 * ks][3]); w.z = pk2(S[2 * ks + 1][0], S[2 * ks + 1][1]); w.w = pk2(S[2 * ks + 1][2], S[2 * ks + 1][3]); bfr[ks] = __builtin_bit_cast(bf16x8, w); }
#pragma unroll
        for (int m = 0; m < 4; ++m) { f32x4 sn = (f32x4){bf_lo(o.c[m].x), bf_hi(o.c[m].x), bf_lo(o.c[m].y), bf_hi(o.c[m].y)}; sn = MFMA16(o.f[m][0], bfr[0], sn); sn = MFMA16(o.f[m][1], bfr[1], sn); S[m] = sn; }
#pragma unroll
        for (int ks = 0; ks < 2; ++ks) { v4u w; w.x = pk2(S[2 * ks][0], S[2 * ks][1]); w.y = pk2(S[2 * ks][2], S[2 * ks][3]); w.z = pk2(S[2 * ks + 1][0], S[2 * ks + 1][1]); w.w = pk2(S[2 * ks + 1][2], S[2 * ks + 1][3]);
            XCH[((((step + 1) & 1) * 4 + sl) * 2 + ks) * 64 + lane] = w; }
    } else {
#pragma unroll
        for (int ks = 0; ks < 2; ++ks) bfr[ks] = __builtin_bit_cast(bf16x8, XCH[(((step & 1) * 4 + sl) * 2 + ks) * 64 + lane]);
#pragma unroll
        for (int m = 0; m < 4; ++m) { f32x4 y = (f32x4){bf_lo(o.c[m].x), bf_hi(o.c[m].x), bf_lo(o.c[m].y), bf_hi(o.c[m].y)}; y = MFMA16(bfr[0], o.f[m][0], y); y = MFMA16(bfr[1], o.f[m][1], y);
            const int tau = 16 * m + il, tl = d ? 63 - tau : tau; v2u w; w.x = pk2(y[0], y[1]); w.y = pk2(y[2], y[3]);
            *(v2u*)(YR + (size_t)(o.tile * 64 + tl) * RWW + hh * 64 + sl * 16 + 4 * g) = w; }
    }
}
__device__ __forceinline__ void rwkv_chain_chunks(Frame& F, int item) {
    const int chain = item >> 2, sl = item & 3, d = chain & 1, hh = (chain >> 1) & 15, b = chain >> 5, role = F.wave, lane = F.lane;
    bf16* YR = (bf16*)(F.ws + WS_YR) + (size_t)d * MTOT * RWW;
    { LAS v4u* XCH = (LAS v4u*)F.lds; for (int i = F.tid; i < 4 * 2 * 64; i += NTHR) XCH[i] = (v4u){0u, 0u, 0u, 0u}; }
    __syncthreads();
    if (F.wave >= 2) {
#pragma unroll 1
        for (int step = 0; step < 68; ++step) LDS_BAR();
        return; }
    f32x4 S[4];
#pragma unroll
    for (int m = 0; m < 4; ++m) S[m] = (f32x4){0.f, 0.f, 0.f, 0.f};
    ChunkOps A, B, C, E;
    chunk_load(F, A, 0, b, hh, d, sl, role, lane); chunk_load(F, B, 1, b, hh, d, sl, role, lane); chunk_load(F, C, 2, b, hh, d, sl, role, lane);
#pragma unroll 1
    for (int step = 0; step < 68; step += 4) {
        chunk_load(F, E, step + 3, b, hh, d, sl, role, lane);
        chunk_apply(F, A, S, step, YR, hh, d, sl, role, lane); LDS_BAR();
        chunk_load(F, A, step + 4, b, hh, d, sl, role, lane);
        chunk_apply(F, B, S, step + 1, YR, hh, d, sl, role, lane); LDS_BAR();
        chunk_load(F, B, step + 5, b, hh, d, sl, role, lane);
        chunk_apply(F, C, S, step + 2, YR, hh, d, sl, role, lane); LDS_BAR();
        chunk_load(F, C, step + 6, b, hh, d, sl, role, lane);
        chunk_apply(F, E, S, step + 3, YR, hh, d, sl, role, lane); LDS_BAR();
    }
}
__device__ __forceinline__ void merge_unit(Frame& F, int l, int u) {
    const int c = u >> 2; const TileInfo ti = tile_info(c); const int t0 = ti.t0 + (u & 3) * 16; const bf16* P = (const bf16*)(F.ws + WS_P);
    LAS bf16* SG = (LAS bf16*)F.lds; LAS bf16* GO = (LAS bf16*)(F.lds + 10752);
    const float* mu0 = gin(F.in[I_MU]) + (size_t)l * 2 * RW_COLS; const float* mu1 = mu0 + RW_COLS;
    if (F.tid < 16 * 20) { const int t = F.tid / 20, k8 = (F.tid % 20) * 8, tt = t0 + t, rc = 3 * RWW + 256 + k8; const bf16* p = P + (size_t)(ti.seq_base + tt) * IN_PAD + 2 * LRW + rc;
        float x[8], xm[8], xn[8]; ld8bf(p, x); ld8bf(p - (tt > 0 ? IN_PAD : 0), xm); ld8bf(p + (tt + 1 < ti.seq_len ? IN_PAD : 0), xn); float o[8];
#pragma unroll
        for (int e = 0; e < 8; ++e) { const float pm = tt > 0 ? xm[e] : 0.f, pn = tt + 1 < ti.seq_len ? xn[e] : 0.f; o[e] = fsigmoid(x[e] + mu0[rc + e] * (pm - x[e]) + mu1[rc + e] * (pn - x[e])); }
        v4u w; w.x = pk2(o[0], o[1]); w.y = pk2(o[2], o[3]); w.z = pk2(o[4], o[5]); w.w = pk2(o[6], o[7]); *(LAS v4u*)(SG + t * 168 + k8) = w; }
    __syncthreads();
    { const int lane = F.lane; const bf16* G2 = (const bf16*)(F.ws + WS_G2T) + (size_t)l * 1024 * 160;
      bf16x8 af[5];
#pragma unroll
      for (int k = 0; k < 5; ++k) af[k] = frag_lds(SG, 168, 0, 32 * k, lane);
#pragma unroll 2
      for (int n = 0; n < 8; ++n) { const int n0 = F.wave * 128 + n * 16; f32x4 a0 = {0.f, 0.f, 0.f, 0.f};
#pragma unroll
          for (int k = 0; k < 5; ++k) a0 = MFMA16(af[k], frag_g(G2, 160, n0, 32 * k, lane), a0);
#pragma unroll
          for (int r = 0; r < 4; ++r) GO[(4 * (lane >> 4) + r) * 1032 + n0 + (lane & 15)] = (bf16)f2bf(a0[r]); } }
    __syncthreads();
    { bf16* MRG = (bf16*)(F.ws + WS_H);
      for (int it = F.tid; it < 16 * 256; it += NTHR) { const int t = it >> 8, cgp = it & 255, tt = t0 + t; const size_t grow = (size_t)(ti.seq_base + tt);
          float o[8];
          if (cgp < 128) { const int ch = cgp * 8; float gq8[8]; ld8bf(P + grow * IN_PAD + LRW + ch, gq8); const f32x4 g0 = {gq8[0], gq8[1], gq8[2], gq8[3]}, g1 = {gq8[4], gq8[5], gq8[6], gq8[7]};
              const bf16* hl = (const bf16*)(F.ws + WS_LB) + grow * LRW + ch; const bf16* ac = (const bf16*)(F.ws + WS_LA) + grow * LRW + ch; const float* hi = (const float*)(F.ws + WS_LHIN) + (size_t)c * LRW + ch;
              float h0[8], c0[8], h1[8], c1[8]; ld8bf(hl, h0); ld8bf(ac, c0); ld8bf(hl + (size_t)MTOT * LRW, h1); ld8bf(ac + (size_t)MTOT * LRW, c1);
              const f32x4 i00 = *(const f32x4*)hi, i01 = *(const f32x4*)(hi + 4), i10 = *(const f32x4*)(hi + (size_t)NTILE * LRW), i11 = *(const f32x4*)(hi + (size_t)NTILE * LRW + 4);
              const f32x4 a0 = {h0[0] + c0[0] * i00.x + h1[0] + c1[0] * i10.x, h0[1] + c0[1] * i00.y + h1[1] + c1[1] * i10.y, h0[2] + c0[2] * i00.z + h1[2] + c1[2] * i10.z, h0[3] + c0[3] * i00.w + h1[3] + c1[3] * i10.w};
              const f32x4 a1 = {h0[4] + c0[4] * i01.x + h1[4] + c1[4] * i11.x, h0[5] + c0[5] * i01.y + h1[5] + c1[5] * i11.y, h0[6] + c0[6] * i01.z + h1[6] + c1[6] * i11.z, h0[7] + c0[7] * i01.w + h1[7] + c1[7] * i11.w};
              o[0] = gelu_tanh(g0.x) * a0.x; o[1] = gelu_tanh(g0.y) * a0.y; o[2] = gelu_tanh(g0.z) * a0.z; o[3] = gelu_tanh(g0.w) * a0.w;
              o[4] = gelu_tanh(g1.x) * a1.x; o[5] = gelu_tanh(g1.y) * a1.y; o[6] = gelu_tanh(g1.z) * a1.z; o[7] = gelu_tanh(g1.w) * a1.w; }
          else { const int ch = (cgp - 128) * 8, hh = ch >> 6; const bf16* yr = (const bf16*)(F.ws + WS_YR) + grow * RWW + ch;
              float ya[8], yb[8], va[8]; ld8bf(yr, ya); ld8bf(yr + (size_t)MTOT * RWW, yb); ld8bf((const bf16*)(F.ws + WS_RV) + grow * RWW + ch, va);
              float s1 = 0.f, q1 = 0.f;
#pragma unroll
              for (int e = 0; e < 8; ++e) { ya[e] += yb[e]; s1 += ya[e]; q1 += ya[e] * ya[e]; }
              s1 = red8(s1); q1 = red8(q1);
              const float mean = s1 * (1.0f / 64.0f), var = fmaxf(q1 * (1.0f / 64.0f) - mean * mean, 0.f); const f32x2 st = {mean, __builtin_amdgcn_rsqf(var + GN_EPS)};
              const float beta = ((const float*)(F.ws + WS_BETA))[grow * NH + hh] + ((const float*)(F.ws + WS_BETA))[((size_t)MTOT + grow) * NH + hh];
              const float* gg = gin(F.in[I_GNG]) + (size_t)l * RWW + ch; const float* gb = gin(F.in[I_GNB]) + (size_t)l * RWW + ch;
              const v4u gq = *(const LAS v4u*)(GO + t * 1032 + ch); const float gv[8] = {bf_lo(gq.x), bf_hi(gq.x), bf_lo(gq.y), bf_hi(gq.y), bf_lo(gq.z), bf_hi(gq.z), bf_lo(gq.w), bf_hi(gq.w)};
#pragma unroll
              for (int e = 0; e < 8; ++e) o[e] = ((ya[e] - st.x) * st.y * gg[e] + gb[e] + beta * va[e]) * gv[e]; }
          v4u w; w.x = pk2(o[0], o[1]); w.y = pk2(o[2], o[3]); w.z = pk2(o[4], o[5]); w.w = pk2(o[6], o[7]);
          *(v4u*)(MRG + grow * D + cgp * 8) = w; } }
    __syncthreads();
}

__device__ __forceinline__ void ln_row(float (&z)[32], const float* g, const float* b, int lane) {
    float s = 0.f;
#pragma unroll
    for (int i = 0; i < 32; ++i) s += z[i];
    const float mean = wave_sum(s) * (1.0f / D); float q = 0.f;
#pragma unroll
    for (int i = 0; i < 32; ++i) { z[i] -= mean; q += z[i] * z[i]; }
    const float rstd = __builtin_amdgcn_rsqf(wave_sum(q) * (1.0f / D) + LN_EPS);
#pragma unroll
    for (int j = 0; j < 4; ++j) { const int e = j * 512 + lane * 8; const f32x4 g0 = *(const f32x4*)(g + e), g1 = *(const f32x4*)(g + e + 4), b0 = *(const f32x4*)(b + e), b1 = *(const f32x4*)(b + e + 4);
        const float gs[8] = {g0.x, g0.y, g0.z, g0.w, g1.x, g1.y, g1.z, g1.w}, bs[8] = {b0.x, b0.y, b0.z, b0.w, b1.x, b1.y, b1.z, b1.w};
#pragma unroll
        for (int i = 0; i < 8; ++i) z[j * 8 + i] = z[j * 8 + i] * rstd * gs[i] + bs[i]; }
}
__device__ __forceinline__ void load32(const float* p, int lane, float (&v)[32]) {
#pragma unroll
    for (int j = 0; j < 4; ++j) { const int e = j * 512 + lane * 8; const f32x4 a = *(const f32x4*)(p + e), b = *(const f32x4*)(p + e + 4);
        v[j * 8 + 0] = a.x; v[j * 8 + 1] = a.y; v[j * 8 + 2] = a.z; v[j * 8 + 3] = a.w; v[j * 8 + 4] = b.x; v[j * 8 + 5] = b.y; v[j * 8 + 6] = b.z; v[j * 8 + 7] = b.w; }
}
__device__ __forceinline__ void store32(float* p, int lane, const float (&v)[32]) {
#pragma unroll
    for (int j = 0; j < 4; ++j) { const int e = j * 512 + lane * 8; *(f32x4*)(p + e) = (f32x4){v[j * 8 + 0], v[j * 8 + 1], v[j * 8 + 2], v[j * 8 + 3]}; *(f32x4*)(p + e + 4) = (f32x4){v[j * 8 + 4], v[j * 8 + 5], v[j * 8 + 6], v[j * 8 + 7]}; }
}
__device__ __forceinline__ void store32_mod_bf16(bf16* p, const float* sh, const float* sc, int lane, const float (&v)[32]) {
#pragma unroll
    for (int j = 0; j < 4; ++j) { const int e = j * 512 + lane * 8; const f32x4 s0 = *(const f32x4*)(sh + e), s1 = *(const f32x4*)(sh + e + 4), c0 = *(const f32x4*)(sc + e), c1 = *(const f32x4*)(sc + e + 4);
        v4u o; o.x = pk2(v[j * 8 + 0] * (1.f + c0.x) + s0.x, v[j * 8 + 1] * (1.f + c0.y) + s0.y); o.y = pk2(v[j * 8 + 2] * (1.f + c0.z) + s0.z, v[j * 8 + 3] * (1.f + c0.w) + s0.w);
        o.z = pk2(v[j * 8 + 4] * (1.f + c1.x) + s1.x, v[j * 8 + 5] * (1.f + c1.y) + s1.y); o.w = pk2(v[j * 8 + 6] * (1.f + c1.z) + s1.z, v[j * 8 + 7] * (1.f + c1.w) + s1.w);
        *(v4u*)(p + e) = o; }
}
__device__ __forceinline__ void ln1_rows(Frame& F, int l, int nrows, bool dry = false) {
    const int gw = F.vcu * NWAVES + F.wave, NGW = F.G * NWAVES; float* X = (float*)(F.ws + WS_X); const float* O = (const float*)(F.ws + WS_O); bf16* H = (bf16*)(F.ws + WS_H);
    float* Xo = dry ? (float*)(F.ws + WS_LA) : X; bf16* Ho = dry ? (bf16*)(F.ws + WS_LB) : H;
    for (int row = gw; row < nrows; row += NGW) { const float* md = (const float*)(F.ws + WS_MOD) + ((size_t)l * 3 + mod_row(row)) * (6 * D);
        float z[32], o[32], gt[32]; load32(X + (size_t)row * D, F.lane, z); load32(md + 2 * D, F.lane, gt);
#pragma unroll
        for (int j = 0; j < 4; ++j) { float t8[8]; ld8bf((const bf16*)(F.ws + WS_O) + (size_t)row * D + j * 512 + F.lane * 8, t8);
#pragma unroll
            for (int i = 0; i < 8; ++i) o[j * 8 + i] = t8[i]; }
#pragma unroll
        for (int i = 0; i < 32; ++i) z[i] = ALPHA * z[i] + gt[i] * o[i];
        ln_row(z, gin(F.in[I_LN1G]) + (size_t)l * D, gin(F.in[I_LN1B]) + (size_t)l * D, F.lane);
        store32(Xo + (size_t)row * D, F.lane, z);
        store32_mod_bf16(Ho + (size_t)row * D, md + 3 * D, md + 4 * D, F.lane, z); }
}

__device__ __forceinline__ unsigned ord_key(float s, int k) { unsigned u = __builtin_bit_cast(unsigned, s); u = (u & 0x80000000u) ? ~u : (u | 0x80000000u); return (u & ~127u) | (unsigned)(127 - k); }
__device__ __forceinline__ float key_score(unsigned key) { const unsigned u = key & ~127u; return __builtin_bit_cast(float, (u & 0x80000000u) ? (u ^ 0x80000000u) : ~u); }
__device__ __forceinline__ void bitonic_top16(unsigned (&A)[16], const unsigned (&B)[16]) {
#pragma unroll
    for (int i = 0; i < 16; ++i) A[i] = A[i] > B[15 - i] ? A[i] : B[15 - i];
#pragma unroll
    for (int st = 8; st >= 1; st >>= 1)
#pragma unroll
        for (int i = 0; i < 16; ++i) if (!(i & st)) { const unsigned hi = A[i] > A[i + st] ? A[i] : A[i + st], lo = A[i] > A[i + st] ? A[i + st] : A[i]; A[i] = hi; A[i + st] = lo; }
}
__device__ __forceinline__ void ins16(unsigned (&L)[16], unsigned x) {
#pragma unroll
    for (int i = 0; i < 16; ++i) { const unsigned hi = L[i] > x ? L[i] : x; x = L[i] > x ? x : L[i]; L[i] = hi; }
}
__device__ __forceinline__ unsigned ord_key8(float s, unsigned tag) { unsigned u = __builtin_bit_cast(unsigned, s); u = (u & 0x80000000u) ? ~u : (u | 0x80000000u); return (u & ~255u) | tag; }
__device__ __forceinline__ float key_score8(unsigned key) { const unsigned u = key & ~255u; return __builtin_bit_cast(float, (u & 0x80000000u) ? (u ^ 0x80000000u) : ~u); }
__device__ __forceinline__ void peer_topk_unit(Frame& F, int l, int tile, int h) {
    int tid = F.tid; asm volatile("" : "+v"(tid));
    const int lane = tid & 63, wave = F.wave;
    LAS bf16* AQ = (LAS bf16*)F.lds; LAS float* SC = (LAS float*)(F.lds + 33792);
    LAS unsigned* bufA = (LAS unsigned*)F.lds; LAS unsigned* bufB = (LAS unsigned*)(F.lds + 33792); LAS unsigned* FIN = (LAS unsigned*)(F.lds + 66560); LAS unsigned char* PAIRT = (LAS unsigned char*)(F.lds + 99584);
    if (tid < 50) { int c = tid, i = 0; for (; i < 16; ++i) { const int n = 16 / (i + 1); if (c < n) break; c -= n; } PAIRT[tid] = (unsigned char)(i * 16 + c); }
    for (int idx = tid; idx < 64 * 64; idx += NTHR) { const int t = idx >> 6, c4 = (idx & 63) * 4; *(LAS v2u*)(AQ + t * 264 + c4) = *(const v2u*)((const bf16*)(F.ws + WS_QP) + (size_t)(tile * 64 + t) * D + h * 256 + c4); }
    __syncthreads();
    { const bf16* SK = (const bf16*)(F.ws + WS_SUBK) + (size_t)((l * 8 + h) * 2) * 128 * 128;
#pragma unroll
      for (int p = 0; p < 2; ++p) { bf16x8 bfr[4];
#pragma unroll
          for (int k = 0; k < 4; ++k) bfr[k] = frag_g(SK + (size_t)p * 128 * 128, 128, 16 * wave, 32 * k, lane);
#pragma unroll
          for (int m = 0; m < 4; ++m) { f32x4 acc = {0.f, 0.f, 0.f, 0.f};
#pragma unroll
              for (int k = 0; k < 4; ++k) acc = MFMA16(frag_lds(AQ, 264, 16 * m, p * 128 + 32 * k, lane), bfr[k], acc);
#pragma unroll
              for (int r = 0; r < 4; ++r) SC[(16 * m + 4 * (lane >> 4) + r) * 257 + p * 128 + 16 * wave + (lane & 15)] = acc[r]; } } }
    __syncthreads();
    const int t = lane, r = wave, p = r & 1, qd = r >> 1;
    unsigned L[16], B[16];
#pragma unroll
    for (int i = 0; i < 16; ++i) L[i] = 0u;
    { const LAS float* sp = SC + t * 257 + p * 128 + 32 * qd;
#pragma unroll 4
      for (int k = 0; k < 32; ++k) ins16(L, ord_key(sp[k], 32 * qd + k)); }
#pragma unroll
    for (int i = 0; i < 16; ++i) bufA[(r * 16 + i) * 64 + t] = L[i];
    __syncthreads();
#pragma unroll
    for (int i = 0; i < 16; ++i) B[i] = bufA[((r ^ 2) * 16 + i) * 64 + t];
    bitonic_top16(L, B);
#pragma unroll
    for (int i = 0; i < 16; ++i) bufB[(r * 16 + i) * 64 + t] = L[i];
    __syncthreads();
#pragma unroll
    for (int i = 0; i < 16; ++i) B[i] = bufB[((r ^ 4) * 16 + i) * 64 + t];
    bitonic_top16(L, B);
    if (qd == 0) {
#pragma unroll
        for (int i = 0; i < 16; ++i) FIN[(p * 16 + i) * 64 + t] = L[i]; }
    __syncthreads();
#pragma unroll
    for (int i = 0; i < 16; ++i) L[i] = 0u;
#pragma unroll
    for (int q = 0; q < 7; ++q) { const int c = q * 8 + r; if (c < 50) { const unsigned pr = PAIRT[c]; const unsigned ka = FIN[(0 * 16 + (pr >> 4)) * 64 + t], kb = FIN[(1 * 16 + (pr & 15)) * 64 + t];
            ins16(L, ord_key8(key_score(ka) + key_score(kb), pr)); } }
#pragma unroll
    for (int i = 0; i < 16; ++i) bufB[(r * 16 + i) * 64 + t] = L[i];
    __syncthreads();
#pragma unroll
    for (int i = 0; i < 16; ++i) B[i] = bufB[((r ^ 1) * 16 + i) * 64 + t];
    bitonic_top16(L, B);
#pragma unroll
    for (int i = 0; i < 16; ++i) bufA[(r * 16 + i) * 64 + t] = L[i];
    __syncthreads();
#pragma unroll
    for (int i = 0; i < 16; ++i) B[i] = bufA[((r ^ 2) * 16 + i) * 64 + t];
    bitonic_top16(L, B);
    __syncthreads();
#pragma unroll
    for (int i = 0; i < 16; ++i) bufB[(r * 16 + i) * 64 + t] = L[i];
    __syncthreads();
#pragma unroll
    for (int i = 0; i < 16; ++i) B[i] = bufB[((r ^ 4) * 16 + i) * 64 + t];
    bitonic_top16(L, B);
    { const float mx = key_score8(L[0]); float sum = 0.f, e0 = 0.f, e1 = 0.f; unsigned k0 = 0u, k1 = 0u;
#pragma unroll
      for (int i = 0; i < 16; ++i) { const float e = fexp(key_score8(L[i]) - mx); sum += e; if (i == 2 * r) { e0 = e; k0 = L[i]; } if (i == 2 * r + 1) { e1 = e; k1 = L[i]; } }
      const float inv = __builtin_amdgcn_rcpf(sum);
      const unsigned pa = k0 & 255u, pb = k1 & 255u;
      const int id0 = (127 - (int)(FIN[(0 * 16 + (pa >> 4)) * 64 + t] & 127u)) * 128 + (127 - (int)(FIN[(1 * 16 + (pa & 15)) * 64 + t] & 127u));
      const int id1 = (127 - (int)(FIN[(0 * 16 + (pb >> 4)) * 64 + t] & 127u)) * 128 + (127 - (int)(FIN[(1 * 16 + (pb & 15)) * 64 + t] & 127u));
      int* IDX = (int*)(F.ws + WS_IDX) + (size_t)(tile * 64 + t) * PE_SEL + h * 16 + 2 * r; float* GT = (float*)(F.ws + WS_GATE) + (size_t)(tile * 64 + t) * PE_SEL + h * 16 + 2 * r;
      *(int2*)IDX = make_int2(id0, id1); *(f32x2*)GT = (f32x2){e0 * inv, e1 * inv}; }
    __syncthreads();
}

#ifndef GPROBE
#define GPROBE 0
#endif
#ifndef GPROBE_MASK
#define GPROBE_MASK (~0u)
#endif
#ifndef EBU_
#define EBU_ 8
#endif
#ifndef EBV_
#define EBV_ 8
#endif
constexpr int EB = 8;
__device__ __forceinline__ v32f ld_row6(const unsigned char* row, int lane) {
    const v4u a = *(const v4u*)(row + lane * 16); const v2u b = *(const v2u*)(row + 1024 + lane * 8);
    return __builtin_amdgcn_cvt_scalef32_pk32_f32_fp6((v6u){a.x, a.y, a.z, a.w, b.x, b.y}, 1.0f);
}
#define SCHED_FENCE() __builtin_amdgcn_sched_barrier(0)
template <int EB> __device__ __forceinline__ void ld_rows(__amdgpu_buffer_rsrc_t TB, unsigned tbo, int sel, int k0, unsigned lo16, unsigned emask, v4u (&wa)[EB], v2u (&wb)[EB]) {
#pragma unroll
    for (int q = 0; q < EB; ++q) { const unsigned e = (unsigned)__builtin_amdgcn_readlane(sel, (k0 + q) & 63) & emask;
        wa[q] = __builtin_bit_cast(v4u, __builtin_amdgcn_raw_buffer_load_b128(TB, lo16, e * (unsigned)EROW + tbo, 0));
        wb[q] = __builtin_bit_cast(v2u, __builtin_amdgcn_raw_buffer_load_b64(TB, (lo16 >> 1) + 1024u, e * (unsigned)EROW + tbo, 0)); }
}
typedef float f32p __attribute__((ext_vector_type(2)));
template <int EB> __device__ __forceinline__ void u_batch(const v4u (&wa)[EB], const v2u (&wb)[EB], const f32p (&hf)[16], int k0, int lane, LAS float* dots) {
    static_assert(EB == 4, "the transposing reduction below takes four experts at a time");
    float s4[4];
#pragma unroll
    for (int q = 0; q < EB; ++q) { const v32f uf = __builtin_amdgcn_cvt_scalef32_pk32_f32_fp6((v6u){wa[q].x, wa[q].y, wa[q].z, wa[q].w, wb[q].x, wb[q].y}, 1.0f);
        f32p p0 = {0.f, 0.f}, p1 = {0.f, 0.f};
#pragma unroll
        for (int i = 0; i < 16; i += 2) { p0 = __builtin_elementwise_fma((f32p){uf[2 * i], uf[2 * i + 1]}, hf[i], p0); p1 = __builtin_elementwise_fma((f32p){uf[2 * i + 2], uf[2 * i + 3]}, hf[i + 1], p1); }
        p0 += p1; s4[q] = p0.x + p0.y; }
    const bool b0 = lane & 1, b1 = lane & 2;
    const float t0 = s4[0] + dpp_f<0xB1>(s4[0]), t1 = s4[1] + dpp_f<0xB1>(s4[1]), t2 = s4[2] + dpp_f<0xB1>(s4[2]), t3 = s4[3] + dpp_f<0xB1>(s4[3]);
    const float r01 = b0 ? t1 : t0, r23 = b0 ? t3 : t2;
    const float w0 = r01 + dpp_f<0x4E>(r01), w1 = r23 + dpp_f<0x4E>(r23);
    float r = b1 ? w1 : w0;
    r += dpp_f<0x124>(r); r += dpp_f<0x128>(r);
    dots[k0 >> 2] = r;
}
template <int EB> __device__ __forceinline__ void v_batch(const v4u (&wa)[EB], const v2u (&wb)[EB], int k0, float csel, f32p (&acc)[16]) {
#pragma unroll
    for (int q = 0; q < EB; ++q) { const float cf = __builtin_bit_cast(float, __builtin_amdgcn_readlane(__builtin_bit_cast(int, csel), (k0 + q) & 63));
        const v32f vf = __builtin_amdgcn_cvt_scalef32_pk32_f32_fp6((v6u){wa[q].x, wa[q].y, wa[q].z, wa[q].w, wb[q].x, wb[q].y}, 1.0f);
        const f32p c2 = {cf, cf};
#pragma unroll
        for (int i = 0; i < 16; ++i) acc[i] = __builtin_elementwise_fma((f32p){vf[2 * i], vf[2 * i + 1]}, c2, acc[i]); }
}
template <int EB> __device__ __forceinline__ void peer_token(Frame& F, int l, int row, int kb, int ke, float (&acc)[32], unsigned emask = ~0u) {
    const int lane = F.lane; const unsigned lo16 = lane * 16;
    const __amdgpu_buffer_rsrc_t TB = __builtin_amdgcn_make_buffer_rsrc((void*)(F.ws + WS_UB + (size_t)l * PE_NE * EROW), 0, 0xffffffffu, 0x00020000);
    constexpr unsigned UB = 0u, VB = (unsigned)(WS_VB - WS_UB);
    static_assert(WS_VB > WS_UB && (size_t)(WS_VB - WS_UB) + (size_t)PE_NE * EROW < 0xffffffffull, "table offsets must fit the 32-bit buffer offset");
    LAS float* dots = (LAS float*)(F.lds + 49152) + (F.wave * 64 + lane) * 33;
    const float* SU = (const float*)(F.ws + WS_SU) + (size_t)l * PE_NE; const float* SV = (const float*)(F.ws + WS_SV) + (size_t)l * PE_NE;
    const bf16* H = (const bf16*)(F.ws + WS_H);
    const int* IDX = (const int*)(F.ws + WS_IDX) + (size_t)row * PE_SEL; const float* GT = (const float*)(F.ws + WS_GATE) + (size_t)row * PE_SEL;
    const int il = IDX[lane], ih = IDX[64 + lane]; const float gl = GT[lane], gh = GT[64 + lane];
    f32p hf[16];
#pragma unroll
    for (int j = 0; j < 4; ++j) { const v4u t4 = *(const v4u*)(H + (size_t)row * D + lane * 32 + j * 8);
        hf[4 * j] = (f32p){bf_lo(t4.x), bf_hi(t4.x)}; hf[4 * j + 1] = (f32p){bf_lo(t4.y), bf_hi(t4.y)}; hf[4 * j + 2] = (f32p){bf_lo(t4.z), bf_hi(t4.z)}; hf[4 * j + 3] = (f32p){bf_lo(t4.w), bf_hi(t4.w)}; }
    const float sul = SU[il], suh = SU[ih], svl = SV[il], svh = SV[ih];
    SCHED_FENCE(); __builtin_amdgcn_s_waitcnt(0x0070); SCHED_FENCE();
    v4u a0[EB], a1[EB]; v2u b0[EB], b1[EB];
    ld_rows<EB>(TB, UB, kb < 64 ? il : ih, kb, lo16, emask, a0, b0); SCHED_FENCE();
#pragma unroll 1
    for (int k0 = kb; k0 < ke; k0 += 2 * EB) {
        ld_rows<EB>(TB, UB, k0 < 64 ? il : ih, k0 + EB, lo16, emask, a1, b1); SCHED_FENCE();
        u_batch<EB>(a0, b0, hf, k0, lane, dots); SCHED_FENCE();
        { const int kn = k0 + 2 * EB; const bool last = kn >= ke; const int k2 = last ? kb : kn; ld_rows<EB>(TB, last ? VB : UB, k2 < 64 ? il : ih, k2, lo16, emask, a0, b0); } SCHED_FENCE();
        u_batch<EB>(a1, b1, hf, k0 + EB, lane, dots); SCHED_FENCE(); }
    float dl = 0.f, dh = 0.f;
    { const LAS float* dr = (const LAS float*)(F.lds + 49152) + (F.wave * 64 + (lane & 3)) * 33 + (lane >> 2);
#pragma unroll
      for (int r4 = 0; r4 < 4; ++r4) { dl += dr[r4 * 16 * 33]; dh += dr[r4 * 16 * 33 + 16]; } }
    const float cl = gl * svl * gelu_erf(dl * sul), ch = gh * svh * gelu_erf(dh * suh);
    f32p ac2[16];
#pragma unroll
    for (int i = 0; i < 16; ++i) ac2[i] = (f32p){0.f, 0.f};
#pragma unroll 1
    for (int k0 = kb; k0 < ke; k0 += 2 * EB) {
        ld_rows<EB>(TB, VB, k0 < 64 ? il : ih, k0 + EB, lo16, emask, a1, b1); SCHED_FENCE();
        v_batch<EB>(a0, b0, k0, k0 < 64 ? cl : ch, ac2); SCHED_FENCE();
        { const int kn = k0 + 2 * EB; const int k2 = kn >= ke ? k0 : kn; ld_rows<EB>(TB, VB, k2 < 64 ? il : ih, k2, lo16, emask, a0, b0); } SCHED_FENCE();
        v_batch<EB>(a1, b1, k0 + EB, k0 < 64 ? cl : ch, ac2); SCHED_FENCE(); }
#pragma unroll
    for (int i = 0; i < 16; ++i) { acc[2 * i] = ac2[i].x; acc[2 * i + 1] = ac2[i].y; }
}
__device__ __forceinline__ void peer_finish(Frame& F, int l, int row, const float (&acc)[32], bool dry) {
    const int lane = F.lane;
    float* X = (float*)(F.ws + WS_X); bf16* H = (bf16*)(F.ws + WS_H); float* Xo = dry ? (float*)(F.ws + WS_LA) : X; bf16* Ho = dry ? (bf16*)(F.ws + WS_LB) : H; float* Oo = dry ? (float*)(F.ws + WS_LA) : (float*)F.out;
    const float* md = (const float*)(F.ws + WS_MOD) + ((size_t)l * 3 + mod_row(row)) * (6 * D);
    float z[32]; float s = 0.f;
#pragma unroll
    for (int q = 0; q < 8; ++q) { const int e = lane * 32 + q * 4; const f32x4 xv = *(const f32x4*)(X + (size_t)row * D + e), gv = *(const f32x4*)(md + 5 * D + e);
        z[q * 4 + 0] = ALPHA * xv.x + gv.x * acc[q * 4 + 0]; z[q * 4 + 1] = ALPHA * xv.y + gv.y * acc[q * 4 + 1]; z[q * 4 + 2] = ALPHA * xv.z + gv.z * acc[q * 4 + 2]; z[q * 4 + 3] = ALPHA * xv.w + gv.w * acc[q * 4 + 3]; }
#pragma unroll
    for (int i = 0; i < 32; ++i) s += z[i];
    const float mean = wave_sum(s) * (1.0f / D); float qv = 0.f;
#pragma unroll
    for (int i = 0; i < 32; ++i) { z[i] -= mean; qv += z[i] * z[i]; }
    const float rstd = __builtin_amdgcn_rsqf(wave_sum(qv) * (1.0f / D) + LN_EPS);
    const float* lg = gin(F.in[I_LN2G]) + (size_t)l * D; const float* lb = gin(F.in[I_LN2B]) + (size_t)l * D; const float* mn = (const float*)(F.ws + WS_MOD) + ((size_t)(l + 1 < DEPTH ? l + 1 : l) * 3 + mod_row(row)) * (6 * D);
    unsigned hw[16];
#pragma unroll
    for (int q = 0; q < 8; ++q) { const int e = lane * 32 + q * 4; const f32x4 g4 = *(const f32x4*)(lg + e), b4 = *(const f32x4*)(lb + e);
        f32x4 o; o.x = z[q * 4 + 0] * rstd * g4.x + b4.x; o.y = z[q * 4 + 1] * rstd * g4.y + b4.y; o.z = z[q * 4 + 2] * rstd * g4.z + b4.z; o.w = z[q * 4 + 3] * rstd * g4.w + b4.w;
        if (l + 1 < DEPTH) { *(f32x4*)(Xo + (size_t)row * D + e) = o; const f32x4 s4 = *(const f32x4*)(mn + e), c4 = *(const f32x4*)(mn + D + e);
            hw[2 * q] = pk2(o.x * (1.f + c4.x) + s4.x, o.y * (1.f + c4.y) + s4.y); hw[2 * q + 1] = pk2(o.z * (1.f + c4.z) + s4.z, o.w * (1.f + c4.w) + s4.w); }
        else *(f32x4*)(Oo + (size_t)row * D + e) = o; }
    if (l + 1 < DEPTH) {
#pragma unroll
        for (int j = 0; j < 4; ++j) *(v4u*)(Ho + (size_t)row * D + lane * 32 + j * 8) = (v4u){hw[4 * j], hw[4 * j + 1], hw[4 * j + 2], hw[4 * j + 3]}; }
}
__device__ __forceinline__ void peer_rows(Frame& F, int l, int nrows, bool dry = false) {
    const int gw = F.vcu * NWAVES + F.wave, NGW = F.G * NWAVES, lane = F.lane;
    for (int row = gw; row < NLAT; row += NGW) { Frame F2 = F; { int t_ = F.lane; asm volatile("" : "+v"(t_)); F2.lane = t_; }
        float acc[32]; peer_token<EBU_>(F2, l, row, 0, PE_SEL, acc, dry ? GPROBE_MASK : ~0u); { int t_ = F2.lane; asm volatile("" : "+v"(t_)); F2.lane = t_; } peer_finish(F2, l, row, acc, dry); }
    if (nrows > NLAT) { LAS float* PART = (LAS float*)F.lds;
        for (int r2 = F.vcu * 2 + (F.wave >> 2); r2 < NCTX; r2 += F.G * 2) { const int row = NLAT + r2, part = F.wave & 3, slot = F.wave >> 2; float acc[32]; Frame F2 = F; { int t_ = F.lane; asm volatile("" : "+v"(t_)); F2.lane = t_; }
            peer_token<EBU_>(F2, l, row, 32 * part, 32 * part + 32, acc, dry ? GPROBE_MASK : ~0u);
            if (part) { LAS float* pw = PART + ((slot * 3 + part - 1) * 32) * 64 + lane;
#pragma unroll
                for (int i = 0; i < 32; ++i) pw[i * 64] = acc[i]; }
            __syncthreads();
            if (part == 0) { const LAS float* pr = PART + (slot * 96) * 64 + lane;
#pragma unroll
                for (int p = 0; p < 3; ++p)
#pragma unroll
                    for (int i = 0; i < 32; ++i) acc[i] += pr[(p * 32 + i) * 64];
                peer_finish(F2, l, row, acc, dry); }
            __syncthreads(); } }
}
#ifndef MK_PER_PHASE
#define MK_PER_PHASE 0
#endif
constexpr int NPH_PRO = 3, NPH_LAYER = 9, NPHASES = NPH_PRO + DEPTH * NPH_LAYER;
__global__ void __launch_bounds__(NTHR, 2) trunk_fwd(Args args) {
    extern __shared__ __attribute__((aligned(16))) unsigned char lds_raw[];
    Frame F0;
    F0.lds = (LAS unsigned char*)lds_raw;
    F0.tid = threadIdx.x; F0.lane = F0.tid & 63; F0.wave = __builtin_amdgcn_readfirstlane(F0.tid >> 6);
    F0.G = gridDim.x; { const int bx = blockIdx.x; F0.vcu = (F0.G % 8 == 0) ? (bx % 8) * (F0.G / 8) + bx / 8 : bx; }
    F0.in = args.in; F0.out = (GAS float*)args.out; F0.ws = (GAS unsigned char*)args.ws;
    volatile LAS unsigned* MISC = (volatile LAS unsigned*)(F0.lds + MISC_OFF);
    for (int u = F0.tid; u < (LDS_BYTES - LDSCTL_OFF) / 4; u += NTHR) ((LAS unsigned*)(F0.lds + LDSCTL_OFF))[u] = 0u;
    __syncthreads();
    const int lo = args.ph_lo, hi = args.ph_hi;
    XcdBarrier bar; bar.bar = (unsigned*)(F0.ws + WS_CTL) + CW_BAR; bar.x = 0; bar.st = nullptr;
    if (hi - lo > 1) bar = xcd_barrier_post((unsigned*)(F0.ws + WS_CTL) + CW_BAR, MISC + 8);
#ifndef PHMASK
#define PHMASK 0xfff
#endif
#define PHM(b) ((PHMASK >> (b)) & 1)
#ifndef PHREP
#define PHREP 0
#endif
#define NREP(b) (1 + ((PHREP >> (b)) & 1))
#define IN(k) (lo <= (k) && (k) < hi)
#define LAUNDER() Frame F = F0; int bx_ = blockIdx.x; __builtin_amdgcn_s_waitcnt(0x0070); { int ws_ = F0.wave; asm volatile("" : "+s"(ws_)); int ln_; asm volatile("v_mbcnt_lo_u32_b32 %0, -1, 0\n\tv_mbcnt_hi_u32_b32 %0, -1, %0" : "=v"(ln_)); F.wave = ws_; F.lane = ln_; F.tid = ws_ * 64 + ln_; \
    GAS unsigned char* w_ = F0.ws; asm volatile("" : "+s"(w_)); F.ws = w_; int v_ = F0.vcu; asm volatile("" : "+s"(v_)); F.vcu = v_; int g_ = F0.G; asm volatile("" : "+s"(g_)); F.G = g_; \
    GAS float* o_ = F0.out; asm volatile("" : "+s"(o_)); F.out = o_; asm volatile("" : "+s"(bx_)); \
    unsigned l_ = (unsigned)(size_t)F0.lds; asm volatile("" : "+v"(l_)); F.lds = (LAS unsigned char*)(size_t)l_; }
#define SEAM(k) do { if (IN(k) && IN((k) + 1)) xcd_barrier(bar); } while (0)

    if (PHM(0) && IN(0)) for (int rep_ = 0; rep_ < NREP(0); ++rep_) { LAUNDER(); p0_prologue(F); } SEAM(0);
    if (PHM(1) && IN(1)) { LAUNDER(); p0b_mod_reduce(F); } SEAM(1);
    if (PHM(2) && IN(2)) { LAUNDER(); modulate_rows(F, 0, 0, MTOT); } SEAM(2);

#pragma unroll 1
    for (int l = 0; l < DEPTH; ++l) {
        const int pb = NPH_PRO + l * NPH_LAYER;
        const int mrows = (l + 1 < DEPTH) ? MTOT : NLAT;
        if (PHM(3) && IN(pb + 0)) for (int rep_ = 0; rep_ < NREP(3); ++rep_) { LAUNDER(); pg8::Gemm g{(const pg8::bf16_t*)(F.ws + WS_H), (const pg8::bf16_t*)(F.ws + WS_WIN) + (size_t)l * IN_PAD * D, MTOT, IN_PAD, D, D};
            pg8::StaticOrder S; S.init(MTOT, IN_PAD, F.G, bx_); pg8::EpiBf16<0> E{(pg8::bf16_t*)(F.ws + WS_P), IN_PAD, nullptr, 0, 0};
            pg8::gemm_phase<pg8::EpiBf16<0>, pg8::StaticOrder, false>(F.lds, g, S, E, nullptr, F.tid); }
        SEAM(pb + 0);
        if (PHM(4) && IN(pb + 1)) for (int rep_ = 0; rep_ < NREP(4); ++rep_) { LAUNDER(); for (int r2 = 0; r2 < NREP(12); ++r2) for (int u = F.vcu; u < NTILE * NH; u += F.G) lru_prep_unit(F, l, u >> 4, u & 15); asm volatile("" ::: "memory"); for (int r2 = 0; r2 < NREP(13); ++r2) { int cur_hd = -1;
                for (int v = F.vcu; v < 2 * NTILE * NH; v += F.G) { const int hh_ = (v >> 1) & 15, d_ = v & 1;
                    if (hh_ * 2 + d_ != cur_hd) { cur_hd = hh_ * 2 + d_; __syncthreads(); LAS float* MUS = (LAS float*)(F.lds + 125184); const float* mu = gin(F.in[I_MU]) + (size_t)l * 2 * RW_COLS;
                        for (int i = F.tid; i < 5 * 2 * 64; i += NTHR) { const int g = i >> 7, wh = (i >> 6) & 1, col = i & 63; const int rc = g < 3 ? g * RWW + hh_ * 64 : 3 * RWW + (g - 3) * 128 + d_ * 64; MUS[i] = mu[(size_t)wh * RW_COLS + rc + col]; }
                        __syncthreads(); }
                    rwkv_chunk_prep(F, l, v >> 5, hh_, d_); } } }
        SEAM(pb + 1);
        if (PHM(5) && IN(pb + 2)) for (int rep_ = 0; rep_ < NREP(5); ++rep_) { LAUNDER(); for (int u = F.vcu; u < 256; u += F.G) { if (u < 32 && F.wave >= 2 && F.wave < 4) lru_scan(F, u * 128 + F.tid - 128); rwkv_chain_chunks(F, u); } }
        SEAM(pb + 2);
        if (PHM(6) && IN(pb + 3)) for (int rep_ = 0; rep_ < NREP(6); ++rep_) { LAUNDER(); for (int u = F.vcu; u < 4 * NTILE; u += F.G) merge_unit(F, l, u); }
        SEAM(pb + 3);
        if (PHM(7) && IN(pb + 4)) for (int rep_ = 0; rep_ < NREP(7); ++rep_) { LAUNDER(); pg8::Gemm g{(const pg8::bf16_t*)(F.ws + WS_H), (const pg8::bf16_t*)(F.ws + WS_WOUT) + (size_t)l * D * D, mrows, D, D, D};
            pg8::StaticOrder S; S.init(mrows, D, F.G, bx_); pg8::EpiBf16<0> E{(pg8::bf16_t*)(F.ws + WS_O), D, nullptr, 0, 0};
            pg8::gemm_phase<pg8::EpiBf16<0>, pg8::StaticOrder, false>(F.lds, g, S, E, nullptr, F.tid); }
        SEAM(pb + 4);
        if (PHM(8) && IN(pb + 5)) { LAUNDER(); if (NREP(8) > 1) ln1_rows(F, l, mrows, true); ln1_rows(F, l, mrows); }
        SEAM(pb + 5);
        if (PHM(9) && IN(pb + 6)) for (int rep_ = 0; rep_ < NREP(9); ++rep_) { LAUNDER(); pg8::Gemm g{(const pg8::bf16_t*)(F.ws + WS_H), (const pg8::bf16_t*)(F.ws + WS_WQ) + (size_t)l * D * D, mrows, D, D, D};
            pg8::StaticOrder S; S.init(mrows, D, F.G, bx_); pg8::EpiBf16<0> E{(pg8::bf16_t*)(F.ws + WS_QP), D, nullptr, 0, 0};
            pg8::gemm_phase<pg8::EpiBf16<0>, pg8::StaticOrder, false>(F.lds, g, S, E, nullptr, F.tid); }
        SEAM(pb + 6);
        if (PHM(10) && IN(pb + 7)) for (int rep_ = 0; rep_ < NREP(10); ++rep_) { LAUNDER(); for (int u = F.vcu; u < (mrows / 64) * PE_H; u += F.G) peer_topk_unit(F, l, u >> 3, u & 7); }
        SEAM(pb + 7);
        if (PHM(11) && IN(pb + 8)) { LAUNDER(); for (int rep_ = 0; rep_ < NREP(11); ++rep_) { int dry_ = rep_ + 1 < NREP(11); if (NREP(11) > 1) asm volatile("" : "+s"(dry_)); peer_rows(F, l, mrows, dry_ != 0); } }
        if (l + 1 < DEPTH) SEAM(pb + 8);
    }
#undef IN
#undef SEAM
}

extern "C" void kernel_launch(void* const* d_in, const int* in_sizes, int n_in, void* d_out, int out_size, void* d_ws, size_t ws_size, hipStream_t stream) {
    static int grid = 0;
    if (grid == 0) {
        if (n_in != N_IN || out_size != NLAT * D || ws_size < WS_END) { fprintf(stderr, "kernel_launch: unexpected shapes (n_in %d, out %d, ws %zu < %zu)\n", n_in, out_size, ws_size, (size_t)WS_END); grid = -1; return; }
        int dev = 0, cus = 0, per_cu = 0;
        if (hipGetDevice(&dev) != hipSuccess || hipDeviceGetAttribute(&cus, hipDeviceAttributeMultiprocessorCount, dev) != hipSuccess) { grid = -1; return; }
        if (hipFuncSetAttribute((const void*)trunk_fwd, hipFuncAttributeMaxDynamicSharedMemorySize, LDS_BYTES) != hipSuccess) { fprintf(stderr, "kernel_launch: hipFuncSetAttribute failed\n"); grid = -1; return; }
        if (hipOccupancyMaxActiveBlocksPerMultiprocessor(&per_cu, (const void*)trunk_fwd, NTHR, LDS_BYTES) != hipSuccess || per_cu < 1) fprintf(stderr, "kernel_launch: occupancy query reports %d\n", per_cu);
        (void)hipGetLastError();
        grid = cus;
    }
    if (grid < 0) return;
    (void)hipMemsetAsync((char*)d_ws + WS_CTL, 0, CTL_ZERO_BYTES, stream);
    Args a{};
    for (int i = 0; i < N_IN; ++i) a.in[i] = (const float*)d_in[i];
    a.out = (float*)d_out; a.ws = (unsigned char*)d_ws;
#if MK_PER_PHASE
    for (int ph = 0; ph < NPHASES; ++ph) { a.ph_lo = ph; a.ph_hi = ph + 1; hipLaunchKernelGGL(trunk_fwd, dim3(grid), dim3(NTHR), LDS_BYTES, stream, a); }
#else
    a.ph_lo = 0; a.ph_hi = NPHASES;
    hipLaunchKernelGGL(trunk_fwd, dim3(grid), dim3(NTHR), LDS_BYTES, stream, a);
#endif
    const hipError_t le = hipPeekAtLastError();
    if (le != hipSuccess) fprintf(stderr, "kernel_launch: launch failed: %s\n", hipGetErrorName(le));
}
```

```cpp
#include <hip/hip_runtime.h>
#include <cstdio>
#include <cstdint>

constexpr int D = 2048, NB = 2, SEQ = 4096, DEPTH = 4, CTXL = 256;
constexpr int NLAT = NB * SEQ, NCTX = NB * CTXL, MTOT = NLAT + NCTX;
constexpr int LRW = 1024, RWW = 1024, NH = 16, HD = 64;
constexpr int RW_COLS = 3488, IN_COLS = 5536, IN_PAD = 5632;
constexpr int PE_H = 8, PE_K = 128, PE_DQ = 256, PE_TOP = 16, PE_NE = 16384, PE_SEL = PE_H * PE_TOP;
constexpr int NTILE = MTOT / 64;
constexpr float ALPHA = 1.681792830507429f;
constexpr float LN_EPS = 1e-5f, GN_EPS = 64e-5f;
constexpr int KSPLIT = 16;

enum { I_X = 0, I_C, I_CTX, I_CCTX, I_ADAW, I_ADAB, I_WIN, I_CONVW, I_CONVB, I_WA, I_BA, I_WX, I_BX, I_LAM, I_MU, I_W0, I_W2, I_A0, I_A2, I_G2,
       I_KK, I_KA, I_RK, I_GNG, I_GNB, I_WOUT, I_LN1G, I_LN1B, I_WQ, I_SUBK, I_U, I_V, I_LN2G, I_LN2B, N_IN };

constexpr size_t MiB = 1u << 20;
constexpr size_t al(size_t x) { return (x + MiB - 1) / MiB * MiB; }
constexpr size_t WS_CTL = 0, CTL_ZERO_BYTES = 1 * MiB;
constexpr size_t WS_MOD   = WS_CTL + CTL_ZERO_BYTES;
constexpr size_t WS_MODP  = al(WS_MOD + (size_t)DEPTH * 3 * 6 * D * 4);
constexpr size_t WS_WIN   = al(WS_MODP + (size_t)KSPLIT * DEPTH * 3 * 6 * D * 4);
constexpr size_t WS_WOUT  = al(WS_WIN + (size_t)DEPTH * IN_PAD * D * 2);
constexpr size_t WS_WQ    = al(WS_WOUT + (size_t)DEPTH * D * D * 2);
constexpr size_t WS_SUBK  = al(WS_WQ + (size_t)DEPTH * D * D * 2);
constexpr size_t WS_WLRU  = al(WS_SUBK + (size_t)DEPTH * 8 * 2 * 128 * 128 * 2);
constexpr size_t WS_W2T   = al(WS_WLRU + (size_t)DEPTH * 2 * 2 * 16 * 64 * 64 * 2);
constexpr size_t WS_A2T   = al(WS_W2T + (size_t)DEPTH * 2 * 1024 * 64 * 2);
constexpr size_t WS_G2T   = al(WS_A2T + (size_t)DEPTH * 2 * 1024 * 64 * 2);
constexpr size_t WS_UB    = al(WS_G2T + (size_t)DEPTH * 1024 * 160 * 2);
constexpr size_t WS_VB    = al(WS_UB + (size_t)DEPTH * PE_NE * D);
constexpr size_t WS_SU    = al(WS_VB + (size_t)DEPTH * PE_NE * D);
constexpr size_t WS_SV    = al(WS_SU + (size_t)DEPTH * PE_NE * 4);
constexpr size_t WS_X     = al(WS_SV + (size_t)DEPTH * PE_NE * 4);
constexpr size_t WS_H     = al(WS_X + (size_t)MTOT * D * 4);
constexpr size_t WS_P     = al(WS_H + (size_t)MTOT * D * 2);
constexpr size_t WS_LA    = al(WS_P + (size_t)MTOT * IN_PAD * 4);
constexpr size_t WS_LB    = al(WS_LA + (size_t)2 * MTOT * LRW * 4);
constexpr size_t WS_LAGG  = al(WS_LB + (size_t)2 * MTOT * LRW * 4);
constexpr size_t WS_LHIN  = al(WS_LAGG + (size_t)4 * NTILE * LRW * 4);
constexpr int KSL = 8;
constexpr size_t WS_SLAB  = al(WS_LHIN + (size_t)2 * NTILE * LRW * 4);
constexpr size_t WS_YL    = al(WS_SLAB + (size_t)2 * KSL * NCTX * D * 4);
constexpr int NUNIT = NTILE * NH * 2;
constexpr size_t WS_RV    = al(WS_YL + 4096);
constexpr size_t WS_QM    = al(WS_RV + (size_t)MTOT * RWW * 4);
constexpr size_t WS_PHI   = al(WS_QM + (size_t)NUNIT * 4096 * 2);
constexpr size_t WS_Y0F   = al(WS_PHI + (size_t)NUNIT * 4096 * 2);
constexpr size_t WS_PSF   = al(WS_Y0F + (size_t)NUNIT * 4096 * 2);
constexpr size_t WS_YR    = al(WS_PSF + (size_t)NUNIT * 4096 * 2);
constexpr size_t WS_BETA  = al(WS_YR + (size_t)2 * MTOT * RWW * 4);
constexpr size_t WS_IDX   = al(WS_BETA + (size_t)2 * MTOT * NH * 4);
constexpr size_t WS_GATE  = al(WS_IDX + (size_t)MTOT * PE_SEL * 4);
constexpr size_t WS_END   = al(WS_GATE + (size_t)MTOT * PE_SEL * 4);
constexpr size_t WS_O = WS_P;
constexpr size_t WS_QP = WS_P + (size_t)MTOT * D * 4;
static_assert(WS_QP + (size_t)MTOT * D * 4 <= WS_LA, "O/QP overlay inside P");

constexpr int CW_CTX = 16384, CTX_TILES = (NCTX / 256) * (D / 256);
constexpr int CW_BAR = 4096;

constexpr int RING_BYTES = 131072;
constexpr int LDSCTL_OFF = RING_BYTES, MISC_OFF = LDSCTL_OFF + 320;
constexpr int LDS_BYTES = 147456;
constexpr int NWAVES = 8, NTHR = 512;

#define GAS __attribute__((address_space(1)))
#define LAS __attribute__((address_space(3)))
typedef unsigned short bf16;
typedef unsigned v4u __attribute__((ext_vector_type(4)));
typedef unsigned v2u __attribute__((ext_vector_type(2)));
typedef float f32x4 __attribute__((ext_vector_type(4)));
typedef float f32x2 __attribute__((ext_vector_type(2)));
typedef short bf16x8 __attribute__((ext_vector_type(8)));
typedef unsigned v6u __attribute__((ext_vector_type(6)));
typedef unsigned v16u __attribute__((ext_vector_type(16)));
typedef float v32f __attribute__((ext_vector_type(32)));
typedef __bf16 v32bf __attribute__((ext_vector_type(32)));
constexpr int EROW = 1536;
#define RLX_AGENT __ATOMIC_RELAXED, __HIP_MEMORY_SCOPE_AGENT
#define LDS_WAIT() asm volatile("s_waitcnt lgkmcnt(0)" ::: "memory")
#define VM_WAIT() asm volatile("s_waitcnt vmcnt(0)" ::: "memory")

__device__ __forceinline__ const float* gin(const float* p) { return (const float*)(const GAS float*)p; }
__device__ __forceinline__ unsigned f2bf(float f) { unsigned u = __builtin_bit_cast(unsigned, f); return (u + 0x7fffu + ((u >> 16) & 1u)) >> 16; }
typedef __bf16 bf16x2t __attribute__((ext_vector_type(2)));
__device__ __forceinline__ unsigned pk2(float lo, float hi) { return __builtin_bit_cast(unsigned, __builtin_convertvector((f32x2){lo, hi}, bf16x2t)); }
__device__ __forceinline__ float bf_lo(unsigned w) { return __builtin_bit_cast(float, w << 16); }
__device__ __forceinline__ float bf_hi(unsigned w) { return __builtin_bit_cast(float, w & 0xffff0000u); }
__device__ __forceinline__ float fexp(float x) { return __builtin_amdgcn_exp2f(x * 1.4426950408889634f); }
__device__ __forceinline__ float fsigmoid(float x) { return __builtin_amdgcn_rcpf(1.0f + fexp(-x)); }
__device__ __forceinline__ float fsoftplus(float x) { return fmaxf(x, 0.f) + 0.6931471805599453f * __builtin_amdgcn_logf(1.0f + fexp(-fabsf(x))); }
__device__ __forceinline__ float ftanh(float x) { const float e = fexp(2.0f * x); return 1.0f - 2.0f * __builtin_amdgcn_rcpf(e + 1.0f); }
__device__ __forceinline__ float gelu_tanh(float x) { return 0.5f * x * (1.0f + ftanh(0.7978845608028654f * (x + 0.044715f * x * x * x))); }
__device__ __forceinline__ float gelu_erf(float v) {
    const float av = fabsf(v), t = __builtin_amdgcn_rcpf(av * 0.2316418882f + 1.0f);
    float q = t * 0.5307027145f + (-0.7265760135f); q = q * t + 0.7107068705f; q = q * t + (-0.142248368f); q = q * t + 0.127414796f; q = q * t;
    const float e = __builtin_amdgcn_exp2f((v * v) * (-0.72134752044f));
    const float m = v * (q * e);
    return v < 0.f ? m : v - m;
}
template <int CTRL> __device__ __forceinline__ float dpp_f(float v) { return __builtin_bit_cast(float, __builtin_amdgcn_update_dpp(0, __builtin_bit_cast(int, v), CTRL, 0xf, 0xf, true)); }
__device__ __forceinline__ float red8(float v) { v += dpp_f<0xB1>(v); v += dpp_f<0x4E>(v); v += dpp_f<0x141>(v); return v; }
__device__ __forceinline__ float red16(float v) { v = red8(v); v += dpp_f<0x140>(v); return v; }
__device__ __forceinline__ float wave_total(float v) {
    v = red16(v);
    v += __builtin_bit_cast(float, __builtin_amdgcn_update_dpp(0, __builtin_bit_cast(int, v), 0x142, 0xa, 0xf, false));
    v += __builtin_bit_cast(float, __builtin_amdgcn_update_dpp(0, __builtin_bit_cast(int, v), 0x143, 0xc, 0xf, false));
    return __builtin_bit_cast(float, __builtin_amdgcn_readlane(__builtin_bit_cast(int, v), 63));
}
__device__ __forceinline__ float wave_sum(float v) { return wave_total(v); }
__device__ __forceinline__ float wave_max(float v) {
    v = fmaxf(v, dpp_f<0xB1>(v)); v = fmaxf(v, dpp_f<0x4E>(v)); v = fmaxf(v, dpp_f<0x141>(v)); v = fmaxf(v, dpp_f<0x140>(v));
    const float a = __builtin_bit_cast(float, __builtin_amdgcn_readlane(__builtin_bit_cast(int, v), 0)), b = __builtin_bit_cast(float, __builtin_amdgcn_readlane(__builtin_bit_cast(int, v), 16));
    const float c = __builtin_bit_cast(float, __builtin_amdgcn_readlane(__builtin_bit_cast(int, v), 32)), d = __builtin_bit_cast(float, __builtin_amdgcn_readlane(__builtin_bit_cast(int, v), 48));
    return fmaxf(fmaxf(a, b), fmaxf(c, d));
}
#define EBU_ 4
#define XB_TMO      128
#define XB_XCNT(j)  (256  + 64 * (j))
#define XB_XSUB(j)  (1280 + 64 * (j))
#define XB_XGEN(j)  (2304 + 64 * (j))
#define XB_TOP      3328
#define XB_TOPGEN   3392
#define XCD_BAR_WORDS 3456
#define XB_SPIN_CAP (1u << 18)

__device__ __forceinline__ unsigned xb_ld(unsigned* p)              { return __hip_atomic_load(p, __ATOMIC_RELAXED, __HIP_MEMORY_SCOPE_AGENT); }
__device__ __forceinline__ unsigned xb_add(unsigned* p, unsigned v) { return __hip_atomic_fetch_add(p, v, __ATOMIC_RELAXED, __HIP_MEMORY_SCOPE_AGENT); }
__device__ __forceinline__ unsigned xb_xcc_id() { return (unsigned)__builtin_amdgcn_s_getreg((3 << 11) | 20) & 0xFu; }
#define XB_SPIN(cond, bar) do { unsigned _sp = 0; while (cond) { __builtin_amdgcn_s_sleep(1); \
    if ((++_sp & 255u) == 0u) { if (xb_ld(&(bar)[XB_TMO])) break; if (_sp > XB_SPIN_CAP) { atomicAdd(&(bar)[XB_TMO], 1u); break; } } } } while (0)

struct XcdBarrier {
    unsigned* bar; unsigned x;
    volatile LAS unsigned* st;
};

__device__ __forceinline__ XcdBarrier xcd_barrier_post(unsigned* bar, volatile LAS unsigned* st) {
    XcdBarrier b; b.bar = bar; b.x = xb_xcc_id(); b.st = st;
    if (threadIdx.x == 0) (void)xb_add(&bar[XB_XCNT(b.x)], 1u);
    return b;
}
__device__ __forceinline__ void xcd_barrier_complete(unsigned* bar, unsigned x, unsigned& nloc, unsigned& nx) {
    const unsigned G = gridDim.x * gridDim.y * gridDim.z;
    unsigned sum, cnt, mine, sp = 0u;
    for (;;) {
        sum = 0u; cnt = 0u; mine = 0u;
#pragma unroll
        for (unsigned j = 0; j < 16; ++j) { const unsigned c = xb_ld(&bar[XB_XCNT(j)]); sum += c; cnt += (c > 0u) ? 1u : 0u; }
        if (sum == G) { mine = xb_ld(&bar[XB_XCNT(x)]); break; }
        __builtin_amdgcn_s_sleep(1);
        if ((++sp & 255u) == 0u) { if (xb_ld(&bar[XB_TMO])) break; if (sp > XB_SPIN_CAP) { atomicAdd(&bar[XB_TMO], 1u); break; } }
    }
    nloc = mine > 0u ? mine : 1u; nx = cnt > 0u ? cnt : 1u;
}

__device__ __forceinline__ void xcd_barrier(const XcdBarrier& b) {
    asm volatile("s_waitcnt vmcnt(0)" ::: "memory");
    __syncthreads();
    if (threadIdx.x == 0) {
        unsigned* bar = b.bar;
        __builtin_amdgcn_s_waitcnt(0);
        unsigned nloc = b.st[0], nx = b.st[1];
        if (nloc == 0u) { xcd_barrier_complete(bar, b.x, nloc, nx); b.st[0] = nloc; b.st[1] = nx; }
        const unsigned old = xb_add(&bar[XB_XSUB(b.x)], 1u);
        const unsigned gen = old / nloc;
        if (old + 1u == (gen + 1u) * nloc) {
            __builtin_amdgcn_fence(__ATOMIC_RELEASE, "agent");
            asm volatile("s_waitcnt vmcnt(0)" ::: "memory");
            const unsigned og = xb_add(&bar[XB_TOP], 1u);
            const unsigned tg = og / nx;
            if (og + 1u == (tg + 1u) * nx) xb_add(&bar[XB_TOPGEN], 1u);
            else XB_SPIN(xb_ld(&bar[XB_TOPGEN]) == tg, bar);
            __builtin_amdgcn_fence(__ATOMIC_ACQUIRE, "agent");
            xb_add(&bar[XB_XGEN(b.x)], 1u);
            asm volatile("s_waitcnt vmcnt(0)" ::: "memory");
        } else {
            XB_SPIN(xb_ld(&bar[XB_XGEN(b.x)]) == gen, bar);
            __builtin_amdgcn_fence(__ATOMIC_ACQUIRE, "agent");
            asm volatile("s_waitcnt vmcnt(0)" ::: "memory");
        }
    }
    __syncthreads();
}
namespace pg8 {
#define PG8_LAS __attribute__((address_space(3)))
typedef unsigned short bf16_t;
typedef short bf16x8 __attribute__((ext_vector_type(8)));
typedef float f32x4 __attribute__((ext_vector_type(4)));
typedef unsigned u32x4 __attribute__((ext_vector_type(4)));
constexpr int BM = 256, BK = 64, HALF = 128, HTB = HALF * BK * 2  , STAGE_BYTES = 8 * HTB, NXCD = 8, WGM = 8;

__host__ __device__ __forceinline__ int lds_byte(int r, int c) { const int st = (r >> 4) * 2 + (c >> 5), rr = r & 15, cc = c & 31, ob = rr * 64 + cc * 2; return st * 1024 + (ob ^ (((ob >> 9) & 1) << 5)); }
__host__ __device__ __forceinline__ void stage_rc(int b, int& R, int& C) { const int st = b / 1024, sb = b % 1024, swz = sb ^ (((sb >> 9) & 1) << 5); R = (st >> 1) * 16 + swz / 64; C = (st & 1) * 32 + (swz % 64) / 2; }
__host__ __device__ __forceinline__ int perm32(int rho) { const int n = rho >> 4, i = rho & 15; return 8 * (i >> 2) + 4 * n + (i & 3); }

struct Unit { int pm, pn, kofs = 0, slab = 0; };
struct Gemm { const bf16_t* A; const bf16_t* Bt; int M, N, K, ld; };

struct StaticOrder {
    int nM, nN, nwg, G, c;
    __host__ __device__ void init(int M, int N, int G_, int c_) { nM = M / BM; nN = N / BM; nwg = nM * nN; G = G_; c = c_; }
    __host__ __device__ bool next(int i, Unit& u) const {
        const long L = (long)i * G + c; if (L >= nwg) return false;
        int wgid = (int)L; { const int q = nwg / NXCD, r = nwg % NXCD, xcd = wgid % NXCD, off = wgid / NXCD; wgid = (xcd < r ? xcd * (q + 1) : r * (q + 1) + (xcd - r) * q) + off; }
        const int nig = WGM * nN, gid = wgid / nig, fm = gid * WGM, gsz = (nM - fm) < WGM ? (nM - fm) : WGM;
        u.pm = fm + ((wgid % nig) % gsz); u.pn = (wgid % nig) / gsz; return true;
    }
    __device__ __forceinline__ void a_ready(const Unit&) const {}
    __device__ __forceinline__ void done(const Unit&) const {}
};
struct SplitKOrder {
    int nM, nN, nS, klen, G, c;
    __host__ __device__ void init(int M, int N, int nS_, int klen_, int G_, int c_) { nM = M / BM; nN = N / BM; nS = nS_; klen = klen_; G = G_; c = c_; }
    __host__ __device__ bool next(int i, Unit& u) const { const long L = (long)i * G + c; if (L >= (long)nM * nN * nS) return false; const int l = (int)L; u.pm = l % nM; u.pn = (l / nM) % nN; const int ks = l / (nM * nN); u.kofs = ks * klen; u.slab = ks; return true; }
    __device__ __forceinline__ void a_ready(const Unit&) const {}
    __device__ __forceinline__ void done(const Unit&) const {}
};
struct CtxOrder {
    int pm0, nN, nT, c; unsigned* cnt; bool lead;
    __device__ bool next(int i, Unit& u) const { if (i != 0 || c >= nT) return false; u.pm = pm0 + c / nN; u.pn = c % nN; return true; }
    __device__ __forceinline__ void a_ready(const Unit&) const {}
    __device__ __forceinline__ void done(const Unit&) const { __builtin_amdgcn_fence(__ATOMIC_RELEASE, "agent"); if (lead) __hip_atomic_fetch_add(cnt, 1u, __ATOMIC_RELAXED, __HIP_MEMORY_SCOPE_AGENT); }
};
struct CountedOrder : StaticOrder {
    const unsigned* ready; unsigned need; unsigned* tmo;
    __device__ __forceinline__ void a_ready(const Unit& u) const {
        if (threadIdx.x < 64) {
            const unsigned long long t0 = __builtin_amdgcn_s_memrealtime(); unsigned polls = 0;
            while ((unsigned)__builtin_amdgcn_readfirstlane(__hip_atomic_load(ready + 64 * u.pm, __ATOMIC_RELAXED, __HIP_MEMORY_SCOPE_AGENT)) < need) {
                if ((++polls & 255u) == 0u && __builtin_amdgcn_readfirstlane(__hip_atomic_load(tmo, __ATOMIC_RELAXED, __HIP_MEMORY_SCOPE_AGENT)) != 0u) break;
                if (__builtin_amdgcn_s_memrealtime() - t0 > 2000000ull) {
                    if (threadIdx.x == 0) { unsigned expect = 0u; __hip_atomic_compare_exchange_strong(tmo + 1, &expect, 0x600u | (unsigned)(u.pm & 0xff), __ATOMIC_RELAXED, __ATOMIC_RELAXED, __HIP_MEMORY_SCOPE_AGENT); __hip_atomic_store(tmo, 1u, __ATOMIC_RELAXED, __HIP_MEMORY_SCOPE_AGENT); }
                    break; }
                __builtin_amdgcn_s_sleep(2); }
            __builtin_amdgcn_fence(__ATOMIC_ACQUIRE, "agent");
            asm volatile("s_waitcnt vmcnt(0)" ::: "memory");
        }
#if !defined(BROKEN_HOOK_NO_BARRIER)
        asm volatile("" ::: "memory"); __builtin_amdgcn_s_barrier(); asm volatile("" ::: "memory");
#endif
    }
};

__device__ __forceinline__ unsigned cvt_pk_bf16(float lo, float hi) { unsigned r; asm volatile("v_cvt_pk_bf16_f32 %0, %1, %2" : "=v"(r) : "v"(lo), "v"(hi)); return r; }
typedef float f32x2 __attribute__((ext_vector_type(2)));
__device__ __forceinline__ f32x2 gelu_pk(f32x2 v) {
    const f32x2 av = __builtin_elementwise_abs(v), d = av * 0.2316418882f + 1.0f;
    f32x2 t; t.x = __builtin_amdgcn_rcpf(d.x); t.y = __builtin_amdgcn_rcpf(d.y);
    f32x2 q = t * 0.5307027145f + (-0.7265760135f); q = q * t + 0.7107068705f; q = q * t + (-0.142248368f); q = q * t + 0.127414796f; q = q * t;
    const f32x2 s = (v * v) * (-0.72134752044f);
    f32x2 e; e.x = __builtin_amdgcn_exp2f(s.x); e.y = __builtin_amdgcn_exp2f(s.y);
    const f32x2 m = v * (q * e), r = v - m;
    f32x2 o; o.x = v.x < 0.f ? m.x : r.x; o.y = v.y < 0.f ? m.y : r.y; return o;
}

struct EpiF32 {
    static constexpr bool PERM = false, AFTER_DRAIN = false;
    float* C; int ldc; const float* bias; size_t slab_stride = 0;
    __device__ __forceinline__ void operator()(const f32x4 (&acc)[2][2][4][2], const Unit& u, int wr, int wc, int fr, int fq) const {
        const int row0 = u.pm * BM + wr * 64 + fr, col0 = u.pn * BM + wc * 32 + 4 * fq; float* const Cb = C + (size_t)u.slab * slab_stride;
        f32x4 bv[2][2];
#pragma unroll
        for (int bj = 0; bj < 2; ++bj)
#pragma unroll
            for (int n = 0; n < 2; ++n) bv[bj][n] = bias ? *(const f32x4*)(bias + col0 + bj * HALF + n * 16) : (f32x4){0.f, 0.f, 0.f, 0.f};
#pragma unroll
        for (int ai = 0; ai < 2; ++ai)
#pragma unroll
            for (int m = 0; m < 4; ++m) { float* rowp = Cb + (size_t)(row0 + ai * HALF + m * 16) * ldc + col0;
#pragma unroll
                for (int bj = 0; bj < 2; ++bj)
#pragma unroll
                    for (int n = 0; n < 2; ++n) *(f32x4*)(rowp + bj * HALF + n * 16) = acc[ai][bj][m][n] + bv[bj][n]; }
    }
};
template <int ACT  > struct EpiBf16 {
    static constexpr bool PERM = true, AFTER_DRAIN = false;
    bf16_t* O; int ldc; const float* bias; int split_cols; size_t split_stride;
    __device__ __forceinline__ void operator()(const f32x4 (&acc)[2][2][4][2], const Unit& u, int wr, int wc, int fr, int fq) const {
        const int row0 = u.pm * BM + wr * 64 + fr; int colt = u.pn * BM; bf16_t* base = O;
        if (split_cols) { const int t = colt / split_cols; base += (size_t)t * split_stride; colt -= t * split_cols; }
        const int col0 = colt + wc * 32 + 8 * fq, bcol0 = u.pn * BM + wc * 32 + 8 * fq;
        f32x4 bv[2][2];
#pragma unroll
        for (int bj = 0; bj < 2; ++bj)
#pragma unroll
            for (int n = 0; n < 2; ++n) bv[bj][n] = bias ? *(const f32x4*)(bias + bcol0 + bj * HALF + 4 * n) : (f32x4){0.f, 0.f, 0.f, 0.f};
#pragma unroll
        for (int ai = 0; ai < 2; ++ai)
#pragma unroll
            for (int m = 0; m < 4; ++m) { bf16_t* rowp = base + (size_t)(row0 + ai * HALF + m * 16) * ldc + col0;
#pragma unroll
                for (int bj = 0; bj < 2; ++bj) { f32x4 v0 = acc[ai][bj][m][0] + bv[bj][0], v1 = acc[ai][bj][m][1] + bv[bj][1];
                    if (ACT == 1) { f32x2 a = gelu_pk((f32x2){v0[0], v0[1]}), b = gelu_pk((f32x2){v0[2], v0[3]}), c = gelu_pk((f32x2){v1[0], v1[1]}), d = gelu_pk((f32x2){v1[2], v1[3]});
                        v0 = (f32x4){a.x, a.y, b.x, b.y}; v1 = (f32x4){c.x, c.y, d.x, d.y}; }
                    if (ACT == 2) {
#pragma unroll
                        for (int j = 0; j < 4; ++j) { v0[j] = 0.5f * v0[j] * (1.0f + erff(v0[j] * 0.70710678f)); v1[j] = 0.5f * v1[j] * (1.0f + erff(v1[j] * 0.70710678f)); } }
                    u32x4 w; w.x = cvt_pk_bf16(v0[0], v0[1]); w.y = cvt_pk_bf16(v0[2], v0[3]); w.z = cvt_pk_bf16(v1[0], v1[1]); w.w = cvt_pk_bf16(v1[2], v1[3]);
                    *(u32x4*)(rowp + bj * HALF) = w; } }
    }
};
template <class Epi, class Sched, bool STAMP = false>
__device__ __forceinline__ void gemm_phase(PG8_LAS unsigned char* lds, const Gemm g, const Sched& S, const Epi& E, unsigned long long* stamps, const int tid) {
    const int  wid = __builtin_amdgcn_readfirstlane(tid >> 6), lane = tid & 63, wr = wid >> 2, wc = wid & 3, fr = lane & 15, fq = lane >> 4;
    const int K = g.ld, nt = g.K / BK;
    int ts_lo = 0, ts_hi = 0, nts = 0; const unsigned long long rt_entry = STAMP ? (unsigned long long)wall_clock64() : 0ull;
#define PG8_STAMP() do { if (STAMP && wid == 0 && nts < 64) { const unsigned long long _c = (unsigned long long)clock64(); \
        ts_lo = (lane == nts) ? (int)(unsigned)_c : ts_lo; ts_hi = (lane == nts) ? (int)(unsigned)(_c >> 32) : ts_hi; ++nts; } } while (0)
    PG8_STAMP();
    unsigned voffA[2], voffB[2];
#pragma unroll
    for (int i = 0; i < 2; ++i) { int R, C; stage_rc(tid * 16 + i * 8192, R, C); const int Rb = Epi::PERM ? ((R & ~31) + perm32(R & 31)) : R;
        voffA[i] = (unsigned)(R * K + C) * 2u; voffB[i] = (unsigned)(Rb * K + C) * 2u; }
    const size_t kstep = (size_t)(BK * 2);
    const size_t hstep = (size_t)HALF * K * 2;
    const size_t tstep = 2 * hstep;
    const unsigned ldsw = (unsigned)wid * 1024u;
    const int aoff = lds_byte(wr * 64 + fr, fq * 8), boff = lds_byte(wc * 32 + fr, fq * 8);
#define PG8_SA(b, h) (((b) * 2 + (h)) * HTB)
#define PG8_SB(b, h) ((4 + (b) * 2 + (h)) * HTB)
#define PG8_STAGE(bufoff, gbase, voff) do { _Pragma("unroll") for (int _i = 0; _i < 2; ++_i) \
        __builtin_amdgcn_global_load_lds((const unsigned*)((const char*)(gbase) + (voff)[_i]), (PG8_LAS unsigned*)(lds + (bufoff) + ldsw + _i * 8192), 16, 0, 0); } while (0)
#define PG8_LDA(dst, b, h) do { _Pragma("unroll") for (int m = 0; m < 4; ++m) _Pragma("unroll") for (int k = 0; k < 2; ++k) dst[m][k] = *(const PG8_LAS bf16x8*)(lds + PG8_SA(b, h) + aoff + m * 2048 + k * 1024); } while (0)
#define PG8_LDB(dst, b, h) do { _Pragma("unroll") for (int n = 0; n < 2; ++n) _Pragma("unroll") for (int k = 0; k < 2; ++k) dst[n][k] = *(const PG8_LAS bf16x8*)(lds + PG8_SB(b, h) + boff + n * 2048 + k * 1024); } while (0)
#define PG8_MMA(ai, bj, At, Bt) do { __builtin_amdgcn_s_setprio(1); _Pragma("unroll") for (int m = 0; m < 4; ++m) _Pragma("unroll") for (int n = 0; n < 2; ++n) _Pragma("unroll") for (int k = 0; k < 2; ++k) \
        acc[ai][bj][m][n] = __builtin_amdgcn_mfma_f32_16x16x32_bf16(Bt[n][k], At[m][k], acc[ai][bj][m][n], 0, 0, 0); __builtin_amdgcn_s_setprio(0); } while (0)
#define PG8_WAIT_V(n) asm volatile("s_waitcnt vmcnt(" #n ")" ::: "memory")
#define PG8_WAIT_L(n) asm volatile("s_waitcnt lgkmcnt(" #n ")" ::: "memory")
#define PG8_BAR __builtin_amdgcn_s_barrier()
#define PG8_SCHED __builtin_amdgcn_sched_barrier(0)
    Unit cur, nxt; int ui = 0;
    if (!S.next(0, cur)) return;
    f32x4 acc[2][2][4][2];
#pragma unroll
    for (int a = 0; a < 2; ++a)
#pragma unroll
        for (int b = 0; b < 2; ++b)
#pragma unroll
            for (int m = 0; m < 4; ++m)
#pragma unroll
                for (int n = 0; n < 2; ++n) acc[a][b][m][n] = (f32x4){0.f, 0.f, 0.f, 0.f};
    bf16x8 At[4][2], B0[2][2], B1[2][2];
    const char* cA = (const char*)g.A + (size_t)cur.pm * tstep + (size_t)cur.kofs * 2; const char* cB = (const char*)g.Bt + (size_t)cur.pn * tstep + (size_t)cur.kofs * 2;
    S.a_ready(cur);
    PG8_STAGE(PG8_SB(0, 0), cB, voffB); PG8_STAGE(PG8_SA(0, 0), cA, voffA); PG8_STAGE(PG8_SB(0, 1), cB + hstep, voffB); PG8_STAGE(PG8_SA(0, 1), cA + hstep, voffA);
    if (wr == 1) PG8_BAR;
    PG8_WAIT_V(4); PG8_BAR;
    PG8_STAGE(PG8_SB(1, 0), cB + kstep, voffB); PG8_STAGE(PG8_SA(1, 0), cA + kstep, voffA); PG8_STAGE(PG8_SB(1, 1), cB + hstep + kstep, voffB);
    PG8_WAIT_V(6); PG8_BAR;
    PG8_STAMP();
    for (;;) {
        const bool has_next = S.next(ui + 1, nxt);
        const char* nA = has_next ? (const char*)g.A + (size_t)nxt.pm * tstep + (size_t)nxt.kofs * 2 : cA; const char* nB = has_next ? (const char*)g.Bt + (size_t)nxt.pn * tstep + (size_t)nxt.kofs * 2 : cB;
        for (int t = 0; t < nt; t += 2) {
            const bool last = (t == nt - 2);
            const char* a1 = cA + (size_t)(t + 1) * kstep;
            const char* a2 = last ? nA : cA + (size_t)(t + 2) * kstep; const char* b2 = last ? nB : cB + (size_t)(t + 2) * kstep;
            const char* a3 = a2 + kstep; const char* b3 = b2 + kstep;
            if (last && has_next) S.a_ready(nxt);
            PG8_LDB(B0, 0, 0); PG8_SCHED; PG8_LDA(At, 0, 0); PG8_STAGE(PG8_SA(1, 1), a1 + hstep, voffA);
            PG8_WAIT_L(8); PG8_BAR; PG8_WAIT_L(0); PG8_MMA(0, 0, At, B0); PG8_BAR; PG8_SCHED;
            PG8_LDB(B1, 0, 1); PG8_STAGE(PG8_SB(0, 0), b2, voffB);
            PG8_BAR; PG8_WAIT_L(0); PG8_MMA(0, 1, At, B1); PG8_BAR;
            PG8_LDA(At, 0, 1); PG8_STAGE(PG8_SA(0, 0), a2, voffA);
            PG8_BAR; PG8_WAIT_L(0); PG8_MMA(1, 0, At, B0); PG8_BAR; PG8_SCHED;
            PG8_STAGE(PG8_SB(0, 1), b2 + hstep, voffB);
            PG8_WAIT_V(6); PG8_BAR; PG8_MMA(1, 1, At, B1); PG8_BAR;
            PG8_LDB(B0, 1, 0); PG8_SCHED; PG8_LDA(At, 1, 0); PG8_STAGE(PG8_SA(0, 1), a2 + hstep, voffA);
            PG8_WAIT_L(8); PG8_BAR; PG8_WAIT_L(0); PG8_MMA(0, 0, At, B0); PG8_BAR; PG8_SCHED;
            PG8_LDB(B1, 1, 1); PG8_STAGE(PG8_SB(1, 0), b3, voffB);
            PG8_BAR; PG8_WAIT_L(0); PG8_MMA(0, 1, At, B1); PG8_BAR;
            PG8_LDA(At, 1, 1); PG8_STAGE(PG8_SA(1, 0), a3, voffA);
            PG8_BAR; PG8_WAIT_L(0); PG8_MMA(1, 0, At, B0); PG8_BAR; PG8_SCHED;
            PG8_STAGE(PG8_SB(1, 1), b3 + hstep, voffB);
            PG8_WAIT_V(6); PG8_BAR; PG8_MMA(1, 1, At, B1); PG8_BAR;
        }
        PG8_STAMP();
        if constexpr (!Epi::AFTER_DRAIN) { E(acc, cur, wr, wc, fr, fq); S.done(cur); }
        PG8_STAMP();
        if (!has_next) break;
#pragma unroll
        for (int a = 0; a < 2; ++a)
#pragma unroll
            for (int b = 0; b < 2; ++b)
#pragma unroll
                for (int m = 0; m < 4; ++m)
#pragma unroll
                    for (int n = 0; n < 2; ++n) acc[a][b][m][n] = (f32x4){0.f, 0.f, 0.f, 0.f};
        cur = nxt; cA = nA; cB = nB; ++ui;
    }
    PG8_WAIT_V(0);
    if (wr == 0) PG8_BAR;
    PG8_BAR;
    if constexpr (Epi::AFTER_DRAIN) { E.fused(acc, cur, wr, wc, fr, fq, lds, wid, lane); S.done(cur); }
    PG8_STAMP();
    if (STAMP && wid == 0) { stamps[lane] = lane < nts ? (((unsigned long long)(unsigned)ts_hi << 32) | (unsigned)ts_lo) : 0ull;
        if (lane == 62) stamps[62] = rt_entry; if (lane == 63) stamps[63] = (unsigned long long)wall_clock64(); }
#undef PG8_STAMP
#undef PG8_SA
#undef PG8_SB
#undef PG8_STAGE
#undef PG8_LDA
#undef PG8_LDB
#undef PG8_MMA
#undef PG8_WAIT_V
#undef PG8_WAIT_L
#undef PG8_BAR
#undef PG8_SCHED
}
}
struct Args { const float* in[N_IN]; float* out; unsigned char* ws; int ph_lo, ph_hi; };
struct Frame {
    LAS unsigned char* lds;
    int tid, lane, wave, vcu, G;
    const float* const* in; GAS float* out; GAS unsigned char* ws;
};
using bf16x2v = __attribute__((ext_vector_type(2))) __bf16;
__device__ __forceinline__ float dot2bf(unsigned a, unsigned b, float acc) { return __builtin_amdgcn_fdot2_f32_bf16(__builtin_bit_cast(bf16x2v, a), __builtin_bit_cast(bf16x2v, b), acc, false); }

__device__ __forceinline__ void ld8bf(const bf16* p, float (&o)[8]) { const v4u w = *(const v4u*)p; o[0] = bf_lo(w.x); o[1] = bf_hi(w.x); o[2] = bf_lo(w.y); o[3] = bf_hi(w.y); o[4] = bf_lo(w.z); o[5] = bf_hi(w.z); o[6] = bf_lo(w.w); o[7] = bf_hi(w.w); }
struct TileInfo { int seq_base, seq_len, t0; };
__device__ __forceinline__ TileInfo tile_info(int c) {
    TileInfo ti;
    if (c < 128) { ti.seq_base = (c >> 6) * SEQ; ti.seq_len = SEQ; ti.t0 = (c & 63) * 64; }
    else { const int cc = c - 128; ti.seq_base = NLAT + (cc >> 2) * CTXL; ti.seq_len = CTXL; ti.t0 = (cc & 3) * 64; }
    return ti;
}
__device__ __forceinline__ int mod_row(int row) { return row < NLAT ? (row >> 12) : 2; }
__device__ __forceinline__ bf16x8 frag_lds(const LAS bf16* base, int ld, int row0, int k0, int lane) { return *(const LAS bf16x8*)(base + (row0 + (lane & 15)) * ld + k0 + 8 * (lane >> 4)); }
__device__ __forceinline__ bf16x8 frag_g(const bf16* base, int ld, int row0, int k0, int lane) { return *(const bf16x8*)(base + (size_t)(row0 + (lane & 15)) * ld + k0 + 8 * (lane >> 4)); }
#define MFMA16(a, b, c) __builtin_amdgcn_mfma_f32_16x16x32_bf16((a), (b), (c), 0, 0, 0)

__device__ __forceinline__ void p0_transpose_item(const float* W, int K, int N, bf16* WT, LAS float* scr, int item, int lane) {
    const int nblk = N / 32, kb = item / nblk, nb = item % nblk, k0 = 64 * kb, n0 = 32 * nb;
#pragma unroll 8
    for (int i = 0; i < 32; ++i) { const int kk = 2 * i + (lane >> 5); scr[kk * 33 + (lane & 31)] = W[(size_t)(k0 + kk) * N + n0 + (lane & 31)]; }
    LDS_WAIT(); asm volatile("" ::: "memory");
    const int c = lane & 7;
#pragma unroll
    for (int j = 0; j < 4; ++j) { const int n = (lane >> 3) + 8 * j; const LAS float* s = scr + (8 * c) * 33 + n;
        v4u o; o.x = pk2(s[0 * 33], s[1 * 33]); o.y = pk2(s[2 * 33], s[3 * 33]); o.z = pk2(s[4 * 33], s[5 * 33]); o.w = pk2(s[6 * 33], s[7 * 33]);
        *(v4u*)(WT + (size_t)(n0 + n) * K + k0 + 8 * c) = o; }
    LDS_WAIT(); asm volatile("" ::: "memory");
}
__device__ __forceinline__ void conv_f32_bf16(const float* src, bf16* dst, size_t n8, size_t i0, size_t stride) {
    for (size_t i = i0; i < n8; i += stride) { const f32x4 a = *(const f32x4*)(src + i * 8), b = *(const f32x4*)(src + i * 8 + 4);
        v4u o; o.x = pk2(a.x, a.y); o.y = pk2(a.z, a.w); o.z = pk2(b.x, b.y); o.w = pk2(b.z, b.w); *(v4u*)(dst + i * 8) = o; }
}
__device__ __forceinline__ void convert_layer(Frame& F, int l, int w, int NW, LAS float* scr) {
    constexpr int IT_IN = (D / 64) * (IN_COLS / 32), IT_SQ = (D / 64) * (D / 32);
    for (int it = w; it < IT_IN + 2 * IT_SQ; it += NW) {
        int r = it;
        if (r < IT_IN) { p0_transpose_item(gin(F.in[I_WIN]) + (size_t)l * D * IN_COLS, D, IN_COLS, (bf16*)(F.ws + WS_WIN) + (size_t)l * IN_PAD * D, scr, r, F.lane); continue; }
        r -= IT_IN;
        if (r < IT_SQ) { p0_transpose_item(gin(F.in[I_WOUT]) + (size_t)l * D * D, D, D, (bf16*)(F.ws + WS_WOUT) + (size_t)l * D * D, scr, r, F.lane); continue; }
        r -= IT_SQ;
        p0_transpose_item(gin(F.in[I_WQ]) + (size_t)l * D * D, D, D, (bf16*)(F.ws + WS_WQ) + (size_t)l * D * D, scr, r, F.lane);
    }
    { constexpr int PADV = (IN_PAD - IN_COLS) * D / 8;
      for (int i = w * 64 + F.lane; i < PADV; i += NW * 64) *(v4u*)((bf16*)(F.ws + WS_WIN) + ((size_t)l * IN_PAD + IN_COLS) * D + (size_t)i * 8) = (v4u){0u, 0u, 0u, 0u}; }
    for (int it = w; it < 2 * PE_NE; it += NW) {
        const int tab = it >= PE_NE, r = l * PE_NE + (tab ? it - PE_NE : it); const float* src = gin(F.in[tab ? I_V : I_U]) + (size_t)r * D + F.lane * 32;
        f32x4 x[8]; float mx = 0.f;
#pragma unroll
        for (int i = 0; i < 8; ++i) { x[i] = *(const f32x4*)(src + i * 4); mx = fmaxf(mx, fmaxf(fmaxf(fabsf(x[i].x), fabsf(x[i].y)), fmaxf(fabsf(x[i].z), fabsf(x[i].w)))); }
        mx = wave_max(mx); const float sc = mx > 0.f ? mx * (1.0f / 7.5f) : 1.0f, inv = 1.0f / sc;
        v16u pk;
#pragma unroll
        for (int i = 0; i < 8; ++i) { pk[2 * i] = pk2(x[i].x * inv, x[i].y * inv); pk[2 * i + 1] = pk2(x[i].z * inv, x[i].w * inv); }
        const v6u q = __builtin_amdgcn_cvt_scalef32_pk32_fp6_bf16(__builtin_bit_cast(v32bf, pk), 1.0f);
        unsigned char* dst = (unsigned char*)(F.ws + (tab ? WS_VB : WS_UB)) + (size_t)r * EROW;
        *(v4u*)(dst + F.lane * 16) = (v4u){q[0], q[1], q[2], q[3]}; *(v2u*)(dst + 1024 + F.lane * 8) = (v2u){q[4], q[5]};
        if (F.lane == 0) ((float*)(F.ws + (tab ? WS_SV : WS_SU)))[r] = sc;
    }
}
__device__ __forceinline__ void p0_prologue(Frame& F) {
    LAS float* scr = (LAS float*)(F.lds + F.wave * 16384);
    const int gw = F.vcu * NWAVES + F.wave, NGW = F.G * NWAVES;
    const size_t gt = (size_t)F.vcu * NTHR + F.tid, NGT = (size_t)F.G * NTHR;
    for (int l = 0; l < DEPTH; ++l) convert_layer(F, l, gw, NGW, scr);
    { bf16* dst = (bf16*)(F.ws + WS_WLRU);
      for (size_t idx = gt; idx < (size_t)DEPTH * 2 * 2 * 16 * 64 * 64; idx += NGT) { const int i = (int)(idx & 63), j = (int)((idx >> 6) & 63), m = (int)(idx >> 12);
          const int hh = m & 15, d = (m >> 4) & 1, gate = (m >> 5) & 1, l = m >> 6; const float* src = gin(F.in[gate ? I_WX : I_WA]);
          dst[idx] = (bf16)f2bf(src[((size_t)((l * 2 + d) * 16 + hh) * 64 + i) * 64 + j]); } }
    { bf16* d2 = (bf16*)(F.ws + WS_W2T); bf16* da = (bf16*)(F.ws + WS_A2T);
      for (size_t idx = gt; idx < (size_t)DEPTH * 2 * 1024 * 64; idx += NGT) { const int k = (int)(idx & 63), c = (int)((idx >> 6) & 1023), ld = (int)(idx >> 16);
          d2[idx] = (bf16)f2bf(gin(F.in[I_W2])[((size_t)ld * 64 + k) * 1024 + c]); da[idx] = (bf16)f2bf(gin(F.in[I_A2])[((size_t)ld * 64 + k) * 1024 + c]); } }
    { bf16* dg = (bf16*)(F.ws + WS_G2T);
      for (size_t idx = gt; idx < (size_t)DEPTH * 1024 * 160; idx += NGT) { const int k = (int)(idx % 160), c = (int)((idx / 160) % 1024), l = (int)(idx / (160 * 1024));
          dg[idx] = (bf16)f2bf(gin(F.in[I_G2])[((size_t)l * 160 + k) * 1024 + c]); } }
    conv_f32_bf16(gin(F.in[I_SUBK]), (bf16*)(F.ws + WS_SUBK), (size_t)DEPTH * 8 * 2 * 128 * 128 / 8, gt, NGT);
    { float* X = (float*)(F.ws + WS_X);
      for (size_t i0 = gt; i0 < (size_t)MTOT * D / 4; i0 += 4 * NGT) { f32x4 v[4];
#pragma unroll
          for (int u = 0; u < 4; ++u) { const size_t i = i0 + (size_t)u * NGT; const int row = (int)(i / (D / 4)), e0 = (int)(i % (D / 4)) * 4;
              v[u] = i < (size_t)MTOT * D / 4 ? (row < NLAT ? *(const f32x4*)(gin(F.in[I_X]) + (size_t)row * D + e0) : *(const f32x4*)(gin(F.in[I_CTX]) + (size_t)(row - NLAT) * D + e0)) : (f32x4){0.f, 0.f, 0.f, 0.f}; }
#pragma unroll
          for (int u = 0; u < 4; ++u) { const size_t i = i0 + (size_t)u * NGT; if (i >= (size_t)MTOT * D / 4) continue; const int row = (int)(i / (D / 4)), e0 = (int)(i % (D / 4)) * 4;
              if (row < NLAT) { const int t = row & (SEQ - 1); const float pr = (float)(t >> 6), pc = (float)(t & 63); float o[4];
#pragma unroll
                  for (int j = 0; j < 4; ++j) { const int e = e0 + j, q = e >> 9, fi = e & 511; const float freq = __builtin_amdgcn_exp2f(-13.287712379549449f * (float)fi * (1.0f / 512.0f));
                      const float ang = ((q >> 1) ? pc : pr) * freq; float rev = ang * 0.15915494309189535f; rev -= floorf(rev);
                      o[j] = (q & 1) ? __builtin_amdgcn_cosf(rev) : __builtin_amdgcn_sinf(rev); }
                  v[u].x += o[0]; v[u].y += o[1]; v[u].z += o[2]; v[u].w += o[3]; }
              *(f32x4*)(X + (size_t)row * D + e0) = v[u]; } } }
    { float* MODP = (float*)(F.ws + WS_MODP); const float* cin = gin(F.in[I_C]); const float* cctx = gin(F.in[I_CCTX]);
      for (int it = gw; it < DEPTH * KSPLIT * 48; it += NGW) { const int cg = it % 48, kp = (it / 48) % KSPLIT, l = it / (48 * KSPLIT); const int col = cg * 256 + F.lane * 4, k0 = kp * (D / KSPLIT);
          f32x4 a0 = {0.f, 0.f, 0.f, 0.f}, a1 = a0, a2 = a0; const float* wp = gin(F.in[I_ADAW]) + ((size_t)l * D + k0) * (6 * D) + col;
#pragma unroll 8
          for (int k = 0; k < D / KSPLIT; ++k) { const f32x4 w = *(const f32x4*)(wp + (size_t)k * (6 * D)); const float c0 = cin[k0 + k], c1 = cin[D + k0 + k], c2 = cctx[k0 + k];
              const float s0 = c0 * fsigmoid(c0), s1 = c1 * fsigmoid(c1), s2 = c2 * fsigmoid(c2); a0 += w * s0; a1 += w * s1; a2 += w * s2; }
          float* o = MODP + ((size_t)(kp * DEPTH + l) * 3) * (6 * D) + col; *(f32x4*)o = a0; *(f32x4*)(o + 6 * D) = a1; *(f32x4*)(o + 12 * D) = a2; } }
}
__device__ __forceinline__ void p0b_mod_reduce(Frame& F) {
    const size_t gt = (size_t)F.vcu * NTHR + F.tid, NGT = (size_t)F.G * NTHR; const float* MODP = (const float*)(F.ws + WS_MODP); float* MOD = (float*)(F.ws + WS_MOD);
    for (size_t i = gt; i < (size_t)DEPTH * 3 * 6 * D; i += NGT) { const int n = (int)(i % (6 * D)), l = (int)(i / (3 * 6 * D)); float s = gin(F.in[I_ADAB])[(size_t)l * 6 * D + n];
#pragma unroll
        for (int kp = 0; kp < KSPLIT; ++kp) s += MODP[(size_t)kp * DEPTH * 3 * 6 * D + i];
        MOD[i] = s; }
}
__device__ __forceinline__ void modulate_rows(Frame& F, int l, int which, int nrows) {
    const int gw = F.vcu * NWAVES + F.wave, NGW = F.G * NWAVES; const float* X = (const float*)(F.ws + WS_X); bf16* H = (bf16*)(F.ws + WS_H);
    for (int row = gw; row < nrows; row += NGW) { const float* md = (const float*)(F.ws + WS_MOD) + ((size_t)l * 3 + mod_row(row)) * (6 * D) + which * 3 * D;
#pragma unroll
        for (int j = 0; j < 4; ++j) { const int e = j * 512 + F.lane * 8; const f32x4 x0 = *(const f32x4*)(X + (size_t)row * D + e), x1 = *(const f32x4*)(X + (size_t)row * D + e + 4);
            const f32x4 s0 = *(const f32x4*)(md + e), s1 = *(const f32x4*)(md + e + 4), c0 = *(const f32x4*)(md + D + e), c1 = *(const f32x4*)(md + D + e + 4);
            const f32x4 y0 = x0 * (c0 + 1.0f) + s0, y1 = x1 * (c1 + 1.0f) + s1;
            v4u o; o.x = pk2(y0.x, y0.y); o.y = pk2(y0.z, y0.w); o.z = pk2(y1.x, y1.y); o.w = pk2(y1.z, y1.w); *(v4u*)(H + (size_t)row * D + e) = o; } }
}

__device__ __forceinline__ void lru_prep_unit(Frame& F, int l, int c, int hh) {
    int tid = F.tid; asm volatile("" : "+v"(tid));
    const int lane = tid & 63, wave = F.wave;
    const TileInfo ti = tile_info(c); const bf16* P = (const bf16*)(F.ws + WS_P);
    LAS float* Us = (LAS float*)F.lds; LAS float* XC = (LAS float*)(F.lds + 17408); LAS bf16* XCb = (LAS bf16*)(F.lds + 34304);
    LAS float* LAs = (LAS float*)(F.lds + 43520); LAS float* LBs = (LAS float*)(F.lds + 76288); LAS float* SEGA = (LAS float*)(F.lds + 109056); LAS float* SEGH = SEGA + 512;
    for (int idx = tid; idx < 67 * 8; idx += NTHR) { const int r = idx >> 3, c8 = (idx & 7) * 8, t = ti.t0 - 2 + r; float x[8];
        if (t >= 0 && t < ti.seq_len) ld8bf(P + (size_t)(ti.seq_base + t) * IN_PAD + hh * 64 + c8, x);
        else {
#pragma unroll
            for (int e = 0; e < 8; ++e) x[e] = 0.f; }
        *(LAS f32x4*)(Us + r * 64 + c8) = (f32x4){x[0], x[1], x[2], x[3]}; *(LAS f32x4*)(Us + r * 64 + c8 + 4) = (f32x4){x[4], x[5], x[6], x[7]}; }
    __syncthreads();
    { const int ch = tid & 63, cg = hh * 64 + ch; const float* cw = gin(F.in[I_CONVW]) + (size_t)l * 4 * LRW + cg;
      const float w0 = cw[0], w1 = cw[LRW], w2 = cw[2 * LRW], w3 = cw[3 * LRW], cb = gin(F.in[I_CONVB])[(size_t)l * LRW + cg];
#pragma unroll
      for (int k = 0; k < 8; ++k) { const int t = (tid >> 6) + 8 * k;
          const float v = cb + w0 * Us[t * 64 + ch] + w1 * Us[(t + 1) * 64 + ch] + w2 * Us[(t + 2) * 64 + ch] + w3 * Us[(t + 3) * 64 + ch];
          XC[t * 65 + ch] = v; XCb[t * 72 + ch] = (bf16)f2bf(v); } }
    __syncthreads();
    { const int d = wave >> 2, m = wave & 3;
      const bf16x8 a0 = frag_lds(XCb, 72, 16 * m, 0, lane), a1 = frag_lds(XCb, 72, 16 * m, 32, lane);
      const bf16* Wa = (const bf16*)(F.ws + WS_WLRU) + (size_t)(((l * 2 + 0) * 2 + d) * 16 + hh) * 4096;
      const bf16* Wx = (const bf16*)(F.ws + WS_WLRU) + (size_t)(((l * 2 + 1) * 2 + d) * 16 + hh) * 4096;
#pragma unroll
      for (int n = 0; n < 4; ++n) {
          f32x4 ar = {0.f, 0.f, 0.f, 0.f}, ai = ar;
          ar = MFMA16(a0, frag_g(Wa, 64, 16 * n, 0, lane), ar); ar = MFMA16(a1, frag_g(Wa, 64, 16 * n, 32, lane), ar);
          ai = MFMA16(a0, frag_g(Wx, 64, 16 * n, 0, lane), ai); ai = MFMA16(a1, frag_g(Wx, 64, 16 * n, 32, lane), ai);
          const int col = 16 * n + (lane & 15), cg = hh * 64 + col;
          const float ba = gin(F.in[I_BA])[(size_t)(l * 2 + d) * LRW + cg], bx = gin(F.in[I_BX])[(size_t)(l * 2 + d) * LRW + cg];
          const float sp = fsoftplus(-gin(F.in[I_LAM])[(size_t)(l * 2 + d) * LRW + cg]);
#pragma unroll
          for (int r = 0; r < 4; ++r) { const int row = 16 * m + 4 * (lane >> 4) + r;
              const float rr = fsigmoid(ar[r] + ba), ii = fsigmoid(ai[r] + bx), loga = -8.0f * rr * sp, a = fexp(loga);
              const float bb = __builtin_amdgcn_sqrtf(fmaxf(1.0f - a * a, 0.f)) * ii * XC[row * 65 + col];
              LAs[(d * 64 + row) * 64 + col] = a; LBs[(d * 64 + row) * 64 + col] = bb; } } }
    __syncthreads();
    { const int col = tid & 63, seg = (tid >> 6) & 3, d = tid >> 8, cg = hh * 64 + col; float hl[16], al[16]; float h = 0.f, A = 1.f;
#pragma unroll
      for (int i = 0; i < 16; ++i) { const int tau = 16 * seg + i, row = d ? 63 - tau : tau; const float a = LAs[(d * 64 + row) * 64 + col], b = LBs[(d * 64 + row) * 64 + col]; h = a * h + b; A *= a; hl[i] = h; al[i] = A; }
      SEGA[(d * 4 + seg) * 64 + col] = A; SEGH[(d * 4 + seg) * 64 + col] = h;
      __syncthreads();
      float Hin = 0.f, Ain = 1.f;
#pragma unroll
      for (int s2 = 0; s2 < 3; ++s2) if (s2 < seg) { const float sa = SEGA[(d * 4 + s2) * 64 + col]; Hin = sa * Hin + SEGH[(d * 4 + s2) * 64 + col]; Ain *= sa; }
      bf16* HL = (bf16*)(F.ws + WS_LB) + (size_t)d * MTOT * LRW; bf16* AC = (bf16*)(F.ws + WS_LA) + (size_t)d * MTOT * LRW;
#pragma unroll
      for (int i = 0; i < 16; ++i) { const int tau = 16 * seg + i, row = d ? 63 - tau : tau; const size_t o = (size_t)(ti.seq_base + ti.t0 + row) * LRW + cg; HL[o] = (bf16)f2bf(hl[i] + al[i] * Hin); AC[o] = (bf16)f2bf(al[i] * Ain); }
      if (seg == 3) { float* AG = (float*)(F.ws + WS_LAGG); AG[((size_t)(0 * 2 + d) * NTILE + c) * LRW + cg] = al[15] * Ain; AG[((size_t)(1 * 2 + d) * NTILE + c) * LRW + cg] = hl[15] + al[15] * Hin; } }
    __syncthreads();
}
__device__ __forceinline__ void shifted8(const bf16* P, size_t grow, bool hp, bool hn, const float* mu0, const float* mu1, int rc, float (&o)[8]) {
    const bf16* p = P + grow * IN_PAD + 2 * LRW + rc;
    float xs[8], ms[8], ns[8]; ld8bf(p, xs);
#pragma unroll
    for (int e = 0; e < 8; ++e) { ms[e] = 0.f; ns[e] = 0.f; }
    if (hp) ld8bf(p - IN_PAD, ms);
    if (hn) ld8bf(p + IN_PAD, ns);
    const f32x4 a0 = *(const f32x4*)(mu0 + rc), a1 = *(const f32x4*)(mu0 + rc + 4), b0 = *(const f32x4*)(mu1 + rc), b1 = *(const f32x4*)(mu1 + rc + 4);
    const float m0[8] = {a0.x, a0.y, a0.z, a0.w, a1.x, a1.y, a1.z, a1.w}, m1[8] = {b0.x, b0.y, b0.z, b0.w, b1.x, b1.y, b1.z, b1.w};
#pragma unroll
    for (int e = 0; e < 8; ++e) o[e] = xs[e] + m0[e] * (ms[e] - xs[e]) + m1[e] * (ns[e] - xs[e]);
}
constexpr int MB = 9216;
constexpr int MLD = 72;
#define MSLOT(k) ((LAS bf16*)(F.lds + (k) * MB))
__device__ __forceinline__ int prow(int c) { return (c & ~7) | ((c + (c >> 3)) & 7); }
__device__ __forceinline__ bf16x8 frag_lds_p(const LAS bf16* base, int ld, int row0, int k0, int lane) { return *(const LAS bf16x8*)(base + prow(row0 + (lane & 15)) * ld + k0 + 8 * (lane >> 4)); }
template <bool PY, bool PX> __device__ __forceinline__ f32x4 mm_tile_p(const LAS bf16* Y, int rt, const LAS bf16* X, int ct, f32x4 acc, int lane) {
    acc = MFMA16(PY ? frag_lds_p(Y, MLD, 16 * rt, 0, lane) : frag_lds(Y, MLD, 16 * rt, 0, lane), PX ? frag_lds_p(X, MLD, 16 * ct, 0, lane) : frag_lds(X, MLD, 16 * ct, 0, lane), acc);
    acc = MFMA16(PY ? frag_lds_p(Y, MLD, 16 * rt, 32, lane) : frag_lds(Y, MLD, 16 * rt, 32, lane), PX ? frag_lds_p(X, MLD, 16 * ct, 32, lane) : frag_lds(X, MLD, 16 * ct, 32, lane), acc);
    return acc;
}
__device__ __forceinline__ f32x4 mm_tile(const LAS bf16* Y, int rt, const LAS bf16* X, int ct, f32x4 acc, int lane) {
    acc = MFMA16(frag_lds(Y, MLD, 16 * rt, 0, lane), frag_lds(X, MLD, 16 * ct, 0, lane), acc);
    acc = MFMA16(frag_lds(Y, MLD, 16 * rt, 32, lane), frag_lds(X, MLD, 16 * ct, 32, lane), acc);
    return acc;
}
__device__ __forceinline__ void st_tile(LAS bf16* Dst, int rt, int ct, f32x4 acc, int lane) {
    v2u o; o.x = pk2(acc[0], acc[1]); o.y = pk2(acc[2], acc[3]);
    *(LAS v2u*)(Dst + (16 * ct + (lane & 15)) * MLD + 16 * rt + 4 * (lane >> 4)) = o;
}
__device__ __forceinline__ f32x4 ld_tile(const LAS bf16* Src, int rt, int ct, int lane) {
    const v2u o = *(const LAS v2u*)(Src + (16 * ct + (lane & 15)) * MLD + 16 * rt + 4 * (lane >> 4));
    return (f32x4){bf_lo(o.x), bf_hi(o.x), bf_lo(o.y), bf_hi(o.y)};
}
template <int MASK> __device__ __forceinline__ void mm64(LAS bf16* Dst, const LAS bf16* X, const LAS bf16* Y, int wave, int lane) {
    const int rt = wave >> 1;
#pragma unroll
    for (int q = 0; q < 2; ++q) { const int ct = 2 * (wave & 1) + q; f32x4 acc = {0.f, 0.f, 0.f, 0.f};
        acc = mm_tile(Y, rt, X, ct, acc, lane);
        if (MASK) { const int c = 16 * ct + (lane & 15);
#pragma unroll
            for (int g = 0; g < 4; ++g) { const int r = 16 * rt + 4 * (lane >> 4) + g; const bool keep = MASK == 1 ? (c > r) : MASK == 2 ? (r > c) : (c >= r); if (!keep) acc[g] = 0.f; } }
        st_tile(Dst, rt, ct, acc, lane); }
}
#ifndef CPROBE
#define CPROBE 0
#endif
struct RawS1 { v4u x[5][3]; };
template <int G0, int G1> __device__ __forceinline__ void load_raw(Frame& F, int c, int hh, int d, int tid, RawS1& raw) {
    const TileInfo ti = tile_info(c); const int t = tid >> 3, c8 = (tid & 7) * 8, tt = ti.t0 + t; const bool hp = tt > 0, hn = tt + 1 < ti.seq_len;
    const bf16* p0 = (const bf16*)(F.ws + WS_P) + (size_t)(ti.seq_base + tt) * IN_PAD + 2 * LRW + c8;
#pragma unroll
    for (int g = G0; g < G1; ++g) { const int rc = g < 3 ? g * RWW + hh * 64 : 3 * RWW + (g - 3) * 128 + d * 64; const bf16* p = p0 + rc;
        raw.x[g][0] = *(const v4u*)p; raw.x[g][1] = *(const v4u*)(p - (hp ? IN_PAD : 0)); raw.x[g][2] = *(const v4u*)(p + (hn ? IN_PAD : 0)); }
}
__device__ __forceinline__ void shift_raw(const v4u (&x)[3], const LAS float* mus, bool hp, bool hn, float (&o)[8]) {
    const f32x4 a0 = *(const LAS f32x4*)mus, a1 = *(const LAS f32x4*)(mus + 4), b0 = *(const LAS f32x4*)(mus + 64), b1 = *(const LAS f32x4*)(mus + 68);
    const float m0[8] = {a0.x, a0.y, a0.z, a0.w, a1.x, a1.y, a1.z, a1.w}, m1[8] = {b0.x, b0.y, b0.z, b0.w, b1.x, b1.y, b1.z, b1.w};
    const unsigned xw[4] = {x[0].x, x[0].y, x[0].z, x[0].w}, pw[4] = {x[1].x, x[1].y, x[1].z, x[1].w}, nw[4] = {x[2].x, x[2].y, x[2].z, x[2].w};
#pragma unroll
    for (int e = 0; e < 8; ++e) { const float xs = (e & 1) ? bf_hi(xw[e >> 1]) : bf_lo(xw[e >> 1]), ms = hp ? ((e & 1) ? bf_hi(pw[e >> 1]) : bf_lo(pw[e >> 1])) : 0.f, ns = hn ? ((e & 1) ? bf_hi(nw[e >> 1]) : bf_lo(nw[e >> 1])) : 0.f;
        o[e] = xs + m0[e] * (ms - xs) + m1[e] * (ns - xs); }
}
__device__ __forceinline__ void rwkv_chunk_prep(Frame& F, int l, int c, int hh, int d) {
    RawS1 raw;
    int tid = F.tid; asm volatile("" : "+v"(tid));
    const TileInfo ti = tile_info(c); const int lane = tid & 63, wave = F.wave;
    LAS bf16* TW = MSLOT(0); LAS bf16* AD = MSLOT(1);
    LAS float* CUM = (LAS float*)(F.lds + 8 * MB); LAS float* AVs = (LAS float*)(F.lds + 8 * MB + 16640);
    LAS float* CWL = (LAS float*)(F.lds + 13 * MB); LAS float* SEGT = (LAS float*)(F.lds + 13 * MB + 256); LAS float* MUS = (LAS float*)(F.lds + 125184);
    const int uidx = (c * NH + hh) * 2 + d;
    const int t = tid >> 3, c8 = (tid & 7) * 8, tt = ti.t0 + t; const size_t grow = (size_t)(ti.seq_base + tt); const bool hp = tt > 0, hn = tt + 1 < ti.seq_len;
    float rv[8], kv[8], vv[8], kk[8];
    load_raw<0, 5>(F, c, hh, d, tid, raw);
    for (int rp_ = 0; rp_ < (CPROBE == 1 ? 2 : 1); ++rp_) {
    shift_raw(raw.x[0], MUS + 0 * 128 + c8, hp, hn, rv);
    shift_raw(raw.x[1], MUS + 1 * 128 + c8, hp, hn, kv);
    shift_raw(raw.x[2], MUS + 2 * 128 + c8, hp, hn, vv);
    { float ss = 0.f; const float* kkw = gin(F.in[I_KK]) + (size_t)l * RWW + hh * 64 + c8;
#pragma unroll
      for (int e = 0; e < 8; ++e) { kk[e] = kv[e] * kkw[e]; ss += kk[e] * kk[e]; }
      ss = red8(ss); const float inv = __builtin_amdgcn_rsqf(fmaxf(ss, 1e-24f));
#pragma unroll
      for (int e = 0; e < 8; ++e) kk[e] *= inv; }
    if (d == 0) { v4u o; o.x = pk2(vv[0], vv[1]); o.y = pk2(vv[2], vv[3]); o.z = pk2(vv[4], vv[5]); o.w = pk2(vv[6], vv[7]); *(v4u*)((bf16*)(F.ws + WS_RV) + grow * RWW + hh * 64 + c8) = o; }
    { float x[8]; v4u o;
      shift_raw(raw.x[3], MUS + 3 * 128 + c8, hp, hn, x);
      o.x = pk2(ftanh(x[0]), ftanh(x[1])); o.y = pk2(ftanh(x[2]), ftanh(x[3])); o.z = pk2(ftanh(x[4]), ftanh(x[5])); o.w = pk2(ftanh(x[6]), ftanh(x[7])); *(LAS v4u*)(TW + t * MLD + c8) = o;
      shift_raw(raw.x[4], MUS + 4 * 128 + c8, hp, hn, x);
      o.x = pk2(x[0], x[1]); o.y = pk2(x[2], x[3]); o.z = pk2(x[4], x[5]); o.w = pk2(x[6], x[7]); *(LAS v4u*)(AD + t * MLD + c8) = o; }
    asm volatile("" ::: "memory"); }
    bf16x8 w2f[2][2], a2f[2][2];
    { const bf16* W2 = (const bf16*)(F.ws + WS_W2T) + ((size_t)(l * 2 + d) * 1024 + hh * 64) * 64; const bf16* A2 = (const bf16*)(F.ws + WS_A2T) + ((size_t)(l * 2 + d) * 1024 + hh * 64) * 64;
#pragma unroll
      for (int q = 0; q < 2; ++q) { const int n = (wave >> 2) * 2 + q;
#pragma unroll
          for (int k = 0; k < 2; ++k) { w2f[q][k] = frag_g(W2, 64, 16 * n, 32 * k, lane); a2f[q][k] = frag_g(A2, 64, 16 * n, 32 * k, lane); } } }
    __syncthreads();
    for (int rp_ = 0; rp_ < (CPROBE == 2 ? 2 : 1); ++rp_) { const int m = wave & 3; const bf16x8 w0f = frag_lds(TW, MLD, 16 * m, 0, lane), w1f = frag_lds(TW, MLD, 16 * m, 32, lane), d0f = frag_lds(AD, MLD, 16 * m, 0, lane), d1f = frag_lds(AD, MLD, 16 * m, 32, lane);
#pragma unroll
      for (int q = 0; q < 2; ++q) { const int n = (wave >> 2) * 2 + q; f32x4 aw = {0.f, 0.f, 0.f, 0.f}, aa = aw;
          aw = MFMA16(w0f, w2f[q][0], aw); aw = MFMA16(w1f, w2f[q][1], aw);
          aa = MFMA16(d0f, a2f[q][0], aa); aa = MFMA16(d1f, a2f[q][1], aa);
          const int col = 16 * n + (lane & 15), cg = hh * 64 + col; const float w0 = gin(F.in[I_W0])[(size_t)(l * 2 + d) * RWW + cg], a0 = gin(F.in[I_A0])[(size_t)(l * 2 + d) * RWW + cg];
#pragma unroll
          for (int g = 0; g < 4; ++g) { const int row = 16 * m + 4 * (lane >> 4) + g; const float wlog = -fsoftplus(-(w0 + aw[g])) - 0.5f;
              CUM[row * 65 + col] = -fexp(wlog); AVs[row * 65 + col] = fsigmoid(a0 + aa[g]); } } }
    __syncthreads();
    { const int col = tid & 63, seg = tid >> 6; float pre[8]; float run = 0.f;
#pragma unroll
      for (int i = 0; i < 8; ++i) { const int tau = seg * 8 + i, tr = d ? 63 - tau : tau; run += CUM[tr * 65 + col]; pre[i] = run; }
      SEGT[seg * 64 + col] = run;
      __syncthreads();
      float off = 0.f;
#pragma unroll
      for (int s = 0; s < 8; ++s) if (s < seg) off += SEGT[s * 64 + col];
#pragma unroll
      for (int i = 0; i < 8; ++i) { const int tau = seg * 8 + i, tr = d ? 63 - tau : tau; CUM[tr * 65 + col] = off + pre[i]; }
      if (seg == 7) CWL[col] = fexp(off + pre[7]); }
    __syncthreads();
    for (int rp_ = 0; rp_ < (CPROBE == 3 ? 2 : 1); ++rp_) { const int tau = d ? 63 - t : t, tprev = d ? t + 1 : t - 1;
      const float* kaw = gin(F.in[I_KA]) + (size_t)l * RWW + hh * 64 + c8; const float* rkw = gin(F.in[I_RK]) + (size_t)l * RWW + hh * 64 + c8;
      LAS bf16* At = MSLOT(0); LAS bf16* AtT = MSLOT(1); LAS bf16* Bt = MSLOT(2); LAS bf16* BtT = MSLOT(3); LAS bf16* Kt = MSLOT(4); LAS bf16* KtT = MSLOT(5); LAS bf16* Rt = MSLOT(6); LAS bf16* VT = MSLOT(7);
      float bsum = 0.f; unsigned pa[4], pb[4], pk[4], pr[4];
#pragma unroll
      for (int e2 = 0; e2 < 4; ++e2) { float at2[2], bt2[2], kt2[2], rt2[2];
#pragma unroll
          for (int q = 0; q < 2; ++q) { const int e = 2 * e2 + q; const float cum = CUM[t * 65 + c8 + e], cumx = tau > 0 ? CUM[tprev * 65 + c8 + e] : 0.f, a = AVs[t * 65 + c8 + e];
              const float kd = kv[e] * (1.0f + (a - 1.0f) * kaw[e]), ex = fexp(cum), exm = fexp(-cum);
              at2[q] = -kk[e] * fexp(cumx); bt2[q] = kk[e] * a * exm; kt2[q] = kd * exm; rt2[q] = rv[e] * ex; bsum += rv[e] * kd * rkw[e];
              const int pr_ = prow(c8 + e) * MLD + tau; AtT[pr_] = (bf16)f2bf(at2[q]); BtT[pr_] = (bf16)f2bf(bt2[q]); KtT[pr_] = (bf16)f2bf(kt2[q]); VT[pr_] = (bf16)f2bf(vv[e]); }
          pa[e2] = pk2(at2[0], at2[1]); pb[e2] = pk2(bt2[0], bt2[1]); pk[e2] = pk2(kt2[0], kt2[1]); pr[e2] = pk2(rt2[0], rt2[1]); }
      *(LAS v4u*)(At + tau * MLD + c8) = (v4u){pa[0], pa[1], pa[2], pa[3]}; *(LAS v4u*)(Bt + tau * MLD + c8) = (v4u){pb[0], pb[1], pb[2], pb[3]};
      *(LAS v4u*)(Kt + tau * MLD + c8) = (v4u){pk[0], pk[1], pk[2], pk[3]}; *(LAS v4u*)(Rt + tau * MLD + c8) = (v4u){pr[0], pr[1], pr[2], pr[3]};
      bsum = red8(bsum);
      if ((tid & 7) == 0) ((float*)(F.ws + WS_BETA))[((size_t)d * MTOT + grow) * NH + hh] = bsum; }
    __syncthreads();
    LAS bf16* At = MSLOT(0); LAS bf16* AtT = MSLOT(1); LAS bf16* Bt = MSLOT(2); LAS bf16* BtT = MSLOT(3); LAS bf16* Kt = MSLOT(4); LAS bf16* KtT = MSLOT(5); LAS bf16* Rt = MSLOT(6); LAS bf16* VT = MSLOT(7);
    LAS bf16* Pm = MSLOT(8); LAS bf16* AkVT = MSLOT(9); LAS bf16* Gak = MSLOT(10); LAS bf16* Grb = MSLOT(11); LAS bf16* Grk = MSLOT(12);
    LAS bf16* TAT = MSLOT(0); LAS bf16* U0T = MSLOT(2); LAS bf16* TD = (LAS bf16*)(F.lds + 122112); constexpr int TDLD = 24;
    for (int rp_ = 0; rp_ < (CPROBE == 4 ? 2 : 1); ++rp_) {
    mm64<1>(Pm, At, Bt, wave, lane);
    __syncthreads();
    if (wave == 0) { const int blk = lane >> 4, cc = lane & 15; float tv[16];
#pragma unroll
        for (int r = 0; r < 16; ++r) { asm volatile("" ::: "memory"); const LAS bf16* ar = Pm + (16 * blk + r) * MLD + 16 * blk; const v4u q0 = *(const LAS v4u*)ar, q1 = *(const LAS v4u*)(ar + 8);
            const float av_[16] = {bf_lo(q0.x), bf_hi(q0.x), bf_lo(q0.y), bf_hi(q0.y), bf_lo(q0.z), bf_hi(q0.z), bf_lo(q0.w), bf_hi(q0.w), bf_lo(q1.x), bf_hi(q1.x), bf_lo(q1.y), bf_hi(q1.y), bf_lo(q1.z), bf_hi(q1.z), bf_lo(q1.w), bf_hi(q1.w)};
            float acc0 = (r == cc) ? 1.0f : 0.f, acc1 = 0.f;
#pragma unroll
            for (int m = 0; m < r; ++m) { if (m & 1) acc1 += av_[m] * tv[m]; else acc0 += av_[m] * tv[m]; }
            tv[r] = acc0 + acc1; }
#pragma unroll
        for (int r = 0; r < 16; ++r) TD[(16 * blk + r) * TDLD + cc] = (bf16)f2bf(tv[r]);
    } else {
#pragma unroll 1
        for (int q = wave - 1; q < 48; q += 7) { const int pr = q >> 4, tl = q & 15, rt = tl >> 2, ct = tl & 3;
            const LAS bf16* X = pr == 0 ? At : Rt; const LAS bf16* Y = pr == 1 ? Bt : Kt; LAS bf16* Dst = pr == 0 ? Gak : pr == 1 ? Grb : Grk;
            f32x4 acc = {0.f, 0.f, 0.f, 0.f}; acc = mm_tile(Y, rt, X, ct, acc, lane);
            const int cI = 16 * ct + (lane & 15);
#pragma unroll
            for (int g = 0; g < 4; ++g) { const int rI = 16 * rt + 4 * (lane >> 4) + g; const bool keep = pr == 0 ? (cI > rI) : (cI >= rI); if (!keep) acc[g] = 0.f; }
            st_tile(Dst, rt, ct, acc, lane); }
    }
    __syncthreads(); }
    { const int rt = wave >> 1;
#pragma unroll
      for (int q = 0; q < 2; ++q) { const int ct = 2 * (wave & 1) + q; f32x4 acc = {0.f, 0.f, 0.f, 0.f}; acc = mm_tile_p<false, true>(Gak, rt, VT, ct, acc, lane); st_tile(AkVT, rt, ct, acc, lane); } }
    { const v4u z = {0u, 0u, 0u, 0u}; for (int i = tid; i < 64 * 8; i += NTHR) { const int row = i >> 3, c8_ = (i & 7) * 8; *(LAS v4u*)(TAT + row * MLD + c8_) = z; *(LAS v4u*)(U0T + row * MLD + c8_) = z; } }
    __syncthreads();
    for (int rp_ = 0; rp_ < (CPROBE == 5 ? 2 : 1); ++rp_)
#pragma unroll 1
    for (int bi = 0; bi < 4; ++bi) {
        const int g = lane >> 4, il = lane & 15, nt = wave & 3; const LAS bf16* RH = (wave < 4) ? AtT : AkVT; LAS bf16* XT = (wave < 4) ? TAT : U0T;
        const v2u rq = *(const LAS v2u*)(RH + ((wave < 4) ? prow(16 * nt + il) : 16 * nt + il) * MLD + 16 * bi + 4 * g);
        f32x4 acc = {bf_lo(rq.x), bf_hi(rq.x), bf_lo(rq.y), bf_hi(rq.y)};
#pragma unroll
        for (int ks = 0; ks < 2; ++ks) if (32 * ks < 16 * bi) {
            bf16x8 af = frag_lds(Pm, MLD, 16 * bi, 32 * ks, lane); if (32 * ks + 8 * g >= 16 * bi) af = (bf16x8){0, 0, 0, 0, 0, 0, 0, 0};
            acc = MFMA16(af, frag_lds(XT, MLD, 16 * nt, 32 * ks, lane), acc); }
        v4u rb; rb.x = pk2(acc[0], acc[1]); rb.y = pk2(acc[2], acc[3]); rb.z = 0u; rb.w = 0u;
        const v2u tq = *(const LAS v2u*)(TD + (16 * bi + il) * TDLD + 4 * g); v4u tf; tf.x = tq.x; tf.y = tq.y; tf.z = 0u; tf.w = 0u;
        f32x4 xo = {0.f, 0.f, 0.f, 0.f}; xo = MFMA16(__builtin_bit_cast(bf16x8, tf), __builtin_bit_cast(bf16x8, rb), xo);
        v2u o; o.x = pk2(xo[0], xo[1]); o.y = pk2(xo[2], xo[3]); *(LAS v2u*)(XT + (16 * nt + il) * MLD + 16 * bi + 4 * g) = o;
        __syncthreads();
    }
    for (int rp_ = 0; rp_ < (CPROBE == 6 ? 2 : 1); ++rp_) {
    {
      bf16* QMg = (bf16*)(F.ws + WS_QM) + (size_t)uidx * 4096; bf16* PHg = (bf16*)(F.ws + WS_PHI) + (size_t)uidx * 4096; const int rt = wave >> 1;
#pragma unroll
      for (int q = 0; q < 2; ++q) { const int ct = 2 * (wave & 1) + q; const int cidx = 16 * ct + (lane & 15), r0 = 16 * rt + 4 * (lane >> 4), qpos = 32 * (rt >> 1) + 8 * (lane >> 4) + 4 * (rt & 1);
          f32x4 acc = ld_tile(Rt, rt, ct, lane); acc = mm_tile(TAT, rt, Grb, ct, acc, lane);
          v2u o; o.x = pk2(acc[0], acc[1]); o.y = pk2(acc[2], acc[3]); *(v2u*)(QMg + cidx * 64 + qpos) = o;
          asm volatile("" ::: "memory");
          f32x4 ph = {0.f, 0.f, 0.f, 0.f}; ph = mm_tile_p<false, true>(TAT, rt, BtT, ct, ph, lane); const float cw = CWL[cidx];
#pragma unroll
          for (int g = 0; g < 4; ++g) ph[g] = cw * (ph[g] + ((r0 + g == cidx) ? 1.0f : 0.f));
          o.x = pk2(ph[0], ph[1]); o.y = pk2(ph[2], ph[3]); *(v2u*)(PHg + cidx * 64 + qpos) = o; } }
    {
      bf16* Y0g = (bf16*)(F.ws + WS_Y0F) + (size_t)uidx * 4096; bf16* PSg = (bf16*)(F.ws + WS_PSF) + (size_t)uidx * 4096; const int rt = wave >> 1;
#pragma unroll
      for (int q = 0; q < 2; ++q) { const int ct = 2 * (wave & 1) + q;
          asm volatile("" ::: "memory");
          f32x4 y0 = {0.f, 0.f, 0.f, 0.f}; y0 = mm_tile(U0T, rt, Grb, ct, y0, lane); asm volatile("" ::: "memory"); y0 = mm_tile_p<true, false>(VT, rt, Grk, ct, y0, lane);
          { v2u w; w.x = pk2(y0[0], y0[1]); w.y = pk2(y0[2], y0[3]); *(v2u*)(Y0g + ((rt * 4 + ct) * 64 + lane) * 4) = w; }
          asm volatile("" ::: "memory");
          f32x4 ps = {0.f, 0.f, 0.f, 0.f}; ps = mm_tile_p<true, false>(BtT, rt, U0T, ct, ps, lane); asm volatile("" ::: "memory"); ps = mm_tile_p<true, true>(KtT, rt, VT, ct, ps, lane);
#pragma unroll
          for (int g = 0; g < 4; ++g) ps[g] *= CWL[16 * rt + 4 * (lane >> 4) + g];
          { v2u w; w.x = pk2(ps[0], ps[1]); w.y = pk2(ps[2], ps[3]); *(v2u*)(PSg + ((ct * 4 + rt) * 64 + lane) * 4) = w; } } } }
    __syncthreads();
}
#define LDS_BAR() do { asm volatile("s_waitcnt lgkmcnt(0)" ::: "memory"); __builtin_amdgcn_s_barrier(); asm volatile("" ::: "memory"); } while (0)
struct ChunkOps { bf16x8 f[4][2]; v2u c[4]; int tile; };
__device__ __forceinline__ void chunk_load(Frame& F, ChunkOps& o, int step, int b, int hh, int d, int sl, int role, int lane) {
    const int g = lane >> 4, il = lane & 15;
    step = step < 67 ? step : 67;
    const int cc = d ? 3 - step : step, lc = d ? 67 - step : step - 4; const int tile = step < 4 ? 128 + b * 4 + cc : b * 64 + lc;
    o.tile = tile;
    const size_t uidx = (size_t)(tile * NH + hh) * 2 + d;
    const bf16* Mg = (const bf16*)(F.ws + (role ? WS_QM : WS_PHI)) + uidx * 4096 + il * 64 + 8 * g; const bf16* Cg = (const bf16*)(F.ws + (role ? WS_Y0F : WS_PSF)) + uidx * 4096 + (sl * 4 * 64 + lane) * 4;
#pragma unroll
    for (int m = 0; m < 4; ++m) { o.f[m][0] = *(const bf16x8*)(Mg + m * 1024); o.f[m][1] = *(const bf16x8*)(Mg + m * 1024 + 32); o.c[m] = *(const v2u*)(Cg + m * 256); }
}
__device__ __forceinline__ void lru_scan(Frame& F, int idx) {
    const int ch = idx & 1023, b = (idx >> 10) & 1, d = idx >> 11;
    const float* AG = (const float*)(F.ws + WS_LAGG); float* HIN = (float*)(F.ws + WS_LHIN);
    float carry = 0.f;
#pragma unroll 4
    for (int step = 0; step < 68; ++step) { int tile; if (step < 4) tile = 128 + b * 4 + (d ? 3 - step : step); else tile = b * 64 + (d ? 63 - (step - 4) : step - 4);
        const float a = AG[((size_t)(0 * 2 + d) * NTILE + tile) * LRW + ch], hh_ = AG[((size_t)(1 * 2 + d) * NTILE + tile) * LRW + ch];
        HIN[((size_t)d * NTILE + tile) * LRW + ch] = carry; carry = a * carry + hh_; }
}

__device__ __forceinline__ void chunk_apply(Frame& F, const ChunkOps& o, f32x4 (&S)[4], int step, bf16* YR, int hh, int d, int sl, int role, int lane) {
    const int g = lane >> 4, il = lane & 15; LAS v4u* XCH = (LAS v4u*)F.lds;
    bf16x8 bfr[2];
    if (role == 0) {
#pragma unroll
        for (int ks = 0; ks < 2; ++ks) { v4u w; w.x = pk2(S[2 * ks][0], S[2 * ks][1]); w.y = pk2(S[2 * ks][2], S[2 * ks][3]); w.z = pk2(S[2 * ks + 1][0], S[2 * ks + 1][1]); w.w = pk2(S[2 * ks + 1][2], S[2 * ks + 1][3]); bfr[ks] = __builtin_bit_cast(bf16x8, w); }
#pragma unroll
        for (int m = 0; m < 4; ++m) { f32x4 sn = (f32x4){bf_lo(o.c[m].x), bf_hi(o.c[m].x), bf_lo(o.c[m].y), bf_hi(o.c[m].y)}; sn = MFMA16(o.f[m][0], bfr[0], sn); sn = MFMA16(o.f[m][1], bfr[1], sn); S[m] = sn; }
#pragma unroll
        for (int ks = 0; ks < 2; ++ks) { v4u w; w.x = pk2(S[2 * ks][0], S[2 * ks][1]); w.y = pk2(S[2 * ks][2], S[2 * ks][3]); w.z = pk2(S[2 * ks + 1][0], S[2 * ks + 1][1]); w.w = pk2(S[2 * ks + 1][2], S[2 * ks + 1][3]);
            XCH[((((step + 1) & 1) * 4 + sl) * 2 + ks) * 64 + lane] = w; }
    } else {
#pragma unroll
        for (int ks = 0; ks < 2; ++ks) bfr[ks] = __builtin_bit_cast(bf16x8, XCH[(((step & 1) * 4 + sl) * 2 + ks) * 64 + lane]);
#pragma unroll
        for (int m = 0; m < 4; ++m) { f32x4 y = (f32x4){bf_lo(o.c[m].x), bf_hi(o.c[m].x), bf_lo(o.c[m].y), bf_hi(o.c[m].y)}; y = MFMA16(bfr[0], o.f[m][0], y); y = MFMA16(bfr[1], o.f[m][1], y);
            const int tau = 16 * m + il, tl = d ? 63 - tau : tau; v2u w; w.x = pk2(y[0], y[1]); w.y = pk2(y[2], y[3]);
            *(v2u*)(YR + (size_t)(o.tile * 64 + tl) * RWW + hh * 64 + sl * 16 + 4 * g) = w; }
    }
}
__device__ __forceinline__ void rwkv_chain_chunks(Frame& F, int item) {
    const int chain = item >> 2, sl = item & 3, d = chain & 1, hh = (chain >> 1) & 15, b = chain >> 5, role = F.wave, lane = F.lane;
    bf16* YR = (bf16*)(F.ws + WS_YR) + (size_t)d * MTOT * RWW;
    { LAS v4u* XCH = (LAS v4u*)F.lds; for (int i = F.tid; i < 4 * 2 * 64; i += NTHR) XCH[i] = (v4u){0u, 0u, 0u, 0u}; }
    __syncthreads();
    if (F.wave >= 2) {
#pragma unroll 1
        for (int step = 0; step < 68; ++step) LDS_BAR();
        return; }
    f32x4 S[4];
#pragma unroll
    for (int m = 0; m < 4; ++m) S[m] = (f32x4){0.f, 0.f, 0.f, 0.f};
    ChunkOps A, B, C, E;
    chunk_load(F, A, 0, b, hh, d, sl, role, lane); chunk_load(F, B, 1, b, hh, d, sl, role, lane); chunk_load(F, C, 2, b, hh, d, sl, role, lane);
#pragma unroll 1
    for (int step = 0; step < 68; step += 4) {
        chunk_load(F, E, step + 3, b, hh, d, sl, role, lane);
        chunk_apply(F, A, S, step, YR, hh, d, sl, role, lane); LDS_BAR();
        chunk_load(F, A, step + 4, b, hh, d, sl, role, lane);
        chunk_apply(F, B, S, step + 1, YR, hh, d, sl, role, lane); LDS_BAR();
        chunk_load(F, B, step + 5, b, hh, d, sl, role, lane);
        chunk_apply(F, C, S, step + 2, YR, hh, d, sl, role, lane); LDS_BAR();
        chunk_load(F, C, step + 6, b, hh, d, sl, role, lane);
        chunk_apply(F, E, S, step + 3, YR, hh, d, sl, role, lane); LDS_BAR();
    }
}
__device__ __forceinline__ void merge_unit(Frame& F, int l, int u) {
    const int c = u >> 2; const TileInfo ti = tile_info(c); const int t0 = ti.t0 + (u & 3) * 16; const bf16* P = (const bf16*)(F.ws + WS_P);
    LAS bf16* SG = (LAS bf16*)F.lds; LAS bf16* GO = (LAS bf16*)(F.lds + 10752);
    const float* mu0 = gin(F.in[I_MU]) + (size_t)l * 2 * RW_COLS; const float* mu1 = mu0 + RW_COLS;
    if (F.tid < 16 * 20) { const int t = F.tid / 20, k8 = (F.tid % 20) * 8, tt = t0 + t, rc = 3 * RWW + 256 + k8; const bf16* p = P + (size_t)(ti.seq_base + tt) * IN_PAD + 2 * LRW + rc;
        float x[8], xm[8], xn[8]; ld8bf(p, x); ld8bf(p - (tt > 0 ? IN_PAD : 0), xm); ld8bf(p + (tt + 1 < ti.seq_len ? IN_PAD : 0), xn); float o[8];
#pragma unroll
        for (int e = 0; e < 8; ++e) { const float pm = tt > 0 ? xm[e] : 0.f, pn = tt + 1 < ti.seq_len ? xn[e] : 0.f; o[e] = fsigmoid(x[e] + mu0[rc + e] * (pm - x[e]) + mu1[rc + e] * (pn - x[e])); }
        v4u w; w.x = pk2(o[0], o[1]); w.y = pk2(o[2], o[3]); w.z = pk2(o[4], o[5]); w.w = pk2(o[6], o[7]); *(LAS v4u*)(SG + t * 168 + k8) = w; }
    __syncthreads();
    { const int lane = F.lane; const bf16* G2 = (const bf16*)(F.ws + WS_G2T) + (size_t)l * 1024 * 160;
      bf16x8 af[5];
#pragma unroll
      for (int k = 0; k < 5; ++k) af[k] = frag_lds(SG, 168, 0, 32 * k, lane);
#pragma unroll 2
      for (int n = 0; n < 8; ++n) { const int n0 = F.wave * 128 + n * 16; f32x4 a0 = {0.f, 0.f, 0.f, 0.f};
#pragma unroll
          for (int k = 0; k < 5; ++k) a0 = MFMA16(af[k], frag_g(G2, 160, n0, 32 * k, lane), a0);
#pragma unroll
          for (int r = 0; r < 4; ++r) GO[(4 * (lane >> 4) + r) * 1032 + n0 + (lane & 15)] = (bf16)f2bf(a0[r]); } }
    __syncthreads();
    { bf16* MRG = (bf16*)(F.ws + WS_H);
      for (int it = F.tid; it < 16 * 256; it += NTHR) { const int t = it >> 8, cgp = it & 255, tt = t0 + t; const size_t grow = (size_t)(ti.seq_base + tt);
          float o[8];
          if (cgp < 128) { const int ch = cgp * 8; float gq8[8]; ld8bf(P + grow * IN_PAD + LRW + ch, gq8); const f32x4 g0 = {gq8[0], gq8[1], gq8[2], gq8[3]}, g1 = {gq8[4], gq8[5], gq8[6], gq8[7]};
              const bf16* hl = (const bf16*)(F.ws + WS_LB) + grow * LRW + ch; const bf16* ac = (const bf16*)(F.ws + WS_LA) + grow * LRW + ch; const float* hi = (const float*)(F.ws + WS_LHIN) + (size_t)c * LRW + ch;
              float h0[8], c0[8], h1[8], c1[8]; ld8bf(hl, h0); ld8bf(ac, c0); ld8bf(hl + (size_t)MTOT * LRW, h1); ld8bf(ac + (size_t)MTOT * LRW, c1);
              const f32x4 i00 = *(const f32x4*)hi, i01 = *(const f32x4*)(hi + 4), i10 = *(const f32x4*)(hi + (size_t)NTILE * LRW), i11 = *(const f32x4*)(hi + (size_t)NTILE * LRW + 4);
              const f32x4 a0 = {h0[0] + c0[0] * i00.x + h1[0] + c1[0] * i10.x, h0[1] + c0[1] * i00.y + h1[1] + c1[1] * i10.y, h0[2] + c0[2] * i00.z + h1[2] + c1[2] * i10.z, h0[3] + c0[3] * i00.w + h1[3] + c1[3] * i10.w};
              const f32x4 a1 = {h0[4] + c0[4] * i01.x + h1[4] + c1[4] * i11.x, h0[5] + c0[5] * i01.y + h1[5] + c1[5] * i11.y, h0[6] + c0[6] * i01.z + h1[6] + c1[6] * i11.z, h0[7] + c0[7] * i01.w + h1[7] + c1[7] * i11.w};
              o[0] = gelu_tanh(g0.x) * a0.x; o[1] = gelu_tanh(g0.y) * a0.y; o[2] = gelu_tanh(g0.z) * a0.z; o[3] = gelu_tanh(g0.w) * a0.w;
              o[4] = gelu_tanh(g1.x) * a1.x; o[5] = gelu_tanh(g1.y) * a1.y; o[6] = gelu_tanh(g1.z) * a1.z; o[7] = gelu_tanh(g1.w) * a1.w; }
          else { const int ch = (cgp - 128) * 8, hh = ch >> 6; const bf16* yr = (const bf16*)(F.ws + WS_YR) + grow * RWW + ch;
              float ya[8], yb[8], va[8]; ld8bf(yr, ya); ld8bf(yr + (size_t)MTOT * RWW, yb); ld8bf((const bf16*)(F.ws + WS_RV) + grow * RWW + ch, va);
              float s1 = 0.f, q1 = 0.f;
#pragma unroll
              for (int e = 0; e < 8; ++e) { ya[e] += yb[e]; s1 += ya[e]; q1 += ya[e] * ya[e]; }
              s1 = red8(s1); q1 = red8(q1);
              const float mean = s1 * (1.0f / 64.0f), var = fmaxf(q1 * (1.0f / 64.0f) - mean * mean, 0.f); const f32x2 st = {mean, __builtin_amdgcn_rsqf(var + GN_EPS)};
              const float beta = ((const float*)(F.ws + WS_BETA))[grow * NH + hh] + ((const float*)(F.ws + WS_BETA))[((size_t)MTOT + grow) * NH + hh];
              const float* gg = gin(F.in[I_GNG]) + (size_t)l * RWW + ch; const float* gb = gin(F.in[I_GNB]) + (size_t)l * RWW + ch;
              const v4u gq = *(const LAS v4u*)(GO + t * 1032 + ch); const float gv[8] = {bf_lo(gq.x), bf_hi(gq.x), bf_lo(gq.y), bf_hi(gq.y), bf_lo(gq.z), bf_hi(gq.z), bf_lo(gq.w), bf_hi(gq.w)};
#pragma unroll
              for (int e = 0; e < 8; ++e) o[e] = ((ya[e] - st.x) * st.y * gg[e] + gb[e] + beta * va[e]) * gv[e]; }
          v4u w; w.x = pk2(o[0], o[1]); w.y = pk2(o[2], o[3]); w.z = pk2(o[4], o[5]); w.w = pk2(o[6], o[7]);
          *(v4u*)(MRG + grow * D + cgp * 8) = w; } }
    __syncthreads();
}

__device__ __forceinline__ void ln_row(float (&z)[32], const float* g, const float* b, int lane) {
    float s = 0.f;
#pragma unroll
    for (int i = 0; i < 32; ++i) s += z[i];
    const float mean = wave_sum(s) * (1.0f / D); float q = 0.f;
#pragma unroll
    for (int i = 0; i < 32; ++i) { z[i] -= mean; q += z[i] * z[i]; }
    const float rstd = __builtin_amdgcn_rsqf(wave_sum(q) * (1.0f / D) + LN_EPS);
#pragma unroll
    for (int j = 0; j < 4; ++j) { const int e = j * 512 + lane * 8; const f32x4 g0 = *(const f32x4*)(g + e), g1 = *(const f32x4*)(g + e + 4), b0 = *(const f32x4*)(b + e), b1 = *(const f32x4*)(b + e + 4);
        const float gs[8] = {g0.x, g0.y, g0.z, g0.w, g1.x, g1.y, g1.z, g1.w}, bs[8] = {b0.x, b0.y, b0.z, b0.w, b1.x, b1.y, b1.z, b1.w};
#pragma unroll
        for (int i = 0; i < 8; ++i) z[j * 8 + i] = z[j * 8 + i] * rstd * gs[i] + bs[i]; }
}
__device__ __forceinline__ void load32(const float* p, int lane, float (&v)[32]) {
#pragma unroll
    for (int j = 0; j < 4; ++j) { const int e = j * 512 + lane * 8; const f32x4 a = *(const f32x4*)(p + e), b = *(const f32x4*)(p + e + 4);
        v[j * 8 + 0] = a.x; v[j * 8 + 1] = a.y; v[j * 8 + 2] = a.z; v[j * 8 + 3] = a.w; v[j * 8 + 4] = b.x; v[j * 8 + 5] = b.y; v[j * 8 + 6] = b.z; v[j * 8 + 7] = b.w; }
}
__device__ __forceinline__ void store32(float* p, int lane, const float (&v)[32]) {
#pragma unroll
    for (int j = 0; j < 4; ++j) { const int e = j * 512 + lane * 8; *(f32x4*)(p + e) = (f32x4){v[j * 8 + 0], v[j * 8 + 1], v[j * 8 + 2], v[j * 8 + 3]}; *(f32x4*)(p + e + 4) = (f32x4){v[j * 8 + 4], v[j * 8 + 5], v[j * 8 + 6], v[j * 8 + 7]}; }
}
__device__ __forceinline__ void store32_mod_bf16(bf16* p, const float* sh, const float* sc, int lane, const float (&v)[32]) {
#pragma unroll
    for (int j = 0; j < 4; ++j) { const int e = j * 512 + lane * 8; const f32x4 s0 = *(const f32x4*)(sh + e), s1 = *(const f32x4*)(sh + e + 4), c0 = *(const f32x4*)(sc + e), c1 = *(const f32x4*)(sc + e + 4);
        v4u o; o.x = pk2(v[j * 8 + 0] * (1.f + c0.x) + s0.x, v[j * 8 + 1] * (1.f + c0.y) + s0.y); o.y = pk2(v[j * 8 + 2] * (1.f + c0.z) + s0.z, v[j * 8 + 3] * (1.f + c0.w) + s0.w);
        o.z = pk2(v[j * 8 + 4] * (1.f + c1.x) + s1.x, v[j * 8 + 5] * (1.f + c1.y) + s1.y); o.w = pk2(v[j * 8 + 6] * (1.f + c1.z) + s1.z, v[j * 8 + 7] * (1.f + c1.w) + s1.w);
        *(v4u*)(p + e) = o; }
}
__device__ __forceinline__ void ctx_wait(const unsigned* cnt, unsigned need) {
    unsigned sp = 0;
    while ((unsigned)__builtin_amdgcn_readfirstlane((int)__hip_atomic_load(cnt, __ATOMIC_RELAXED, __HIP_MEMORY_SCOPE_AGENT)) < need) { __builtin_amdgcn_s_sleep(2); if (++sp > (1u << 20)) break; }
    __builtin_amdgcn_fence(__ATOMIC_ACQUIRE, "agent");
}
__device__ __forceinline__ void ln1_rows(Frame& F, int l, int nrows, bool dry = false, const unsigned* cnt = nullptr, unsigned need = 0) {
    bool waited = false;
    const int gw = F.vcu * NWAVES + F.wave, NGW = F.G * NWAVES; float* X = (float*)(F.ws + WS_X); const float* O = (const float*)(F.ws + WS_O); bf16* H = (bf16*)(F.ws + WS_H);
    float* Xo = dry ? (float*)(F.ws + WS_LA) : X; bf16* Ho = dry ? (bf16*)(F.ws + WS_LB) : H;
    for (int row = gw; row < nrows; row += NGW) { const float* md = (const float*)(F.ws + WS_MOD) + ((size_t)l * 3 + mod_row(row)) * (6 * D);
        if (cnt && row >= NLAT && !waited) { ctx_wait(cnt, need); waited = true; }
        float z[32], o[32], gt[32]; load32(X + (size_t)row * D, F.lane, z); load32(md + 2 * D, F.lane, gt);
#pragma unroll
        for (int j = 0; j < 4; ++j) { float t8[8]; ld8bf((const bf16*)(F.ws + WS_O) + (size_t)row * D + j * 512 + F.lane * 8, t8);
#pragma unroll
            for (int i = 0; i < 8; ++i) o[j * 8 + i] = t8[i]; }
#pragma unroll
        for (int i = 0; i < 32; ++i) z[i] = ALPHA * z[i] + gt[i] * o[i];
        ln_row(z, gin(F.in[I_LN1G]) + (size_t)l * D, gin(F.in[I_LN1B]) + (size_t)l * D, F.lane);
        store32(Xo + (size_t)row * D, F.lane, z);
        store32_mod_bf16(Ho + (size_t)row * D, md + 3 * D, md + 4 * D, F.lane, z); }
}

__device__ __forceinline__ unsigned ord_key(float s, int k) { unsigned u = __builtin_bit_cast(unsigned, s); u = (u & 0x80000000u) ? ~u : (u | 0x80000000u); return (u & ~127u) | (unsigned)(127 - k); }
__device__ __forceinline__ float key_score(unsigned key) { const unsigned u = key & ~127u; return __builtin_bit_cast(float, (u & 0x80000000u) ? (u ^ 0x80000000u) : ~u); }
__device__ __forceinline__ void bitonic_top16(unsigned (&A)[16], const unsigned (&B)[16]) {
#pragma unroll
    for (int i = 0; i < 16; ++i) A[i] = A[i] > B[15 - i] ? A[i] : B[15 - i];
#pragma unroll
    for (int st = 8; st >= 1; st >>= 1)
#pragma unroll
        for (int i = 0; i < 16; ++i) if (!(i & st)) { const unsigned hi = A[i] > A[i + st] ? A[i] : A[i + st], lo = A[i] > A[i + st] ? A[i + st] : A[i]; A[i] = hi; A[i + st] = lo; }
}
__device__ __forceinline__ void ins16(unsigned (&L)[16], unsigned x) {
#pragma unroll
    for (int i = 0; i < 16; ++i) { const unsigned hi = L[i] > x ? L[i] : x; x = L[i] > x ? x : L[i]; L[i] = hi; }
}
__device__ __forceinline__ unsigned ord_key8(float s, unsigned tag) { unsigned u = __builtin_bit_cast(unsigned, s); u = (u & 0x80000000u) ? ~u : (u | 0x80000000u); return (u & ~255u) | tag; }
__device__ __forceinline__ float key_score8(unsigned key) { const unsigned u = key & ~255u; return __builtin_bit_cast(float, (u & 0x80000000u) ? (u ^ 0x80000000u) : ~u); }
__device__ __forceinline__ void peer_topk_unit(Frame& F, int l, int tile, int h) {
    int tid = F.tid; asm volatile("" : "+v"(tid));
    const int lane = tid & 63, wave = F.wave;
    LAS bf16* AQ = (LAS bf16*)F.lds; LAS float* SC = (LAS float*)(F.lds + 33792);
    LAS unsigned* bufA = (LAS unsigned*)F.lds; LAS unsigned* bufB = (LAS unsigned*)(F.lds + 33792); LAS unsigned* FIN = (LAS unsigned*)(F.lds + 66560); LAS unsigned char* PAIRT = (LAS unsigned char*)(F.lds + 99584);
    if (tid < 50) { int c = tid, i = 0; for (; i < 16; ++i) { const int n = 16 / (i + 1); if (c < n) break; c -= n; } PAIRT[tid] = (unsigned char)(i * 16 + c); }
    for (int idx = tid; idx < 64 * 64; idx += NTHR) { const int t = idx >> 6, c4 = (idx & 63) * 4; *(LAS v2u*)(AQ + t * 264 + c4) = *(const v2u*)((const bf16*)(F.ws + WS_QP) + (size_t)(tile * 64 + t) * D + h * 256 + c4); }
    __syncthreads();
    { const bf16* SK = (const bf16*)(F.ws + WS_SUBK) + (size_t)((l * 8 + h) * 2) * 128 * 128;
#pragma unroll
      for (int p = 0; p < 2; ++p) { bf16x8 bfr[4];
#pragma unroll
          for (int k = 0; k < 4; ++k) bfr[k] = frag_g(SK + (size_t)p * 128 * 128, 128, 16 * wave, 32 * k, lane);
#pragma unroll
          for (int m = 0; m < 4; ++m) { f32x4 acc = {0.f, 0.f, 0.f, 0.f};
#pragma unroll
              for (int k = 0; k < 4; ++k) acc = MFMA16(frag_lds(AQ, 264, 16 * m, p * 128 + 32 * k, lane), bfr[k], acc);
#pragma unroll
              for (int r = 0; r < 4; ++r) SC[(16 * m + 4 * (lane >> 4) + r) * 257 + p * 128 + 16 * wave + (lane & 15)] = acc[r]; } } }
    __syncthreads();
    const int t = lane, r = wave, p = r & 1, qd = r >> 1;
    unsigned L[16], B[16];
#pragma unroll
    for (int i = 0; i < 16; ++i) L[i] = 0u;
    { const LAS float* sp = SC + t * 257 + p * 128 + 32 * qd;
#pragma unroll 4
      for (int k = 0; k < 32; ++k) ins16(L, ord_key(sp[k], 32 * qd + k)); }
#pragma unroll
    for (int i = 0; i < 16; ++i) bufA[(r * 16 + i) * 64 + t] = L[i];
    __syncthreads();
#pragma unroll
    for (int i = 0; i < 16; ++i) B[i] = bufA[((r ^ 2) * 16 + i) * 64 + t];
    bitonic_top16(L, B);
#pragma unroll
    for (int i = 0; i < 16; ++i) bufB[(r * 16 + i) * 64 + t] = L[i];
    __syncthreads();
#pragma unroll
    for (int i = 0; i < 16; ++i) B[i] = bufB[((r ^ 4) * 16 + i) * 64 + t];
    bitonic_top16(L, B);
    if (qd == 0) {
#pragma unroll
        for (int i = 0; i < 16; ++i) FIN[(p * 16 + i) * 64 + t] = L[i]; }
    __syncthreads();
#pragma unroll
    for (int i = 0; i < 16; ++i) L[i] = 0u;
#pragma unroll
    for (int q = 0; q < 7; ++q) { const int c = q * 8 + r; if (c < 50) { const unsigned pr = PAIRT[c]; const unsigned ka = FIN[(0 * 16 + (pr >> 4)) * 64 + t], kb = FIN[(1 * 16 + (pr & 15)) * 64 + t];
            ins16(L, ord_key8(key_score(ka) + key_score(kb), pr)); } }
#pragma unroll
    for (int i = 0; i < 16; ++i) bufB[(r * 16 + i) * 64 + t] = L[i];
    __syncthreads();
#pragma unroll
    for (int i = 0; i < 16; ++i) B[i] = bufB[((r ^ 1) * 16 + i) * 64 + t];
    bitonic_top16(L, B);
#pragma unroll
    for (int i = 0; i < 16; ++i) bufA[(r * 16 + i) * 64 + t] = L[i];
    __syncthreads();
#pragma unroll
    for (int i = 0; i < 16; ++i) B[i] = bufA[((r ^ 2) * 16 + i) * 64 + t];
    bitonic_top16(L, B);
    __syncthreads();
#pragma unroll
    for (int i = 0; i < 16; ++i) bufB[(r * 16 + i) * 64 + t] = L[i];
    __syncthreads();
#pragma unroll
    for (int i = 0; i < 16; ++i) B[i] = bufB[((r ^ 4) * 16 + i) * 64 + t];
    bitonic_top16(L, B);
    { const float mx = key_score8(L[0]); float sum = 0.f, e0 = 0.f, e1 = 0.f; unsigned k0 = 0u, k1 = 0u;
#pragma unroll
      for (int i = 0; i < 16; ++i) { const float e = fexp(key_score8(L[i]) - mx); sum += e; if (i == 2 * r) { e0 = e; k0 = L[i]; } if (i == 2 * r + 1) { e1 = e; k1 = L[i]; } }
      const float inv = __builtin_amdgcn_rcpf(sum);
      const unsigned pa = k0 & 255u, pb = k1 & 255u;
      const int id0 = (127 - (int)(FIN[(0 * 16 + (pa >> 4)) * 64 + t] & 127u)) * 128 + (127 - (int)(FIN[(1 * 16 + (pa & 15)) * 64 + t] & 127u));
      const int id1 = (127 - (int)(FIN[(0 * 16 + (pb >> 4)) * 64 + t] & 127u)) * 128 + (127 - (int)(FIN[(1 * 16 + (pb & 15)) * 64 + t] & 127u));
      int* IDX = (int*)(F.ws + WS_IDX) + (size_t)(tile * 64 + t) * PE_SEL + h * 16 + 2 * r; float* GT = (float*)(F.ws + WS_GATE) + (size_t)(tile * 64 + t) * PE_SEL + h * 16 + 2 * r;
      *(int2*)IDX = make_int2(id0, id1); *(f32x2*)GT = (f32x2){e0 * inv, e1 * inv}; }
    __syncthreads();
}

#ifndef GPROBE
#define GPROBE 0
#endif
#ifndef GPROBE_MASK
#define GPROBE_MASK (~0u)
#endif
#ifndef EBU_
#define EBU_ 8
#endif
#ifndef EBV_
#define EBV_ 8
#endif
constexpr int EB = 8;
__device__ __forceinline__ v32f ld_row6(const unsigned char* row, int lane) {
    const v4u a = *(const v4u*)(row + lane * 16); const v2u b = *(const v2u*)(row + 1024 + lane * 8);
    return __builtin_amdgcn_cvt_scalef32_pk32_f32_fp6((v6u){a.x, a.y, a.z, a.w, b.x, b.y}, 1.0f);
}
#define SCHED_FENCE() __builtin_amdgcn_sched_barrier(0)
template <int EB> __device__ __forceinline__ void ld_rows(__amdgpu_buffer_rsrc_t TB, unsigned tbo, int sel, int k0, unsigned lo16, unsigned emask, v4u (&wa)[EB], v2u (&wb)[EB]) {
#pragma unroll
    for (int q = 0; q < EB; ++q) { const unsigned e = (unsigned)__builtin_amdgcn_readlane(sel, (k0 + q) & 63) & emask;
        wa[q] = __builtin_bit_cast(v4u, __builtin_amdgcn_raw_buffer_load_b128(TB, lo16, e * (unsigned)EROW + tbo, 0));
        wb[q] = __builtin_bit_cast(v2u, __builtin_amdgcn_raw_buffer_load_b64(TB, (lo16 >> 1) + 1024u, e * (unsigned)EROW + tbo, 0)); }
}
typedef float f32p __attribute__((ext_vector_type(2)));
template <int EB> __device__ __forceinline__ void u_batch(const v4u (&wa)[EB], const v2u (&wb)[EB], const f32p (&hf)[16], int k0, int lane, LAS float* dots) {
    static_assert(EB == 4, "the transposing reduction below takes four experts at a time");
    float s4[4];
#pragma unroll
    for (int q = 0; q < EB; ++q) { const v32f uf = __builtin_amdgcn_cvt_scalef32_pk32_f32_fp6((v6u){wa[q].x, wa[q].y, wa[q].z, wa[q].w, wb[q].x, wb[q].y}, 1.0f);
        f32p p0 = {0.f, 0.f}, p1 = {0.f, 0.f};
#pragma unroll
        for (int i = 0; i < 16; i += 2) { p0 = __builtin_elementwise_fma((f32p){uf[2 * i], uf[2 * i + 1]}, hf[i], p0); p1 = __builtin_elementwise_fma((f32p){uf[2 * i + 2], uf[2 * i + 3]}, hf[i + 1], p1); }
        p0 += p1; s4[q] = p0.x + p0.y; }
    const bool b0 = lane & 1, b1 = lane & 2;
    const float t0 = s4[0] + dpp_f<0xB1>(s4[0]), t1 = s4[1] + dpp_f<0xB1>(s4[1]), t2 = s4[2] + dpp_f<0xB1>(s4[2]), t3 = s4[3] + dpp_f<0xB1>(s4[3]);
    const float r01 = b0 ? t1 : t0, r23 = b0 ? t3 : t2;
    const float w0 = r01 + dpp_f<0x4E>(r01), w1 = r23 + dpp_f<0x4E>(r23);
    float r = b1 ? w1 : w0;
    r += dpp_f<0x124>(r); r += dpp_f<0x128>(r);
    dots[k0 >> 2] = r;
}
template <int EB> __device__ __forceinline__ void v_batch(const v4u (&wa)[EB], const v2u (&wb)[EB], int k0, float csel, f32p (&acc)[16]) {
#pragma unroll
    for (int q = 0; q < EB; ++q) { const float cf = __builtin_bit_cast(float, __builtin_amdgcn_readlane(__builtin_bit_cast(int, csel), (k0 + q) & 63));
        const v32f vf = __builtin_amdgcn_cvt_scalef32_pk32_f32_fp6((v6u){wa[q].x, wa[q].y, wa[q].z, wa[q].w, wb[q].x, wb[q].y}, 1.0f);
        const f32p c2 = {cf, cf};
#pragma unroll
        for (int i = 0; i < 16; ++i) acc[i] = __builtin_elementwise_fma((f32p){vf[2 * i], vf[2 * i + 1]}, c2, acc[i]); }
}
template <int EB> __device__ __forceinline__ void peer_token(Frame& F, int l, int row, int kb, int ke, float (&acc)[32], unsigned emask = ~0u) {
    const int lane = F.lane; const unsigned lo16 = lane * 16;
    const __amdgpu_buffer_rsrc_t TB = __builtin_amdgcn_make_buffer_rsrc((void*)(F.ws + WS_UB + (size_t)l * PE_NE * EROW), 0, 0xffffffffu, 0x00020000);
    constexpr unsigned UB = 0u, VB = (unsigned)(WS_VB - WS_UB);
    static_assert(WS_VB > WS_UB && (size_t)(WS_VB - WS_UB) + (size_t)PE_NE * EROW < 0xffffffffull, "table offsets must fit the 32-bit buffer offset");
    LAS float* dots = (LAS float*)(F.lds + 49152) + (F.wave * 64 + lane) * 33;
    const float* SU = (const float*)(F.ws + WS_SU) + (size_t)l * PE_NE; const float* SV = (const float*)(F.ws + WS_SV) + (size_t)l * PE_NE;
    const bf16* H = (const bf16*)(F.ws + WS_H);
    const int* IDX = (const int*)(F.ws + WS_IDX) + (size_t)row * PE_SEL; const float* GT = (const float*)(F.ws + WS_GATE) + (size_t)row * PE_SEL;
    const int il = IDX[lane], ih = IDX[64 + lane]; const float gl = GT[lane], gh = GT[64 + lane];
    f32p hf[16];
#pragma unroll
    for (int j = 0; j < 4; ++j) { const v4u t4 = *(const v4u*)(H + (size_t)row * D + lane * 32 + j * 8);
        hf[4 * j] = (f32p){bf_lo(t4.x), bf_hi(t4.x)}; hf[4 * j + 1] = (f32p){bf_lo(t4.y), bf_hi(t4.y)}; hf[4 * j + 2] = (f32p){bf_lo(t4.z), bf_hi(t4.z)}; hf[4 * j + 3] = (f32p){bf_lo(t4.w), bf_hi(t4.w)}; }
    const float sul = SU[il], suh = SU[ih], svl = SV[il], svh = SV[ih];
    SCHED_FENCE(); __builtin_amdgcn_s_waitcnt(0x0070); SCHED_FENCE();
    v4u a0[EB], a1[EB]; v2u b0[EB], b1[EB];
    ld_rows<EB>(TB, UB, kb < 64 ? il : ih, kb, lo16, emask, a0, b0); SCHED_FENCE();
#pragma unroll 1
    for (int k0 = kb; k0 < ke; k0 += 2 * EB) {
        ld_rows<EB>(TB, UB, k0 < 64 ? il : ih, k0 + EB, lo16, emask, a1, b1); SCHED_FENCE();
        u_batch<EB>(a0, b0, hf, k0, lane, dots); SCHED_FENCE();
        { const int kn = k0 + 2 * EB; const bool last = kn >= ke; const int k2 = last ? kb : kn; ld_rows<EB>(TB, last ? VB : UB, k2 < 64 ? il : ih, k2, lo16, emask, a0, b0); } SCHED_FENCE();
        u_batch<EB>(a1, b1, hf, k0 + EB, lane, dots); SCHED_FENCE(); }
    float dl = 0.f, dh = 0.f;
    { const LAS float* dr = (const LAS float*)(F.lds + 49152) + (F.wave * 64 + (lane & 3)) * 33 + (lane >> 2);
#pragma unroll
      for (int r4 = 0; r4 < 4; ++r4) { dl += dr[r4 * 16 * 33]; dh += dr[r4 * 16 * 33 + 16]; } }
    const float cl = gl * svl * gelu_erf(dl * sul), ch = gh * svh * gelu_erf(dh * suh);
    f32p ac2[16];
#pragma unroll
    for (int i = 0; i < 16; ++i) ac2[i] = (f32p){0.f, 0.f};
#pragma unroll 1
    for (int k0 = kb; k0 < ke; k0 += 2 * EB) {
        ld_rows<EB>(TB, VB, k0 < 64 ? il : ih, k0 + EB, lo16, emask, a1, b1); SCHED_FENCE();
        v_batch<EB>(a0, b0, k0, k0 < 64 ? cl : ch, ac2); SCHED_FENCE();
        { const int kn = k0 + 2 * EB; const int k2 = kn >= ke ? k0 : kn; ld_rows<EB>(TB, VB, k2 < 64 ? il : ih, k2, lo16, emask, a0, b0); } SCHED_FENCE();
        v_batch<EB>(a1, b1, k0 + EB, k0 < 64 ? cl : ch, ac2); SCHED_FENCE(); }
#pragma unroll
    for (int i = 0; i < 16; ++i) { acc[2 * i] = ac2[i].x; acc[2 * i + 1] = ac2[i].y; }
}
__device__ __forceinline__ void peer_finish(Frame& F, int l, int row, const float (&acc)[32], bool dry) {
    const int lane = F.lane;
    float* X = (float*)(F.ws + WS_X); bf16* H = (bf16*)(F.ws + WS_H); float* Xo = dry ? (float*)(F.ws + WS_LA) : X; bf16* Ho = dry ? (bf16*)(F.ws + WS_LB) : H; float* Oo = dry ? (float*)(F.ws + WS_LA) : (float*)F.out;
    const float* md = (const float*)(F.ws + WS_MOD) + ((size_t)l * 3 + mod_row(row)) * (6 * D);
    float z[32]; float s = 0.f;
#pragma unroll
    for (int q = 0; q < 8; ++q) { const int e = lane * 32 + q * 4; const f32x4 xv = *(const f32x4*)(X + (size_t)row * D + e), gv = *(const f32x4*)(md + 5 * D + e);
        z[q * 4 + 0] = ALPHA * xv.x + gv.x * acc[q * 4 + 0]; z[q * 4 + 1] = ALPHA * xv.y + gv.y * acc[q * 4 + 1]; z[q * 4 + 2] = ALPHA * xv.z + gv.z * acc[q * 4 + 2]; z[q * 4 + 3] = ALPHA * xv.w + gv.w * acc[q * 4 + 3]; }
#pragma unroll
    for (int i = 0; i < 32; ++i) s += z[i];
    const float mean = wave_sum(s) * (1.0f / D); float qv = 0.f;
#pragma unroll
    for (int i = 0; i < 32; ++i) { z[i] -= mean; qv += z[i] * z[i]; }
    const float rstd = __builtin_amdgcn_rsqf(wave_sum(qv) * (1.0f / D) + LN_EPS);
    const float* lg = gin(F.in[I_LN2G]) + (size_t)l * D; const float* lb = gin(F.in[I_LN2B]) + (size_t)l * D; const float* mn = (const float*)(F.ws + WS_MOD) + ((size_t)(l + 1 < DEPTH ? l + 1 : l) * 3 + mod_row(row)) * (6 * D);
    unsigned hw[16];
#pragma unroll
    for (int q = 0; q < 8; ++q) { const int e = lane * 32 + q * 4; const f32x4 g4 = *(const f32x4*)(lg + e), b4 = *(const f32x4*)(lb + e);
        f32x4 o; o.x = z[q * 4 + 0] * rstd * g4.x + b4.x; o.y = z[q * 4 + 1] * rstd * g4.y + b4.y; o.z = z[q * 4 + 2] * rstd * g4.z + b4.z; o.w = z[q * 4 + 3] * rstd * g4.w + b4.w;
        if (l + 1 < DEPTH) { *(f32x4*)(Xo + (size_t)row * D + e) = o; const f32x4 s4 = *(const f32x4*)(mn + e), c4 = *(const f32x4*)(mn + D + e);
            hw[2 * q] = pk2(o.x * (1.f + c4.x) + s4.x, o.y * (1.f + c4.y) + s4.y); hw[2 * q + 1] = pk2(o.z * (1.f + c4.z) + s4.z, o.w * (1.f + c4.w) + s4.w); }
        else *(f32x4*)(Oo + (size_t)row * D + e) = o; }
    if (l + 1 < DEPTH) {
#pragma unroll
        for (int j = 0; j < 4; ++j) *(v4u*)(Ho + (size_t)row * D + lane * 32 + j * 8) = (v4u){hw[4 * j], hw[4 * j + 1], hw[4 * j + 2], hw[4 * j + 3]}; }
}
__device__ __forceinline__ void peer_rows(Frame& F, int l, int nrows, bool dry = false) {
    const int gw = F.vcu * NWAVES + F.wave, NGW = F.G * NWAVES, lane = F.lane;
    for (int row = gw; row < NLAT; row += NGW) { Frame F2 = F; { int t_ = F.lane; asm volatile("" : "+v"(t_)); F2.lane = t_; }
        float acc[32]; peer_token<EBU_>(F2, l, row, 0, PE_SEL, acc, dry ? GPROBE_MASK : ~0u); { int t_ = F2.lane; asm volatile("" : "+v"(t_)); F2.lane = t_; } peer_finish(F2, l, row, acc, dry); }
    if (nrows > NLAT) { LAS float* PART = (LAS float*)F.lds;
        for (int r2 = F.vcu * 2 + (F.wave >> 2); r2 < NCTX; r2 += F.G * 2) { const int row = NLAT + r2, part = F.wave & 3, slot = F.wave >> 2; float acc[32]; Frame F2 = F; { int t_ = F.lane; asm volatile("" : "+v"(t_)); F2.lane = t_; }
            peer_token<EBU_>(F2, l, row, 32 * part, 32 * part + 32, acc, dry ? GPROBE_MASK : ~0u);
            if (part) { LAS float* pw = PART + ((slot * 3 + part - 1) * 32) * 64 + lane;
#pragma unroll
                for (int i = 0; i < 32; ++i) pw[i * 64] = acc[i]; }
            __syncthreads();
            if (part == 0) { const LAS float* pr = PART + (slot * 96) * 64 + lane;
#pragma unroll
                for (int p = 0; p < 3; ++p)
#pragma unroll
                    for (int i = 0; i < 32; ++i) acc[i] += pr[(p * 32 + i) * 64];
                peer_finish(F2, l, row, acc, dry); }
            __syncthreads(); } }
}
#ifndef MK_PER_PHASE
#define MK_PER_PHASE 0
#endif
constexpr int NPH_PRO = 3, NPH_LAYER = 9, NPHASES = NPH_PRO + DEPTH * NPH_LAYER;
__global__ void __launch_bounds__(NTHR, 2) trunk_fwd(Args args) {
    extern __shared__ __attribute__((aligned(16))) unsigned char lds_raw[];
    Frame F0;
    F0.lds = (LAS unsigned char*)lds_raw;
    F0.tid = threadIdx.x; F0.lane = F0.tid & 63; F0.wave = __builtin_amdgcn_readfirstlane(F0.tid >> 6);
    F0.G = gridDim.x; { const int bx = blockIdx.x; F0.vcu = (F0.G % 8 == 0) ? (bx % 8) * (F0.G / 8) + bx / 8 : bx; }
    F0.in = args.in; F0.out = (GAS float*)args.out; F0.ws = (GAS unsigned char*)args.ws;
    volatile LAS unsigned* MISC = (volatile LAS unsigned*)(F0.lds + MISC_OFF);
    for (int u = F0.tid; u < (LDS_BYTES - LDSCTL_OFF) / 4; u += NTHR) ((LAS unsigned*)(F0.lds + LDSCTL_OFF))[u] = 0u;
    __syncthreads();
    const int lo = args.ph_lo, hi = args.ph_hi;
    XcdBarrier bar; bar.bar = (unsigned*)(F0.ws + WS_CTL) + CW_BAR; bar.x = 0; bar.st = nullptr;
    if (hi - lo > 1) bar = xcd_barrier_post((unsigned*)(F0.ws + WS_CTL) + CW_BAR, MISC + 8);
#ifndef PHMASK
#define PHMASK 0xfff
#endif
#define PHM(b) ((PHMASK >> (b)) & 1)
#ifndef PHREP
#define PHREP 0
#endif
#define NREP(b) (1 + ((PHREP >> (b)) & 1))
#define IN(k) (lo <= (k) && (k) < hi)
#define LAUNDER() Frame F = F0; int bx_ = blockIdx.x; __builtin_amdgcn_s_waitcnt(0x0070); { int ws_ = F0.wave; asm volatile("" : "+s"(ws_)); int ln_; asm volatile("v_mbcnt_lo_u32_b32 %0, -1, 0\n\tv_mbcnt_hi_u32_b32 %0, -1, %0" : "=v"(ln_)); F.wave = ws_; F.lane = ln_; F.tid = ws_ * 64 + ln_; \
    GAS unsigned char* w_ = F0.ws; asm volatile("" : "+s"(w_)); F.ws = w_; int v_ = F0.vcu; asm volatile("" : "+s"(v_)); F.vcu = v_; int g_ = F0.G; asm volatile("" : "+s"(g_)); F.G = g_; \
    GAS float* o_ = F0.out; asm volatile("" : "+s"(o_)); F.out = o_; asm volatile("" : "+s"(bx_)); \
    unsigned l_ = (unsigned)(size_t)F0.lds; asm volatile("" : "+v"(l_)); F.lds = (LAS unsigned char*)(size_t)l_; }
#define SEAM(k) do { if (IN(k) && IN((k) + 1)) xcd_barrier(bar); } while (0)

    if (PHM(0) && IN(0)) for (int rep_ = 0; rep_ < NREP(0); ++rep_) { LAUNDER(); p0_prologue(F); } SEAM(0);
    if (PHM(1) && IN(1)) { LAUNDER(); p0b_mod_reduce(F); } SEAM(1);
    if (PHM(2) && IN(2)) { LAUNDER(); modulate_rows(F, 0, 0, MTOT); } SEAM(2);

#pragma unroll 1
    for (int l = 0; l < DEPTH; ++l) {
        const int pb = NPH_PRO + l * NPH_LAYER;
        const int mrows = (l + 1 < DEPTH) ? MTOT : NLAT;
        if (PHM(3) && IN(pb + 0)) for (int rep_ = 0; rep_ < NREP(3); ++rep_) { LAUNDER(); pg8::Gemm g{(const pg8::bf16_t*)(F.ws + WS_H), (const pg8::bf16_t*)(F.ws + WS_WIN) + (size_t)l * IN_PAD * D, MTOT, IN_PAD, D, D};
            pg8::StaticOrder S; S.init(MTOT, IN_PAD, F.G, bx_); pg8::EpiBf16<0> E{(pg8::bf16_t*)(F.ws + WS_P), IN_PAD, nullptr, 0, 0};
            pg8::gemm_phase<pg8::EpiBf16<0>, pg8::StaticOrder, false>(F.lds, g, S, E, nullptr, F.tid); }
        SEAM(pb + 0);
        if (PHM(4) && IN(pb + 1)) for (int rep_ = 0; rep_ < NREP(4); ++rep_) { LAUNDER(); for (int r2 = 0; r2 < NREP(12); ++r2) for (int u = F.vcu; u < NTILE * NH; u += F.G) lru_prep_unit(F, l, u >> 4, u & 15); asm volatile("" ::: "memory"); for (int r2 = 0; r2 < NREP(13); ++r2) { int cur_hd = -1;
                for (int v = F.vcu; v < 2 * NTILE * NH; v += F.G) { const int hh_ = (v >> 1) & 15, d_ = v & 1;
                    if (hh_ * 2 + d_ != cur_hd) { cur_hd = hh_ * 2 + d_; __syncthreads(); LAS float* MUS = (LAS float*)(F.lds + 125184); const float* mu = gin(F.in[I_MU]) + (size_t)l * 2 * RW_COLS;
                        for (int i = F.tid; i < 5 * 2 * 64; i += NTHR) { const int g = i >> 7, wh = (i >> 6) & 1, col = i & 63; const int rc = g < 3 ? g * RWW + hh_ * 64 : 3 * RWW + (g - 3) * 128 + d_ * 64; MUS[i] = mu[(size_t)wh * RW_COLS + rc + col]; }
                        __syncthreads(); }
                    rwkv_chunk_prep(F, l, v >> 5, hh_, d_); } } }
        SEAM(pb + 1);
        if (PHM(5) && IN(pb + 2)) for (int rep_ = 0; rep_ < NREP(5); ++rep_) { LAUNDER(); for (int u = F.vcu; u < 256; u += F.G) { if (u < 32 && F.wave >= 2 && F.wave < 4) lru_scan(F, u * 128 + F.tid - 128); rwkv_chain_chunks(F, u); } }
        SEAM(pb + 2);
        if (PHM(6) && IN(pb + 3)) for (int rep_ = 0; rep_ < NREP(6); ++rep_) { LAUNDER(); for (int u = F.vcu; u < 4 * NTILE; u += F.G) merge_unit(F, l, u); }
        SEAM(pb + 3);
        const bool defer = (l + 1 < DEPTH) && F0.G > 2 * CTX_TILES;
        if (PHM(7) && IN(pb + 4)) for (int rep_ = 0; rep_ < NREP(7); ++rep_) { LAUNDER(); const int mr = defer ? NLAT : mrows; pg8::Gemm g{(const pg8::bf16_t*)(F.ws + WS_H), (const pg8::bf16_t*)(F.ws + WS_WOUT) + (size_t)l * D * D, mr, D, D, D};
            pg8::StaticOrder S; S.init(mr, D, F.G, bx_); pg8::EpiBf16<0> E{(pg8::bf16_t*)(F.ws + WS_O), D, nullptr, 0, 0};
            pg8::gemm_phase<pg8::EpiBf16<0>, pg8::StaticOrder, false>(F.lds, g, S, E, nullptr, F.tid); }
        SEAM(pb + 4);
        if (PHM(8) && IN(pb + 5)) { LAUNDER();
            if (defer) { unsigned* cnt = (unsigned*)(F.ws + WS_CTL) + CW_CTX + 64 * (2 * l);
                if (bx_ < CTX_TILES) { pg8::Gemm g{(const pg8::bf16_t*)(F.ws + WS_H), (const pg8::bf16_t*)(F.ws + WS_WOUT) + (size_t)l * D * D, MTOT, D, D, D};
                    pg8::CtxOrder S{NLAT / 256, D / 256, CTX_TILES, bx_, cnt, F.lane == 0}; pg8::EpiBf16<0> E{(pg8::bf16_t*)(F.ws + WS_O), D, nullptr, 0, 0};
                    pg8::gemm_phase<pg8::EpiBf16<0>, pg8::CtxOrder, false>(F.lds, g, S, E, nullptr, F.tid); }
                else { Frame F2 = F; F2.vcu = bx_ - CTX_TILES; F2.G = F.G - CTX_TILES; ln1_rows(F2, l, MTOT, false, cnt, 8u * CTX_TILES); } }
            else ln1_rows(F, l, mrows); }
        SEAM(pb + 5);
        if (PHM(9) && IN(pb + 6)) for (int rep_ = 0; rep_ < NREP(9); ++rep_) { LAUNDER(); const int mr = defer ? NLAT : mrows; pg8::Gemm g{(const pg8::bf16_t*)(F.ws + WS_H), (const pg8::bf16_t*)(F.ws + WS_WQ) + (size_t)l * D * D, mr, D, D, D};
            pg8::StaticOrder S; S.init(mr, D, F.G, bx_); pg8::EpiBf16<0> E{(pg8::bf16_t*)(F.ws + WS_QP), D, nullptr, 0, 0};
            pg8::gemm_phase<pg8::EpiBf16<0>, pg8::StaticOrder, false>(F.lds, g, S, E, nullptr, F.tid); }
        SEAM(pb + 6);
        if (PHM(10) && IN(pb + 7)) { LAUNDER();
            if (defer) { unsigned* cnt = (unsigned*)(F.ws + WS_CTL) + CW_CTX + 64 * (2 * l + 1);
                if (bx_ < CTX_TILES) { pg8::Gemm g{(const pg8::bf16_t*)(F.ws + WS_H), (const pg8::bf16_t*)(F.ws + WS_WQ) + (size_t)l * D * D, MTOT, D, D, D};
                    pg8::CtxOrder S{NLAT / 256, D / 256, CTX_TILES, bx_, cnt, F.lane == 0}; pg8::EpiBf16<0> E{(pg8::bf16_t*)(F.ws + WS_QP), D, nullptr, 0, 0};
                    pg8::gemm_phase<pg8::EpiBf16<0>, pg8::CtxOrder, false>(F.lds, g, S, E, nullptr, F.tid); }
                else { bool waited = false;
                    for (int u = bx_ - CTX_TILES; u < (MTOT / 64) * PE_H; u += F.G - CTX_TILES) { if (u >= (NLAT / 64) * PE_H && !waited) { ctx_wait(cnt, 8u * CTX_TILES); waited = true; } peer_topk_unit(F, l, u >> 3, u & 7); } } }
            else for (int u = F.vcu; u < (mrows / 64) * PE_H; u += F.G) peer_topk_unit(F, l, u >> 3, u & 7); }
        SEAM(pb + 7);
        if (PHM(11) && IN(pb + 8)) { LAUNDER(); for (int rep_ = 0; rep_ < NREP(11); ++rep_) { int dry_ = rep_ + 1 < NREP(11); if (NREP(11) > 1) asm volatile("" : "+s"(dry_)); peer_rows(F, l, mrows, dry_ != 0); } }
        if (l + 1 < DEPTH) SEAM(pb + 8);
    }
#undef IN
#undef SEAM
}

extern "C" void kernel_launch(void* const* d_in, const int* in_sizes, int n_in, void* d_out, int out_size, void* d_ws, size_t ws_size, hipStream_t stream) {
    static int grid = 0;
    if (grid == 0) {
        if (n_in != N_IN || out_size != NLAT * D || ws_size < WS_END) { fprintf(stderr, "kernel_launch: unexpected shapes (n_in %d, out %d, ws %zu < %zu)\n", n_in, out_size, ws_size, (size_t)WS_END); grid = -1; return; }
        int dev = 0, cus = 0, per_cu = 0;
        if (hipGetDevice(&dev) != hipSuccess || hipDeviceGetAttribute(&cus, hipDeviceAttributeMultiprocessorCount, dev) != hipSuccess) { grid = -1; return; }
        if (hipFuncSetAttribute((const void*)trunk_fwd, hipFuncAttributeMaxDynamicSharedMemorySize, LDS_BYTES) != hipSuccess) { fprintf(stderr, "kernel_launch: hipFuncSetAttribute failed\n"); grid = -1; return; }
        if (hipOccupancyMaxActiveBlocksPerMultiprocessor(&per_cu, (const void*)trunk_fwd, NTHR, LDS_BYTES) != hipSuccess || per_cu < 1) fprintf(stderr, "kernel_launch: occupancy query reports %d\n", per_cu);
        (void)hipGetLastError();
        grid = cus;
    }
    if (grid < 0) return;
    (void)hipMemsetAsync((char*)d_ws + WS_CTL, 0, CTL_ZERO_BYTES, stream);
    Args a{};
    for (int i = 0; i < N_IN; ++i) a.in[i] = (const float*)d_in[i];
    a.out = (float*)d_out; a.ws = (unsigned char*)d_ws;
#if MK_PER_PHASE
    for (int ph = 0; ph < NPHASES; ++ph) { a.ph_lo = ph; a.ph_hi = ph + 1; hipLaunchKernelGGL(trunk_fwd, dim3(grid), dim3(NTHR), LDS_BYTES, stream, a); }
#else
    a.ph_lo = 0; a.ph_hi = NPHASES;
    hipLaunchKernelGGL(trunk_fwd, dim3(grid), dim3(NTHR), LDS_BYTES, stream, a);
#endif
    const hipError_t le = hipPeekAtLastError();
    if (le != hipSuccess) fprintf(stderr, "kernel_launch: launch failed: %s\n", hipGetErrorName(le));
}
```

```cpp
#include <hip/hip_runtime.h>
#include <cstdio>
#include <cstdint>

constexpr int D = 2048, NB = 2, SEQ = 4096, DEPTH = 4, CTXL = 256;
constexpr int NLAT = NB * SEQ, NCTX = NB * CTXL, MTOT = NLAT + NCTX;
constexpr int LRW = 1024, RWW = 1024, NH = 16, HD = 64;
constexpr int RW_COLS = 3488, IN_COLS = 5536, IN_PAD = 5632;
constexpr int PE_H = 8, PE_K = 128, PE_DQ = 256, PE_TOP = 16, PE_NE = 16384, PE_SEL = PE_H * PE_TOP;
constexpr int NTILE = MTOT / 64;
constexpr float ALPHA = 1.681792830507429f;
constexpr float LN_EPS = 1e-5f, GN_EPS = 64e-5f;
constexpr int KSPLIT = 16;

enum { I_X = 0, I_C, I_CTX, I_CCTX, I_ADAW, I_ADAB, I_WIN, I_CONVW, I_CONVB, I_WA, I_BA, I_WX, I_BX, I_LAM, I_MU, I_W0, I_W2, I_A0, I_A2, I_G2,
       I_KK, I_KA, I_RK, I_GNG, I_GNB, I_WOUT, I_LN1G, I_LN1B, I_WQ, I_SUBK, I_U, I_V, I_LN2G, I_LN2B, N_IN };

constexpr size_t MiB = 1u << 20;
constexpr size_t al(size_t x) { return (x + MiB - 1) / MiB * MiB; }
constexpr size_t WS_CTL = 0, CTL_ZERO_BYTES = 1 * MiB;
constexpr size_t WS_MOD   = WS_CTL + CTL_ZERO_BYTES;
constexpr size_t WS_MODP  = al(WS_MOD + (size_t)DEPTH * 3 * 6 * D * 4);
constexpr size_t WS_WIN   = al(WS_MODP + (size_t)KSPLIT * DEPTH * 3 * 6 * D * 4);
constexpr size_t WS_WOUT  = al(WS_WIN + (size_t)DEPTH * IN_PAD * D * 2);
constexpr size_t WS_WQ    = al(WS_WOUT + (size_t)DEPTH * D * D * 2);
constexpr size_t WS_SUBK  = al(WS_WQ + (size_t)DEPTH * D * D * 2);
constexpr size_t WS_WLRU  = al(WS_SUBK + (size_t)DEPTH * 8 * 2 * 128 * 128 * 2);
constexpr size_t WS_W2T   = al(WS_WLRU + (size_t)DEPTH * 2 * 2 * 16 * 64 * 64 * 2);
constexpr size_t WS_A2T   = al(WS_W2T + (size_t)DEPTH * 2 * 1024 * 64 * 2);
constexpr size_t WS_G2T   = al(WS_A2T + (size_t)DEPTH * 2 * 1024 * 64 * 2);
constexpr size_t WS_UB    = al(WS_G2T + (size_t)DEPTH * 1024 * 160 * 2);
constexpr size_t WS_VB    = al(WS_UB + (size_t)DEPTH * PE_NE * D);
constexpr size_t WS_SU    = al(WS_VB + (size_t)DEPTH * PE_NE * D);
constexpr size_t WS_SV    = al(WS_SU + (size_t)DEPTH * PE_NE * 4);
constexpr size_t WS_X     = al(WS_SV + (size_t)DEPTH * PE_NE * 4);
constexpr size_t WS_H     = al(WS_X + (size_t)MTOT * D * 4);
constexpr size_t WS_P     = al(WS_H + (size_t)MTOT * D * 2);
constexpr size_t WS_LA    = al(WS_P + (size_t)MTOT * IN_PAD * 4);
constexpr size_t WS_LB    = al(WS_LA + (size_t)2 * MTOT * LRW * 4);
constexpr size_t WS_LAGG  = al(WS_LB + (size_t)2 * MTOT * LRW * 4);
constexpr size_t WS_LHIN  = al(WS_LAGG + (size_t)4 * NTILE * LRW * 4);
constexpr int KSL = 8;
constexpr size_t WS_SLAB  = al(WS_LHIN + (size_t)2 * NTILE * LRW * 4);
constexpr size_t WS_YL    = al(WS_SLAB + (size_t)2 * KSL * NCTX * D * 4);
constexpr int NUNIT = NTILE * NH * 2;
constexpr size_t WS_RV    = al(WS_YL + 4096);
constexpr size_t WS_QM    = al(WS_RV + (size_t)MTOT * RWW * 4);
constexpr size_t WS_PHI   = al(WS_QM + (size_t)NUNIT * 4096 * 2);
constexpr size_t WS_Y0F   = al(WS_PHI + (size_t)NUNIT * 4096 * 2);
constexpr size_t WS_PSF   = al(WS_Y0F + (size_t)NUNIT * 4096 * 2);
constexpr size_t WS_YR    = al(WS_PSF + (size_t)NUNIT * 4096 * 2);
constexpr size_t WS_BETA  = al(WS_YR + (size_t)2 * MTOT * RWW * 4);
constexpr size_t WS_IDX   = al(WS_BETA + (size_t)2 * MTOT * NH * 4);
constexpr size_t WS_GATE  = al(WS_IDX + (size_t)MTOT * PE_SEL * 4);
constexpr size_t WS_END   = al(WS_GATE + (size_t)MTOT * PE_SEL * 4);
constexpr size_t WS_O = WS_P;
constexpr size_t WS_QP = WS_P + (size_t)MTOT * D * 4;
static_assert(WS_QP + (size_t)MTOT * D * 4 <= WS_LA, "O/QP overlay inside P");

constexpr int CW_CTX = 16384, CTX_TILES = (NCTX / 256) * (D / 256);
constexpr int CW_BAR = 4096;

constexpr int RING_BYTES = 131072;
constexpr int LDSCTL_OFF = RING_BYTES, MISC_OFF = LDSCTL_OFF + 320;
constexpr int LDS_BYTES = 147456;
constexpr int NWAVES = 8, NTHR = 512;

#define GAS __attribute__((address_space(1)))
#define LAS __attribute__((address_space(3)))
typedef unsigned short bf16;
typedef unsigned v4u __attribute__((ext_vector_type(4)));
typedef unsigned v2u __attribute__((ext_vector_type(2)));
typedef float f32x4 __attribute__((ext_vector_type(4)));
typedef float f32x2 __attribute__((ext_vector_type(2)));
typedef short bf16x8 __attribute__((ext_vector_type(8)));
typedef unsigned v6u __attribute__((ext_vector_type(6)));
typedef unsigned v16u __attribute__((ext_vector_type(16)));
typedef float v32f __attribute__((ext_vector_type(32)));
typedef __bf16 v32bf __attribute__((ext_vector_type(32)));
constexpr int EROW = 1536;
#define RLX_AGENT __ATOMIC_RELAXED, __HIP_MEMORY_SCOPE_AGENT
#define LDS_WAIT() asm volatile("s_waitcnt lgkmcnt(0)" ::: "memory")
#define VM_WAIT() asm volatile("s_waitcnt vmcnt(0)" ::: "memory")

__device__ __forceinline__ const float* gin(const float* p) { return (const float*)(const GAS float*)p; }
__device__ __forceinline__ unsigned f2bf(float f) { unsigned u = __builtin_bit_cast(unsigned, f); return (u + 0x7fffu + ((u >> 16) & 1u)) >> 16; }
typedef __bf16 bf16x2t __attribute__((ext_vector_type(2)));
__device__ __forceinline__ unsigned pk2(float lo, float hi) { return __builtin_bit_cast(unsigned, __builtin_convertvector((f32x2){lo, hi}, bf16x2t)); }
__device__ __forceinline__ float bf_lo(unsigned w) { return __builtin_bit_cast(float, w << 16); }
__device__ __forceinline__ float bf_hi(unsigned w) { return __builtin_bit_cast(float, w & 0xffff0000u); }
__device__ __forceinline__ float fexp(float x) { return __builtin_amdgcn_exp2f(x * 1.4426950408889634f); }
__device__ __forceinline__ float fsigmoid(float x) { return __builtin_amdgcn_rcpf(1.0f + fexp(-x)); }
__device__ __forceinline__ float fsoftplus(float x) { return fmaxf(x, 0.f) + 0.6931471805599453f * __builtin_amdgcn_logf(1.0f + fexp(-fabsf(x))); }
__device__ __forceinline__ float ftanh(float x) { const float e = fexp(2.0f * x); return 1.0f - 2.0f * __builtin_amdgcn_rcpf(e + 1.0f); }
__device__ __forceinline__ float gelu_tanh(float x) { return 0.5f * x * (1.0f + ftanh(0.7978845608028654f * (x + 0.044715f * x * x * x))); }
__device__ __forceinline__ float gelu_erf(float v) {
    const float av = fabsf(v), t = __builtin_amdgcn_rcpf(av * 0.2316418882f + 1.0f);
    float q = t * 0.5307027145f + (-0.7265760135f); q = q * t + 0.7107068705f; q = q * t + (-0.142248368f); q = q * t + 0.127414796f; q = q * t;
    const float e = __builtin_amdgcn_exp2f((v * v) * (-0.72134752044f));
    const float m = v * (q * e);
    return v < 0.f ? m : v - m;
}
template <int CTRL> __device__ __forceinline__ float dpp_f(float v) { return __builtin_bit_cast(float, __builtin_amdgcn_update_dpp(0, __builtin_bit_cast(int, v), CTRL, 0xf, 0xf, true)); }
__device__ __forceinline__ float red8(float v) { v += dpp_f<0xB1>(v); v += dpp_f<0x4E>(v); v += dpp_f<0x141>(v); return v; }
__device__ __forceinline__ float red16(float v) { v = red8(v); v += dpp_f<0x140>(v); return v; }
__device__ __forceinline__ float wave_total(float v) {
    v = red16(v);
    v += __builtin_bit_cast(float, __builtin_amdgcn_update_dpp(0, __builtin_bit_cast(int, v), 0x142, 0xa, 0xf, false));
    v += __builtin_bit_cast(float, __builtin_amdgcn_update_dpp(0, __builtin_bit_cast(int, v), 0x143, 0xc, 0xf, false));
    return __builtin_bit_cast(float, __builtin_amdgcn_readlane(__builtin_bit_cast(int, v), 63));
}
__device__ __forceinline__ float wave_sum(float v) { return wave_total(v); }
__device__ __forceinline__ float wave_max(float v) {
    v = fmaxf(v, dpp_f<0xB1>(v)); v = fmaxf(v, dpp_f<0x4E>(v)); v = fmaxf(v, dpp_f<0x141>(v)); v = fmaxf(v, dpp_f<0x140>(v));
    const float a = __builtin_bit_cast(float, __builtin_amdgcn_readlane(__builtin_bit_cast(int, v), 0)), b = __builtin_bit_cast(float, __builtin_amdgcn_readlane(__builtin_bit_cast(int, v), 16));
    const float c = __builtin_bit_cast(float, __builtin_amdgcn_readlane(__builtin_bit_cast(int, v), 32)), d = __builtin_bit_cast(float, __builtin_amdgcn_readlane(__builtin_bit_cast(int, v), 48));
    return fmaxf(fmaxf(a, b), fmaxf(c, d));
}
#define EBU_ 4
#define XB_TMO      128
#define XB_XCNT(j)  (256  + 64 * (j))
#define XB_XSUB(j)  (1280 + 64 * (j))
#define XB_XGEN(j)  (2304 + 64 * (j))
#define XB_TOP      3328
#define XB_TOPGEN   3392
#define XCD_BAR_WORDS 3456
#define XB_SPIN_CAP (1u << 18)

__device__ __forceinline__ unsigned xb_ld(unsigned* p)              { return __hip_atomic_load(p, __ATOMIC_RELAXED, __HIP_MEMORY_SCOPE_AGENT); }
__device__ __forceinline__ unsigned xb_add(unsigned* p, unsigned v) { return __hip_atomic_fetch_add(p, v, __ATOMIC_RELAXED, __HIP_MEMORY_SCOPE_AGENT); }
__device__ __forceinline__ unsigned xb_xcc_id() { return (unsigned)__builtin_amdgcn_s_getreg((3 << 11) | 20) & 0xFu; }
#define XB_SPIN(cond, bar) do { unsigned _sp = 0; while (cond) { __builtin_amdgcn_s_sleep(1); \
    if ((++_sp & 255u) == 0u) { if (xb_ld(&(bar)[XB_TMO])) break; if (_sp > XB_SPIN_CAP) { atomicAdd(&(bar)[XB_TMO], 1u); break; } } } } while (0)

struct XcdBarrier {
    unsigned* bar; unsigned x;
    volatile LAS unsigned* st;
};

__device__ __forceinline__ XcdBarrier xcd_barrier_post(unsigned* bar, volatile LAS unsigned* st) {
    XcdBarrier b; b.bar = bar; b.x = xb_xcc_id(); b.st = st;
    if (threadIdx.x == 0) (void)xb_add(&bar[XB_XCNT(b.x)], 1u);
    return b;
}
__device__ __forceinline__ void xcd_barrier_complete(unsigned* bar, unsigned x, unsigned& nloc, unsigned& nx) {
    const unsigned G = gridDim.x * gridDim.y * gridDim.z;
    unsigned sum, cnt, mine, sp = 0u;
    for (;;) {
        sum = 0u; cnt = 0u; mine = 0u;
#pragma unroll
        for (unsigned j = 0; j < 16; ++j) { const unsigned c = xb_ld(&bar[XB_XCNT(j)]); sum += c; cnt += (c > 0u) ? 1u : 0u; }
        if (sum == G) { mine = xb_ld(&bar[XB_XCNT(x)]); break; }
        __builtin_amdgcn_s_sleep(1);
        if ((++sp & 255u) == 0u) { if (xb_ld(&bar[XB_TMO])) break; if (sp > XB_SPIN_CAP) { atomicAdd(&bar[XB_TMO], 1u); break; } }
    }
    nloc = mine > 0u ? mine : 1u; nx = cnt > 0u ? cnt : 1u;
}

__device__ __forceinline__ void xcd_barrier(const XcdBarrier& b) {
    asm volatile("s_waitcnt vmcnt(0)" ::: "memory");
    __syncthreads();
    if (threadIdx.x == 0) {
        unsigned* bar = b.bar;
        __builtin_amdgcn_s_waitcnt(0);
        unsigned nloc = b.st[0], nx = b.st[1];
        if (nloc == 0u) { xcd_barrier_complete(bar, b.x, nloc, nx); b.st[0] = nloc; b.st[1] = nx; }
        const unsigned old = xb_add(&bar[XB_XSUB(b.x)], 1u);
        const unsigned gen = old / nloc;
        if (old + 1u == (gen + 1u) * nloc) {
            __builtin_amdgcn_fence(__ATOMIC_RELEASE, "agent");
            asm volatile("s_waitcnt vmcnt(0)" ::: "memory");
            const unsigned og = xb_add(&bar[XB_TOP], 1u);
            const unsigned tg = og / nx;
            if (og + 1u == (tg + 1u) * nx) xb_add(&bar[XB_TOPGEN], 1u);
            else XB_SPIN(xb_ld(&bar[XB_TOPGEN]) == tg, bar);
            __builtin_amdgcn_fence(__ATOMIC_ACQUIRE, "agent");
            xb_add(&bar[XB_XGEN(b.x)], 1u);
            asm volatile("s_waitcnt vmcnt(0)" ::: "memory");
        } else {
            XB_SPIN(xb_ld(&bar[XB_XGEN(b.x)]) == gen, bar);
            __builtin_amdgcn_fence(__ATOMIC_ACQUIRE, "agent");
            asm volatile("s_waitcnt vmcnt(0)" ::: "memory");
        }
    }
    __syncthreads();
}
namespace pg8 {
#define PG8_LAS __attribute__((address_space(3)))
typedef unsigned short bf16_t;
typedef short bf16x8 __attribute__((ext_vector_type(8)));
typedef float f32x4 __attribute__((ext_vector_type(4)));
typedef unsigned u32x4 __attribute__((ext_vector_type(4)));
constexpr int BM = 256, BK = 64, HALF = 128, HTB = HALF * BK * 2  , STAGE_BYTES = 8 * HTB, NXCD = 8, WGM = 8;

__host__ __device__ __forceinline__ int lds_byte(int r, int c) { const int st = (r >> 4) * 2 + (c >> 5), rr = r & 15, cc = c & 31, ob = rr * 64 + cc * 2; return st * 1024 + (ob ^ (((ob >> 9) & 1) << 5)); }
__host__ __device__ __forceinline__ void stage_rc(int b, int& R, int& C) { const int st = b / 1024, sb = b % 1024, swz = sb ^ (((sb >> 9) & 1) << 5); R = (st >> 1) * 16 + swz / 64; C = (st & 1) * 32 + (swz % 64) / 2; }
__host__ __device__ __forceinline__ int perm32(int rho) { const int n = rho >> 4, i = rho & 15; return 8 * (i >> 2) + 4 * n + (i & 3); }

struct Unit { int pm, pn, kofs = 0, slab = 0; };
struct Gemm { const bf16_t* A; const bf16_t* Bt; int M, N, K, ld; };

struct StaticOrder {
    int nM, nN, nwg, G, c;
    __host__ __device__ void init(int M, int N, int G_, int c_) { nM = M / BM; nN = N / BM; nwg = nM * nN; G = G_; c = c_; }
    __host__ __device__ bool next(int i, Unit& u) const {
        const long L = (long)i * G + c; if (L >= nwg) return false;
        int wgid = (int)L; { const int q = nwg / NXCD, r = nwg % NXCD, xcd = wgid % NXCD, off = wgid / NXCD; wgid = (xcd < r ? xcd * (q + 1) : r * (q + 1) + (xcd - r) * q) + off; }
        const int nig = WGM * nN, gid = wgid / nig, fm = gid * WGM, gsz = (nM - fm) < WGM ? (nM - fm) : WGM;
        u.pm = fm + ((wgid % nig) % gsz); u.pn = (wgid % nig) / gsz; return true;
    }
    __device__ __forceinline__ void a_ready(const Unit&) const {}
    __device__ __forceinline__ void done(const Unit&) const {}
};
struct SplitKOrder {
    int nM, nN, nS, klen, G, c;
    __host__ __device__ void init(int M, int N, int nS_, int klen_, int G_, int c_) { nM = M / BM; nN = N / BM; nS = nS_; klen = klen_; G = G_; c = c_; }
    __host__ __device__ bool next(int i, Unit& u) const { const long L = (long)i * G + c; if (L >= (long)nM * nN * nS) return false; const int l = (int)L; u.pm = l % nM; u.pn = (l / nM) % nN; const int ks = l / (nM * nN); u.kofs = ks * klen; u.slab = ks; return true; }
    __device__ __forceinline__ void a_ready(const Unit&) const {}
    __device__ __forceinline__ void done(const Unit&) const {}
};
struct CtxOrder {
    int pm0, nN, nT, c; unsigned* cnt; bool lead; int nS = 1, klen = 0;
    __device__ bool next(int i, Unit& u) const { if (i != 0 || c >= nT * nS) return false; const int tl = c / nS, ks = c % nS; u.pm = pm0 + tl / nN; u.pn = tl % nN; u.kofs = ks * klen; u.slab = ks; return true; }
    __device__ __forceinline__ void a_ready(const Unit&) const {}
    __device__ __forceinline__ void done(const Unit&) const { __builtin_amdgcn_fence(__ATOMIC_RELEASE, "agent"); if (lead) __hip_atomic_fetch_add(cnt, 1u, __ATOMIC_RELAXED, __HIP_MEMORY_SCOPE_AGENT); }
};
struct CountedOrder : StaticOrder {
    const unsigned* ready; unsigned need; unsigned* tmo;
    __device__ __forceinline__ void a_ready(const Unit& u) const {
        if (threadIdx.x < 64) {
            const unsigned long long t0 = __builtin_amdgcn_s_memrealtime(); unsigned polls = 0;
            while ((unsigned)__builtin_amdgcn_readfirstlane(__hip_atomic_load(ready + 64 * u.pm, __ATOMIC_RELAXED, __HIP_MEMORY_SCOPE_AGENT)) < need) {
                if ((++polls & 255u) == 0u && __builtin_amdgcn_readfirstlane(__hip_atomic_load(tmo, __ATOMIC_RELAXED, __HIP_MEMORY_SCOPE_AGENT)) != 0u) break;
                if (__builtin_amdgcn_s_memrealtime() - t0 > 2000000ull) {
                    if (threadIdx.x == 0) { unsigned expect = 0u; __hip_atomic_compare_exchange_strong(tmo + 1, &expect, 0x600u | (unsigned)(u.pm & 0xff), __ATOMIC_RELAXED, __ATOMIC_RELAXED, __HIP_MEMORY_SCOPE_AGENT); __hip_atomic_store(tmo, 1u, __ATOMIC_RELAXED, __HIP_MEMORY_SCOPE_AGENT); }
                    break; }
                __builtin_amdgcn_s_sleep(2); }
            __builtin_amdgcn_fence(__ATOMIC_ACQUIRE, "agent");
            asm volatile("s_waitcnt vmcnt(0)" ::: "memory");
        }
#if !defined(BROKEN_HOOK_NO_BARRIER)
        asm volatile("" ::: "memory"); __builtin_amdgcn_s_barrier(); asm volatile("" ::: "memory");
#endif
    }
};

__device__ __forceinline__ unsigned cvt_pk_bf16(float lo, float hi) { unsigned r; asm volatile("v_cvt_pk_bf16_f32 %0, %1, %2" : "=v"(r) : "v"(lo), "v"(hi)); return r; }
typedef float f32x2 __attribute__((ext_vector_type(2)));
__device__ __forceinline__ f32x2 gelu_pk(f32x2 v) {
    const f32x2 av = __builtin_elementwise_abs(v), d = av * 0.2316418882f + 1.0f;
    f32x2 t; t.x = __builtin_amdgcn_rcpf(d.x); t.y = __builtin_amdgcn_rcpf(d.y);
    f32x2 q = t * 0.5307027145f + (-0.7265760135f); q = q * t + 0.7107068705f; q = q * t + (-0.142248368f); q = q * t + 0.127414796f; q = q * t;
    const f32x2 s = (v * v) * (-0.72134752044f);
    f32x2 e; e.x = __builtin_amdgcn_exp2f(s.x); e.y = __builtin_amdgcn_exp2f(s.y);
    const f32x2 m = v * (q * e), r = v - m;
    f32x2 o; o.x = v.x < 0.f ? m.x : r.x; o.y = v.y < 0.f ? m.y : r.y; return o;
}

struct EpiF32 {
    static constexpr bool PERM = false, AFTER_DRAIN = false;
    float* C; int ldc; const float* bias; size_t slab_stride = 0;
    __device__ __forceinline__ void operator()(const f32x4 (&acc)[2][2][4][2], const Unit& u, int wr, int wc, int fr, int fq) const {
        const int row0 = u.pm * BM + wr * 64 + fr, col0 = u.pn * BM + wc * 32 + 4 * fq; float* const Cb = C + (size_t)u.slab * slab_stride;
        f32x4 bv[2][2];
#pragma unroll
        for (int bj = 0; bj < 2; ++bj)
#pragma unroll
            for (int n = 0; n < 2; ++n) bv[bj][n] = bias ? *(const f32x4*)(bias + col0 + bj * HALF + n * 16) : (f32x4){0.f, 0.f, 0.f, 0.f};
#pragma unroll
        for (int ai = 0; ai < 2; ++ai)
#pragma unroll
            for (int m = 0; m < 4; ++m) { float* rowp = Cb + (size_t)(row0 + ai * HALF + m * 16) * ldc + col0;
#pragma unroll
                for (int bj = 0; bj < 2; ++bj)
#pragma unroll
                    for (int n = 0; n < 2; ++n) *(f32x4*)(rowp + bj * HALF + n * 16) = acc[ai][bj][m][n] + bv[bj][n]; }
    }
};
template <int ACT  > struct EpiBf16 {
    static constexpr bool PERM = true, AFTER_DRAIN = false;
    bf16_t* O; int ldc; const float* bias; int split_cols; size_t split_stride;
    __device__ __forceinline__ void operator()(const f32x4 (&acc)[2][2][4][2], const Unit& u, int wr, int wc, int fr, int fq) const {
        const int row0 = u.pm * BM + wr * 64 + fr; int colt = u.pn * BM; bf16_t* base = O;
        if (split_cols) { const int t = colt / split_cols; base += (size_t)t * split_stride; colt -= t * split_cols; }
        const int col0 = colt + wc * 32 + 8 * fq, bcol0 = u.pn * BM + wc * 32 + 8 * fq;
        f32x4 bv[2][2];
#pragma unroll
        for (int bj = 0; bj < 2; ++bj)
#pragma unroll
            for (int n = 0; n < 2; ++n) bv[bj][n] = bias ? *(const f32x4*)(bias + bcol0 + bj * HALF + 4 * n) : (f32x4){0.f, 0.f, 0.f, 0.f};
#pragma unroll
        for (int ai = 0; ai < 2; ++ai)
#pragma unroll
            for (int m = 0; m < 4; ++m) { bf16_t* rowp = base + (size_t)(row0 + ai * HALF + m * 16) * ldc + col0;
#pragma unroll
                for (int bj = 0; bj < 2; ++bj) { f32x4 v0 = acc[ai][bj][m][0] + bv[bj][0], v1 = acc[ai][bj][m][1] + bv[bj][1];
                    if (ACT == 1) { f32x2 a = gelu_pk((f32x2){v0[0], v0[1]}), b = gelu_pk((f32x2){v0[2], v0[3]}), c = gelu_pk((f32x2){v1[0], v1[1]}), d = gelu_pk((f32x2){v1[2], v1[3]});
                        v0 = (f32x4){a.x, a.y, b.x, b.y}; v1 = (f32x4){c.x, c.y, d.x, d.y}; }
                    if (ACT == 2) {
#pragma unroll
                        for (int j = 0; j < 4; ++j) { v0[j] = 0.5f * v0[j] * (1.0f + erff(v0[j] * 0.70710678f)); v1[j] = 0.5f * v1[j] * (1.0f + erff(v1[j] * 0.70710678f)); } }
                    u32x4 w; w.x = cvt_pk_bf16(v0[0], v0[1]); w.y = cvt_pk_bf16(v0[2], v0[3]); w.z = cvt_pk_bf16(v1[0], v1[1]); w.w = cvt_pk_bf16(v1[2], v1[3]);
                    *(u32x4*)(rowp + bj * HALF) = w; } }
    }
};
template <class Epi, class Sched, bool STAMP = false>
__device__ __forceinline__ void gemm_phase(PG8_LAS unsigned char* lds, const Gemm g, const Sched& S, const Epi& E, unsigned long long* stamps, const int tid) {
    const int  wid = __builtin_amdgcn_readfirstlane(tid >> 6), lane = tid & 63, wr = wid >> 2, wc = wid & 3, fr = lane & 15, fq = lane >> 4;
    const int K = g.ld, nt = g.K / BK;
    int ts_lo = 0, ts_hi = 0, nts = 0; const unsigned long long rt_entry = STAMP ? (unsigned long long)wall_clock64() : 0ull;
#define PG8_STAMP() do { if (STAMP && wid == 0 && nts < 64) { const unsigned long long _c = (unsigned long long)clock64(); \
        ts_lo = (lane == nts) ? (int)(unsigned)_c : ts_lo; ts_hi = (lane == nts) ? (int)(unsigned)(_c >> 32) : ts_hi; ++nts; } } while (0)
    PG8_STAMP();
    unsigned voffA[2], voffB[2];
#pragma unroll
    for (int i = 0; i < 2; ++i) { int R, C; stage_rc(tid * 16 + i * 8192, R, C); const int Rb = Epi::PERM ? ((R & ~31) + perm32(R & 31)) : R;
        voffA[i] = (unsigned)(R * K + C) * 2u; voffB[i] = (unsigned)(Rb * K + C) * 2u; }
    const size_t kstep = (size_t)(BK * 2);
    const size_t hstep = (size_t)HALF * K * 2;
    const size_t tstep = 2 * hstep;
    const unsigned ldsw = (unsigned)wid * 1024u;
    const int aoff = lds_byte(wr * 64 + fr, fq * 8), boff = lds_byte(wc * 32 + fr, fq * 8);
#define PG8_SA(b, h) (((b) * 2 + (h)) * HTB)
#define PG8_SB(b, h) ((4 + (b) * 2 + (h)) * HTB)
#define PG8_STAGE(bufoff, gbase, voff) do { _Pragma("unroll") for (int _i = 0; _i < 2; ++_i) \
        __builtin_amdgcn_global_load_lds((const unsigned*)((const char*)(gbase) + (voff)[_i]), (PG8_LAS unsigned*)(lds + (bufoff) + ldsw + _i * 8192), 16, 0, 0); } while (0)
#define PG8_LDA(dst, b, h) do { _Pragma("unroll") for (int m = 0; m < 4; ++m) _Pragma("unroll") for (int k = 0; k < 2; ++k) dst[m][k] = *(const PG8_LAS bf16x8*)(lds + PG8_SA(b, h) + aoff + m * 2048 + k * 1024); } while (0)
#define PG8_LDB(dst, b, h) do { _Pragma("unroll") for (int n = 0; n < 2; ++n) _Pragma("unroll") for (int k = 0; k < 2; ++k) dst[n][k] = *(const PG8_LAS bf16x8*)(lds + PG8_SB(b, h) + boff + n * 2048 + k * 1024); } while (0)
#define PG8_MMA(ai, bj, At, Bt) do { __builtin_amdgcn_s_setprio(1); _Pragma("unroll") for (int m = 0; m < 4; ++m) _Pragma("unroll") for (int n = 0; n < 2; ++n) _Pragma("unroll") for (int k = 0; k < 2; ++k) \
        acc[ai][bj][m][n] = __builtin_amdgcn_mfma_f32_16x16x32_bf16(Bt[n][k], At[m][k], acc[ai][bj][m][n], 0, 0, 0); __builtin_amdgcn_s_setprio(0); } while (0)
#define PG8_WAIT_V(n) asm volatile("s_waitcnt vmcnt(" #n ")" ::: "memory")
#define PG8_WAIT_L(n) asm volatile("s_waitcnt lgkmcnt(" #n ")" ::: "memory")
#define PG8_BAR __builtin_amdgcn_s_barrier()
#define PG8_SCHED __builtin_amdgcn_sched_barrier(0)
    Unit cur, nxt; int ui = 0;
    if (!S.next(0, cur)) return;
    f32x4 acc[2][2][4][2];
#pragma unroll
    for (int a = 0; a < 2; ++a)
#pragma unroll
        for (int b = 0; b < 2; ++b)
#pragma unroll
            for (int m = 0; m < 4; ++m)
#pragma unroll
                for (int n = 0; n < 2; ++n) acc[a][b][m][n] = (f32x4){0.f, 0.f, 0.f, 0.f};
    bf16x8 At[4][2], B0[2][2], B1[2][2];
    const char* cA = (const char*)g.A + (size_t)cur.pm * tstep + (size_t)cur.kofs * 2; const char* cB = (const char*)g.Bt + (size_t)cur.pn * tstep + (size_t)cur.kofs * 2;
    S.a_ready(cur);
    PG8_STAGE(PG8_SB(0, 0), cB, voffB); PG8_STAGE(PG8_SA(0, 0), cA, voffA); PG8_STAGE(PG8_SB(0, 1), cB + hstep, voffB); PG8_STAGE(PG8_SA(0, 1), cA + hstep, voffA);
    if (wr == 1) PG8_BAR;
    PG8_WAIT_V(4); PG8_BAR;
    PG8_STAGE(PG8_SB(1, 0), cB + kstep, voffB); PG8_STAGE(PG8_SA(1, 0), cA + kstep, voffA); PG8_STAGE(PG8_SB(1, 1), cB + hstep + kstep, voffB);
    PG8_WAIT_V(6); PG8_BAR;
    PG8_STAMP();
    for (;;) {
        const bool has_next = S.next(ui + 1, nxt);
        const char* nA = has_next ? (const char*)g.A + (size_t)nxt.pm * tstep + (size_t)nxt.kofs * 2 : cA; const char* nB = has_next ? (const char*)g.Bt + (size_t)nxt.pn * tstep + (size_t)nxt.kofs * 2 : cB;
        for (int t = 0; t < nt; t += 2) {
            const bool last = (t == nt - 2);
            const char* a1 = cA + (size_t)(t + 1) * kstep;
            const char* a2 = last ? nA : cA + (size_t)(t + 2) * kstep; const char* b2 = last ? nB : cB + (size_t)(t + 2) * kstep;
            const char* a3 = a2 + kstep; const char* b3 = b2 + kstep;
            if (last && has_next) S.a_ready(nxt);
            PG8_LDB(B0, 0, 0); PG8_SCHED; PG8_LDA(At, 0, 0); PG8_STAGE(PG8_SA(1, 1), a1 + hstep, voffA);
            PG8_WAIT_L(8); PG8_BAR; PG8_WAIT_L(0); PG8_MMA(0, 0, At, B0); PG8_BAR; PG8_SCHED;
            PG8_LDB(B1, 0, 1); PG8_STAGE(PG8_SB(0, 0), b2, voffB);
            PG8_BAR; PG8_WAIT_L(0); PG8_MMA(0, 1, At, B1); PG8_BAR;
            PG8_LDA(At, 0, 1); PG8_STAGE(PG8_SA(0, 0), a2, voffA);
            PG8_BAR; PG8_WAIT_L(0); PG8_MMA(1, 0, At, B0); PG8_BAR; PG8_SCHED;
            PG8_STAGE(PG8_SB(0, 1), b2 + hstep, voffB);
            PG8_WAIT_V(6); PG8_BAR; PG8_MMA(1, 1, At, B1); PG8_BAR;
            PG8_LDB(B0, 1, 0); PG8_SCHED; PG8_LDA(At, 1, 0); PG8_STAGE(PG8_SA(0, 1), a2 + hstep, voffA);
            PG8_WAIT_L(8); PG8_BAR; PG8_WAIT_L(0); PG8_MMA(0, 0, At, B0); PG8_BAR; PG8_SCHED;
            PG8_LDB(B1, 1, 1); PG8_STAGE(PG8_SB(1, 0), b3, voffB);
            PG8_BAR; PG8_WAIT_L(0); PG8_MMA(0, 1, At, B1); PG8_BAR;
            PG8_LDA(At, 1, 1); PG8_STAGE(PG8_SA(1, 0), a3, voffA);
            PG8_BAR; PG8_WAIT_L(0); PG8_MMA(1, 0, At, B0); PG8_BAR; PG8_SCHED;
            PG8_STAGE(PG8_SB(1, 1), b3 + hstep, voffB);
            PG8_WAIT_V(6); PG8_BAR; PG8_MMA(1, 1, At, B1); PG8_BAR;
        }
        PG8_STAMP();
        if constexpr (!Epi::AFTER_DRAIN) { E(acc, cur, wr, wc, fr, fq); S.done(cur); }
        PG8_STAMP();
        if (!has_next) break;
#pragma unroll
        for (int a = 0; a < 2; ++a)
#pragma unroll
            for (int b = 0; b < 2; ++b)
#pragma unroll
                for (int m = 0; m < 4; ++m)
#pragma unroll
                    for (int n = 0; n < 2; ++n) acc[a][b][m][n] = (f32x4){0.f, 0.f, 0.f, 0.f};
        cur = nxt; cA = nA; cB = nB; ++ui;
    }
    PG8_WAIT_V(0);
    if (wr == 0) PG8_BAR;
    PG8_BAR;
    if constexpr (Epi::AFTER_DRAIN) { E.fused(acc, cur, wr, wc, fr, fq, lds, wid, lane); S.done(cur); }
    PG8_STAMP();
    if (STAMP && wid == 0) { stamps[lane] = lane < nts ? (((unsigned long long)(unsigned)ts_hi << 32) | (unsigned)ts_lo) : 0ull;
        if (lane == 62) stamps[62] = rt_entry; if (lane == 63) stamps[63] = (unsigned long long)wall_clock64(); }
#undef PG8_STAMP
#undef PG8_SA
#undef PG8_SB
#undef PG8_STAGE
#undef PG8_LDA
#undef PG8_LDB
#undef PG8_MMA
#undef PG8_WAIT_V
#undef PG8_WAIT_L
#undef PG8_BAR
#undef PG8_SCHED
}
}
struct Args { const float* in[N_IN]; float* out; unsigned char* ws; int ph_lo, ph_hi; };
struct Frame {
    LAS unsigned char* lds;
    int tid, lane, wave, vcu, G;
    const float* const* in; GAS float* out; GAS unsigned char* ws;
};
using bf16x2v = __attribute__((ext_vector_type(2))) __bf16;
__device__ __forceinline__ float dot2bf(unsigned a, unsigned b, float acc) { return __builtin_amdgcn_fdot2_f32_bf16(__builtin_bit_cast(bf16x2v, a), __builtin_bit_cast(bf16x2v, b), acc, false); }

__device__ __forceinline__ void ld8bf(const bf16* p, float (&o)[8]) { const v4u w = *(const v4u*)p; o[0] = bf_lo(w.x); o[1] = bf_hi(w.x); o[2] = bf_lo(w.y); o[3] = bf_hi(w.y); o[4] = bf_lo(w.z); o[5] = bf_hi(w.z); o[6] = bf_lo(w.w); o[7] = bf_hi(w.w); }
struct TileInfo { int seq_base, seq_len, t0; };
__device__ __forceinline__ TileInfo tile_info(int c) {
    TileInfo ti;
    if (c < 128) { ti.seq_base = (c >> 6) * SEQ; ti.seq_len = SEQ; ti.t0 = (c & 63) * 64; }
    else { const int cc = c - 128; ti.seq_base = NLAT + (cc >> 2) * CTXL; ti.seq_len = CTXL; ti.t0 = (cc & 3) * 64; }
    return ti;
}
#define LDS_BAR() do { asm volatile("s_waitcnt lgkmcnt(0)" ::: "memory"); __builtin_amdgcn_s_barrier(); asm volatile("" ::: "memory"); } while (0)
__device__ __forceinline__ int mod_row(int row) { return row < NLAT ? (row >> 12) : 2; }
__device__ __forceinline__ bf16x8 frag_lds(const LAS bf16* base, int ld, int row0, int k0, int lane) { return *(const LAS bf16x8*)(base + (row0 + (lane & 15)) * ld + k0 + 8 * (lane >> 4)); }
__device__ __forceinline__ bf16x8 frag_g(const bf16* base, int ld, int row0, int k0, int lane) { return *(const bf16x8*)(base + (size_t)(row0 + (lane & 15)) * ld + k0 + 8 * (lane >> 4)); }
#define MFMA16(a, b, c) __builtin_amdgcn_mfma_f32_16x16x32_bf16((a), (b), (c), 0, 0, 0)

__device__ __forceinline__ void p0_transpose_item(const float* W, int K, int N, bf16* WT, LAS float* scr, int item, int lane) {
    const int nblk = N / 32, kb = item / nblk, nb = item % nblk, k0 = 64 * kb, n0 = 32 * nb;
#pragma unroll 8
    for (int i = 0; i < 32; ++i) { const int kk = 2 * i + (lane >> 5); scr[kk * 33 + (lane & 31)] = W[(size_t)(k0 + kk) * N + n0 + (lane & 31)]; }
    LDS_WAIT(); asm volatile("" ::: "memory");
    const int c = lane & 7;
#pragma unroll
    for (int j = 0; j < 4; ++j) { const int n = (lane >> 3) + 8 * j; const LAS float* s = scr + (8 * c) * 33 + n;
        v4u o; o.x = pk2(s[0 * 33], s[1 * 33]); o.y = pk2(s[2 * 33], s[3 * 33]); o.z = pk2(s[4 * 33], s[5 * 33]); o.w = pk2(s[6 * 33], s[7 * 33]);
        *(v4u*)(WT + (size_t)(n0 + n) * K + k0 + 8 * c) = o; }
    LDS_WAIT(); asm volatile("" ::: "memory");
}
__device__ __forceinline__ void conv_f32_bf16(const float* src, bf16* dst, size_t n8, size_t i0, size_t stride) {
    for (size_t i = i0; i < n8; i += stride) { const f32x4 a = *(const f32x4*)(src + i * 8), b = *(const f32x4*)(src + i * 8 + 4);
        v4u o; o.x = pk2(a.x, a.y); o.y = pk2(a.z, a.w); o.z = pk2(b.x, b.y); o.w = pk2(b.z, b.w); *(v4u*)(dst + i * 8) = o; }
}
__device__ __forceinline__ void convert_layer(Frame& F, int l, int w, int NW, LAS float* scr) {
    constexpr int IT_IN = (D / 64) * (IN_COLS / 32), IT_SQ = (D / 64) * (D / 32);
    for (int it = w; it < IT_IN + 2 * IT_SQ; it += NW) {
        int r = it;
        if (r < IT_IN) { p0_transpose_item(gin(F.in[I_WIN]) + (size_t)l * D * IN_COLS, D, IN_COLS, (bf16*)(F.ws + WS_WIN) + (size_t)l * IN_PAD * D, scr, r, F.lane); continue; }
        r -= IT_IN;
        if (r < IT_SQ) { p0_transpose_item(gin(F.in[I_WOUT]) + (size_t)l * D * D, D, D, (bf16*)(F.ws + WS_WOUT) + (size_t)l * D * D, scr, r, F.lane); continue; }
        r -= IT_SQ;
        p0_transpose_item(gin(F.in[I_WQ]) + (size_t)l * D * D, D, D, (bf16*)(F.ws + WS_WQ) + (size_t)l * D * D, scr, r, F.lane);
    }
    { constexpr int PADV = (IN_PAD - IN_COLS) * D / 8;
      for (int i = w * 64 + F.lane; i < PADV; i += NW * 64) *(v4u*)((bf16*)(F.ws + WS_WIN) + ((size_t)l * IN_PAD + IN_COLS) * D + (size_t)i * 8) = (v4u){0u, 0u, 0u, 0u}; }
    for (int it = w; it < 2 * PE_NE; it += NW) {
        const int tab = it >= PE_NE, r = l * PE_NE + (tab ? it - PE_NE : it); const float* src = gin(F.in[tab ? I_V : I_U]) + (size_t)r * D + F.lane * 4;
        f32x4 x[8]; float mx = 0.f;
#pragma unroll
        for (int i = 0; i < 8; ++i) { x[i] = __builtin_nontemporal_load((const f32x4*)(src + i * 256)); mx = fmaxf(mx, fmaxf(fmaxf(fabsf(x[i].x), fabsf(x[i].y)), fmaxf(fabsf(x[i].z), fabsf(x[i].w)))); }
        mx = wave_max(mx); const float sc = mx > 0.f ? mx * (1.0f / 7.5f) : 1.0f, inv = 1.0f / sc;
        v16u pk;
#pragma unroll
        for (int i = 0; i < 8; ++i) { pk[2 * i] = pk2(x[i].x * inv, x[i].y * inv); pk[2 * i + 1] = pk2(x[i].z * inv, x[i].w * inv); }
        const v6u q = __builtin_amdgcn_cvt_scalef32_pk32_fp6_bf16(__builtin_bit_cast(v32bf, pk), 1.0f);
        unsigned char* dst = (unsigned char*)(F.ws + (tab ? WS_VB : WS_UB)) + (size_t)r * EROW;
        *(v4u*)(dst + F.lane * 16) = (v4u){q[0], q[1], q[2], q[3]}; *(v2u*)(dst + 1024 + F.lane * 8) = (v2u){q[4], q[5]};
        if (F.lane == 0) ((float*)(F.ws + (tab ? WS_SV : WS_SU)))[r] = sc;
    }
}
__device__ __forceinline__ void p0_prologue(Frame& F) {
    LAS float* scr = (LAS float*)(F.lds + F.wave * 16384);
    const int gw = F.vcu * NWAVES + F.wave, NGW = F.G * NWAVES;
    const size_t gt = (size_t)F.vcu * NTHR + F.tid, NGT = (size_t)F.G * NTHR;
    for (int l = 0; l < DEPTH; ++l) convert_layer(F, l, gw, NGW, scr);
    { bf16* dst = (bf16*)(F.ws + WS_WLRU);
      for (size_t idx = gt; idx < (size_t)DEPTH * 2 * 2 * 16 * 64 * 64; idx += NGT) { const int i = (int)(idx & 63), j = (int)((idx >> 6) & 63), m = (int)(idx >> 12);
          const int hh = m & 15, d = (m >> 4) & 1, gate = (m >> 5) & 1, l = m >> 6; const float* src = gin(F.in[gate ? I_WX : I_WA]);
          dst[idx] = (bf16)f2bf(src[((size_t)((l * 2 + d) * 16 + hh) * 64 + i) * 64 + j]); } }
    { bf16* d2 = (bf16*)(F.ws + WS_W2T); bf16* da = (bf16*)(F.ws + WS_A2T);
      for (size_t idx = gt; idx < (size_t)DEPTH * 2 * 1024 * 64; idx += NGT) { const int k = (int)(idx & 63), c = (int)((idx >> 6) & 1023), ld = (int)(idx >> 16);
          d2[idx] = (bf16)f2bf(gin(F.in[I_W2])[((size_t)ld * 64 + k) * 1024 + c]); da[idx] = (bf16)f2bf(gin(F.in[I_A2])[((size_t)ld * 64 + k) * 1024 + c]); } }
    { bf16* dg = (bf16*)(F.ws + WS_G2T);
      for (size_t idx = gt; idx < (size_t)DEPTH * 1024 * 160; idx += NGT) { const int k = (int)(idx % 160), c = (int)((idx / 160) % 1024), l = (int)(idx / (160 * 1024));
          dg[idx] = (bf16)f2bf(gin(F.in[I_G2])[((size_t)l * 160 + k) * 1024 + c]); } }
    conv_f32_bf16(gin(F.in[I_SUBK]), (bf16*)(F.ws + WS_SUBK), (size_t)DEPTH * 8 * 2 * 128 * 128 / 8, gt, NGT);
    { bf16* X = (bf16*)(F.ws + WS_X);
      for (size_t i0 = gt; i0 < (size_t)MTOT * D / 4; i0 += 4 * NGT) { f32x4 v[4];
#pragma unroll
          for (int u = 0; u < 4; ++u) { const size_t i = i0 + (size_t)u * NGT; const int row = (int)(i / (D / 4)), e0 = (int)(i % (D / 4)) * 4;
              v[u] = i < (size_t)MTOT * D / 4 ? (row < NLAT ? *(const f32x4*)(gin(F.in[I_X]) + (size_t)row * D + e0) : *(const f32x4*)(gin(F.in[I_CTX]) + (size_t)(row - NLAT) * D + e0)) : (f32x4){0.f, 0.f, 0.f, 0.f}; }
#pragma unroll
          for (int u = 0; u < 4; ++u) { const size_t i = i0 + (size_t)u * NGT; if (i >= (size_t)MTOT * D / 4) continue; const int row = (int)(i / (D / 4)), e0 = (int)(i % (D / 4)) * 4;
              if (row < NLAT) { const int t = row & (SEQ - 1); const float pr = (float)(t >> 6), pc = (float)(t & 63); float o[4];
#pragma unroll
                  for (int j = 0; j < 4; ++j) { const int e = e0 + j, q = e >> 9, fi = e & 511; const float freq = __builtin_amdgcn_exp2f(-13.287712379549449f * (float)fi * (1.0f / 512.0f));
                      const float ang = ((q >> 1) ? pc : pr) * freq; float rev = ang * 0.15915494309189535f; rev -= floorf(rev);
                      o[j] = (q & 1) ? __builtin_amdgcn_cosf(rev) : __builtin_amdgcn_sinf(rev); }
                  v[u].x += o[0]; v[u].y += o[1]; v[u].z += o[2]; v[u].w += o[3]; }
              *(v2u*)(X + (size_t)row * D + e0) = (v2u){pk2(v[u].x, v[u].y), pk2(v[u].z, v[u].w)}; } } }
    { float* MODP = (float*)(F.ws + WS_MODP); const float* cin = gin(F.in[I_C]); const float* cctx = gin(F.in[I_CCTX]);
      for (int it = gw; it < DEPTH * KSPLIT * 48; it += NGW) { const int cg = it % 48, kp = (it / 48) % KSPLIT, l = it / (48 * KSPLIT); const int col = cg * 256 + F.lane * 4, k0 = kp * (D / KSPLIT);
          f32x4 a0 = {0.f, 0.f, 0.f, 0.f}, a1 = a0, a2 = a0; const float* wp = gin(F.in[I_ADAW]) + ((size_t)l * D + k0) * (6 * D) + col;
#pragma unroll 8
          for (int k = 0; k < D / KSPLIT; ++k) { const f32x4 w = *(const f32x4*)(wp + (size_t)k * (6 * D)); const float c0 = cin[k0 + k], c1 = cin[D + k0 + k], c2 = cctx[k0 + k];
              const float s0 = c0 * fsigmoid(c0), s1 = c1 * fsigmoid(c1), s2 = c2 * fsigmoid(c2); a0 += w * s0; a1 += w * s1; a2 += w * s2; }
          float* o = MODP + ((size_t)(kp * DEPTH + l) * 3) * (6 * D) + col; *(f32x4*)o = a0; *(f32x4*)(o + 6 * D) = a1; *(f32x4*)(o + 12 * D) = a2; } }
}
__device__ __forceinline__ void p0b_mod_reduce(Frame& F) {
    const size_t gt = (size_t)F.vcu * NTHR + F.tid, NGT = (size_t)F.G * NTHR; const float* MODP = (const float*)(F.ws + WS_MODP); float* MOD = (float*)(F.ws + WS_MOD);
    for (size_t i = gt; i < (size_t)DEPTH * 3 * 6 * D; i += NGT) { const int n = (int)(i % (6 * D)), l = (int)(i / (3 * 6 * D)); float s = gin(F.in[I_ADAB])[(size_t)l * 6 * D + n];
#pragma unroll
        for (int kp = 0; kp < KSPLIT; ++kp) s += MODP[(size_t)kp * DEPTH * 3 * 6 * D + i];
        MOD[i] = s; }
}
__device__ __forceinline__ void modulate_rows(Frame& F, int l, int which, int nrows) {
    LAS float* VL = (LAS float*)F.lds;
    for (int i = F.tid; i < 6 * (D / 4); i += NTHR) { const int vec = i / (D / 4), e = (i % (D / 4)) * 4;
        *(LAS f32x4*)(VL + vec * D + e) = *(const f32x4*)((const float*)(F.ws + WS_MOD) + ((size_t)l * 3 + vec / 2) * (6 * D) + which * 3 * D + (vec & 1) * D + e); }
    __syncthreads();
    const int gw = F.vcu * NWAVES + F.wave, NGW = F.G * NWAVES; const bf16* X = (const bf16*)(F.ws + WS_X); bf16* H = (bf16*)(F.ws + WS_H);
    for (int row = gw; row < nrows; row += NGW) { const LAS float* md = VL + mod_row(row) * 2 * D;
#pragma unroll
        for (int j = 0; j < 4; ++j) { const int e = j * 512 + F.lane * 8; const v4u xw = *(const v4u*)(X + (size_t)row * D + e); const f32x4 x0 = {bf_lo(xw.x), bf_hi(xw.x), bf_lo(xw.y), bf_hi(xw.y)}, x1 = {bf_lo(xw.z), bf_hi(xw.z), bf_lo(xw.w), bf_hi(xw.w)};
            const f32x4 s0 = *(const LAS f32x4*)(md + e), s1 = *(const LAS f32x4*)(md + e + 4), c0 = *(const LAS f32x4*)(md + D + e), c1 = *(const LAS f32x4*)(md + D + e + 4);
            const f32x4 y0 = x0 * (c0 + 1.0f) + s0, y1 = x1 * (c1 + 1.0f) + s1;
            v4u o; o.x = pk2(y0.x, y0.y); o.y = pk2(y0.z, y0.w); o.z = pk2(y1.x, y1.y); o.w = pk2(y1.z, y1.w); *(v4u*)(H + (size_t)row * D + e) = o; } }
}

__device__ __forceinline__ v4u lru_load_in(Frame& F, int tid, int c, int hh) {
    const TileInfo ti = tile_info(c); const bf16* P = (const bf16*)(F.ws + WS_P);
    const int r = tid >> 3, c8 = (tid & 7) * 8, t = ti.t0 - 2 + r; const int tc = t < 0 ? 0 : (t >= ti.seq_len ? ti.seq_len - 1 : t);
    return *(const v4u*)(P + (size_t)(ti.seq_base + tc) * IN_PAD + hh * 64 + c8);
}
__device__ __forceinline__ void lru_prep_unit(Frame& F, int l, int c, int hh, v4u& pre, v4u& pre2, bool have_in, int nu) {
    int tid = F.tid; asm volatile("" : "+v"(tid));
    const int lane = tid & 63, wave = F.wave;
    const TileInfo ti = tile_info(c); const bf16* P = (const bf16*)(F.ws + WS_P);
    if (!have_in) { pre = lru_load_in(F, tid, c, hh); pre2 = lru_load_in(F, tid < 24 ? tid + NTHR : tid, c, hh); }
    LAS float* Us = (LAS float*)F.lds; LAS float* XC = (LAS float*)(F.lds + 17408); LAS bf16* XCb = (LAS bf16*)(F.lds + 34304);
    LAS float* LAs = (LAS float*)(F.lds + 43520); LAS float* LBs = (LAS float*)(F.lds + 76288); LAS float* SEGA = (LAS float*)(F.lds + 109056); LAS float* SEGH = SEGA + 512;
    const float* cw = gin(F.in[I_CONVW]) + (size_t)l * 4 * LRW + hh * 64 + (tid & 63);
    const float w0 = cw[0], w1 = cw[LRW], w2 = cw[2 * LRW], w3 = cw[3 * LRW], cb = gin(F.in[I_CONVB])[(size_t)l * LRW + hh * 64 + (tid & 63)];
    float gba[4], gbx[4], glam[4];
#pragma unroll
    for (int n = 0; n < 4; ++n) { const size_t o_ = (size_t)(l * 2 + (wave >> 2)) * LRW + hh * 64 + 16 * n + (lane & 15); gba[n] = gin(F.in[I_BA])[o_]; gbx[n] = gin(F.in[I_BX])[o_]; glam[n] = gin(F.in[I_LAM])[o_]; }
#pragma unroll
    for (int k = 0; k < 2; ++k) { const int idx = tid + k * NTHR; if (idx < 67 * 8) { const int r = idx >> 3, c8 = (idx & 7) * 8, t = ti.t0 - 2 + r; const bool ok = t >= 0 && t < ti.seq_len;
        const v4u w = k ? pre2 : pre;
        *(LAS f32x4*)(Us + r * 64 + c8) = ok ? (f32x4){bf_lo(w.x), bf_hi(w.x), bf_lo(w.y), bf_hi(w.y)} : (f32x4){0.f, 0.f, 0.f, 0.f}; *(LAS f32x4*)(Us + r * 64 + c8 + 4) = ok ? (f32x4){bf_lo(w.z), bf_hi(w.z), bf_lo(w.w), bf_hi(w.w)} : (f32x4){0.f, 0.f, 0.f, 0.f}; } }
    if (nu >= 0) { pre = lru_load_in(F, tid, nu >> 4, nu & 15); pre2 = lru_load_in(F, tid < 24 ? tid + NTHR : tid, nu >> 4, nu & 15); }
    LDS_BAR();
    { const int ch = tid & 63;
#pragma unroll
      for (int k = 0; k < 8; ++k) { const int t = (tid >> 6) + 8 * k;
          const float v = cb + w0 * Us[t * 64 + ch] + w1 * Us[(t + 1) * 64 + ch] + w2 * Us[(t + 2) * 64 + ch] + w3 * Us[(t + 3) * 64 + ch];
          XC[t * 65 + ch] = v; XCb[t * 72 + ch] = (bf16)f2bf(v); } }
    LDS_BAR();
    { const int d = wave >> 2, m = wave & 3;
      const bf16x8 a0 = frag_lds(XCb, 72, 16 * m, 0, lane), a1 = frag_lds(XCb, 72, 16 * m, 32, lane);
      const bf16* Wa = (const bf16*)(F.ws + WS_WLRU) + (size_t)(((l * 2 + 0) * 2 + d) * 16 + hh) * 4096;
      const bf16* Wx = (const bf16*)(F.ws + WS_WLRU) + (size_t)(((l * 2 + 1) * 2 + d) * 16 + hh) * 4096;
#pragma unroll
      for (int n = 0; n < 4; ++n) {
          f32x4 ar = {0.f, 0.f, 0.f, 0.f}, ai = ar;
          ar = MFMA16(a0, frag_g(Wa, 64, 16 * n, 0, lane), ar); ar = MFMA16(a1, frag_g(Wa, 64, 16 * n, 32, lane), ar);
          ai = MFMA16(a0, frag_g(Wx, 64, 16 * n, 0, lane), ai); ai = MFMA16(a1, frag_g(Wx, 64, 16 * n, 32, lane), ai);
          const int col = 16 * n + (lane & 15), cg = hh * 64 + col;
          const float ba = gba[n], bx = gbx[n];
          const float sp = fsoftplus(-glam[n]);
#pragma unroll
          for (int r = 0; r < 4; ++r) { const int row = 16 * m + 4 * (lane >> 4) + r;
              const float rr = fsigmoid(ar[r] + ba), ii = fsigmoid(ai[r] + bx), loga = -8.0f * rr * sp, a = fexp(loga);
              const float bb = __builtin_amdgcn_sqrtf(fmaxf(1.0f - a * a, 0.f)) * ii * XC[row * 65 + col];
              LAs[(d * 64 + row) * 64 + col] = a; LBs[(d * 64 + row) * 64 + col] = bb; } } }
    LDS_BAR();
    { const int col = tid & 63, seg = (tid >> 6) & 3, d = tid >> 8, cg = hh * 64 + col; float hl[16], al[16]; float h = 0.f, A = 1.f;
#pragma unroll
      for (int i = 0; i < 16; ++i) { const int tau = 16 * seg + i, row = d ? 63 - tau : tau; const float a = LAs[(d * 64 + row) * 64 + col], b = LBs[(d * 64 + row) * 64 + col]; h = a * h + b; A *= a; hl[i] = h; al[i] = A; }
      SEGA[(d * 4 + seg) * 64 + col] = A; SEGH[(d * 4 + seg) * 64 + col] = h;
      LDS_BAR();
      float Hin = 0.f, Ain = 1.f;
#pragma unroll
      for (int s2 = 0; s2 < 3; ++s2) if (s2 < seg) { const float sa = SEGA[(d * 4 + s2) * 64 + col]; Hin = sa * Hin + SEGH[(d * 4 + s2) * 64 + col]; Ain *= sa; }
      bf16* HL = (bf16*)(F.ws + WS_LB) + (size_t)d * MTOT * LRW; bf16* AC = (bf16*)(F.ws + WS_LA) + (size_t)d * MTOT * LRW;
#pragma unroll
      for (int i = 0; i < 16; ++i) { const int tau = 16 * seg + i, row = d ? 63 - tau : tau; const size_t o = (size_t)(ti.seq_base + ti.t0 + row) * LRW + cg; HL[o] = (bf16)f2bf(hl[i] + al[i] * Hin); AC[o] = (bf16)f2bf(al[i] * Ain); }
      if (seg == 3) { float* AG = (float*)(F.ws + WS_LAGG); AG[((size_t)(0 * 2 + d) * NTILE + c) * LRW + cg] = al[15] * Ain; AG[((size_t)(1 * 2 + d) * NTILE + c) * LRW + cg] = hl[15] + al[15] * Hin; } }
    LDS_BAR();
}
__device__ __forceinline__ void shifted8(const bf16* P, size_t grow, bool hp, bool hn, const float* mu0, const float* mu1, int rc, float (&o)[8]) {
    const bf16* p = P + grow * IN_PAD + 2 * LRW + rc;
    float xs[8], ms[8], ns[8]; ld8bf(p, xs);
#pragma unroll
    for (int e = 0; e < 8; ++e) { ms[e] = 0.f; ns[e] = 0.f; }
    if (hp) ld8bf(p - IN_PAD, ms);
    if (hn) ld8bf(p + IN_PAD, ns);
    const f32x4 a0 = *(const f32x4*)(mu0 + rc), a1 = *(const f32x4*)(mu0 + rc + 4), b0 = *(const f32x4*)(mu1 + rc), b1 = *(const f32x4*)(mu1 + rc + 4);
    const float m0[8] = {a0.x, a0.y, a0.z, a0.w, a1.x, a1.y, a1.z, a1.w}, m1[8] = {b0.x, b0.y, b0.z, b0.w, b1.x, b1.y, b1.z, b1.w};
#pragma unroll
    for (int e = 0; e < 8; ++e) o[e] = xs[e] + m0[e] * (ms[e] - xs[e]) + m1[e] * (ns[e] - xs[e]);
}
constexpr int MB = 9216;
constexpr int MLD = 72;
#define MSLOT(k) ((LAS bf16*)(F.lds + (k) * MB))
__device__ __forceinline__ int prow(int c) { return (c & ~7) | ((c + (c >> 3)) & 7); }
__device__ __forceinline__ bf16x8 frag_lds_p(const LAS bf16* base, int ld, int row0, int k0, int lane) { return *(const LAS bf16x8*)(base + prow(row0 + (lane & 15)) * ld + k0 + 8 * (lane >> 4)); }
typedef short v4s16 __attribute__((ext_vector_type(4)));
__device__ __forceinline__ bf16x8 frag_tr(const LAS bf16* M, int ld, int c0, int k0, int lane) {
    const int il = lane & 15; const LAS bf16* p = M + (k0 + 8 * (lane >> 4) + (il >> 2)) * ld + c0 + 4 * (il & 3);
    const v4s16 a = __builtin_amdgcn_ds_read_tr16_b64_v4i16((LAS v4s16*)p), b = __builtin_amdgcn_ds_read_tr16_b64_v4i16((LAS v4s16*)(p + 4 * ld));
    return (bf16x8){a.x, a.y, a.z, a.w, b.x, b.y, b.z, b.w};
}
template <bool PY, bool PX> __device__ __forceinline__ f32x4 mm_tile_p(const LAS bf16* Y, int rt, const LAS bf16* X, int ct, f32x4 acc, int lane) {
    acc = MFMA16(PY ? frag_tr(Y, MLD, 16 * rt, 0, lane) : frag_lds(Y, MLD, 16 * rt, 0, lane), PX ? frag_tr(X, MLD, 16 * ct, 0, lane) : frag_lds(X, MLD, 16 * ct, 0, lane), acc);
    acc = MFMA16(PY ? frag_tr(Y, MLD, 16 * rt, 32, lane) : frag_lds(Y, MLD, 16 * rt, 32, lane), PX ? frag_tr(X, MLD, 16 * ct, 32, lane) : frag_lds(X, MLD, 16 * ct, 32, lane), acc);
    return acc;
}
__device__ __forceinline__ f32x4 mm_tile(const LAS bf16* Y, int rt, const LAS bf16* X, int ct, f32x4 acc, int lane) {
    acc = MFMA16(frag_lds(Y, MLD, 16 * rt, 0, lane), frag_lds(X, MLD, 16 * ct, 0, lane), acc);
    acc = MFMA16(frag_lds(Y, MLD, 16 * rt, 32, lane), frag_lds(X, MLD, 16 * ct, 32, lane), acc);
    return acc;
}
__device__ __forceinline__ void st_tile(LAS bf16* Dst, int rt, int ct, f32x4 acc, int lane) {
    v2u o; o.x = pk2(acc[0], acc[1]); o.y = pk2(acc[2], acc[3]);
    *(LAS v2u*)(Dst + (16 * ct + (lane & 15)) * MLD + 16 * rt + 4 * (lane >> 4)) = o;
}
__device__ __forceinline__ f32x4 ld_tile(const LAS bf16* Src, int rt, int ct, int lane) {
    const v2u o = *(const LAS v2u*)(Src + (16 * ct + (lane & 15)) * MLD + 16 * rt + 4 * (lane >> 4));
    return (f32x4){bf_lo(o.x), bf_hi(o.x), bf_lo(o.y), bf_hi(o.y)};
}
template <int MASK> __device__ __forceinline__ void mm64(LAS bf16* Dst, const LAS bf16* X, const LAS bf16* Y, int wave, int lane) {
    const int rt = wave >> 1;
#pragma unroll
    for (int q = 0; q < 2; ++q) { const int ct = 2 * (wave & 1) + q; f32x4 acc = {0.f, 0.f, 0.f, 0.f};
        acc = mm_tile(Y, rt, X, ct, acc, lane);
        if (MASK) { const int c = 16 * ct + (lane & 15);
#pragma unroll
            for (int g = 0; g < 4; ++g) { const int r = 16 * rt + 4 * (lane >> 4) + g; const bool keep = MASK == 1 ? (c > r) : MASK == 2 ? (r > c) : (c >= r); if (!keep) acc[g] = 0.f; } }
        st_tile(Dst, rt, ct, acc, lane); }
}
#ifndef CPROBE
#define CPROBE 0
#endif
struct RawS1 { v4u x[5][3]; };
template <int G0, int G1> __device__ __forceinline__ void load_raw(Frame& F, int c, int hh, int d, int tid, RawS1& raw) {
    const TileInfo ti = tile_info(c); const int t = tid >> 3, c8 = (tid & 7) * 8, tt = ti.t0 + t; const bool hp = tt > 0, hn = tt + 1 < ti.seq_len;
    const bf16* p0 = (const bf16*)(F.ws + WS_P) + (size_t)(ti.seq_base + tt) * IN_PAD + 2 * LRW + c8;
#pragma unroll
    for (int g = G0; g < G1; ++g) { const int rc = g < 3 ? g * RWW + hh * 64 : 3 * RWW + (g - 3) * 128 + d * 64; const bf16* p = p0 + rc;
        raw.x[g][0] = *(const v4u*)p; raw.x[g][1] = *(const v4u*)(p - (hp ? IN_PAD : 0)); raw.x[g][2] = *(const v4u*)(p + (hn ? IN_PAD : 0)); }
}
__device__ __forceinline__ void shift_raw(const v4u (&x)[3], const LAS float* mus, bool hp, bool hn, float (&o)[8]) {
    const f32x4 a0 = *(const LAS f32x4*)mus, a1 = *(const LAS f32x4*)(mus + 4), b0 = *(const LAS f32x4*)(mus + 64), b1 = *(const LAS f32x4*)(mus + 68);
    const float m0[8] = {a0.x, a0.y, a0.z, a0.w, a1.x, a1.y, a1.z, a1.w}, m1[8] = {b0.x, b0.y, b0.z, b0.w, b1.x, b1.y, b1.z, b1.w};
    const unsigned xw[4] = {x[0].x, x[0].y, x[0].z, x[0].w}, pw[4] = {x[1].x, x[1].y, x[1].z, x[1].w}, nw[4] = {x[2].x, x[2].y, x[2].z, x[2].w};
#pragma unroll
    for (int e = 0; e < 8; ++e) { const float xs = (e & 1) ? bf_hi(xw[e >> 1]) : bf_lo(xw[e >> 1]), ms = hp ? ((e & 1) ? bf_hi(pw[e >> 1]) : bf_lo(pw[e >> 1])) : 0.f, ns = hn ? ((e & 1) ? bf_hi(nw[e >> 1]) : bf_lo(nw[e >> 1])) : 0.f;
        o[e] = xs + m0[e] * (ms - xs) + m1[e] * (ns - xs); }
}
__device__ __forceinline__ void rwkv_chunk_prep(Frame& F, int l, int c, int hh, int d) {
    RawS1 raw;
    int tid = F.tid; asm volatile("" : "+v"(tid));
    const TileInfo ti = tile_info(c); const int lane = tid & 63, wave = F.wave;
    LAS bf16* TW = MSLOT(0); LAS bf16* AD = MSLOT(1);
    LAS float* CUM = (LAS float*)(F.lds + 8 * MB); LAS float* AVs = (LAS float*)(F.lds + 8 * MB + 16640);
    LAS float* CWL = (LAS float*)(F.lds + 13 * MB); LAS float* SEGT = (LAS float*)(F.lds + 13 * MB + 256); LAS float* MUS = (LAS float*)(F.lds + 125184);
    const int uidx = (c * NH + hh) * 2 + d;
    const int t = tid >> 3, c8 = (tid & 7) * 8, tt = ti.t0 + t; const size_t grow = (size_t)(ti.seq_base + tt); const bool hp = tt > 0, hn = tt + 1 < ti.seq_len;
    float rv[8], kv[8], vv[8], kk[8];
    load_raw<0, 5>(F, c, hh, d, tid, raw);
    float kkw[8];
    { const float* kp_ = gin(F.in[I_KK]) + (size_t)l * RWW + hh * 64 + c8; const f32x4 q0 = *(const f32x4*)kp_, q1 = *(const f32x4*)(kp_ + 4); kkw[0] = q0.x; kkw[1] = q0.y; kkw[2] = q0.z; kkw[3] = q0.w; kkw[4] = q1.x; kkw[5] = q1.y; kkw[6] = q1.z; kkw[7] = q1.w; }
    for (int rp_ = 0; rp_ < (CPROBE == 1 ? 2 : 1); ++rp_) {
    shift_raw(raw.x[0], MUS + 0 * 128 + c8, hp, hn, rv);
    shift_raw(raw.x[1], MUS + 1 * 128 + c8, hp, hn, kv);
    shift_raw(raw.x[2], MUS + 2 * 128 + c8, hp, hn, vv);
    { float ss = 0.f;
#pragma unroll
      for (int e = 0; e < 8; ++e) { kk[e] = kv[e] * kkw[e]; ss += kk[e] * kk[e]; }
      ss = red8(ss); const float inv = __builtin_amdgcn_rsqf(fmaxf(ss, 1e-24f));
#pragma unroll
      for (int e = 0; e < 8; ++e) kk[e] *= inv; }
    if (d == 0) { v4u o; o.x = pk2(vv[0], vv[1]); o.y = pk2(vv[2], vv[3]); o.z = pk2(vv[4], vv[5]); o.w = pk2(vv[6], vv[7]); *(v4u*)((bf16*)(F.ws + WS_RV) + grow * RWW + hh * 64 + c8) = o; }
    { float x[8]; v4u o;
      shift_raw(raw.x[3], MUS + 3 * 128 + c8, hp, hn, x);
      o.x = pk2(ftanh(x[0]), ftanh(x[1])); o.y = pk2(ftanh(x[2]), ftanh(x[3])); o.z = pk2(ftanh(x[4]), ftanh(x[5])); o.w = pk2(ftanh(x[6]), ftanh(x[7])); *(LAS v4u*)(TW + t * MLD + c8) = o;
      shift_raw(raw.x[4], MUS + 4 * 128 + c8, hp, hn, x);
      o.x = pk2(x[0], x[1]); o.y = pk2(x[2], x[3]); o.z = pk2(x[4], x[5]); o.w = pk2(x[6], x[7]); *(LAS v4u*)(AD + t * MLD + c8) = o; }
    asm volatile("" ::: "memory"); }
    bf16x8 w2f[2][2], a2f[2][2];
    { const bf16* W2 = (const bf16*)(F.ws + WS_W2T) + ((size_t)(l * 2 + d) * 1024 + hh * 64) * 64; const bf16* A2 = (const bf16*)(F.ws + WS_A2T) + ((size_t)(l * 2 + d) * 1024 + hh * 64) * 64;
#pragma unroll
      for (int q = 0; q < 2; ++q) { const int n = (wave >> 2) * 2 + q;
#pragma unroll
          for (int k = 0; k < 2; ++k) { w2f[q][k] = frag_g(W2, 64, 16 * n, 32 * k, lane); a2f[q][k] = frag_g(A2, 64, 16 * n, 32 * k, lane); } } }
    float kaw[8], rkw[8];
    { const float* kap = gin(F.in[I_KA]) + (size_t)l * RWW + hh * 64 + c8; const float* rkp = gin(F.in[I_RK]) + (size_t)l * RWW + hh * 64 + c8;
      const f32x4 k0 = *(const f32x4*)kap, k1 = *(const f32x4*)(kap + 4), r0 = *(const f32x4*)rkp, r1 = *(const f32x4*)(rkp + 4);
      kaw[0] = k0.x; kaw[1] = k0.y; kaw[2] = k0.z; kaw[3] = k0.w; kaw[4] = k1.x; kaw[5] = k1.y; kaw[6] = k1.z; kaw[7] = k1.w; rkw[0] = r0.x; rkw[1] = r0.y; rkw[2] = r0.z; rkw[3] = r0.w; rkw[4] = r1.x; rkw[5] = r1.y; rkw[6] = r1.z; rkw[7] = r1.w; }
    float w0v[2], a0v[2];
#pragma unroll
    for (int q = 0; q < 2; ++q) { const int cg = hh * 64 + 16 * ((wave >> 2) * 2 + q) + (lane & 15); w0v[q] = gin(F.in[I_W0])[(size_t)(l * 2 + d) * RWW + cg]; a0v[q] = gin(F.in[I_A0])[(size_t)(l * 2 + d) * RWW + cg]; }
    __syncthreads();
    for (int rp_ = 0; rp_ < (CPROBE == 2 ? 2 : 1); ++rp_) { const int m = wave & 3; const bf16x8 w0f = frag_lds(TW, MLD, 16 * m, 0, lane), w1f = frag_lds(TW, MLD, 16 * m, 32, lane), d0f = frag_lds(AD, MLD, 16 * m, 0, lane), d1f = frag_lds(AD, MLD, 16 * m, 32, lane);
#pragma unroll
      for (int q = 0; q < 2; ++q) { const int n = (wave >> 2) * 2 + q; f32x4 aw = {0.f, 0.f, 0.f, 0.f}, aa = aw;
          aw = MFMA16(w0f, w2f[q][0], aw); aw = MFMA16(w1f, w2f[q][1], aw);
          aa = MFMA16(d0f, a2f[q][0], aa); aa = MFMA16(d1f, a2f[q][1], aa);
          const int col = 16 * n + (lane & 15); const float w0 = w0v[q], a0 = a0v[q];
#pragma unroll
          for (int g = 0; g < 4; ++g) { const int row = 16 * m + 4 * (lane >> 4) + g; const float wlog = -fsoftplus(-(w0 + aw[g])) - 0.5f;
              CUM[row * 65 + col] = -fexp(wlog); AVs[row * 65 + col] = fsigmoid(a0 + aa[g]); } } }
    __syncthreads();
    { const int col = tid & 63, seg = tid >> 6; float pre[8]; float run = 0.f;
#pragma unroll
      for (int i = 0; i < 8; ++i) { const int tau = seg * 8 + i, tr = d ? 63 - tau : tau; run += CUM[tr * 65 + col]; pre[i] = run; }
      SEGT[seg * 64 + col] = run;
      __syncthreads();
      float off = 0.f;
#pragma unroll
      for (int s = 0; s < 8; ++s) if (s < seg) off += SEGT[s * 64 + col];
#pragma unroll
      for (int i = 0; i < 8; ++i) { const int tau = seg * 8 + i, tr = d ? 63 - tau : tau; CUM[tr * 65 + col] = off + pre[i]; }
      if (seg == 7) CWL[col] = fexp(off + pre[7]); }
    __syncthreads();
    for (int rp_ = 0; rp_ < (CPROBE == 3 ? 2 : 1); ++rp_) { const int tau = d ? 63 - t : t, tprev = d ? t + 1 : t - 1;
      LAS bf16* At = MSLOT(0); LAS bf16* Bt = MSLOT(2); LAS bf16* Kt = MSLOT(4); LAS bf16* Rt = MSLOT(6); LAS bf16* Vm = MSLOT(7);
      float bsum = 0.f; unsigned pa[4], pb[4], pk[4], pr[4];
#pragma unroll
      for (int e2 = 0; e2 < 4; ++e2) { float at2[2], bt2[2], kt2[2], rt2[2];
#pragma unroll
          for (int q = 0; q < 2; ++q) { const int e = 2 * e2 + q; const float cum = CUM[t * 65 + c8 + e], cumx = tau > 0 ? CUM[tprev * 65 + c8 + e] : 0.f, a = AVs[t * 65 + c8 + e];
              const float kd = kv[e] * (1.0f + (a - 1.0f) * kaw[e]), ex = fexp(cum), exm = fexp(-cum);
              at2[q] = -kk[e] * fexp(cumx); bt2[q] = kk[e] * a * exm; kt2[q] = kd * exm; rt2[q] = rv[e] * ex; bsum += rv[e] * kd * rkw[e];
              }
          pa[e2] = pk2(at2[0], at2[1]); pb[e2] = pk2(bt2[0], bt2[1]); pk[e2] = pk2(kt2[0], kt2[1]); pr[e2] = pk2(rt2[0], rt2[1]); }
      *(LAS v4u*)(At + tau * MLD + c8) = (v4u){pa[0], pa[1], pa[2], pa[3]}; *(LAS v4u*)(Bt + tau * MLD + c8) = (v4u){pb[0], pb[1], pb[2], pb[3]};
      *(LAS v4u*)(Kt + tau * MLD + c8) = (v4u){pk[0], pk[1], pk[2], pk[3]}; *(LAS v4u*)(Rt + tau * MLD + c8) = (v4u){pr[0], pr[1], pr[2], pr[3]};
      *(LAS v4u*)(Vm + tau * MLD + c8) = (v4u){pk2(vv[0], vv[1]), pk2(vv[2], vv[3]), pk2(vv[4], vv[5]), pk2(vv[6], vv[7])};
      bsum = red8(bsum);
      if ((tid & 7) == 0) ((float*)(F.ws + WS_BETA))[((size_t)d * MTOT + grow) * NH + hh] = bsum; }
    __syncthreads();
    LAS bf16* At = MSLOT(0); LAS bf16* Bt = MSLOT(2); LAS bf16* Kt = MSLOT(4); LAS bf16* Rt = MSLOT(6); LAS bf16* Vm = MSLOT(7);
    LAS bf16* Pm = MSLOT(8); LAS bf16* AkVT = MSLOT(9); LAS bf16* Gak = MSLOT(10); LAS bf16* Grb = MSLOT(11); LAS bf16* Grk = MSLOT(12);
    LAS bf16* TAT = MSLOT(1); LAS bf16* U0T = MSLOT(3); LAS bf16* TD = (LAS bf16*)(F.lds + 122112); constexpr int TDLD = 24;
    for (int rp_ = 0; rp_ < (CPROBE == 4 ? 2 : 1); ++rp_) {
    mm64<1>(Pm, At, Bt, wave, lane);
    __syncthreads();
    if (wave == 0) { const int blk = lane >> 4, cc = lane & 15; float tv[16];
#pragma unroll
        for (int r = 0; r < 16; ++r) { asm volatile("" ::: "memory"); const LAS bf16* ar = Pm + (16 * blk + r) * MLD + 16 * blk; const v4u q0 = *(const LAS v4u*)ar, q1 = *(const LAS v4u*)(ar + 8);
            const float av_[16] = {bf_lo(q0.x), bf_hi(q0.x), bf_lo(q0.y), bf_hi(q0.y), bf_lo(q0.z), bf_hi(q0.z), bf_lo(q0.w), bf_hi(q0.w), bf_lo(q1.x), bf_hi(q1.x), bf_lo(q1.y), bf_hi(q1.y), bf_lo(q1.z), bf_hi(q1.z), bf_lo(q1.w), bf_hi(q1.w)};
            float acc0 = (r == cc) ? 1.0f : 0.f, acc1 = 0.f;
#pragma unroll
            for (int m = 0; m < r; ++m) { if (m & 1) acc1 += av_[m] * tv[m]; else acc0 += av_[m] * tv[m]; }
            tv[r] = acc0 + acc1; }
#pragma unroll
        for (int r = 0; r < 16; ++r) TD[(16 * blk + r) * TDLD + cc] = (bf16)f2bf(tv[r]);
    } else {
#pragma unroll 1
        for (int q = wave - 1; q < 48; q += 7) { const int pr = q >> 4, tl = q & 15, rt = tl >> 2, ct = tl & 3;
            const LAS bf16* X = pr == 0 ? At : Rt; const LAS bf16* Y = pr == 1 ? Bt : Kt; LAS bf16* Dst = pr == 0 ? Gak : pr == 1 ? Grb : Grk;
            f32x4 acc = {0.f, 0.f, 0.f, 0.f}; acc = mm_tile(Y, rt, X, ct, acc, lane);
            const int cI = 16 * ct + (lane & 15);
#pragma unroll
            for (int g = 0; g < 4; ++g) { const int rI = 16 * rt + 4 * (lane >> 4) + g; const bool keep = pr == 0 ? (cI > rI) : (cI >= rI); if (!keep) acc[g] = 0.f; }
            st_tile(Dst, rt, ct, acc, lane); }
    }
    __syncthreads(); }
    { const int rt = wave >> 1;
#pragma unroll
      for (int q = 0; q < 2; ++q) { const int ct = 2 * (wave & 1) + q; f32x4 acc = {0.f, 0.f, 0.f, 0.f}; acc = mm_tile_p<false, true>(Gak, rt, Vm, ct, acc, lane); st_tile(AkVT, rt, ct, acc, lane); } }
    { const v4u z = {0u, 0u, 0u, 0u}; for (int i = tid; i < 64 * 8; i += NTHR) { const int row = i >> 3, c8_ = (i & 7) * 8; *(LAS v4u*)(TAT + row * MLD + c8_) = z; *(LAS v4u*)(U0T + row * MLD + c8_) = z; } }
    __syncthreads();
    for (int rp_ = 0; rp_ < (CPROBE == 5 ? 2 : 1); ++rp_)
#pragma unroll 1
    for (int bi = 0; bi < 4; ++bi) {
        const int g = lane >> 4, il = lane & 15, nt = wave & 3; LAS bf16* XT = (wave < 4) ? TAT : U0T;
        v2u rq;
        if (wave < 4) { const v4s16 a_ = __builtin_amdgcn_ds_read_tr16_b64_v4i16((LAS v4s16*)(At + (16 * bi + 4 * g + (il >> 2)) * MLD + 16 * nt + 4 * (il & 3))); rq = __builtin_bit_cast(v2u, a_); }
        else rq = *(const LAS v2u*)(AkVT + (16 * nt + il) * MLD + 16 * bi + 4 * g);
        f32x4 acc = {bf_lo(rq.x), bf_hi(rq.x), bf_lo(rq.y), bf_hi(rq.y)};
#pragma unroll
        for (int ks = 0; ks < 2; ++ks) if (32 * ks < 16 * bi) {
            bf16x8 af = frag_lds(Pm, MLD, 16 * bi, 32 * ks, lane); if (32 * ks + 8 * g >= 16 * bi) af = (bf16x8){0, 0, 0, 0, 0, 0, 0, 0};
            acc = MFMA16(af, frag_lds(XT, MLD, 16 * nt, 32 * ks, lane), acc); }
        v4u rb; rb.x = pk2(acc[0], acc[1]); rb.y = pk2(acc[2], acc[3]); rb.z = 0u; rb.w = 0u;
        const v2u tq = *(const LAS v2u*)(TD + (16 * bi + il) * TDLD + 4 * g); v4u tf; tf.x = tq.x; tf.y = tq.y; tf.z = 0u; tf.w = 0u;
        f32x4 xo = {0.f, 0.f, 0.f, 0.f}; xo = MFMA16(__builtin_bit_cast(bf16x8, tf), __builtin_bit_cast(bf16x8, rb), xo);
        v2u o; o.x = pk2(xo[0], xo[1]); o.y = pk2(xo[2], xo[3]); *(LAS v2u*)(XT + (16 * nt + il) * MLD + 16 * bi + 4 * g) = o;
        asm volatile("s_waitcnt lgkmcnt(0)" ::: "memory");
    }
    __syncthreads();
    for (int rp_ = 0; rp_ < (CPROBE == 6 ? 2 : 1); ++rp_) {
    {
      bf16* QMg = (bf16*)(F.ws + WS_QM) + (size_t)uidx * 4096; bf16* PHg = (bf16*)(F.ws + WS_PHI) + (size_t)uidx * 4096; const int rt = wave >> 1;
#pragma unroll
      for (int q = 0; q < 2; ++q) { const int ct = 2 * (wave & 1) + q; const int cidx = 16 * ct + (lane & 15), r0 = 16 * rt + 4 * (lane >> 4), qpos = 32 * (rt >> 1) + 8 * (lane >> 4) + 4 * (rt & 1);
          f32x4 acc = ld_tile(Rt, rt, ct, lane); acc = mm_tile(TAT, rt, Grb, ct, acc, lane);
          v2u o; o.x = pk2(acc[0], acc[1]); o.y = pk2(acc[2], acc[3]); *(v2u*)(QMg + cidx * 64 + qpos) = o;
          asm volatile("" ::: "memory");
          f32x4 ph = {0.f, 0.f, 0.f, 0.f}; ph = mm_tile_p<false, true>(TAT, rt, Bt, ct, ph, lane); const float cw = CWL[cidx];
#pragma unroll
          for (int g = 0; g < 4; ++g) ph[g] = cw * (ph[g] + ((r0 + g == cidx) ? 1.0f : 0.f));
          o.x = pk2(ph[0], ph[1]); o.y = pk2(ph[2], ph[3]); *(v2u*)(PHg + cidx * 64 + qpos) = o; } }
    {
      bf16* Y0g = (bf16*)(F.ws + WS_Y0F) + (size_t)uidx * 4096; bf16* PSg = (bf16*)(F.ws + WS_PSF) + (size_t)uidx * 4096; const int rt = wave >> 1;
#pragma unroll
      for (int q = 0; q < 2; ++q) { const int ct = 2 * (wave & 1) + q;
          asm volatile("" ::: "memory");
          f32x4 y0 = {0.f, 0.f, 0.f, 0.f}; y0 = mm_tile(U0T, rt, Grb, ct, y0, lane); asm volatile("" ::: "memory"); y0 = mm_tile_p<true, false>(Vm, rt, Grk, ct, y0, lane);
          { v2u w; w.x = pk2(y0[0], y0[1]); w.y = pk2(y0[2], y0[3]); *(v2u*)(Y0g + ((rt * 4 + ct) * 64 + lane) * 4) = w; }
          asm volatile("" ::: "memory");
          f32x4 ps = {0.f, 0.f, 0.f, 0.f}; ps = mm_tile_p<true, false>(Bt, rt, U0T, ct, ps, lane); asm volatile("" ::: "memory"); ps = mm_tile_p<true, true>(Kt, rt, Vm, ct, ps, lane);
#pragma unroll
          for (int g = 0; g < 4; ++g) ps[g] *= CWL[16 * rt + 4 * (lane >> 4) + g];
          { v2u w; w.x = pk2(ps[0], ps[1]); w.y = pk2(ps[2], ps[3]); *(v2u*)(PSg + ((ct * 4 + rt) * 64 + lane) * 4) = w; } } } }
    __syncthreads();
}
struct ChunkOps { bf16x8 f[4][2]; v2u c[4]; int tile; };
__device__ __forceinline__ void chunk_load(Frame& F, ChunkOps& o, int step, int b, int hh, int d, int sl, int role, int lane) {
    const int g = lane >> 4, il = lane & 15;
    step = step < 67 ? step : 67;
    const int cc = d ? 3 - step : step, lc = d ? 67 - step : step - 4; const int tile = step < 4 ? 128 + b * 4 + cc : b * 64 + lc;
    o.tile = tile;
    const size_t uidx = (size_t)(tile * NH + hh) * 2 + d;
    const bf16* Mg = (const bf16*)(F.ws + (role ? WS_QM : WS_PHI)) + uidx * 4096 + il * 64 + 8 * g; const bf16* Cg = (const bf16*)(F.ws + (role ? WS_Y0F : WS_PSF)) + uidx * 4096 + (sl * 4 * 64 + lane) * 4;
#pragma unroll
    for (int m = 0; m < 4; ++m) { o.f[m][0] = *(const bf16x8*)(Mg + m * 1024); o.f[m][1] = *(const bf16x8*)(Mg + m * 1024 + 32); o.c[m] = *(const v2u*)(Cg + m * 256); }
}
__device__ __forceinline__ void lru_scan(Frame& F, int idx) {
    const int ch = idx & 1023, b = (idx >> 10) & 1, d = idx >> 11;
    const float* AG = (const float*)(F.ws + WS_LAGG); float* HIN = (float*)(F.ws + WS_LHIN);
    float carry = 0.f;
#pragma unroll 1
    for (int g = 0; g < 2; ++g) { float av[34], hv[34];
#pragma unroll
        for (int i = 0; i < 34; ++i) { const int step = 34 * g + i; const int tile = step < 4 ? 128 + b * 4 + (d ? 3 - step : step) : b * 64 + (d ? 63 - (step - 4) : step - 4);
            av[i] = AG[((size_t)(0 * 2 + d) * NTILE + tile) * LRW + ch]; hv[i] = AG[((size_t)(1 * 2 + d) * NTILE + tile) * LRW + ch]; }
#pragma unroll
        for (int i = 0; i < 34; ++i) { const int step = 34 * g + i; const int tile = step < 4 ? 128 + b * 4 + (d ? 3 - step : step) : b * 64 + (d ? 63 - (step - 4) : step - 4);
            HIN[((size_t)d * NTILE + tile) * LRW + ch] = carry; carry = av[i] * carry + hv[i]; } }
}

__device__ __forceinline__ void chunk_apply(Frame& F, const ChunkOps& o, f32x4 (&S)[4], int step, bf16* YR, int hh, int d, int sl, int role, int lane) {
    const int g = lane >> 4, il = lane & 15; LAS v4u* XCH = (LAS v4u*)F.lds;
    bf16x8 bfr[2];
    if (role == 0) {
#pragma unroll
        for (int ks = 0; ks < 2; ++ks) { v4u w; w.x = pk2(S[2 * ks][0], S[2 * ks][1]); w.y = pk2(S[2 * ks][2], S[2 * ks][3]); w.z = pk2(S[2 * ks + 1][0], S[2 * ks + 1][1]); w.w = pk2(S[2 * ks + 1][2], S[2 * ks + 1][3]); bfr[ks] = __builtin_bit_cast(bf16x8, w); }
#pragma unroll
        for (int m = 0; m < 4; ++m) { f32x4 sn = (f32x4){bf_lo(o.c[m].x), bf_hi(o.c[m].x), bf_lo(o.c[m].y), bf_hi(o.c[m].y)}; sn = MFMA16(o.f[m][0], bfr[0], sn); sn = MFMA16(o.f[m][1], bfr[1], sn); S[m] = sn; }
#pragma unroll
        for (int ks = 0; ks < 2; ++ks) { v4u w; w.x = pk2(S[2 * ks][0], S[2 * ks][1]); w.y = pk2(S[2 * ks][2], S[2 * ks][3]); w.z = pk2(S[2 * ks + 1][0], S[2 * ks + 1][1]); w.w = pk2(S[2 * ks + 1][2], S[2 * ks + 1][3]);
            XCH[((((step + 1) & 1) * 4 + sl) * 2 + ks) * 64 + lane] = w; }
    } else {
#pragma unroll
        for (int ks = 0; ks < 2; ++ks) bfr[ks] = __builtin_bit_cast(bf16x8, XCH[(((step & 1) * 4 + sl) * 2 + ks) * 64 + lane]);
#pragma unroll
        for (int m = 0; m < 4; ++m) { f32x4 y = (f32x4){bf_lo(o.c[m].x), bf_hi(o.c[m].x), bf_lo(o.c[m].y), bf_hi(o.c[m].y)}; y = MFMA16(bfr[0], o.f[m][0], y); y = MFMA16(bfr[1], o.f[m][1], y);
            const int tau = 16 * m + il, tl = d ? 63 - tau : tau; v2u w; w.x = pk2(y[0], y[1]); w.y = pk2(y[2], y[3]);
            *(v2u*)(YR + (size_t)(o.tile * 64 + tl) * RWW + hh * 64 + sl * 16 + 4 * g) = w; }
    }
}
struct ChunkOp1 { bf16x8 f0, f1; v2u c; int tile; };
__device__ __forceinline__ void chunk_load1(Frame& F, ChunkOp1& o, int step, int b, int hh, int d, int sl, int role, int m, int lane) {
    const int g = lane >> 4, il = lane & 15;
    step = step < 67 ? step : 67;
    const int cc = d ? 3 - step : step, lc = d ? 67 - step : step - 4; const int tile = step < 4 ? 128 + b * 4 + cc : b * 64 + lc;
    o.tile = tile;
    const size_t uidx = (size_t)(tile * NH + hh) * 2 + d;
    const bf16* Mg = (const bf16*)(F.ws + (role ? WS_QM : WS_PHI)) + uidx * 4096 + il * 64 + 8 * g + m * 1024; const bf16* Cg = (const bf16*)(F.ws + (role ? WS_Y0F : WS_PSF)) + uidx * 4096 + (sl * 4 * 64 + lane) * 4 + m * 256;
    o.f0 = *(const bf16x8*)Mg; o.f1 = *(const bf16x8*)(Mg + 32); o.c = *(const v2u*)Cg;
}
__device__ __forceinline__ void chunk_step1(Frame& F, const ChunkOp1& o, int step, bf16* YR, int hh, int d, int sl, int role, int m, int lane) {
    const int g = lane >> 4, il = lane & 15; LAS v4u* XCH = (LAS v4u*)F.lds;
    const bf16x8 b0 = __builtin_bit_cast(bf16x8, XCH[((step & 1) * 2 + 0) * 64 + lane]), b1 = __builtin_bit_cast(bf16x8, XCH[((step & 1) * 2 + 1) * 64 + lane]);
    f32x4 a = (f32x4){bf_lo(o.c.x), bf_hi(o.c.x), bf_lo(o.c.y), bf_hi(o.c.y)};
    if (role == 0) { a = MFMA16(o.f0, b0, a); a = MFMA16(o.f1, b1, a);
        *(LAS v2u*)((LAS unsigned char*)(XCH + ((((step + 1) & 1) * 2 + (m >> 1)) * 64 + lane)) + 8 * (m & 1)) = (v2u){pk2(a[0], a[1]), pk2(a[2], a[3])}; }
    else { a = MFMA16(b0, o.f0, a); a = MFMA16(b1, o.f1, a);
        const int tau = 16 * m + il, tl = d ? 63 - tau : tau;
        *(v2u*)(YR + (size_t)(o.tile * 64 + tl) * RWW + hh * 64 + sl * 16 + 4 * g) = (v2u){pk2(a[0], a[1]), pk2(a[2], a[3])}; }
}
__device__ __forceinline__ void rwkv_chain_chunks(Frame& F, int item) {
    const int chain = item >> 2, sl = item & 3, d = chain & 1, hh = (chain >> 1) & 15, b = chain >> 5, role = F.wave >> 2, m = F.wave & 3, lane = F.lane;
    bf16* YR = (bf16*)(F.ws + WS_YR) + (size_t)d * MTOT * RWW;
    { LAS v4u* XCH = (LAS v4u*)F.lds; for (int i = F.tid; i < 2 * 2 * 64; i += NTHR) XCH[i] = (v4u){0u, 0u, 0u, 0u}; }
    __syncthreads();
    if (role == 0) __builtin_amdgcn_s_setprio(1);
    ChunkOp1 R0, R1, R2, R3, R4, R5, R6, R7;
#define CL(R_, s_) chunk_load1(F, R_, (s_), b, hh, d, sl, role, m, lane)
#define CS(R_, s_) do { chunk_step1(F, R_, (s_), YR, hh, d, sl, role, m, lane); LDS_BAR(); } while (0)
    CL(R0, 0); CL(R1, 1); CL(R2, 2); CL(R3, 3); CL(R4, 4); CL(R5, 5); CL(R6, 6);
#pragma unroll 1
    for (int step = 0; step < 64; step += 8) {
        CL(R7, step + 7); CS(R0, step);
        CL(R0, step + 8); CS(R1, step + 1);
        CL(R1, step + 9); CS(R2, step + 2);
        CL(R2, step + 10); CS(R3, step + 3);
        CL(R3, step + 11); CS(R4, step + 4);
        CL(R4, step + 12); CS(R5, step + 5);
        CL(R5, step + 13); CS(R6, step + 6);
        CL(R6, step + 14); CS(R7, step + 7); }
    CS(R0, 64); CS(R1, 65); CS(R2, 66); CS(R3, 67);
    __builtin_amdgcn_s_setprio(0);
#undef CL
#undef CS
}
__device__ __forceinline__ void merge_unit(Frame& F, int l, int uu) {
    const int u = uu % (4 * NTILE), half = uu / (4 * NTILE); const int c = u >> 2; const TileInfo ti = tile_info(c); const int t0 = ti.t0 + (u & 3) * 16; const bf16* P = (const bf16*)(F.ws + WS_P);
    LAS bf16* SG = (LAS bf16*)F.lds; LAS bf16* GO = (LAS bf16*)(F.lds + 10752);
    const float* mu0 = gin(F.in[I_MU]) + (size_t)l * 2 * RW_COLS; const float* mu1 = mu0 + RW_COLS;
    if (half == 1) {
    if (F.tid < 16 * 20) { const int t = F.tid / 20, k8 = (F.tid % 20) * 8, tt = t0 + t, rc = 3 * RWW + 256 + k8; const bf16* p = P + (size_t)(ti.seq_base + tt) * IN_PAD + 2 * LRW + rc;
        const f32x4 m00 = *(const f32x4*)(mu0 + rc), m01 = *(const f32x4*)(mu0 + rc + 4), m10 = *(const f32x4*)(mu1 + rc), m11 = *(const f32x4*)(mu1 + rc + 4);
        const v4u xr = *(const v4u*)p, xmr = *(const v4u*)(p - (tt > 0 ? IN_PAD : 0)), xnr = *(const v4u*)(p + (tt + 1 < ti.seq_len ? IN_PAD : 0));
        const float a0_[8] = {m00.x, m00.y, m00.z, m00.w, m01.x, m01.y, m01.z, m01.w}, a1_[8] = {m10.x, m10.y, m10.z, m10.w, m11.x, m11.y, m11.z, m11.w};
        const float x[8] = {bf_lo(xr.x), bf_hi(xr.x), bf_lo(xr.y), bf_hi(xr.y), bf_lo(xr.z), bf_hi(xr.z), bf_lo(xr.w), bf_hi(xr.w)}, xm[8] = {bf_lo(xmr.x), bf_hi(xmr.x), bf_lo(xmr.y), bf_hi(xmr.y), bf_lo(xmr.z), bf_hi(xmr.z), bf_lo(xmr.w), bf_hi(xmr.w)}, xn[8] = {bf_lo(xnr.x), bf_hi(xnr.x), bf_lo(xnr.y), bf_hi(xnr.y), bf_lo(xnr.z), bf_hi(xnr.z), bf_lo(xnr.w), bf_hi(xnr.w)}; float o[8];
#pragma unroll
        for (int e = 0; e < 8; ++e) { const float pm = tt > 0 ? xm[e] : 0.f, pn = tt + 1 < ti.seq_len ? xn[e] : 0.f; o[e] = fsigmoid(x[e] + a0_[e] * (pm - x[e]) + a1_[e] * (pn - x[e])); }
        v4u w; w.x = pk2(o[0], o[1]); w.y = pk2(o[2], o[3]); w.z = pk2(o[4], o[5]); w.w = pk2(o[6], o[7]); *(LAS v4u*)(SG + t * 168 + k8) = w; }
    __syncthreads();
    { const int lane = F.lane; const bf16* G2 = (const bf16*)(F.ws + WS_G2T) + (size_t)l * 1024 * 160;
      bf16x8 af[5];
#pragma unroll
      for (int k = 0; k < 5; ++k) af[k] = frag_lds(SG, 168, 0, 32 * k, lane);
#pragma unroll 1
      for (int nh = 0; nh < 2; ++nh) { bf16x8 bq[4][5];
#pragma unroll
          for (int n = 0; n < 4; ++n)
#pragma unroll
              for (int k = 0; k < 5; ++k) bq[n][k] = frag_g(G2, 160, F.wave * 128 + (4 * nh + n) * 16, 32 * k, lane);
#pragma unroll
          for (int n = 0; n < 4; ++n) { const int n0 = F.wave * 128 + (4 * nh + n) * 16; f32x4 a0 = {0.f, 0.f, 0.f, 0.f};
#pragma unroll
              for (int k = 0; k < 5; ++k) a0 = MFMA16(bq[n][k], af[k], a0);
              *(LAS v2u*)(GO + (lane & 15) * 1032 + n0 + 4 * (lane >> 4)) = (v2u){pk2(a0[0], a0[1]), pk2(a0[2], a0[3])}; } } }
    __syncthreads(); }
    { bf16* MRG = (bf16*)(F.ws + WS_H);
#pragma unroll 2
      for (int it = F.tid; it < 16 * 128; it += NTHR) { const int t = it >> 7, cgp = (it & 127) + 128 * half, tt = t0 + t; const size_t grow = (size_t)(ti.seq_base + tt);
          float o[8];
          if (cgp < 128) { const int ch = cgp * 8; float gq8[8]; ld8bf(P + grow * IN_PAD + LRW + ch, gq8); const f32x4 g0 = {gq8[0], gq8[1], gq8[2], gq8[3]}, g1 = {gq8[4], gq8[5], gq8[6], gq8[7]};
              const bf16* hl = (const bf16*)(F.ws + WS_LB) + grow * LRW + ch; const bf16* ac = (const bf16*)(F.ws + WS_LA) + grow * LRW + ch; const float* hi = (const float*)(F.ws + WS_LHIN) + (size_t)c * LRW + ch;
              float h0[8], c0[8], h1[8], c1[8]; ld8bf(hl, h0); ld8bf(ac, c0); ld8bf(hl + (size_t)MTOT * LRW, h1); ld8bf(ac + (size_t)MTOT * LRW, c1);
              const f32x4 i00 = *(const f32x4*)hi, i01 = *(const f32x4*)(hi + 4), i10 = *(const f32x4*)(hi + (size_t)NTILE * LRW), i11 = *(const f32x4*)(hi + (size_t)NTILE * LRW + 4);
              const f32x4 a0 = {h0[0] + c0[0] * i00.x + h1[0] + c1[0] * i10.x, h0[1] + c0[1] * i00.y + h1[1] + c1[1] * i10.y, h0[2] + c0[2] * i00.z + h1[2] + c1[2] * i10.z, h0[3] + c0[3] * i00.w + h1[3] + c1[3] * i10.w};
              const f32x4 a1 = {h0[4] + c0[4] * i01.x + h1[4] + c1[4] * i11.x, h0[5] + c0[5] * i01.y + h1[5] + c1[5] * i11.y, h0[6] + c0[6] * i01.z + h1[6] + c1[6] * i11.z, h0[7] + c0[7] * i01.w + h1[7] + c1[7] * i11.w};
              o[0] = gelu_tanh(g0.x) * a0.x; o[1] = gelu_tanh(g0.y) * a0.y; o[2] = gelu_tanh(g0.z) * a0.z; o[3] = gelu_tanh(g0.w) * a0.w;
              o[4] = gelu_tanh(g1.x) * a1.x; o[5] = gelu_tanh(g1.y) * a1.y; o[6] = gelu_tanh(g1.z) * a1.z; o[7] = gelu_tanh(g1.w) * a1.w; }
          else { const int ch = (cgp - 128) * 8, hh = ch >> 6; const bf16* yr = (const bf16*)(F.ws + WS_YR) + grow * RWW + ch;
              float ya[8], yb[8], va[8]; ld8bf(yr, ya); ld8bf(yr + (size_t)MTOT * RWW, yb); ld8bf((const bf16*)(F.ws + WS_RV) + grow * RWW + ch, va);
              float s1 = 0.f, q1 = 0.f;
#pragma unroll
              for (int e = 0; e < 8; ++e) { ya[e] += yb[e]; s1 += ya[e]; q1 += ya[e] * ya[e]; }
              s1 = red8(s1); q1 = red8(q1);
              const float mean = s1 * (1.0f / 64.0f), var = fmaxf(q1 * (1.0f / 64.0f) - mean * mean, 0.f); const f32x2 st = {mean, __builtin_amdgcn_rsqf(var + GN_EPS)};
              const float beta = ((const float*)(F.ws + WS_BETA))[grow * NH + hh] + ((const float*)(F.ws + WS_BETA))[((size_t)MTOT + grow) * NH + hh];
              const float* ggp = gin(F.in[I_GNG]) + (size_t)l * RWW + ch; const float* gbp = gin(F.in[I_GNB]) + (size_t)l * RWW + ch;
              const f32x4 gg0 = *(const f32x4*)ggp, gg1 = *(const f32x4*)(ggp + 4), gb0 = *(const f32x4*)gbp, gb1 = *(const f32x4*)(gbp + 4);
              const float gg[8] = {gg0.x, gg0.y, gg0.z, gg0.w, gg1.x, gg1.y, gg1.z, gg1.w}, gb[8] = {gb0.x, gb0.y, gb0.z, gb0.w, gb1.x, gb1.y, gb1.z, gb1.w};
              const v4u gq = *(const LAS v4u*)(GO + t * 1032 + ch); const float gv[8] = {bf_lo(gq.x), bf_hi(gq.x), bf_lo(gq.y), bf_hi(gq.y), bf_lo(gq.z), bf_hi(gq.z), bf_lo(gq.w), bf_hi(gq.w)};
#pragma unroll
              for (int e = 0; e < 8; ++e) o[e] = ((ya[e] - st.x) * st.y * gg[e] + gb[e] + beta * va[e]) * gv[e]; }
          v4u w; w.x = pk2(o[0], o[1]); w.y = pk2(o[2], o[3]); w.z = pk2(o[4], o[5]); w.w = pk2(o[6], o[7]);
          *(v4u*)(MRG + grow * D + cgp * 8) = w; } }
    __syncthreads();
}

__device__ __forceinline__ void ln_row(float (&z)[32], const float* g, const float* b, int lane) {
    float s = 0.f;
#pragma unroll
    for (int i = 0; i < 32; ++i) s += z[i];
    const float mean = wave_sum(s) * (1.0f / D); float q = 0.f;
#pragma unroll
    for (int i = 0; i < 32; ++i) { z[i] -= mean; q += z[i] * z[i]; }
    const float rstd = __builtin_amdgcn_rsqf(wave_sum(q) * (1.0f / D) + LN_EPS);
#pragma unroll
    for (int j = 0; j < 4; ++j) { const int e = j * 512 + lane * 8; const f32x4 g0 = *(const f32x4*)(g + e), g1 = *(const f32x4*)(g + e + 4), b0 = *(const f32x4*)(b + e), b1 = *(const f32x4*)(b + e + 4);
        const float gs[8] = {g0.x, g0.y, g0.z, g0.w, g1.x, g1.y, g1.z, g1.w}, bs[8] = {b0.x, b0.y, b0.z, b0.w, b1.x, b1.y, b1.z, b1.w};
#pragma unroll
        for (int i = 0; i < 8; ++i) z[j * 8 + i] = z[j * 8 + i] * rstd * gs[i] + bs[i]; }
}
__device__ __forceinline__ void load32(const float* p, int lane, float (&v)[32]) {
#pragma unroll
    for (int j = 0; j < 4; ++j) { const int e = j * 512 + lane * 8; const f32x4 a = *(const f32x4*)(p + e), b = *(const f32x4*)(p + e + 4);
        v[j * 8 + 0] = a.x; v[j * 8 + 1] = a.y; v[j * 8 + 2] = a.z; v[j * 8 + 3] = a.w; v[j * 8 + 4] = b.x; v[j * 8 + 5] = b.y; v[j * 8 + 6] = b.z; v[j * 8 + 7] = b.w; }
}
__device__ __forceinline__ void store32(float* p, int lane, const float (&v)[32]) {
#pragma unroll
    for (int j = 0; j < 4; ++j) { const int e = j * 512 + lane * 8; *(f32x4*)(p + e) = (f32x4){v[j * 8 + 0], v[j * 8 + 1], v[j * 8 + 2], v[j * 8 + 3]}; *(f32x4*)(p + e + 4) = (f32x4){v[j * 8 + 4], v[j * 8 + 5], v[j * 8 + 6], v[j * 8 + 7]}; }
}
__device__ __forceinline__ void store32_mod_bf16(bf16* p, const float* sh, const float* sc, int lane, const float (&v)[32]) {
#pragma unroll
    for (int j = 0; j < 4; ++j) { const int e = j * 512 + lane * 8; const f32x4 s0 = *(const f32x4*)(sh + e), s1 = *(const f32x4*)(sh + e + 4), c0 = *(const f32x4*)(sc + e), c1 = *(const f32x4*)(sc + e + 4);
        v4u o; o.x = pk2(v[j * 8 + 0] * (1.f + c0.x) + s0.x, v[j * 8 + 1] * (1.f + c0.y) + s0.y); o.y = pk2(v[j * 8 + 2] * (1.f + c0.z) + s0.z, v[j * 8 + 3] * (1.f + c0.w) + s0.w);
        o.z = pk2(v[j * 8 + 4] * (1.f + c1.x) + s1.x, v[j * 8 + 5] * (1.f + c1.y) + s1.y); o.w = pk2(v[j * 8 + 6] * (1.f + c1.z) + s1.z, v[j * 8 + 7] * (1.f + c1.w) + s1.w);
        *(v4u*)(p + e) = o; }
}
__device__ __forceinline__ void ctx_wait(const unsigned* cnt, unsigned need) {
    unsigned sp = 0;
    while ((unsigned)__builtin_amdgcn_readfirstlane((int)__hip_atomic_load(cnt, __ATOMIC_RELAXED, __HIP_MEMORY_SCOPE_AGENT)) < need) { __builtin_amdgcn_s_sleep(2); if (++sp > (1u << 20)) break; }
    __builtin_amdgcn_fence(__ATOMIC_ACQUIRE, "agent");
}
__device__ __forceinline__ void load32_l(const LAS float* p, int lane, float (&v)[32]) {
#pragma unroll
    for (int j = 0; j < 4; ++j) { const int e = j * 512 + lane * 8; const f32x4 a = *(const LAS f32x4*)(p + e), b = *(const LAS f32x4*)(p + e + 4);
        v[j * 8 + 0] = a.x; v[j * 8 + 1] = a.y; v[j * 8 + 2] = a.z; v[j * 8 + 3] = a.w; v[j * 8 + 4] = b.x; v[j * 8 + 5] = b.y; v[j * 8 + 6] = b.z; v[j * 8 + 7] = b.w; }
}
__device__ __forceinline__ void ln1_rows(Frame& F, int l, int nrows, bool dry = false, const unsigned* cnt = nullptr, unsigned need = 0, const bf16* slab1 = nullptr) {
    bool waited = false;
    LAS float* VL = (LAS float*)F.lds;
    for (int i = F.tid; i < 11 * (D / 4); i += NTHR) { const int vec = i / (D / 4), e = (i % (D / 4)) * 4;
        const float* src = vec < 9 ? (const float*)(F.ws + WS_MOD) + ((size_t)l * 3 + vec / 3) * (6 * D) + (2 + vec % 3) * D : gin(F.in[vec == 9 ? I_LN1G : I_LN1B]) + (size_t)l * D;
        *(LAS f32x4*)(VL + vec * D + e) = *(const f32x4*)(src + e); }
    __syncthreads();
    const int gw = F.vcu * NWAVES + F.wave, NGW = F.G * NWAVES; bf16* X = (bf16*)(F.ws + WS_X); bf16* H = (bf16*)(F.ws + WS_H);
    bf16* Xo = dry ? (bf16*)(F.ws + WS_LA) : X; bf16* Ho = dry ? (bf16*)(F.ws + WS_LB) : H;
    for (int row = gw; row < nrows; row += NGW) { const LAS float* mv = VL + mod_row(row) * 3 * D;
        if (cnt && row >= NLAT && !waited) { ctx_wait(cnt, need); waited = true; }
        float z[32], o[32], gt[32]; load32_l(mv, F.lane, gt);
#pragma unroll
        for (int j = 0; j < 4; ++j) { float t8[8]; ld8bf(X + (size_t)row * D + j * 512 + F.lane * 8, t8);
#pragma unroll
            for (int i = 0; i < 8; ++i) z[j * 8 + i] = t8[i]; }
#pragma unroll
        for (int j = 0; j < 4; ++j) { float t8[8]; ld8bf((const bf16*)(F.ws + WS_O) + (size_t)row * D + j * 512 + F.lane * 8, t8);
#pragma unroll
            for (int i = 0; i < 8; ++i) o[j * 8 + i] = t8[i]; }
        if (slab1 && row >= NLAT) {
#pragma unroll
            for (int j = 0; j < 4; ++j) { float t8[8]; ld8bf(slab1 + (size_t)(row - NLAT) * D + j * 512 + F.lane * 8, t8);
#pragma unroll
                for (int i = 0; i < 8; ++i) o[j * 8 + i] += t8[i]; } }
#pragma unroll
        for (int i = 0; i < 32; ++i) z[i] = ALPHA * z[i] + gt[i] * o[i];
        { float s = 0.f;
#pragma unroll
          for (int i = 0; i < 32; ++i) s += z[i];
          const float mean = wave_sum(s) * (1.0f / D); float q = 0.f;
#pragma unroll
          for (int i = 0; i < 32; ++i) { z[i] -= mean; q += z[i] * z[i]; }
          const float rstd = __builtin_amdgcn_rsqf(wave_sum(q) * (1.0f / D) + LN_EPS);
          float gs[32], bs[32]; load32_l(VL + 9 * D, F.lane, gs); load32_l(VL + 10 * D, F.lane, bs);
#pragma unroll
          for (int i = 0; i < 32; ++i) z[i] = z[i] * rstd * gs[i] + bs[i]; }
#pragma unroll
        for (int j = 0; j < 4; ++j) *(v4u*)(Xo + (size_t)row * D + j * 512 + F.lane * 8) = (v4u){pk2(z[j * 8 + 0], z[j * 8 + 1]), pk2(z[j * 8 + 2], z[j * 8 + 3]), pk2(z[j * 8 + 4], z[j * 8 + 5]), pk2(z[j * 8 + 6], z[j * 8 + 7])};
        { float sh[32], sc[32]; load32_l(mv + D, F.lane, sh); load32_l(mv + 2 * D, F.lane, sc);
#pragma unroll
          for (int j = 0; j < 4; ++j) { const int e = j * 512 + F.lane * 8; v4u o4;
              o4.x = pk2(z[j * 8 + 0] * (1.f + sc[j * 8 + 0]) + sh[j * 8 + 0], z[j * 8 + 1] * (1.f + sc[j * 8 + 1]) + sh[j * 8 + 1]); o4.y = pk2(z[j * 8 + 2] * (1.f + sc[j * 8 + 2]) + sh[j * 8 + 2], z[j * 8 + 3] * (1.f + sc[j * 8 + 3]) + sh[j * 8 + 3]);
              o4.z = pk2(z[j * 8 + 4] * (1.f + sc[j * 8 + 4]) + sh[j * 8 + 4], z[j * 8 + 5] * (1.f + sc[j * 8 + 5]) + sh[j * 8 + 5]); o4.w = pk2(z[j * 8 + 6] * (1.f + sc[j * 8 + 6]) + sh[j * 8 + 6], z[j * 8 + 7] * (1.f + sc[j * 8 + 7]) + sh[j * 8 + 7]);
              *(v4u*)(Ho + (size_t)row * D + e) = o4; } } }
}

__device__ __forceinline__ unsigned ord_key(float s, int k) { unsigned u = __builtin_bit_cast(unsigned, s); u = (u & 0x80000000u) ? ~u : (u | 0x80000000u); return (u & ~127u) | (unsigned)(127 - k); }
__device__ __forceinline__ float key_score(unsigned key) { const unsigned u = key & ~127u; return __builtin_bit_cast(float, (u & 0x80000000u) ? (u ^ 0x80000000u) : ~u); }
__device__ __forceinline__ void bitonic_top16(unsigned (&A)[16], const unsigned (&B)[16]) {
#pragma unroll
    for (int i = 0; i < 16; ++i) A[i] = A[i] > B[15 - i] ? A[i] : B[15 - i];
#pragma unroll
    for (int st = 8; st >= 1; st >>= 1)
#pragma unroll
        for (int i = 0; i < 16; ++i) if (!(i & st)) { const unsigned hi = A[i] > A[i + st] ? A[i] : A[i + st], lo = A[i] > A[i + st] ? A[i + st] : A[i]; A[i] = hi; A[i + st] = lo; }
}
__device__ __forceinline__ void sort16_desc(unsigned (&A)[16]) {
#pragma unroll
    for (int k = 2; k <= 16; k <<= 1)
#pragma unroll
        for (int j = k >> 1; j >= 1; j >>= 1)
#pragma unroll
            for (int i = 0; i < 16; ++i) { const int p = i ^ j; if (p > i) { const unsigned hi = A[i] > A[p] ? A[i] : A[p], lo = A[i] > A[p] ? A[p] : A[i]; const bool desc = (i & k) == 0; A[i] = desc ? hi : lo; A[p] = desc ? lo : hi; } }
}
__device__ __forceinline__ void sort8_desc(unsigned (&A)[8]) {
#pragma unroll
    for (int k = 2; k <= 8; k <<= 1)
#pragma unroll
        for (int j = k >> 1; j >= 1; j >>= 1)
#pragma unroll
            for (int i = 0; i < 8; ++i) { const int p = i ^ j; if (p > i) { const unsigned hi = A[i] > A[p] ? A[i] : A[p], lo = A[i] > A[p] ? A[p] : A[i]; const bool desc = (i & k) == 0; A[i] = desc ? hi : lo; A[p] = desc ? lo : hi; } }
}
__device__ __forceinline__ void ins16(unsigned (&L)[16], unsigned x) {
#pragma unroll
    for (int i = 0; i < 16; ++i) { const unsigned hi = L[i] > x ? L[i] : x; x = L[i] > x ? x : L[i]; L[i] = hi; }
}
__device__ __forceinline__ unsigned ord_key8(float s, unsigned tag) { unsigned u = __builtin_bit_cast(unsigned, s); u = (u & 0x80000000u) ? ~u : (u | 0x80000000u); return (u & ~255u) | tag; }
__device__ __forceinline__ float key_score8(unsigned key) { const unsigned u = key & ~255u; return __builtin_bit_cast(float, (u & 0x80000000u) ? (u ^ 0x80000000u) : ~u); }
__device__ __forceinline__ void peer_topk_unit(Frame& F, int l, int tile, int h) {
    int tid = F.tid; asm volatile("" : "+v"(tid));
    const int lane = tid & 63, wave = F.wave;
    LAS bf16* AQ = (LAS bf16*)F.lds; LAS float* SC = (LAS float*)(F.lds + 33792);
    LAS unsigned* bufA = (LAS unsigned*)F.lds; LAS unsigned* bufB = (LAS unsigned*)(F.lds + 33792); LAS unsigned* FIN = (LAS unsigned*)(F.lds + 66560); LAS unsigned char* PAIRT = (LAS unsigned char*)(F.lds + 99584);
    if (tid < 50) { int c = tid, i = 0; for (; i < 16; ++i) { const int n = 16 / (i + 1); if (c < n) break; c -= n; } PAIRT[tid] = (unsigned char)(i * 16 + c); }
    for (int idx = tid; idx < 64 * 32; idx += NTHR) { const int t = idx >> 5, c8 = (idx & 31) * 8; *(LAS v4u*)(AQ + t * 264 + c8) = *(const v4u*)((const bf16*)(F.ws + WS_QP) + (size_t)(tile * 64 + t) * D + h * 256 + c8); }
    __syncthreads();
    { const bf16* SK = (const bf16*)(F.ws + WS_SUBK) + (size_t)((l * 8 + h) * 2) * 128 * 128;
#pragma unroll
      for (int p = 0; p < 2; ++p) { bf16x8 bfr[4];
#pragma unroll
          for (int k = 0; k < 4; ++k) bfr[k] = frag_g(SK + (size_t)p * 128 * 128, 128, 16 * wave, 32 * k, lane);
#pragma unroll
          for (int m = 0; m < 4; ++m) { f32x4 acc = {0.f, 0.f, 0.f, 0.f};
#pragma unroll
              for (int k = 0; k < 4; ++k) acc = MFMA16(frag_lds(AQ, 264, 16 * m, p * 128 + 32 * k, lane), bfr[k], acc);
#pragma unroll
              for (int r = 0; r < 4; ++r) SC[(16 * m + 4 * (lane >> 4) + r) * 257 + p * 128 + 16 * wave + (lane & 15)] = acc[r]; } } }
    __syncthreads();
    const int t = lane, r = wave, p = r & 1, qd = r >> 1;
    unsigned L[16], B[16];
    { const LAS float* sp = SC + t * 257 + p * 128 + 32 * qd;
#pragma unroll
      for (int k = 0; k < 16; ++k) { L[k] = ord_key(sp[k], 32 * qd + k); B[k] = ord_key(sp[16 + k], 32 * qd + 16 + k); }
      sort16_desc(L); sort16_desc(B); bitonic_top16(L, B); }
#pragma unroll
    for (int i = 0; i < 16; ++i) bufA[(r * 16 + i) * 64 + t] = L[i];
    __syncthreads();
#pragma unroll
    for (int i = 0; i < 16; ++i) B[i] = bufA[((r ^ 2) * 16 + i) * 64 + t];
    bitonic_top16(L, B);
#pragma unroll
    for (int i = 0; i < 16; ++i) bufB[(r * 16 + i) * 64 + t] = L[i];
    __syncthreads();
#pragma unroll
    for (int i = 0; i < 16; ++i) B[i] = bufB[((r ^ 4) * 16 + i) * 64 + t];
    bitonic_top16(L, B);
    if (qd == 0) {
#pragma unroll
        for (int i = 0; i < 16; ++i) FIN[(p * 16 + i) * 64 + t] = L[i]; }
    __syncthreads();
    { unsigned K8[8];
#pragma unroll
      for (int q = 0; q < 7; ++q) { const int c = q * 8 + r; unsigned key = 0u; if (c < 50) { const unsigned pr = PAIRT[c]; const unsigned ka = FIN[(0 * 16 + (pr >> 4)) * 64 + t], kb = FIN[(1 * 16 + (pr & 15)) * 64 + t];
              key = ord_key8(key_score(ka) + key_score(kb), pr); } K8[q] = key; }
      K8[7] = 0u; sort8_desc(K8);
#pragma unroll
      for (int i = 0; i < 8; ++i) { L[i] = K8[i]; L[8 + i] = 0u; } }
#pragma unroll
    for (int i = 0; i < 16; ++i) bufB[(r * 16 + i) * 64 + t] = L[i];
    __syncthreads();
#pragma unroll
    for (int i = 0; i < 16; ++i) B[i] = bufB[((r ^ 1) * 16 + i) * 64 + t];
    bitonic_top16(L, B);
#pragma unroll
    for (int i = 0; i < 16; ++i) bufA[(r * 16 + i) * 64 + t] = L[i];
    __syncthreads();
#pragma unroll
    for (int i = 0; i < 16; ++i) B[i] = bufA[((r ^ 2) * 16 + i) * 64 + t];
    bitonic_top16(L, B);
    __syncthreads();
#pragma unroll
    for (int i = 0; i < 16; ++i) bufB[(r * 16 + i) * 64 + t] = L[i];
    __syncthreads();
#pragma unroll
    for (int i = 0; i < 16; ++i) B[i] = bufB[((r ^ 4) * 16 + i) * 64 + t];
    bitonic_top16(L, B);
    { const float mx = key_score8(L[0]); float sum = 0.f, e0 = 0.f, e1 = 0.f; unsigned k0 = 0u, k1 = 0u;
#pragma unroll
      for (int i = 0; i < 16; ++i) { const float e = fexp(key_score8(L[i]) - mx); sum += e; if (i == 2 * r) { e0 = e; k0 = L[i]; } if (i == 2 * r + 1) { e1 = e; k1 = L[i]; } }
      const float inv = __builtin_amdgcn_rcpf(sum);
      const unsigned pa = k0 & 255u, pb = k1 & 255u;
      const int id0 = (127 - (int)(FIN[(0 * 16 + (pa >> 4)) * 64 + t] & 127u)) * 128 + (127 - (int)(FIN[(1 * 16 + (pa & 15)) * 64 + t] & 127u));
      const int id1 = (127 - (int)(FIN[(0 * 16 + (pb >> 4)) * 64 + t] & 127u)) * 128 + (127 - (int)(FIN[(1 * 16 + (pb & 15)) * 64 + t] & 127u));
      int* IDX = (int*)(F.ws + WS_IDX) + (size_t)(tile * 64 + t) * PE_SEL + h * 16 + 2 * r; float* GT = (float*)(F.ws + WS_GATE) + (size_t)(tile * 64 + t) * PE_SEL + h * 16 + 2 * r;
      *(int2*)IDX = make_int2(id0, id1); *(f32x2*)GT = (f32x2){e0 * inv, e1 * inv}; }
    __syncthreads();
}

#ifndef GPROBE
#define GPROBE 0
#endif
#ifndef GPROBE_MASK
#define GPROBE_MASK (~0u)
#endif
#ifndef EBU_
#define EBU_ 8
#endif
#ifndef EBV_
#define EBV_ 8
#endif
constexpr int EB = 8;
__device__ __forceinline__ v32f ld_row6(const unsigned char* row, int lane) {
    const v4u a = *(const v4u*)(row + lane * 16); const v2u b = *(const v2u*)(row + 1024 + lane * 8);
    return __builtin_amdgcn_cvt_scalef32_pk32_f32_fp6((v6u){a.x, a.y, a.z, a.w, b.x, b.y}, 1.0f);
}
#define SCHED_FENCE() __builtin_amdgcn_sched_barrier(0)
template <int EB> __device__ __forceinline__ void ld_rows(__amdgpu_buffer_rsrc_t TB, unsigned tbo, int sel, int k0, unsigned lo16, unsigned emask, v6u (&w)[EB]) {
#pragma unroll
    for (int q = 0; q < EB; ++q) { const unsigned e = (unsigned)__builtin_amdgcn_readlane(sel, (k0 + q) & 63) & emask;
        const v4u a = __builtin_bit_cast(v4u, __builtin_amdgcn_raw_buffer_load_b128(TB, lo16, e * (unsigned)EROW + tbo, 0));
        const v2u b = __builtin_bit_cast(v2u, __builtin_amdgcn_raw_buffer_load_b64(TB, (lo16 >> 1) + 1024u, e * (unsigned)EROW + tbo, 0));
        w[q] = (v6u){a.x, a.y, a.z, a.w, b.x, b.y}; }
}
typedef float f32p __attribute__((ext_vector_type(2)));
template <int EB> __device__ __forceinline__ void u_batch(const v4u (&wa)[EB], const v2u (&wb)[EB], const f32p (&hf)[16], int k0, int lane, LAS float* dots) {
    static_assert(EB == 4, "the transposing reduction below takes four experts at a time");
    float s4[4];
#pragma unroll
    for (int q = 0; q < EB; ++q) { const v32f uf = __builtin_amdgcn_cvt_scalef32_pk32_f32_fp6((v6u){wa[q].x, wa[q].y, wa[q].z, wa[q].w, wb[q].x, wb[q].y}, 1.0f);
        f32p p0 = {0.f, 0.f}, p1 = {0.f, 0.f};
#pragma unroll
        for (int i = 0; i < 16; i += 2) { p0 = __builtin_elementwise_fma((f32p){uf[2 * i], uf[2 * i + 1]}, hf[i], p0); p1 = __builtin_elementwise_fma((f32p){uf[2 * i + 2], uf[2 * i + 3]}, hf[i + 1], p1); }
        p0 += p1; s4[q] = p0.x + p0.y; }
    const bool b0 = lane & 1, b1 = lane & 2;
    const float t0 = s4[0] + dpp_f<0xB1>(s4[0]), t1 = s4[1] + dpp_f<0xB1>(s4[1]), t2 = s4[2] + dpp_f<0xB1>(s4[2]), t3 = s4[3] + dpp_f<0xB1>(s4[3]);
    const float r01 = b0 ? t1 : t0, r23 = b0 ? t3 : t2;
    const float w0 = r01 + dpp_f<0x4E>(r01), w1 = r23 + dpp_f<0x4E>(r23);
    float r = b1 ? w1 : w0;
    r += dpp_f<0x124>(r); r += dpp_f<0x128>(r);
    dots[k0 >> 2] = r;
}
template <int EB> __device__ __forceinline__ void v_batch(const v6u (&w)[EB], int k0, float csel, f32p (&acc)[16]) {
#pragma unroll
    for (int q = 0; q < EB; ++q) { const float cf = __builtin_bit_cast(float, __builtin_amdgcn_readlane(__builtin_bit_cast(int, csel), (k0 + q) & 63));
        const v32f vf = __builtin_amdgcn_cvt_scalef32_pk32_f32_fp6(w[q], 1.0f);
        const f32p c2 = {cf, cf};
#pragma unroll
        for (int i = 0; i < 16; ++i) acc[i] = __builtin_elementwise_fma((f32p){vf[2 * i], vf[2 * i + 1]}, c2, acc[i]); }
}
struct PeerTok { int il, ih; float gl, gh; v2u h2[8]; };
__device__ __forceinline__ void peer_tok_load(Frame& F, int row, PeerTok& t) {
    const int lane = F.lane; const int* IDX = (const int*)(F.ws + WS_IDX) + (size_t)row * PE_SEL; const float* GT = (const float*)(F.ws + WS_GATE) + (size_t)row * PE_SEL; const bf16* H = (const bf16*)(F.ws + WS_H);
    t.il = IDX[lane]; t.ih = IDX[64 + lane]; t.gl = GT[lane]; t.gh = GT[64 + lane];
#pragma unroll
    for (int q = 0; q < 8; ++q) t.h2[q] = *(const v2u*)(H + (size_t)row * D + q * 256 + lane * 4);
}
typedef int v8i __attribute__((ext_vector_type(8)));
template <int NEG> __device__ __forceinline__ float u_dots_mfma(Frame& F, __amdgpu_buffer_rsrc_t TB, int il, int ih, int kb, unsigned emask, const f32p (&hf)[16], LAS unsigned char* hb, LAS float* dotsT, const float* SU, const float* SV, float (&sc)[4], int nrow = -1, PeerTok* nxt = nullptr) {
    const int lane = F.lane, n = lane & 15, g = lane >> 4, c = lane & 3, ep = (lane >> 2) & 3;
    float am = 0.f;
#pragma unroll
    for (int i = 0; i < 16; ++i) am = fmaxf(am, fmaxf(fabsf(hf[i].x), fabsf(hf[i].y)));
    am = wave_max(am); const float sh = am > 0.f ? 7.5f / am : 1.0f;
    { v16u pk;
#pragma unroll
      for (int i = 0; i < 16; ++i) pk[i] = pk2(hf[i].x * sh, hf[i].y * sh);
      const v6u hq = __builtin_amdgcn_cvt_scalef32_pk32_fp6_bf16(__builtin_bit_cast(v32bf, pk), 1.0f);
      const v32f back = __builtin_amdgcn_cvt_scalef32_pk32_f32_fp6(hq, 1.0f);
#pragma unroll
      for (int i = 0; i < 16; ++i) pk[i] = pk2((hf[i].x * sh - back[2 * i]) * 16.0f, (hf[i].y * sh - back[2 * i + 1]) * 16.0f);
      const v6u rq = __builtin_amdgcn_cvt_scalef32_pk32_fp6_bf16(__builtin_bit_cast(v32bf, pk), 1.0f);
      LAS v2u* w0 = (LAS v2u*)(hb + lane * 24); LAS v2u* w1 = (LAS v2u*)(hb + 1536 + lane * 24);
      w0[0] = (v2u){hq[0], hq[1]}; w0[1] = (v2u){hq[2], hq[3]}; w0[2] = (v2u){hq[4], hq[5]};
      w1[0] = (v2u){rq[0], rq[1]}; w1[1] = (v2u){rq[2], rq[3]}; w1[2] = (v2u){rq[4], rq[5]}; }
    asm volatile("" ::: "memory");
    v8i bv[4];
#pragma unroll
    for (int s4 = 0; s4 < 4; ++s4) { const LAS v2u* qp = (const LAS v2u*)(hb + ((n >> 2) & 1) * 1536 + (16 * s4 + 4 * g + (n & 3)) * 24); const v2u q0 = qp[0], q1 = qp[1], q2 = qp[2];
        bv[s4] = (v8i){(int)q0.x, (int)q0.y, (int)q1.x, (int)q1.y, (int)q2.x, (int)q2.y, 0, 0}; }
    const unsigned lo16 = 64 * g + 16 * c, lo8 = 1024 + 32 * g + 8 * c;
    const float fm = n < 4 ? 1.0f : (n < 8 ? 0.0625f : 0.0f);
    const bool s1 = (n & 3) == 1, s2 = (n & 3) == 2, s3 = (n & 3) == 3;
    LAS float* wout = dotsT + (n == 0 ? g * 32 : 128 + lane);
    SCHED_FENCE(); __builtin_amdgcn_s_waitcnt(0x0070); SCHED_FENCE();
    sc[0] = SU[il]; sc[1] = SU[ih]; sc[2] = SV[il]; sc[3] = SV[ih]; SCHED_FENCE();
    if (nxt) { peer_tok_load(F, nrow, *nxt); SCHED_FENCE(); }
    constexpr int NG = 4 * NEG; const int m0 = kb >> 2;
    v4u ra[4][4]; v2u rb[4][4];
#define U_LOAD(R_, m_) { const int mm_ = m0 + (m_); const unsigned e_ = (unsigned)__builtin_amdgcn_ds_bpermute(((4 * mm_ + ep) & 63) * 4, (4 * mm_ < 64) ? il : ih) & emask; const unsigned o_ = e_ * (unsigned)EROW; \
        _Pragma("unroll") for (int s4 = 0; s4 < 4; ++s4) { ra[R_][s4] = __builtin_bit_cast(v4u, __builtin_amdgcn_raw_buffer_load_b128(TB, o_ + lo16, 256 * s4, 0)); rb[R_][s4] = __builtin_bit_cast(v2u, __builtin_amdgcn_raw_buffer_load_b64(TB, o_ + lo8, 128 * s4, 0)); } }
#define U_COMP(R_, m_) { f32x4 ac_ = {0.f, 0.f, 0.f, 0.f}; \
        _Pragma("unroll") for (int s4 = 0; s4 < 4; ++s4) { const v8i av = {(int)ra[R_][s4].x, (int)ra[R_][s4].y, (int)ra[R_][s4].z, (int)ra[R_][s4].w, (int)rb[R_][s4].x, (int)rb[R_][s4].y, 0, 0}; \
            ac_ = __builtin_amdgcn_mfma_scale_f32_16x16x128_f8f6f4(av, bv[s4], ac_, 2, 2, 0, 0, 0, 0); } \
        float v_ = s1 ? ac_[1] : ac_[0]; v_ = s2 ? ac_[2] : v_; v_ = s3 ? ac_[3] : v_; v_ = red8(v_ * fm); wout[m0 + (m_)] = v_; }
    U_LOAD(0, 0); SCHED_FENCE(); U_LOAD(1, 1); SCHED_FENCE(); U_LOAD(2, 2); SCHED_FENCE();
#pragma unroll
    for (int m = 0; m < NG; m += 4) {
        U_LOAD(3, m + 3); SCHED_FENCE(); U_COMP(0, m); SCHED_FENCE();
        if (m + 4 < NG) { U_LOAD(0, m + 4); } SCHED_FENCE(); U_COMP(1, m + 1); SCHED_FENCE();
        if (m + 5 < NG) { U_LOAD(1, m + 5); } SCHED_FENCE(); U_COMP(2, m + 2); SCHED_FENCE();
        if (m + 6 < NG) { U_LOAD(2, m + 6); } SCHED_FENCE(); U_COMP(3, m + 3); SCHED_FENCE(); }
#undef U_LOAD
#undef U_COMP
    asm volatile("" ::: "memory");
    return sh;
}
template <int EB, int NEG> __device__ __forceinline__ void peer_token(Frame& F, int l, int row, int kb, float (&acc)[32], unsigned emask = ~0u, const PeerTok* cur = nullptr, int nrow = -1, PeerTok* nxt = nullptr) {
    const int lane = F.lane, ke = kb + 16 * NEG; const unsigned lo16 = lane * 16;
    const __amdgpu_buffer_rsrc_t TB = __builtin_amdgcn_make_buffer_rsrc((void*)(F.ws + WS_UB + (size_t)l * PE_NE * EROW), 0, 0xffffffffu, 0x00020000);
    constexpr unsigned VB = (unsigned)(WS_VB - WS_UB);
    static_assert(WS_VB > WS_UB && (size_t)(WS_VB - WS_UB) + (size_t)PE_NE * EROW < 0xffffffffull, "table offsets must fit the 32-bit buffer offset");
    LAS float* dots = (LAS float*)(F.lds + 49152) + F.wave * 224;
    LAS unsigned char* hb = F.lds + 57344 + F.wave * 3072;
    const float* SU = (const float*)(F.ws + WS_SU) + (size_t)l * PE_NE; const float* SV = (const float*)(F.ws + WS_SV) + (size_t)l * PE_NE;
    const bf16* H = (const bf16*)(F.ws + WS_H);
    const int* IDX = (const int*)(F.ws + WS_IDX) + (size_t)row * PE_SEL; const float* GT = (const float*)(F.ws + WS_GATE) + (size_t)row * PE_SEL;
    PeerTok me; if (cur) me = *cur; else peer_tok_load(F, row, me);
    const int il = me.il, ih = me.ih; const float gl = me.gl, gh = me.gh;
    float sh, sc4[4];
    { f32p hf[16];
#pragma unroll
      for (int q = 0; q < 8; ++q) { const v2u t2 = me.h2[q]; hf[2 * q] = (f32p){bf_lo(t2.x), bf_hi(t2.x)}; hf[2 * q + 1] = (f32p){bf_lo(t2.y), bf_hi(t2.y)}; }
      sh = u_dots_mfma<NEG>(F, TB, il, ih, kb, emask, hf, hb, dots, SU, SV, sc4, nrow, nxt); }
    v6u a0[EB], a1[EB], a2[EB];
#define V_LD(A_, B_, k_) ld_rows<EB>(TB, VB, (k_) < 64 ? il : ih, (k_), lo16, emask, A_); SCHED_FENCE()
#define V_DO(A_, B_, k_) v_batch<EB>(A_, (k_), (k_) < 64 ? cl : ch, ac2); SCHED_FENCE()
    V_LD(a0, b0, kb); V_LD(a1, b1, kb + EB);
    const float sul = sc4[0], suh = sc4[1], svl = sc4[2], svh = sc4[3];
    const float rsh = 1.0f / sh, dl = dots[(lane & 3) * 32 + (lane >> 2)] * rsh, dh = dots[(lane & 3) * 32 + 16 + (lane >> 2)] * rsh;
    const float cl = gl * svl * gelu_erf(dl * sul), ch = gh * svh * gelu_erf(dh * suh);
    f32p ac2[16];
#pragma unroll
    for (int i = 0; i < 16; ++i) ac2[i] = (f32p){0.f, 0.f};
    static_assert((16 * NEG / EB) % 3 == 2, "the ring schedule below leaves exactly two loaded batches for the epilogue");
    int k0 = kb;
#pragma unroll 1
    for (; k0 + 4 * EB < ke; k0 += 3 * EB) {
        V_LD(a2, b2, k0 + 2 * EB); V_DO(a0, b0, k0);
        V_LD(a0, b0, k0 + 3 * EB); V_DO(a1, b1, k0 + EB);
        V_LD(a1, b1, k0 + 4 * EB); V_DO(a2, b2, k0 + 2 * EB); }
    V_DO(a0, b0, k0); V_DO(a1, b1, k0 + EB);
#undef V_LD
#undef V_DO
#pragma unroll
    for (int i = 0; i < 16; ++i) { acc[2 * i] = ac2[i].x; acc[2 * i + 1] = ac2[i].y; }
}
constexpr int PVEC_OFF = 81920;
__device__ __forceinline__ void peer_vectors(Frame& F, int l) {
    LAS bf16* VL = (LAS bf16*)(F.lds + PVEC_OFF);
    for (int i = F.tid; i < 11 * (D / 4); i += NTHR) { const int vec = i / (D / 4), e = (i % (D / 4)) * 4; const float* src;
        if (vec < 9) { const int v = vec / 3, kind = vec % 3; src = kind == 0 ? (const float*)(F.ws + WS_MOD) + ((size_t)l * 3 + v) * (6 * D) + 5 * D : (const float*)(F.ws + WS_MOD) + ((size_t)(l + 1 < DEPTH ? l + 1 : l) * 3 + v) * (6 * D) + (kind - 1) * D; }
        else src = gin(F.in[vec == 9 ? I_LN2G : I_LN2B]) + (size_t)l * D;
        const f32x4 x = *(const f32x4*)(src + e); *(LAS v2u*)(VL + vec * D + e) = (v2u){pk2(x.x, x.y), pk2(x.z, x.w)}; }
    __syncthreads();
}
__device__ __forceinline__ f32x4 pvec4(const LAS bf16* p) { const v2u w = *(const LAS v2u*)p; return (f32x4){bf_lo(w.x), bf_hi(w.x), bf_lo(w.y), bf_hi(w.y)}; }
__device__ __forceinline__ void peer_finish(Frame& F, int l, int row, const float (&acc)[32], bool dry) {
    const int lane = F.lane;
    bf16* X = (bf16*)(F.ws + WS_X); bf16* H = (bf16*)(F.ws + WS_H); bf16* Xo = dry ? (bf16*)(F.ws + WS_LA) : X; bf16* Ho = dry ? (bf16*)(F.ws + WS_LB) : H; float* Oo = dry ? (float*)(F.ws + WS_LA) : (float*)F.out;
    const LAS bf16* VL = (const LAS bf16*)(F.lds + PVEC_OFF) + mod_row(row) * 3 * D; const LAS bf16* LG = (const LAS bf16*)(F.lds + PVEC_OFF) + 9 * D;
    float z[32]; float s = 0.f;
#pragma unroll
    for (int q = 0; q < 8; ++q) { const int e = q * 256 + lane * 4; const v2u xw = *(const v2u*)(X + (size_t)row * D + e); const f32x4 xv = {bf_lo(xw.x), bf_hi(xw.x), bf_lo(xw.y), bf_hi(xw.y)}, gv = pvec4(VL + e);
        z[q * 4 + 0] = ALPHA * xv.x + gv.x * acc[q * 4 + 0]; z[q * 4 + 1] = ALPHA * xv.y + gv.y * acc[q * 4 + 1]; z[q * 4 + 2] = ALPHA * xv.z + gv.z * acc[q * 4 + 2]; z[q * 4 + 3] = ALPHA * xv.w + gv.w * acc[q * 4 + 3]; }
#pragma unroll
    for (int i = 0; i < 32; ++i) s += z[i];
    const float mean = wave_sum(s) * (1.0f / D); float qv = 0.f;
#pragma unroll
    for (int i = 0; i < 32; ++i) { z[i] -= mean; qv += z[i] * z[i]; }
    const float rstd = __builtin_amdgcn_rsqf(wave_sum(qv) * (1.0f / D) + LN_EPS);
    unsigned hw[16];
#pragma unroll
    for (int q = 0; q < 8; ++q) { const int e = q * 256 + lane * 4; const f32x4 g4 = pvec4(LG + e), b4 = pvec4(LG + D + e);
        f32x4 o; o.x = z[q * 4 + 0] * rstd * g4.x + b4.x; o.y = z[q * 4 + 1] * rstd * g4.y + b4.y; o.z = z[q * 4 + 2] * rstd * g4.z + b4.z; o.w = z[q * 4 + 3] * rstd * g4.w + b4.w;
        if (l + 1 < DEPTH) { *(v2u*)(Xo + (size_t)row * D + e) = (v2u){pk2(o.x, o.y), pk2(o.z, o.w)}; const f32x4 s4 = pvec4(VL + D + e), c4 = pvec4(VL + 2 * D + e);
            hw[2 * q] = pk2(o.x * (1.f + c4.x) + s4.x, o.y * (1.f + c4.y) + s4.y); hw[2 * q + 1] = pk2(o.z * (1.f + c4.z) + s4.z, o.w * (1.f + c4.w) + s4.w); }
        else *(f32x4*)(Oo + (size_t)row * D + e) = o; }
    if (l + 1 < DEPTH) {
#pragma unroll
        for (int q = 0; q < 8; ++q) *(v2u*)(Ho + (size_t)row * D + q * 256 + lane * 4) = (v2u){hw[2 * q], hw[2 * q + 1]}; }
}
__device__ __forceinline__ void peer_rows(Frame& F, int l, int nrows, bool dry = false) {
    const int gw = F.vcu * NWAVES + F.wave, NGW = F.G * NWAVES, lane = F.lane;
    peer_vectors(F, l);
    { PeerTok tk; if (gw < NLAT) peer_tok_load(F, gw, tk);
      for (int row = gw; row < NLAT; row += NGW) { Frame F2 = F; { int t_ = F.lane; asm volatile("" : "+v"(t_)); F2.lane = t_; }
        float acc[32]; PeerTok nx; const int nrow = row + NGW; const bool more = nrow < NLAT;
        peer_token<EBU_, 8>(F2, l, row, 0, acc, dry ? GPROBE_MASK : ~0u, &tk, nrow, more ? &nx : nullptr); { int t_ = F2.lane; asm volatile("" : "+v"(t_)); F2.lane = t_; } peer_finish(F2, l, row, acc, dry);
        if (more) tk = nx; } }
    if (nrows > NLAT) { LAS float* PART = (LAS float*)F.lds;
        for (int r2 = F.vcu * 2 + (F.wave >> 2); r2 < NCTX; r2 += F.G * 2) { const int row = NLAT + r2, part = F.wave & 3, slot = F.wave >> 2; float acc[32]; Frame F2 = F; { int t_ = F.lane; asm volatile("" : "+v"(t_)); F2.lane = t_; }
            peer_token<EBU_, 2>(F2, l, row, 32 * part, acc, dry ? GPROBE_MASK : ~0u);
            if (part) { LAS float* pw = PART + ((slot * 3 + part - 1) * 32) * 64 + lane;
#pragma unroll
                for (int i = 0; i < 32; ++i) pw[i * 64] = acc[i]; }
            __syncthreads();
            if (part == 0) { const LAS float* pr = PART + (slot * 96) * 64 + lane;
#pragma unroll
                for (int p = 0; p < 3; ++p)
#pragma unroll
                    for (int i = 0; i < 32; ++i) acc[i] += pr[(p * 32 + i) * 64];
                peer_finish(F2, l, row, acc, dry); }
            __syncthreads(); } }
}
#ifndef MK_PER_PHASE
#define MK_PER_PHASE 0
#endif
constexpr int NPH_PRO = 3, NPH_LAYER = 9, NPHASES = NPH_PRO + DEPTH * NPH_LAYER;
__global__ void __launch_bounds__(NTHR, 2) trunk_fwd(Args args) {
    extern __shared__ __attribute__((aligned(16))) unsigned char lds_raw[];
    Frame F0;
    F0.lds = (LAS unsigned char*)lds_raw;
    F0.tid = threadIdx.x; F0.lane = F0.tid & 63; F0.wave = __builtin_amdgcn_readfirstlane(F0.tid >> 6);
    F0.G = gridDim.x; { const int bx = blockIdx.x; F0.vcu = (F0.G % 8 == 0) ? (bx % 8) * (F0.G / 8) + bx / 8 : bx; }
    F0.in = args.in; F0.out = (GAS float*)args.out; F0.ws = (GAS unsigned char*)args.ws;
    volatile LAS unsigned* MISC = (volatile LAS unsigned*)(F0.lds + MISC_OFF);
    for (int u = F0.tid; u < (LDS_BYTES - LDSCTL_OFF) / 4; u += NTHR) ((LAS unsigned*)(F0.lds + LDSCTL_OFF))[u] = 0u;
    __syncthreads();
    const int lo = args.ph_lo, hi = args.ph_hi;
    XcdBarrier bar; bar.bar = (unsigned*)(F0.ws + WS_CTL) + CW_BAR; bar.x = 0; bar.st = nullptr;
    if (hi - lo > 1) bar = xcd_barrier_post((unsigned*)(F0.ws + WS_CTL) + CW_BAR, MISC + 8);
#ifndef PHMASK
#define PHMASK 0xfff
#endif
#define PHM(b) ((PHMASK >> (b)) & 1)
#ifndef PHREP
#define PHREP 0
#endif
#define NREP(b) (1 + ((PHREP >> (b)) & 1))
#define IN(k) (lo <= (k) && (k) < hi)
#define LAUNDER() Frame F = F0; int bx_ = blockIdx.x; __builtin_amdgcn_s_waitcnt(0x0070); { int ws_ = F0.wave; asm volatile("" : "+s"(ws_)); int ln_; asm volatile("v_mbcnt_lo_u32_b32 %0, -1, 0\n\tv_mbcnt_hi_u32_b32 %0, -1, %0" : "=v"(ln_)); F.wave = ws_; F.lane = ln_; F.tid = ws_ * 64 + ln_; \
    GAS unsigned char* w_ = F0.ws; asm volatile("" : "+s"(w_)); F.ws = w_; int v_ = F0.vcu; asm volatile("" : "+s"(v_)); F.vcu = v_; int g_ = F0.G; asm volatile("" : "+s"(g_)); F.G = g_; \
    GAS float* o_ = F0.out; asm volatile("" : "+s"(o_)); F.out = o_; asm volatile("" : "+s"(bx_)); \
    unsigned l_ = (unsigned)(size_t)F0.lds; asm volatile("" : "+v"(l_)); F.lds = (LAS unsigned char*)(size_t)l_; }
#define SEAM(k) do { if (IN(k) && IN((k) + 1)) xcd_barrier(bar); } while (0)

    if (PHM(0) && IN(0)) for (int rep_ = 0; rep_ < NREP(0); ++rep_) { LAUNDER(); p0_prologue(F); } SEAM(0);
    if (PHM(1) && IN(1)) { LAUNDER(); p0b_mod_reduce(F); } SEAM(1);
    if (PHM(2) && IN(2)) { LAUNDER(); modulate_rows(F, 0, 0, MTOT); } SEAM(2);

#pragma unroll 1
    for (int l = 0; l < DEPTH; ++l) {
        const int pb = NPH_PRO + l * NPH_LAYER;
        const int mrows = (l + 1 < DEPTH) ? MTOT : NLAT;
        if (PHM(3) && IN(pb + 0)) for (int rep_ = 0; rep_ < NREP(3); ++rep_) { LAUNDER(); pg8::Gemm g{(const pg8::bf16_t*)(F.ws + WS_H), (const pg8::bf16_t*)(F.ws + WS_WIN) + (size_t)l * IN_PAD * D, MTOT, IN_PAD, D, D};
            pg8::StaticOrder S; S.init(MTOT, IN_PAD, F.G, bx_); pg8::EpiBf16<0> E{(pg8::bf16_t*)(F.ws + WS_P), IN_PAD, nullptr, 0, 0};
            pg8::gemm_phase<pg8::EpiBf16<0>, pg8::StaticOrder, false>(F.lds, g, S, E, nullptr, F.tid); }
        SEAM(pb + 0);
        if (PHM(4) && IN(pb + 1)) for (int rep_ = 0; rep_ < NREP(4); ++rep_) { LAUNDER(); for (int r2 = 0; r2 < NREP(12); ++r2) { v4u in_ = {0u, 0u, 0u, 0u}, in2_ = in_; bool hv_ = false; for (int u = F.vcu; u < NTILE * NH; u += F.G) { const int nu_ = u + F.G < NTILE * NH ? u + F.G : -1; lru_prep_unit(F, l, u >> 4, u & 15, in_, in2_, hv_, nu_); hv_ = nu_ >= 0; } } asm volatile("" ::: "memory"); for (int r2 = 0; r2 < NREP(13); ++r2) { int cur_hd = -1;
                for (int v = F.vcu; v < 2 * NTILE * NH; v += F.G) { const int hh_ = (v >> 1) & 15, d_ = v & 1;
                    if (hh_ * 2 + d_ != cur_hd) { cur_hd = hh_ * 2 + d_; __syncthreads(); LAS float* MUS = (LAS float*)(F.lds + 125184); const float* mu = gin(F.in[I_MU]) + (size_t)l * 2 * RW_COLS;
                        for (int i = F.tid; i < 5 * 2 * 64; i += NTHR) { const int g = i >> 7, wh = (i >> 6) & 1, col = i & 63; const int rc = g < 3 ? g * RWW + hh_ * 64 : 3 * RWW + (g - 3) * 128 + d_ * 64; MUS[i] = mu[(size_t)wh * RW_COLS + rc + col]; }
                        __syncthreads(); }
                    rwkv_chunk_prep(F, l, v >> 5, hh_, d_); } } }
        SEAM(pb + 1);
        if (PHM(5) && IN(pb + 2)) for (int rep_ = 0; rep_ < NREP(5); ++rep_) { LAUNDER(); for (int u = F.vcu; u < 256; u += F.G) { if (u < 32 && F.wave >= 2 && F.wave < 4) lru_scan(F, u * 128 + F.tid - 128); rwkv_chain_chunks(F, u); } }
        SEAM(pb + 2);
        if (PHM(6) && IN(pb + 3)) for (int rep_ = 0; rep_ < NREP(6); ++rep_) { LAUNDER(); for (int u = F.vcu; u < 8 * NTILE; u += F.G) merge_unit(F, l, u); }
        SEAM(pb + 3);
        const bool defer = (l + 1 < DEPTH) && F0.G > 4 * CTX_TILES;
        if (PHM(7) && IN(pb + 4)) for (int rep_ = 0; rep_ < NREP(7); ++rep_) { LAUNDER(); const int mr = defer ? NLAT : mrows; pg8::Gemm g{(const pg8::bf16_t*)(F.ws + WS_H), (const pg8::bf16_t*)(F.ws + WS_WOUT) + (size_t)l * D * D, mr, D, D, D};
            pg8::StaticOrder S; S.init(mr, D, F.G, bx_); pg8::EpiBf16<0> E{(pg8::bf16_t*)(F.ws + WS_O), D, nullptr, 0, 0};
            pg8::gemm_phase<pg8::EpiBf16<0>, pg8::StaticOrder, false>(F.lds, g, S, E, nullptr, F.tid); }
        SEAM(pb + 4);
        if (PHM(8) && IN(pb + 5)) { LAUNDER();
            if (defer) { unsigned* cnt = (unsigned*)(F.ws + WS_CTL) + CW_CTX + 64 * (2 * l);
                if (bx_ < 2 * CTX_TILES) { pg8::Gemm g{(const pg8::bf16_t*)(F.ws + WS_H), (const pg8::bf16_t*)(F.ws + WS_WOUT) + (size_t)l * D * D, MTOT, D, D / 2, D};
                    pg8::CtxOrder S{NLAT / 256, D / 256, CTX_TILES, bx_, cnt, F.lane == 0, 2, D / 2};
                    pg8::bf16_t* obase = (bx_ & 1) ? (pg8::bf16_t*)(F.ws + WS_SLAB) - (size_t)NLAT * D : (pg8::bf16_t*)(F.ws + WS_O);
                    pg8::EpiBf16<0> E{obase, D, nullptr, 0, 0};
                    pg8::gemm_phase<pg8::EpiBf16<0>, pg8::CtxOrder, false>(F.lds, g, S, E, nullptr, F.tid); }
                else { Frame F2 = F; F2.vcu = bx_ - 2 * CTX_TILES; F2.G = F.G - 2 * CTX_TILES; ln1_rows(F2, l, MTOT, false, cnt, 16u * CTX_TILES, (const bf16*)(F.ws + WS_SLAB)); } }
            else ln1_rows(F, l, mrows); }
        SEAM(pb + 5);
        if (PHM(9) && IN(pb + 6)) for (int rep_ = 0; rep_ < NREP(9); ++rep_) { LAUNDER(); const int mr = defer ? NLAT : mrows; pg8::Gemm g{(const pg8::bf16_t*)(F.ws + WS_H), (const pg8::bf16_t*)(F.ws + WS_WQ) + (size_t)l * D * D, mr, D, D, D};
            pg8::StaticOrder S; S.init(mr, D, F.G, bx_); pg8::EpiBf16<0> E{(pg8::bf16_t*)(F.ws + WS_QP), D, nullptr, 0, 0};
            pg8::gemm_phase<pg8::EpiBf16<0>, pg8::StaticOrder, false>(F.lds, g, S, E, nullptr, F.tid); }
        SEAM(pb + 6);
        if (PHM(10) && IN(pb + 7)) { LAUNDER();
            if (defer) { unsigned* cnt = (unsigned*)(F.ws + WS_CTL) + CW_CTX + 64 * (2 * l + 1);
                if (bx_ < CTX_TILES) { pg8::Gemm g{(const pg8::bf16_t*)(F.ws + WS_H), (const pg8::bf16_t*)(F.ws + WS_WQ) + (size_t)l * D * D, MTOT, D, D, D};
                    pg8::CtxOrder S{NLAT / 256, D / 256, CTX_TILES, bx_, cnt, F.lane == 0}; pg8::EpiBf16<0> E{(pg8::bf16_t*)(F.ws + WS_QP), D, nullptr, 0, 0};
                    pg8::gemm_phase<pg8::EpiBf16<0>, pg8::CtxOrder, false>(F.lds, g, S, E, nullptr, F.tid); }
                else { bool waited = false;
                    for (int u = bx_ - CTX_TILES; u < (MTOT / 64) * PE_H; u += F.G - CTX_TILES) { if (u >= (NLAT / 64) * PE_H && !waited) { ctx_wait(cnt, 8u * CTX_TILES); waited = true; } peer_topk_unit(F, l, u >> 3, u & 7); } } }
            else for (int u = F.vcu; u < (mrows / 64) * PE_H; u += F.G) peer_topk_unit(F, l, u >> 3, u & 7); }
        SEAM(pb + 7);
        if (PHM(11) && IN(pb + 8)) { LAUNDER(); for (int rep_ = 0; rep_ < NREP(11); ++rep_) { int dry_ = rep_ + 1 < NREP(11); if (NREP(11) > 1) asm volatile("" : "+s"(dry_)); peer_rows(F, l, mrows, dry_ != 0); } }
        if (l + 1 < DEPTH) SEAM(pb + 8);
    }
#undef IN
#undef SEAM
}

extern "C" void kernel_launch(void* const* d_in, const int* in_sizes, int n_in, void* d_out, int out_size, void* d_ws, size_t ws_size, hipStream_t stream) {
    static int grid = 0;
    if (grid == 0) {
        if (n_in != N_IN || out_size != NLAT * D || ws_size < WS_END) { fprintf(stderr, "kernel_launch: unexpected shapes (n_in %d, out %d, ws %zu < %zu)\n", n_in, out_size, ws_size, (size_t)WS_END); grid = -1; return; }
        int dev = 0, cus = 0, per_cu = 0;
        if (hipGetDevice(&dev) != hipSuccess || hipDeviceGetAttribute(&cus, hipDeviceAttributeMultiprocessorCount, dev) != hipSuccess) { grid = -1; return; }
        if (hipFuncSetAttribute((const void*)trunk_fwd, hipFuncAttributeMaxDynamicSharedMemorySize, LDS_BYTES) != hipSuccess) { fprintf(stderr, "kernel_launch: hipFuncSetAttribute failed\n"); grid = -1; return; }
        if (hipOccupancyMaxActiveBlocksPerMultiprocessor(&per_cu, (const void*)trunk_fwd, NTHR, LDS_BYTES) != hipSuccess || per_cu < 1) fprintf(stderr, "kernel_launch: occupancy query reports %d\n", per_cu);
        (void)hipGetLastError();
        grid = cus;
    }
    if (grid < 0) return;
    (void)hipMemsetAsync((char*)d_ws + WS_CTL, 0, CTL_ZERO_BYTES, stream);
    Args a{};
    for (int i = 0; i < N_IN; ++i) a.in[i] = (const float*)d_in[i];
    a.out = (float*)d_out; a.ws = (unsigned char*)d_ws;
#if MK_PER_PHASE
    for (int ph = 0; ph < NPHASES; ++ph) { a.ph_lo = ph; a.ph_hi = ph + 1; hipLaunchKernelGGL(trunk_fwd, dim3(grid), dim3(NTHR), LDS_BYTES, stream, a); }
#else
    a.ph_lo = 0; a.ph_hi = NPHASES;
    hipLaunchKernelGGL(trunk_fwd, dim3(grid), dim3(NTHR), LDS_BYTES, stream, a);
#endif
    const hipError_t le = hipPeekAtLastError();
    if (le != hipSuccess) fprintf(stderr, "kernel_launch: launch failed: %s\n", hipGetErrorName(le));
}
```
